# Optimizing an MI355X kernel written in HIP

```python
import math
import jax
import jax.numpy as jnp
from jax import lax
import numpy as np

D_MODEL = 1024
BATCH = 16
SEQ = 2048
DEPTH = 4

GRID_W = 64
CTX_LEN = 256
NORM_EPS = 1e-6
HEAD_DIM = D_MODEL // 16

GLA_HEADS = 4
GLA_DV = HEAD_DIM
GLA_DK = HEAD_DIM // 2
GLA_GATE_RANK = 16
GLA_TAU = 16.0
GLA_CHUNK = 64

NAT_HEADS = 4
NAT_DH = HEAD_DIM
NAT_WIN_R = 8
NAT_WIN_C = 16

DIFF_HEADS = 4
DIFF_DH = HEAD_DIM
Q_BLOCK = 128
ROPE_BASE = 10000.0

PEER_HEADS = 8
PEER_NKEYS = 128
PEER_EXPERTS = PEER_NKEYS * PEER_NKEYS
PEER_QDIM = 128
PEER_HALF = PEER_QDIM // 2
PEER_TOPK = 16
PEER_TOKEN_BLOCK = 128

GLA_WIDTH = GLA_HEADS * GLA_DV
NAT_WIDTH = NAT_HEADS * NAT_DH
DIFF_WIDTH = DIFF_HEADS * 2 * DIFF_DH
MIX_WIDTH = GLA_WIDTH + NAT_WIDTH + DIFF_WIDTH
PROJ_SIZES = (GLA_HEADS * GLA_DK, GLA_HEADS * GLA_DK, GLA_WIDTH, GLA_WIDTH, GLA_GATE_RANK, GLA_GATE_RANK,
              NAT_WIDTH, NAT_WIDTH, NAT_WIDTH, DIFF_WIDTH, DIFF_WIDTH, DIFF_WIDTH)
PROJ_WIDTH = sum(PROJ_SIZES)

kernel_name = "hybrid_gla_natten_diffattn_peer_dit"


def rms_norm(x, g):
    xf = x.astype(jnp.float32)
    y = xf * lax.rsqrt(jnp.mean(xf * xf, axis=-1, keepdims=True) + NORM_EPS)
    return (y * g.astype(jnp.float32)).astype(x.dtype)


def modulate(x, g, shift, scale):
    return rms_norm(x, g) * (1 + scale) + shift


def heads(t, n):
    return t.reshape(t.shape[:-1] + (n, t.shape[-1] // n))


def flip(t):
    return jnp.flip(t, axis=1)


def split_proj(p):
    points = np.cumsum(PROJ_SIZES)[:-1].tolist()
    return jnp.split(p, points, axis=-1)


def head_rms(o, g):
    of = o.astype(jnp.float32)
    of = of * lax.rsqrt(jnp.mean(of * of, axis=-1, keepdims=True) + NORM_EPS)
    return of.reshape(of.shape[:-2] + (-1,)) * g.astype(jnp.float32)


def gla_scan(q, k, v, g, s0):
    B, L, H, K = q.shape
    V = v.shape[-1]
    n = L // GLA_CHUNK

    def to_chunks(t):
        return t.reshape(B, n, GLA_CHUNK, H, t.shape[-1]).transpose(1, 0, 3, 2, 4).astype(jnp.float32)

    qc, kc, vc, gc = (to_chunks(t) for t in (q, k, v, g))
    mask = jnp.tril(jnp.ones((GLA_CHUNK, GLA_CHUNK), dtype=bool))[:, :, None]

    def step(s, inp):
        qi, ki, vi, gi = inp
        b = jnp.cumsum(gi, axis=2)
        diff = b[:, :, :, None, :] - b[:, :, None, :, :]
        decay = jnp.exp(jnp.where(mask, diff, -jnp.inf))
        a = jnp.einsum('bhik,bhjk,bhijk->bhij', qi, ki, decay)
        o = jnp.einsum('bhij,bhjv->bhiv', a, vi) + jnp.einsum('bhik,bhkv->bhiv', qi * jnp.exp(b), s)
        b_last = b[:, :, -1, :]
        s_new = jnp.exp(b_last)[..., None] * s + jnp.einsum(
            'bhjk,bhjv->bhkv', ki * jnp.exp(b_last[:, :, None, :] - b), vi)
        return s_new, o

    s_fin, o = lax.scan(step, s0.astype(jnp.float32), (qc, kc, vc, gc))
    o = o.transpose(1, 0, 3, 2, 4).reshape(B, L, H, V)
    return o, s_fin


def gla_final_state(k, v, g):
    b = jnp.cumsum(g.astype(jnp.float32), axis=1)
    w = jnp.exp(b[:, -1:] - b)
    return jnp.einsum('blhk,blhv->bhkv', k.astype(jnp.float32) * w, v.astype(jnp.float32))


def gla_inputs(p, gate_up, gate_b):
    q = heads(p[0], GLA_HEADS) * GLA_DK ** -0.5
    k = heads(p[1], GLA_HEADS)
    v = heads(p[2], GLA_HEADS)
    g_f = heads(jax.nn.log_sigmoid((p[4] @ gate_up[0] + gate_b[0]).astype(jnp.float32)) / GLA_TAU, GLA_HEADS)
    g_b = heads(jax.nn.log_sigmoid((p[5] @ gate_up[1] + gate_b[1]).astype(jnp.float32)) / GLA_TAU, GLA_HEADS)
    return q, k, v, g_f, g_b


def gla_output(o, r, norm_g):
    return (head_rms(o, norm_g) * jax.nn.silu(r.astype(jnp.float32))).astype(r.dtype)


def gla_mix(p, pc, gate_up, gate_b, norm_g, need_ctx):
    q, k, v, g_f, g_b = gla_inputs(p, gate_up, gate_b)
    qc, kc, vc, gc_f, gc_b = gla_inputs(pc, gate_up, gate_b)
    s_f = gla_final_state(kc, vc, gc_f)
    s_b = gla_final_state(flip(kc), flip(vc), flip(gc_b))
    o = gla_scan(q, k, v, g_f, s_f)[0] + flip(gla_scan(flip(q), flip(k), flip(v), flip(g_b), s_b)[0])
    y = gla_output(o, p[3], norm_g)
    if not need_ctx:
        return y, None
    zero = jnp.zeros_like(s_f)
    oc = gla_scan(qc, kc, vc, gc_f, zero)[0] + flip(gla_scan(flip(qc), flip(kc), flip(vc), flip(gc_b), zero)[0])
    return y, gla_output(oc, pc[3], norm_g)


def neighbourhood_attention(q, k, v, kc, vc, rpb):
    B, S, H, d = q.shape
    rows = S // GRID_W
    wr = min(NAT_WIN_R, rows)
    r = jnp.arange(rows)
    row_start = jnp.clip(r - wr // 2, 0, rows - wr)
    row_idx = row_start[:, None] + jnp.arange(wr)[None, :]
    cidx = jnp.arange(GRID_W)
    col_start = jnp.clip(cidx - NAT_WIN_C // 2, 0, GRID_W - NAT_WIN_C)
    col_mask = (cidx[None, :] >= col_start[:, None]) & (cidx[None, :] < col_start[:, None] + NAT_WIN_C)
    dr = row_idx - r[:, None] + NAT_WIN_R - 1
    dc = jnp.clip(cidx[None, :] - cidx[:, None] + NAT_WIN_C - 1, 0, 2 * NAT_WIN_C - 2)
    bias = rpb[:, dr[:, None, :, None], dc[None, :, None, :]].astype(jnp.float32)

    scale = d ** -0.5
    qg = q.reshape(B, rows, GRID_W, H, d)
    kg = k.reshape(B, rows, GRID_W, H, d)[:, row_idx]
    vg = v.reshape(B, rows, GRID_W, H, d)[:, row_idx]
    s_win = jnp.einsum('brchd,brjkhd->bhrcjk', qg, kg).astype(jnp.float32) * scale + bias[None]
    s_win = jnp.where(col_mask[:, None, :], s_win, -jnp.inf)
    s_ctx = jnp.einsum('brchd,bmhd->bhrcm', qg, kc).astype(jnp.float32) * scale
    n_win = wr * GRID_W
    s = jnp.concatenate([s_win.reshape(B, H, rows, GRID_W, n_win), s_ctx], axis=-1)
    p = jax.nn.softmax(s, axis=-1).astype(v.dtype)
    p_win = p[..., :n_win].reshape(B, H, rows, GRID_W, wr, GRID_W)
    p_ctx = p[..., n_win:]
    o = jnp.einsum('bhrcjk,brjkhd->brchd', p_win, vg) + jnp.einsum('bhrcm,bmhd->brchd', p_ctx, vc)
    return o.reshape(B, S, H * d)


def softmax_attention(q, k, v):
    s = jnp.einsum('bqhd,bkhd->bhqk', q, k).astype(jnp.float32) * q.shape[-1] ** -0.5
    p = jax.nn.softmax(s, axis=-1).astype(v.dtype)
    return jnp.einsum('bhqk,bkhd->bqhd', p, v)


def rope_1d(x, pos):
    half = x.shape[-1] // 2
    inv = ROPE_BASE ** (-jnp.arange(half, dtype=jnp.float32) / half)
    ang = pos.astype(jnp.float32)[:, None] * inv[None, :]
    cos = jnp.cos(ang)[None, :, None, :]
    sin = jnp.sin(ang)[None, :, None, :]
    x1 = x[..., :half].astype(jnp.float32)
    x2 = x[..., half:].astype(jnp.float32)
    return jnp.concatenate([x1 * cos - x2 * sin, x2 * cos + x1 * sin], axis=-1).astype(x.dtype)


def rope_axial(x, row, col):
    h = x.shape[-1] // 2
    return jnp.concatenate([rope_1d(x[..., :h], row), rope_1d(x[..., h:], col)], axis=-1)


def diff_inputs(p):
    q = p[9].reshape(p[9].shape[:-1] + (DIFF_HEADS, 2, DIFF_DH))
    k = p[10].reshape(p[10].shape[:-1] + (DIFF_HEADS, 2, DIFF_DH))
    v = heads(p[11], DIFF_HEADS)
    return q[..., 0, :], q[..., 1, :], k[..., 0, :], k[..., 1, :], v


def diff_core(q1, q2, k1, k2, v, lam):
    scale = q1.shape[-1] ** -0.5
    a1 = jax.nn.softmax(jnp.einsum('bqhd,bkhd->bhqk', q1, k1).astype(jnp.float32) * scale, axis=-1)
    a2 = jax.nn.softmax(jnp.einsum('bqhd,bkhd->bhqk', q2, k2).astype(jnp.float32) * scale, axis=-1)
    return jnp.einsum('bhqk,bkhe->bqhe', (a1 - lam * a2).astype(v.dtype), v)


def diff_attention_latent(q1, q2, k1, k2, v, k1c, k2c, vc, lam):
    B, S, H, d = q1.shape
    k1a = jnp.concatenate([k1c, k1], axis=1)
    k2a = jnp.concatenate([k2c, k2], axis=1)
    va = jnp.concatenate([vc, v], axis=1)
    nb = S // Q_BLOCK

    def to_blocks(t):
        return jnp.swapaxes(t.reshape(B, nb, Q_BLOCK, H, d), 0, 1)

    def attend(qs):
        return diff_core(qs[0], qs[1], k1a, k2a, va, lam)

    o = lax.map(attend, (to_blocks(q1), to_blocks(q2)))
    return jnp.swapaxes(o, 0, 1).reshape(B, S, H, 2 * d)


def token_mix(h, hc, row, col, w_in, gate_up, gate_b, gla_g, rpb, lam_vec, diff_g, lam_init, need_ctx):
    p = split_proj(h @ w_in)
    pc = split_proj(hc @ w_in)
    y_gla, yc_gla = gla_mix(p, pc, gate_up, gate_b, gla_g, need_ctx)
    nq, nk, nv = (heads(t, NAT_HEADS) for t in p[6:9])
    nqc, nkc, nvc = (heads(t, NAT_HEADS) for t in pc[6:9])
    y_nat = neighbourhood_attention(nq, nk, nv, nkc, nvc, rpb)
    lv = lam_vec.astype(jnp.float32)
    lam = jnp.exp(jnp.sum(lv[0] * lv[1])) - jnp.exp(jnp.sum(lv[2] * lv[3])) + lam_init
    q1, q2, k1, k2, dv = diff_inputs(p)
    q1c, q2c, k1c, k2c, dvc = diff_inputs(pc)
    q1, q2, k1, k2 = (rope_axial(t, row, col) for t in (q1, q2, k1, k2))
    o_diff = diff_attention_latent(q1, q2, k1, k2, dv, k1c, k2c, dvc, lam)
    y_diff = head_rms(o_diff, diff_g) * (1.0 - lam_init)
    y = jnp.concatenate([y_gla, y_nat.astype(h.dtype), y_diff.astype(h.dtype)], axis=-1)
    if not need_ctx:
        return y, None
    yc_nat = softmax_attention(nqc, nkc, nvc).reshape(hc.shape[:-1] + (NAT_WIDTH,))
    yc_diff = head_rms(diff_core(q1c, q2c, k1c, k2c, dvc, lam), diff_g) * (1.0 - lam_init)
    yc = jnp.concatenate([yc_gla, yc_nat.astype(hc.dtype), yc_diff.astype(hc.dtype)], axis=-1)
    return y, yc


def peer_ffn(h, wq, subkeys, u, v):
    B, L, D = h.shape
    hb = h.reshape(-1, PEER_TOKEN_BLOCK, D)

    def block(hx):
        tb = hx.shape[0]
        q = (hx @ wq).reshape(tb, PEER_HEADS, 2, PEER_HALF)
        s1 = jnp.einsum('thd,nd->thn', q[:, :, 0], subkeys[0]).astype(jnp.float32)
        s2 = jnp.einsum('thd,nd->thn', q[:, :, 1], subkeys[1]).astype(jnp.float32)
        v1, i1 = lax.top_k(s1, PEER_TOPK)
        v2, i2 = lax.top_k(s2, PEER_TOPK)
        cand = (v1[..., :, None] + v2[..., None, :]).reshape(tb, PEER_HEADS, -1)
        cid = (i1[..., :, None] * PEER_NKEYS + i2[..., None, :]).reshape(tb, PEER_HEADS, -1)
        top, pos = lax.top_k(cand, PEER_TOPK)
        eid = jnp.take_along_axis(cid, pos, axis=-1)
        gate = jax.nn.softmax(top, axis=-1)
        act = jax.nn.gelu(jnp.einsum('td,thkd->thk', hx, u[eid]).astype(jnp.float32))
        return jnp.einsum('thk,thkd->td', (gate * act).astype(hx.dtype), v[eid])

    return lax.map(block, hb).reshape(B, L, D)


def setup_inputs(seed: int = 0) -> dict:
    key = jax.random.key(seed)
    ks = jax.random.split(key, 21)
    D = D_MODEL

    def nrm(k, shape, s):
        return jax.random.normal(k, shape, jnp.float32) * s

    return {
        "x": nrm(ks[0], (BATCH, SEQ, D), 1.0),
        "c": nrm(ks[1], (BATCH, D), 1.0),
        "ctx": nrm(ks[2], (BATCH, CTX_LEN, D), 1.0),
        "c_ctx": nrm(ks[3], (D,), 1.0),
        "ada_w": nrm(ks[4], (DEPTH, D, 6 * D), 0.5 * D ** -0.5),
        "ada_b": nrm(ks[5], (DEPTH, 6 * D), 0.01),
        "norm1_g": 1.0 + nrm(ks[6], (DEPTH, D), 0.02),
        "norm2_g": 1.0 + nrm(ks[7], (DEPTH, D), 0.02),
        "w_in": nrm(ks[8], (DEPTH, D, PROJ_WIDTH), D ** -0.5),
        "gla_gate_up": nrm(ks[9], (DEPTH, 2, GLA_GATE_RANK, GLA_HEADS * GLA_DK), GLA_GATE_RANK ** -0.5),
        "gla_gate_b": 1.0 + nrm(ks[10], (DEPTH, 2, GLA_HEADS * GLA_DK), 0.1),
        "gla_norm_g": 1.0 + nrm(ks[11], (DEPTH, GLA_WIDTH), 0.02),
        "nat_rpb": nrm(ks[12], (DEPTH, NAT_HEADS, 2 * NAT_WIN_R - 1, 2 * NAT_WIN_C - 1), 0.1),
        "diff_lambda": nrm(ks[13], (DEPTH, 4, DIFF_DH), 0.1),
        "diff_norm_g": 1.0 + nrm(ks[14], (DEPTH, DIFF_WIDTH), 0.02),
        "w_out": nrm(ks[15], (DEPTH, MIX_WIDTH, D), MIX_WIDTH ** -0.5),
        "peer_wq": nrm(ks[16], (DEPTH, D, PEER_HEADS * PEER_QDIM), D ** -0.5),
        "peer_subkeys": nrm(ks[17], (DEPTH, 2, PEER_NKEYS, PEER_HALF), PEER_HALF ** -0.5),
        "peer_u": nrm(ks[18], (DEPTH, PEER_EXPERTS, D), D ** -0.5),
        "peer_v": nrm(ks[19], (DEPTH, PEER_EXPERTS, D), PEER_HEADS ** -0.5),
        "final_g": 1.0 + nrm(ks[20], (D,), 0.02),
    }


def reference(x, c, ctx, c_ctx, ada_w, ada_b, norm1_g, norm2_g, w_in, gla_gate_up, gla_gate_b, gla_norm_g,
              nat_rpb, diff_lambda, diff_norm_g, w_out, peer_wq, peer_subkeys, peer_u, peer_v, final_g):
    B, S, D = x.shape
    t = jnp.arange(S)
    row = t // GRID_W
    col = t % GRID_W
    xc = ctx
    for l in range(DEPTH):
        last = l == DEPTH - 1
        lam_init = 0.8 - 0.6 * math.exp(-0.3 * l)
        mod = jnp.split((jax.nn.silu(c) @ ada_w[l] + ada_b[l])[:, None, :], 6, axis=-1)
        mod_c = jnp.split(jax.nn.silu(c_ctx) @ ada_w[l] + ada_b[l], 6, axis=-1)
        h = modulate(x, norm1_g[l], mod[0], mod[1])
        hc = modulate(xc, norm1_g[l], mod_c[0], mod_c[1])
        y, yc = token_mix(h, hc, row, col, w_in[l], gla_gate_up[l], gla_gate_b[l], gla_norm_g[l],
                          nat_rpb[l], diff_lambda[l], diff_norm_g[l], lam_init, not last)
        x = x + mod[2] * (y @ w_out[l])
        h2 = modulate(x, norm2_g[l], mod[3], mod[4])
        x = x + mod[5] * peer_ffn(h2, peer_wq[l], peer_subkeys[l], peer_u[l], peer_v[l])
        if not last:
            xc = xc + mod_c[2] * (yc @ w_out[l])
            hc2 = modulate(xc, norm2_g[l], mod_c[3], mod_c[4])
            xc = xc + mod_c[5] * peer_ffn(hc2, peer_wq[l], peer_subkeys[l], peer_u[l], peer_v[l])
    return rms_norm(x, final_g)
```

```cpp
#include <hip/hip_runtime.h>
#include <hip/hip_cooperative_groups.h>
#include <stdint.h>
#include <stdio.h>
namespace cg = cooperative_groups;

#ifndef N_LAUNCH_MODE
#define N_LAUNCH_MODE 0
#endif

#define DI __device__ __forceinline__
typedef unsigned short bf16_t;
typedef short bf16x8 __attribute__((ext_vector_type(8)));
typedef float f32x4 __attribute__((ext_vector_type(4)));
typedef unsigned u32x4 __attribute__((ext_vector_type(4)));
typedef unsigned u32x2 __attribute__((ext_vector_type(2)));

constexpr int NB = 16, SEQ = 2048, DM = 1024, NL = 4, CTXL = 256;
constexpr int TL = NB * SEQ;
constexpr int TC = NB * CTXL;
constexpr int TT = TL + TC;
constexpr int PN_LD = 2176;
constexpr int C_GQ = 0, C_GK = 128, C_GR = 256, C_NQ = 512, C_NK = 768, C_DQ = 1024, C_DK = 1536, C_GATE = 2048;
constexpr int R_GV = 0, R_NV = 256, R_DV = 512;
constexpr float LOG2E = 1.4426950408889634f;
constexpr float SC_LOG2 = 0.125f * LOG2E;
constexpr float NEG_BIG = -1e30f;

constexpr size_t MiB = 1u << 20;
constexpr size_t OFF_CTL = 0;
constexpr size_t OFF_MOD = 1 * MiB;
constexpr size_t OFF_WIN = 3 * MiB;
constexpr size_t OFF_WOUT = 28 * MiB;
constexpr size_t OFF_WQ = 36 * MiB;
constexpr size_t OFF_SK = 44 * MiB;
constexpr size_t OFF_U = 45 * MiB;
constexpr size_t OFF_V = 173 * MiB;
constexpr size_t OFF_XRES = 301 * MiB;
constexpr size_t OFF_H = 445 * MiB;
constexpr size_t OFF_P = 517 * MiB;
constexpr size_t OFF_VT = OFF_P + 153 * MiB;
constexpr size_t OFF_QP = OFF_P;
constexpr size_t OFF_EID = OFF_P + 72 * MiB;
constexpr size_t OFF_GATE = OFF_P + 90 * MiB;
constexpr size_t OFF_Y = 742 * MiB;
constexpr size_t WS_END = 814 * MiB;

constexpr int LDS_BYTES = 65536;

struct Params {
  const float *x, *c, *ctx, *c_ctx, *ada_w, *ada_b, *norm1_g, *norm2_g, *w_in, *gate_up, *gate_b, *gla_norm_g,
      *rpb, *dlam, *diff_g, *w_out, *wq, *subkeys, *pu, *pv, *final_g;
  float* out;
  unsigned char* ws;
  int ph_lo, ph_hi;
};

DI unsigned f2bf(float f) { unsigned u = __float_as_uint(f); return (u + 0x7fffu + ((u >> 16) & 1u)) >> 16; }
DI unsigned pk2(float lo, float hi) { return f2bf(lo) | (f2bf(hi) << 16); }
DI float bflo(unsigned u) { return __uint_as_float(u << 16); }
DI float bfhi(unsigned u) { return __uint_as_float(u & 0xffff0000u); }
DI void unpack8(const u32x4 v, float* f) {
  f[0] = bflo(v.x); f[1] = bfhi(v.x); f[2] = bflo(v.y); f[3] = bfhi(v.y);
  f[4] = bflo(v.z); f[5] = bfhi(v.z); f[6] = bflo(v.w); f[7] = bfhi(v.w);
}
DI float wave_sum(float v) {
#pragma unroll
  for (int o = 32; o >= 1; o >>= 1) v += __shfl_xor(v, o);
  return v;
}
DI f32x4 mfma16(bf16x8 a, bf16x8 b, f32x4 c) { return __builtin_amdgcn_mfma_f32_16x16x32_bf16(a, b, c, 0, 0, 0); }

DI int win_src_col(int r) {
  if (r < 256) return r;
  if (r < 512) return r - 256 + 512;
  if (r < 768) return r - 512 + 800;
  if (r < 1024) return r - 768 + 1056;
  if (r < 1536) return r - 1024 + 1568;
  if (r < 2048) return r - 1536 + 2080;
  if (r < 2080) return r - 2048 + 768;
  if (r < 2176) return -1;
  if (r < 2432) return r - 2176 + 256;
  if (r < 2688) return r - 2432 + 1312;
  return r - 2688 + 2592;
}

DI void transpose_item(const float* __restrict__ W, int N, int src, bf16_t* __restrict__ dst, float* lds) {
  const int tid = threadIdx.x;
  for (int kc = 0; kc < 8; ++kc) {
    __syncthreads();
#pragma unroll
    for (int i = 0; i < 16; ++i) {
      int k = i * 8 + (tid >> 5), n = tid & 31;
      lds[k * 33 + n] = (src < 0) ? 0.f : W[(size_t)(kc * 128 + k) * N + src + n];
    }
    __syncthreads();
    int row = tid >> 3, k0 = (tid & 7) * 16;
    unsigned o[8];
#pragma unroll
    for (int e = 0; e < 8; ++e) o[e] = pk2(lds[(k0 + 2 * e) * 33 + row], lds[(k0 + 2 * e + 1) * 33 + row]);
    u32x4 a = {o[0], o[1], o[2], o[3]}, b = {o[4], o[5], o[6], o[7]};
    bf16_t* d = dst + (size_t)row * 1024 + kc * 128 + k0;
    *(u32x4*)d = a; *(u32x4*)(d + 8) = b;
  }
}

DI void phase_prologue(const Params& p, unsigned char* lds) {
  const int tid = threadIdx.x, nb = gridDim.x, bid = blockIdx.x;
  bf16_t* winT = (bf16_t*)(p.ws + OFF_WIN);
  bf16_t* woutT = (bf16_t*)(p.ws + OFF_WOUT);
  bf16_t* wqT = (bf16_t*)(p.ws + OFF_WQ);
  constexpr int PER_LAYER = 100 + 32 + 32;
  for (int item = bid; item < NL * PER_LAYER; item += nb) {
    int l = item / PER_LAYER, r = item % PER_LAYER;
    if (r < 100) {
      int row = r * 32;
      transpose_item(p.w_in + (size_t)l * 1024 * 3104, 3104, win_src_col(row), winT + ((size_t)l * 3200 + row) * 1024, (float*)lds);
    } else if (r < 132) {
      int row = (r - 100) * 32;
      transpose_item(p.w_out + (size_t)l * 1024 * 1024, 1024, row, woutT + ((size_t)l * 1024 + row) * 1024, (float*)lds);
    } else {
      int row = (r - 132) * 32;
      transpose_item(p.wq + (size_t)l * 1024 * 1024, 1024, row, wqT + ((size_t)l * 1024 + row) * 1024, (float*)lds);
    }
  }
  {
    const size_t total8 = (size_t)NL * 16384 * 1024 / 8;
    bf16_t* ub = (bf16_t*)(p.ws + OFF_U);
    bf16_t* vb = (bf16_t*)(p.ws + OFF_V);
    for (size_t i = (size_t)bid * 256 + tid; i < total8; i += (size_t)nb * 256) {
      const float4 a0 = *(const float4*)(p.pu + i * 8), a1 = *(const float4*)(p.pu + i * 8 + 4);
      const float4 b0 = *(const float4*)(p.pv + i * 8), b1 = *(const float4*)(p.pv + i * 8 + 4);
      u32x4 ua = {pk2(a0.x, a0.y), pk2(a0.z, a0.w), pk2(a1.x, a1.y), pk2(a1.z, a1.w)};
      u32x4 va = {pk2(b0.x, b0.y), pk2(b0.z, b0.w), pk2(b1.x, b1.y), pk2(b1.z, b1.w)};
      *(u32x4*)(ub + i * 8) = ua;
      *(u32x4*)(vb + i * 8) = va;
    }
  }
  {
    bf16_t* sk = (bf16_t*)(p.ws + OFF_SK);
    for (int i = bid * 256 + tid; i < NL * 2 * 128 * 64; i += nb * 256) sk[i] = (bf16_t)f2bf(p.subkeys[i]);
  }
  {
    float* modbuf = (float*)(p.ws + OFF_MOD);
    float* sc = (float*)lds;
    float* red = (float*)(lds + 17 * 512 * 4);
    for (int item = bid; item < NL * 96; item += nb) {
      const int l = item / 96, cb = item % 96, col = cb * 64 + (tid & 63), kq = tid >> 6;
      float acc[17];
#pragma unroll
      for (int r = 0; r < 17; ++r) acc[r] = 0.f;
      for (int half = 0; half < 2; ++half) {
        __syncthreads();
        for (int e = tid; e < 17 * 512; e += 256) {
          int r = e >> 9, k = e & 511;
          float cv = (r < 16) ? p.c[r * 1024 + half * 512 + k] : p.c_ctx[half * 512 + k];
          sc[e] = cv / (1.f + __expf(-cv));
        }
        __syncthreads();
        const float* wp = p.ada_w + ((size_t)l * 1024 + half * 512 + kq * 128) * 6144 + col;
        for (int kk = 0; kk < 128; ++kk) {
          const float w = wp[(size_t)kk * 6144];
#pragma unroll
          for (int r = 0; r < 17; ++r) acc[r] += sc[r * 512 + kq * 128 + kk] * w;
        }
      }
#pragma unroll
      for (int r = 0; r < 17; ++r) red[(kq * 17 + r) * 64 + (tid & 63)] = acc[r];
      __syncthreads();
      for (int e = tid; e < 17 * 64; e += 256) {
        int r = e >> 6, cc = e & 63;
        float s = red[(0 * 17 + r) * 64 + cc] + red[(1 * 17 + r) * 64 + cc] + red[(2 * 17 + r) * 64 + cc] + red[(3 * 17 + r) * 64 + cc];
        int colg = cb * 64 + cc;
        modbuf[((size_t)l * 17 + r) * 6144 + colg] = s + p.ada_b[l * 6144 + colg];
      }
      __syncthreads();
    }
  }
}

DI void phase_norm(const Params& p, int l, int which, int ntok) {
  const int lane = threadIdx.x & 63, gw = blockIdx.x * 4 + (threadIdx.x >> 6), nw = gridDim.x * 4;
  const float* gvec = (which == 0 ? p.norm1_g : p.norm2_g) + l * 1024;
  const int ish = which == 0 ? 0 : 3, isc = which == 0 ? 1 : 4;
  const float* xres = (const float*)(p.ws + OFF_XRES);
  const float* modbuf = (const float*)(p.ws + OFF_MOD);
  bf16_t* hbuf = (bf16_t*)(p.ws + OFF_H);
  for (int t = gw; t < ntok; t += nw) {
    const float* src = (which == 0 && l == 0) ? (t < TL ? p.x + (size_t)t * 1024 : p.ctx + (size_t)(t - TL) * 1024) : xres + (size_t)t * 1024;
    const int b = t < TL ? (t >> 11) : 16;
    const float* md = modbuf + ((size_t)l * 17 + b) * 6144;
    float4 v[4];
    float ss = 0.f;
#pragma unroll
    for (int i = 0; i < 4; ++i) {
      v[i] = *(const float4*)(src + 4 * lane + 256 * i);
      ss += v[i].x * v[i].x + v[i].y * v[i].y + v[i].z * v[i].z + v[i].w * v[i].w;
    }
    ss = wave_sum(ss);
    const float rstd = rsqrtf(ss * (1.f / 1024.f) + 1e-6f);
#pragma unroll
    for (int i = 0; i < 4; ++i) {
      const int col = 4 * lane + 256 * i;
      const float4 g4 = *(const float4*)(gvec + col), sh = *(const float4*)(md + ish * 1024 + col), sc = *(const float4*)(md + isc * 1024 + col);
      float o0 = v[i].x * rstd * g4.x * (1.f + sc.x) + sh.x;
      float o1 = v[i].y * rstd * g4.y * (1.f + sc.y) + sh.y;
      float o2 = v[i].z * rstd * g4.z * (1.f + sc.z) + sh.z;
      float o3 = v[i].w * rstd * g4.w * (1.f + sc.w) + sh.w;
      u32x2 o = {pk2(o0, o1), pk2(o2, o3)};
      *(u32x2*)(hbuf + (size_t)t * 1024 + col) = o;
    }
  }
}

template <int EPI>
DI void gemm_tile(const bf16_t* __restrict__ P, const bf16_t* __restrict__ Q, int it, int jt, void* outp, int ld,
                  const float* xin_lat, const float* xin_ctx, const float* modl, unsigned char* lds) {
  const int tid = threadIdx.x, lane = tid & 63, w = tid >> 6, wi = w >> 1, wj = w & 1, lr = lane & 15, g = lane >> 4;
  unsigned char* Ps = lds;
  unsigned char* Qs = lds + 16384;
  f32x4 acc[4][4];
#pragma unroll
  for (int a = 0; a < 4; ++a)
#pragma unroll
    for (int b = 0; b < 4; ++b) acc[a][b] = (f32x4){0.f, 0.f, 0.f, 0.f};
  const int c = tid & 7, r0 = tid >> 3;
  const bf16_t* pg = P + (size_t)(it * 128 + r0) * 1024 + c * 8;
  const bf16_t* qg = Q + (size_t)(jt * 128 + r0) * 1024 + c * 8;
  u32x4 pr[4], qr[4];
#pragma unroll
  for (int ii = 0; ii < 4; ++ii) { pr[ii] = *(const u32x4*)(pg + (size_t)ii * 32 * 1024); qr[ii] = *(const u32x4*)(qg + (size_t)ii * 32 * 1024); }
  for (int kb = 0; kb < 16; ++kb) {
#pragma unroll
    for (int ii = 0; ii < 4; ++ii) {
      const int row = r0 + 32 * ii;
      const unsigned off = row * 128 + ((c ^ (row & 7)) << 4);
      *(u32x4*)(Ps + off) = pr[ii];
      *(u32x4*)(Qs + off) = qr[ii];
    }
    __syncthreads();
    if (kb < 15) {
#pragma unroll
      for (int ii = 0; ii < 4; ++ii) {
        pr[ii] = *(const u32x4*)(pg + (size_t)ii * 32 * 1024 + (kb + 1) * 64);
        qr[ii] = *(const u32x4*)(qg + (size_t)ii * 32 * 1024 + (kb + 1) * 64);
      }
    }
#pragma unroll
    for (int ks = 0; ks < 2; ++ks) {
      bf16x8 pf[4], qf[4];
      const int ch = ks * 4 + g;
#pragma unroll
      for (int mi = 0; mi < 4; ++mi) { const int row = wi * 64 + mi * 16 + lr; pf[mi] = *(const bf16x8*)(Ps + row * 128 + ((ch ^ (row & 7)) << 4)); }
#pragma unroll
      for (int nj = 0; nj < 4; ++nj) { const int row = wj * 64 + nj * 16 + lr; qf[nj] = *(const bf16x8*)(Qs + row * 128 + ((ch ^ (row & 7)) << 4)); }
#pragma unroll
      for (int mi = 0; mi < 4; ++mi)
#pragma unroll
        for (int nj = 0; nj < 4; ++nj) acc[mi][nj] = mfma16(pf[mi], qf[nj], acc[mi][nj]);
    }
    __syncthreads();
  }
#pragma unroll
  for (int mi = 0; mi < 4; ++mi)
#pragma unroll
    for (int nj = 0; nj < 4; ++nj) {
      const int j = jt * 128 + wj * 64 + nj * 16 + lr;
      const int i = it * 128 + wi * 64 + mi * 16 + 4 * g;
      const f32x4 a = acc[mi][nj];
      if (EPI == 0) {
        u32x2 o = {pk2(a[0], a[1]), pk2(a[2], a[3])};
        *(u32x2*)((bf16_t*)outp + (size_t)j * ld + i) = o;
      } else {
        const int b = j < TL ? (j >> 11) : 16;
        const float4 gt = *(const float4*)(modl + (size_t)b * 6144 + 2 * 1024 + i);
        const float* xs = (j < TL) ? xin_lat + (size_t)j * 1024 + i : xin_ctx + (size_t)(j - TL) * 1024 + i;
        const float4 xv = *(const float4*)xs;
        float4 o = {xv.x + gt.x * a[0], xv.y + gt.y * a[1], xv.z + gt.z * a[2], xv.w + gt.w * a[3]};
        *(float4*)((float*)outp + (size_t)j * 1024 + i) = o;
      }
    }
}

DI void phase_gemm_in(const Params& p, int l, unsigned char* lds) {
  const bf16_t* W = (const bf16_t*)(p.ws + OFF_WIN) + (size_t)l * 3200 * 1024;
  const bf16_t* H = (const bf16_t*)(p.ws + OFF_H);
  bf16_t* PN = (bf16_t*)(p.ws + OFF_P);
  bf16_t* VT = (bf16_t*)(p.ws + OFF_VT);
  constexpr int NJT = TT / 128;
  constexpr int T1 = NJT * 17, T2 = NJT * 8;
  for (int t = blockIdx.x; t < T1 + T2; t += gridDim.x) {
    if (t < T1) { const int jt = t / 17, it = t % 17; gemm_tile<0>(W, H, it, jt, PN, PN_LD, nullptr, nullptr, nullptr, lds); }
    else { const int u = t - T1; const int it = u >> 3, jt = u & 7; gemm_tile<0>(H, W + (size_t)2176 * 1024, it, jt, VT, TT, nullptr, nullptr, nullptr, lds); }
  }
}
DI void phase_gemm_out(const Params& p, int l, int ntok, unsigned char* lds) {
  const bf16_t* W = (const bf16_t*)(p.ws + OFF_WOUT) + (size_t)l * 1024 * 1024;
  const bf16_t* Y = (const bf16_t*)(p.ws + OFF_Y);
  float* xres = (float*)(p.ws + OFF_XRES);
  const float* modl = (const float*)(p.ws + OFF_MOD) + (size_t)l * 17 * 6144;
  const float* xl = (l == 0) ? p.x : xres;
  const float* xc = (l == 0) ? p.ctx : xres + (size_t)TL * 1024;
  const int ntile = (ntok / 128) * 8;
  for (int t = blockIdx.x; t < ntile; t += gridDim.x) {
    const int jt = t >> 3, it = t & 7;
    gemm_tile<1>(W, Y, it, jt, xres, 1024, xl, xc, modl, lds);
  }
}
DI void phase_gemm_q(const Params& p, int l, int ntok, unsigned char* lds) {
  const bf16_t* W = (const bf16_t*)(p.ws + OFF_WQ) + (size_t)l * 1024 * 1024;
  const bf16_t* H = (const bf16_t*)(p.ws + OFF_H);
  bf16_t* QP = (bf16_t*)(p.ws + OFF_QP);
  const int ntile = (ntok / 128) * 8;
  for (int t = blockIdx.x; t < ntile; t += gridDim.x) {
    const int jt = t >> 3, it = t & 7;
    gemm_tile<0>(W, H, it, jt, QP, 1024, nullptr, nullptr, nullptr, lds);
  }
}

DI void phase_rope(const Params& p, unsigned char* lds) {
  float2* tab = (float2*)lds;
  for (int e = threadIdx.x; e < 1024; e += 256) {
    const int pos = e >> 4, i = e & 15;
    const float inv = exp2f(-(float)i * (13.287712379549449f / 16.f));
    const float ang = (float)pos * inv;
    tab[e] = make_float2(__cosf(ang), __sinf(ang));
  }
  __syncthreads();
  bf16_t* PN = (bf16_t*)(p.ws + OFF_P);
  const int total = TL * 16;
  for (int idx = blockIdx.x * 256 + threadIdx.x; idx < total; idx += gridDim.x * 256) {
    const int t = idx >> 4, vec = idx & 15;
    const int col = ((vec >> 3) ? C_DK : C_DQ) + ((vec >> 1) & 3) * 128 + (vec & 1) * 64;
    bf16_t* ptr = PN + (size_t)t * PN_LD + col;
    float xv[64];
#pragma unroll
    for (int q = 0; q < 8; ++q) { const u32x4 v = *(const u32x4*)(ptr + q * 8); unpack8(v, xv + q * 8); }
    const int row = (t & 2047) >> 6, cp = t & 63;
#pragma unroll
    for (int i = 0; i < 16; ++i) {
      const float2 cs = tab[row * 16 + i];
      const float x1 = xv[i], x2 = xv[16 + i];
      xv[i] = x1 * cs.x - x2 * cs.y; xv[16 + i] = x2 * cs.x + x1 * cs.y;
      const float2 cs2 = tab[cp * 16 + i];
      const float y1 = xv[32 + i], y2 = xv[48 + i];
      xv[32 + i] = y1 * cs2.x - y2 * cs2.y; xv[48 + i] = y2 * cs2.x + y1 * cs2.y;
    }
#pragma unroll
    for (int q = 0; q < 8; ++q) {
      u32x4 o = {pk2(xv[q * 8], xv[q * 8 + 1]), pk2(xv[q * 8 + 2], xv[q * 8 + 3]), pk2(xv[q * 8 + 4], xv[q * 8 + 5]), pk2(xv[q * 8 + 6], xv[q * 8 + 7])};
      *(u32x4*)(ptr + q * 8) = o;
    }
  }
}

struct SrcSeg {
  const bf16_t* PN; const bf16_t* VT; int kcol, vrow, t0, n0, t1, n1, lr, g;
  const bf16_t* k0p; const bf16_t* k1p; const bf16_t* vp;
  DI int nsteps() const { return n0 + n1; }
  DI void setup(int st) {
    const int tok0 = st < n0 ? t0 + st * 32 : t1 + (st - n0) * 32;
    const int kap = 8 * (lr >> 2) + (lr & 3);
    k0p = PN + (size_t)(tok0 + kap) * PN_LD + kcol + 8 * g;
    k1p = k0p + (size_t)4 * PN_LD;
    vp = VT + (size_t)(vrow + lr) * TT + tok0 + 8 * g;
  }
  DI bf16x8 kfrag(int m, int kt, int ks) const { return *(const bf16x8*)((kt ? k1p : k0p) + m * 64 + ks * 32); }
  DI bf16x8 vfrag(int dt) const { return *(const bf16x8*)(vp + (size_t)dt * 16 * TT); }
  DI float score(float raw, int kt, int r) const { return raw * SC_LOG2; }
};
struct SrcNat {
  const bf16_t* PN; const bf16_t* VT; int kcol, vrow, b, rq, rs, cs, qc, cstart, lr, g, st_;
  const float* rpbh;
  const bf16_t* k0p; const bf16_t* k1p; const bf16_t* vp;
  DI int nsteps() const { return 16; }
  DI void setup(int st) {
    st_ = st;
    const int tok0 = st < 8 ? b * 2048 + (rs + st) * 64 + cs : TL + b * 256 + (st - 8) * 32;
    const int kap = 8 * (lr >> 2) + (lr & 3);
    k0p = PN + (size_t)(tok0 + kap) * PN_LD + kcol + 8 * g;
    k1p = k0p + (size_t)4 * PN_LD;
    vp = VT + (size_t)(vrow + lr) * TT + tok0 + 8 * g;
  }
  DI bf16x8 kfrag(int m, int kt, int ks) const { return *(const bf16x8*)((kt ? k1p : k0p) + ks * 32); }
  DI bf16x8 vfrag(int dt) const { return *(const bf16x8*)(vp + (size_t)dt * 16 * TT); }
  DI float score(float raw, int kt, int r) const {
    if (st_ >= 8) return raw * SC_LOG2;
    const int kc = cs + 8 * g + 4 * kt + r;
    const bool valid = (kc >= cstart) && (kc < cstart + 16);
    int dc = kc - qc + 15; dc = dc < 0 ? 0 : (dc > 30 ? 30 : dc);
    const float bias = rpbh[(rs + st_ - rq + 7) * 31 + dc];
    return valid ? (raw * 0.125f + bias) * LOG2E : NEG_BIG;
  }
};

template <int MAPS, int DVT, class Src>
DI void flash_wave(Src& S, const bf16_t* qptr  , f32x4 (&o)[MAPS][DVT], float (&ltot)[MAPS]) {
  bf16x8 qf[MAPS][2];
#pragma unroll
  for (int m = 0; m < MAPS; ++m)
#pragma unroll
    for (int ks = 0; ks < 2; ++ks) qf[m][ks] = *(const bf16x8*)(qptr + m * 64 + ks * 32);
  float mrun[MAPS], lrun[MAPS];
#pragma unroll
  for (int m = 0; m < MAPS; ++m) {
    mrun[m] = NEG_BIG; lrun[m] = 0.f;
#pragma unroll
    for (int dt = 0; dt < DVT; ++dt) o[m][dt] = (f32x4){0.f, 0.f, 0.f, 0.f};
  }
  const int ns = S.nsteps();
  for (int st = 0; st < ns; ++st) {
    S.setup(st);
    bf16x8 pf[MAPS];
#pragma unroll
    for (int m = 0; m < MAPS; ++m) {
      f32x4 s[2];
#pragma unroll
      for (int kt = 0; kt < 2; ++kt) {
        s[kt] = (f32x4){0.f, 0.f, 0.f, 0.f};
#pragma unroll
        for (int ks = 0; ks < 2; ++ks) s[kt] = mfma16(S.kfrag(m, kt, ks), qf[m][ks], s[kt]);
      }
      float mt = NEG_BIG;
#pragma unroll
      for (int kt = 0; kt < 2; ++kt)
#pragma unroll
        for (int r = 0; r < 4; ++r) { s[kt][r] = S.score(s[kt][r], kt, r); mt = fmaxf(mt, s[kt][r]); }
      mt = fmaxf(mt, __shfl_xor(mt, 16));
      mt = fmaxf(mt, __shfl_xor(mt, 32));
      const bool need = mt > mrun[m] + 8.f;
      if (__any(need)) {
        const float mnew = need ? mt : mrun[m];
        const float alpha = exp2f(mrun[m] - mnew);
        lrun[m] *= alpha;
#pragma unroll
        for (int dt = 0; dt < DVT; ++dt) { o[m][dt][0] *= alpha; o[m][dt][1] *= alpha; o[m][dt][2] *= alpha; o[m][dt][3] *= alpha; }
        mrun[m] = mnew;
      }
      float pv[8];
      float ls = 0.f;
#pragma unroll
      for (int kt = 0; kt < 2; ++kt)
#pragma unroll
        for (int r = 0; r < 4; ++r) { pv[kt * 4 + r] = exp2f(s[kt][r] - mrun[m]); ls += pv[kt * 4 + r]; }
      lrun[m] += ls;
      u32x4 pk = {pk2(pv[0], pv[1]), pk2(pv[2], pv[3]), pk2(pv[4], pv[5]), pk2(pv[6], pv[7])};
      pf[m] = __builtin_bit_cast(bf16x8, pk);
    }
#pragma unroll
    for (int dt = 0; dt < DVT; ++dt) {
      const bf16x8 vf = S.vfrag(dt);
#pragma unroll
      for (int m = 0; m < MAPS; ++m) o[m][dt] = mfma16(vf, pf[m], o[m][dt]);
    }
  }
#pragma unroll
  for (int m = 0; m < MAPS; ++m) {
    float l = lrun[m];
    l += __shfl_xor(l, 16);
    l += __shfl_xor(l, 32);
    ltot[m] = l;
  }
}

DI void diff_wave_task(const Params& p, int l, int b, int hd, int qtok0, bool ctx_only) {
  const int lane = threadIdx.x & 63, lr = lane & 15, g = lane >> 4;
  const bf16_t* PN = (const bf16_t*)(p.ws + OFF_P);
  const bf16_t* VT = (const bf16_t*)(p.ws + OFF_VT);
  bf16_t* Y = (bf16_t*)(p.ws + OFF_Y);
  const float* lv = p.dlam + l * 256;
  float sa = lv[lane] * lv[64 + lane], sb = lv[128 + lane] * lv[192 + lane];
  sa = wave_sum(sa); sb = wave_sum(sb);
  const float lam_init = 0.8f - 0.6f * expf(-0.3f * (float)l);
  const float lam = expf(sa) - expf(sb) + lam_init;
  SrcSeg S;
  S.PN = PN; S.VT = VT; S.kcol = C_DK + hd * 128; S.vrow = R_DV + hd * 128; S.lr = lr; S.g = g;
  S.t0 = TL + b * 256; S.n0 = 8; S.t1 = b * 2048; S.n1 = ctx_only ? 0 : 64;
  f32x4 o[2][8];
  float lt[2];
  const int qtok = qtok0 + lr;
  flash_wave<2, 8, SrcSeg>(S, PN + (size_t)qtok * PN_LD + C_DQ + hd * 128 + 8 * g, o, lt);
  const float i0 = 1.f / lt[0], i1 = lam / lt[1];
  float ss = 0.f;
#pragma unroll
  for (int dt = 0; dt < 8; ++dt)
#pragma unroll
    for (int r = 0; r < 4; ++r) { const float v = o[0][dt][r] * i0 - o[1][dt][r] * i1; o[0][dt][r] = v; ss += v * v; }
  ss += __shfl_xor(ss, 16);
  ss += __shfl_xor(ss, 32);
  const float rstd = rsqrtf(ss * (1.f / 128.f) + 1e-6f) * (1.f - lam_init);
  const float* dg = p.diff_g + l * 512 + hd * 128;
#pragma unroll
  for (int dt = 0; dt < 8; ++dt) {
    const float4 gg = *(const float4*)(dg + dt * 16 + 4 * g);
    u32x2 ov = {pk2(o[0][dt][0] * rstd * gg.x, o[0][dt][1] * rstd * gg.y), pk2(o[0][dt][2] * rstd * gg.z, o[0][dt][3] * rstd * gg.w)};
    *(u32x2*)(Y + (size_t)qtok * 1024 + 512 + hd * 128 + dt * 16 + 4 * g) = ov;
  }
}

DI void nat_wave_task(const Params& p, int l, int b, int head, int rq, int ct, const float* rpb_lds) {
  const int lane = threadIdx.x & 63, lr = lane & 15, g = lane >> 4;
  const bf16_t* PN = (const bf16_t*)(p.ws + OFF_P);
  const bf16_t* VT = (const bf16_t*)(p.ws + OFF_VT);
  bf16_t* Y = (bf16_t*)(p.ws + OFF_Y);
  SrcNat S;
  S.PN = PN; S.VT = VT; S.kcol = C_NK + head * 64; S.vrow = R_NV + head * 64; S.b = b; S.rq = rq; S.lr = lr; S.g = g;
  int rs = rq - 4; rs = rs < 0 ? 0 : (rs > 24 ? 24 : rs);
  S.rs = rs;
  int cs = 16 * ct - 8; cs = cs < 0 ? 0 : (cs > 32 ? 32 : cs);
  S.cs = cs;
  S.qc = 16 * ct + lr;
  int cst = S.qc - 8; cst = cst < 0 ? 0 : (cst > 48 ? 48 : cst);
  S.cstart = cst;
  S.rpbh = rpb_lds + head * 465;
  f32x4 o[1][4];
  float lt[1];
  const int qtok = b * 2048 + rq * 64 + 16 * ct + lr;
  flash_wave<1, 4, SrcNat>(S, PN + (size_t)qtok * PN_LD + C_NQ + head * 64 + 8 * g, o, lt);
  const float inv = 1.f / lt[0];
#pragma unroll
  for (int dt = 0; dt < 4; ++dt) {
    u32x2 ov = {pk2(o[0][dt][0] * inv, o[0][dt][1] * inv), pk2(o[0][dt][2] * inv, o[0][dt][3] * inv)};
    *(u32x2*)(Y + (size_t)qtok * 1024 + 256 + head * 64 + dt * 16 + 4 * g) = ov;
  }
}
DI void natctx_wave_task(const Params& p, int b, int head, int qt) {
  const int lane = threadIdx.x & 63, lr = lane & 15, g = lane >> 4;
  const bf16_t* PN = (const bf16_t*)(p.ws + OFF_P);
  const bf16_t* VT = (const bf16_t*)(p.ws + OFF_VT);
  bf16_t* Y = (bf16_t*)(p.ws + OFF_Y);
  SrcSeg S;
  S.PN = PN; S.VT = VT; S.kcol = C_NK + head * 64; S.vrow = R_NV + head * 64; S.lr = lr; S.g = g;
  S.t0 = TL + b * 256; S.n0 = 8; S.t1 = 0; S.n1 = 0;
  f32x4 o[1][4];
  float lt[1];
  const int qtok = TL + b * 256 + qt * 16 + lr;
  flash_wave<1, 4, SrcSeg>(S, PN + (size_t)qtok * PN_LD + C_NQ + head * 64 + 8 * g, o, lt);
  const float inv = 1.f / lt[0];
#pragma unroll
  for (int dt = 0; dt < 4; ++dt) {
    u32x2 ov = {pk2(o[0][dt][0] * inv, o[0][dt][1] * inv), pk2(o[0][dt][2] * inv, o[0][dt][3] * inv)};
    *(u32x2*)(Y + (size_t)qtok * 1024 + 256 + head * 64 + dt * 16 + 4 * g) = ov;
  }
}

DI void gla_task(const Params& p, int l, int task, unsigned char* lds) {
  const int tid = threadIdx.x, lane = tid & 63, w = tid >> 6, vv = lane & 15, g = lane >> 4;
  const int b = task >> 3, h = (task >> 1) & 3, dir = task & 1;
  const bf16_t* PN = (const bf16_t*)(p.ws + OFF_P);
  const bf16_t* VT = (const bf16_t*)(p.ws + OFF_VT);
  float* og = (float*)(p.ws + OFF_H);
  float* Gup = (float*)lds;
  float* Gb = Gup + 512;
  float* As = Gb + 32;
  float* Ks = As + 2048;
  float* Qs = Ks + 2048;
  float* Vs = Qs + 2048;
  __syncthreads();
  for (int e = tid; e < 512; e += 256) { const int r = e >> 5, kd = e & 31; Gup[e] = p.gate_up[((size_t)(l * 2 + dir) * 16 + r) * 128 + h * 32 + kd]; }
  if (tid < 32) Gb[tid] = p.gate_b[(l * 2 + dir) * 128 + h * 32 + tid];
  float S[8];
#pragma unroll
  for (int e = 0; e < 8; ++e) S[e] = 0.f;
  for (int cc = 0; cc < 36; ++cc) {
    int tok0;
    if (cc < 4) { const int ch = dir == 0 ? cc : 3 - cc; tok0 = TL + b * 256 + ch * 64; }
    else { const int ch = dir == 0 ? cc - 4 : 35 - cc; tok0 = b * 2048 + ch * 64; }
    __syncthreads();
    {
      const int i = tid >> 2, part = tid & 3;
      const bf16_t* row = PN + (size_t)(tok0 + i) * PN_LD;
      const u32x4 qv = *(const u32x4*)(row + C_GQ + h * 32 + part * 8);
      const u32x4 kv = *(const u32x4*)(row + C_GK + h * 32 + part * 8);
      const u32x4 g0 = *(const u32x4*)(row + C_GATE + dir * 16);
      const u32x4 g1 = *(const u32x4*)(row + C_GATE + dir * 16 + 8);
      float gd[16], qf[8], kf[8];
      unpack8(g0, gd); unpack8(g1, gd + 8); unpack8(qv, qf); unpack8(kv, kf);
#pragma unroll
      for (int e = 0; e < 8; ++e) {
        const int kd = part * 8 + e;
        float pre = Gb[kd];
#pragma unroll
        for (int r = 0; r < 16; ++r) pre += gd[r] * Gup[r * 32 + kd];
        const float ls = fminf(pre, 0.f) - log1pf(__expf(-fabsf(pre)));
        As[i * 32 + kd] = __expf(ls * (1.f / 16.f));
        Ks[i * 32 + kd] = kf[e];
        Qs[i * 32 + kd] = qf[e] * 0.17677669529663687f;
      }
      const int v = tid >> 2;
      const bf16_t* vp = VT + (size_t)(R_GV + h * 64 + v) * TT + tok0 + part * 16;
      const u32x4 v0 = *(const u32x4*)vp, v1 = *(const u32x4*)(vp + 8);
      float vf[16];
      unpack8(v0, vf); unpack8(v1, vf + 8);
#pragma unroll
      for (int e = 0; e < 16; ++e) Vs[(part * 16 + e) * 65 + v] = vf[e];
    }
    __syncthreads();
    for (int s = 0; s < 64; ++s) {
      const int i = dir == 0 ? s : 63 - s;
      const float4 a0 = *(const float4*)(As + i * 32 + 8 * g), a1 = *(const float4*)(As + i * 32 + 8 * g + 4);
      const float4 k0 = *(const float4*)(Ks + i * 32 + 8 * g), k1 = *(const float4*)(Ks + i * 32 + 8 * g + 4);
      const float4 q0 = *(const float4*)(Qs + i * 32 + 8 * g), q1 = *(const float4*)(Qs + i * 32 + 8 * g + 4);
      const float v = Vs[i * 65 + 16 * w + vv];
      S[0] = a0.x * S[0] + k0.x * v; S[1] = a0.y * S[1] + k0.y * v; S[2] = a0.z * S[2] + k0.z * v; S[3] = a0.w * S[3] + k0.w * v;
      S[4] = a1.x * S[4] + k1.x * v; S[5] = a1.y * S[5] + k1.y * v; S[6] = a1.z * S[6] + k1.z * v; S[7] = a1.w * S[7] + k1.w * v;
      float o = q0.x * S[0] + q0.y * S[1] + q0.z * S[2] + q0.w * S[3] + q1.x * S[4] + q1.y * S[5] + q1.z * S[6] + q1.w * S[7];
      o += __shfl_xor(o, 16);
      o += __shfl_xor(o, 32);
      if (g == 0) og[((size_t)dir * TT + tok0 + i) * 256 + h * 64 + 16 * w + vv] = o;
    }
  }
}

DI void phase_mixers(const Params& p, int l, bool last, unsigned* ctr, unsigned char* lds) {
  const int tid = threadIdx.x, w = tid >> 6;
  volatile int* slot = (volatile int*)(lds + LDS_BYTES - 16);
  float* rpb_lds = (float*)(lds + 48 * 1024);
  for (int e = tid; e < 4 * 465; e += 256) rpb_lds[e] = p.rpb[(size_t)l * 4 * 465 + e];
  const int ntask = 128 + 2048 + 2048 + (last ? 0 : 512);
  for (;;) {
    __syncthreads();
    if (tid == 0) *slot = (int)atomicAdd(ctr, 1u);
    __syncthreads();
    const int task = *slot;
    if (task >= ntask) break;
    if (task < 128) { gla_task(p, l, task, lds); }
    else if (task < 128 + 2048) { const int wt = (task - 128) * 4 + w; diff_wave_task(p, l, wt >> 9, (wt >> 7) & 3, (wt >> 9) * 2048 + (wt & 127) * 16, false); }
    else if (task < 128 + 4096) { const int wt = (task - 128 - 2048) * 4 + w; nat_wave_task(p, l, wt >> 9, (wt >> 7) & 3, (wt >> 2) & 31, wt & 3, rpb_lds); }
    else if (task < 128 + 4096 + 256) { const int wt = (task - 128 - 4096) * 4 + w; const int b = wt >> 6; diff_wave_task(p, l, b, (wt >> 4) & 3, TL + b * 256 + (wt & 15) * 16, true); }
    else { const int wt = (task - 128 - 4096 - 256) * 4 + w; natctx_wave_task(p, wt >> 6, (wt >> 4) & 3, wt & 15); }
  }
}

DI void phase_gla_fin(const Params& p, int l, int ntok) {
  const int lane = threadIdx.x & 63, gw = blockIdx.x * 4 + (threadIdx.x >> 6), nw = gridDim.x * 4;
  const float* og = (const float*)(p.ws + OFF_H);
  const bf16_t* PN = (const bf16_t*)(p.ws + OFF_P);
  bf16_t* Y = (bf16_t*)(p.ws + OFF_Y);
  const float4 gg = *(const float4*)(p.gla_norm_g + l * 256 + 4 * lane);
  for (int t = gw; t < ntok; t += nw) {
    const float4 a = *(const float4*)(og + (size_t)t * 256 + 4 * lane), bq = *(const float4*)(og + ((size_t)TT + t) * 256 + 4 * lane);
    const float o0 = a.x + bq.x, o1 = a.y + bq.y, o2 = a.z + bq.z, o3 = a.w + bq.w;
    float ss = o0 * o0 + o1 * o1 + o2 * o2 + o3 * o3;
    ss += __shfl_xor(ss, 1); ss += __shfl_xor(ss, 2); ss += __shfl_xor(ss, 4); ss += __shfl_xor(ss, 8);
    const float rstd = rsqrtf(ss * (1.f / 64.f) + 1e-6f);
    const u32x2 rv = *(const u32x2*)(PN + (size_t)t * PN_LD + C_GR + 4 * lane);
    const float r0 = bflo(rv.x), r1 = bfhi(rv.x), r2 = bflo(rv.y), r3 = bfhi(rv.y);
    const float y0 = o0 * rstd * gg.x * (r0 / (1.f + __expf(-r0)));
    const float y1 = o1 * rstd * gg.y * (r1 / (1.f + __expf(-r1)));
    const float y2 = o2 * rstd * gg.z * (r2 / (1.f + __expf(-r2)));
    const float y3 = o3 * rstd * gg.w * (r3 / (1.f + __expf(-r3)));
    u32x2 ov = {pk2(y0, y1), pk2(y2, y3)};
    *(u32x2*)(Y + (size_t)t * 1024 + 4 * lane) = ov;
  }
}

struct PairTab { int a[52], b[52]; };
constexpr PairTab make_pairs() {
  PairTab t{};
  int n = 0;
  for (int a = 0; a < 16; ++a)
    for (int b = 0; b < 16; ++b)
      if ((a + 1) * (b + 1) <= 16) { t.a[n] = a; t.b[n] = b; ++n; }
  for (; n < 52; ++n) { t.a[n] = -1; t.b[n] = -1; }
  return t;
}

DI void topk_half(const bf16_t* skh  , const bf16_t* qrow  , int lr, int g, float (&list)[16]) {
  bf16x8 qf[2];
  qf[0] = *(const bf16x8*)(qrow); qf[1] = *(const bf16x8*)(qrow + 32);
  float s[32];
#pragma unroll
  for (int nt = 0; nt < 8; ++nt) {
    f32x4 acc = {0.f, 0.f, 0.f, 0.f};
#pragma unroll
    for (int ks = 0; ks < 2; ++ks) {
      const bf16x8 af = *(const bf16x8*)(skh + (size_t)(nt * 16 + lr) * 64 + ks * 32 + 8 * g);
      acc = mfma16(af, qf[ks], acc);
    }
#pragma unroll
    for (int r = 0; r < 4; ++r) {
      const unsigned n = nt * 16 + 4 * g + r;
      s[nt * 4 + r] = __uint_as_float((__float_as_uint(acc[r]) & ~127u) | n);
    }
  }
#pragma unroll
  for (int k = 0; k < 16; ++k) {
    float m = s[0];
#pragma unroll
    for (int i = 1; i < 32; ++i) m = fmaxf(m, s[i]);
    m = fmaxf(m, __shfl_xor(m, 16));
    m = fmaxf(m, __shfl_xor(m, 32));
    list[k] = m;
#pragma unroll
    for (int i = 0; i < 32; ++i) s[i] = (s[i] == m) ? -3.0e38f : s[i];
  }
}

DI void phase_topk(const Params& p, int l, int ntok) {
  constexpr PairTab PT = make_pairs();
  const int lane = threadIdx.x & 63, lr = lane & 15, g = lane >> 4;
  const int gw = blockIdx.x * 4 + (threadIdx.x >> 6), nw = gridDim.x * 4;
  const bf16_t* QP = (const bf16_t*)(p.ws + OFF_QP);
  const bf16_t* sk = (const bf16_t*)(p.ws + OFF_SK) + (size_t)l * 2 * 128 * 64;
  int* eid = (int*)(p.ws + OFF_EID);
  float* gate = (float*)(p.ws + OFF_GATE);
  const int ntask = (ntok / 16) * 8;
  for (int task = gw; task < ntask; task += nw) {
    const int tt = task >> 3, hd = task & 7;
    const int tok = tt * 16 + lr;
    float v1[16], v2[16];
    topk_half(sk, QP + (size_t)tok * 1024 + hd * 128 + 8 * g, lr, g, v1);
    topk_half(sk + 128 * 64, QP + (size_t)tok * 1024 + hd * 128 + 64 + 8 * g, lr, g, v2);
    float cand[13];
    int ceid[13];
#pragma unroll
    for (int c = 0; c < 13; ++c) {
      float sv[4];
      int ev[4];
#pragma unroll
      for (int gi = 0; gi < 4; ++gi) {
        const int pi = 4 * c + gi;
        if (PT.a[pi] >= 0) {
          const float a = v1[PT.a[pi] < 0 ? 0 : PT.a[pi]], bq = v2[PT.b[pi] < 0 ? 0 : PT.b[pi]];
          sv[gi] = __uint_as_float((__float_as_uint(a + bq) & ~63u) | (unsigned)pi);
          ev[gi] = (int)((__float_as_uint(a) & 127u) * 128u + (__float_as_uint(bq) & 127u));
        } else { sv[gi] = -3.0e38f; ev[gi] = 0; }
      }
      cand[c] = g == 0 ? sv[0] : (g == 1 ? sv[1] : (g == 2 ? sv[2] : sv[3]));
      ceid[c] = g == 0 ? ev[0] : (g == 1 ? ev[1] : (g == 2 ? ev[2] : ev[3]));
    }
    float topv[16];
#pragma unroll
    for (int k = 0; k < 16; ++k) {
      float m = cand[0];
#pragma unroll
      for (int c = 1; c < 13; ++c) m = fmaxf(m, cand[c]);
      m = fmaxf(m, __shfl_xor(m, 16));
      m = fmaxf(m, __shfl_xor(m, 32));
      topv[k] = m;
      int my = -1;
#pragma unroll
      for (int c = 0; c < 13; ++c) { if (cand[c] == m) { my = ceid[c]; cand[c] = -3.0e38f; } }
      if (my >= 0) eid[(size_t)tok * 128 + hd * 16 + k] = my;
    }
    if (g == 0) {
      float ex[16], sum = 0.f;
#pragma unroll
      for (int k = 0; k < 16; ++k) { ex[k] = __expf(topv[k] - topv[0]); sum += ex[k]; }
      const float inv = 1.f / sum;
#pragma unroll
      for (int q = 0; q < 4; ++q) {
        float4 o = {ex[4 * q] * inv, ex[4 * q + 1] * inv, ex[4 * q + 2] * inv, ex[4 * q + 3] * inv};
        *(float4*)(gate + (size_t)tok * 128 + hd * 16 + 4 * q) = o;
      }
    }
  }
}

DI float gelu_tanh(float x) {
  const float z = 0.7978845608028654f * (x + 0.044715f * x * x * x);
  const float e = __expf(2.f * z);
  const float th = 1.f - 2.f / (e + 1.f);
  return 0.5f * x * (1.f + th);
}
DI void phase_gather(const Params& p, int l, int ntok) {
  const int lane = threadIdx.x & 63, gw = blockIdx.x * 4 + (threadIdx.x >> 6), nw = gridDim.x * 4;
  const bf16_t* H = (const bf16_t*)(p.ws + OFF_H);
  const bf16_t* U = (const bf16_t*)(p.ws + OFF_U) + (size_t)l * 16384 * 1024;
  const bf16_t* V = (const bf16_t*)(p.ws + OFF_V) + (size_t)l * 16384 * 1024;
  const int* eid = (const int*)(p.ws + OFF_EID);
  const float* gate = (const float*)(p.ws + OFF_GATE);
  float* xres = (float*)(p.ws + OFF_XRES);
  const float* modbuf = (const float*)(p.ws + OFF_MOD);
  for (int t = gw; t < ntok; t += nw) {
    float hx[16];
    {
      const u32x4 ha = *(const u32x4*)(H + (size_t)t * 1024 + 8 * lane), hb = *(const u32x4*)(H + (size_t)t * 1024 + 512 + 8 * lane);
      unpack8(ha, hx); unpack8(hb, hx + 8);
    }
    const int e0 = eid[(size_t)t * 128 + lane], e1 = eid[(size_t)t * 128 + 64 + lane];
    const float g0 = gate[(size_t)t * 128 + lane], g1 = gate[(size_t)t * 128 + 64 + lane];
    float out[16];
#pragma unroll
    for (int i = 0; i < 16; ++i) out[i] = 0.f;
    for (int half = 0; half < 2; ++half) {
      const int ev = half ? e1 : e0;
      const float gv = half ? g1 : g0;
      for (int j = 0; j < 64; j += 4) {
        u32x4 ua[4], ub[4], va[4], vb[4];
        float gt[4];
#pragma unroll
        for (int q = 0; q < 4; ++q) {
          const int e = __builtin_amdgcn_readlane(ev, j + q);
          gt[q] = __int_as_float(__builtin_amdgcn_readlane(__float_as_int(gv), j + q));
          const bf16_t* ur = U + (size_t)e * 1024 + 8 * lane;
          const bf16_t* vr = V + (size_t)e * 1024 + 8 * lane;
          ua[q] = *(const u32x4*)ur; ub[q] = *(const u32x4*)(ur + 512);
          va[q] = *(const u32x4*)vr; vb[q] = *(const u32x4*)(vr + 512);
        }
#pragma unroll
        for (int q = 0; q < 4; ++q) {
          float uf[16];
          unpack8(ua[q], uf); unpack8(ub[q], uf + 8);
          float d = 0.f;
#pragma unroll
          for (int i = 0; i < 16; ++i) d += hx[i] * uf[i];
          d = wave_sum(d);
          const float wgt = gt[q] * gelu_tanh(d);
          float vf[16];
          unpack8(va[q], vf); unpack8(vb[q], vf + 8);
#pragma unroll
          for (int i = 0; i < 16; ++i) out[i] += wgt * vf[i];
        }
      }
    }
    const int b = t < TL ? (t >> 11) : 16;
    const float* md = modbuf + ((size_t)l * 17 + b) * 6144 + 5 * 1024;
    float* xr = xres + (size_t)t * 1024;
#pragma unroll
    for (int hq = 0; hq < 2; ++hq)
#pragma unroll
      for (int q = 0; q < 2; ++q) {
        const int col = hq * 512 + 8 * lane + 4 * q;
        const float4 m4 = *(const float4*)(md + col);
        float4 xv = *(const float4*)(xr + col);
        xv.x += m4.x * out[hq * 8 + q * 4 + 0]; xv.y += m4.y * out[hq * 8 + q * 4 + 1];
        xv.z += m4.z * out[hq * 8 + q * 4 + 2]; xv.w += m4.w * out[hq * 8 + q * 4 + 3];
        *(float4*)(xr + col) = xv;
      }
  }
}

DI void phase_final(const Params& p) {
  const int lane = threadIdx.x & 63, gw = blockIdx.x * 4 + (threadIdx.x >> 6), nw = gridDim.x * 4;
  const float* xres = (const float*)(p.ws + OFF_XRES);
  for (int t = gw; t < TL; t += nw) {
    const float* src = xres + (size_t)t * 1024;
    float4 v[4];
    float ss = 0.f;
#pragma unroll
    for (int i = 0; i < 4; ++i) {
      v[i] = *(const float4*)(src + 4 * lane + 256 * i);
      ss += v[i].x * v[i].x + v[i].y * v[i].y + v[i].z * v[i].z + v[i].w * v[i].w;
    }
    ss = wave_sum(ss);
    const float rstd = rsqrtf(ss * (1.f / 1024.f) + 1e-6f);
#pragma unroll
    for (int i = 0; i < 4; ++i) {
      const int col = 4 * lane + 256 * i;
      const float4 g4 = *(const float4*)(p.final_g + col);
      float4 o = {v[i].x * rstd * g4.x, v[i].y * rstd * g4.y, v[i].z * rstd * g4.z, v[i].w * rstd * g4.w};
      *(float4*)(p.out + (size_t)t * 1024 + col) = o;
    }
  }
}

constexpr int PH_PER_LAYER = 10;
constexpr int N_PHASES = 1 + NL * PH_PER_LAYER + 1;

template <int KIND>
DI void run_phase(const Params& p, int ph, unsigned char* lds) {
  unsigned* ctl = (unsigned*)(p.ws + OFF_CTL);
  if (ph == 0) { if (KIND < 0 || KIND == 0) phase_prologue(p, lds); }
  else if (ph == N_PHASES - 1) { if (KIND < 0 || KIND == 11) phase_final(p); }
  else {
    const int l = (ph - 1) / PH_PER_LAYER, s = (ph - 1) % PH_PER_LAYER;
    const bool last = (l == NL - 1);
    const int ntok = last ? TL : TT;
    if (s == 0) { if (KIND < 0 || KIND == 1) phase_norm(p, l, 0, TT); }
    else if (s == 1) { if (KIND < 0 || KIND == 2) phase_gemm_in(p, l, lds); }
    else if (s == 2) { if (KIND < 0 || KIND == 3) phase_rope(p, lds); }
    else if (s == 3) { if (KIND < 0 || KIND == 4) phase_mixers(p, l, last, ctl + 64 * (1 + l), lds); }
    else if (s == 4) { if (KIND < 0 || KIND == 5) phase_gla_fin(p, l, ntok); }
    else if (s == 5) { if (KIND < 0 || KIND == 6) phase_gemm_out(p, l, ntok, lds); }
    else if (s == 6) { if (KIND < 0 || KIND == 7) phase_norm(p, l, 1, ntok); }
    else if (s == 7) { if (KIND < 0 || KIND == 8) phase_gemm_q(p, l, ntok, lds); }
    else if (s == 8) { if (KIND < 0 || KIND == 9) phase_topk(p, l, ntok); }
    else { if (KIND < 0 || KIND == 10) phase_gather(p, l, ntok); }
  }
}

#if N_LAUNCH_MODE == 1
__global__ void __launch_bounds__(256, 2) mk_fwd(Params p) {
  __shared__ __attribute__((aligned(16))) unsigned char lds[LDS_BYTES];
  for (int ph = p.ph_lo; ph < p.ph_hi; ++ph) {
    run_phase<-1>(p, ph, lds);
    if (ph + 1 < p.ph_hi) cg::this_grid().sync();
  }
}
#else
template <int KIND>
__global__ void __launch_bounds__(256, 2) mk_phase(Params p) {
  __shared__ __attribute__((aligned(16))) unsigned char lds[LDS_BYTES];
  run_phase<KIND>(p, p.ph_lo, lds);
}
#endif

extern "C" void kernel_launch(void* const* d_in, const int* in_sizes, int n_in, void* d_out, int out_size, void* d_ws,
                              size_t ws_size, hipStream_t stream) {
  static int grid = 0;
  if (grid == 0) {
    if (n_in != 21 || ws_size < WS_END || out_size != TL * DM) { fprintf(stderr, "kernel_launch: unexpected shapes (n_in %d ws %zu out %d)\n", n_in, ws_size, out_size); grid = -1; return; }
    int dev = 0, cus = 0, per_cu = 2;
    (void)hipGetDevice(&dev);
    (void)hipDeviceGetAttribute(&cus, hipDeviceAttributeMultiprocessorCount, dev);
#if N_LAUNCH_MODE == 1
    (void)hipOccupancyMaxActiveBlocksPerMultiprocessor(&per_cu, (const void*)mk_fwd, 256, 0);
    if (per_cu < 1) per_cu = 1;
    if (per_cu > 2) per_cu = 2;
#endif
    grid = cus * per_cu;
  }
  if (grid < 0) return;
  (void)hipMemsetAsync((char*)d_ws + OFF_CTL, 0, 65536, stream);
  Params p{};
  const float** pp = (const float**)&p;
  for (int i = 0; i < 21; ++i) pp[i] = (const float*)d_in[i];
  p.out = (float*)d_out;
  p.ws = (unsigned char*)d_ws;
#if N_LAUNCH_MODE == 1
  p.ph_lo = 0; p.ph_hi = N_PHASES;
  void* args[] = {&p};
  hipError_t e = hipLaunchCooperativeKernel((const void*)mk_fwd, dim3(grid), dim3(256), args, 0, stream);
  if (e != hipSuccess) fprintf(stderr, "cooperative launch failed: %s (grid %d)\n", hipGetErrorString(e), grid);
#else
  for (int ph = 0; ph < N_PHASES; ++ph) {
    p.ph_lo = ph; p.ph_hi = ph + 1;
    const int kind = ph == 0 ? 0 : (ph == N_PHASES - 1 ? 11 : 1 + (ph - 1) % PH_PER_LAYER);
    switch (kind) {
      case 0: hipLaunchKernelGGL(mk_phase<0>, dim3(grid), dim3(256), 0, stream, p); break;
      case 1: hipLaunchKernelGGL(mk_phase<1>, dim3(grid), dim3(256), 0, stream, p); break;
      case 2: hipLaunchKernelGGL(mk_phase<2>, dim3(grid), dim3(256), 0, stream, p); break;
      case 3: hipLaunchKernelGGL(mk_phase<3>, dim3(grid), dim3(256), 0, stream, p); break;
      case 4: hipLaunchKernelGGL(mk_phase<4>, dim3(grid), dim3(256), 0, stream, p); break;
      case 5: hipLaunchKernelGGL(mk_phase<5>, dim3(grid), dim3(256), 0, stream, p); break;
      case 6: hipLaunchKernelGGL(mk_phase<6>, dim3(grid), dim3(256), 0, stream, p); break;
      case 7: hipLaunchKernelGGL(mk_phase<7>, dim3(grid), dim3(256), 0, stream, p); break;
      case 8: hipLaunchKernelGGL(mk_phase<8>, dim3(grid), dim3(256), 0, stream, p); break;
      case 9: hipLaunchKernelGGL(mk_phase<9>, dim3(grid), dim3(256), 0, stream, p); break;
      case 10: hipLaunchKernelGGL(mk_phase<10>, dim3(grid), dim3(256), 0, stream, p); break;
      default: hipLaunchKernelGGL(mk_phase<11>, dim3(grid), dim3(256), 0, stream, p); break;
    }
  }
#endif
}
```

```cpp
#include <hip/hip_runtime.h>
#include <hip/hip_cooperative_groups.h>
#include <stdint.h>
#include <stdio.h>
namespace cg = cooperative_groups;

#ifndef N_LAUNCH_MODE
#define N_LAUNCH_MODE 1
#endif

#define DI __device__ __forceinline__
typedef unsigned short bf16_t;
typedef short bf16x8 __attribute__((ext_vector_type(8)));
typedef float f32x4 __attribute__((ext_vector_type(4)));
typedef unsigned u32x4 __attribute__((ext_vector_type(4)));
typedef unsigned u32x2 __attribute__((ext_vector_type(2)));

constexpr int NB = 16, SEQ = 2048, DM = 1024, NL = 4, CTXL = 256;
constexpr int TL = NB * SEQ;
constexpr int TC = NB * CTXL;
constexpr int TT = TL + TC;
constexpr int PN_LD = 2176;
constexpr int C_GQ = 0, C_GK = 128, C_GR = 256, C_NQ = 512, C_NK = 768, C_DQ = 1024, C_DK = 1536, C_GATE = 2048;
constexpr int R_GV = 0, R_NV = 256, R_DV = 512;
constexpr float LOG2E = 1.4426950408889634f;
constexpr float SC_LOG2 = 0.125f * LOG2E;
constexpr float NEG_BIG = -1e30f;

constexpr size_t MiB = 1u << 20;
constexpr size_t OFF_CTL = 0;
constexpr size_t OFF_MOD = 1 * MiB;
constexpr size_t OFF_WIN = 3 * MiB;
constexpr size_t OFF_WOUT = 28 * MiB;
constexpr size_t OFF_WQ = 36 * MiB;
constexpr size_t OFF_SK = 44 * MiB;
constexpr size_t OFF_U = 45 * MiB;
constexpr size_t OFF_V = 173 * MiB;
constexpr size_t OFF_XRES = 301 * MiB;
constexpr size_t OFF_H = 445 * MiB;
constexpr size_t OFF_P = 517 * MiB;
constexpr size_t OFF_VT = OFF_P + 153 * MiB;
constexpr size_t OFF_QP = OFF_P;
constexpr size_t OFF_EID = OFF_P + 72 * MiB;
constexpr size_t OFF_GATE = OFF_P + 90 * MiB;
constexpr size_t OFF_Y = 742 * MiB;
constexpr size_t WS_END = 814 * MiB;

constexpr int LDS_BYTES = 65536;

struct Params {
  const float *x, *c, *ctx, *c_ctx, *ada_w, *ada_b, *norm1_g, *norm2_g, *w_in, *gate_up, *gate_b, *gla_norm_g,
      *rpb, *dlam, *diff_g, *w_out, *wq, *subkeys, *pu, *pv, *final_g;
  float* out;
  unsigned char* ws;
  int ph_lo, ph_hi;
};

DI int ltid() { int t = threadIdx.x; asm volatile("" : "+v"(t)); return t; }
DI int lbid() { int t = blockIdx.x; asm volatile("" : "+s"(t)); return t; }
DI int lgdim() { int t = gridDim.x; asm volatile("" : "+s"(t)); return t; }

DI unsigned f2bf(float f) { unsigned u = __float_as_uint(f); return (u + 0x7fffu + ((u >> 16) & 1u)) >> 16; }
DI unsigned pk2(float lo, float hi) { return f2bf(lo) | (f2bf(hi) << 16); }
DI float bflo(unsigned u) { return __uint_as_float(u << 16); }
DI float bfhi(unsigned u) { return __uint_as_float(u & 0xffff0000u); }
DI void unpack8(const u32x4 v, float* f) {
  f[0] = bflo(v.x); f[1] = bfhi(v.x); f[2] = bflo(v.y); f[3] = bfhi(v.y);
  f[4] = bflo(v.z); f[5] = bfhi(v.z); f[6] = bflo(v.w); f[7] = bfhi(v.w);
}
DI float wave_sum(float v) {
#pragma unroll
  for (int o = 32; o >= 1; o >>= 1) v += __shfl_xor(v, o);
  return v;
}
DI f32x4 mfma16(bf16x8 a, bf16x8 b, f32x4 c) { return __builtin_amdgcn_mfma_f32_16x16x32_bf16(a, b, c, 0, 0, 0); }

DI int win_src_col(int r) {
  if (r < 256) return r;
  if (r < 512) return r - 256 + 512;
  if (r < 768) return r - 512 + 800;
  if (r < 1024) return r - 768 + 1056;
  if (r < 1536) return r - 1024 + 1568;
  if (r < 2048) return r - 1536 + 2080;
  if (r < 2080) return r - 2048 + 768;
  if (r < 2176) return -1;
  if (r < 2432) return r - 2176 + 256;
  if (r < 2688) return r - 2432 + 1312;
  return r - 2688 + 2592;
}

DI void transpose_item(const float* __restrict__ W, int N, int src, bf16_t* __restrict__ dst, float* lds) {
  const int tid = ltid();
  for (int kc = 0; kc < 8; ++kc) {
    __syncthreads();
#pragma unroll
    for (int i = 0; i < 16; ++i) {
      int k = i * 8 + (tid >> 5), n = tid & 31;
      lds[k * 33 + n] = (src < 0) ? 0.f : W[(size_t)(kc * 128 + k) * N + src + n];
    }
    __syncthreads();
    int row = tid >> 3, k0 = (tid & 7) * 16;
    unsigned o[8];
#pragma unroll
    for (int e = 0; e < 8; ++e) o[e] = pk2(lds[(k0 + 2 * e) * 33 + row], lds[(k0 + 2 * e + 1) * 33 + row]);
    u32x4 a = {o[0], o[1], o[2], o[3]}, b = {o[4], o[5], o[6], o[7]};
    bf16_t* d = dst + (size_t)row * 1024 + kc * 128 + k0;
    *(u32x4*)d = a; *(u32x4*)(d + 8) = b;
  }
}

DI void phase_prologue(const Params& p, unsigned char* lds) {
  const int tid = ltid(), nb = lgdim(), bid = lbid();
  bf16_t* winT = (bf16_t*)(p.ws + OFF_WIN);
  bf16_t* woutT = (bf16_t*)(p.ws + OFF_WOUT);
  bf16_t* wqT = (bf16_t*)(p.ws + OFF_WQ);
  constexpr int PER_LAYER = 100 + 32 + 32;
  for (int item = bid; item < NL * PER_LAYER; item += nb) {
    int l = item / PER_LAYER, r = item % PER_LAYER;
    if (r < 100) {
      int row = r * 32;
      transpose_item(p.w_in + (size_t)l * 1024 * 3104, 3104, win_src_col(row), winT + ((size_t)l * 3200 + row) * 1024, (float*)lds);
    } else if (r < 132) {
      int row = (r - 100) * 32;
      transpose_item(p.w_out + (size_t)l * 1024 * 1024, 1024, row, woutT + ((size_t)l * 1024 + row) * 1024, (float*)lds);
    } else {
      int row = (r - 132) * 32;
      transpose_item(p.wq + (size_t)l * 1024 * 1024, 1024, row, wqT + ((size_t)l * 1024 + row) * 1024, (float*)lds);
    }
  }
  {
    const size_t total8 = (size_t)NL * 16384 * 1024 / 8;
    bf16_t* ub = (bf16_t*)(p.ws + OFF_U);
    bf16_t* vb = (bf16_t*)(p.ws + OFF_V);
    for (size_t i = (size_t)bid * 256 + tid; i < total8; i += (size_t)nb * 256) {
      const float4 a0 = *(const float4*)(p.pu + i * 8), a1 = *(const float4*)(p.pu + i * 8 + 4);
      const float4 b0 = *(const float4*)(p.pv + i * 8), b1 = *(const float4*)(p.pv + i * 8 + 4);
      u32x4 ua = {pk2(a0.x, a0.y), pk2(a0.z, a0.w), pk2(a1.x, a1.y), pk2(a1.z, a1.w)};
      u32x4 va = {pk2(b0.x, b0.y), pk2(b0.z, b0.w), pk2(b1.x, b1.y), pk2(b1.z, b1.w)};
      *(u32x4*)(ub + i * 8) = ua;
      *(u32x4*)(vb + i * 8) = va;
    }
  }
  {
    bf16_t* sk = (bf16_t*)(p.ws + OFF_SK);
    for (int i = bid * 256 + tid; i < NL * 2 * 128 * 64; i += nb * 256) sk[i] = (bf16_t)f2bf(p.subkeys[i]);
  }
  {
    float* modbuf = (float*)(p.ws + OFF_MOD);
    float* sc = (float*)lds;
    float* red = (float*)(lds + 17 * 512 * 4);
    for (int item = bid; item < NL * 96; item += nb) {
      const int l = item / 96, cb = item % 96, col = cb * 64 + (tid & 63), kq = tid >> 6;
      float acc[17];
#pragma unroll
      for (int r = 0; r < 17; ++r) acc[r] = 0.f;
      for (int half = 0; half < 2; ++half) {
        __syncthreads();
        for (int e = tid; e < 17 * 512; e += 256) {
          int r = e >> 9, k = e & 511;
          float cv = (r < 16) ? p.c[r * 1024 + half * 512 + k] : p.c_ctx[half * 512 + k];
          sc[e] = cv / (1.f + __expf(-cv));
        }
        __syncthreads();
        const float* wp = p.ada_w + ((size_t)l * 1024 + half * 512 + kq * 128) * 6144 + col;
        for (int kk = 0; kk < 128; ++kk) {
          const float w = wp[(size_t)kk * 6144];
#pragma unroll
          for (int r = 0; r < 17; ++r) acc[r] += sc[r * 512 + kq * 128 + kk] * w;
        }
      }
#pragma unroll
      for (int r = 0; r < 17; ++r) red[(kq * 17 + r) * 64 + (tid & 63)] = acc[r];
      __syncthreads();
      for (int e = tid; e < 17 * 64; e += 256) {
        int r = e >> 6, cc = e & 63;
        float s = red[(0 * 17 + r) * 64 + cc] + red[(1 * 17 + r) * 64 + cc] + red[(2 * 17 + r) * 64 + cc] + red[(3 * 17 + r) * 64 + cc];
        int colg = cb * 64 + cc;
        modbuf[((size_t)l * 17 + r) * 6144 + colg] = s + p.ada_b[l * 6144 + colg];
      }
      __syncthreads();
    }
  }
}

DI void phase_norm(const Params& p, int l, int which, int ntok) {
  const int lane = ltid() & 63, gw = lbid() * 4 + (ltid() >> 6), nw = lgdim() * 4;
  const float* gvec = (which == 0 ? p.norm1_g : p.norm2_g) + l * 1024;
  const int ish = which == 0 ? 0 : 3, isc = which == 0 ? 1 : 4;
  const float* xres = (const float*)(p.ws + OFF_XRES);
  const float* modbuf = (const float*)(p.ws + OFF_MOD);
  bf16_t* hbuf = (bf16_t*)(p.ws + OFF_H);
  for (int t = gw; t < ntok; t += nw) {
    const float* src = (which == 0 && l == 0) ? (t < TL ? p.x + (size_t)t * 1024 : p.ctx + (size_t)(t - TL) * 1024) : xres + (size_t)t * 1024;
    const int b = t < TL ? (t >> 11) : 16;
    const float* md = modbuf + ((size_t)l * 17 + b) * 6144;
    float4 v[4];
    float ss = 0.f;
#pragma unroll
    for (int i = 0; i < 4; ++i) {
      v[i] = *(const float4*)(src + 4 * lane + 256 * i);
      ss += v[i].x * v[i].x + v[i].y * v[i].y + v[i].z * v[i].z + v[i].w * v[i].w;
    }
    ss = wave_sum(ss);
    const float rstd = rsqrtf(ss * (1.f / 1024.f) + 1e-6f);
#pragma unroll
    for (int i = 0; i < 4; ++i) {
      const int col = 4 * lane + 256 * i;
      const float4 g4 = *(const float4*)(gvec + col), sh = *(const float4*)(md + ish * 1024 + col), sc = *(const float4*)(md + isc * 1024 + col);
      float o0 = v[i].x * rstd * g4.x * (1.f + sc.x) + sh.x;
      float o1 = v[i].y * rstd * g4.y * (1.f + sc.y) + sh.y;
      float o2 = v[i].z * rstd * g4.z * (1.f + sc.z) + sh.z;
      float o3 = v[i].w * rstd * g4.w * (1.f + sc.w) + sh.w;
      u32x2 o = {pk2(o0, o1), pk2(o2, o3)};
      *(u32x2*)(hbuf + (size_t)t * 1024 + col) = o;
    }
  }
}

template <int EPI>
DI void gemm_tile(const bf16_t* __restrict__ P, const bf16_t* __restrict__ Q, int it, int jt, void* outp, int ld,
                  const float* xin_lat, const float* xin_ctx, const float* modl, unsigned char* lds) {
  const int tid = ltid(), lane = tid & 63, w = tid >> 6, wi = w >> 1, wj = w & 1, lr = lane & 15, g = lane >> 4;
  unsigned char* Ps = lds;
  unsigned char* Qs = lds + 16384;
  f32x4 acc[4][4];
#pragma unroll
  for (int a = 0; a < 4; ++a)
#pragma unroll
    for (int b = 0; b < 4; ++b) acc[a][b] = (f32x4){0.f, 0.f, 0.f, 0.f};
  const int c = tid & 7, r0 = tid >> 3;
  const bf16_t* pg = P + (size_t)(it * 128 + r0) * 1024 + c * 8;
  const bf16_t* qg = Q + (size_t)(jt * 128 + r0) * 1024 + c * 8;
  u32x4 pr[4], qr[4];
#pragma unroll
  for (int ii = 0; ii < 4; ++ii) { pr[ii] = *(const u32x4*)(pg + (size_t)ii * 32 * 1024); qr[ii] = *(const u32x4*)(qg + (size_t)ii * 32 * 1024); }
  for (int kb = 0; kb < 16; ++kb) {
#pragma unroll
    for (int ii = 0; ii < 4; ++ii) {
      const int row = r0 + 32 * ii;
      const unsigned off = row * 128 + ((c ^ (row & 7)) << 4);
      *(u32x4*)(Ps + off) = pr[ii];
      *(u32x4*)(Qs + off) = qr[ii];
    }
    __syncthreads();
    if (kb < 15) {
#pragma unroll
      for (int ii = 0; ii < 4; ++ii) {
        pr[ii] = *(const u32x4*)(pg + (size_t)ii * 32 * 1024 + (kb + 1) * 64);
        qr[ii] = *(const u32x4*)(qg + (size_t)ii * 32 * 1024 + (kb + 1) * 64);
      }
    }
#pragma unroll
    for (int ks = 0; ks < 2; ++ks) {
      bf16x8 pf[4], qf[4];
      const int ch = ks * 4 + g;
#pragma unroll
      for (int mi = 0; mi < 4; ++mi) { const int row = wi * 64 + mi * 16 + lr; pf[mi] = *(const bf16x8*)(Ps + row * 128 + ((ch ^ (row & 7)) << 4)); }
#pragma unroll
      for (int nj = 0; nj < 4; ++nj) { const int row = wj * 64 + nj * 16 + lr; qf[nj] = *(const bf16x8*)(Qs + row * 128 + ((ch ^ (row & 7)) << 4)); }
#pragma unroll
      for (int mi = 0; mi < 4; ++mi)
#pragma unroll
        for (int nj = 0; nj < 4; ++nj) acc[mi][nj] = mfma16(pf[mi], qf[nj], acc[mi][nj]);
    }
    __syncthreads();
  }
#pragma unroll
  for (int mi = 0; mi < 4; ++mi)
#pragma unroll
    for (int nj = 0; nj < 4; ++nj) {
      const int j = jt * 128 + wj * 64 + nj * 16 + lr;
      const int i = it * 128 + wi * 64 + mi * 16 + 4 * g;
      const f32x4 a = acc[mi][nj];
      if (EPI == 0) {
        u32x2 o = {pk2(a[0], a[1]), pk2(a[2], a[3])};
        *(u32x2*)((bf16_t*)outp + (size_t)j * ld + i) = o;
      } else {
        const int b = j < TL ? (j >> 11) : 16;
        const float4 gt = *(const float4*)(modl + (size_t)b * 6144 + 2 * 1024 + i);
        const float* xs = (j < TL) ? xin_lat + (size_t)j * 1024 + i : xin_ctx + (size_t)(j - TL) * 1024 + i;
        const float4 xv = *(const float4*)xs;
        float4 o = {xv.x + gt.x * a[0], xv.y + gt.y * a[1], xv.z + gt.z * a[2], xv.w + gt.w * a[3]};
        *(float4*)((float*)outp + (size_t)j * 1024 + i) = o;
      }
    }
}

DI void phase_gemm_in(const Params& p, int l, unsigned char* lds) {
  const bf16_t* W = (const bf16_t*)(p.ws + OFF_WIN) + (size_t)l * 3200 * 1024;
  const bf16_t* H = (const bf16_t*)(p.ws + OFF_H);
  bf16_t* PN = (bf16_t*)(p.ws + OFF_P);
  bf16_t* VT = (bf16_t*)(p.ws + OFF_VT);
  constexpr int NJT = TT / 128;
  constexpr int T1 = NJT * 17, T2 = NJT * 8;
  for (int t = lbid(); t < T1 + T2; t += lgdim()) {
    if (t < T1) { const int jt = t / 17, it = t % 17; gemm_tile<0>(W, H, it, jt, PN, PN_LD, nullptr, nullptr, nullptr, lds); }
    else { const int u = t - T1; const int it = u >> 3, jt = u & 7; gemm_tile<0>(H, W + (size_t)2176 * 1024, it, jt, VT, TT, nullptr, nullptr, nullptr, lds); }
  }
}
DI void phase_gemm_out(const Params& p, int l, int ntok, unsigned char* lds) {
  const bf16_t* W = (const bf16_t*)(p.ws + OFF_WOUT) + (size_t)l * 1024 * 1024;
  const bf16_t* Y = (const bf16_t*)(p.ws + OFF_Y);
  float* xres = (float*)(p.ws + OFF_XRES);
  const float* modl = (const float*)(p.ws + OFF_MOD) + (size_t)l * 17 * 6144;
  const float* xl = (l == 0) ? p.x : xres;
  const float* xc = (l == 0) ? p.ctx : xres + (size_t)TL * 1024;
  const int ntile = (ntok / 128) * 8;
  for (int t = lbid(); t < ntile; t += lgdim()) {
    const int jt = t >> 3, it = t & 7;
    gemm_tile<1>(W, Y, it, jt, xres, 1024, xl, xc, modl, lds);
  }
}
DI void phase_gemm_q(const Params& p, int l, int ntok, unsigned char* lds) {
  const bf16_t* W = (const bf16_t*)(p.ws + OFF_WQ) + (size_t)l * 1024 * 1024;
  const bf16_t* H = (const bf16_t*)(p.ws + OFF_H);
  bf16_t* QP = (bf16_t*)(p.ws + OFF_QP);
  const int ntile = (ntok / 128) * 8;
  for (int t = lbid(); t < ntile; t += lgdim()) {
    const int jt = t >> 3, it = t & 7;
    gemm_tile<0>(W, H, it, jt, QP, 1024, nullptr, nullptr, nullptr, lds);
  }
}

DI void phase_rope(const Params& p, unsigned char* lds) {
  float2* tab = (float2*)lds;
  for (int e = ltid(); e < 1024; e += 256) {
    const int pos = e >> 4, i = e & 15;
    const float inv = exp2f(-(float)i * (13.287712379549449f / 16.f));
    const float ang = (float)pos * inv;
    tab[e] = make_float2(__cosf(ang), __sinf(ang));
  }
  __syncthreads();
  bf16_t* PN = (bf16_t*)(p.ws + OFF_P);
  const int total = TL * 16;
  for (int idx = lbid() * 256 + ltid(); idx < total; idx += lgdim() * 256) {
    const int t = idx >> 4, vec = idx & 15;
    const int col = ((vec >> 3) ? C_DK : C_DQ) + ((vec >> 1) & 3) * 128 + (vec & 1) * 64;
    bf16_t* ptr = PN + (size_t)t * PN_LD + col;
    float xv[64];
#pragma unroll
    for (int q = 0; q < 8; ++q) { const u32x4 v = *(const u32x4*)(ptr + q * 8); unpack8(v, xv + q * 8); }
    const int row = (t & 2047) >> 6, cp = t & 63;
#pragma unroll
    for (int i = 0; i < 16; ++i) {
      const float2 cs = tab[row * 16 + i];
      const float x1 = xv[i], x2 = xv[16 + i];
      xv[i] = x1 * cs.x - x2 * cs.y; xv[16 + i] = x2 * cs.x + x1 * cs.y;
      const float2 cs2 = tab[cp * 16 + i];
      const float y1 = xv[32 + i], y2 = xv[48 + i];
      xv[32 + i] = y1 * cs2.x - y2 * cs2.y; xv[48 + i] = y2 * cs2.x + y1 * cs2.y;
    }
#pragma unroll
    for (int q = 0; q < 8; ++q) {
      u32x4 o = {pk2(xv[q * 8], xv[q * 8 + 1]), pk2(xv[q * 8 + 2], xv[q * 8 + 3]), pk2(xv[q * 8 + 4], xv[q * 8 + 5]), pk2(xv[q * 8 + 6], xv[q * 8 + 7])};
      *(u32x4*)(ptr + q * 8) = o;
    }
  }
}

struct SrcSeg {
  const bf16_t* PN; const bf16_t* VT; int kcol, vrow, t0, n0, t1, n1, lr, g;
  const bf16_t* k0p; const bf16_t* k1p; const bf16_t* vp;
  DI int nsteps() const { return n0 + n1; }
  DI void setup(int st) {
    const int tok0 = st < n0 ? t0 + st * 32 : t1 + (st - n0) * 32;
    const int kap = 8 * (lr >> 2) + (lr & 3);
    k0p = PN + (size_t)(tok0 + kap) * PN_LD + kcol + 8 * g;
    k1p = k0p + (size_t)4 * PN_LD;
    vp = VT + (size_t)(vrow + lr) * TT + tok0 + 8 * g;
  }
  DI bf16x8 kfrag(int m, int kt, int ks) const { return *(const bf16x8*)((kt ? k1p : k0p) + m * 64 + ks * 32); }
  DI bf16x8 vfrag(int dt) const { return *(const bf16x8*)(vp + (size_t)dt * 16 * TT); }
  DI float score(float raw, int kt, int r) const { return raw * SC_LOG2; }
};
struct SrcNat {
  const bf16_t* PN; const bf16_t* VT; int kcol, vrow, b, rq, rs, cs, qc, cstart, lr, g, st_;
  const float* rpbh;
  const bf16_t* k0p; const bf16_t* k1p; const bf16_t* vp;
  DI int nsteps() const { return 16; }
  DI void setup(int st) {
    st_ = st;
    const int tok0 = st < 8 ? b * 2048 + (rs + st) * 64 + cs : TL + b * 256 + (st - 8) * 32;
    const int kap = 8 * (lr >> 2) + (lr & 3);
    k0p = PN + (size_t)(tok0 + kap) * PN_LD + kcol + 8 * g;
    k1p = k0p + (size_t)4 * PN_LD;
    vp = VT + (size_t)(vrow + lr) * TT + tok0 + 8 * g;
  }
  DI bf16x8 kfrag(int m, int kt, int ks) const { return *(const bf16x8*)((kt ? k1p : k0p) + ks * 32); }
  DI bf16x8 vfrag(int dt) const { return *(const bf16x8*)(vp + (size_t)dt * 16 * TT); }
  DI float score(float raw, int kt, int r) const {
    if (st_ >= 8) return raw * SC_LOG2;
    const int kc = cs + 8 * g + 4 * kt + r;
    const bool valid = (kc >= cstart) && (kc < cstart + 16);
    int dc = kc - qc + 15; dc = dc < 0 ? 0 : (dc > 30 ? 30 : dc);
    const float bias = rpbh[(rs + st_ - rq + 7) * 31 + dc];
    return valid ? (raw * 0.125f + bias) * LOG2E : NEG_BIG;
  }
};

template <int MAPS, int DVT, class Src>
DI void flash_wave(Src& S, const bf16_t* qptr  , f32x4 (&o)[MAPS][DVT], float (&ltot)[MAPS]) {
  bf16x8 qf[MAPS][2];
#pragma unroll
  for (int m = 0; m < MAPS; ++m)
#pragma unroll
    for (int ks = 0; ks < 2; ++ks) qf[m][ks] = *(const bf16x8*)(qptr + m * 64 + ks * 32);
  float mrun[MAPS], lrun[MAPS];
#pragma unroll
  for (int m = 0; m < MAPS; ++m) {
    mrun[m] = NEG_BIG; lrun[m] = 0.f;
#pragma unroll
    for (int dt = 0; dt < DVT; ++dt) o[m][dt] = (f32x4){0.f, 0.f, 0.f, 0.f};
  }
  const int ns = S.nsteps();
  for (int st = 0; st < ns; ++st) {
    S.setup(st);
    bf16x8 pf[MAPS];
#pragma unroll
    for (int m = 0; m < MAPS; ++m) {
      f32x4 s[2];
#pragma unroll
      for (int kt = 0; kt < 2; ++kt) {
        s[kt] = (f32x4){0.f, 0.f, 0.f, 0.f};
#pragma unroll
        for (int ks = 0; ks < 2; ++ks) s[kt] = mfma16(S.kfrag(m, kt, ks), qf[m][ks], s[kt]);
      }
      float mt = NEG_BIG;
#pragma unroll
      for (int kt = 0; kt < 2; ++kt)
#pragma unroll
        for (int r = 0; r < 4; ++r) { s[kt][r] = S.score(s[kt][r], kt, r); mt = fmaxf(mt, s[kt][r]); }
      mt = fmaxf(mt, __shfl_xor(mt, 16));
      mt = fmaxf(mt, __shfl_xor(mt, 32));
      const bool need = mt > mrun[m] + 8.f;
      if (__any(need)) {
        const float mnew = need ? mt : mrun[m];
        const float alpha = exp2f(mrun[m] - mnew);
        lrun[m] *= alpha;
#pragma unroll
        for (int dt = 0; dt < DVT; ++dt) { o[m][dt][0] *= alpha; o[m][dt][1] *= alpha; o[m][dt][2] *= alpha; o[m][dt][3] *= alpha; }
        mrun[m] = mnew;
      }
      float pv[8];
      float ls = 0.f;
#pragma unroll
      for (int kt = 0; kt < 2; ++kt)
#pragma unroll
        for (int r = 0; r < 4; ++r) { pv[kt * 4 + r] = exp2f(s[kt][r] - mrun[m]); ls += pv[kt * 4 + r]; }
      lrun[m] += ls;
      u32x4 pk = {pk2(pv[0], pv[1]), pk2(pv[2], pv[3]), pk2(pv[4], pv[5]), pk2(pv[6], pv[7])};
      pf[m] = __builtin_bit_cast(bf16x8, pk);
    }
#pragma unroll
    for (int dt = 0; dt < DVT; ++dt) {
      const bf16x8 vf = S.vfrag(dt);
#pragma unroll
      for (int m = 0; m < MAPS; ++m) o[m][dt] = mfma16(vf, pf[m], o[m][dt]);
    }
  }
#pragma unroll
  for (int m = 0; m < MAPS; ++m) {
    float l = lrun[m];
    l += __shfl_xor(l, 16);
    l += __shfl_xor(l, 32);
    ltot[m] = l;
  }
}

DI void diff_wave_task(const Params& p, int l, int b, int hd, int qtok0, bool ctx_only) {
  const int lane = ltid() & 63, lr = lane & 15, g = lane >> 4;
  const bf16_t* PN = (const bf16_t*)(p.ws + OFF_P);
  const bf16_t* VT = (const bf16_t*)(p.ws + OFF_VT);
  bf16_t* Y = (bf16_t*)(p.ws + OFF_Y);
  const float* lv = p.dlam + l * 256;
  float sa = lv[lane] * lv[64 + lane], sb = lv[128 + lane] * lv[192 + lane];
  sa = wave_sum(sa); sb = wave_sum(sb);
  const float lam_init = 0.8f - 0.6f * expf(-0.3f * (float)l);
  const float lam = expf(sa) - expf(sb) + lam_init;
  SrcSeg S;
  S.PN = PN; S.VT = VT; S.kcol = C_DK + hd * 128; S.vrow = R_DV + hd * 128; S.lr = lr; S.g = g;
  S.t0 = TL + b * 256; S.n0 = 8; S.t1 = b * 2048; S.n1 = ctx_only ? 0 : 64;
  f32x4 o[2][8];
  float lt[2];
  const int qtok = qtok0 + lr;
  flash_wave<2, 8, SrcSeg>(S, PN + (size_t)qtok * PN_LD + C_DQ + hd * 128 + 8 * g, o, lt);
  const float i0 = 1.f / lt[0], i1 = lam / lt[1];
  float ss = 0.f;
#pragma unroll
  for (int dt = 0; dt < 8; ++dt)
#pragma unroll
    for (int r = 0; r < 4; ++r) { const float v = o[0][dt][r] * i0 - o[1][dt][r] * i1; o[0][dt][r] = v; ss += v * v; }
  ss += __shfl_xor(ss, 16);
  ss += __shfl_xor(ss, 32);
  const float rstd = rsqrtf(ss * (1.f / 128.f) + 1e-6f) * (1.f - lam_init);
  const float* dg = p.diff_g + l * 512 + hd * 128;
#pragma unroll
  for (int dt = 0; dt < 8; ++dt) {
    const float4 gg = *(const float4*)(dg + dt * 16 + 4 * g);
    u32x2 ov = {pk2(o[0][dt][0] * rstd * gg.x, o[0][dt][1] * rstd * gg.y), pk2(o[0][dt][2] * rstd * gg.z, o[0][dt][3] * rstd * gg.w)};
    *(u32x2*)(Y + (size_t)qtok * 1024 + 512 + hd * 128 + dt * 16 + 4 * g) = ov;
  }
}

DI void nat_wave_task(const Params& p, int l, int b, int head, int rq, int ct, const float* rpb_lds) {
  const int lane = ltid() & 63, lr = lane & 15, g = lane >> 4;
  const bf16_t* PN = (const bf16_t*)(p.ws + OFF_P);
  const bf16_t* VT = (const bf16_t*)(p.ws + OFF_VT);
  bf16_t* Y = (bf16_t*)(p.ws + OFF_Y);
  SrcNat S;
  S.PN = PN; S.VT = VT; S.kcol = C_NK + head * 64; S.vrow = R_NV + head * 64; S.b = b; S.rq = rq; S.lr = lr; S.g = g;
  int rs = rq - 4; rs = rs < 0 ? 0 : (rs > 24 ? 24 : rs);
  S.rs = rs;
  int cs = 16 * ct - 8; cs = cs < 0 ? 0 : (cs > 32 ? 32 : cs);
  S.cs = cs;
  S.qc = 16 * ct + lr;
  int cst = S.qc - 8; cst = cst < 0 ? 0 : (cst > 48 ? 48 : cst);
  S.cstart = cst;
  S.rpbh = rpb_lds + head * 465;
  f32x4 o[1][4];
  float lt[1];
  const int qtok = b * 2048 + rq * 64 + 16 * ct + lr;
  flash_wave<1, 4, SrcNat>(S, PN + (size_t)qtok * PN_LD + C_NQ + head * 64 + 8 * g, o, lt);
  const float inv = 1.f / lt[0];
#pragma unroll
  for (int dt = 0; dt < 4; ++dt) {
    u32x2 ov = {pk2(o[0][dt][0] * inv, o[0][dt][1] * inv), pk2(o[0][dt][2] * inv, o[0][dt][3] * inv)};
    *(u32x2*)(Y + (size_t)qtok * 1024 + 256 + head * 64 + dt * 16 + 4 * g) = ov;
  }
}
DI void natctx_wave_task(const Params& p, int b, int head, int qt) {
  const int lane = ltid() & 63, lr = lane & 15, g = lane >> 4;
  const bf16_t* PN = (const bf16_t*)(p.ws + OFF_P);
  const bf16_t* VT = (const bf16_t*)(p.ws + OFF_VT);
  bf16_t* Y = (bf16_t*)(p.ws + OFF_Y);
  SrcSeg S;
  S.PN = PN; S.VT = VT; S.kcol = C_NK + head * 64; S.vrow = R_NV + head * 64; S.lr = lr; S.g = g;
  S.t0 = TL + b * 256; S.n0 = 8; S.t1 = 0; S.n1 = 0;
  f32x4 o[1][4];
  float lt[1];
  const int qtok = TL + b * 256 + qt * 16 + lr;
  flash_wave<1, 4, SrcSeg>(S, PN + (size_t)qtok * PN_LD + C_NQ + head * 64 + 8 * g, o, lt);
  const float inv = 1.f / lt[0];
#pragma unroll
  for (int dt = 0; dt < 4; ++dt) {
    u32x2 ov = {pk2(o[0][dt][0] * inv, o[0][dt][1] * inv), pk2(o[0][dt][2] * inv, o[0][dt][3] * inv)};
    *(u32x2*)(Y + (size_t)qtok * 1024 + 256 + head * 64 + dt * 16 + 4 * g) = ov;
  }
}

DI void gla_task(const Params& p, int l, int task, unsigned char* lds) {
  const int tid = ltid(), lane = tid & 63, w = tid >> 6, vv = lane & 15, g = lane >> 4;
  const int b = task >> 3, h = (task >> 1) & 3, dir = task & 1;
  const bf16_t* PN = (const bf16_t*)(p.ws + OFF_P);
  const bf16_t* VT = (const bf16_t*)(p.ws + OFF_VT);
  float* og = (float*)(p.ws + OFF_H);
  float* Gup = (float*)lds;
  float* Gb = Gup + 512;
  float* As = Gb + 32;
  float* Ks = As + 2048;
  float* Qs = Ks + 2048;
  float* Vs = Qs + 2048;
  __syncthreads();
  for (int e = tid; e < 512; e += 256) { const int r = e >> 5, kd = e & 31; Gup[e] = p.gate_up[((size_t)(l * 2 + dir) * 16 + r) * 128 + h * 32 + kd]; }
  if (tid < 32) Gb[tid] = p.gate_b[(l * 2 + dir) * 128 + h * 32 + tid];
  float S[8];
#pragma unroll
  for (int e = 0; e < 8; ++e) S[e] = 0.f;
  for (int cc = 0; cc < 36; ++cc) {
    int tok0;
    if (cc < 4) { const int ch = dir == 0 ? cc : 3 - cc; tok0 = TL + b * 256 + ch * 64; }
    else { const int ch = dir == 0 ? cc - 4 : 35 - cc; tok0 = b * 2048 + ch * 64; }
    __syncthreads();
    {
      const int i = tid >> 2, part = tid & 3;
      const bf16_t* row = PN + (size_t)(tok0 + i) * PN_LD;
      const u32x4 qv = *(const u32x4*)(row + C_GQ + h * 32 + part * 8);
      const u32x4 kv = *(const u32x4*)(row + C_GK + h * 32 + part * 8);
      const u32x4 g0 = *(const u32x4*)(row + C_GATE + dir * 16);
      const u32x4 g1 = *(const u32x4*)(row + C_GATE + dir * 16 + 8);
      float gd[16], qf[8], kf[8];
      unpack8(g0, gd); unpack8(g1, gd + 8); unpack8(qv, qf); unpack8(kv, kf);
#pragma unroll
      for (int e = 0; e < 8; ++e) {
        const int kd = part * 8 + e;
        float pre = Gb[kd];
#pragma unroll
        for (int r = 0; r < 16; ++r) pre += gd[r] * Gup[r * 32 + kd];
        const float ls = fminf(pre, 0.f) - log1pf(__expf(-fabsf(pre)));
        As[i * 32 + kd] = __expf(ls * (1.f / 16.f));
        Ks[i * 32 + kd] = kf[e];
        Qs[i * 32 + kd] = qf[e] * 0.17677669529663687f;
      }
      const int v = tid >> 2;
      const bf16_t* vp = VT + (size_t)(R_GV + h * 64 + v) * TT + tok0 + part * 16;
      const u32x4 v0 = *(const u32x4*)vp, v1 = *(const u32x4*)(vp + 8);
      float vf[16];
      unpack8(v0, vf); unpack8(v1, vf + 8);
#pragma unroll
      for (int e = 0; e < 16; ++e) Vs[(part * 16 + e) * 65 + v] = vf[e];
    }
    __syncthreads();
    for (int s = 0; s < 64; ++s) {
      const int i = dir == 0 ? s : 63 - s;
      const float4 a0 = *(const float4*)(As + i * 32 + 8 * g), a1 = *(const float4*)(As + i * 32 + 8 * g + 4);
      const float4 k0 = *(const float4*)(Ks + i * 32 + 8 * g), k1 = *(const float4*)(Ks + i * 32 + 8 * g + 4);
      const float4 q0 = *(const float4*)(Qs + i * 32 + 8 * g), q1 = *(const float4*)(Qs + i * 32 + 8 * g + 4);
      const float v = Vs[i * 65 + 16 * w + vv];
      S[0] = a0.x * S[0] + k0.x * v; S[1] = a0.y * S[1] + k0.y * v; S[2] = a0.z * S[2] + k0.z * v; S[3] = a0.w * S[3] + k0.w * v;
      S[4] = a1.x * S[4] + k1.x * v; S[5] = a1.y * S[5] + k1.y * v; S[6] = a1.z * S[6] + k1.z * v; S[7] = a1.w * S[7] + k1.w * v;
      float o = q0.x * S[0] + q0.y * S[1] + q0.z * S[2] + q0.w * S[3] + q1.x * S[4] + q1.y * S[5] + q1.z * S[6] + q1.w * S[7];
      o += __shfl_xor(o, 16);
      o += __shfl_xor(o, 32);
      if (g == 0) og[((size_t)dir * TT + tok0 + i) * 256 + h * 64 + 16 * w + vv] = o;
    }
  }
}

DI void phase_mixers(const Params& p, int l, bool last, unsigned* ctr, unsigned char* lds) {
  const int tid = ltid(), w = tid >> 6;
  volatile int* slot = (volatile int*)(lds + LDS_BYTES - 16);
  float* rpb_lds = (float*)(lds + 48 * 1024);
  for (int e = tid; e < 4 * 465; e += 256) rpb_lds[e] = p.rpb[(size_t)l * 4 * 465 + e];
  const int ntask = 128 + 2048 + 2048 + (last ? 0 : 512);
  for (;;) {
    __syncthreads();
    if (tid == 0) *slot = (int)atomicAdd(ctr, 1u);
    __syncthreads();
    const int task = *slot;
    if (task >= ntask) break;
    if (task < 128) { gla_task(p, l, task, lds); }
    else if (task < 128 + 2048) { const int wt = (task - 128) * 4 + w; diff_wave_task(p, l, wt >> 9, (wt >> 7) & 3, (wt >> 9) * 2048 + (wt & 127) * 16, false); }
    else if (task < 128 + 4096) { const int wt = (task - 128 - 2048) * 4 + w; nat_wave_task(p, l, wt >> 9, (wt >> 7) & 3, (wt >> 2) & 31, wt & 3, rpb_lds); }
    else if (task < 128 + 4096 + 256) { const int wt = (task - 128 - 4096) * 4 + w; const int b = wt >> 6; diff_wave_task(p, l, b, (wt >> 4) & 3, TL + b * 256 + (wt & 15) * 16, true); }
    else { const int wt = (task - 128 - 4096 - 256) * 4 + w; natctx_wave_task(p, wt >> 6, (wt >> 4) & 3, wt & 15); }
  }
}

DI void phase_gla_fin(const Params& p, int l, int ntok) {
  const int lane = ltid() & 63, gw = lbid() * 4 + (ltid() >> 6), nw = lgdim() * 4;
  const float* og = (const float*)(p.ws + OFF_H);
  const bf16_t* PN = (const bf16_t*)(p.ws + OFF_P);
  bf16_t* Y = (bf16_t*)(p.ws + OFF_Y);
  const float4 gg = *(const float4*)(p.gla_norm_g + l * 256 + 4 * lane);
  for (int t = gw; t < ntok; t += nw) {
    const float4 a = *(const float4*)(og + (size_t)t * 256 + 4 * lane), bq = *(const float4*)(og + ((size_t)TT + t) * 256 + 4 * lane);
    const float o0 = a.x + bq.x, o1 = a.y + bq.y, o2 = a.z + bq.z, o3 = a.w + bq.w;
    float ss = o0 * o0 + o1 * o1 + o2 * o2 + o3 * o3;
    ss += __shfl_xor(ss, 1); ss += __shfl_xor(ss, 2); ss += __shfl_xor(ss, 4); ss += __shfl_xor(ss, 8);
    const float rstd = rsqrtf(ss * (1.f / 64.f) + 1e-6f);
    const u32x2 rv = *(const u32x2*)(PN + (size_t)t * PN_LD + C_GR + 4 * lane);
    const float r0 = bflo(rv.x), r1 = bfhi(rv.x), r2 = bflo(rv.y), r3 = bfhi(rv.y);
    const float y0 = o0 * rstd * gg.x * (r0 / (1.f + __expf(-r0)));
    const float y1 = o1 * rstd * gg.y * (r1 / (1.f + __expf(-r1)));
    const float y2 = o2 * rstd * gg.z * (r2 / (1.f + __expf(-r2)));
    const float y3 = o3 * rstd * gg.w * (r3 / (1.f + __expf(-r3)));
    u32x2 ov = {pk2(y0, y1), pk2(y2, y3)};
    *(u32x2*)(Y + (size_t)t * 1024 + 4 * lane) = ov;
  }
}

struct PairTab { int a[52], b[52]; };
constexpr PairTab make_pairs() {
  PairTab t{};
  int n = 0;
  for (int a = 0; a < 16; ++a)
    for (int b = 0; b < 16; ++b)
      if ((a + 1) * (b + 1) <= 16) { t.a[n] = a; t.b[n] = b; ++n; }
  for (; n < 52; ++n) { t.a[n] = -1; t.b[n] = -1; }
  return t;
}

DI void topk_half(const bf16_t* skh  , const bf16_t* qrow  , int lr, int g, float (&list)[16]) {
  bf16x8 qf[2];
  qf[0] = *(const bf16x8*)(qrow); qf[1] = *(const bf16x8*)(qrow + 32);
  float s[32];
#pragma unroll
  for (int nt = 0; nt < 8; ++nt) {
    f32x4 acc = {0.f, 0.f, 0.f, 0.f};
#pragma unroll
    for (int ks = 0; ks < 2; ++ks) {
      const bf16x8 af = *(const bf16x8*)(skh + (size_t)(nt * 16 + lr) * 64 + ks * 32 + 8 * g);
      acc = mfma16(af, qf[ks], acc);
    }
#pragma unroll
    for (int r = 0; r < 4; ++r) {
      const unsigned n = nt * 16 + 4 * g + r;
      s[nt * 4 + r] = __uint_as_float((__float_as_uint(acc[r]) & ~127u) | n);
    }
  }
#pragma unroll
  for (int k = 0; k < 16; ++k) {
    float m = s[0];
#pragma unroll
    for (int i = 1; i < 32; ++i) m = fmaxf(m, s[i]);
    m = fmaxf(m, __shfl_xor(m, 16));
    m = fmaxf(m, __shfl_xor(m, 32));
    list[k] = m;
#pragma unroll
    for (int i = 0; i < 32; ++i) s[i] = (s[i] == m) ? -3.0e38f : s[i];
  }
}

DI void phase_topk(const Params& p, int l, int ntok) {
  constexpr PairTab PT = make_pairs();
  const int lane = ltid() & 63, lr = lane & 15, g = lane >> 4;
  const int gw = lbid() * 4 + (ltid() >> 6), nw = lgdim() * 4;
  const bf16_t* QP = (const bf16_t*)(p.ws + OFF_QP);
  const bf16_t* sk = (const bf16_t*)(p.ws + OFF_SK) + (size_t)l * 2 * 128 * 64;
  int* eid = (int*)(p.ws + OFF_EID);
  float* gate = (float*)(p.ws + OFF_GATE);
  const int ntask = (ntok / 16) * 8;
  for (int task = gw; task < ntask; task += nw) {
    const int tt = task >> 3, hd = task & 7;
    const int tok = tt * 16 + lr;
    float v1[16], v2[16];
    topk_half(sk, QP + (size_t)tok * 1024 + hd * 128 + 8 * g, lr, g, v1);
    topk_half(sk + 128 * 64, QP + (size_t)tok * 1024 + hd * 128 + 64 + 8 * g, lr, g, v2);
    float cand[13];
    int ceid[13];
#pragma unroll
    for (int c = 0; c < 13; ++c) {
      float sv[4];
      int ev[4];
#pragma unroll
      for (int gi = 0; gi < 4; ++gi) {
        const int pi = 4 * c + gi;
        if (PT.a[pi] >= 0) {
          const float a = v1[PT.a[pi] < 0 ? 0 : PT.a[pi]], bq = v2[PT.b[pi] < 0 ? 0 : PT.b[pi]];
          sv[gi] = __uint_as_float((__float_as_uint(a + bq) & ~63u) | (unsigned)pi);
          ev[gi] = (int)((__float_as_uint(a) & 127u) * 128u + (__float_as_uint(bq) & 127u));
        } else { sv[gi] = -3.0e38f; ev[gi] = 0; }
      }
      cand[c] = g == 0 ? sv[0] : (g == 1 ? sv[1] : (g == 2 ? sv[2] : sv[3]));
      ceid[c] = g == 0 ? ev[0] : (g == 1 ? ev[1] : (g == 2 ? ev[2] : ev[3]));
    }
    float topv[16];
#pragma unroll
    for (int k = 0; k < 16; ++k) {
      float m = cand[0];
#pragma unroll
      for (int c = 1; c < 13; ++c) m = fmaxf(m, cand[c]);
      m = fmaxf(m, __shfl_xor(m, 16));
      m = fmaxf(m, __shfl_xor(m, 32));
      topv[k] = m;
      int my = -1;
#pragma unroll
      for (int c = 0; c < 13; ++c) { if (cand[c] == m) { my = ceid[c]; cand[c] = -3.0e38f; } }
      if (my >= 0) eid[(size_t)tok * 128 + hd * 16 + k] = my;
    }
    if (g == 0) {
      float ex[16], sum = 0.f;
#pragma unroll
      for (int k = 0; k < 16; ++k) { ex[k] = __expf(topv[k] - topv[0]); sum += ex[k]; }
      const float inv = 1.f / sum;
#pragma unroll
      for (int q = 0; q < 4; ++q) {
        float4 o = {ex[4 * q] * inv, ex[4 * q + 1] * inv, ex[4 * q + 2] * inv, ex[4 * q + 3] * inv};
        *(float4*)(gate + (size_t)tok * 128 + hd * 16 + 4 * q) = o;
      }
    }
  }
}

DI float gelu_tanh(float x) {
  const float z = 0.7978845608028654f * (x + 0.044715f * x * x * x);
  const float e = __expf(2.f * z);
  const float th = 1.f - 2.f / (e + 1.f);
  return 0.5f * x * (1.f + th);
}
DI void phase_gather(const Params& p, int l, int ntok) {
  const int lane = ltid() & 63, gw = lbid() * 4 + (ltid() >> 6), nw = lgdim() * 4;
  const bf16_t* H = (const bf16_t*)(p.ws + OFF_H);
  const bf16_t* U = (const bf16_t*)(p.ws + OFF_U) + (size_t)l * 16384 * 1024;
  const bf16_t* V = (const bf16_t*)(p.ws + OFF_V) + (size_t)l * 16384 * 1024;
  const int* eid = (const int*)(p.ws + OFF_EID);
  const float* gate = (const float*)(p.ws + OFF_GATE);
  float* xres = (float*)(p.ws + OFF_XRES);
  const float* modbuf = (const float*)(p.ws + OFF_MOD);
  for (int t = gw; t < ntok; t += nw) {
    float hx[16];
    {
      const u32x4 ha = *(const u32x4*)(H + (size_t)t * 1024 + 8 * lane), hb = *(const u32x4*)(H + (size_t)t * 1024 + 512 + 8 * lane);
      unpack8(ha, hx); unpack8(hb, hx + 8);
    }
    const int e0 = eid[(size_t)t * 128 + lane], e1 = eid[(size_t)t * 128 + 64 + lane];
    const float g0 = gate[(size_t)t * 128 + lane], g1 = gate[(size_t)t * 128 + 64 + lane];
    float out[16];
#pragma unroll
    for (int i = 0; i < 16; ++i) out[i] = 0.f;
    for (int half = 0; half < 2; ++half) {
      const int ev = half ? e1 : e0;
      const float gv = half ? g1 : g0;
      for (int j = 0; j < 64; j += 4) {
        u32x4 ua[4], ub[4], va[4], vb[4];
        float gt[4];
#pragma unroll
        for (int q = 0; q < 4; ++q) {
          const int e = __builtin_amdgcn_readlane(ev, j + q);
          gt[q] = __int_as_float(__builtin_amdgcn_readlane(__float_as_int(gv), j + q));
          const bf16_t* ur = U + (size_t)e * 1024 + 8 * lane;
          const bf16_t* vr = V + (size_t)e * 1024 + 8 * lane;
          ua[q] = *(const u32x4*)ur; ub[q] = *(const u32x4*)(ur + 512);
          va[q] = *(const u32x4*)vr; vb[q] = *(const u32x4*)(vr + 512);
        }
#pragma unroll
        for (int q = 0; q < 4; ++q) {
          float uf[16];
          unpack8(ua[q], uf); unpack8(ub[q], uf + 8);
          float d = 0.f;
#pragma unroll
          for (int i = 0; i < 16; ++i) d += hx[i] * uf[i];
          d = wave_sum(d);
          const float wgt = gt[q] * gelu_tanh(d);
          float vf[16];
          unpack8(va[q], vf); unpack8(vb[q], vf + 8);
#pragma unroll
          for (int i = 0; i < 16; ++i) out[i] += wgt * vf[i];
        }
      }
    }
    const int b = t < TL ? (t >> 11) : 16;
    const float* md = modbuf + ((size_t)l * 17 + b) * 6144 + 5 * 1024;
    float* xr = xres + (size_t)t * 1024;
#pragma unroll
    for (int hq = 0; hq < 2; ++hq)
#pragma unroll
      for (int q = 0; q < 2; ++q) {
        const int col = hq * 512 + 8 * lane + 4 * q;
        const float4 m4 = *(const float4*)(md + col);
        float4 xv = *(const float4*)(xr + col);
        xv.x += m4.x * out[hq * 8 + q * 4 + 0]; xv.y += m4.y * out[hq * 8 + q * 4 + 1];
        xv.z += m4.z * out[hq * 8 + q * 4 + 2]; xv.w += m4.w * out[hq * 8 + q * 4 + 3];
        *(float4*)(xr + col) = xv;
      }
  }
}

DI void phase_final(const Params& p) {
  const int lane = ltid() & 63, gw = lbid() * 4 + (ltid() >> 6), nw = lgdim() * 4;
  const float* xres = (const float*)(p.ws + OFF_XRES);
  for (int t = gw; t < TL; t += nw) {
    const float* src = xres + (size_t)t * 1024;
    float4 v[4];
    float ss = 0.f;
#pragma unroll
    for (int i = 0; i < 4; ++i) {
      v[i] = *(const float4*)(src + 4 * lane + 256 * i);
      ss += v[i].x * v[i].x + v[i].y * v[i].y + v[i].z * v[i].z + v[i].w * v[i].w;
    }
    ss = wave_sum(ss);
    const float rstd = rsqrtf(ss * (1.f / 1024.f) + 1e-6f);
#pragma unroll
    for (int i = 0; i < 4; ++i) {
      const int col = 4 * lane + 256 * i;
      const float4 g4 = *(const float4*)(p.final_g + col);
      float4 o = {v[i].x * rstd * g4.x, v[i].y * rstd * g4.y, v[i].z * rstd * g4.z, v[i].w * rstd * g4.w};
      *(float4*)(p.out + (size_t)t * 1024 + col) = o;
    }
  }
}

constexpr int PH_PER_LAYER = 10;
constexpr int N_PHASES = 1 + NL * PH_PER_LAYER + 1;

template <int KIND>
DI void run_phase(const Params& p, int ph, unsigned char* lds) {
  unsigned* ctl = (unsigned*)(p.ws + OFF_CTL);
  if (ph == 0) { if (KIND < 0 || KIND == 0) phase_prologue(p, lds); }
  else if (ph == N_PHASES - 1) { if (KIND < 0 || KIND == 11) phase_final(p); }
  else {
    const int l = (ph - 1) / PH_PER_LAYER, s = (ph - 1) % PH_PER_LAYER;
    const bool last = (l == NL - 1);
    const int ntok = last ? TL : TT;
    if (s == 0) { if (KIND < 0 || KIND == 1) phase_norm(p, l, 0, TT); }
    else if (s == 1) { if (KIND < 0 || KIND == 2) phase_gemm_in(p, l, lds); }
    else if (s == 2) { if (KIND < 0 || KIND == 3) phase_rope(p, lds); }
    else if (s == 3) { if (KIND < 0 || KIND == 4) phase_mixers(p, l, last, ctl + 64 * (1 + l), lds); }
    else if (s == 4) { if (KIND < 0 || KIND == 5) phase_gla_fin(p, l, ntok); }
    else if (s == 5) { if (KIND < 0 || KIND == 6) phase_gemm_out(p, l, ntok, lds); }
    else if (s == 6) { if (KIND < 0 || KIND == 7) phase_norm(p, l, 1, ntok); }
    else if (s == 7) { if (KIND < 0 || KIND == 8) phase_gemm_q(p, l, ntok, lds); }
    else if (s == 8) { if (KIND < 0 || KIND == 9) phase_topk(p, l, ntok); }
    else { if (KIND < 0 || KIND == 10) phase_gather(p, l, ntok); }
  }
}

#if N_LAUNCH_MODE == 1
__global__ void __launch_bounds__(256, 2) mk_fwd(Params p) {
  __shared__ __attribute__((aligned(16))) unsigned char lds[LDS_BYTES];
  unsigned* ctl = (unsigned*)(p.ws + OFF_CTL);
  cg::grid_group grid = cg::this_grid();
  phase_prologue(p, lds); grid.sync();
  for (int l = 0; l < NL; ++l) {
    const bool last = (l == NL - 1);
    const int ntok = last ? TL : TT;
    phase_norm(p, l, 0, TT); grid.sync();
    phase_gemm_in(p, l, lds); grid.sync();
    phase_rope(p, lds); grid.sync();
    phase_mixers(p, l, last, ctl + 64 * (1 + l), lds); grid.sync();
    phase_gla_fin(p, l, ntok); grid.sync();
    phase_gemm_out(p, l, ntok, lds); grid.sync();
    phase_norm(p, l, 1, ntok); grid.sync();
    phase_gemm_q(p, l, ntok, lds); grid.sync();
    phase_topk(p, l, ntok); grid.sync();
    phase_gather(p, l, ntok); grid.sync();
  }
  phase_final(p);
}
#else
template <int KIND>
__global__ void __launch_bounds__(256, 2) mk_phase(Params p) {
  __shared__ __attribute__((aligned(16))) unsigned char lds[LDS_BYTES];
  run_phase<KIND>(p, p.ph_lo, lds);
}
#endif

extern "C" void kernel_launch(void* const* d_in, const int* in_sizes, int n_in, void* d_out, int out_size, void* d_ws,
                              size_t ws_size, hipStream_t stream) {
  static int grid = 0;
  if (grid == 0) {
    if (n_in != 21 || ws_size < WS_END || out_size != TL * DM) { fprintf(stderr, "kernel_launch: unexpected shapes (n_in %d ws %zu out %d)\n", n_in, ws_size, out_size); grid = -1; return; }
    int dev = 0, cus = 0, per_cu = 2;
    (void)hipGetDevice(&dev);
    (void)hipDeviceGetAttribute(&cus, hipDeviceAttributeMultiprocessorCount, dev);
#if N_LAUNCH_MODE == 1
    (void)hipOccupancyMaxActiveBlocksPerMultiprocessor(&per_cu, (const void*)mk_fwd, 256, 0);
    if (per_cu < 1) per_cu = 1;
    if (per_cu > 2) per_cu = 2;
#endif
    grid = cus * per_cu;
  }
  if (grid < 0) return;
  (void)hipMemsetAsync((char*)d_ws + OFF_CTL, 0, 65536, stream);
  Params p{};
  const float** pp = (const float**)&p;
  for (int i = 0; i < 21; ++i) pp[i] = (const float*)d_in[i];
  p.out = (float*)d_out;
  p.ws = (unsigned char*)d_ws;
#if N_LAUNCH_MODE == 1
  p.ph_lo = 0; p.ph_hi = N_PHASES;
  void* args[] = {&p};
  hipError_t e = hipLaunchCooperativeKernel((const void*)mk_fwd, dim3(grid), dim3(256), args, 0, stream);
  if (e != hipSuccess) fprintf(stderr, "cooperative launch failed: %s (grid %d)\n", hipGetErrorString(e), grid);
#else
  for (int ph = 0; ph < N_PHASES; ++ph) {
    p.ph_lo = ph; p.ph_hi = ph + 1;
    const int kind = ph == 0 ? 0 : (ph == N_PHASES - 1 ? 11 : 1 + (ph - 1) % PH_PER_LAYER);
    switch (kind) {
      case 0: hipLaunchKernelGGL(mk_phase<0>, dim3(grid), dim3(256), 0, stream, p); break;
      case 1: hipLaunchKernelGGL(mk_phase<1>, dim3(grid), dim3(256), 0, stream, p); break;
      case 2: hipLaunchKernelGGL(mk_phase<2>, dim3(grid), dim3(256), 0, stream, p); break;
      case 3: hipLaunchKernelGGL(mk_phase<3>, dim3(grid), dim3(256), 0, stream, p); break;
      case 4: hipLaunchKernelGGL(mk_phase<4>, dim3(grid), dim3(256), 0, stream, p); break;
      case 5: hipLaunchKernelGGL(mk_phase<5>, dim3(grid), dim3(256), 0, stream, p); break;
      case 6: hipLaunchKernelGGL(mk_phase<6>, dim3(grid), dim3(256), 0, stream, p); break;
      case 7: hipLaunchKernelGGL(mk_phase<7>, dim3(grid), dim3(256), 0, stream, p); break;
      case 8: hipLaunchKernelGGL(mk_phase<8>, dim3(grid), dim3(256), 0, stream, p); break;
      case 9: hipLaunchKernelGGL(mk_phase<9>, dim3(grid), dim3(256), 0, stream, p); break;
      case 10: hipLaunchKernelGGL(mk_phase<10>, dim3(grid), dim3(256), 0, stream, p); break;
      default: hipLaunchKernelGGL(mk_phase<11>, dim3(grid), dim3(256), 0, stream, p); break;
    }
  }
#endif
}
```

```cpp
#include <hip/hip_runtime.h>
#include <hip/hip_cooperative_groups.h>
#include <stdint.h>
#include <stdio.h>
namespace cg = cooperative_groups;

#ifndef N_LAUNCH_MODE
#define N_LAUNCH_MODE 1
#endif

#define DI __device__ __forceinline__
typedef unsigned short bf16_t;
typedef short bf16x8 __attribute__((ext_vector_type(8)));
typedef float f32x4 __attribute__((ext_vector_type(4)));
typedef unsigned u32x4 __attribute__((ext_vector_type(4)));
typedef unsigned u32x2 __attribute__((ext_vector_type(2)));
typedef float f32x2 __attribute__((ext_vector_type(2)));

constexpr int NB = 16, SEQ = 2048, DM = 1024, NL = 4, CTXL = 256;
constexpr int TL = NB * SEQ;
constexpr int TC = NB * CTXL;
constexpr int TT = TL + TC;
constexpr int PN_LD = 2176;
constexpr int C_GQ = 0, C_GK = 128, C_GR = 256, C_NQ = 512, C_NK = 768, C_DQ = 1024, C_DK = 1536, C_GATE = 2048;
constexpr int R_GV = 0, R_NV = 256, R_DV = 512;
constexpr float LOG2E = 1.4426950408889634f;
constexpr float SC_LOG2 = 0.125f * LOG2E;
constexpr float NEG_BIG = -1e30f;

constexpr size_t MiB = 1u << 20;
constexpr size_t OFF_CTL = 0;
constexpr size_t OFF_MOD = 1 * MiB;
constexpr size_t OFF_WIN = 3 * MiB;
constexpr size_t OFF_WOUT = 28 * MiB;
constexpr size_t OFF_WQ = 36 * MiB;
constexpr size_t OFF_SK = 44 * MiB;
constexpr size_t OFF_USCL = 44 * MiB + 256 * 1024;
constexpr size_t OFF_VSCL = 44 * MiB + 512 * 1024;
constexpr size_t OFF_U = 45 * MiB;
constexpr size_t OFF_V = 109 * MiB;
constexpr size_t OFF_XRES = 301 * MiB;
constexpr size_t OFF_H = 445 * MiB;
constexpr size_t OFF_P = 517 * MiB;
constexpr size_t OFF_VT = OFF_P + 153 * MiB;
constexpr size_t OFF_QP = OFF_P;
constexpr size_t OFF_EID = OFF_P + 72 * MiB;
constexpr size_t OFF_GATE = OFF_P + 90 * MiB;
constexpr size_t OFF_H8 = OFF_P + 126 * MiB;
constexpr size_t OFF_HINV = OFF_P + 162 * MiB;
constexpr size_t OFF_Y = 742 * MiB;
constexpr size_t WS_END = 814 * MiB;

constexpr int LDS_BYTES = 65536;

struct Params {
  const float *x, *c, *ctx, *c_ctx, *ada_w, *ada_b, *norm1_g, *norm2_g, *w_in, *gate_up, *gate_b, *gla_norm_g,
      *rpb, *dlam, *diff_g, *w_out, *wq, *subkeys, *pu, *pv, *final_g;
  float* out;
  unsigned char* ws;
  int ph_lo, ph_hi;
};

DI int ltid() { int t = threadIdx.x; asm volatile("" : "+v"(t)); return t; }
DI int lbid() { int t = blockIdx.x; asm volatile("" : "+s"(t)); return t; }
DI int lgdim() { int t = gridDim.x; asm volatile("" : "+s"(t)); return t; }

DI unsigned f2bf(float f) { unsigned u = __float_as_uint(f); return (u + 0x7fffu + ((u >> 16) & 1u)) >> 16; }
DI unsigned pk2(float lo, float hi) { return f2bf(lo) | (f2bf(hi) << 16); }
DI float bflo(unsigned u) { return __uint_as_float(u << 16); }
DI float bfhi(unsigned u) { return __uint_as_float(u & 0xffff0000u); }
DI void unpack8(const u32x4 v, float* f) {
  f[0] = bflo(v.x); f[1] = bfhi(v.x); f[2] = bflo(v.y); f[3] = bfhi(v.y);
  f[4] = bflo(v.z); f[5] = bfhi(v.z); f[6] = bflo(v.w); f[7] = bfhi(v.w);
}
DI float wave_sum(float v) {
#pragma unroll
  for (int o = 32; o >= 1; o >>= 1) v += __shfl_xor(v, o);
  return v;
}
DI f32x4 mfma16(bf16x8 a, bf16x8 b, f32x4 c) { return __builtin_amdgcn_mfma_f32_16x16x32_bf16(a, b, c, 0, 0, 0); }

DI int win_src_col(int r) {
  if (r < 256) return r;
  if (r < 512) return r - 256 + 512;
  if (r < 768) return r - 512 + 800;
  if (r < 1024) return r - 768 + 1056;
  if (r < 1536) return r - 1024 + 1568;
  if (r < 2048) return r - 1536 + 2080;
  if (r < 2080) return r - 2048 + 768;
  if (r < 2176) return -1;
  if (r < 2432) return r - 2176 + 256;
  if (r < 2688) return r - 2432 + 1312;
  return r - 2688 + 2592;
}

DI void transpose_item(const float* __restrict__ W, int N, int src, bf16_t* __restrict__ dst, float* lds) {
  const int tid = ltid();
  for (int kc = 0; kc < 8; ++kc) {
    __syncthreads();
#pragma unroll
    for (int i = 0; i < 16; ++i) {
      int k = i * 8 + (tid >> 5), n = tid & 31;
      lds[k * 33 + n] = (src < 0) ? 0.f : W[(size_t)(kc * 128 + k) * N + src + n];
    }
    __syncthreads();
    int row = tid >> 3, k0 = (tid & 7) * 16;
    unsigned o[8];
#pragma unroll
    for (int e = 0; e < 8; ++e) o[e] = pk2(lds[(k0 + 2 * e) * 33 + row], lds[(k0 + 2 * e + 1) * 33 + row]);
    u32x4 a = {o[0], o[1], o[2], o[3]}, b = {o[4], o[5], o[6], o[7]};
    bf16_t* d = dst + (size_t)row * 1024 + kc * 128 + k0;
    *(u32x4*)d = a; *(u32x4*)(d + 8) = b;
  }
}

DI void phase_prologue(const Params& p, unsigned char* lds) {
  const int tid = ltid(), nb = lgdim(), bid = lbid();
  bf16_t* winT = (bf16_t*)(p.ws + OFF_WIN);
  bf16_t* woutT = (bf16_t*)(p.ws + OFF_WOUT);
  bf16_t* wqT = (bf16_t*)(p.ws + OFF_WQ);
  constexpr int PER_LAYER = 100 + 32 + 32;
  for (int item = bid; item < NL * PER_LAYER; item += nb) {
    int l = item / PER_LAYER, r = item % PER_LAYER;
    if (r < 100) {
      int row = r * 32;
      transpose_item(p.w_in + (size_t)l * 1024 * 3104, 3104, win_src_col(row), winT + ((size_t)l * 3200 + row) * 1024, (float*)lds);
    } else if (r < 132) {
      int row = (r - 100) * 32;
      transpose_item(p.w_out + (size_t)l * 1024 * 1024, 1024, row, woutT + ((size_t)l * 1024 + row) * 1024, (float*)lds);
    } else {
      int row = (r - 132) * 32;
      transpose_item(p.wq + (size_t)l * 1024 * 1024, 1024, row, wqT + ((size_t)l * 1024 + row) * 1024, (float*)lds);
    }
  }
  {
    const int lane = tid & 63, gw = bid * 4 + (tid >> 6), nw = nb * 4;
    unsigned char* u8 = p.ws + OFF_U;
    unsigned char* v8 = p.ws + OFF_V;
    float* uscl = (float*)(p.ws + OFF_USCL);
    float* vscl = (float*)(p.ws + OFF_VSCL);
    for (int row = gw; row < 2 * NL * 16384; row += nw) {
      const int tab = row >= NL * 16384, r = tab ? row - NL * 16384 : row;
      const float* src = (tab ? p.pv : p.pu) + (size_t)r * 1024 + 16 * lane;
      float4 f[4];
      float am = 0.f;
#pragma unroll
      for (int i = 0; i < 4; ++i) {
        f[i] = *(const float4*)(src + 4 * i);
        am = fmaxf(am, fmaxf(fmaxf(fabsf(f[i].x), fabsf(f[i].y)), fmaxf(fabsf(f[i].z), fabsf(f[i].w))));
      }
#pragma unroll
      for (int o = 32; o >= 1; o >>= 1) am = fmaxf(am, __shfl_xor(am, o));
      const float sc = am > 0.f ? 448.f / am : 0.f;
      u32x4 q;
#pragma unroll
      for (int i = 0; i < 4; ++i) {
        int pk = 0;
        pk = __builtin_amdgcn_cvt_pk_fp8_f32(f[i].x * sc, f[i].y * sc, pk, false);
        pk = __builtin_amdgcn_cvt_pk_fp8_f32(f[i].z * sc, f[i].w * sc, pk, true);
        q[i] = (unsigned)pk;
      }
      *(u32x4*)((tab ? v8 : u8) + (size_t)r * 1024 + 16 * lane) = q;
      if (lane == 0) (tab ? vscl : uscl)[r] = am * (1.f / 448.f);
    }
  }
  {
    bf16_t* sk = (bf16_t*)(p.ws + OFF_SK);
    for (int i = bid * 256 + tid; i < NL * 2 * 128 * 64; i += nb * 256) sk[i] = (bf16_t)f2bf(p.subkeys[i]);
  }
  {
    float* modbuf = (float*)(p.ws + OFF_MOD);
    float* sc = (float*)lds;
    float* red = (float*)(lds + 17 * 512 * 4);
    for (int item = bid; item < NL * 96; item += nb) {
      const int l = item / 96, cb = item % 96, col = cb * 64 + (tid & 63), kq = tid >> 6;
      float acc[17];
#pragma unroll
      for (int r = 0; r < 17; ++r) acc[r] = 0.f;
      for (int half = 0; half < 2; ++half) {
        __syncthreads();
        for (int e = tid; e < 17 * 512; e += 256) {
          int r = e >> 9, k = e & 511;
          float cv = (r < 16) ? p.c[r * 1024 + half * 512 + k] : p.c_ctx[half * 512 + k];
          sc[e] = cv / (1.f + __expf(-cv));
        }
        __syncthreads();
        const float* wp = p.ada_w + ((size_t)l * 1024 + half * 512 + kq * 128) * 6144 + col;
        for (int kk = 0; kk < 128; ++kk) {
          const float w = wp[(size_t)kk * 6144];
#pragma unroll
          for (int r = 0; r < 17; ++r) acc[r] += sc[r * 512 + kq * 128 + kk] * w;
        }
      }
#pragma unroll
      for (int r = 0; r < 17; ++r) red[(kq * 17 + r) * 64 + (tid & 63)] = acc[r];
      __syncthreads();
      for (int e = tid; e < 17 * 64; e += 256) {
        int r = e >> 6, cc = e & 63;
        float s = red[(0 * 17 + r) * 64 + cc] + red[(1 * 17 + r) * 64 + cc] + red[(2 * 17 + r) * 64 + cc] + red[(3 * 17 + r) * 64 + cc];
        int colg = cb * 64 + cc;
        modbuf[((size_t)l * 17 + r) * 6144 + colg] = s + p.ada_b[l * 6144 + colg];
      }
      __syncthreads();
    }
  }
}

DI void phase_norm(const Params& p, int l, int which, int ntok) {
  const int lane = ltid() & 63, gw = lbid() * 4 + (ltid() >> 6), nw = lgdim() * 4;
  const float* gvec = (which == 0 ? p.norm1_g : p.norm2_g) + l * 1024;
  const int ish = which == 0 ? 0 : 3, isc = which == 0 ? 1 : 4;
  const float* xres = (const float*)(p.ws + OFF_XRES);
  const float* modbuf = (const float*)(p.ws + OFF_MOD);
  bf16_t* hbuf = (bf16_t*)(p.ws + OFF_H);
  for (int t = gw; t < ntok; t += nw) {
    const float* src = (which == 0 && l == 0) ? (t < TL ? p.x + (size_t)t * 1024 : p.ctx + (size_t)(t - TL) * 1024) : xres + (size_t)t * 1024;
    const int b = t < TL ? (t >> 11) : 16;
    const float* md = modbuf + ((size_t)l * 17 + b) * 6144;
    float4 v[4];
    float ss = 0.f;
#pragma unroll
    for (int i = 0; i < 4; ++i) {
      v[i] = *(const float4*)(src + 4 * lane + 256 * i);
      ss += v[i].x * v[i].x + v[i].y * v[i].y + v[i].z * v[i].z + v[i].w * v[i].w;
    }
    ss = wave_sum(ss);
    const float rstd = rsqrtf(ss * (1.f / 1024.f) + 1e-6f);
    float am = 0.f;
#pragma unroll
    for (int i = 0; i < 4; ++i) {
      const int col = 4 * lane + 256 * i;
      const float4 g4 = *(const float4*)(gvec + col), sh = *(const float4*)(md + ish * 1024 + col), sc = *(const float4*)(md + isc * 1024 + col);
      float o0 = v[i].x * rstd * g4.x * (1.f + sc.x) + sh.x;
      float o1 = v[i].y * rstd * g4.y * (1.f + sc.y) + sh.y;
      float o2 = v[i].z * rstd * g4.z * (1.f + sc.z) + sh.z;
      float o3 = v[i].w * rstd * g4.w * (1.f + sc.w) + sh.w;
      u32x2 o = {pk2(o0, o1), pk2(o2, o3)};
      *(u32x2*)(hbuf + (size_t)t * 1024 + col) = o;
      v[i].x = o0; v[i].y = o1; v[i].z = o2; v[i].w = o3;
      am = fmaxf(am, fmaxf(fmaxf(fabsf(o0), fabsf(o1)), fmaxf(fabsf(o2), fabsf(o3))));
    }
    if (which == 1) {
#pragma unroll
      for (int o = 32; o >= 1; o >>= 1) am = fmaxf(am, __shfl_xor(am, o));
      const float qs = am > 0.f ? 448.f / am : 0.f;
      unsigned char* h8 = p.ws + OFF_H8 + (size_t)t * 1024;
#pragma unroll
      for (int i = 0; i < 4; ++i) {
        int pk = 0;
        pk = __builtin_amdgcn_cvt_pk_fp8_f32(v[i].x * qs, v[i].y * qs, pk, false);
        pk = __builtin_amdgcn_cvt_pk_fp8_f32(v[i].z * qs, v[i].w * qs, pk, true);
        *(int*)(h8 + 4 * lane + 256 * i) = pk;
      }
      if (lane == 0) ((float*)(p.ws + OFF_HINV))[t] = am * (1.f / 448.f);
    }
  }
}

template <int EPI>
DI void gemm_tile(const bf16_t* __restrict__ P, const bf16_t* __restrict__ Q, int it, int jt, void* outp, int ld,
                  const float* xin_lat, const float* xin_ctx, const float* modl, unsigned char* lds) {
  const int tid = ltid(), lane = tid & 63, w = tid >> 6, wi = w >> 1, wj = w & 1, lr = lane & 15, g = lane >> 4;
  unsigned char* Ps = lds;
  unsigned char* Qs = lds + 16384;
  f32x4 acc[4][4];
#pragma unroll
  for (int a = 0; a < 4; ++a)
#pragma unroll
    for (int b = 0; b < 4; ++b) acc[a][b] = (f32x4){0.f, 0.f, 0.f, 0.f};
  const int c = tid & 7, r0 = tid >> 3;
  const bf16_t* pg = P + (size_t)(it * 128 + r0) * 1024 + c * 8;
  const bf16_t* qg = Q + (size_t)(jt * 128 + r0) * 1024 + c * 8;
  u32x4 pr[4], qr[4];
#pragma unroll
  for (int ii = 0; ii < 4; ++ii) { pr[ii] = *(const u32x4*)(pg + (size_t)ii * 32 * 1024); qr[ii] = *(const u32x4*)(qg + (size_t)ii * 32 * 1024); }
  for (int kb = 0; kb < 16; ++kb) {
#pragma unroll
    for (int ii = 0; ii < 4; ++ii) {
      const int row = r0 + 32 * ii;
      const unsigned off = row * 128 + ((c ^ (row & 7)) << 4);
      *(u32x4*)(Ps + off) = pr[ii];
      *(u32x4*)(Qs + off) = qr[ii];
    }
    __syncthreads();
    if (kb < 15) {
#pragma unroll
      for (int ii = 0; ii < 4; ++ii) {
        pr[ii] = *(const u32x4*)(pg + (size_t)ii * 32 * 1024 + (kb + 1) * 64);
        qr[ii] = *(const u32x4*)(qg + (size_t)ii * 32 * 1024 + (kb + 1) * 64);
      }
    }
#pragma unroll
    for (int ks = 0; ks < 2; ++ks) {
      bf16x8 pf[4], qf[4];
      const int ch = ks * 4 + g;
#pragma unroll
      for (int mi = 0; mi < 4; ++mi) { const int row = wi * 64 + mi * 16 + lr; pf[mi] = *(const bf16x8*)(Ps + row * 128 + ((ch ^ (row & 7)) << 4)); }
#pragma unroll
      for (int nj = 0; nj < 4; ++nj) { const int row = wj * 64 + nj * 16 + lr; qf[nj] = *(const bf16x8*)(Qs + row * 128 + ((ch ^ (row & 7)) << 4)); }
#pragma unroll
      for (int mi = 0; mi < 4; ++mi)
#pragma unroll
        for (int nj = 0; nj < 4; ++nj) acc[mi][nj] = mfma16(pf[mi], qf[nj], acc[mi][nj]);
    }
    __syncthreads();
  }
#pragma unroll
  for (int mi = 0; mi < 4; ++mi)
#pragma unroll
    for (int nj = 0; nj < 4; ++nj) {
      const int j = jt * 128 + wj * 64 + nj * 16 + lr;
      const int i = it * 128 + wi * 64 + mi * 16 + 4 * g;
      const f32x4 a = acc[mi][nj];
      if (EPI == 0) {
        u32x2 o = {pk2(a[0], a[1]), pk2(a[2], a[3])};
        *(u32x2*)((bf16_t*)outp + (size_t)j * ld + i) = o;
      } else {
        const int b = j < TL ? (j >> 11) : 16;
        const float4 gt = *(const float4*)(modl + (size_t)b * 6144 + 2 * 1024 + i);
        const float* xs = (j < TL) ? xin_lat + (size_t)j * 1024 + i : xin_ctx + (size_t)(j - TL) * 1024 + i;
        const float4 xv = *(const float4*)xs;
        float4 o = {xv.x + gt.x * a[0], xv.y + gt.y * a[1], xv.z + gt.z * a[2], xv.w + gt.w * a[3]};
        *(float4*)((float*)outp + (size_t)j * 1024 + i) = o;
      }
    }
}

DI void phase_gemm_in(const Params& p, int l, unsigned char* lds) {
  const bf16_t* W = (const bf16_t*)(p.ws + OFF_WIN) + (size_t)l * 3200 * 1024;
  const bf16_t* H = (const bf16_t*)(p.ws + OFF_H);
  bf16_t* PN = (bf16_t*)(p.ws + OFF_P);
  bf16_t* VT = (bf16_t*)(p.ws + OFF_VT);
  constexpr int NJT = TT / 128;
  constexpr int T1 = NJT * 17, T2 = NJT * 8;
  for (int t = lbid(); t < T1 + T2; t += lgdim()) {
    if (t < T1) { const int jt = t / 17, it = t % 17; gemm_tile<0>(W, H, it, jt, PN, PN_LD, nullptr, nullptr, nullptr, lds); }
    else { const int u = t - T1; const int it = u >> 3, jt = u & 7; gemm_tile<0>(H, W + (size_t)2176 * 1024, it, jt, VT, TT, nullptr, nullptr, nullptr, lds); }
  }
}
DI void phase_gemm_out(const Params& p, int l, int ntok, unsigned char* lds) {
  const bf16_t* W = (const bf16_t*)(p.ws + OFF_WOUT) + (size_t)l * 1024 * 1024;
  const bf16_t* Y = (const bf16_t*)(p.ws + OFF_Y);
  float* xres = (float*)(p.ws + OFF_XRES);
  const float* modl = (const float*)(p.ws + OFF_MOD) + (size_t)l * 17 * 6144;
  const float* xl = (l == 0) ? p.x : xres;
  const float* xc = (l == 0) ? p.ctx : xres + (size_t)TL * 1024;
  const int ntile = (ntok / 128) * 8;
  for (int t = lbid(); t < ntile; t += lgdim()) {
    const int jt = t >> 3, it = t & 7;
    gemm_tile<1>(W, Y, it, jt, xres, 1024, xl, xc, modl, lds);
  }
}
DI void phase_gemm_q(const Params& p, int l, int ntok, unsigned char* lds) {
  const bf16_t* W = (const bf16_t*)(p.ws + OFF_WQ) + (size_t)l * 1024 * 1024;
  const bf16_t* H = (const bf16_t*)(p.ws + OFF_H);
  bf16_t* QP = (bf16_t*)(p.ws + OFF_QP);
  const int ntile = (ntok / 128) * 8;
  for (int t = lbid(); t < ntile; t += lgdim()) {
    const int jt = t >> 3, it = t & 7;
    gemm_tile<0>(W, H, it, jt, QP, 1024, nullptr, nullptr, nullptr, lds);
  }
}

DI void phase_rope(const Params& p, unsigned char* lds) {
  float2* tab = (float2*)lds;
  for (int e = ltid(); e < 1024; e += 256) {
    const int pos = e >> 4, i = e & 15;
    const float inv = exp2f(-(float)i * (13.287712379549449f / 16.f));
    const float ang = (float)pos * inv;
    tab[e] = make_float2(__cosf(ang), __sinf(ang));
  }
  __syncthreads();
  bf16_t* PN = (bf16_t*)(p.ws + OFF_P);
  const int total = TL * 16;
  for (int idx = lbid() * 256 + ltid(); idx < total; idx += lgdim() * 256) {
    const int t = idx >> 4, vec = idx & 15;
    const int col = ((vec >> 3) ? C_DK : C_DQ) + ((vec >> 1) & 3) * 128 + (vec & 1) * 64;
    bf16_t* ptr = PN + (size_t)t * PN_LD + col;
    float xv[64];
#pragma unroll
    for (int q = 0; q < 8; ++q) { const u32x4 v = *(const u32x4*)(ptr + q * 8); unpack8(v, xv + q * 8); }
    const int row = (t & 2047) >> 6, cp = t & 63;
#pragma unroll
    for (int i = 0; i < 16; ++i) {
      const float2 cs = tab[row * 16 + i];
      const float x1 = xv[i], x2 = xv[16 + i];
      xv[i] = x1 * cs.x - x2 * cs.y; xv[16 + i] = x2 * cs.x + x1 * cs.y;
      const float2 cs2 = tab[cp * 16 + i];
      const float y1 = xv[32 + i], y2 = xv[48 + i];
      xv[32 + i] = y1 * cs2.x - y2 * cs2.y; xv[48 + i] = y2 * cs2.x + y1 * cs2.y;
    }
#pragma unroll
    for (int q = 0; q < 8; ++q) {
      u32x4 o = {pk2(xv[q * 8], xv[q * 8 + 1]), pk2(xv[q * 8 + 2], xv[q * 8 + 3]), pk2(xv[q * 8 + 4], xv[q * 8 + 5]), pk2(xv[q * 8 + 6], xv[q * 8 + 7])};
      *(u32x4*)(ptr + q * 8) = o;
    }
  }
}

struct SrcSeg {
  const bf16_t* PN; const bf16_t* VT; int kcol, vrow, t0, n0, t1, n1, lr, g;
  const bf16_t* k0p; const bf16_t* k1p; const bf16_t* vp;
  DI int nsteps() const { return n0 + n1; }
  DI void setup(int st) {
    const int tok0 = st < n0 ? t0 + st * 32 : t1 + (st - n0) * 32;
    const int kap = 8 * (lr >> 2) + (lr & 3);
    k0p = PN + (size_t)(tok0 + kap) * PN_LD + kcol + 8 * g;
    k1p = k0p + (size_t)4 * PN_LD;
    vp = VT + (size_t)(vrow + lr) * TT + tok0 + 8 * g;
  }
  DI bf16x8 kfrag(int m, int kt, int ks) const { return *(const bf16x8*)((kt ? k1p : k0p) + m * 64 + ks * 32); }
  DI bf16x8 vfrag(int dt) const { return *(const bf16x8*)(vp + (size_t)dt * 16 * TT); }
  DI float score(float raw, int kt, int r) const { return raw * SC_LOG2; }
};
struct SrcNat {
  const bf16_t* PN; const bf16_t* VT; int kcol, vrow, b, rq, rs, cs, qc, cstart, lr, g, st_;
  const float* rpbh;
  const bf16_t* k0p; const bf16_t* k1p; const bf16_t* vp;
  DI int nsteps() const { return 16; }
  DI void setup(int st) {
    st_ = st;
    const int tok0 = st < 8 ? b * 2048 + (rs + st) * 64 + cs : TL + b * 256 + (st - 8) * 32;
    const int kap = 8 * (lr >> 2) + (lr & 3);
    k0p = PN + (size_t)(tok0 + kap) * PN_LD + kcol + 8 * g;
    k1p = k0p + (size_t)4 * PN_LD;
    vp = VT + (size_t)(vrow + lr) * TT + tok0 + 8 * g;
  }
  DI bf16x8 kfrag(int m, int kt, int ks) const { return *(const bf16x8*)((kt ? k1p : k0p) + ks * 32); }
  DI bf16x8 vfrag(int dt) const { return *(const bf16x8*)(vp + (size_t)dt * 16 * TT); }
  DI float score(float raw, int kt, int r) const {
    if (st_ >= 8) return raw * SC_LOG2;
    const int kc = cs + 8 * g + 4 * kt + r;
    const bool valid = (kc >= cstart) && (kc < cstart + 16);
    int dc = kc - qc + 15; dc = dc < 0 ? 0 : (dc > 30 ? 30 : dc);
    const float bias = rpbh[(rs + st_ - rq + 7) * 31 + dc];
    return valid ? (raw * 0.125f + bias) * LOG2E : NEG_BIG;
  }
};

template <int MAPS, int DVT, class Src>
DI void flash_wave(Src& S, const bf16_t* qptr  , f32x4 (&o)[MAPS][DVT], float (&ltot)[MAPS]) {
  bf16x8 qf[MAPS][2];
#pragma unroll
  for (int m = 0; m < MAPS; ++m)
#pragma unroll
    for (int ks = 0; ks < 2; ++ks) qf[m][ks] = *(const bf16x8*)(qptr + m * 64 + ks * 32);
  float mrun[MAPS], lrun[MAPS];
#pragma unroll
  for (int m = 0; m < MAPS; ++m) {
    mrun[m] = NEG_BIG; lrun[m] = 0.f;
#pragma unroll
    for (int dt = 0; dt < DVT; ++dt) o[m][dt] = (f32x4){0.f, 0.f, 0.f, 0.f};
  }
  const int ns = S.nsteps();
  for (int st = 0; st < ns; ++st) {
    S.setup(st);
    bf16x8 pf[MAPS];
#pragma unroll
    for (int m = 0; m < MAPS; ++m) {
      f32x4 s[2];
#pragma unroll
      for (int kt = 0; kt < 2; ++kt) {
        s[kt] = (f32x4){0.f, 0.f, 0.f, 0.f};
#pragma unroll
        for (int ks = 0; ks < 2; ++ks) s[kt] = mfma16(S.kfrag(m, kt, ks), qf[m][ks], s[kt]);
      }
      float mt = NEG_BIG;
#pragma unroll
      for (int kt = 0; kt < 2; ++kt)
#pragma unroll
        for (int r = 0; r < 4; ++r) { s[kt][r] = S.score(s[kt][r], kt, r); mt = fmaxf(mt, s[kt][r]); }
      mt = fmaxf(mt, __shfl_xor(mt, 16));
      mt = fmaxf(mt, __shfl_xor(mt, 32));
      const bool need = mt > mrun[m] + 8.f;
      if (__any(need)) {
        const float mnew = need ? mt : mrun[m];
        const float alpha = exp2f(mrun[m] - mnew);
        lrun[m] *= alpha;
#pragma unroll
        for (int dt = 0; dt < DVT; ++dt) { o[m][dt][0] *= alpha; o[m][dt][1] *= alpha; o[m][dt][2] *= alpha; o[m][dt][3] *= alpha; }
        mrun[m] = mnew;
      }
      float pv[8];
      float ls = 0.f;
#pragma unroll
      for (int kt = 0; kt < 2; ++kt)
#pragma unroll
        for (int r = 0; r < 4; ++r) { pv[kt * 4 + r] = exp2f(s[kt][r] - mrun[m]); ls += pv[kt * 4 + r]; }
      lrun[m] += ls;
      u32x4 pk = {pk2(pv[0], pv[1]), pk2(pv[2], pv[3]), pk2(pv[4], pv[5]), pk2(pv[6], pv[7])};
      pf[m] = __builtin_bit_cast(bf16x8, pk);
    }
#pragma unroll
    for (int dt = 0; dt < DVT; ++dt) {
      const bf16x8 vf = S.vfrag(dt);
#pragma unroll
      for (int m = 0; m < MAPS; ++m) o[m][dt] = mfma16(vf, pf[m], o[m][dt]);
    }
  }
#pragma unroll
  for (int m = 0; m < MAPS; ++m) {
    float l = lrun[m];
    l += __shfl_xor(l, 16);
    l += __shfl_xor(l, 32);
    ltot[m] = l;
  }
}

DI void diff_wave_task(const Params& p, int l, int b, int hd, int qtok0, bool ctx_only) {
  const int lane = ltid() & 63, lr = lane & 15, g = lane >> 4;
  const bf16_t* PN = (const bf16_t*)(p.ws + OFF_P);
  const bf16_t* VT = (const bf16_t*)(p.ws + OFF_VT);
  bf16_t* Y = (bf16_t*)(p.ws + OFF_Y);
  const float* lv = p.dlam + l * 256;
  float sa = lv[lane] * lv[64 + lane], sb = lv[128 + lane] * lv[192 + lane];
  sa = wave_sum(sa); sb = wave_sum(sb);
  const float lam_init = 0.8f - 0.6f * expf(-0.3f * (float)l);
  const float lam = expf(sa) - expf(sb) + lam_init;
  SrcSeg S;
  S.PN = PN; S.VT = VT; S.kcol = C_DK + hd * 128; S.vrow = R_DV + hd * 128; S.lr = lr; S.g = g;
  S.t0 = TL + b * 256; S.n0 = 8; S.t1 = b * 2048; S.n1 = ctx_only ? 0 : 64;
  f32x4 o[2][8];
  float lt[2];
  const int qtok = qtok0 + lr;
  flash_wave<2, 8, SrcSeg>(S, PN + (size_t)qtok * PN_LD + C_DQ + hd * 128 + 8 * g, o, lt);
  const float i0 = 1.f / lt[0], i1 = lam / lt[1];
  float ss = 0.f;
#pragma unroll
  for (int dt = 0; dt < 8; ++dt)
#pragma unroll
    for (int r = 0; r < 4; ++r) { const float v = o[0][dt][r] * i0 - o[1][dt][r] * i1; o[0][dt][r] = v; ss += v * v; }
  ss += __shfl_xor(ss, 16);
  ss += __shfl_xor(ss, 32);
  const float rstd = rsqrtf(ss * (1.f / 128.f) + 1e-6f) * (1.f - lam_init);
  const float* dg = p.diff_g + l * 512 + hd * 128;
#pragma unroll
  for (int dt = 0; dt < 8; ++dt) {
    const float4 gg = *(const float4*)(dg + dt * 16 + 4 * g);
    u32x2 ov = {pk2(o[0][dt][0] * rstd * gg.x, o[0][dt][1] * rstd * gg.y), pk2(o[0][dt][2] * rstd * gg.z, o[0][dt][3] * rstd * gg.w)};
    *(u32x2*)(Y + (size_t)qtok * 1024 + 512 + hd * 128 + dt * 16 + 4 * g) = ov;
  }
}

DI void nat_wave_task(const Params& p, int l, int b, int head, int rq, int ct, const float* rpb_lds) {
  const int lane = ltid() & 63, lr = lane & 15, g = lane >> 4;
  const bf16_t* PN = (const bf16_t*)(p.ws + OFF_P);
  const bf16_t* VT = (const bf16_t*)(p.ws + OFF_VT);
  bf16_t* Y = (bf16_t*)(p.ws + OFF_Y);
  SrcNat S;
  S.PN = PN; S.VT = VT; S.kcol = C_NK + head * 64; S.vrow = R_NV + head * 64; S.b = b; S.rq = rq; S.lr = lr; S.g = g;
  int rs = rq - 4; rs = rs < 0 ? 0 : (rs > 24 ? 24 : rs);
  S.rs = rs;
  int cs = 16 * ct - 8; cs = cs < 0 ? 0 : (cs > 32 ? 32 : cs);
  S.cs = cs;
  S.qc = 16 * ct + lr;
  int cst = S.qc - 8; cst = cst < 0 ? 0 : (cst > 48 ? 48 : cst);
  S.cstart = cst;
  S.rpbh = rpb_lds + head * 465;
  f32x4 o[1][4];
  float lt[1];
  const int qtok = b * 2048 + rq * 64 + 16 * ct + lr;
  flash_wave<1, 4, SrcNat>(S, PN + (size_t)qtok * PN_LD + C_NQ + head * 64 + 8 * g, o, lt);
  const float inv = 1.f / lt[0];
#pragma unroll
  for (int dt = 0; dt < 4; ++dt) {
    u32x2 ov = {pk2(o[0][dt][0] * inv, o[0][dt][1] * inv), pk2(o[0][dt][2] * inv, o[0][dt][3] * inv)};
    *(u32x2*)(Y + (size_t)qtok * 1024 + 256 + head * 64 + dt * 16 + 4 * g) = ov;
  }
}
DI void natctx_wave_task(const Params& p, int b, int head, int qt) {
  const int lane = ltid() & 63, lr = lane & 15, g = lane >> 4;
  const bf16_t* PN = (const bf16_t*)(p.ws + OFF_P);
  const bf16_t* VT = (const bf16_t*)(p.ws + OFF_VT);
  bf16_t* Y = (bf16_t*)(p.ws + OFF_Y);
  SrcSeg S;
  S.PN = PN; S.VT = VT; S.kcol = C_NK + head * 64; S.vrow = R_NV + head * 64; S.lr = lr; S.g = g;
  S.t0 = TL + b * 256; S.n0 = 8; S.t1 = 0; S.n1 = 0;
  f32x4 o[1][4];
  float lt[1];
  const int qtok = TL + b * 256 + qt * 16 + lr;
  flash_wave<1, 4, SrcSeg>(S, PN + (size_t)qtok * PN_LD + C_NQ + head * 64 + 8 * g, o, lt);
  const float inv = 1.f / lt[0];
#pragma unroll
  for (int dt = 0; dt < 4; ++dt) {
    u32x2 ov = {pk2(o[0][dt][0] * inv, o[0][dt][1] * inv), pk2(o[0][dt][2] * inv, o[0][dt][3] * inv)};
    *(u32x2*)(Y + (size_t)qtok * 1024 + 256 + head * 64 + dt * 16 + 4 * g) = ov;
  }
}

DI void gla_task(const Params& p, int l, int task, unsigned char* lds) {
  const int tid = ltid(), lane = tid & 63, w = tid >> 6, vv = lane & 15, g = lane >> 4;
  const int b = task >> 3, h = (task >> 1) & 3, dir = task & 1;
  const bf16_t* PN = (const bf16_t*)(p.ws + OFF_P);
  const bf16_t* VT = (const bf16_t*)(p.ws + OFF_VT);
  float* og = (float*)(p.ws + OFF_H);
  float* Gup = (float*)lds;
  float* Gb = Gup + 512;
  float* As = Gb + 32;
  float* Ks = As + 2048;
  float* Qs = Ks + 2048;
  float* Vs = Qs + 2048;
  __syncthreads();
  for (int e = tid; e < 512; e += 256) { const int r = e >> 5, kd = e & 31; Gup[e] = p.gate_up[((size_t)(l * 2 + dir) * 16 + r) * 128 + h * 32 + kd]; }
  if (tid < 32) Gb[tid] = p.gate_b[(l * 2 + dir) * 128 + h * 32 + tid];
  float S[8];
#pragma unroll
  for (int e = 0; e < 8; ++e) S[e] = 0.f;
  for (int cc = 0; cc < 36; ++cc) {
    int tok0;
    if (cc < 4) { const int ch = dir == 0 ? cc : 3 - cc; tok0 = TL + b * 256 + ch * 64; }
    else { const int ch = dir == 0 ? cc - 4 : 35 - cc; tok0 = b * 2048 + ch * 64; }
    __syncthreads();
    {
      const int i = tid >> 2, part = tid & 3;
      const bf16_t* row = PN + (size_t)(tok0 + i) * PN_LD;
      const u32x4 qv = *(const u32x4*)(row + C_GQ + h * 32 + part * 8);
      const u32x4 kv = *(const u32x4*)(row + C_GK + h * 32 + part * 8);
      const u32x4 g0 = *(const u32x4*)(row + C_GATE + dir * 16);
      const u32x4 g1 = *(const u32x4*)(row + C_GATE + dir * 16 + 8);
      float gd[16], qf[8], kf[8];
      unpack8(g0, gd); unpack8(g1, gd + 8); unpack8(qv, qf); unpack8(kv, kf);
#pragma unroll
      for (int e = 0; e < 8; ++e) {
        const int kd = part * 8 + e;
        float pre = Gb[kd];
#pragma unroll
        for (int r = 0; r < 16; ++r) pre += gd[r] * Gup[r * 32 + kd];
        const float ls = fminf(pre, 0.f) - log1pf(__expf(-fabsf(pre)));
        As[i * 32 + kd] = __expf(ls * (1.f / 16.f));
        Ks[i * 32 + kd] = kf[e];
        Qs[i * 32 + kd] = qf[e] * 0.17677669529663687f;
      }
      const int v = tid >> 2;
      const bf16_t* vp = VT + (size_t)(R_GV + h * 64 + v) * TT + tok0 + part * 16;
      const u32x4 v0 = *(const u32x4*)vp, v1 = *(const u32x4*)(vp + 8);
      float vf[16];
      unpack8(v0, vf); unpack8(v1, vf + 8);
#pragma unroll
      for (int e = 0; e < 16; ++e) Vs[(part * 16 + e) * 65 + v] = vf[e];
    }
    __syncthreads();
    for (int s = 0; s < 64; ++s) {
      const int i = dir == 0 ? s : 63 - s;
      const float4 a0 = *(const float4*)(As + i * 32 + 8 * g), a1 = *(const float4*)(As + i * 32 + 8 * g + 4);
      const float4 k0 = *(const float4*)(Ks + i * 32 + 8 * g), k1 = *(const float4*)(Ks + i * 32 + 8 * g + 4);
      const float4 q0 = *(const float4*)(Qs + i * 32 + 8 * g), q1 = *(const float4*)(Qs + i * 32 + 8 * g + 4);
      const float v = Vs[i * 65 + 16 * w + vv];
      S[0] = a0.x * S[0] + k0.x * v; S[1] = a0.y * S[1] + k0.y * v; S[2] = a0.z * S[2] + k0.z * v; S[3] = a0.w * S[3] + k0.w * v;
      S[4] = a1.x * S[4] + k1.x * v; S[5] = a1.y * S[5] + k1.y * v; S[6] = a1.z * S[6] + k1.z * v; S[7] = a1.w * S[7] + k1.w * v;
      float o = q0.x * S[0] + q0.y * S[1] + q0.z * S[2] + q0.w * S[3] + q1.x * S[4] + q1.y * S[5] + q1.z * S[6] + q1.w * S[7];
      o += __shfl_xor(o, 16);
      o += __shfl_xor(o, 32);
      if (g == 0) og[((size_t)dir * TT + tok0 + i) * 256 + h * 64 + 16 * w + vv] = o;
    }
  }
}

DI void phase_mixers(const Params& p, int l, bool last, unsigned* ctr, unsigned char* lds) {
  const int tid = ltid(), w = tid >> 6;
  volatile int* slot = (volatile int*)(lds + LDS_BYTES - 16);
  float* rpb_lds = (float*)(lds + 48 * 1024);
  for (int e = tid; e < 4 * 465; e += 256) rpb_lds[e] = p.rpb[(size_t)l * 4 * 465 + e];
  const int ntask = 128 + 2048 + 2048 + (last ? 0 : 512);
  for (;;) {
    __syncthreads();
    if (tid == 0) *slot = (int)atomicAdd(ctr, 1u);
    __syncthreads();
    const int task = *slot;
    if (task >= ntask) break;
    if (task < 128) { gla_task(p, l, task, lds); }
    else if (task < 128 + 2048) { const int wt = (task - 128) * 4 + w; diff_wave_task(p, l, wt >> 9, (wt >> 7) & 3, (wt >> 9) * 2048 + (wt & 127) * 16, false); }
    else if (task < 128 + 4096) { const int wt = (task - 128 - 2048) * 4 + w; nat_wave_task(p, l, wt >> 9, (wt >> 7) & 3, (wt >> 2) & 31, wt & 3, rpb_lds); }
    else if (task < 128 + 4096 + 256) { const int wt = (task - 128 - 4096) * 4 + w; const int b = wt >> 6; diff_wave_task(p, l, b, (wt >> 4) & 3, TL + b * 256 + (wt & 15) * 16, true); }
    else { const int wt = (task - 128 - 4096 - 256) * 4 + w; natctx_wave_task(p, wt >> 6, (wt >> 4) & 3, wt & 15); }
  }
}

DI void phase_gla_fin(const Params& p, int l, int ntok) {
  const int lane = ltid() & 63, gw = lbid() * 4 + (ltid() >> 6), nw = lgdim() * 4;
  const float* og = (const float*)(p.ws + OFF_H);
  const bf16_t* PN = (const bf16_t*)(p.ws + OFF_P);
  bf16_t* Y = (bf16_t*)(p.ws + OFF_Y);
  const float4 gg = *(const float4*)(p.gla_norm_g + l * 256 + 4 * lane);
  for (int t = gw; t < ntok; t += nw) {
    const float4 a = *(const float4*)(og + (size_t)t * 256 + 4 * lane), bq = *(const float4*)(og + ((size_t)TT + t) * 256 + 4 * lane);
    const float o0 = a.x + bq.x, o1 = a.y + bq.y, o2 = a.z + bq.z, o3 = a.w + bq.w;
    float ss = o0 * o0 + o1 * o1 + o2 * o2 + o3 * o3;
    ss += __shfl_xor(ss, 1); ss += __shfl_xor(ss, 2); ss += __shfl_xor(ss, 4); ss += __shfl_xor(ss, 8);
    const float rstd = rsqrtf(ss * (1.f / 64.f) + 1e-6f);
    const u32x2 rv = *(const u32x2*)(PN + (size_t)t * PN_LD + C_GR + 4 * lane);
    const float r0 = bflo(rv.x), r1 = bfhi(rv.x), r2 = bflo(rv.y), r3 = bfhi(rv.y);
    const float y0 = o0 * rstd * gg.x * (r0 / (1.f + __expf(-r0)));
    const float y1 = o1 * rstd * gg.y * (r1 / (1.f + __expf(-r1)));
    const float y2 = o2 * rstd * gg.z * (r2 / (1.f + __expf(-r2)));
    const float y3 = o3 * rstd * gg.w * (r3 / (1.f + __expf(-r3)));
    u32x2 ov = {pk2(y0, y1), pk2(y2, y3)};
    *(u32x2*)(Y + (size_t)t * 1024 + 4 * lane) = ov;
  }
}

struct PairTab { int a[52], b[52]; };
constexpr PairTab make_pairs() {
  PairTab t{};
  int n = 0;
  for (int a = 0; a < 16; ++a)
    for (int b = 0; b < 16; ++b)
      if ((a + 1) * (b + 1) <= 16) { t.a[n] = a; t.b[n] = b; ++n; }
  for (; n < 52; ++n) { t.a[n] = -1; t.b[n] = -1; }
  return t;
}

DI void topk_half(const bf16_t* skh  , const bf16_t* qrow  , int lr, int g, float (&list)[16]) {
  bf16x8 qf[2];
  qf[0] = *(const bf16x8*)(qrow); qf[1] = *(const bf16x8*)(qrow + 32);
  float s[32];
#pragma unroll
  for (int nt = 0; nt < 8; ++nt) {
    f32x4 acc = {0.f, 0.f, 0.f, 0.f};
#pragma unroll
    for (int ks = 0; ks < 2; ++ks) {
      const bf16x8 af = *(const bf16x8*)(skh + (size_t)(nt * 16 + lr) * 64 + ks * 32 + 8 * g);
      acc = mfma16(af, qf[ks], acc);
    }
#pragma unroll
    for (int r = 0; r < 4; ++r) {
      const unsigned n = nt * 16 + 4 * g + r;
      s[nt * 4 + r] = __uint_as_float((__float_as_uint(acc[r]) & ~127u) | n);
    }
  }
#pragma unroll
  for (int k = 0; k < 16; ++k) {
    float m = s[0];
#pragma unroll
    for (int i = 1; i < 32; ++i) m = fmaxf(m, s[i]);
    m = fmaxf(m, __shfl_xor(m, 16));
    m = fmaxf(m, __shfl_xor(m, 32));
    list[k] = m;
#pragma unroll
    for (int i = 0; i < 32; ++i) s[i] = (s[i] == m) ? -3.0e38f : s[i];
  }
}

DI void phase_topk(const Params& p, int l, int ntok) {
  constexpr PairTab PT = make_pairs();
  const int lane = ltid() & 63, lr = lane & 15, g = lane >> 4;
  const int gw = lbid() * 4 + (ltid() >> 6), nw = lgdim() * 4;
  const bf16_t* QP = (const bf16_t*)(p.ws + OFF_QP);
  const bf16_t* sk = (const bf16_t*)(p.ws + OFF_SK) + (size_t)l * 2 * 128 * 64;
  int* eid = (int*)(p.ws + OFF_EID);
  float* gate = (float*)(p.ws + OFF_GATE);
  const int ntask = (ntok / 16) * 8;
  for (int task = gw; task < ntask; task += nw) {
    const int tt = task >> 3, hd = task & 7;
    const int tok = tt * 16 + lr;
    float v1[16], v2[16];
    topk_half(sk, QP + (size_t)tok * 1024 + hd * 128 + 8 * g, lr, g, v1);
    topk_half(sk + 128 * 64, QP + (size_t)tok * 1024 + hd * 128 + 64 + 8 * g, lr, g, v2);
    float cand[13];
    int ceid[13];
#pragma unroll
    for (int c = 0; c < 13; ++c) {
      float sv[4];
      int ev[4];
#pragma unroll
      for (int gi = 0; gi < 4; ++gi) {
        const int pi = 4 * c + gi;
        if (PT.a[pi] >= 0) {
          const float a = v1[PT.a[pi] < 0 ? 0 : PT.a[pi]], bq = v2[PT.b[pi] < 0 ? 0 : PT.b[pi]];
          sv[gi] = __uint_as_float((__float_as_uint(a + bq) & ~63u) | (unsigned)pi);
          ev[gi] = (int)((__float_as_uint(a) & 127u) * 128u + (__float_as_uint(bq) & 127u));
        } else { sv[gi] = -3.0e38f; ev[gi] = 0; }
      }
      cand[c] = g == 0 ? sv[0] : (g == 1 ? sv[1] : (g == 2 ? sv[2] : sv[3]));
      ceid[c] = g == 0 ? ev[0] : (g == 1 ? ev[1] : (g == 2 ? ev[2] : ev[3]));
    }
    float topv[16];
#pragma unroll
    for (int k = 0; k < 16; ++k) {
      float m = cand[0];
#pragma unroll
      for (int c = 1; c < 13; ++c) m = fmaxf(m, cand[c]);
      m = fmaxf(m, __shfl_xor(m, 16));
      m = fmaxf(m, __shfl_xor(m, 32));
      topv[k] = m;
      int my = -1;
#pragma unroll
      for (int c = 0; c < 13; ++c) { if (cand[c] == m) { my = ceid[c]; cand[c] = -3.0e38f; } }
      if (my >= 0) eid[(size_t)tok * 128 + hd * 16 + k] = my;
    }
    if (g == 0) {
      float ex[16], sum = 0.f;
#pragma unroll
      for (int k = 0; k < 16; ++k) { ex[k] = __expf(topv[k] - topv[0]); sum += ex[k]; }
      const float inv = 1.f / sum;
#pragma unroll
      for (int q = 0; q < 4; ++q) {
        float4 o = {ex[4 * q] * inv, ex[4 * q + 1] * inv, ex[4 * q + 2] * inv, ex[4 * q + 3] * inv};
        *(float4*)(gate + (size_t)tok * 128 + hd * 16 + 4 * q) = o;
      }
    }
  }
}

DI float gelu_tanh(float x) {
  const float z = 0.7978845608028654f * (x + 0.044715f * x * x * x);
  const float e = __expf(2.f * z);
  const float th = 1.f - 2.f / (e + 1.f);
  return 0.5f * x * (1.f + th);
}
DI void phase_gather(const Params& p, int l, int ntok, unsigned char* lds) {
  const int tid = ltid(), lane = tid & 63, w = tid >> 6, lr = lane & 15, g = lane >> 4;
  const int gw = lbid() * 4 + w, nw = lgdim() * 4;
  const unsigned char* U8 = p.ws + OFF_U + (size_t)l * 16384 * 1024;
  const unsigned char* V8 = p.ws + OFF_V + (size_t)l * 16384 * 1024;
  const float* uscl = (const float*)(p.ws + OFF_USCL) + l * 16384;
  const float* vscl = (const float*)(p.ws + OFF_VSCL) + l * 16384;
  const unsigned char* H8 = p.ws + OFF_H8;
  const float* hinv = (const float*)(p.ws + OFF_HINV);
  const int* eid = (const int*)(p.ws + OFF_EID);
  const float* gate = (const float*)(p.ws + OFF_GATE);
  float* xres = (float*)(p.ws + OFF_XRES);
  const float* modbuf = (const float*)(p.ws + OFF_MOD);
  unsigned char* hl = lds + w * 1024;
  for (int t = gw; t < ntok; t += nw) {
    {
      const u32x4 hq = *(const u32x4*)(H8 + (size_t)t * 1024 + lane * 16);
      *(u32x4*)(hl + lane * 16) = hq;
    }
    const float hs = hinv[t];
    const int e0 = eid[(size_t)t * 128 + lane], e1 = eid[(size_t)t * 128 + 64 + lane];
    const float su0 = uscl[e0] * hs, su1 = uscl[e1] * hs;
    const float gv0 = gate[(size_t)t * 128 + lane] * vscl[e0], gv1 = gate[(size_t)t * 128 + 64 + lane] * vscl[e1];
    float out[16];
#pragma unroll
    for (int i = 0; i < 16; ++i) out[i] = 0.f;
#pragma unroll 1
    for (int grp = 0; grp < 8; ++grp) {
      const int esel = grp < 4 ? e0 : e1;
      const float susel = grp < 4 ? su0 : su1, gvsel = grp < 4 ? gv0 : gv1;
      const int lb = (grp & 3) * 16;
      const int erow = __shfl(esel, lb + lr);
      const unsigned char* ur = U8 + (size_t)erow * 1024 + g * 16;
      u32x4 ub[16], va[8];
#pragma unroll
      for (int c = 0; c < 16; ++c) ub[c] = *(const u32x4*)(ur + c * 64);
#pragma unroll
      for (int j = 0; j < 8; ++j) {
        const int ej = __builtin_amdgcn_readlane(esel, lb + j);
        va[j] = *(const u32x4*)(V8 + (size_t)ej * 1024 + lane * 16);
      }
      f32x4 acc = {0.f, 0.f, 0.f, 0.f};
#pragma unroll
      for (int c = 0; c < 16; ++c) {
        const long b0 = *(const long*)(hl + c * 64 + g * 16), b1 = *(const long*)(hl + c * 64 + g * 16 + 8);
        const long a0 = __builtin_bit_cast(long, (u32x2){ub[c].x, ub[c].y}), a1 = __builtin_bit_cast(long, (u32x2){ub[c].z, ub[c].w});
        acc = __builtin_amdgcn_mfma_f32_16x16x32_fp8_fp8(a0, b0, acc, 0, 0, 0);
        acc = __builtin_amdgcn_mfma_f32_16x16x32_fp8_fp8(a1, b1, acc, 0, 0, 0);
        if ((c & 3) == 3) __builtin_amdgcn_sched_barrier(0);
      }
      u32x4 vb[8];
#pragma unroll
      for (int j = 0; j < 8; ++j) {
        const int ej = __builtin_amdgcn_readlane(esel, lb + 8 + j);
        vb[j] = *(const u32x4*)(V8 + (size_t)ej * 1024 + lane * 16);
      }
      float wv[4];
#pragma unroll
      for (int r = 0; r < 4; ++r) {
        const float sur = __shfl(susel, lb + 4 * g + r), gvr = __shfl(gvsel, lb + 4 * g + r);
        wv[r] = gvr * gelu_tanh(acc[r] * sur);
      }
#pragma unroll
      for (int j = 0; j < 16; ++j) {
        const float wj = __int_as_float(__builtin_amdgcn_readlane(__float_as_int(wv[j & 3]), 16 * (j >> 2)));
        const u32x4 vv = j < 8 ? va[j & 7] : vb[j & 7];
#pragma unroll
        for (int q = 0; q < 4; ++q) {
          const f32x2 lo = __builtin_amdgcn_cvt_pk_f32_fp8((int)vv[q], false), hi = __builtin_amdgcn_cvt_pk_f32_fp8((int)vv[q], true);
          out[4 * q + 0] += wj * lo[0]; out[4 * q + 1] += wj * lo[1]; out[4 * q + 2] += wj * hi[0]; out[4 * q + 3] += wj * hi[1];
        }
      }
    }
    const int b = t < TL ? (t >> 11) : 16;
    const float* md = modbuf + ((size_t)l * 17 + b) * 6144 + 5 * 1024 + 16 * lane;
    float* xr = xres + (size_t)t * 1024 + 16 * lane;
#pragma unroll
    for (int q = 0; q < 4; ++q) {
      const float4 m4 = *(const float4*)(md + 4 * q);
      float4 xv = *(const float4*)(xr + 4 * q);
      xv.x += m4.x * out[4 * q + 0]; xv.y += m4.y * out[4 * q + 1]; xv.z += m4.z * out[4 * q + 2]; xv.w += m4.w * out[4 * q + 3];
      *(float4*)(xr + 4 * q) = xv;
    }
  }
}

DI void phase_final(const Params& p) {
  const int lane = ltid() & 63, gw = lbid() * 4 + (ltid() >> 6), nw = lgdim() * 4;
  const float* xres = (const float*)(p.ws + OFF_XRES);
  for (int t = gw; t < TL; t += nw) {
    const float* src = xres + (size_t)t * 1024;
    float4 v[4];
    float ss = 0.f;
#pragma unroll
    for (int i = 0; i < 4; ++i) {
      v[i] = *(const float4*)(src + 4 * lane + 256 * i);
      ss += v[i].x * v[i].x + v[i].y * v[i].y + v[i].z * v[i].z + v[i].w * v[i].w;
    }
    ss = wave_sum(ss);
    const float rstd = rsqrtf(ss * (1.f / 1024.f) + 1e-6f);
#pragma unroll
    for (int i = 0; i < 4; ++i) {
      const int col = 4 * lane + 256 * i;
      const float4 g4 = *(const float4*)(p.final_g + col);
      float4 o = {v[i].x * rstd * g4.x, v[i].y * rstd * g4.y, v[i].z * rstd * g4.z, v[i].w * rstd * g4.w};
      *(float4*)(p.out + (size_t)t * 1024 + col) = o;
    }
  }
}


#define LAS __attribute__((address_space(3)))
#define XB_TMO      128
#define XB_XCNT(j)  (256  + 64 * (j))
#define XB_XSUB(j)  (1280 + 64 * (j))
#define XB_XGEN(j)  (2304 + 64 * (j))
#define XB_TOP      3328
#define XB_TOPGEN   3392
#define XCD_BAR_WORDS 3456
#define XB_SPIN_CAP (1u << 22)
DI unsigned xb_ld(unsigned* p) { return __hip_atomic_load(p, __ATOMIC_RELAXED, __HIP_MEMORY_SCOPE_AGENT); }
DI unsigned xb_add(unsigned* p, unsigned v) { return __hip_atomic_fetch_add(p, v, __ATOMIC_RELAXED, __HIP_MEMORY_SCOPE_AGENT); }
DI unsigned xb_xcc_id() { return (unsigned)__builtin_amdgcn_s_getreg((3 << 11) | 20) & 0xFu; }
#define XB_SPIN(cond, bar) do { unsigned _sp = 0; while (cond) { __builtin_amdgcn_s_sleep(1); \
    if ((++_sp & 255u) == 0u) { if (xb_ld(&(bar)[XB_TMO])) break; if (_sp > XB_SPIN_CAP) { atomicAdd(&(bar)[XB_TMO], 1u); break; } } } } while (0)
struct XcdBarrier { unsigned* bar; unsigned x; volatile unsigned* st; };
DI XcdBarrier xcd_barrier_post(unsigned* bar, volatile unsigned* st) {
  XcdBarrier b; b.bar = bar; b.x = xb_xcc_id(); b.st = st;
  if (threadIdx.x == 0) (void)xb_add(&bar[XB_XCNT(b.x)], 1u);
  return b;
}
DI void xcd_barrier_complete(unsigned* bar, unsigned x, unsigned& nloc, unsigned& nx) {
  const unsigned G = gridDim.x * gridDim.y * gridDim.z;
  unsigned sum, cnt, mine, sp = 0u;
  for (;;) {
    sum = 0u; cnt = 0u; mine = 0u;
#pragma unroll
    for (unsigned j = 0; j < 16; ++j) { const unsigned c = xb_ld(&bar[XB_XCNT(j)]); sum += c; cnt += (c > 0u) ? 1u : 0u; mine = (j == x) ? c : mine; }
    if (sum == G) break;
    __builtin_amdgcn_s_sleep(1);
    if ((++sp & 255u) == 0u) { if (xb_ld(&bar[XB_TMO])) break; if (sp > XB_SPIN_CAP) { atomicAdd(&bar[XB_TMO], 1u); break; } }
  }
  nloc = mine > 0u ? mine : 1u; nx = cnt > 0u ? cnt : 1u;
}
DI void xcd_barrier(const XcdBarrier& b) {
  asm volatile("s_waitcnt vmcnt(0)" ::: "memory");
  __syncthreads();
  if (threadIdx.x == 0) {
    unsigned* bar = b.bar;
    __builtin_amdgcn_s_waitcnt(0);
    unsigned nloc = b.st[0], nx = b.st[1];
    if (nloc == 0u) { xcd_barrier_complete(bar, b.x, nloc, nx); b.st[0] = nloc; b.st[1] = nx; }
    const unsigned old = xb_add(&bar[XB_XSUB(b.x)], 1u);
    const unsigned gen = old / nloc;
    if (old + 1u == (gen + 1u) * nloc) {
      __builtin_amdgcn_fence(__ATOMIC_RELEASE, "agent");
      asm volatile("s_waitcnt vmcnt(0)" ::: "memory");
      const unsigned og = xb_add(&bar[XB_TOP], 1u);
      const unsigned tg = og / nx;
      if (og + 1u == (tg + 1u) * nx) xb_add(&bar[XB_TOPGEN], 1u);
      else XB_SPIN(xb_ld(&bar[XB_TOPGEN]) == tg, bar);
      __builtin_amdgcn_fence(__ATOMIC_ACQUIRE, "agent");
      xb_add(&bar[XB_XGEN(b.x)], 1u);
      asm volatile("s_waitcnt vmcnt(0)" ::: "memory");
    } else {
      XB_SPIN(xb_ld(&bar[XB_XGEN(b.x)]) == gen, bar);
      __builtin_amdgcn_fence(__ATOMIC_ACQUIRE, "agent");
      asm volatile("s_waitcnt vmcnt(0)" ::: "memory");
    }
  }
  __syncthreads();
}

constexpr int PH_PER_LAYER = 10;
constexpr int N_PHASES = 1 + NL * PH_PER_LAYER + 1;

template <int KIND>
DI void run_phase(const Params& p, int ph, unsigned char* lds) {
  unsigned* ctl = (unsigned*)(p.ws + OFF_CTL);
  if (ph == 0) { if (KIND < 0 || KIND == 0) phase_prologue(p, lds); }
  else if (ph == N_PHASES - 1) { if (KIND < 0 || KIND == 11) phase_final(p); }
  else {
    const int l = (ph - 1) / PH_PER_LAYER, s = (ph - 1) % PH_PER_LAYER;
    const bool last = (l == NL - 1);
    const int ntok = last ? TL : TT;
    if (s == 0) { if (KIND < 0 || KIND == 1) phase_norm(p, l, 0, TT); }
    else if (s == 1) { if (KIND < 0 || KIND == 2) phase_gemm_in(p, l, lds); }
    else if (s == 2) { if (KIND < 0 || KIND == 3) phase_rope(p, lds); }
    else if (s == 3) { if (KIND < 0 || KIND == 4) phase_mixers(p, l, last, ctl + 64 * (1 + l), lds); }
    else if (s == 4) { if (KIND < 0 || KIND == 5) phase_gla_fin(p, l, ntok); }
    else if (s == 5) { if (KIND < 0 || KIND == 6) phase_gemm_out(p, l, ntok, lds); }
    else if (s == 6) { if (KIND < 0 || KIND == 7) phase_norm(p, l, 1, ntok); }
    else if (s == 7) { if (KIND < 0 || KIND == 8) phase_gemm_q(p, l, ntok, lds); }
    else if (s == 8) { if (KIND < 0 || KIND == 9) phase_topk(p, l, ntok); }
    else { if (KIND < 0 || KIND == 10) phase_gather(p, l, ntok, lds); }
  }
}

#if N_LAUNCH_MODE == 1
constexpr int CW_BAR = 4096;
__global__ void __launch_bounds__(256, 2) mk_fwd(Params p) {
  __shared__ __attribute__((aligned(16))) unsigned char lds[LDS_BYTES];
  unsigned* ctl = (unsigned*)(p.ws + OFF_CTL);
  volatile unsigned* st = (volatile unsigned*)(lds + LDS_BYTES - 32);
  if (threadIdx.x < 2) st[threadIdx.x] = 0u;
  __syncthreads();
  (void)xcd_barrier_post(ctl + CW_BAR, st);
#define GSYNC() do { XcdBarrier bb; bb.bar = (unsigned*)(p.ws + OFF_CTL) + CW_BAR; bb.x = xb_xcc_id(); bb.st = (volatile unsigned*)(lds + LDS_BYTES - 32); xcd_barrier(bb); } while (0)
  phase_prologue(p, lds); cg::this_grid().sync();
  for (int l = 0; l < NL; ++l) {
    const bool last = (l == NL - 1);
    const int ntok = last ? TL : TT;
    phase_norm(p, l, 0, TT); GSYNC();
    phase_gemm_in(p, l, lds); GSYNC();
    phase_rope(p, lds); GSYNC();
    phase_mixers(p, l, last, ctl + 64 * (1 + l), lds); GSYNC();
    phase_gla_fin(p, l, ntok); GSYNC();
    phase_gemm_out(p, l, ntok, lds); GSYNC();
    phase_norm(p, l, 1, ntok); GSYNC();
    phase_gemm_q(p, l, ntok, lds); GSYNC();
    phase_topk(p, l, ntok); GSYNC();
    phase_gather(p, l, ntok, lds); GSYNC();
  }
  phase_final(p);
}
#else
template <int KIND>
__global__ void __launch_bounds__(256, 2) mk_phase(Params p) {
  __shared__ __attribute__((aligned(16))) unsigned char lds[LDS_BYTES];
  run_phase<KIND>(p, p.ph_lo, lds);
}
#endif

extern "C" void kernel_launch(void* const* d_in, const int* in_sizes, int n_in, void* d_out, int out_size, void* d_ws,
                              size_t ws_size, hipStream_t stream) {
  static int grid = 0;
  if (grid == 0) {
    if (n_in != 21 || ws_size < WS_END || out_size != TL * DM) { fprintf(stderr, "kernel_launch: unexpected shapes (n_in %d ws %zu out %d)\n", n_in, ws_size, out_size); grid = -1; return; }
    int dev = 0, cus = 0, per_cu = 2;
    (void)hipGetDevice(&dev);
    (void)hipDeviceGetAttribute(&cus, hipDeviceAttributeMultiprocessorCount, dev);
#if N_LAUNCH_MODE == 1
    (void)hipOccupancyMaxActiveBlocksPerMultiprocessor(&per_cu, (const void*)mk_fwd, 256, 0);
    if (per_cu < 1) per_cu = 1;
    if (per_cu > 2) per_cu = 2;
#endif
    grid = cus * per_cu;
  }
  if (grid < 0) return;
  (void)hipMemsetAsync((char*)d_ws + OFF_CTL, 0, 65536, stream);
  Params p{};
  const float** pp = (const float**)&p;
  for (int i = 0; i < 21; ++i) pp[i] = (const float*)d_in[i];
  p.out = (float*)d_out;
  p.ws = (unsigned char*)d_ws;
#if N_LAUNCH_MODE == 1
  p.ph_lo = 0; p.ph_hi = N_PHASES;
  void* args[] = {&p};
  hipError_t e = hipLaunchCooperativeKernel((const void*)mk_fwd, dim3(grid), dim3(256), args, 0, stream);
  if (e != hipSuccess) fprintf(stderr, "cooperative launch failed: %s (grid %d)\n", hipGetErrorString(e), grid);
#else
  for (int ph = 0; ph < N_PHASES; ++ph) {
    p.ph_lo = ph; p.ph_hi = ph + 1;
    const int kind = ph == 0 ? 0 : (ph == N_PHASES - 1 ? 11 : 1 + (ph - 1) % PH_PER_LAYER);
    switch (kind) {
      case 0: hipLaunchKernelGGL(mk_phase<0>, dim3(grid), dim3(256), 0, stream, p); break;
      case 1: hipLaunchKernelGGL(mk_phase<1>, dim3(grid), dim3(256), 0, stream, p); break;
      case 2: hipLaunchKernelGGL(mk_phase<2>, dim3(grid), dim3(256), 0, stream, p); break;
      case 3: hipLaunchKernelGGL(mk_phase<3>, dim3(grid), dim3(256), 0, stream, p); break;
      case 4: hipLaunchKernelGGL(mk_phase<4>, dim3(grid), dim3(256), 0, stream, p); break;
      case 5: hipLaunchKernelGGL(mk_phase<5>, dim3(grid), dim3(256), 0, stream, p); break;
      case 6: hipLaunchKernelGGL(mk_phase<6>, dim3(grid), dim3(256), 0, stream, p); break;
      case 7: hipLaunchKernelGGL(mk_phase<7>, dim3(grid), dim3(256), 0, stream, p); break;
      case 8: hipLaunchKernelGGL(mk_phase<8>, dim3(grid), dim3(256), 0, stream, p); break;
      case 9: hipLaunchKernelGGL(mk_phase<9>, dim3(grid), dim3(256), 0, stream, p); break;
      case 10: hipLaunchKernelGGL(mk_phase<10>, dim3(grid), dim3(256), 0, stream, p); break;
      default: hipLaunchKernelGGL(mk_phase<11>, dim3(grid), dim3(256), 0, stream, p); break;
    }
  }
#endif
}
```

```cpp
#include <hip/hip_runtime.h>
#include <hip/hip_cooperative_groups.h>
#include <stdint.h>
#include <stdio.h>
namespace cg = cooperative_groups;

#ifndef N_LAUNCH_MODE
#define N_LAUNCH_MODE 1
#endif

#define DI __device__ __forceinline__
typedef unsigned short bf16_t;
typedef short bf16x8 __attribute__((ext_vector_type(8)));
typedef float f32x4 __attribute__((ext_vector_type(4)));
typedef unsigned u32x4 __attribute__((ext_vector_type(4)));
typedef unsigned u32x2 __attribute__((ext_vector_type(2)));
typedef float f32x2 __attribute__((ext_vector_type(2)));

constexpr int NB = 16, SEQ = 2048, DM = 1024, NL = 4, CTXL = 256;
constexpr int TL = NB * SEQ;
constexpr int TC = NB * CTXL;
constexpr int TT = TL + TC;
constexpr int PN_LD = 2176;
constexpr int C_GQ = 0, C_GK = 128, C_GR = 256, C_NQ = 512, C_NK = 768, C_DQ = 1024, C_DK = 1536, C_GATE = 2048;
constexpr int R_GV = 0, R_NV = 256, R_DV = 512;
constexpr float LOG2E = 1.4426950408889634f;
constexpr float SC_LOG2 = 0.125f * LOG2E;
constexpr float NEG_BIG = -1e30f;

constexpr size_t MiB = 1u << 20;
constexpr size_t OFF_CTL = 0;
constexpr size_t OFF_MOD = 1 * MiB;
constexpr size_t OFF_WIN = 3 * MiB;
constexpr size_t OFF_WOUT = 28 * MiB;
constexpr size_t OFF_WQ = 36 * MiB;
constexpr size_t OFF_SK = 44 * MiB;
constexpr size_t OFF_USCL = 44 * MiB + 256 * 1024;
constexpr size_t OFF_VSCL = 44 * MiB + 512 * 1024;
constexpr size_t OFF_U = 45 * MiB;
constexpr size_t OFF_V = 109 * MiB;
constexpr size_t OFF_XRES = 301 * MiB;
constexpr size_t OFF_H = 445 * MiB;
constexpr size_t OFF_P = 517 * MiB;
constexpr size_t OFF_VT = OFF_P + 153 * MiB;
constexpr size_t OFF_QP = OFF_P;
constexpr size_t OFF_EID = OFF_P + 72 * MiB;
constexpr size_t OFF_GATE = OFF_P + 90 * MiB;
constexpr size_t OFF_H8 = OFF_P + 126 * MiB;
constexpr size_t OFF_HINV = OFF_P + 162 * MiB;
constexpr size_t OFF_Y = 742 * MiB;
constexpr size_t WS_END = 814 * MiB;

constexpr int LDS_BYTES = 65536 + 8192;

struct Params {
  const float *x, *c, *ctx, *c_ctx, *ada_w, *ada_b, *norm1_g, *norm2_g, *w_in, *gate_up, *gate_b, *gla_norm_g,
      *rpb, *dlam, *diff_g, *w_out, *wq, *subkeys, *pu, *pv, *final_g;
  float* out;
  unsigned char* ws;
  int ph_lo, ph_hi;
};

DI int ltid() { int t = threadIdx.x; asm volatile("" : "+v"(t)); return t; }
DI int lbid() { int t = blockIdx.x; asm volatile("" : "+s"(t)); return t; }
DI int lgdim() { int t = gridDim.x; asm volatile("" : "+s"(t)); return t; }

DI unsigned f2bf(float f) { unsigned u = __float_as_uint(f); return (u + 0x7fffu + ((u >> 16) & 1u)) >> 16; }
DI unsigned pk2(float lo, float hi) { return f2bf(lo) | (f2bf(hi) << 16); }
DI float bflo(unsigned u) { return __uint_as_float(u << 16); }
DI float bfhi(unsigned u) { return __uint_as_float(u & 0xffff0000u); }
DI void unpack8(const u32x4 v, float* f) {
  f[0] = bflo(v.x); f[1] = bfhi(v.x); f[2] = bflo(v.y); f[3] = bfhi(v.y);
  f[4] = bflo(v.z); f[5] = bfhi(v.z); f[6] = bflo(v.w); f[7] = bfhi(v.w);
}
DI float wave_sum(float v) {
#pragma unroll
  for (int o = 32; o >= 1; o >>= 1) v += __shfl_xor(v, o);
  return v;
}
DI f32x4 mfma16(bf16x8 a, bf16x8 b, f32x4 c) { return __builtin_amdgcn_mfma_f32_16x16x32_bf16(a, b, c, 0, 0, 0); }

DI int win_src_col(int r) {
  if (r < 256) return r;
  if (r < 512) return r - 256 + 512;
  if (r < 768) return r - 512 + 800;
  if (r < 1024) return r - 768 + 1056;
  if (r < 1536) return r - 1024 + 1568;
  if (r < 2048) return r - 1536 + 2080;
  if (r < 2080) return r - 2048 + 768;
  if (r < 2176) return -1;
  if (r < 2432) return r - 2176 + 256;
  if (r < 2688) return r - 2432 + 1312;
  return r - 2688 + 2592;
}

DI void transpose_item(const float* __restrict__ W, int N, int src, bf16_t* __restrict__ dst, float* lds) {
  const int tid = ltid();
  for (int kc = 0; kc < 8; ++kc) {
    __syncthreads();
#pragma unroll
    for (int i = 0; i < 16; ++i) {
      int k = i * 8 + (tid >> 5), n = tid & 31;
      lds[k * 33 + n] = (src < 0) ? 0.f : W[(size_t)(kc * 128 + k) * N + src + n];
    }
    __syncthreads();
    int row = tid >> 3, k0 = (tid & 7) * 16;
    unsigned o[8];
#pragma unroll
    for (int e = 0; e < 8; ++e) o[e] = pk2(lds[(k0 + 2 * e) * 33 + row], lds[(k0 + 2 * e + 1) * 33 + row]);
    u32x4 a = {o[0], o[1], o[2], o[3]}, b = {o[4], o[5], o[6], o[7]};
    bf16_t* d = dst + (size_t)row * 1024 + kc * 128 + k0;
    *(u32x4*)d = a; *(u32x4*)(d + 8) = b;
  }
}

DI void phase_prologue(const Params& p, unsigned char* lds) {
  const int tid = ltid(), nb = lgdim(), bid = lbid();
  bf16_t* winT = (bf16_t*)(p.ws + OFF_WIN);
  bf16_t* woutT = (bf16_t*)(p.ws + OFF_WOUT);
  bf16_t* wqT = (bf16_t*)(p.ws + OFF_WQ);
  constexpr int PER_LAYER = 100 + 32 + 32;
  for (int item = bid; item < NL * PER_LAYER; item += nb) {
    int l = item / PER_LAYER, r = item % PER_LAYER;
    if (r < 100) {
      int row = r * 32;
      transpose_item(p.w_in + (size_t)l * 1024 * 3104, 3104, win_src_col(row), winT + ((size_t)l * 3200 + row) * 1024, (float*)lds);
    } else if (r < 132) {
      int row = (r - 100) * 32;
      transpose_item(p.w_out + (size_t)l * 1024 * 1024, 1024, row, woutT + ((size_t)l * 1024 + row) * 1024, (float*)lds);
    } else {
      int row = (r - 132) * 32;
      transpose_item(p.wq + (size_t)l * 1024 * 1024, 1024, row, wqT + ((size_t)l * 1024 + row) * 1024, (float*)lds);
    }
  }
  {
    const int lane = tid & 63, gw = bid * 4 + (tid >> 6), nw = nb * 4;
    unsigned char* u8 = p.ws + OFF_U;
    unsigned char* v8 = p.ws + OFF_V;
    float* uscl = (float*)(p.ws + OFF_USCL);
    float* vscl = (float*)(p.ws + OFF_VSCL);
    for (int row = gw; row < 2 * NL * 16384; row += nw) {
      const int tab = row >= NL * 16384, r = tab ? row - NL * 16384 : row;
      const float* src = (tab ? p.pv : p.pu) + (size_t)r * 1024 + 16 * lane;
      float4 f[4];
      float am = 0.f;
#pragma unroll
      for (int i = 0; i < 4; ++i) {
        f[i] = *(const float4*)(src + 4 * i);
        am = fmaxf(am, fmaxf(fmaxf(fabsf(f[i].x), fabsf(f[i].y)), fmaxf(fabsf(f[i].z), fabsf(f[i].w))));
      }
#pragma unroll
      for (int o = 32; o >= 1; o >>= 1) am = fmaxf(am, __shfl_xor(am, o));
      const float sc = am > 0.f ? 448.f / am : 0.f;
      u32x4 q;
#pragma unroll
      for (int i = 0; i < 4; ++i) {
        int pk = 0;
        pk = __builtin_amdgcn_cvt_pk_fp8_f32(f[i].x * sc, f[i].y * sc, pk, false);
        pk = __builtin_amdgcn_cvt_pk_fp8_f32(f[i].z * sc, f[i].w * sc, pk, true);
        q[i] = (unsigned)pk;
      }
      *(u32x4*)((tab ? v8 : u8) + (size_t)r * 1024 + 16 * lane) = q;
      if (lane == 0) (tab ? vscl : uscl)[r] = am * (1.f / 448.f);
    }
  }
  {
    bf16_t* sk = (bf16_t*)(p.ws + OFF_SK);
    for (int i = bid * 256 + tid; i < NL * 2 * 128 * 64; i += nb * 256) sk[i] = (bf16_t)f2bf(p.subkeys[i]);
  }
  {
    float* modbuf = (float*)(p.ws + OFF_MOD);
    float* sc = (float*)lds;
    float* red = (float*)(lds + 17 * 512 * 4);
    for (int item = bid; item < NL * 96; item += nb) {
      const int l = item / 96, cb = item % 96, col = cb * 64 + (tid & 63), kq = tid >> 6;
      float acc[17];
#pragma unroll
      for (int r = 0; r < 17; ++r) acc[r] = 0.f;
      for (int half = 0; half < 2; ++half) {
        __syncthreads();
        for (int e = tid; e < 17 * 512; e += 256) {
          int r = e >> 9, k = e & 511;
          float cv = (r < 16) ? p.c[r * 1024 + half * 512 + k] : p.c_ctx[half * 512 + k];
          sc[e] = cv / (1.f + __expf(-cv));
        }
        __syncthreads();
        const float* wp = p.ada_w + ((size_t)l * 1024 + half * 512 + kq * 128) * 6144 + col;
        for (int kk = 0; kk < 128; ++kk) {
          const float w = wp[(size_t)kk * 6144];
#pragma unroll
          for (int r = 0; r < 17; ++r) acc[r] += sc[r * 512 + kq * 128 + kk] * w;
        }
      }
#pragma unroll
      for (int r = 0; r < 17; ++r) red[(kq * 17 + r) * 64 + (tid & 63)] = acc[r];
      __syncthreads();
      for (int e = tid; e < 17 * 64; e += 256) {
        int r = e >> 6, cc = e & 63;
        float s = red[(0 * 17 + r) * 64 + cc] + red[(1 * 17 + r) * 64 + cc] + red[(2 * 17 + r) * 64 + cc] + red[(3 * 17 + r) * 64 + cc];
        int colg = cb * 64 + cc;
        modbuf[((size_t)l * 17 + r) * 6144 + colg] = s + p.ada_b[l * 6144 + colg];
      }
      __syncthreads();
    }
  }
}

DI void phase_norm(const Params& p, int l, int which, int ntok) {
  const int lane = ltid() & 63, gw = lbid() * 4 + (ltid() >> 6), nw = lgdim() * 4;
  const float* gvec = (which == 0 ? p.norm1_g : p.norm2_g) + l * 1024;
  const int ish = which == 0 ? 0 : 3, isc = which == 0 ? 1 : 4;
  const float* xres = (const float*)(p.ws + OFF_XRES);
  const float* modbuf = (const float*)(p.ws + OFF_MOD);
  bf16_t* hbuf = (bf16_t*)(p.ws + OFF_H);
  for (int t = gw; t < ntok; t += nw) {
    const float* src = (which == 0 && l == 0) ? (t < TL ? p.x + (size_t)t * 1024 : p.ctx + (size_t)(t - TL) * 1024) : xres + (size_t)t * 1024;
    const int b = t < TL ? (t >> 11) : 16;
    const float* md = modbuf + ((size_t)l * 17 + b) * 6144;
    float4 v[4];
    float ss = 0.f;
#pragma unroll
    for (int i = 0; i < 4; ++i) {
      v[i] = *(const float4*)(src + 4 * lane + 256 * i);
      ss += v[i].x * v[i].x + v[i].y * v[i].y + v[i].z * v[i].z + v[i].w * v[i].w;
    }
    ss = wave_sum(ss);
    const float rstd = rsqrtf(ss * (1.f / 1024.f) + 1e-6f);
    float am = 0.f;
#pragma unroll
    for (int i = 0; i < 4; ++i) {
      const int col = 4 * lane + 256 * i;
      const float4 g4 = *(const float4*)(gvec + col), sh = *(const float4*)(md + ish * 1024 + col), sc = *(const float4*)(md + isc * 1024 + col);
      float o0 = v[i].x * rstd * g4.x * (1.f + sc.x) + sh.x;
      float o1 = v[i].y * rstd * g4.y * (1.f + sc.y) + sh.y;
      float o2 = v[i].z * rstd * g4.z * (1.f + sc.z) + sh.z;
      float o3 = v[i].w * rstd * g4.w * (1.f + sc.w) + sh.w;
      u32x2 o = {pk2(o0, o1), pk2(o2, o3)};
      *(u32x2*)(hbuf + (size_t)t * 1024 + col) = o;
      v[i].x = o0; v[i].y = o1; v[i].z = o2; v[i].w = o3;
      am = fmaxf(am, fmaxf(fmaxf(fabsf(o0), fabsf(o1)), fmaxf(fabsf(o2), fabsf(o3))));
    }
    if (which == 1) {
#pragma unroll
      for (int o = 32; o >= 1; o >>= 1) am = fmaxf(am, __shfl_xor(am, o));
      const float qs = am > 0.f ? 448.f / am : 0.f;
      unsigned char* h8 = p.ws + OFF_H8 + (size_t)t * 1024;
#pragma unroll
      for (int i = 0; i < 4; ++i) {
        int pk = 0;
        pk = __builtin_amdgcn_cvt_pk_fp8_f32(v[i].x * qs, v[i].y * qs, pk, false);
        pk = __builtin_amdgcn_cvt_pk_fp8_f32(v[i].z * qs, v[i].w * qs, pk, true);
        *(int*)(h8 + 4 * lane + 256 * i) = pk;
      }
      if (lane == 0) ((float*)(p.ws + OFF_HINV))[t] = am * (1.f / 448.f);
    }
  }
}

template <int EPI>
DI void gemm_tile(const bf16_t* __restrict__ P, const bf16_t* __restrict__ Q, int it, int jt, void* outp, int ld,
                  const float* xin_lat, const float* xin_ctx, const float* modl, unsigned char* lds) {
  const int tid = ltid(), lane = tid & 63, w = tid >> 6, wi = w >> 1, wj = w & 1, lr = lane & 15, g = lane >> 4;
  unsigned char* Ps = lds;
  unsigned char* Qs = lds + 16384;
  f32x4 acc[4][4];
#pragma unroll
  for (int a = 0; a < 4; ++a)
#pragma unroll
    for (int b = 0; b < 4; ++b) acc[a][b] = (f32x4){0.f, 0.f, 0.f, 0.f};
  const int c = tid & 7, r0 = tid >> 3;
  const bf16_t* pg = P + (size_t)(it * 128 + r0) * 1024 + c * 8;
  const bf16_t* qg = Q + (size_t)(jt * 128 + r0) * 1024 + c * 8;
  u32x4 pr[4], qr[4];
#pragma unroll
  for (int ii = 0; ii < 4; ++ii) { pr[ii] = *(const u32x4*)(pg + (size_t)ii * 32 * 1024); qr[ii] = *(const u32x4*)(qg + (size_t)ii * 32 * 1024); }
  for (int kb = 0; kb < 16; ++kb) {
#pragma unroll
    for (int ii = 0; ii < 4; ++ii) {
      const int row = r0 + 32 * ii;
      const unsigned off = row * 128 + ((c ^ (row & 7)) << 4);
      *(u32x4*)(Ps + off) = pr[ii];
      *(u32x4*)(Qs + off) = qr[ii];
    }
    __syncthreads();
    if (kb < 15) {
#pragma unroll
      for (int ii = 0; ii < 4; ++ii) {
        pr[ii] = *(const u32x4*)(pg + (size_t)ii * 32 * 1024 + (kb + 1) * 64);
        qr[ii] = *(const u32x4*)(qg + (size_t)ii * 32 * 1024 + (kb + 1) * 64);
      }
    }
#pragma unroll
    for (int ks = 0; ks < 2; ++ks) {
      bf16x8 pf[4], qf[4];
      const int ch = ks * 4 + g;
#pragma unroll
      for (int mi = 0; mi < 4; ++mi) { const int row = wi * 64 + mi * 16 + lr; pf[mi] = *(const bf16x8*)(Ps + row * 128 + ((ch ^ (row & 7)) << 4)); }
#pragma unroll
      for (int nj = 0; nj < 4; ++nj) { const int row = wj * 64 + nj * 16 + lr; qf[nj] = *(const bf16x8*)(Qs + row * 128 + ((ch ^ (row & 7)) << 4)); }
#pragma unroll
      for (int mi = 0; mi < 4; ++mi)
#pragma unroll
        for (int nj = 0; nj < 4; ++nj) acc[mi][nj] = mfma16(pf[mi], qf[nj], acc[mi][nj]);
    }
    __syncthreads();
  }
#pragma unroll
  for (int mi = 0; mi < 4; ++mi)
#pragma unroll
    for (int nj = 0; nj < 4; ++nj) {
      const int j = jt * 128 + wj * 64 + nj * 16 + lr;
      const int i = it * 128 + wi * 64 + mi * 16 + 4 * g;
      const f32x4 a = acc[mi][nj];
      if (EPI == 0) {
        u32x2 o = {pk2(a[0], a[1]), pk2(a[2], a[3])};
        *(u32x2*)((bf16_t*)outp + (size_t)j * ld + i) = o;
      } else {
        const int b = j < TL ? (j >> 11) : 16;
        const float4 gt = *(const float4*)(modl + (size_t)b * 6144 + 2 * 1024 + i);
        const float* xs = (j < TL) ? xin_lat + (size_t)j * 1024 + i : xin_ctx + (size_t)(j - TL) * 1024 + i;
        const float4 xv = *(const float4*)xs;
        float4 o = {xv.x + gt.x * a[0], xv.y + gt.y * a[1], xv.z + gt.z * a[2], xv.w + gt.w * a[3]};
        *(float4*)((float*)outp + (size_t)j * 1024 + i) = o;
      }
    }
}

DI void phase_gemm_in(const Params& p, int l, unsigned char* lds) {
  const bf16_t* W = (const bf16_t*)(p.ws + OFF_WIN) + (size_t)l * 3200 * 1024;
  const bf16_t* H = (const bf16_t*)(p.ws + OFF_H);
  bf16_t* PN = (bf16_t*)(p.ws + OFF_P);
  bf16_t* VT = (bf16_t*)(p.ws + OFF_VT);
  constexpr int NJT = TT / 128;
  constexpr int T1 = NJT * 17, T2 = NJT * 8;
  for (int t = lbid(); t < T1 + T2; t += lgdim()) {
    if (t < T1) { const int jt = t / 17, it = t % 17; gemm_tile<0>(W, H, it, jt, PN, PN_LD, nullptr, nullptr, nullptr, lds); }
    else { const int u = t - T1; const int it = u >> 3, jt = u & 7; gemm_tile<0>(H, W + (size_t)2176 * 1024, it, jt, VT, TT, nullptr, nullptr, nullptr, lds); }
  }
}
DI void phase_gemm_out(const Params& p, int l, int ntok, unsigned char* lds) {
  const bf16_t* W = (const bf16_t*)(p.ws + OFF_WOUT) + (size_t)l * 1024 * 1024;
  const bf16_t* Y = (const bf16_t*)(p.ws + OFF_Y);
  float* xres = (float*)(p.ws + OFF_XRES);
  const float* modl = (const float*)(p.ws + OFF_MOD) + (size_t)l * 17 * 6144;
  const float* xl = (l == 0) ? p.x : xres;
  const float* xc = (l == 0) ? p.ctx : xres + (size_t)TL * 1024;
  const int ntile = (ntok / 128) * 8;
  for (int t = lbid(); t < ntile; t += lgdim()) {
    const int jt = t >> 3, it = t & 7;
    gemm_tile<1>(W, Y, it, jt, xres, 1024, xl, xc, modl, lds);
  }
}
DI void phase_gemm_q(const Params& p, int l, int ntok, unsigned char* lds) {
  const bf16_t* W = (const bf16_t*)(p.ws + OFF_WQ) + (size_t)l * 1024 * 1024;
  const bf16_t* H = (const bf16_t*)(p.ws + OFF_H);
  bf16_t* QP = (bf16_t*)(p.ws + OFF_QP);
  const int ntile = (ntok / 128) * 8;
  for (int t = lbid(); t < ntile; t += lgdim()) {
    const int jt = t >> 3, it = t & 7;
    gemm_tile<0>(W, H, it, jt, QP, 1024, nullptr, nullptr, nullptr, lds);
  }
}

DI void phase_rope(const Params& p, unsigned char* lds) {
  float2* tab = (float2*)lds;
  for (int e = ltid(); e < 1024; e += 256) {
    const int pos = e >> 4, i = e & 15;
    const float inv = exp2f(-(float)i * (13.287712379549449f / 16.f));
    const float ang = (float)pos * inv;
    tab[e] = make_float2(__cosf(ang), __sinf(ang));
  }
  __syncthreads();
  bf16_t* PN = (bf16_t*)(p.ws + OFF_P);
  const int total = TL * 16;
  for (int idx = lbid() * 256 + ltid(); idx < total; idx += lgdim() * 256) {
    const int t = idx >> 4, vec = idx & 15;
    const int col = ((vec >> 3) ? C_DK : C_DQ) + ((vec >> 1) & 3) * 128 + (vec & 1) * 64;
    bf16_t* ptr = PN + (size_t)t * PN_LD + col;
    float xv[64];
#pragma unroll
    for (int q = 0; q < 8; ++q) { const u32x4 v = *(const u32x4*)(ptr + q * 8); unpack8(v, xv + q * 8); }
    const int row = (t & 2047) >> 6, cp = t & 63;
#pragma unroll
    for (int i = 0; i < 16; ++i) {
      const float2 cs = tab[row * 16 + i];
      const float x1 = xv[i], x2 = xv[16 + i];
      xv[i] = x1 * cs.x - x2 * cs.y; xv[16 + i] = x2 * cs.x + x1 * cs.y;
      const float2 cs2 = tab[cp * 16 + i];
      const float y1 = xv[32 + i], y2 = xv[48 + i];
      xv[32 + i] = y1 * cs2.x - y2 * cs2.y; xv[48 + i] = y2 * cs2.x + y1 * cs2.y;
    }
#pragma unroll
    for (int q = 0; q < 8; ++q) {
      u32x4 o = {pk2(xv[q * 8], xv[q * 8 + 1]), pk2(xv[q * 8 + 2], xv[q * 8 + 3]), pk2(xv[q * 8 + 4], xv[q * 8 + 5]), pk2(xv[q * 8 + 6], xv[q * 8 + 7])};
      *(u32x4*)(ptr + q * 8) = o;
    }
  }
}

struct SrcSeg {
  const bf16_t* PN; const bf16_t* VT; int kcol, vrow, t0, n0, t1, n1, lr, g;
  const bf16_t* k0p; const bf16_t* k1p; const bf16_t* vp;
  DI int nsteps() const { return n0 + n1; }
  DI void setup(int st) {
    const int tok0 = st < n0 ? t0 + st * 32 : t1 + (st - n0) * 32;
    const int kap = 8 * (lr >> 2) + (lr & 3);
    k0p = PN + (size_t)(tok0 + kap) * PN_LD + kcol + 8 * g;
    k1p = k0p + (size_t)4 * PN_LD;
    vp = VT + (size_t)(vrow + lr) * TT + tok0 + 8 * g;
  }
  DI bf16x8 kfrag(int m, int kt, int ks) const { return *(const bf16x8*)((kt ? k1p : k0p) + m * 64 + ks * 32); }
  DI bf16x8 vfrag(int dt) const { return *(const bf16x8*)(vp + (size_t)dt * 16 * TT); }
  DI float score(float raw, int kt, int r) const { return raw * SC_LOG2; }
};
struct SrcNat {
  const bf16_t* PN; const bf16_t* VT; int kcol, vrow, b, rq, rs, cs, qc, cstart, lr, g, st_;
  const float* rpbh;
  const bf16_t* k0p; const bf16_t* k1p; const bf16_t* vp;
  DI int nsteps() const { return 16; }
  DI void setup(int st) {
    st_ = st;
    const int tok0 = st < 8 ? b * 2048 + (rs + st) * 64 + cs : TL + b * 256 + (st - 8) * 32;
    const int kap = 8 * (lr >> 2) + (lr & 3);
    k0p = PN + (size_t)(tok0 + kap) * PN_LD + kcol + 8 * g;
    k1p = k0p + (size_t)4 * PN_LD;
    vp = VT + (size_t)(vrow + lr) * TT + tok0 + 8 * g;
  }
  DI bf16x8 kfrag(int m, int kt, int ks) const { return *(const bf16x8*)((kt ? k1p : k0p) + ks * 32); }
  DI bf16x8 vfrag(int dt) const { return *(const bf16x8*)(vp + (size_t)dt * 16 * TT); }
  DI float score(float raw, int kt, int r) const {
    if (st_ >= 8) return raw * SC_LOG2;
    const int kc = cs + 8 * g + 4 * kt + r;
    const bool valid = (kc >= cstart) && (kc < cstart + 16);
    int dc = kc - qc + 15; dc = dc < 0 ? 0 : (dc > 30 ? 30 : dc);
    const float bias = rpbh[(rs + st_ - rq + 7) * 31 + dc];
    return valid ? (raw * 0.125f + bias) * LOG2E : NEG_BIG;
  }
};

template <int MAPS, int DVT, class Src>
DI void flash_wave(Src& S, const bf16_t* qptr  , f32x4 (&o)[MAPS][DVT], float (&ltot)[MAPS]) {
  bf16x8 qf[MAPS][2];
#pragma unroll
  for (int m = 0; m < MAPS; ++m)
#pragma unroll
    for (int ks = 0; ks < 2; ++ks) qf[m][ks] = *(const bf16x8*)(qptr + m * 64 + ks * 32);
  float mrun[MAPS], lrun[MAPS];
#pragma unroll
  for (int m = 0; m < MAPS; ++m) {
    mrun[m] = NEG_BIG; lrun[m] = 0.f;
#pragma unroll
    for (int dt = 0; dt < DVT; ++dt) o[m][dt] = (f32x4){0.f, 0.f, 0.f, 0.f};
  }
  const int ns = S.nsteps();
  for (int st = 0; st < ns; ++st) {
    S.setup(st);
    bf16x8 pf[MAPS];
#pragma unroll
    for (int m = 0; m < MAPS; ++m) {
      f32x4 s[2];
#pragma unroll
      for (int kt = 0; kt < 2; ++kt) {
        s[kt] = (f32x4){0.f, 0.f, 0.f, 0.f};
#pragma unroll
        for (int ks = 0; ks < 2; ++ks) s[kt] = mfma16(S.kfrag(m, kt, ks), qf[m][ks], s[kt]);
      }
      float mt = NEG_BIG;
#pragma unroll
      for (int kt = 0; kt < 2; ++kt)
#pragma unroll
        for (int r = 0; r < 4; ++r) { s[kt][r] = S.score(s[kt][r], kt, r); mt = fmaxf(mt, s[kt][r]); }
      mt = fmaxf(mt, __shfl_xor(mt, 16));
      mt = fmaxf(mt, __shfl_xor(mt, 32));
      const bool need = mt > mrun[m] + 8.f;
      if (__any(need)) {
        const float mnew = need ? mt : mrun[m];
        const float alpha = exp2f(mrun[m] - mnew);
        lrun[m] *= alpha;
#pragma unroll
        for (int dt = 0; dt < DVT; ++dt) { o[m][dt][0] *= alpha; o[m][dt][1] *= alpha; o[m][dt][2] *= alpha; o[m][dt][3] *= alpha; }
        mrun[m] = mnew;
      }
      float pv[8];
      float ls = 0.f;
#pragma unroll
      for (int kt = 0; kt < 2; ++kt)
#pragma unroll
        for (int r = 0; r < 4; ++r) { pv[kt * 4 + r] = exp2f(s[kt][r] - mrun[m]); ls += pv[kt * 4 + r]; }
      lrun[m] += ls;
      u32x4 pk = {pk2(pv[0], pv[1]), pk2(pv[2], pv[3]), pk2(pv[4], pv[5]), pk2(pv[6], pv[7])};
      pf[m] = __builtin_bit_cast(bf16x8, pk);
    }
#pragma unroll
    for (int dt = 0; dt < DVT; ++dt) {
      const bf16x8 vf = S.vfrag(dt);
#pragma unroll
      for (int m = 0; m < MAPS; ++m) o[m][dt] = mfma16(vf, pf[m], o[m][dt]);
    }
  }
#pragma unroll
  for (int m = 0; m < MAPS; ++m) {
    float l = lrun[m];
    l += __shfl_xor(l, 16);
    l += __shfl_xor(l, 32);
    ltot[m] = l;
  }
}

DI void diff_wave_task(const Params& p, int l, int b, int hd, int qtok0, bool ctx_only) {
  const int lane = ltid() & 63, lr = lane & 15, g = lane >> 4;
  const bf16_t* PN = (const bf16_t*)(p.ws + OFF_P);
  const bf16_t* VT = (const bf16_t*)(p.ws + OFF_VT);
  bf16_t* Y = (bf16_t*)(p.ws + OFF_Y);
  const float* lv = p.dlam + l * 256;
  float sa = lv[lane] * lv[64 + lane], sb = lv[128 + lane] * lv[192 + lane];
  sa = wave_sum(sa); sb = wave_sum(sb);
  const float lam_init = 0.8f - 0.6f * expf(-0.3f * (float)l);
  const float lam = expf(sa) - expf(sb) + lam_init;
  SrcSeg S;
  S.PN = PN; S.VT = VT; S.kcol = C_DK + hd * 128; S.vrow = R_DV + hd * 128; S.lr = lr; S.g = g;
  S.t0 = TL + b * 256; S.n0 = 8; S.t1 = b * 2048; S.n1 = ctx_only ? 0 : 64;
  f32x4 o[2][8];
  float lt[2];
  const int qtok = qtok0 + lr;
  flash_wave<2, 8, SrcSeg>(S, PN + (size_t)qtok * PN_LD + C_DQ + hd * 128 + 8 * g, o, lt);
  const float i0 = 1.f / lt[0], i1 = lam / lt[1];
  float ss = 0.f;
#pragma unroll
  for (int dt = 0; dt < 8; ++dt)
#pragma unroll
    for (int r = 0; r < 4; ++r) { const float v = o[0][dt][r] * i0 - o[1][dt][r] * i1; o[0][dt][r] = v; ss += v * v; }
  ss += __shfl_xor(ss, 16);
  ss += __shfl_xor(ss, 32);
  const float rstd = rsqrtf(ss * (1.f / 128.f) + 1e-6f) * (1.f - lam_init);
  const float* dg = p.diff_g + l * 512 + hd * 128;
#pragma unroll
  for (int dt = 0; dt < 8; ++dt) {
    const float4 gg = *(const float4*)(dg + dt * 16 + 4 * g);
    u32x2 ov = {pk2(o[0][dt][0] * rstd * gg.x, o[0][dt][1] * rstd * gg.y), pk2(o[0][dt][2] * rstd * gg.z, o[0][dt][3] * rstd * gg.w)};
    *(u32x2*)(Y + (size_t)qtok * 1024 + 512 + hd * 128 + dt * 16 + 4 * g) = ov;
  }
}


DI void diff_block_task(const Params& p, int l, int b, int hd, int qtok0, int nsteps, unsigned char* lds) {
  const int tid = ltid(), lane = tid & 63, w = tid >> 6, lr = lane & 15, g = lane >> 4;
  unsigned char* Kb = lds;
  unsigned char* Vb = lds + 16384;
  unsigned char* Qb = lds + 32768;
  const bf16_t* PN = (const bf16_t*)(p.ws + OFF_P);
  const bf16_t* VT = (const bf16_t*)(p.ws + OFF_VT);
  bf16_t* Y = (bf16_t*)(p.ws + OFF_Y);

  __syncthreads();
  {
    const int row = tid >> 1, hf = tid & 1;
    const bf16_t* src = PN + (size_t)(qtok0 + row) * PN_LD + C_DQ + hd * 128 + hf * 64;
#pragma unroll
    for (int c = 0; c < 8; ++c) {
      const u32x4 v = *(const u32x4*)(src + c * 8);
      const int ch = hf * 8 + c;
      *(u32x4*)(Qb + row * 256 + ((ch ^ (row & 15)) << 4)) = v;
    }
  }
  const int wu = __builtin_amdgcn_readfirstlane(w);
  unsigned kofs[2], vofs[2];
#pragma unroll
  for (int jj = 0; jj < 2; ++jj) {
    const int krow = 4 * (2 * w + jj) + (lane >> 4), kpc = lane & 15;
    const int kch = kpc ^ (((krow >> 3) & 3) * 4 + (krow & 3));
    kofs[jj] = (unsigned)(krow * PN_LD + C_DK + hd * 128 + kch * 8);
    const int vrow = 16 * (2 * w + jj) + (lane >> 2), vpc = lane & 3;
    const int vch = vpc ^ ((vrow >> 2) & 3);
    vofs[jj] = (unsigned)((R_DV + hd * 128 + vrow) * TT + vch * 8);
  }
#define DB_DMA(st, bf) do { const int tk = (st) < 8 ? TL + b * 256 + (st) * 32 : b * 2048 + ((st) - 8) * 32; \
    const bf16_t* kb_ = PN + (size_t)tk * PN_LD; const bf16_t* vb_ = VT + tk; \
    _Pragma("unroll") for (int jj = 0; jj < 2; ++jj) { \
      __builtin_amdgcn_global_load_lds((const unsigned*)(kb_ + kofs[jj]), (unsigned*)(Kb + (bf) * 8192 + (2 * wu + jj) * 1024), 16, 0, 0); \
      __builtin_amdgcn_global_load_lds((const unsigned*)(vb_ + vofs[jj]), (unsigned*)(Vb + (bf) * 8192 + (2 * wu + jj) * 1024), 16, 0, 0); } } while (0)
  DB_DMA(0, 0);
  asm volatile("s_waitcnt vmcnt(0)" ::: "memory");
  __syncthreads();

  f32x4 o[2][2][8];
  float mrun[2][2], lrun[2][2];
#pragma unroll
  for (int m = 0; m < 2; ++m)
#pragma unroll
    for (int qt = 0; qt < 2; ++qt) {
      mrun[m][qt] = NEG_BIG; lrun[m][qt] = 0.f;
#pragma unroll
      for (int dt = 0; dt < 8; ++dt) o[m][qt][dt] = (f32x4){0.f, 0.f, 0.f, 0.f};
    }
  const int kfr = 8 * (lr >> 2) + (lr & 3);
  for (int st = 0; st < nsteps; ++st) {
    if (st + 1 < nsteps) DB_DMA(st + 1, (st + 1) & 1);
    const unsigned char* Kt = Kb + (st & 1) * 8192;
    const unsigned char* Vt = Vb + (st & 1) * 8192;
    bf16x8 pf[2][2];
#pragma unroll
    for (int m = 0; m < 2; ++m) {
      bf16x8 kf[2][2];
#pragma unroll
      for (int kt = 0; kt < 2; ++kt)
#pragma unroll
        for (int ks = 0; ks < 2; ++ks) kf[kt][ks] = *(const bf16x8*)(Kt + (kfr + 4 * kt) * 256 + (((m * 8 + ks * 4 + g) ^ lr) << 4));
#pragma unroll
      for (int qt = 0; qt < 2; ++qt) {
        const int qrow = 32 * w + 16 * qt + lr;
        f32x4 s[2];
        s[0] = (f32x4){0.f, 0.f, 0.f, 0.f}; s[1] = s[0];
#pragma unroll
        for (int ks = 0; ks < 2; ++ks) {
          const bf16x8 qf = *(const bf16x8*)(Qb + qrow * 256 + (((m * 8 + ks * 4 + g) ^ lr) << 4));
          s[0] = mfma16(kf[0][ks], qf, s[0]);
          s[1] = mfma16(kf[1][ks], qf, s[1]);
        }
        float mt = NEG_BIG;
#pragma unroll
        for (int kt = 0; kt < 2; ++kt)
#pragma unroll
          for (int r = 0; r < 4; ++r) { s[kt][r] *= SC_LOG2; mt = fmaxf(mt, s[kt][r]); }
        mt = fmaxf(mt, __shfl_xor(mt, 16));
        mt = fmaxf(mt, __shfl_xor(mt, 32));
        const bool need = mt > mrun[m][qt] + 8.f;
        if (__any(need)) {
          const float mnew = need ? mt : mrun[m][qt];
          const float alpha = exp2f(mrun[m][qt] - mnew);
          lrun[m][qt] *= alpha;
#pragma unroll
          for (int dt = 0; dt < 8; ++dt) { o[m][qt][dt][0] *= alpha; o[m][qt][dt][1] *= alpha; o[m][qt][dt][2] *= alpha; o[m][qt][dt][3] *= alpha; }
          mrun[m][qt] = mnew;
        }
        float pv[8], ls = 0.f;
#pragma unroll
        for (int kt = 0; kt < 2; ++kt)
#pragma unroll
          for (int r = 0; r < 4; ++r) { pv[kt * 4 + r] = exp2f(s[kt][r] - mrun[m][qt]); ls += pv[kt * 4 + r]; }
        lrun[m][qt] += ls;
        u32x4 pk = {pk2(pv[0], pv[1]), pk2(pv[2], pv[3]), pk2(pv[4], pv[5]), pk2(pv[6], pv[7])};
        pf[m][qt] = __builtin_bit_cast(bf16x8, pk);
      }
    }
#pragma unroll
    for (int dt = 0; dt < 8; ++dt) {
      const int vr = 16 * dt + lr;
      const bf16x8 vf = *(const bf16x8*)(Vt + vr * 64 + ((g ^ ((vr >> 2) & 3)) << 4));
#pragma unroll
      for (int m = 0; m < 2; ++m)
#pragma unroll
        for (int qt = 0; qt < 2; ++qt) o[m][qt][dt] = mfma16(vf, pf[m][qt], o[m][qt][dt]);
    }
    asm volatile("s_waitcnt vmcnt(0)" ::: "memory");
    __syncthreads();
  }
#undef DB_DMA
  const float* lv = p.dlam + l * 256;
  float sa = lv[lane] * lv[64 + lane], sb = lv[128 + lane] * lv[192 + lane];
  sa = wave_sum(sa); sb = wave_sum(sb);
  const float lam_init = 0.8f - 0.6f * expf(-0.3f * (float)l);
  const float lam = expf(sa) - expf(sb) + lam_init;
  const float* dg = p.diff_g + l * 512 + hd * 128;
#pragma unroll
  for (int qt = 0; qt < 2; ++qt) {
    float l0 = lrun[0][qt], l1 = lrun[1][qt];
    l0 += __shfl_xor(l0, 16); l0 += __shfl_xor(l0, 32);
    l1 += __shfl_xor(l1, 16); l1 += __shfl_xor(l1, 32);
    const float i0 = 1.f / l0, i1 = lam / l1;
    float ss = 0.f;
#pragma unroll
    for (int dt = 0; dt < 8; ++dt)
#pragma unroll
      for (int r = 0; r < 4; ++r) { const float v = o[0][qt][dt][r] * i0 - o[1][qt][dt][r] * i1; o[0][qt][dt][r] = v; ss += v * v; }
    ss += __shfl_xor(ss, 16);
    ss += __shfl_xor(ss, 32);
    const float rstd = rsqrtf(ss * (1.f / 128.f) + 1e-6f) * (1.f - lam_init);
    const int qtok = qtok0 + 32 * w + 16 * qt + lr;
#pragma unroll
    for (int dt = 0; dt < 8; ++dt) {
      const float4 gg = *(const float4*)(dg + dt * 16 + 4 * g);
      u32x2 ov = {pk2(o[0][qt][dt][0] * rstd * gg.x, o[0][qt][dt][1] * rstd * gg.y), pk2(o[0][qt][dt][2] * rstd * gg.z, o[0][qt][dt][3] * rstd * gg.w)};
      *(u32x2*)(Y + (size_t)qtok * 1024 + 512 + hd * 128 + dt * 16 + 4 * g) = ov;
    }
  }
}

DI void nat_wave_task(const Params& p, int l, int b, int head, int rq, int ct, const float* rpb_lds) {
  const int lane = ltid() & 63, lr = lane & 15, g = lane >> 4;
  const bf16_t* PN = (const bf16_t*)(p.ws + OFF_P);
  const bf16_t* VT = (const bf16_t*)(p.ws + OFF_VT);
  bf16_t* Y = (bf16_t*)(p.ws + OFF_Y);
  SrcNat S;
  S.PN = PN; S.VT = VT; S.kcol = C_NK + head * 64; S.vrow = R_NV + head * 64; S.b = b; S.rq = rq; S.lr = lr; S.g = g;
  int rs = rq - 4; rs = rs < 0 ? 0 : (rs > 24 ? 24 : rs);
  S.rs = rs;
  int cs = 16 * ct - 8; cs = cs < 0 ? 0 : (cs > 32 ? 32 : cs);
  S.cs = cs;
  S.qc = 16 * ct + lr;
  int cst = S.qc - 8; cst = cst < 0 ? 0 : (cst > 48 ? 48 : cst);
  S.cstart = cst;
  S.rpbh = rpb_lds + head * 465;
  f32x4 o[1][4];
  float lt[1];
  const int qtok = b * 2048 + rq * 64 + 16 * ct + lr;
  flash_wave<1, 4, SrcNat>(S, PN + (size_t)qtok * PN_LD + C_NQ + head * 64 + 8 * g, o, lt);
  const float inv = 1.f / lt[0];
#pragma unroll
  for (int dt = 0; dt < 4; ++dt) {
    u32x2 ov = {pk2(o[0][dt][0] * inv, o[0][dt][1] * inv), pk2(o[0][dt][2] * inv, o[0][dt][3] * inv)};
    *(u32x2*)(Y + (size_t)qtok * 1024 + 256 + head * 64 + dt * 16 + 4 * g) = ov;
  }
}
DI void natctx_wave_task(const Params& p, int b, int head, int qt) {
  const int lane = ltid() & 63, lr = lane & 15, g = lane >> 4;
  const bf16_t* PN = (const bf16_t*)(p.ws + OFF_P);
  const bf16_t* VT = (const bf16_t*)(p.ws + OFF_VT);
  bf16_t* Y = (bf16_t*)(p.ws + OFF_Y);
  SrcSeg S;
  S.PN = PN; S.VT = VT; S.kcol = C_NK + head * 64; S.vrow = R_NV + head * 64; S.lr = lr; S.g = g;
  S.t0 = TL + b * 256; S.n0 = 8; S.t1 = 0; S.n1 = 0;
  f32x4 o[1][4];
  float lt[1];
  const int qtok = TL + b * 256 + qt * 16 + lr;
  flash_wave<1, 4, SrcSeg>(S, PN + (size_t)qtok * PN_LD + C_NQ + head * 64 + 8 * g, o, lt);
  const float inv = 1.f / lt[0];
#pragma unroll
  for (int dt = 0; dt < 4; ++dt) {
    u32x2 ov = {pk2(o[0][dt][0] * inv, o[0][dt][1] * inv), pk2(o[0][dt][2] * inv, o[0][dt][3] * inv)};
    *(u32x2*)(Y + (size_t)qtok * 1024 + 256 + head * 64 + dt * 16 + 4 * g) = ov;
  }
}

DI void gla_task(const Params& p, int l, int task, unsigned char* lds) {
  const int tid = ltid(), lane = tid & 63, w = tid >> 6, vv = lane & 15, g = lane >> 4;
  const int b = task >> 3, h = (task >> 1) & 3, dir = task & 1;
  const bf16_t* PN = (const bf16_t*)(p.ws + OFF_P);
  const bf16_t* VT = (const bf16_t*)(p.ws + OFF_VT);
  float* og = (float*)(p.ws + OFF_H);
  float* Gup = (float*)lds;
  float* Gb = Gup + 512;
  float* As = Gb + 32;
  float* Ks = As + 2048;
  float* Qs = Ks + 2048;
  float* Vs = Qs + 2048;
  __syncthreads();
  for (int e = tid; e < 512; e += 256) { const int r = e >> 5, kd = e & 31; Gup[e] = p.gate_up[((size_t)(l * 2 + dir) * 16 + r) * 128 + h * 32 + kd]; }
  if (tid < 32) Gb[tid] = p.gate_b[(l * 2 + dir) * 128 + h * 32 + tid];
  float S[8];
#pragma unroll
  for (int e = 0; e < 8; ++e) S[e] = 0.f;
  for (int cc = 0; cc < 36; ++cc) {
    int tok0;
    if (cc < 4) { const int ch = dir == 0 ? cc : 3 - cc; tok0 = TL + b * 256 + ch * 64; }
    else { const int ch = dir == 0 ? cc - 4 : 35 - cc; tok0 = b * 2048 + ch * 64; }
    __syncthreads();
    {
      const int i = tid >> 2, part = tid & 3;
      const bf16_t* row = PN + (size_t)(tok0 + i) * PN_LD;
      const u32x4 qv = *(const u32x4*)(row + C_GQ + h * 32 + part * 8);
      const u32x4 kv = *(const u32x4*)(row + C_GK + h * 32 + part * 8);
      const u32x4 g0 = *(const u32x4*)(row + C_GATE + dir * 16);
      const u32x4 g1 = *(const u32x4*)(row + C_GATE + dir * 16 + 8);
      float gd[16], qf[8], kf[8];
      unpack8(g0, gd); unpack8(g1, gd + 8); unpack8(qv, qf); unpack8(kv, kf);
#pragma unroll
      for (int e = 0; e < 8; ++e) {
        const int kd = part * 8 + e;
        float pre = Gb[kd];
#pragma unroll
        for (int r = 0; r < 16; ++r) pre += gd[r] * Gup[r * 32 + kd];
        const float ls = fminf(pre, 0.f) - log1pf(__expf(-fabsf(pre)));
        As[i * 32 + kd] = __expf(ls * (1.f / 16.f));
        Ks[i * 32 + kd] = kf[e];
        Qs[i * 32 + kd] = qf[e] * 0.17677669529663687f;
      }
      const int v = tid >> 2;
      const bf16_t* vp = VT + (size_t)(R_GV + h * 64 + v) * TT + tok0 + part * 16;
      const u32x4 v0 = *(const u32x4*)vp, v1 = *(const u32x4*)(vp + 8);
      float vf[16];
      unpack8(v0, vf); unpack8(v1, vf + 8);
#pragma unroll
      for (int e = 0; e < 16; ++e) Vs[(part * 16 + e) * 65 + v] = vf[e];
    }
    __syncthreads();
    for (int s = 0; s < 64; ++s) {
      const int i = dir == 0 ? s : 63 - s;
      const float4 a0 = *(const float4*)(As + i * 32 + 8 * g), a1 = *(const float4*)(As + i * 32 + 8 * g + 4);
      const float4 k0 = *(const float4*)(Ks + i * 32 + 8 * g), k1 = *(const float4*)(Ks + i * 32 + 8 * g + 4);
      const float4 q0 = *(const float4*)(Qs + i * 32 + 8 * g), q1 = *(const float4*)(Qs + i * 32 + 8 * g + 4);
      const float v = Vs[i * 65 + 16 * w + vv];
      S[0] = a0.x * S[0] + k0.x * v; S[1] = a0.y * S[1] + k0.y * v; S[2] = a0.z * S[2] + k0.z * v; S[3] = a0.w * S[3] + k0.w * v;
      S[4] = a1.x * S[4] + k1.x * v; S[5] = a1.y * S[5] + k1.y * v; S[6] = a1.z * S[6] + k1.z * v; S[7] = a1.w * S[7] + k1.w * v;
      float o = q0.x * S[0] + q0.y * S[1] + q0.z * S[2] + q0.w * S[3] + q1.x * S[4] + q1.y * S[5] + q1.z * S[6] + q1.w * S[7];
      o += __shfl_xor(o, 16);
      o += __shfl_xor(o, 32);
      if (g == 0) og[((size_t)dir * TT + tok0 + i) * 256 + h * 64 + 16 * w + vv] = o;
    }
  }
}

DI void phase_mixers(const Params& p, int l, bool last, unsigned* ctr, unsigned char* lds) {
  const int tid = ltid(), w = tid >> 6;
  volatile int* slot = (volatile int*)(lds + LDS_BYTES - 16);
  float* rpb_lds = (float*)(lds + 65536);
  for (int e = tid; e < 4 * 465; e += 256) rpb_lds[e] = p.rpb[(size_t)l * 4 * 465 + e];
  const int ntask = 128 + 1024 + 2048 + (last ? 0 : 128 + 256);
  for (;;) {
    __syncthreads();
    if (tid == 0) *slot = (int)atomicAdd(ctr, 1u);
    __syncthreads();
    const int task = *slot;
    if (task >= ntask) break;
    if (task < 128) { gla_task(p, l, task, lds); }
    else if (task < 128 + 1024) { const int d = task - 128; const int b = d >> 6; diff_block_task(p, l, b, (d >> 4) & 3, b * 2048 + (d & 15) * 128, 72, lds); }
    else if (task < 128 + 1024 + 2048) { const int wt = (task - 128 - 1024) * 4 + w; nat_wave_task(p, l, wt >> 9, (wt >> 7) & 3, (wt >> 2) & 31, wt & 3, rpb_lds); }
    else if (task < 128 + 1024 + 2048 + 128) { const int d = task - 128 - 1024 - 2048; const int b = d >> 3; diff_block_task(p, l, b, (d >> 1) & 3, TL + b * 256 + (d & 1) * 128, 8, lds); }
    else { const int wt = (task - 128 - 1024 - 2048 - 128) * 4 + w; natctx_wave_task(p, wt >> 6, (wt >> 4) & 3, wt & 15); }
  }
}

DI void phase_gla_fin(const Params& p, int l, int ntok) {
  const int lane = ltid() & 63, gw = lbid() * 4 + (ltid() >> 6), nw = lgdim() * 4;
  const float* og = (const float*)(p.ws + OFF_H);
  const bf16_t* PN = (const bf16_t*)(p.ws + OFF_P);
  bf16_t* Y = (bf16_t*)(p.ws + OFF_Y);
  const float4 gg = *(const float4*)(p.gla_norm_g + l * 256 + 4 * lane);
  for (int t = gw; t < ntok; t += nw) {
    const float4 a = *(const float4*)(og + (size_t)t * 256 + 4 * lane), bq = *(const float4*)(og + ((size_t)TT + t) * 256 + 4 * lane);
    const float o0 = a.x + bq.x, o1 = a.y + bq.y, o2 = a.z + bq.z, o3 = a.w + bq.w;
    float ss = o0 * o0 + o1 * o1 + o2 * o2 + o3 * o3;
    ss += __shfl_xor(ss, 1); ss += __shfl_xor(ss, 2); ss += __shfl_xor(ss, 4); ss += __shfl_xor(ss, 8);
    const float rstd = rsqrtf(ss * (1.f / 64.f) + 1e-6f);
    const u32x2 rv = *(const u32x2*)(PN + (size_t)t * PN_LD + C_GR + 4 * lane);
    const float r0 = bflo(rv.x), r1 = bfhi(rv.x), r2 = bflo(rv.y), r3 = bfhi(rv.y);
    const float y0 = o0 * rstd * gg.x * (r0 / (1.f + __expf(-r0)));
    const float y1 = o1 * rstd * gg.y * (r1 / (1.f + __expf(-r1)));
    const float y2 = o2 * rstd * gg.z * (r2 / (1.f + __expf(-r2)));
    const float y3 = o3 * rstd * gg.w * (r3 / (1.f + __expf(-r3)));
    u32x2 ov = {pk2(y0, y1), pk2(y2, y3)};
    *(u32x2*)(Y + (size_t)t * 1024 + 4 * lane) = ov;
  }
}

struct PairTab { int a[52], b[52]; };
constexpr PairTab make_pairs() {
  PairTab t{};
  int n = 0;
  for (int a = 0; a < 16; ++a)
    for (int b = 0; b < 16; ++b)
      if ((a + 1) * (b + 1) <= 16) { t.a[n] = a; t.b[n] = b; ++n; }
  for (; n < 52; ++n) { t.a[n] = -1; t.b[n] = -1; }
  return t;
}

DI void topk_half(const bf16_t* skh  , const bf16_t* qrow  , int lr, int g, float (&list)[16]) {
  bf16x8 qf[2];
  qf[0] = *(const bf16x8*)(qrow); qf[1] = *(const bf16x8*)(qrow + 32);
  float s[32];
#pragma unroll
  for (int nt = 0; nt < 8; ++nt) {
    f32x4 acc = {0.f, 0.f, 0.f, 0.f};
#pragma unroll
    for (int ks = 0; ks < 2; ++ks) {
      const bf16x8 af = *(const bf16x8*)(skh + (size_t)(nt * 16 + lr) * 64 + ks * 32 + 8 * g);
      acc = mfma16(af, qf[ks], acc);
    }
#pragma unroll
    for (int r = 0; r < 4; ++r) {
      const unsigned n = nt * 16 + 4 * g + r;
      s[nt * 4 + r] = __uint_as_float((__float_as_uint(acc[r]) & ~127u) | n);
    }
  }
#pragma unroll
  for (int k = 0; k < 16; ++k) {
    float m = s[0];
#pragma unroll
    for (int i = 1; i < 32; ++i) m = fmaxf(m, s[i]);
    m = fmaxf(m, __shfl_xor(m, 16));
    m = fmaxf(m, __shfl_xor(m, 32));
    list[k] = m;
#pragma unroll
    for (int i = 0; i < 32; ++i) s[i] = (s[i] == m) ? -3.0e38f : s[i];
  }
}

DI void phase_topk(const Params& p, int l, int ntok) {
  constexpr PairTab PT = make_pairs();
  const int lane = ltid() & 63, lr = lane & 15, g = lane >> 4;
  const int gw = lbid() * 4 + (ltid() >> 6), nw = lgdim() * 4;
  const bf16_t* QP = (const bf16_t*)(p.ws + OFF_QP);
  const bf16_t* sk = (const bf16_t*)(p.ws + OFF_SK) + (size_t)l * 2 * 128 * 64;
  int* eid = (int*)(p.ws + OFF_EID);
  float* gate = (float*)(p.ws + OFF_GATE);
  const int ntask = (ntok / 16) * 8;
  for (int task = gw; task < ntask; task += nw) {
    const int tt = task >> 3, hd = task & 7;
    const int tok = tt * 16 + lr;
    float v1[16], v2[16];
    topk_half(sk, QP + (size_t)tok * 1024 + hd * 128 + 8 * g, lr, g, v1);
    topk_half(sk + 128 * 64, QP + (size_t)tok * 1024 + hd * 128 + 64 + 8 * g, lr, g, v2);
    float cand[13];
    int ceid[13];
#pragma unroll
    for (int c = 0; c < 13; ++c) {
      float sv[4];
      int ev[4];
#pragma unroll
      for (int gi = 0; gi < 4; ++gi) {
        const int pi = 4 * c + gi;
        if (PT.a[pi] >= 0) {
          const float a = v1[PT.a[pi] < 0 ? 0 : PT.a[pi]], bq = v2[PT.b[pi] < 0 ? 0 : PT.b[pi]];
          sv[gi] = __uint_as_float((__float_as_uint(a + bq) & ~63u) | (unsigned)pi);
          ev[gi] = (int)((__float_as_uint(a) & 127u) * 128u + (__float_as_uint(bq) & 127u));
        } else { sv[gi] = -3.0e38f; ev[gi] = 0; }
      }
      cand[c] = g == 0 ? sv[0] : (g == 1 ? sv[1] : (g == 2 ? sv[2] : sv[3]));
      ceid[c] = g == 0 ? ev[0] : (g == 1 ? ev[1] : (g == 2 ? ev[2] : ev[3]));
    }
    float topv[16];
#pragma unroll
    for (int k = 0; k < 16; ++k) {
      float m = cand[0];
#pragma unroll
      for (int c = 1; c < 13; ++c) m = fmaxf(m, cand[c]);
      m = fmaxf(m, __shfl_xor(m, 16));
      m = fmaxf(m, __shfl_xor(m, 32));
      topv[k] = m;
      int my = -1;
#pragma unroll
      for (int c = 0; c < 13; ++c) { if (cand[c] == m) { my = ceid[c]; cand[c] = -3.0e38f; } }
      if (my >= 0) eid[(size_t)tok * 128 + hd * 16 + k] = my;
    }
    if (g == 0) {
      float ex[16], sum = 0.f;
#pragma unroll
      for (int k = 0; k < 16; ++k) { ex[k] = __expf(topv[k] - topv[0]); sum += ex[k]; }
      const float inv = 1.f / sum;
#pragma unroll
      for (int q = 0; q < 4; ++q) {
        float4 o = {ex[4 * q] * inv, ex[4 * q + 1] * inv, ex[4 * q + 2] * inv, ex[4 * q + 3] * inv};
        *(float4*)(gate + (size_t)tok * 128 + hd * 16 + 4 * q) = o;
      }
    }
  }
}

DI float gelu_tanh(float x) {
  const float z = 0.7978845608028654f * (x + 0.044715f * x * x * x);
  const float e = __expf(2.f * z);
  const float th = 1.f - 2.f / (e + 1.f);
  return 0.5f * x * (1.f + th);
}
DI void phase_gather(const Params& p, int l, int ntok, unsigned char* lds, bool dry = false) {
  const int tid = ltid(), lane = tid & 63, w = tid >> 6, lr = lane & 15, g = lane >> 4;
  const int gw = lbid() * 4 + w, nw = lgdim() * 4;
  const unsigned char* U8 = p.ws + OFF_U + (size_t)l * 16384 * 1024;
  const unsigned char* V8 = p.ws + OFF_V + (size_t)l * 16384 * 1024;
  const float* uscl = (const float*)(p.ws + OFF_USCL) + l * 16384;
  const float* vscl = (const float*)(p.ws + OFF_VSCL) + l * 16384;
  const unsigned char* H8 = p.ws + OFF_H8;
  const float* hinv = (const float*)(p.ws + OFF_HINV);
  const int* eid = (const int*)(p.ws + OFF_EID);
  const float* gate = (const float*)(p.ws + OFF_GATE);
  float* xres = (float*)(p.ws + OFF_XRES);
  const float* modbuf = (const float*)(p.ws + OFF_MOD);
  unsigned char* hl = lds + w * 1024;
  for (int t = gw; t < ntok; t += nw) {
    {
      const u32x4 hq = *(const u32x4*)(H8 + (size_t)t * 1024 + lane * 16);
      *(u32x4*)(hl + lane * 16) = hq;
    }
    const float hs = hinv[t];
    const int e0 = eid[(size_t)t * 128 + lane], e1 = eid[(size_t)t * 128 + 64 + lane];
    const float su0 = uscl[e0] * hs, su1 = uscl[e1] * hs;
    const float gv0 = gate[(size_t)t * 128 + lane] * vscl[e0], gv1 = gate[(size_t)t * 128 + 64 + lane] * vscl[e1];
    float out[16];
#pragma unroll
    for (int i = 0; i < 16; ++i) out[i] = 0.f;
#pragma unroll 1
    for (int grp = 0; grp < 8; ++grp) {
      const int esel = grp < 4 ? e0 : e1;
      const float susel = grp < 4 ? su0 : su1, gvsel = grp < 4 ? gv0 : gv1;
      const int lb = (grp & 3) * 16;
      const int erow = __shfl(esel, lb + lr);
      const unsigned char* ur = U8 + (size_t)erow * 1024 + g * 16;
      u32x4 ub[16], va[8];
#pragma unroll
      for (int c = 0; c < 16; ++c) ub[c] = *(const u32x4*)(ur + c * 64);
#pragma unroll
      for (int j = 0; j < 8; ++j) {
        const int ej = __builtin_amdgcn_readlane(esel, lb + j);
        va[j] = *(const u32x4*)(V8 + (size_t)ej * 1024 + lane * 16);
      }
      f32x4 acc = {0.f, 0.f, 0.f, 0.f};
#pragma unroll
      for (int c = 0; c < 16; ++c) {
        const long b0 = *(const long*)(hl + c * 64 + g * 16), b1 = *(const long*)(hl + c * 64 + g * 16 + 8);
        const long a0 = __builtin_bit_cast(long, (u32x2){ub[c].x, ub[c].y}), a1 = __builtin_bit_cast(long, (u32x2){ub[c].z, ub[c].w});
        acc = __builtin_amdgcn_mfma_f32_16x16x32_fp8_fp8(a0, b0, acc, 0, 0, 0);
        acc = __builtin_amdgcn_mfma_f32_16x16x32_fp8_fp8(a1, b1, acc, 0, 0, 0);
        if ((c & 3) == 3) __builtin_amdgcn_sched_barrier(0);
      }
      u32x4 vb[8];
#pragma unroll
      for (int j = 0; j < 8; ++j) {
        const int ej = __builtin_amdgcn_readlane(esel, lb + 8 + j);
        vb[j] = *(const u32x4*)(V8 + (size_t)ej * 1024 + lane * 16);
      }
      float wv[4];
#pragma unroll
      for (int r = 0; r < 4; ++r) {
        const float sur = __shfl(susel, lb + 4 * g + r), gvr = __shfl(gvsel, lb + 4 * g + r);
        wv[r] = gvr * gelu_tanh(acc[r] * sur);
      }
#pragma unroll
      for (int j = 0; j < 16; ++j) {
        const float wj = __int_as_float(__builtin_amdgcn_readlane(__float_as_int(wv[j & 3]), 16 * (j >> 2)));
        const u32x4 vv = j < 8 ? va[j & 7] : vb[j & 7];
#pragma unroll
        for (int q = 0; q < 4; ++q) {
          const f32x2 lo = __builtin_amdgcn_cvt_pk_f32_fp8((int)vv[q], false), hi = __builtin_amdgcn_cvt_pk_f32_fp8((int)vv[q], true);
          out[4 * q + 0] += wj * lo[0]; out[4 * q + 1] += wj * lo[1]; out[4 * q + 2] += wj * hi[0]; out[4 * q + 3] += wj * hi[1];
        }
      }
    }
    const int b = t < TL ? (t >> 11) : 16;
    const float* md = modbuf + ((size_t)l * 17 + b) * 6144 + 5 * 1024 + 16 * lane;
    float* xr = xres + (size_t)t * 1024 + 16 * lane;
#pragma unroll
    for (int q = 0; q < 4; ++q) {
      const float4 m4 = *(const float4*)(md + 4 * q);
      float4 xv = *(const float4*)(xr + 4 * q);
      xv.x += m4.x * out[4 * q + 0]; xv.y += m4.y * out[4 * q + 1]; xv.z += m4.z * out[4 * q + 2]; xv.w += m4.w * out[4 * q + 3];
      if (!dry) *(float4*)(xr + 4 * q) = xv;
      else asm volatile("" :: "v"(xv.x), "v"(xv.y), "v"(xv.z), "v"(xv.w));
    }
  }
}

DI void phase_final(const Params& p) {
  const int lane = ltid() & 63, gw = lbid() * 4 + (ltid() >> 6), nw = lgdim() * 4;
  const float* xres = (const float*)(p.ws + OFF_XRES);
  for (int t = gw; t < TL; t += nw) {
    const float* src = xres + (size_t)t * 1024;
    float4 v[4];
    float ss = 0.f;
#pragma unroll
    for (int i = 0; i < 4; ++i) {
      v[i] = *(const float4*)(src + 4 * lane + 256 * i);
      ss += v[i].x * v[i].x + v[i].y * v[i].y + v[i].z * v[i].z + v[i].w * v[i].w;
    }
    ss = wave_sum(ss);
    const float rstd = rsqrtf(ss * (1.f / 1024.f) + 1e-6f);
#pragma unroll
    for (int i = 0; i < 4; ++i) {
      const int col = 4 * lane + 256 * i;
      const float4 g4 = *(const float4*)(p.final_g + col);
      float4 o = {v[i].x * rstd * g4.x, v[i].y * rstd * g4.y, v[i].z * rstd * g4.z, v[i].w * rstd * g4.w};
      *(float4*)(p.out + (size_t)t * 1024 + col) = o;
    }
  }
}


#define LAS __attribute__((address_space(3)))
#define XB_TMO      128
#define XB_XCNT(j)  (256  + 64 * (j))
#define XB_XSUB(j)  (1280 + 64 * (j))
#define XB_XGEN(j)  (2304 + 64 * (j))
#define XB_TOP      3328
#define XB_TOPGEN   3392
#define XCD_BAR_WORDS 3456
#define XB_SPIN_CAP (1u << 22)
DI unsigned xb_ld(unsigned* p) { return __hip_atomic_load(p, __ATOMIC_RELAXED, __HIP_MEMORY_SCOPE_AGENT); }
DI unsigned xb_add(unsigned* p, unsigned v) { return __hip_atomic_fetch_add(p, v, __ATOMIC_RELAXED, __HIP_MEMORY_SCOPE_AGENT); }
DI unsigned xb_xcc_id() { return (unsigned)__builtin_amdgcn_s_getreg((3 << 11) | 20) & 0xFu; }
#define XB_SPIN(cond, bar) do { unsigned _sp = 0; while (cond) { __builtin_amdgcn_s_sleep(1); \
    if ((++_sp & 255u) == 0u) { if (xb_ld(&(bar)[XB_TMO])) break; if (_sp > XB_SPIN_CAP) { atomicAdd(&(bar)[XB_TMO], 1u); break; } } } } while (0)
struct XcdBarrier { unsigned* bar; unsigned x; volatile unsigned* st; };
DI XcdBarrier xcd_barrier_post(unsigned* bar, volatile unsigned* st) {
  XcdBarrier b; b.bar = bar; b.x = xb_xcc_id(); b.st = st;
  if (threadIdx.x == 0) (void)xb_add(&bar[XB_XCNT(b.x)], 1u);
  return b;
}
DI void xcd_barrier_complete(unsigned* bar, unsigned x, unsigned& nloc, unsigned& nx) {
  const unsigned G = gridDim.x * gridDim.y * gridDim.z;
  unsigned sum, cnt, mine, sp = 0u;
  for (;;) {
    sum = 0u; cnt = 0u; mine = 0u;
#pragma unroll
    for (unsigned j = 0; j < 16; ++j) { const unsigned c = xb_ld(&bar[XB_XCNT(j)]); sum += c; cnt += (c > 0u) ? 1u : 0u; mine = (j == x) ? c : mine; }
    if (sum == G) break;
    __builtin_amdgcn_s_sleep(1);
    if ((++sp & 255u) == 0u) { if (xb_ld(&bar[XB_TMO])) break; if (sp > XB_SPIN_CAP) { atomicAdd(&bar[XB_TMO], 1u); break; } }
  }
  nloc = mine > 0u ? mine : 1u; nx = cnt > 0u ? cnt : 1u;
}
DI void xcd_barrier(const XcdBarrier& b) {
  asm volatile("s_waitcnt vmcnt(0)" ::: "memory");
  __syncthreads();
  if (threadIdx.x == 0) {
    unsigned* bar = b.bar;
    __builtin_amdgcn_s_waitcnt(0);
    unsigned nloc = b.st[0], nx = b.st[1];
    if (nloc == 0u) { xcd_barrier_complete(bar, b.x, nloc, nx); b.st[0] = nloc; b.st[1] = nx; }
    const unsigned old = xb_add(&bar[XB_XSUB(b.x)], 1u);
    const unsigned gen = old / nloc;
    if (old + 1u == (gen + 1u) * nloc) {
      __builtin_amdgcn_fence(__ATOMIC_RELEASE, "agent");
      asm volatile("s_waitcnt vmcnt(0)" ::: "memory");
      const unsigned og = xb_add(&bar[XB_TOP], 1u);
      const unsigned tg = og / nx;
      if (og + 1u == (tg + 1u) * nx) xb_add(&bar[XB_TOPGEN], 1u);
      else XB_SPIN(xb_ld(&bar[XB_TOPGEN]) == tg, bar);
      __builtin_amdgcn_fence(__ATOMIC_ACQUIRE, "agent");
      xb_add(&bar[XB_XGEN(b.x)], 1u);
      asm volatile("s_waitcnt vmcnt(0)" ::: "memory");
    } else {
      XB_SPIN(xb_ld(&bar[XB_XGEN(b.x)]) == gen, bar);
      __builtin_amdgcn_fence(__ATOMIC_ACQUIRE, "agent");
      asm volatile("s_waitcnt vmcnt(0)" ::: "memory");
    }
  }
  __syncthreads();
}

constexpr int PH_PER_LAYER = 10;
constexpr int N_PHASES = 1 + NL * PH_PER_LAYER + 1;

template <int KIND>
DI void run_phase(const Params& p, int ph, unsigned char* lds) {
  unsigned* ctl = (unsigned*)(p.ws + OFF_CTL);
  if (ph == 0) { if (KIND < 0 || KIND == 0) phase_prologue(p, lds); }
  else if (ph == N_PHASES - 1) { if (KIND < 0 || KIND == 11) phase_final(p); }
  else {
    const int l = (ph - 1) / PH_PER_LAYER, s = (ph - 1) % PH_PER_LAYER;
    const bool last = (l == NL - 1);
    const int ntok = last ? TL : TT;
    if (s == 0) { if (KIND < 0 || KIND == 1) phase_norm(p, l, 0, TT); }
    else if (s == 1) { if (KIND < 0 || KIND == 2) phase_gemm_in(p, l, lds); }
    else if (s == 2) { if (KIND < 0 || KIND == 3) phase_rope(p, lds); }
    else if (s == 3) { if (KIND < 0 || KIND == 4) phase_mixers(p, l, last, ctl + 64 * (1 + l), lds); }
    else if (s == 4) { if (KIND < 0 || KIND == 5) phase_gla_fin(p, l, ntok); }
    else if (s == 5) { if (KIND < 0 || KIND == 6) phase_gemm_out(p, l, ntok, lds); }
    else if (s == 6) { if (KIND < 0 || KIND == 7) phase_norm(p, l, 1, ntok); }
    else if (s == 7) { if (KIND < 0 || KIND == 8) phase_gemm_q(p, l, ntok, lds); }
    else if (s == 8) { if (KIND < 0 || KIND == 9) phase_topk(p, l, ntok); }
    else { if (KIND < 0 || KIND == 10) phase_gather(p, l, ntok, lds); }
  }
}

#if N_LAUNCH_MODE == 1
#ifndef PROBE_KIND
#define PROBE_KIND -1
#endif
constexpr int CW_BAR = 4096;
__global__ void __launch_bounds__(256, 2) mk_fwd(Params p) {
  __shared__ __attribute__((aligned(16))) unsigned char lds[LDS_BYTES];
  unsigned* ctl = (unsigned*)(p.ws + OFF_CTL);
  volatile unsigned* st = (volatile unsigned*)(lds + LDS_BYTES - 32);
  if (threadIdx.x < 2) st[threadIdx.x] = 0u;
  __syncthreads();
  (void)xcd_barrier_post(ctl + CW_BAR, st);
#define GSYNC() do { XcdBarrier bb; bb.bar = (unsigned*)(p.ws + OFF_CTL) + CW_BAR; bb.x = xb_xcc_id(); bb.st = (volatile unsigned*)(lds + LDS_BYTES - 32); xcd_barrier(bb); } while (0)
  { Params q = p; asm volatile("" : "+s"(q.ws)); phase_prologue(q, lds); } cg::this_grid().sync();
  if (PROBE_KIND == 0) { { Params q = p; asm volatile("" : "+s"(q.ws)); phase_prologue(q, lds); } GSYNC(); }
  for (int l = 0; l < NL; ++l) {
    const bool last = (l == NL - 1);
    const int ntok = last ? TL : TT;
    { Params q = p; asm volatile("" : "+s"(q.ws)); phase_norm(q, l, 0, TT); } GSYNC();
    if (PROBE_KIND == 1) { { Params q = p; asm volatile("" : "+s"(q.ws)); phase_norm(q, l, 0, TT); } GSYNC(); }
    { Params q = p; asm volatile("" : "+s"(q.ws)); phase_gemm_in(q, l, lds); } GSYNC();
    if (PROBE_KIND == 2) { { Params q = p; asm volatile("" : "+s"(q.ws)); phase_gemm_in(q, l, lds); } GSYNC(); }
    { Params q = p; asm volatile("" : "+s"(q.ws)); phase_rope(q, lds); } GSYNC();
    if (PROBE_KIND == 4) { { Params q = p; asm volatile("" : "+s"(q.ws)); phase_mixers(q, l, last, ctl + 64 * (1 + l) + 1, lds); } GSYNC(); }
    { Params q = p; asm volatile("" : "+s"(q.ws)); phase_mixers(q, l, last, ctl + 64 * (1 + l), lds); } GSYNC();
    { Params q = p; asm volatile("" : "+s"(q.ws)); phase_gla_fin(q, l, ntok); } GSYNC();
    if (PROBE_KIND == 5) { { Params q = p; asm volatile("" : "+s"(q.ws)); phase_gla_fin(q, l, ntok); } GSYNC(); }
    { Params q = p; asm volatile("" : "+s"(q.ws)); phase_gemm_out(q, l, ntok, lds); } GSYNC();
    { Params q = p; asm volatile("" : "+s"(q.ws)); phase_norm(q, l, 1, ntok); } GSYNC();
    if (PROBE_KIND == 7) { { Params q = p; asm volatile("" : "+s"(q.ws)); phase_norm(q, l, 1, ntok); } GSYNC(); }
    { Params q = p; asm volatile("" : "+s"(q.ws)); phase_gemm_q(q, l, ntok, lds); } GSYNC();
    if (PROBE_KIND == 8) { { Params q = p; asm volatile("" : "+s"(q.ws)); phase_gemm_q(q, l, ntok, lds); } GSYNC(); }
    { Params q = p; asm volatile("" : "+s"(q.ws)); phase_topk(q, l, ntok); } GSYNC();
    if (PROBE_KIND == 9) { { Params q = p; asm volatile("" : "+s"(q.ws)); phase_topk(q, l, ntok); } GSYNC(); }
    if (PROBE_KIND == 10) { { Params q = p; asm volatile("" : "+s"(q.ws)); phase_gather(q, l, ntok, lds, true); } GSYNC(); }
    { Params q = p; asm volatile("" : "+s"(q.ws)); phase_gather(q, l, ntok, lds); } GSYNC();
  }
  { Params q = p; asm volatile("" : "+s"(q.ws)); phase_final(q); }
}
#else
template <int KIND>
__global__ void __launch_bounds__(256, 2) mk_phase(Params p) {
  __shared__ __attribute__((aligned(16))) unsigned char lds[LDS_BYTES];
  run_phase<KIND>(p, p.ph_lo, lds);
}
#endif

extern "C" void kernel_launch(void* const* d_in, const int* in_sizes, int n_in, void* d_out, int out_size, void* d_ws,
                              size_t ws_size, hipStream_t stream) {
  static int grid = 0;
  if (grid == 0) {
    if (n_in != 21 || ws_size < WS_END || out_size != TL * DM) { fprintf(stderr, "kernel_launch: unexpected shapes (n_in %d ws %zu out %d)\n", n_in, ws_size, out_size); grid = -1; return; }
    int dev = 0, cus = 0, per_cu = 2;
    (void)hipGetDevice(&dev);
    (void)hipDeviceGetAttribute(&cus, hipDeviceAttributeMultiprocessorCount, dev);
#if N_LAUNCH_MODE == 1
    (void)hipOccupancyMaxActiveBlocksPerMultiprocessor(&per_cu, (const void*)mk_fwd, 256, 0);
    if (per_cu < 1) per_cu = 1;
    if (per_cu > 2) per_cu = 2;
#endif
    grid = cus * per_cu;
  }
  if (grid < 0) return;
  (void)hipMemsetAsync((char*)d_ws + OFF_CTL, 0, 65536, stream);
  Params p{};
  const float** pp = (const float**)&p;
  for (int i = 0; i < 21; ++i) pp[i] = (const float*)d_in[i];
  p.out = (float*)d_out;
  p.ws = (unsigned char*)d_ws;
#if N_LAUNCH_MODE == 1
  p.ph_lo = 0; p.ph_hi = N_PHASES;
  void* args[] = {&p};
  hipError_t e = hipLaunchCooperativeKernel((const void*)mk_fwd, dim3(grid), dim3(256), args, 0, stream);
  if (e != hipSuccess) fprintf(stderr, "cooperative launch failed: %s (grid %d)\n", hipGetErrorString(e), grid);
#else
  for (int ph = 0; ph < N_PHASES; ++ph) {
    p.ph_lo = ph; p.ph_hi = ph + 1;
    const int kind = ph == 0 ? 0 : (ph == N_PHASES - 1 ? 11 : 1 + (ph - 1) % PH_PER_LAYER);
    switch (kind) {
      case 0: hipLaunchKernelGGL(mk_phase<0>, dim3(grid), dim3(256), 0, stream, p); break;
      case 1: hipLaunchKernelGGL(mk_phase<1>, dim3(grid), dim3(256), 0, stream, p); break;
      case 2: hipLaunchKernelGGL(mk_phase<2>, dim3(grid), dim3(256), 0, stream, p); break;
      case 3: hipLaunchKernelGGL(mk_phase<3>, dim3(grid), dim3(256), 0, stream, p); break;
      case 4: hipLaunchKernelGGL(mk_phase<4>, dim3(grid), dim3(256), 0, stream, p); break;
      case 5: hipLaunchKernelGGL(mk_phase<5>, dim3(grid), dim3(256), 0, stream, p); break;
      case 6: hipLaunchKernelGGL(mk_phase<6>, dim3(grid), dim3(256), 0, stream, p); break;
      case 7: hipLaunchKernelGGL(mk_phase<7>, dim3(grid), dim3(256), 0, stream, p); break;
      case 8: hipLaunchKernelGGL(mk_phase<8>, dim3(grid), dim3(256), 0, stream, p); break;
      case 9: hipLaunchKernelGGL(mk_phase<9>, dim3(grid), dim3(256), 0, stream, p); break;
      case 10: hipLaunchKernelGGL(mk_phase<10>, dim3(grid), dim3(256), 0, stream, p); break;
      default: hipLaunchKernelGGL(mk_phase<11>, dim3(grid), dim3(256), 0, stream, p); break;
    }
  }
#endif
}
```

```cpp
#include <hip/hip_runtime.h>
#include <hip/hip_cooperative_groups.h>
#include <stdint.h>
#include <stdio.h>
namespace cg = cooperative_groups;

#ifndef N_LAUNCH_MODE
#define N_LAUNCH_MODE 1
#endif

#define DI __device__ __forceinline__
typedef unsigned short bf16_t;
typedef short bf16x8 __attribute__((ext_vector_type(8)));
typedef float f32x4 __attribute__((ext_vector_type(4)));
typedef float f32x2 __attribute__((ext_vector_type(2)));
typedef unsigned u32x4 __attribute__((ext_vector_type(4)));
typedef unsigned u32x2 __attribute__((ext_vector_type(2)));

constexpr int NB = 16, SEQ = 2048, DM = 1024, NL = 4, CTXL = 256;
constexpr int TL = NB * SEQ;
constexpr int TC = NB * CTXL;
constexpr int TT = TL + TC;
constexpr int PN_LD = 2176;
constexpr int C_GQ = 0, C_GK = 128, C_GR = 256, C_NQ = 512, C_NK = 768, C_DQ = 1024, C_DK = 1536, C_GATE = 2048;
constexpr int R_GV = 0, R_NV = 256, R_DV = 512;
constexpr float LOG2E = 1.4426950408889634f;
constexpr float SC_LOG2 = 0.125f * LOG2E;
constexpr float NEG_BIG = -1e30f;

constexpr size_t MiB = 1u << 20;
constexpr size_t OFF_CTL = 0;
constexpr size_t OFF_MOD = 1 * MiB;
constexpr size_t OFF_WIN = 3 * MiB;
constexpr size_t OFF_WOUT = 28 * MiB;
constexpr size_t OFF_WQ = 36 * MiB;
constexpr size_t OFF_SK = 44 * MiB;
constexpr size_t OFF_USCL = 44 * MiB + 256 * 1024;
constexpr size_t OFF_VSCL = 44 * MiB + 512 * 1024;
constexpr size_t OFF_U = 45 * MiB;
constexpr size_t OFF_V = 109 * MiB;
constexpr size_t OFF_XRES = 301 * MiB;
constexpr size_t OFF_H = 445 * MiB;
constexpr size_t OFF_P = 517 * MiB;
constexpr size_t OFF_VT = OFF_P + 153 * MiB;
constexpr size_t OFF_QP = OFF_P;
constexpr size_t OFF_EID = OFF_P + 72 * MiB;
constexpr size_t OFF_GATE = OFF_P + 90 * MiB;
constexpr size_t OFF_H8 = OFF_P + 126 * MiB;
constexpr size_t OFF_HINV = OFF_P + 162 * MiB;
constexpr size_t OFF_Y = 742 * MiB;
constexpr size_t WS_END = 814 * MiB;

constexpr int LDS_BYTES = 65536 + 8192;

struct Params {
  const float *x, *c, *ctx, *c_ctx, *ada_w, *ada_b, *norm1_g, *norm2_g, *w_in, *gate_up, *gate_b, *gla_norm_g,
      *rpb, *dlam, *diff_g, *w_out, *wq, *subkeys, *pu, *pv, *final_g;
  float* out;
  unsigned char* ws;
  int ph_lo, ph_hi;
};

DI int ltid() { int t = threadIdx.x; asm volatile("" : "+v"(t)); return t; }
DI int lbid() { int t = blockIdx.x; asm volatile("" : "+s"(t)); return t; }
DI int lgdim() { int t = gridDim.x; asm volatile("" : "+s"(t)); return t; }

DI unsigned f2bf(float f) { unsigned u = __float_as_uint(f); return (u + 0x7fffu + ((u >> 16) & 1u)) >> 16; }
typedef __bf16 bf16x2_t __attribute__((ext_vector_type(2)));
DI unsigned pk2(float lo, float hi) { f32x2 v = {lo, hi}; return __builtin_bit_cast(unsigned, __builtin_convertvector(v, bf16x2_t)); }
DI float bflo(unsigned u) { return __uint_as_float(u << 16); }
DI float bfhi(unsigned u) { return __uint_as_float(u & 0xffff0000u); }
DI void unpack8(const u32x4 v, float* f) {
  f[0] = bflo(v.x); f[1] = bfhi(v.x); f[2] = bflo(v.y); f[3] = bfhi(v.y);
  f[4] = bflo(v.z); f[5] = bfhi(v.z); f[6] = bflo(v.w); f[7] = bfhi(v.w);
}
DI float wave_sum(float v) {
#pragma unroll
  for (int o = 32; o >= 1; o >>= 1) v += __shfl_xor(v, o);
  return v;
}
DI f32x4 mfma16(bf16x8 a, bf16x8 b, f32x4 c) { return __builtin_amdgcn_mfma_f32_16x16x32_bf16(a, b, c, 0, 0, 0); }

DI int win_src_col(int r) {
  if (r < 256) return r;
  if (r < 512) return r - 256 + 512;
  if (r < 768) return r - 512 + 800;
  if (r < 1024) return r - 768 + 1056;
  if (r < 1536) return r - 1024 + 1568;
  if (r < 2048) return r - 1536 + 2080;
  if (r < 2080) return r - 2048 + 768;
  if (r < 2176) return -1;
  if (r < 2432) return r - 2176 + 256;
  if (r < 2688) return r - 2432 + 1312;
  return r - 2688 + 2592;
}

DI void transpose_item(const float* __restrict__ W, int N, int src, bf16_t* __restrict__ dst, float* lds) {
  const int tid = ltid();
  for (int kc = 0; kc < 8; ++kc) {
    __syncthreads();
#pragma unroll
    for (int i = 0; i < 16; ++i) {
      int k = i * 8 + (tid >> 5), n = tid & 31;
      lds[k * 33 + n] = (src < 0) ? 0.f : W[(size_t)(kc * 128 + k) * N + src + n];
    }
    __syncthreads();
    int row = tid >> 3, k0 = (tid & 7) * 16;
    unsigned o[8];
#pragma unroll
    for (int e = 0; e < 8; ++e) o[e] = pk2(lds[(k0 + 2 * e) * 33 + row], lds[(k0 + 2 * e + 1) * 33 + row]);
    u32x4 a = {o[0], o[1], o[2], o[3]}, b = {o[4], o[5], o[6], o[7]};
    bf16_t* d = dst + (size_t)row * 1024 + kc * 128 + k0;
    *(u32x4*)d = a; *(u32x4*)(d + 8) = b;
  }
}

DI void phase_prologue(const Params& p, unsigned char* lds) {
  const int tid = ltid(), nb = lgdim(), bid = lbid();
  bf16_t* winT = (bf16_t*)(p.ws + OFF_WIN);
  bf16_t* woutT = (bf16_t*)(p.ws + OFF_WOUT);
  bf16_t* wqT = (bf16_t*)(p.ws + OFF_WQ);
  constexpr int PER_LAYER = 100 + 32 + 32;
  for (int item = bid; item < NL * PER_LAYER; item += nb) {
    int l = item / PER_LAYER, r = item % PER_LAYER;
    if (r < 100) {
      int row = r * 32;
      transpose_item(p.w_in + (size_t)l * 1024 * 3104, 3104, win_src_col(row), winT + ((size_t)l * 3200 + row) * 1024, (float*)lds);
    } else if (r < 132) {
      int row = (r - 100) * 32;
      transpose_item(p.w_out + (size_t)l * 1024 * 1024, 1024, row, woutT + ((size_t)l * 1024 + row) * 1024, (float*)lds);
    } else {
      int row = (r - 132) * 32;
      transpose_item(p.wq + (size_t)l * 1024 * 1024, 1024, row, wqT + ((size_t)l * 1024 + row) * 1024, (float*)lds);
    }
  }
  {
    const int lane = tid & 63, gw = bid * 4 + (tid >> 6), nw = nb * 4;
    unsigned char* u8 = p.ws + OFF_U;
    unsigned char* v8 = p.ws + OFF_V;
    float* uscl = (float*)(p.ws + OFF_USCL);
    float* vscl = (float*)(p.ws + OFF_VSCL);
    for (int row = gw; row < 2 * NL * 16384; row += nw) {
      const int tab = row >= NL * 16384, r = tab ? row - NL * 16384 : row;
      const float* src = (tab ? p.pv : p.pu) + (size_t)r * 1024 + 16 * lane;
      float4 f[4];
      float am = 0.f;
#pragma unroll
      for (int i = 0; i < 4; ++i) {
        f[i] = *(const float4*)(src + 4 * i);
        am = fmaxf(am, fmaxf(fmaxf(fabsf(f[i].x), fabsf(f[i].y)), fmaxf(fabsf(f[i].z), fabsf(f[i].w))));
      }
#pragma unroll
      for (int o = 32; o >= 1; o >>= 1) am = fmaxf(am, __shfl_xor(am, o));
      const float sc = am > 0.f ? 448.f / am : 0.f;
      u32x4 q;
#pragma unroll
      for (int i = 0; i < 4; ++i) {
        int pk = 0;
        pk = __builtin_amdgcn_cvt_pk_fp8_f32(f[i].x * sc, f[i].y * sc, pk, false);
        pk = __builtin_amdgcn_cvt_pk_fp8_f32(f[i].z * sc, f[i].w * sc, pk, true);
        q[i] = (unsigned)pk;
      }
      *(u32x4*)((tab ? v8 : u8) + (size_t)r * 1024 + 16 * lane) = q;
      if (lane == 0) (tab ? vscl : uscl)[r] = am * (1.f / 448.f);
    }
  }
  {
    bf16_t* sk = (bf16_t*)(p.ws + OFF_SK);
    for (int i = bid * 256 + tid; i < NL * 2 * 128 * 64; i += nb * 256) sk[i] = (bf16_t)f2bf(p.subkeys[i]);
  }
  {
    float* modbuf = (float*)(p.ws + OFF_MOD);
    float* sc = (float*)lds;
    float* red = (float*)(lds + 17 * 512 * 4);
    for (int item = bid; item < NL * 96; item += nb) {
      const int l = item / 96, cb = item % 96, col = cb * 64 + (tid & 63), kq = tid >> 6;
      float acc[17];
#pragma unroll
      for (int r = 0; r < 17; ++r) acc[r] = 0.f;
      for (int half = 0; half < 2; ++half) {
        __syncthreads();
        for (int e = tid; e < 17 * 512; e += 256) {
          int r = e >> 9, k = e & 511;
          float cv = (r < 16) ? p.c[r * 1024 + half * 512 + k] : p.c_ctx[half * 512 + k];
          sc[e] = cv / (1.f + __expf(-cv));
        }
        __syncthreads();
        const float* wp = p.ada_w + ((size_t)l * 1024 + half * 512 + kq * 128) * 6144 + col;
        for (int kk = 0; kk < 128; ++kk) {
          const float w = wp[(size_t)kk * 6144];
#pragma unroll
          for (int r = 0; r < 17; ++r) acc[r] += sc[r * 512 + kq * 128 + kk] * w;
        }
      }
#pragma unroll
      for (int r = 0; r < 17; ++r) red[(kq * 17 + r) * 64 + (tid & 63)] = acc[r];
      __syncthreads();
      for (int e = tid; e < 17 * 64; e += 256) {
        int r = e >> 6, cc = e & 63;
        float s = red[(0 * 17 + r) * 64 + cc] + red[(1 * 17 + r) * 64 + cc] + red[(2 * 17 + r) * 64 + cc] + red[(3 * 17 + r) * 64 + cc];
        int colg = cb * 64 + cc;
        modbuf[((size_t)l * 17 + r) * 6144 + colg] = s + p.ada_b[l * 6144 + colg];
      }
      __syncthreads();
    }
  }
}

DI void phase_norm(const Params& p, int l, int which, int ntok) {
  const int lane = ltid() & 63, gw = lbid() * 4 + (ltid() >> 6), nw = lgdim() * 4;
  const float* gvec = (which == 0 ? p.norm1_g : p.norm2_g) + l * 1024;
  const int ish = which == 0 ? 0 : 3, isc = which == 0 ? 1 : 4;
  const float* xres = (const float*)(p.ws + OFF_XRES);
  const float* modbuf = (const float*)(p.ws + OFF_MOD);
  bf16_t* hbuf = (bf16_t*)(p.ws + OFF_H);
  for (int t = gw; t < ntok; t += nw) {
    const float* src = (which == 0 && l == 0) ? (t < TL ? p.x + (size_t)t * 1024 : p.ctx + (size_t)(t - TL) * 1024) : xres + (size_t)t * 1024;
    const int b = t < TL ? (t >> 11) : 16;
    const float* md = modbuf + ((size_t)l * 17 + b) * 6144;
    float4 v[4];
    float ss = 0.f;
#pragma unroll
    for (int i = 0; i < 4; ++i) {
      v[i] = *(const float4*)(src + 4 * lane + 256 * i);
      ss += v[i].x * v[i].x + v[i].y * v[i].y + v[i].z * v[i].z + v[i].w * v[i].w;
    }
    ss = wave_sum(ss);
    const float rstd = rsqrtf(ss * (1.f / 1024.f) + 1e-6f);
    float am = 0.f;
#pragma unroll
    for (int i = 0; i < 4; ++i) {
      const int col = 4 * lane + 256 * i;
      const float4 g4 = *(const float4*)(gvec + col), sh = *(const float4*)(md + ish * 1024 + col), sc = *(const float4*)(md + isc * 1024 + col);
      float o0 = v[i].x * rstd * g4.x * (1.f + sc.x) + sh.x;
      float o1 = v[i].y * rstd * g4.y * (1.f + sc.y) + sh.y;
      float o2 = v[i].z * rstd * g4.z * (1.f + sc.z) + sh.z;
      float o3 = v[i].w * rstd * g4.w * (1.f + sc.w) + sh.w;
      u32x2 o = {pk2(o0, o1), pk2(o2, o3)};
      *(u32x2*)(hbuf + (size_t)t * 1024 + col) = o;
      v[i].x = o0; v[i].y = o1; v[i].z = o2; v[i].w = o3;
      am = fmaxf(am, fmaxf(fmaxf(fabsf(o0), fabsf(o1)), fmaxf(fabsf(o2), fabsf(o3))));
    }
    if (which == 1) {
#pragma unroll
      for (int o = 32; o >= 1; o >>= 1) am = fmaxf(am, __shfl_xor(am, o));
      const float qs = am > 0.f ? 448.f / am : 0.f;
      unsigned char* h8 = p.ws + OFF_H8 + (size_t)t * 1024;
#pragma unroll
      for (int i = 0; i < 4; ++i) {
        int pk = 0;
        pk = __builtin_amdgcn_cvt_pk_fp8_f32(v[i].x * qs, v[i].y * qs, pk, false);
        pk = __builtin_amdgcn_cvt_pk_fp8_f32(v[i].z * qs, v[i].w * qs, pk, true);
        *(int*)(h8 + 4 * lane + 256 * i) = pk;
      }
      if (lane == 0) ((float*)(p.ws + OFF_HINV))[t] = am * (1.f / 448.f);
    }
  }
}

template <int EPI>
DI void gemm_tile(const bf16_t* __restrict__ P, const bf16_t* __restrict__ Q, int it, int jt, void* outp, int ld,
                  const float* xin_lat, const float* xin_ctx, const float* modl, unsigned char* lds) {
  const int tid = ltid(), lane = tid & 63, w = tid >> 6, wi = w >> 1, wj = w & 1, lr = lane & 15, g = lane >> 4;
  unsigned char* Ps = lds;
  unsigned char* Qs = lds + 16384;
  f32x4 acc[4][4];
#pragma unroll
  for (int a = 0; a < 4; ++a)
#pragma unroll
    for (int b = 0; b < 4; ++b) acc[a][b] = (f32x4){0.f, 0.f, 0.f, 0.f};
  const int c = tid & 7, r0 = tid >> 3;
  const bf16_t* pg = P + (size_t)(it * 128 + r0) * 1024 + c * 8;
  const bf16_t* qg = Q + (size_t)(jt * 128 + r0) * 1024 + c * 8;
  u32x4 pr[4], qr[4];
#pragma unroll
  for (int ii = 0; ii < 4; ++ii) { pr[ii] = *(const u32x4*)(pg + (size_t)ii * 32 * 1024); qr[ii] = *(const u32x4*)(qg + (size_t)ii * 32 * 1024); }
  for (int kb = 0; kb < 16; ++kb) {
#pragma unroll
    for (int ii = 0; ii < 4; ++ii) {
      const int row = r0 + 32 * ii;
      const unsigned off = row * 128 + ((c ^ (row & 7)) << 4);
      *(u32x4*)(Ps + off) = pr[ii];
      *(u32x4*)(Qs + off) = qr[ii];
    }
    __syncthreads();
    if (kb < 15) {
#pragma unroll
      for (int ii = 0; ii < 4; ++ii) {
        pr[ii] = *(const u32x4*)(pg + (size_t)ii * 32 * 1024 + (kb + 1) * 64);
        qr[ii] = *(const u32x4*)(qg + (size_t)ii * 32 * 1024 + (kb + 1) * 64);
      }
    }
#pragma unroll
    for (int ks = 0; ks < 2; ++ks) {
      bf16x8 pf[4], qf[4];
      const int ch = ks * 4 + g;
#pragma unroll
      for (int mi = 0; mi < 4; ++mi) { const int row = wi * 64 + mi * 16 + lr; pf[mi] = *(const bf16x8*)(Ps + row * 128 + ((ch ^ (row & 7)) << 4)); }
#pragma unroll
      for (int nj = 0; nj < 4; ++nj) { const int row = wj * 64 + nj * 16 + lr; qf[nj] = *(const bf16x8*)(Qs + row * 128 + ((ch ^ (row & 7)) << 4)); }
#pragma unroll
      for (int mi = 0; mi < 4; ++mi)
#pragma unroll
        for (int nj = 0; nj < 4; ++nj) acc[mi][nj] = mfma16(pf[mi], qf[nj], acc[mi][nj]);
    }
    __syncthreads();
  }
#pragma unroll
  for (int mi = 0; mi < 4; ++mi)
#pragma unroll
    for (int nj = 0; nj < 4; ++nj) {
      const int j = jt * 128 + wj * 64 + nj * 16 + lr;
      const int i = it * 128 + wi * 64 + mi * 16 + 4 * g;
      const f32x4 a = acc[mi][nj];
      if (EPI == 0) {
        u32x2 o = {pk2(a[0], a[1]), pk2(a[2], a[3])};
        *(u32x2*)((bf16_t*)outp + (size_t)j * ld + i) = o;
      } else {
        const int b = j < TL ? (j >> 11) : 16;
        const float4 gt = *(const float4*)(modl + (size_t)b * 6144 + 2 * 1024 + i);
        const float* xs = (j < TL) ? xin_lat + (size_t)j * 1024 + i : xin_ctx + (size_t)(j - TL) * 1024 + i;
        const float4 xv = *(const float4*)xs;
        float4 o = {xv.x + gt.x * a[0], xv.y + gt.y * a[1], xv.z + gt.z * a[2], xv.w + gt.w * a[3]};
        *(float4*)((float*)outp + (size_t)j * 1024 + i) = o;
      }
    }
}

DI void phase_gemm_in(const Params& p, int l, unsigned char* lds) {
  const bf16_t* W = (const bf16_t*)(p.ws + OFF_WIN) + (size_t)l * 3200 * 1024;
  const bf16_t* H = (const bf16_t*)(p.ws + OFF_H);
  bf16_t* PN = (bf16_t*)(p.ws + OFF_P);
  bf16_t* VT = (bf16_t*)(p.ws + OFF_VT);
  constexpr int NJT = TT / 128;
  constexpr int T1 = NJT * 17, T2 = NJT * 8;
  for (int t = lbid(); t < T1 + T2; t += lgdim()) {
    if (t < T1) { const int jt = t / 17, it = t % 17; gemm_tile<0>(W, H, it, jt, PN, PN_LD, nullptr, nullptr, nullptr, lds); }
    else { const int u = t - T1; const int it = u >> 3, jt = u & 7; gemm_tile<0>(H, W + (size_t)2176 * 1024, it, jt, VT, TT, nullptr, nullptr, nullptr, lds); }
  }
}
DI void phase_gemm_out(const Params& p, int l, int ntok, unsigned char* lds) {
  const bf16_t* W = (const bf16_t*)(p.ws + OFF_WOUT) + (size_t)l * 1024 * 1024;
  const bf16_t* Y = (const bf16_t*)(p.ws + OFF_Y);
  float* xres = (float*)(p.ws + OFF_XRES);
  const float* modl = (const float*)(p.ws + OFF_MOD) + (size_t)l * 17 * 6144;
  const float* xl = (l == 0) ? p.x : xres;
  const float* xc = (l == 0) ? p.ctx : xres + (size_t)TL * 1024;
  const int ntile = (ntok / 128) * 8;
  for (int t = lbid(); t < ntile; t += lgdim()) {
    const int jt = t >> 3, it = t & 7;
    gemm_tile<1>(W, Y, it, jt, xres, 1024, xl, xc, modl, lds);
  }
}
DI void phase_gemm_q(const Params& p, int l, int ntok, unsigned char* lds) {
  const bf16_t* W = (const bf16_t*)(p.ws + OFF_WQ) + (size_t)l * 1024 * 1024;
  const bf16_t* H = (const bf16_t*)(p.ws + OFF_H);
  bf16_t* QP = (bf16_t*)(p.ws + OFF_QP);
  const int ntile = (ntok / 128) * 8;
  for (int t = lbid(); t < ntile; t += lgdim()) {
    const int jt = t >> 3, it = t & 7;
    gemm_tile<0>(W, H, it, jt, QP, 1024, nullptr, nullptr, nullptr, lds);
  }
}

DI void phase_rope(const Params& p, unsigned char* lds) {
  float2* tab = (float2*)lds;
  for (int e = ltid(); e < 1024; e += 256) {
    const int pos = e >> 4, i = e & 15;
    const float inv = exp2f(-(float)i * (13.287712379549449f / 16.f));
    const float ang = (float)pos * inv;
    tab[e] = make_float2(__cosf(ang), __sinf(ang));
  }
  __syncthreads();
  bf16_t* PN = (bf16_t*)(p.ws + OFF_P);
  const int total = TL * 16;
  for (int idx = lbid() * 256 + ltid(); idx < total; idx += lgdim() * 256) {
    const int t = idx >> 4, vec = idx & 15;
    const int col = ((vec >> 3) ? C_DK : C_DQ) + ((vec >> 1) & 3) * 128 + (vec & 1) * 64;
    bf16_t* ptr = PN + (size_t)t * PN_LD + col;
    float xv[64];
#pragma unroll
    for (int q = 0; q < 8; ++q) { const u32x4 v = *(const u32x4*)(ptr + q * 8); unpack8(v, xv + q * 8); }
    const int row = (t & 2047) >> 6, cp = t & 63;
#pragma unroll
    for (int i = 0; i < 16; ++i) {
      const float2 cs = tab[row * 16 + i];
      const float x1 = xv[i], x2 = xv[16 + i];
      xv[i] = x1 * cs.x - x2 * cs.y; xv[16 + i] = x2 * cs.x + x1 * cs.y;
      const float2 cs2 = tab[cp * 16 + i];
      const float y1 = xv[32 + i], y2 = xv[48 + i];
      xv[32 + i] = y1 * cs2.x - y2 * cs2.y; xv[48 + i] = y2 * cs2.x + y1 * cs2.y;
    }
#pragma unroll
    for (int q = 0; q < 8; ++q) {
      u32x4 o = {pk2(xv[q * 8], xv[q * 8 + 1]), pk2(xv[q * 8 + 2], xv[q * 8 + 3]), pk2(xv[q * 8 + 4], xv[q * 8 + 5]), pk2(xv[q * 8 + 6], xv[q * 8 + 7])};
      *(u32x4*)(ptr + q * 8) = o;
    }
  }
}

struct SrcSeg {
  const bf16_t* PN; const bf16_t* VT; int kcol, vrow, t0, n0, t1, n1, lr, g;
  const bf16_t* k0p; const bf16_t* k1p; const bf16_t* vp;
  DI int nsteps() const { return n0 + n1; }
  DI void setup(int st) {
    const int tok0 = st < n0 ? t0 + st * 32 : t1 + (st - n0) * 32;
    const int kap = 8 * (lr >> 2) + (lr & 3);
    k0p = PN + (size_t)(tok0 + kap) * PN_LD + kcol + 8 * g;
    k1p = k0p + (size_t)4 * PN_LD;
    vp = VT + (size_t)(vrow + lr) * TT + tok0 + 8 * g;
  }
  DI bf16x8 kfrag(int m, int kt, int ks) const { return *(const bf16x8*)((kt ? k1p : k0p) + m * 64 + ks * 32); }
  DI bf16x8 vfrag(int dt) const { return *(const bf16x8*)(vp + (size_t)dt * 16 * TT); }
  DI float score(float raw, int kt, int r) const { return raw * SC_LOG2; }
};
struct SrcNat {
  const bf16_t* PN; const bf16_t* VT; int kcol, vrow, b, rq, rs, cs, qc, cstart, lr, g, st_;
  const float* rpbh;
  const bf16_t* k0p; const bf16_t* k1p; const bf16_t* vp;
  DI int nsteps() const { return 16; }
  DI void setup(int st) {
    st_ = st;
    const int tok0 = st < 8 ? b * 2048 + (rs + st) * 64 + cs : TL + b * 256 + (st - 8) * 32;
    const int kap = 8 * (lr >> 2) + (lr & 3);
    k0p = PN + (size_t)(tok0 + kap) * PN_LD + kcol + 8 * g;
    k1p = k0p + (size_t)4 * PN_LD;
    vp = VT + (size_t)(vrow + lr) * TT + tok0 + 8 * g;
  }
  DI bf16x8 kfrag(int m, int kt, int ks) const { return *(const bf16x8*)((kt ? k1p : k0p) + ks * 32); }
  DI bf16x8 vfrag(int dt) const { return *(const bf16x8*)(vp + (size_t)dt * 16 * TT); }
  DI float score(float raw, int kt, int r) const {
    if (st_ >= 8) return raw * SC_LOG2;
    const int kc = cs + 8 * g + 4 * kt + r;
    const bool valid = (kc >= cstart) && (kc < cstart + 16);
    int dc = kc - qc + 15; dc = dc < 0 ? 0 : (dc > 30 ? 30 : dc);
    const float bias = rpbh[(rs + st_ - rq + 7) * 31 + dc];
    return valid ? (raw * 0.125f + bias) * LOG2E : NEG_BIG;
  }
};

template <int MAPS, int DVT, class Src>
DI void flash_wave(Src& S, const bf16_t* qptr  , f32x4 (&o)[MAPS][DVT], float (&ltot)[MAPS]) {
  bf16x8 qf[MAPS][2];
#pragma unroll
  for (int m = 0; m < MAPS; ++m)
#pragma unroll
    for (int ks = 0; ks < 2; ++ks) qf[m][ks] = *(const bf16x8*)(qptr + m * 64 + ks * 32);
  float mrun[MAPS], lrun[MAPS];
#pragma unroll
  for (int m = 0; m < MAPS; ++m) {
    mrun[m] = NEG_BIG; lrun[m] = 0.f;
#pragma unroll
    for (int dt = 0; dt < DVT; ++dt) o[m][dt] = (f32x4){0.f, 0.f, 0.f, 0.f};
  }
  const int ns = S.nsteps();
  for (int st = 0; st < ns; ++st) {
    S.setup(st);
    bf16x8 pf[MAPS];
#pragma unroll
    for (int m = 0; m < MAPS; ++m) {
      f32x4 s[2];
#pragma unroll
      for (int kt = 0; kt < 2; ++kt) {
        s[kt] = (f32x4){0.f, 0.f, 0.f, 0.f};
#pragma unroll
        for (int ks = 0; ks < 2; ++ks) s[kt] = mfma16(S.kfrag(m, kt, ks), qf[m][ks], s[kt]);
      }
      float mt = NEG_BIG;
#pragma unroll
      for (int kt = 0; kt < 2; ++kt)
#pragma unroll
        for (int r = 0; r < 4; ++r) { s[kt][r] = S.score(s[kt][r], kt, r); mt = fmaxf(mt, s[kt][r]); }
      mt = fmaxf(mt, __shfl_xor(mt, 16));
      mt = fmaxf(mt, __shfl_xor(mt, 32));
      const bool need = mt > mrun[m] + 8.f;
      if (__any(need)) {
        const float mnew = need ? mt : mrun[m];
        const float alpha = __builtin_amdgcn_exp2f(mrun[m] - mnew);
        lrun[m] *= alpha;
#pragma unroll
        for (int dt = 0; dt < DVT; ++dt) { o[m][dt][0] *= alpha; o[m][dt][1] *= alpha; o[m][dt][2] *= alpha; o[m][dt][3] *= alpha; }
        mrun[m] = mnew;
      }
      float pv[8];
      float ls = 0.f;
#pragma unroll
      for (int kt = 0; kt < 2; ++kt)
#pragma unroll
        for (int r = 0; r < 4; ++r) { pv[kt * 4 + r] = __builtin_amdgcn_exp2f(s[kt][r] - mrun[m]); ls += pv[kt * 4 + r]; }
      lrun[m] += ls;
      u32x4 pk = {pk2(pv[0], pv[1]), pk2(pv[2], pv[3]), pk2(pv[4], pv[5]), pk2(pv[6], pv[7])};
      pf[m] = __builtin_bit_cast(bf16x8, pk);
    }
#pragma unroll
    for (int dt = 0; dt < DVT; ++dt) {
      const bf16x8 vf = S.vfrag(dt);
#pragma unroll
      for (int m = 0; m < MAPS; ++m) o[m][dt] = mfma16(vf, pf[m], o[m][dt]);
    }
  }
#pragma unroll
  for (int m = 0; m < MAPS; ++m) {
    float l = lrun[m];
    l += __shfl_xor(l, 16);
    l += __shfl_xor(l, 32);
    ltot[m] = l;
  }
}

DI void diff_wave_task(const Params& p, int l, int b, int hd, int qtok0, bool ctx_only) {
  const int lane = ltid() & 63, lr = lane & 15, g = lane >> 4;
  const bf16_t* PN = (const bf16_t*)(p.ws + OFF_P);
  const bf16_t* VT = (const bf16_t*)(p.ws + OFF_VT);
  bf16_t* Y = (bf16_t*)(p.ws + OFF_Y);
  const float* lv = p.dlam + l * 256;
  float sa = lv[lane] * lv[64 + lane], sb = lv[128 + lane] * lv[192 + lane];
  sa = wave_sum(sa); sb = wave_sum(sb);
  const float lam_init = 0.8f - 0.6f * expf(-0.3f * (float)l);
  const float lam = expf(sa) - expf(sb) + lam_init;
  SrcSeg S;
  S.PN = PN; S.VT = VT; S.kcol = C_DK + hd * 128; S.vrow = R_DV + hd * 128; S.lr = lr; S.g = g;
  S.t0 = TL + b * 256; S.n0 = 8; S.t1 = b * 2048; S.n1 = ctx_only ? 0 : 64;
  f32x4 o[2][8];
  float lt[2];
  const int qtok = qtok0 + lr;
  flash_wave<2, 8, SrcSeg>(S, PN + (size_t)qtok * PN_LD + C_DQ + hd * 128 + 8 * g, o, lt);
  const float i0 = 1.f / lt[0], i1 = lam / lt[1];
  float ss = 0.f;
#pragma unroll
  for (int dt = 0; dt < 8; ++dt)
#pragma unroll
    for (int r = 0; r < 4; ++r) { const float v = o[0][dt][r] * i0 - o[1][dt][r] * i1; o[0][dt][r] = v; ss += v * v; }
  ss += __shfl_xor(ss, 16);
  ss += __shfl_xor(ss, 32);
  const float rstd = rsqrtf(ss * (1.f / 128.f) + 1e-6f) * (1.f - lam_init);
  const float* dg = p.diff_g + l * 512 + hd * 128;
#pragma unroll
  for (int dt = 0; dt < 8; ++dt) {
    const float4 gg = *(const float4*)(dg + dt * 16 + 4 * g);
    u32x2 ov = {pk2(o[0][dt][0] * rstd * gg.x, o[0][dt][1] * rstd * gg.y), pk2(o[0][dt][2] * rstd * gg.z, o[0][dt][3] * rstd * gg.w)};
    *(u32x2*)(Y + (size_t)qtok * 1024 + 512 + hd * 128 + dt * 16 + 4 * g) = ov;
  }
}


DI void diff_block_task(const Params& p, int l, int b, int hd, int qtok0, int nsteps, unsigned char* lds) {
  const int tid = ltid(), lane = tid & 63, w = tid >> 6, lr = lane & 15, g = lane >> 4;
  unsigned char* Kb = lds;
  unsigned char* Vb = lds + 16384;
  unsigned char* Qb = lds + 32768;
  const bf16_t* PN = (const bf16_t*)(p.ws + OFF_P);
  const bf16_t* VT = (const bf16_t*)(p.ws + OFF_VT);
  bf16_t* Y = (bf16_t*)(p.ws + OFF_Y);

  __syncthreads();
  {
    const int row = tid >> 1, hf = tid & 1;
    const bf16_t* src = PN + (size_t)(qtok0 + row) * PN_LD + C_DQ + hd * 128 + hf * 64;
#pragma unroll
    for (int c = 0; c < 8; ++c) {
      const u32x4 v = *(const u32x4*)(src + c * 8);
      const int ch = hf * 8 + c;
      *(u32x4*)(Qb + row * 256 + ((ch ^ (row & 15)) << 4)) = v;
    }
  }
  const int wu = __builtin_amdgcn_readfirstlane(w);
  unsigned kofs[2], vofs[2];
#pragma unroll
  for (int jj = 0; jj < 2; ++jj) {
    const int krow = 4 * (2 * w + jj) + (lane >> 4), kpc = lane & 15;
    const int kch = kpc ^ (((krow >> 3) & 3) * 4 + (krow & 3));
    kofs[jj] = (unsigned)(krow * PN_LD + C_DK + hd * 128 + kch * 8);
    const int vrow = 16 * (2 * w + jj) + (lane >> 2), vpc = lane & 3;
    const int vch = vpc ^ ((vrow >> 2) & 3);
    vofs[jj] = (unsigned)((R_DV + hd * 128 + vrow) * TT + vch * 8);
  }
#define DB_DMA(st, bf) do { const int tk = (st) < 8 ? TL + b * 256 + (st) * 32 : b * 2048 + ((st) - 8) * 32; \
    const bf16_t* kb_ = PN + (size_t)tk * PN_LD; const bf16_t* vb_ = VT + tk; \
    _Pragma("unroll") for (int jj = 0; jj < 2; ++jj) { \
      __builtin_amdgcn_global_load_lds((const unsigned*)(kb_ + kofs[jj]), (unsigned*)(Kb + (bf) * 8192 + (2 * wu + jj) * 1024), 16, 0, 0); \
      __builtin_amdgcn_global_load_lds((const unsigned*)(vb_ + vofs[jj]), (unsigned*)(Vb + (bf) * 8192 + (2 * wu + jj) * 1024), 16, 0, 0); } } while (0)
  DB_DMA(0, 0);
  asm volatile("s_waitcnt vmcnt(0)" ::: "memory");
  __syncthreads();

  f32x4 o[2][2][8];
  float mrun[2][2], lrun[2][2];
#pragma unroll
  for (int m = 0; m < 2; ++m)
#pragma unroll
    for (int qt = 0; qt < 2; ++qt) {
      mrun[m][qt] = NEG_BIG; lrun[m][qt] = 0.f;
#pragma unroll
      for (int dt = 0; dt < 8; ++dt) o[m][qt][dt] = (f32x4){0.f, 0.f, 0.f, 0.f};
    }
  const int kfr = 8 * (lr >> 2) + (lr & 3);
  for (int st = 0; st < nsteps; ++st) {
    if (st + 1 < nsteps) DB_DMA(st + 1, (st + 1) & 1);
    const unsigned char* Kt = Kb + (st & 1) * 8192;
    const unsigned char* Vt = Vb + (st & 1) * 8192;
    bf16x8 pf[2][2];
#pragma unroll
    for (int m = 0; m < 2; ++m) {
      bf16x8 kf[2][2];
#pragma unroll
      for (int kt = 0; kt < 2; ++kt)
#pragma unroll
        for (int ks = 0; ks < 2; ++ks) kf[kt][ks] = *(const bf16x8*)(Kt + (kfr + 4 * kt) * 256 + (((m * 8 + ks * 4 + g) ^ lr) << 4));
#pragma unroll
      for (int qt = 0; qt < 2; ++qt) {
        const int qrow = 32 * w + 16 * qt + lr;
        f32x4 s[2];
        s[0] = (f32x4){0.f, 0.f, 0.f, 0.f}; s[1] = s[0];
#pragma unroll
        for (int ks = 0; ks < 2; ++ks) {
          const bf16x8 qf = *(const bf16x8*)(Qb + qrow * 256 + (((m * 8 + ks * 4 + g) ^ lr) << 4));
          s[0] = mfma16(kf[0][ks], qf, s[0]);
          s[1] = mfma16(kf[1][ks], qf, s[1]);
        }
        float mt = NEG_BIG;
#pragma unroll
        for (int kt = 0; kt < 2; ++kt)
#pragma unroll
          for (int r = 0; r < 4; ++r) { s[kt][r] *= SC_LOG2; mt = fmaxf(mt, s[kt][r]); }
        mt = fmaxf(mt, __shfl_xor(mt, 16));
        mt = fmaxf(mt, __shfl_xor(mt, 32));
        const bool need = mt > mrun[m][qt] + 8.f;
        if (__any(need)) {
          const float mnew = need ? mt : mrun[m][qt];
          const float alpha = __builtin_amdgcn_exp2f(mrun[m][qt] - mnew);
          lrun[m][qt] *= alpha;
#pragma unroll
          for (int dt = 0; dt < 8; ++dt) { o[m][qt][dt][0] *= alpha; o[m][qt][dt][1] *= alpha; o[m][qt][dt][2] *= alpha; o[m][qt][dt][3] *= alpha; }
          mrun[m][qt] = mnew;
        }
        float pv[8], ls = 0.f;
#pragma unroll
        for (int kt = 0; kt < 2; ++kt)
#pragma unroll
          for (int r = 0; r < 4; ++r) { pv[kt * 4 + r] = __builtin_amdgcn_exp2f(s[kt][r] - mrun[m][qt]); ls += pv[kt * 4 + r]; }
        lrun[m][qt] += ls;
        u32x4 pk = {pk2(pv[0], pv[1]), pk2(pv[2], pv[3]), pk2(pv[4], pv[5]), pk2(pv[6], pv[7])};
        pf[m][qt] = __builtin_bit_cast(bf16x8, pk);
        __builtin_amdgcn_sched_barrier(0);
      }
    }
#pragma unroll
    for (int dt = 0; dt < 8; ++dt) {
      const int vr = 16 * dt + lr;
      const bf16x8 vf = *(const bf16x8*)(Vt + vr * 64 + ((g ^ ((vr >> 2) & 3)) << 4));
#pragma unroll
      for (int m = 0; m < 2; ++m)
#pragma unroll
        for (int qt = 0; qt < 2; ++qt) o[m][qt][dt] = mfma16(vf, pf[m][qt], o[m][qt][dt]);
      if ((dt & 1) == 1) __builtin_amdgcn_sched_barrier(0);
    }
    asm volatile("s_waitcnt vmcnt(0)" ::: "memory");
    __syncthreads();
  }
#undef DB_DMA
  const float* lv = p.dlam + l * 256;
  float sa = lv[lane] * lv[64 + lane], sb = lv[128 + lane] * lv[192 + lane];
  sa = wave_sum(sa); sb = wave_sum(sb);
  const float lam_init = 0.8f - 0.6f * expf(-0.3f * (float)l);
  const float lam = expf(sa) - expf(sb) + lam_init;
  const float* dg = p.diff_g + l * 512 + hd * 128;
#pragma unroll
  for (int qt = 0; qt < 2; ++qt) {
    float l0 = lrun[0][qt], l1 = lrun[1][qt];
    l0 += __shfl_xor(l0, 16); l0 += __shfl_xor(l0, 32);
    l1 += __shfl_xor(l1, 16); l1 += __shfl_xor(l1, 32);
    const float i0 = 1.f / l0, i1 = lam / l1;
    float ss = 0.f;
#pragma unroll
    for (int dt = 0; dt < 8; ++dt)
#pragma unroll
      for (int r = 0; r < 4; ++r) { const float v = o[0][qt][dt][r] * i0 - o[1][qt][dt][r] * i1; o[0][qt][dt][r] = v; ss += v * v; }
    ss += __shfl_xor(ss, 16);
    ss += __shfl_xor(ss, 32);
    const float rstd = rsqrtf(ss * (1.f / 128.f) + 1e-6f) * (1.f - lam_init);
    const int qtok = qtok0 + 32 * w + 16 * qt + lr;
#pragma unroll
    for (int dt = 0; dt < 8; ++dt) {
      const float4 gg = *(const float4*)(dg + dt * 16 + 4 * g);
      u32x2 ov = {pk2(o[0][qt][dt][0] * rstd * gg.x, o[0][qt][dt][1] * rstd * gg.y), pk2(o[0][qt][dt][2] * rstd * gg.z, o[0][qt][dt][3] * rstd * gg.w)};
      *(u32x2*)(Y + (size_t)qtok * 1024 + 512 + hd * 128 + dt * 16 + 4 * g) = ov;
    }
  }
}

DI void nat_wave_task(const Params& p, int l, int b, int head, int rq, int ct, const float* rpb_lds) {
  const int lane = ltid() & 63, lr = lane & 15, g = lane >> 4;
  const bf16_t* PN = (const bf16_t*)(p.ws + OFF_P);
  const bf16_t* VT = (const bf16_t*)(p.ws + OFF_VT);
  bf16_t* Y = (bf16_t*)(p.ws + OFF_Y);
  SrcNat S;
  S.PN = PN; S.VT = VT; S.kcol = C_NK + head * 64; S.vrow = R_NV + head * 64; S.b = b; S.rq = rq; S.lr = lr; S.g = g;
  int rs = rq - 4; rs = rs < 0 ? 0 : (rs > 24 ? 24 : rs);
  S.rs = rs;
  int cs = 16 * ct - 8; cs = cs < 0 ? 0 : (cs > 32 ? 32 : cs);
  S.cs = cs;
  S.qc = 16 * ct + lr;
  int cst = S.qc - 8; cst = cst < 0 ? 0 : (cst > 48 ? 48 : cst);
  S.cstart = cst;
  S.rpbh = rpb_lds + head * 465;
  f32x4 o[1][4];
  float lt[1];
  const int qtok = b * 2048 + rq * 64 + 16 * ct + lr;
  flash_wave<1, 4, SrcNat>(S, PN + (size_t)qtok * PN_LD + C_NQ + head * 64 + 8 * g, o, lt);
  const float inv = 1.f / lt[0];
#pragma unroll
  for (int dt = 0; dt < 4; ++dt) {
    u32x2 ov = {pk2(o[0][dt][0] * inv, o[0][dt][1] * inv), pk2(o[0][dt][2] * inv, o[0][dt][3] * inv)};
    *(u32x2*)(Y + (size_t)qtok * 1024 + 256 + head * 64 + dt * 16 + 4 * g) = ov;
  }
}
DI void natctx_wave_task(const Params& p, int b, int head, int qt) {
  const int lane = ltid() & 63, lr = lane & 15, g = lane >> 4;
  const bf16_t* PN = (const bf16_t*)(p.ws + OFF_P);
  const bf16_t* VT = (const bf16_t*)(p.ws + OFF_VT);
  bf16_t* Y = (bf16_t*)(p.ws + OFF_Y);
  SrcSeg S;
  S.PN = PN; S.VT = VT; S.kcol = C_NK + head * 64; S.vrow = R_NV + head * 64; S.lr = lr; S.g = g;
  S.t0 = TL + b * 256; S.n0 = 8; S.t1 = 0; S.n1 = 0;
  f32x4 o[1][4];
  float lt[1];
  const int qtok = TL + b * 256 + qt * 16 + lr;
  flash_wave<1, 4, SrcSeg>(S, PN + (size_t)qtok * PN_LD + C_NQ + head * 64 + 8 * g, o, lt);
  const float inv = 1.f / lt[0];
#pragma unroll
  for (int dt = 0; dt < 4; ++dt) {
    u32x2 ov = {pk2(o[0][dt][0] * inv, o[0][dt][1] * inv), pk2(o[0][dt][2] * inv, o[0][dt][3] * inv)};
    *(u32x2*)(Y + (size_t)qtok * 1024 + 256 + head * 64 + dt * 16 + 4 * g) = ov;
  }
}

DI float quad_sum(float v) {
  v += __int_as_float(__builtin_amdgcn_mov_dpp(__float_as_int(v), 0xB1, 0xF, 0xF, true));
  v += __int_as_float(__builtin_amdgcn_mov_dpp(__float_as_int(v), 0x4E, 0xF, 0xF, true));
  return v;
}
DI void gla_task(const Params& p, int l, int task, unsigned char* lds, int var = 0) {
  const int tid = ltid(), lane = tid & 63, w = tid >> 6, vv = lane >> 2, g = lane & 3;
  const int b = task >> 3, h = (task >> 1) & 3, dir = task & 1;
  const bf16_t* PN = (const bf16_t*)(p.ws + OFF_P);
  const bf16_t* VT = (const bf16_t*)(p.ws + OFF_VT);
  float* og = (float*)(p.ws + OFF_H);
  float* Gup = (float*)lds;
  float* Gb = Gup + 512;
  float* As = Gb + 32;
  float* Ks = As + 2048;
  float* Qs = Ks + 2048;
  float* Vs = Qs + 2048;
  __syncthreads();
  for (int e = tid; e < 512; e += 256) { const int r = e >> 5, kd = e & 31; Gup[e] = p.gate_up[((size_t)(l * 2 + dir) * 16 + r) * 128 + h * 32 + kd]; }
  if (tid < 32) Gb[tid] = p.gate_b[(l * 2 + dir) * 128 + h * 32 + tid];
  float S[8];
#pragma unroll
  for (int e = 0; e < 8; ++e) S[e] = 0.f;
  const int si = tid >> 2, part = tid & 3;
  u32x4 rq, rk, rg0, rg1, rv0, rv1;
#define GLA_TOK0(cc) ((cc) < 4 ? TL + b * 256 + (dir == 0 ? (cc) : 3 - (cc)) * 64 : b * 2048 + (dir == 0 ? (cc) - 4 : 35 - (cc)) * 64)
#define GLA_LOAD(cc) do { const int t0_ = GLA_TOK0(cc); const bf16_t* row = PN + (size_t)(t0_ + si) * PN_LD; \
    rq = *(const u32x4*)(row + C_GQ + h * 32 + part * 8); rk = *(const u32x4*)(row + C_GK + h * 32 + part * 8); \
    rg0 = *(const u32x4*)(row + C_GATE + dir * 16); rg1 = *(const u32x4*)(row + C_GATE + dir * 16 + 8); \
    const bf16_t* vp = VT + (size_t)(R_GV + h * 64 + si) * TT + t0_ + part * 16; rv0 = *(const u32x4*)vp; rv1 = *(const u32x4*)(vp + 8); } while (0)
#define GLA_WRITE() do { float gd[16], qf[8], kf[8], vf[16]; \
    unpack8(rg0, gd); unpack8(rg1, gd + 8); unpack8(rq, qf); unpack8(rk, kf); unpack8(rv0, vf); unpack8(rv1, vf + 8); \
    _Pragma("unroll") for (int e = 0; e < 8; ++e) { const int kd = part * 8 + e; float pre = Gb[kd]; \
      _Pragma("unroll") for (int r = 0; r < 16; ++r) pre += gd[r] * Gup[r * 32 + kd]; \
      const float ls = fminf(pre, 0.f) - log1pf(__expf(-fabsf(pre))); \
      As[si * 32 + kd] = __expf(ls * (1.f / 16.f)); Ks[si * 32 + kd] = kf[e]; Qs[si * 32 + kd] = qf[e] * 0.17677669529663687f; } \
    _Pragma("unroll") for (int e = 0; e < 16; ++e) Vs[(part * 16 + e) * 65 + si] = vf[e]; } while (0)
  GLA_LOAD(0);
  __syncthreads();
  GLA_WRITE();
  __syncthreads();
  for (int cc = 0; cc < 36; ++cc) {
    const int tok0 = GLA_TOK0(cc);
    if (cc + 1 < 36) GLA_LOAD(cc + 1);
    float* ob = og + ((size_t)dir * TT + tok0) * 256 + h * 64 + 16 * w + vv;
#pragma unroll 1
    for (int s0 = 0; s0 < (var == 3 ? 4 : 64); s0 += 4) {
      float4 a0[4], a1[4], k0[4], k1[4], q0[4], q1[4];
      float vx[4];
#pragma unroll
      for (int u = 0; u < 4; ++u) {
        const int i = dir == 0 ? s0 + u : 63 - s0 - u;
        a0[u] = *(const float4*)(As + i * 32 + 8 * g); a1[u] = *(const float4*)(As + i * 32 + 8 * g + 4);
        k0[u] = *(const float4*)(Ks + i * 32 + 8 * g); k1[u] = *(const float4*)(Ks + i * 32 + 8 * g + 4);
        q0[u] = *(const float4*)(Qs + i * 32 + 8 * g); q1[u] = *(const float4*)(Qs + i * 32 + 8 * g + 4);
        vx[u] = Vs[i * 65 + 16 * w + vv];
      }
#pragma unroll
      for (int u = 0; u < 4; ++u) {
        const int i = dir == 0 ? s0 + u : 63 - s0 - u;
        const float v = vx[u];
        S[0] = fmaf(a0[u].x, S[0], k0[u].x * v); S[1] = fmaf(a0[u].y, S[1], k0[u].y * v);
        S[2] = fmaf(a0[u].z, S[2], k0[u].z * v); S[3] = fmaf(a0[u].w, S[3], k0[u].w * v);
        S[4] = fmaf(a1[u].x, S[4], k1[u].x * v); S[5] = fmaf(a1[u].y, S[5], k1[u].y * v);
        S[6] = fmaf(a1[u].z, S[6], k1[u].z * v); S[7] = fmaf(a1[u].w, S[7], k1[u].w * v);
        const float oa = fmaf(q0[u].x, S[0], q0[u].y * S[1]), ob2 = fmaf(q0[u].z, S[2], q0[u].w * S[3]);
        const float oc = fmaf(q1[u].x, S[4], q1[u].y * S[5]), od = fmaf(q1[u].z, S[6], q1[u].w * S[7]);
        float o = (oa + ob2) + (oc + od);
        o = quad_sum(o);
        if (var == 1) asm volatile("" :: "v"(o)); else if (g == 0) ob[(size_t)i * 256] = o;
      }
    }
    __syncthreads();
    if (cc + 1 < 36 && var != 2) GLA_WRITE();
    __syncthreads();
  }
#undef GLA_TOK0
#undef GLA_LOAD
#undef GLA_WRITE
}

DI void phase_mixers(const Params& p, int l, bool last, unsigned* ctr, unsigned char* lds, int mask = 7, int gvar = 0) {
  const int tid = ltid(), w = tid >> 6;
  volatile int* slot = (volatile int*)(lds + LDS_BYTES - 16);
  float* rpb_lds = (float*)(lds + 65536);
  for (int e = tid; e < 4 * 465; e += 256) rpb_lds[e] = p.rpb[(size_t)l * 4 * 465 + e];
  const int ntask = 128 + 1024 + 2048 + (last ? 0 : 128 + 256);
  for (;;) {
    __syncthreads();
    if (tid == 0) *slot = (int)atomicAdd(ctr, 1u);
    __syncthreads();
    const int task = *slot;
    if (task >= ntask) break;
    if (task < 128) { if (mask & 1) { __builtin_amdgcn_s_setprio(3); gla_task(p, l, task, lds, gvar); __builtin_amdgcn_s_setprio(0); } }
    else if (!(mask & 2) && (task < 128 + 1024 || (task >= 128 + 1024 + 2048 && task < 128 + 1024 + 2048 + 128))) {}
    else if (!(mask & 4) && ((task >= 128 + 1024 && task < 128 + 1024 + 2048) || task >= 128 + 1024 + 2048 + 128)) {}
    else if (task < 128 + 1024) { const int d = task - 128; const int b = d >> 6; diff_block_task(p, l, b, (d >> 4) & 3, b * 2048 + (d & 15) * 128, 72, lds); }
    else if (task < 128 + 1024 + 2048) { const int wt = (task - 128 - 1024) * 4 + w; nat_wave_task(p, l, wt >> 9, (wt >> 7) & 3, (wt >> 2) & 31, wt & 3, rpb_lds); }
    else if (task < 128 + 1024 + 2048 + 128) { const int d = task - 128 - 1024 - 2048; const int b = d >> 3; diff_block_task(p, l, b, (d >> 1) & 3, TL + b * 256 + (d & 1) * 128, 8, lds); }
    else { const int wt = (task - 128 - 1024 - 2048 - 128) * 4 + w; natctx_wave_task(p, wt >> 6, (wt >> 4) & 3, wt & 15); }
  }
}

DI void phase_gla_fin(const Params& p, int l, int ntok) {
  const int lane = ltid() & 63, gw = lbid() * 4 + (ltid() >> 6), nw = lgdim() * 4;
  const float* og = (const float*)(p.ws + OFF_H);
  const bf16_t* PN = (const bf16_t*)(p.ws + OFF_P);
  bf16_t* Y = (bf16_t*)(p.ws + OFF_Y);
  const float4 gg = *(const float4*)(p.gla_norm_g + l * 256 + 4 * lane);
  for (int t = gw; t < ntok; t += nw) {
    const float4 a = *(const float4*)(og + (size_t)t * 256 + 4 * lane), bq = *(const float4*)(og + ((size_t)TT + t) * 256 + 4 * lane);
    const float o0 = a.x + bq.x, o1 = a.y + bq.y, o2 = a.z + bq.z, o3 = a.w + bq.w;
    float ss = o0 * o0 + o1 * o1 + o2 * o2 + o3 * o3;
    ss += __shfl_xor(ss, 1); ss += __shfl_xor(ss, 2); ss += __shfl_xor(ss, 4); ss += __shfl_xor(ss, 8);
    const float rstd = rsqrtf(ss * (1.f / 64.f) + 1e-6f);
    const u32x2 rv = *(const u32x2*)(PN + (size_t)t * PN_LD + C_GR + 4 * lane);
    const float r0 = bflo(rv.x), r1 = bfhi(rv.x), r2 = bflo(rv.y), r3 = bfhi(rv.y);
    const float y0 = o0 * rstd * gg.x * (r0 / (1.f + __expf(-r0)));
    const float y1 = o1 * rstd * gg.y * (r1 / (1.f + __expf(-r1)));
    const float y2 = o2 * rstd * gg.z * (r2 / (1.f + __expf(-r2)));
    const float y3 = o3 * rstd * gg.w * (r3 / (1.f + __expf(-r3)));
    u32x2 ov = {pk2(y0, y1), pk2(y2, y3)};
    *(u32x2*)(Y + (size_t)t * 1024 + 4 * lane) = ov;
  }
}

struct PairTab { int a[52], b[52]; };
constexpr PairTab make_pairs() {
  PairTab t{};
  int n = 0;
  for (int a = 0; a < 16; ++a)
    for (int b = 0; b < 16; ++b)
      if ((a + 1) * (b + 1) <= 16) { t.a[n] = a; t.b[n] = b; ++n; }
  for (; n < 52; ++n) { t.a[n] = -1; t.b[n] = -1; }
  return t;
}

DI void topk_half(const bf16_t* skh  , const bf16_t* qrow  , int lr, int g, float (&list)[16]) {
  bf16x8 qf[2];
  qf[0] = *(const bf16x8*)(qrow); qf[1] = *(const bf16x8*)(qrow + 32);
  float s[32];
#pragma unroll
  for (int nt = 0; nt < 8; ++nt) {
    f32x4 acc = {0.f, 0.f, 0.f, 0.f};
#pragma unroll
    for (int ks = 0; ks < 2; ++ks) {
      const bf16x8 af = *(const bf16x8*)(skh + (size_t)(nt * 16 + lr) * 64 + ks * 32 + 8 * g);
      acc = mfma16(af, qf[ks], acc);
    }
#pragma unroll
    for (int r = 0; r < 4; ++r) {
      const unsigned n = nt * 16 + 4 * g + r;
      s[nt * 4 + r] = __uint_as_float((__float_as_uint(acc[r]) & ~127u) | n);
    }
  }
#pragma unroll
  for (int k = 0; k < 16; ++k) {
    float m = s[0];
#pragma unroll
    for (int i = 1; i < 32; ++i) m = fmaxf(m, s[i]);
    m = fmaxf(m, __shfl_xor(m, 16));
    m = fmaxf(m, __shfl_xor(m, 32));
    list[k] = m;
#pragma unroll
    for (int i = 0; i < 32; ++i) s[i] = (s[i] == m) ? -3.0e38f : s[i];
  }
}

DI void phase_topk(const Params& p, int l, int ntok) {
  constexpr PairTab PT = make_pairs();
  const int lane = ltid() & 63, lr = lane & 15, g = lane >> 4;
  const int gw = lbid() * 4 + (ltid() >> 6), nw = lgdim() * 4;
  const bf16_t* QP = (const bf16_t*)(p.ws + OFF_QP);
  const bf16_t* sk = (const bf16_t*)(p.ws + OFF_SK) + (size_t)l * 2 * 128 * 64;
  int* eid = (int*)(p.ws + OFF_EID);
  float* gate = (float*)(p.ws + OFF_GATE);
  const int ntask = (ntok / 16) * 8;
  for (int task = gw; task < ntask; task += nw) {
    const int tt = task >> 3, hd = task & 7;
    const int tok = tt * 16 + lr;
    float v1[16], v2[16];
    topk_half(sk, QP + (size_t)tok * 1024 + hd * 128 + 8 * g, lr, g, v1);
    topk_half(sk + 128 * 64, QP + (size_t)tok * 1024 + hd * 128 + 64 + 8 * g, lr, g, v2);
    float cand[13];
    int ceid[13];
#pragma unroll
    for (int c = 0; c < 13; ++c) {
      float sv[4];
      int ev[4];
#pragma unroll
      for (int gi = 0; gi < 4; ++gi) {
        const int pi = 4 * c + gi;
        if (PT.a[pi] >= 0) {
          const float a = v1[PT.a[pi] < 0 ? 0 : PT.a[pi]], bq = v2[PT.b[pi] < 0 ? 0 : PT.b[pi]];
          sv[gi] = __uint_as_float((__float_as_uint(a + bq) & ~63u) | (unsigned)pi);
          ev[gi] = (int)((__float_as_uint(a) & 127u) * 128u + (__float_as_uint(bq) & 127u));
        } else { sv[gi] = -3.0e38f; ev[gi] = 0; }
      }
      cand[c] = g == 0 ? sv[0] : (g == 1 ? sv[1] : (g == 2 ? sv[2] : sv[3]));
      ceid[c] = g == 0 ? ev[0] : (g == 1 ? ev[1] : (g == 2 ? ev[2] : ev[3]));
    }
    float topv[16];
#pragma unroll
    for (int k = 0; k < 16; ++k) {
      float m = cand[0];
#pragma unroll
      for (int c = 1; c < 13; ++c) m = fmaxf(m, cand[c]);
      m = fmaxf(m, __shfl_xor(m, 16));
      m = fmaxf(m, __shfl_xor(m, 32));
      topv[k] = m;
      int my = -1;
#pragma unroll
      for (int c = 0; c < 13; ++c) { if (cand[c] == m) { my = ceid[c]; cand[c] = -3.0e38f; } }
      if (my >= 0) eid[(size_t)tok * 128 + hd * 16 + k] = my;
    }
    if (g == 0) {
      float ex[16], sum = 0.f;
#pragma unroll
      for (int k = 0; k < 16; ++k) { ex[k] = __expf(topv[k] - topv[0]); sum += ex[k]; }
      const float inv = 1.f / sum;
#pragma unroll
      for (int q = 0; q < 4; ++q) {
        float4 o = {ex[4 * q] * inv, ex[4 * q + 1] * inv, ex[4 * q + 2] * inv, ex[4 * q + 3] * inv};
        *(float4*)(gate + (size_t)tok * 128 + hd * 16 + 4 * q) = o;
      }
    }
  }
}

DI float gelu_tanh(float x) {
  const float z = 0.7978845608028654f * (x + 0.044715f * x * x * x);
  const float e = __expf(2.f * z);
  const float th = 1.f - 2.f / (e + 1.f);
  return 0.5f * x * (1.f + th);
}
DI void phase_gather(const Params& p, int l, int ntok, unsigned char* lds, bool dry = false) {
  const int tid = ltid(), lane = tid & 63, w = tid >> 6, lr = lane & 15, g = lane >> 4;
  const int gw = lbid() * 4 + w, nw = lgdim() * 4;
  const unsigned char* U8 = p.ws + OFF_U + (size_t)l * 16384 * 1024;
  const unsigned char* V8 = p.ws + OFF_V + (size_t)l * 16384 * 1024;
  const float* uscl = (const float*)(p.ws + OFF_USCL) + l * 16384;
  const float* vscl = (const float*)(p.ws + OFF_VSCL) + l * 16384;
  const unsigned char* H8 = p.ws + OFF_H8;
  const float* hinv = (const float*)(p.ws + OFF_HINV);
  const int* eid = (const int*)(p.ws + OFF_EID);
  const float* gate = (const float*)(p.ws + OFF_GATE);
  float* xres = (float*)(p.ws + OFF_XRES);
  const float* modbuf = (const float*)(p.ws + OFF_MOD);
  unsigned char* hl = lds + w * 1024;
  for (int t = gw; t < ntok; t += nw) {
    {
      const u32x4 hq = *(const u32x4*)(H8 + (size_t)t * 1024 + lane * 16);
      *(u32x4*)(hl + lane * 16) = hq;
    }
    const float hs = hinv[t];
    const int e0 = eid[(size_t)t * 128 + lane], e1 = eid[(size_t)t * 128 + 64 + lane];
    const float su0 = uscl[e0] * hs, su1 = uscl[e1] * hs;
    const float gv0 = gate[(size_t)t * 128 + lane] * vscl[e0], gv1 = gate[(size_t)t * 128 + 64 + lane] * vscl[e1];
    float out[16];
#pragma unroll
    for (int i = 0; i < 16; ++i) out[i] = 0.f;
#pragma unroll 1
    for (int grp = 0; grp < 8; ++grp) {
      const int esel = grp < 4 ? e0 : e1;
      const float susel = grp < 4 ? su0 : su1, gvsel = grp < 4 ? gv0 : gv1;
      const int lb = (grp & 3) * 16;
      const int erow = __shfl(esel, lb + lr);
      const unsigned char* ur = U8 + (size_t)erow * 1024 + g * 16;
      u32x4 ub[16], va[8];
#pragma unroll
      for (int c = 0; c < 16; ++c) ub[c] = *(const u32x4*)(ur + c * 64);
#pragma unroll
      for (int j = 0; j < 8; ++j) {
        const int ej = __builtin_amdgcn_readlane(esel, lb + j);
        va[j] = *(const u32x4*)(V8 + (size_t)ej * 1024 + lane * 16);
      }
      f32x4 acc = {0.f, 0.f, 0.f, 0.f};
#pragma unroll
      for (int c = 0; c < 16; ++c) {
        const long b0 = *(const long*)(hl + c * 64 + g * 16), b1 = *(const long*)(hl + c * 64 + g * 16 + 8);
        const long a0 = __builtin_bit_cast(long, (u32x2){ub[c].x, ub[c].y}), a1 = __builtin_bit_cast(long, (u32x2){ub[c].z, ub[c].w});
        acc = __builtin_amdgcn_mfma_f32_16x16x32_fp8_fp8(a0, b0, acc, 0, 0, 0);
        acc = __builtin_amdgcn_mfma_f32_16x16x32_fp8_fp8(a1, b1, acc, 0, 0, 0);
        if ((c & 3) == 3) __builtin_amdgcn_sched_barrier(0);
      }
      u32x4 vb[8];
#pragma unroll
      for (int j = 0; j < 8; ++j) {
        const int ej = __builtin_amdgcn_readlane(esel, lb + 8 + j);
        vb[j] = *(const u32x4*)(V8 + (size_t)ej * 1024 + lane * 16);
      }
      float wv[4];
#pragma unroll
      for (int r = 0; r < 4; ++r) {
        const float sur = __shfl(susel, lb + 4 * g + r), gvr = __shfl(gvsel, lb + 4 * g + r);
        wv[r] = gvr * gelu_tanh(acc[r] * sur);
      }
#pragma unroll
      for (int j = 0; j < 16; ++j) {
        const float wj = __int_as_float(__builtin_amdgcn_readlane(__float_as_int(wv[j & 3]), 16 * (j >> 2)));
        const u32x4 vv = j < 8 ? va[j & 7] : vb[j & 7];
#pragma unroll
        for (int q = 0; q < 4; ++q) {
          const f32x2 lo = __builtin_amdgcn_cvt_pk_f32_fp8((int)vv[q], false), hi = __builtin_amdgcn_cvt_pk_f32_fp8((int)vv[q], true);
          out[4 * q + 0] += wj * lo[0]; out[4 * q + 1] += wj * lo[1]; out[4 * q + 2] += wj * hi[0]; out[4 * q + 3] += wj * hi[1];
        }
      }
    }
    const int b = t < TL ? (t >> 11) : 16;
    const float* md = modbuf + ((size_t)l * 17 + b) * 6144 + 5 * 1024 + 16 * lane;
    float* xr = xres + (size_t)t * 1024 + 16 * lane;
#pragma unroll
    for (int q = 0; q < 4; ++q) {
      const float4 m4 = *(const float4*)(md + 4 * q);
      float4 xv = *(const float4*)(xr + 4 * q);
      xv.x += m4.x * out[4 * q + 0]; xv.y += m4.y * out[4 * q + 1]; xv.z += m4.z * out[4 * q + 2]; xv.w += m4.w * out[4 * q + 3];
      if (!dry) *(float4*)(xr + 4 * q) = xv;
      else asm volatile("" :: "v"(xv.x), "v"(xv.y), "v"(xv.z), "v"(xv.w));
    }
  }
}

DI void phase_final(const Params& p) {
  const int lane = ltid() & 63, gw = lbid() * 4 + (ltid() >> 6), nw = lgdim() * 4;
  const float* xres = (const float*)(p.ws + OFF_XRES);
  for (int t = gw; t < TL; t += nw) {
    const float* src = xres + (size_t)t * 1024;
    float4 v[4];
    float ss = 0.f;
#pragma unroll
    for (int i = 0; i < 4; ++i) {
      v[i] = *(const float4*)(src + 4 * lane + 256 * i);
      ss += v[i].x * v[i].x + v[i].y * v[i].y + v[i].z * v[i].z + v[i].w * v[i].w;
    }
    ss = wave_sum(ss);
    const float rstd = rsqrtf(ss * (1.f / 1024.f) + 1e-6f);
#pragma unroll
    for (int i = 0; i < 4; ++i) {
      const int col = 4 * lane + 256 * i;
      const float4 g4 = *(const float4*)(p.final_g + col);
      float4 o = {v[i].x * rstd * g4.x, v[i].y * rstd * g4.y, v[i].z * rstd * g4.z, v[i].w * rstd * g4.w};
      *(float4*)(p.out + (size_t)t * 1024 + col) = o;
    }
  }
}


#define LAS __attribute__((address_space(3)))
#define XB_TMO      128
#define XB_XCNT(j)  (256  + 64 * (j))
#define XB_XSUB(j)  (1280 + 64 * (j))
#define XB_XGEN(j)  (2304 + 64 * (j))
#define XB_TOP      3328
#define XB_TOPGEN   3392
#define XCD_BAR_WORDS 3456
#define XB_SPIN_CAP (1u << 22)
DI unsigned xb_ld(unsigned* p) { return __hip_atomic_load(p, __ATOMIC_RELAXED, __HIP_MEMORY_SCOPE_AGENT); }
DI unsigned xb_add(unsigned* p, unsigned v) { return __hip_atomic_fetch_add(p, v, __ATOMIC_RELAXED, __HIP_MEMORY_SCOPE_AGENT); }
DI unsigned xb_xcc_id() { return (unsigned)__builtin_amdgcn_s_getreg((3 << 11) | 20) & 0xFu; }
#define XB_SPIN(cond, bar) do { unsigned _sp = 0; while (cond) { __builtin_amdgcn_s_sleep(1); \
    if ((++_sp & 255u) == 0u) { if (xb_ld(&(bar)[XB_TMO])) break; if (_sp > XB_SPIN_CAP) { atomicAdd(&(bar)[XB_TMO], 1u); break; } } } } while (0)
struct XcdBarrier { unsigned* bar; unsigned x; volatile unsigned* st; };
DI XcdBarrier xcd_barrier_post(unsigned* bar, volatile unsigned* st) {
  XcdBarrier b; b.bar = bar; b.x = xb_xcc_id(); b.st = st;
  if (threadIdx.x == 0) (void)xb_add(&bar[XB_XCNT(b.x)], 1u);
  return b;
}
DI void xcd_barrier_complete(unsigned* bar, unsigned x, unsigned& nloc, unsigned& nx) {
  const unsigned G = gridDim.x * gridDim.y * gridDim.z;
  unsigned sum, cnt, mine, sp = 0u;
  for (;;) {
    sum = 0u; cnt = 0u; mine = 0u;
#pragma unroll
    for (unsigned j = 0; j < 16; ++j) { const unsigned c = xb_ld(&bar[XB_XCNT(j)]); sum += c; cnt += (c > 0u) ? 1u : 0u; mine = (j == x) ? c : mine; }
    if (sum == G) break;
    __builtin_amdgcn_s_sleep(1);
    if ((++sp & 255u) == 0u) { if (xb_ld(&bar[XB_TMO])) break; if (sp > XB_SPIN_CAP) { atomicAdd(&bar[XB_TMO], 1u); break; } }
  }
  nloc = mine > 0u ? mine : 1u; nx = cnt > 0u ? cnt : 1u;
}
DI void xcd_barrier(const XcdBarrier& b) {
  asm volatile("s_waitcnt vmcnt(0)" ::: "memory");
  __syncthreads();
  if (threadIdx.x == 0) {
    unsigned* bar = b.bar;
    __builtin_amdgcn_s_waitcnt(0);
    unsigned nloc = b.st[0], nx = b.st[1];
    if (nloc == 0u) { xcd_barrier_complete(bar, b.x, nloc, nx); b.st[0] = nloc; b.st[1] = nx; }
    const unsigned old = xb_add(&bar[XB_XSUB(b.x)], 1u);
    const unsigned gen = old / nloc;
    if (old + 1u == (gen + 1u) * nloc) {
      __builtin_amdgcn_fence(__ATOMIC_RELEASE, "agent");
      asm volatile("s_waitcnt vmcnt(0)" ::: "memory");
      const unsigned og = xb_add(&bar[XB_TOP], 1u);
      const unsigned tg = og / nx;
      if (og + 1u == (tg + 1u) * nx) xb_add(&bar[XB_TOPGEN], 1u);
      else XB_SPIN(xb_ld(&bar[XB_TOPGEN]) == tg, bar);
      __builtin_amdgcn_fence(__ATOMIC_ACQUIRE, "agent");
      xb_add(&bar[XB_XGEN(b.x)], 1u);
      asm volatile("s_waitcnt vmcnt(0)" ::: "memory");
    } else {
      XB_SPIN(xb_ld(&bar[XB_XGEN(b.x)]) == gen, bar);
      __builtin_amdgcn_fence(__ATOMIC_ACQUIRE, "agent");
      asm volatile("s_waitcnt vmcnt(0)" ::: "memory");
    }
  }
  __syncthreads();
}

constexpr int PH_PER_LAYER = 10;
constexpr int N_PHASES = 1 + NL * PH_PER_LAYER + 1;

template <int KIND>
DI void run_phase(const Params& p, int ph, unsigned char* lds) {
  unsigned* ctl = (unsigned*)(p.ws + OFF_CTL);
  if (ph == 0) { if (KIND < 0 || KIND == 0) phase_prologue(p, lds); }
  else if (ph == N_PHASES - 1) { if (KIND < 0 || KIND == 11) phase_final(p); }
  else {
    const int l = (ph - 1) / PH_PER_LAYER, s = (ph - 1) % PH_PER_LAYER;
    const bool last = (l == NL - 1);
    const int ntok = last ? TL : TT;
    if (s == 0) { if (KIND < 0 || KIND == 1) phase_norm(p, l, 0, TT); }
    else if (s == 1) { if (KIND < 0 || KIND == 2) phase_gemm_in(p, l, lds); }
    else if (s == 2) { if (KIND < 0 || KIND == 3) phase_rope(p, lds); }
    else if (s == 3) { if (KIND < 0 || KIND == 4) phase_mixers(p, l, last, ctl + 64 * (1 + l), lds); }
    else if (s == 4) { if (KIND < 0 || KIND == 5) phase_gla_fin(p, l, ntok); }
    else if (s == 5) { if (KIND < 0 || KIND == 6) phase_gemm_out(p, l, ntok, lds); }
    else if (s == 6) { if (KIND < 0 || KIND == 7) phase_norm(p, l, 1, ntok); }
    else if (s == 7) { if (KIND < 0 || KIND == 8) phase_gemm_q(p, l, ntok, lds); }
    else if (s == 8) { if (KIND < 0 || KIND == 9) phase_topk(p, l, ntok); }
    else { if (KIND < 0 || KIND == 10) phase_gather(p, l, ntok, lds); }
  }
}

#if N_LAUNCH_MODE == 1
#ifndef PROBE_KIND
#define PROBE_KIND -1
#endif
#ifndef GLA_VAR
#define GLA_VAR 0
#endif
constexpr int CW_BAR = 4096;
__global__ void __launch_bounds__(256, 2) mk_fwd(Params p) {
  __shared__ __attribute__((aligned(16))) unsigned char lds[LDS_BYTES];
  unsigned* ctl = (unsigned*)(p.ws + OFF_CTL);
  volatile unsigned* st = (volatile unsigned*)(lds + LDS_BYTES - 32);
  if (threadIdx.x < 2) st[threadIdx.x] = 0u;
  __syncthreads();
  (void)xcd_barrier_post(ctl + CW_BAR, st);
#define GSYNC() do { XcdBarrier bb; bb.bar = (unsigned*)(p.ws + OFF_CTL) + CW_BAR; bb.x = xb_xcc_id(); bb.st = (volatile unsigned*)(lds + LDS_BYTES - 32); xcd_barrier(bb); } while (0)
  { Params q = p; { size_t z_ = 0; asm volatile("" : "+s"(z_)); q.ws = p.ws + z_; } phase_prologue(q, lds); } cg::this_grid().sync();
  if (PROBE_KIND == 0) { { Params q = p; { size_t z_ = 0; asm volatile("" : "+s"(z_)); q.ws = p.ws + z_; } phase_prologue(q, lds); } GSYNC(); }
  for (int l = 0; l < NL; ++l) {
    const bool last = (l == NL - 1);
    const int ntok = last ? TL : TT;
    { Params q = p; { size_t z_ = 0; asm volatile("" : "+s"(z_)); q.ws = p.ws + z_; } phase_norm(q, l, 0, TT); } GSYNC();
    if (PROBE_KIND == 1) { { Params q = p; { size_t z_ = 0; asm volatile("" : "+s"(z_)); q.ws = p.ws + z_; } phase_norm(q, l, 0, TT); } GSYNC(); }
    { Params q = p; { size_t z_ = 0; asm volatile("" : "+s"(z_)); q.ws = p.ws + z_; } phase_gemm_in(q, l, lds); } GSYNC();
    if (PROBE_KIND == 2) { { Params q = p; { size_t z_ = 0; asm volatile("" : "+s"(z_)); q.ws = p.ws + z_; } phase_gemm_in(q, l, lds); } GSYNC(); }
    { Params q = p; { size_t z_ = 0; asm volatile("" : "+s"(z_)); q.ws = p.ws + z_; } phase_rope(q, lds); } GSYNC();
    if (PROBE_KIND == 4 || (PROBE_KIND >= 41 && PROBE_KIND <= 47)) { { Params q = p; { size_t z_ = 0; asm volatile("" : "+s"(z_)); q.ws = p.ws + z_; } phase_mixers(q, l, last, ctl + 64 * (1 + l) + 1, lds, PROBE_KIND == 4 ? 7 : PROBE_KIND - 40, GLA_VAR); } GSYNC(); }
    { Params q = p; { size_t z_ = 0; asm volatile("" : "+s"(z_)); q.ws = p.ws + z_; } phase_mixers(q, l, last, ctl + 64 * (1 + l), lds); } GSYNC();
    { Params q = p; { size_t z_ = 0; asm volatile("" : "+s"(z_)); q.ws = p.ws + z_; } phase_gla_fin(q, l, ntok); } GSYNC();
    if (PROBE_KIND == 5) { { Params q = p; { size_t z_ = 0; asm volatile("" : "+s"(z_)); q.ws = p.ws + z_; } phase_gla_fin(q, l, ntok); } GSYNC(); }
    { Params q = p; { size_t z_ = 0; asm volatile("" : "+s"(z_)); q.ws = p.ws + z_; } phase_gemm_out(q, l, ntok, lds); } GSYNC();
    { Params q = p; { size_t z_ = 0; asm volatile("" : "+s"(z_)); q.ws = p.ws + z_; } phase_norm(q, l, 1, ntok); } GSYNC();
    if (PROBE_KIND == 7) { { Params q = p; { size_t z_ = 0; asm volatile("" : "+s"(z_)); q.ws = p.ws + z_; } phase_norm(q, l, 1, ntok); } GSYNC(); }
    { Params q = p; { size_t z_ = 0; asm volatile("" : "+s"(z_)); q.ws = p.ws + z_; } phase_gemm_q(q, l, ntok, lds); } GSYNC();
    if (PROBE_KIND == 8) { { Params q = p; { size_t z_ = 0; asm volatile("" : "+s"(z_)); q.ws = p.ws + z_; } phase_gemm_q(q, l, ntok, lds); } GSYNC(); }
    { Params q = p; { size_t z_ = 0; asm volatile("" : "+s"(z_)); q.ws = p.ws + z_; } phase_topk(q, l, ntok); } GSYNC();
    if (PROBE_KIND == 9) { { Params q = p; { size_t z_ = 0; asm volatile("" : "+s"(z_)); q.ws = p.ws + z_; } phase_topk(q, l, ntok); } GSYNC(); }
    if (PROBE_KIND == 10) { { Params q = p; { size_t z_ = 0; asm volatile("" : "+s"(z_)); q.ws = p.ws + z_; } phase_gather(q, l, ntok, lds, true); } GSYNC(); }
    { Params q = p; { size_t z_ = 0; asm volatile("" : "+s"(z_)); q.ws = p.ws + z_; } phase_gather(q, l, ntok, lds); } GSYNC();
  }
  { Params q = p; { size_t z_ = 0; asm volatile("" : "+s"(z_)); q.ws = p.ws + z_; } phase_final(q); }
}
#else
template <int KIND>
__global__ void __launch_bounds__(256, 2) mk_phase(Params p) {
  __shared__ __attribute__((aligned(16))) unsigned char lds[LDS_BYTES];
  run_phase<KIND>(p, p.ph_lo, lds);
}
#endif

extern "C" void kernel_launch(void* const* d_in, const int* in_sizes, int n_in, void* d_out, int out_size, void* d_ws,
                              size_t ws_size, hipStream_t stream) {
  static int grid = 0;
  if (grid == 0) {
    if (n_in != 21 || ws_size < WS_END || out_size != TL * DM) { fprintf(stderr, "kernel_launch: unexpected shapes (n_in %d ws %zu out %d)\n", n_in, ws_size, out_size); grid = -1; return; }
    int dev = 0, cus = 0, per_cu = 2;
    (void)hipGetDevice(&dev);
    (void)hipDeviceGetAttribute(&cus, hipDeviceAttributeMultiprocessorCount, dev);
#if N_LAUNCH_MODE == 1
    (void)hipOccupancyMaxActiveBlocksPerMultiprocessor(&per_cu, (const void*)mk_fwd, 256, 0);
    if (per_cu < 1) per_cu = 1;
    if (per_cu > 2) per_cu = 2;
#endif
    grid = cus * per_cu;
  }
  if (grid < 0) return;
  (void)hipMemsetAsync((char*)d_ws + OFF_CTL, 0, 65536, stream);
  Params p{};
  const float** pp = (const float**)&p;
  for (int i = 0; i < 21; ++i) pp[i] = (const float*)d_in[i];
  p.out = (float*)d_out;
  p.ws = (unsigned char*)d_ws;
#if N_LAUNCH_MODE == 1
  p.ph_lo = 0; p.ph_hi = N_PHASES;
  void* args[] = {&p};
  hipError_t e = hipLaunchCooperativeKernel((const void*)mk_fwd, dim3(grid), dim3(256), args, 0, stream);
  if (e != hipSuccess) fprintf(stderr, "cooperative launch failed: %s (grid %d)\n", hipGetErrorString(e), grid);
#else
  for (int ph = 0; ph < N_PHASES; ++ph) {
    p.ph_lo = ph; p.ph_hi = ph + 1;
    const int kind = ph == 0 ? 0 : (ph == N_PHASES - 1 ? 11 : 1 + (ph - 1) % PH_PER_LAYER);
    switch (kind) {
      case 0: hipLaunchKernelGGL(mk_phase<0>, dim3(grid), dim3(256), 0, stream, p); break;
      case 1: hipLaunchKernelGGL(mk_phase<1>, dim3(grid), dim3(256), 0, stream, p); break;
      case 2: hipLaunchKernelGGL(mk_phase<2>, dim3(grid), dim3(256), 0, stream, p); break;
      case 3: hipLaunchKernelGGL(mk_phase<3>, dim3(grid), dim3(256), 0, stream, p); break;
      case 4: hipLaunchKernelGGL(mk_phase<4>, dim3(grid), dim3(256), 0, stream, p); break;
      case 5: hipLaunchKernelGGL(mk_phase<5>, dim3(grid), dim3(256), 0, stream, p); break;
      case 6: hipLaunchKernelGGL(mk_phase<6>, dim3(grid), dim3(256), 0, stream, p); break;
      case 7: hipLaunchKernelGGL(mk_phase<7>, dim3(grid), dim3(256), 0, stream, p); break;
      case 8: hipLaunchKernelGGL(mk_phase<8>, dim3(grid), dim3(256), 0, stream, p); break;
      case 9: hipLaunchKernelGGL(mk_phase<9>, dim3(grid), dim3(256), 0, stream, p); break;
      case 10: hipLaunchKernelGGL(mk_phase<10>, dim3(grid), dim3(256), 0, stream, p); break;
      default: hipLaunchKernelGGL(mk_phase<11>, dim3(grid), dim3(256), 0, stream, p); break;
    }
  }
#endif
}
```

```cpp
#include <hip/hip_runtime.h>
#include <hip/hip_cooperative_groups.h>
#include <stdint.h>
#include <stdio.h>
namespace cg = cooperative_groups;

#ifndef N_LAUNCH_MODE
#define N_LAUNCH_MODE 1
#endif

#define DI __device__ __forceinline__
typedef unsigned short bf16_t;
typedef short bf16x8 __attribute__((ext_vector_type(8)));
typedef float f32x4 __attribute__((ext_vector_type(4)));
typedef float f32x2 __attribute__((ext_vector_type(2)));
typedef unsigned u32x4 __attribute__((ext_vector_type(4)));
typedef unsigned u32x2 __attribute__((ext_vector_type(2)));

constexpr int NB = 16, SEQ = 2048, DM = 1024, NL = 4, CTXL = 256;
constexpr int TL = NB * SEQ;
constexpr int TC = NB * CTXL;
constexpr int TT = TL + TC;
constexpr int PN_LD = 2176;
constexpr int C_GQ = 0, C_GK = 128, C_GR = 256, C_NQ = 512, C_NK = 768, C_DQ = 1024, C_DK = 1536, C_GATE = 2048;
constexpr int R_GV = 0, R_NV = 256, R_DV = 512;
constexpr float LOG2E = 1.4426950408889634f;
constexpr float SC_LOG2 = 0.125f * LOG2E;
constexpr float NEG_BIG = -1e30f;

constexpr size_t MiB = 1u << 20;
constexpr size_t OFF_CTL = 0;
constexpr size_t OFF_MOD = 1 * MiB;
constexpr size_t OFF_WIN = 3 * MiB;
constexpr size_t OFF_WOUT = 28 * MiB;
constexpr size_t OFF_WQ = 36 * MiB;
constexpr size_t OFF_SK = 44 * MiB;
constexpr size_t OFF_USCL = 44 * MiB + 256 * 1024;
constexpr size_t OFF_VSCL = 44 * MiB + 512 * 1024;
constexpr size_t OFF_U = 45 * MiB;
constexpr size_t OFF_V = 109 * MiB;
constexpr size_t OFF_XRES = 301 * MiB;
constexpr size_t OFF_H = 445 * MiB;
constexpr size_t OFF_P = 517 * MiB;
constexpr size_t OFF_VT = OFF_P + 153 * MiB;
constexpr size_t OFF_QP = OFF_P;
constexpr size_t OFF_EID = OFF_P + 72 * MiB;
constexpr size_t OFF_GATE = OFF_P + 90 * MiB;
constexpr size_t OFF_H8 = OFF_P + 126 * MiB;
constexpr size_t OFF_HINV = OFF_P + 162 * MiB;
constexpr size_t OFF_Y = 742 * MiB;
constexpr size_t WS_END = 814 * MiB;

constexpr int LDS_BYTES = 65536 + 8192;

struct Params {
  const float *x, *c, *ctx, *c_ctx, *ada_w, *ada_b, *norm1_g, *norm2_g, *w_in, *gate_up, *gate_b, *gla_norm_g,
      *rpb, *dlam, *diff_g, *w_out, *wq, *subkeys, *pu, *pv, *final_g;
  float* out;
  unsigned char* ws;
  int ph_lo, ph_hi;
};

DI int ltid() { int t = threadIdx.x; asm volatile("" : "+v"(t)); return t; }
DI int lbid() { int t = blockIdx.x; asm volatile("" : "+s"(t)); return t; }
DI int lgdim() { int t = gridDim.x; asm volatile("" : "+s"(t)); return t; }

DI unsigned f2bf(float f) { unsigned u = __float_as_uint(f); return (u + 0x7fffu + ((u >> 16) & 1u)) >> 16; }
typedef __bf16 bf16x2_t __attribute__((ext_vector_type(2)));
DI unsigned pk2(float lo, float hi) { f32x2 v = {lo, hi}; return __builtin_bit_cast(unsigned, __builtin_convertvector(v, bf16x2_t)); }
DI float bflo(unsigned u) { return __uint_as_float(u << 16); }
DI float bfhi(unsigned u) { return __uint_as_float(u & 0xffff0000u); }
DI void unpack8(const u32x4 v, float* f) {
  f[0] = bflo(v.x); f[1] = bfhi(v.x); f[2] = bflo(v.y); f[3] = bfhi(v.y);
  f[4] = bflo(v.z); f[5] = bfhi(v.z); f[6] = bflo(v.w); f[7] = bfhi(v.w);
}
DI float wave_sum(float v) {
#pragma unroll
  for (int o = 32; o >= 1; o >>= 1) v += __shfl_xor(v, o);
  return v;
}
DI f32x4 mfma16(bf16x8 a, bf16x8 b, f32x4 c) { return __builtin_amdgcn_mfma_f32_16x16x32_bf16(a, b, c, 0, 0, 0); }

DI int win_src_col(int r) {
  if (r < 256) return r;
  if (r < 512) return r - 256 + 512;
  if (r < 768) return r - 512 + 800;
  if (r < 1024) return r - 768 + 1056;
  if (r < 1536) return r - 1024 + 1568;
  if (r < 2048) return r - 1536 + 2080;
  if (r < 2080) return r - 2048 + 768;
  if (r < 2176) return -1;
  if (r < 2432) return r - 2176 + 256;
  if (r < 2688) return r - 2432 + 1312;
  return r - 2688 + 2592;
}

DI void transpose_item(const float* __restrict__ W, int N, int src, bf16_t* __restrict__ dst, float* lds) {
  const int tid = ltid();
  for (int kc = 0; kc < 8; ++kc) {
    __syncthreads();
#pragma unroll
    for (int i = 0; i < 16; ++i) {
      int k = i * 8 + (tid >> 5), n = tid & 31;
      lds[k * 33 + n] = (src < 0) ? 0.f : W[(size_t)(kc * 128 + k) * N + src + n];
    }
    __syncthreads();
    int row = tid >> 3, k0 = (tid & 7) * 16;
    unsigned o[8];
#pragma unroll
    for (int e = 0; e < 8; ++e) o[e] = pk2(lds[(k0 + 2 * e) * 33 + row], lds[(k0 + 2 * e + 1) * 33 + row]);
    u32x4 a = {o[0], o[1], o[2], o[3]}, b = {o[4], o[5], o[6], o[7]};
    bf16_t* d = dst + (size_t)row * 1024 + kc * 128 + k0;
    *(u32x4*)d = a; *(u32x4*)(d + 8) = b;
  }
}

DI void phase_prologue(const Params& p, unsigned char* lds) {
  const int tid = ltid(), nb = lgdim(), bid = lbid();
  bf16_t* winT = (bf16_t*)(p.ws + OFF_WIN);
  bf16_t* woutT = (bf16_t*)(p.ws + OFF_WOUT);
  bf16_t* wqT = (bf16_t*)(p.ws + OFF_WQ);
  constexpr int PER_LAYER = 100 + 32 + 32;
  for (int item = bid; item < NL * PER_LAYER; item += nb) {
    int l = item / PER_LAYER, r = item % PER_LAYER;
    if (r < 100) {
      int row = r * 32;
      transpose_item(p.w_in + (size_t)l * 1024 * 3104, 3104, win_src_col(row), winT + ((size_t)l * 3200 + row) * 1024, (float*)lds);
    } else if (r < 132) {
      int row = (r - 100) * 32;
      transpose_item(p.w_out + (size_t)l * 1024 * 1024, 1024, row, woutT + ((size_t)l * 1024 + row) * 1024, (float*)lds);
    } else {
      int row = (r - 132) * 32;
      transpose_item(p.wq + (size_t)l * 1024 * 1024, 1024, row, wqT + ((size_t)l * 1024 + row) * 1024, (float*)lds);
    }
  }
  {
    const int lane = tid & 63, gw = bid * 4 + (tid >> 6), nw = nb * 4;
    unsigned char* u8 = p.ws + OFF_U;
    unsigned char* v8 = p.ws + OFF_V;
    float* uscl = (float*)(p.ws + OFF_USCL);
    float* vscl = (float*)(p.ws + OFF_VSCL);
    for (int row = gw; row < 2 * NL * 16384; row += nw) {
      const int tab = row >= NL * 16384, r = tab ? row - NL * 16384 : row;
      const float* src = (tab ? p.pv : p.pu) + (size_t)r * 1024 + 16 * lane;
      float4 f[4];
      float am = 0.f;
#pragma unroll
      for (int i = 0; i < 4; ++i) {
        f[i] = *(const float4*)(src + 4 * i);
        am = fmaxf(am, fmaxf(fmaxf(fabsf(f[i].x), fabsf(f[i].y)), fmaxf(fabsf(f[i].z), fabsf(f[i].w))));
      }
#pragma unroll
      for (int o = 32; o >= 1; o >>= 1) am = fmaxf(am, __shfl_xor(am, o));
      const float sc = am > 0.f ? 448.f / am : 0.f;
      u32x4 q;
#pragma unroll
      for (int i = 0; i < 4; ++i) {
        int pk = 0;
        pk = __builtin_amdgcn_cvt_pk_fp8_f32(f[i].x * sc, f[i].y * sc, pk, false);
        pk = __builtin_amdgcn_cvt_pk_fp8_f32(f[i].z * sc, f[i].w * sc, pk, true);
        q[i] = (unsigned)pk;
      }
      *(u32x4*)((tab ? v8 : u8) + (size_t)r * 1024 + 16 * lane) = q;
      if (lane == 0) (tab ? vscl : uscl)[r] = am * (1.f / 448.f);
    }
  }
  {
    bf16_t* sk = (bf16_t*)(p.ws + OFF_SK);
    for (int i = bid * 256 + tid; i < NL * 2 * 128 * 64; i += nb * 256) sk[i] = (bf16_t)f2bf(p.subkeys[i]);
  }
  {
    float* modbuf = (float*)(p.ws + OFF_MOD);
    float* sc = (float*)lds;
    float* red = (float*)(lds + 17 * 512 * 4);
    for (int item = bid; item < NL * 96; item += nb) {
      const int l = item / 96, cb = item % 96, col = cb * 64 + (tid & 63), kq = tid >> 6;
      float acc[17];
#pragma unroll
      for (int r = 0; r < 17; ++r) acc[r] = 0.f;
      for (int half = 0; half < 2; ++half) {
        __syncthreads();
        for (int e = tid; e < 17 * 512; e += 256) {
          int r = e >> 9, k = e & 511;
          float cv = (r < 16) ? p.c[r * 1024 + half * 512 + k] : p.c_ctx[half * 512 + k];
          sc[e] = cv / (1.f + __expf(-cv));
        }
        __syncthreads();
        const float* wp = p.ada_w + ((size_t)l * 1024 + half * 512 + kq * 128) * 6144 + col;
        for (int kk = 0; kk < 128; ++kk) {
          const float w = wp[(size_t)kk * 6144];
#pragma unroll
          for (int r = 0; r < 17; ++r) acc[r] += sc[r * 512 + kq * 128 + kk] * w;
        }
      }
#pragma unroll
      for (int r = 0; r < 17; ++r) red[(kq * 17 + r) * 64 + (tid & 63)] = acc[r];
      __syncthreads();
      for (int e = tid; e < 17 * 64; e += 256) {
        int r = e >> 6, cc = e & 63;
        float s = red[(0 * 17 + r) * 64 + cc] + red[(1 * 17 + r) * 64 + cc] + red[(2 * 17 + r) * 64 + cc] + red[(3 * 17 + r) * 64 + cc];
        int colg = cb * 64 + cc;
        modbuf[((size_t)l * 17 + r) * 6144 + colg] = s + p.ada_b[l * 6144 + colg];
      }
      __syncthreads();
    }
  }
}

DI void phase_norm(const Params& p, int l, int which, int ntok) {
  const int lane = ltid() & 63, gw = lbid() * 4 + (ltid() >> 6), nw = lgdim() * 4;
  const float* gvec = (which == 0 ? p.norm1_g : p.norm2_g) + l * 1024;
  const int ish = which == 0 ? 0 : 3, isc = which == 0 ? 1 : 4;
  const float* xres = (const float*)(p.ws + OFF_XRES);
  const float* modbuf = (const float*)(p.ws + OFF_MOD);
  bf16_t* hbuf = (bf16_t*)(p.ws + OFF_H);
  for (int t = gw; t < ntok; t += nw) {
    const float* src = (which == 0 && l == 0) ? (t < TL ? p.x + (size_t)t * 1024 : p.ctx + (size_t)(t - TL) * 1024) : xres + (size_t)t * 1024;
    const int b = t < TL ? (t >> 11) : 16;
    const float* md = modbuf + ((size_t)l * 17 + b) * 6144;
    float4 v[4];
    float ss = 0.f;
#pragma unroll
    for (int i = 0; i < 4; ++i) {
      v[i] = *(const float4*)(src + 4 * lane + 256 * i);
      ss += v[i].x * v[i].x + v[i].y * v[i].y + v[i].z * v[i].z + v[i].w * v[i].w;
    }
    ss = wave_sum(ss);
    const float rstd = rsqrtf(ss * (1.f / 1024.f) + 1e-6f);
    float am = 0.f;
#pragma unroll
    for (int i = 0; i < 4; ++i) {
      const int col = 4 * lane + 256 * i;
      const float4 g4 = *(const float4*)(gvec + col), sh = *(const float4*)(md + ish * 1024 + col), sc = *(const float4*)(md + isc * 1024 + col);
      float o0 = v[i].x * rstd * g4.x * (1.f + sc.x) + sh.x;
      float o1 = v[i].y * rstd * g4.y * (1.f + sc.y) + sh.y;
      float o2 = v[i].z * rstd * g4.z * (1.f + sc.z) + sh.z;
      float o3 = v[i].w * rstd * g4.w * (1.f + sc.w) + sh.w;
      u32x2 o = {pk2(o0, o1), pk2(o2, o3)};
      *(u32x2*)(hbuf + (size_t)t * 1024 + col) = o;
      v[i].x = o0; v[i].y = o1; v[i].z = o2; v[i].w = o3;
      am = fmaxf(am, fmaxf(fmaxf(fabsf(o0), fabsf(o1)), fmaxf(fabsf(o2), fabsf(o3))));
    }
    if (which == 1) {
#pragma unroll
      for (int o = 32; o >= 1; o >>= 1) am = fmaxf(am, __shfl_xor(am, o));
      const float qs = am > 0.f ? 448.f / am : 0.f;
      unsigned char* h8 = p.ws + OFF_H8 + (size_t)t * 1024;
#pragma unroll
      for (int i = 0; i < 4; ++i) {
        int pk = 0;
        pk = __builtin_amdgcn_cvt_pk_fp8_f32(v[i].x * qs, v[i].y * qs, pk, false);
        pk = __builtin_amdgcn_cvt_pk_fp8_f32(v[i].z * qs, v[i].w * qs, pk, true);
        *(int*)(h8 + 4 * lane + 256 * i) = pk;
      }
      if (lane == 0) ((float*)(p.ws + OFF_HINV))[t] = am * (1.f / 448.f);
    }
  }
}

template <int EPI>
DI void gemm_tile(const bf16_t* __restrict__ P, const bf16_t* __restrict__ Q, int it, int jt, void* outp, int ld,
                  const float* xin_lat, const float* xin_ctx, const float* modl, unsigned char* lds) {
  const int tid = ltid(), lane = tid & 63, w = tid >> 6, wi = w >> 1, wj = w & 1, lr = lane & 15, g = lane >> 4;
  const int wu = __builtin_amdgcn_readfirstlane(w);
  f32x4 acc[4][4];
#pragma unroll
  for (int a = 0; a < 4; ++a)
#pragma unroll
    for (int b = 0; b < 4; ++b) acc[a][b] = (f32x4){0.f, 0.f, 0.f, 0.f};
  const unsigned lo0 = (unsigned)((lane >> 3) * 1024 + (((lane & 7) ^ (lane >> 4)) << 3));
  const unsigned lo1 = (unsigned)((lane >> 3) * 1024 + (((lane & 7) ^ (4 + (lane >> 4))) << 3));
  const bf16_t* pg = P + (size_t)(it * 128 + 32 * wu) * 1024;
  const bf16_t* qg = Q + (size_t)(jt * 128 + 32 * wu) * 1024;
#define GT_DMA(kb, bf) do { _Pragma("unroll") for (int jj = 0; jj < 4; ++jj) { const unsigned lo_ = (jj & 1) ? lo1 : lo0; \
      __builtin_amdgcn_global_load_lds((const unsigned*)(pg + (size_t)jj * 8192 + (kb) * 64 + lo_), (unsigned*)(lds + (bf) * 32768 + (4 * wu + jj) * 1024), 16, 0, 0); \
      __builtin_amdgcn_global_load_lds((const unsigned*)(qg + (size_t)jj * 8192 + (kb) * 64 + lo_), (unsigned*)(lds + (bf) * 32768 + 16384 + (4 * wu + jj) * 1024), 16, 0, 0); } } while (0)
  __syncthreads();
  GT_DMA(0, 0);
  asm volatile("s_waitcnt vmcnt(0)" ::: "memory");
  __syncthreads();
  for (int kb = 0; kb < 16; ++kb) {
    if (kb < 15) GT_DMA(kb + 1, (kb + 1) & 1);
    const unsigned char* Ps = lds + (kb & 1) * 32768;
    const unsigned char* Qs = Ps + 16384;
#pragma unroll
    for (int ks = 0; ks < 2; ++ks) {
      bf16x8 pf[4], qf[4];
      const int ch = ks * 4 + g;
#pragma unroll
      for (int mi = 0; mi < 4; ++mi) { const int row = wi * 64 + mi * 16 + lr; pf[mi] = *(const bf16x8*)(Ps + (row >> 1) * 256 + (((((row & 1) << 3) | ch) ^ ((row >> 1) & 7)) << 4)); }
#pragma unroll
      for (int nj = 0; nj < 4; ++nj) { const int row = wj * 64 + nj * 16 + lr; qf[nj] = *(const bf16x8*)(Qs + (row >> 1) * 256 + (((((row & 1) << 3) | ch) ^ ((row >> 1) & 7)) << 4)); }
#pragma unroll
      for (int mi = 0; mi < 4; ++mi)
#pragma unroll
        for (int nj = 0; nj < 4; ++nj) acc[mi][nj] = mfma16(pf[mi], qf[nj], acc[mi][nj]);
    }
    asm volatile("s_waitcnt vmcnt(0)" ::: "memory");
    __syncthreads();
  }
#undef GT_DMA
  if (EPI == 2) {
    float inv[4];
#pragma unroll
    for (int r = 0; r < 4; ++r) inv[r] = __builtin_amdgcn_exp2f(-(float)(4 * g + r) * (13.287712379549449f / 16.f));
#pragma unroll
    for (int nj = 0; nj < 4; ++nj) {
      const int j = jt * 128 + wj * 64 + nj * 16 + lr;
      if (j < TL) {
        const float prow = (float)((j & 2047) >> 6), pcol = (float)(j & 63);
#pragma unroll
        for (int r = 0; r < 4; ++r) {
          const float a1 = prow * inv[r], a2 = pcol * inv[r];
          const float c1 = __cosf(a1), s1 = __sinf(a1), c2 = __cosf(a2), s2 = __sinf(a2);
          const float x1 = acc[0][nj][r], x2 = acc[1][nj][r], y1 = acc[2][nj][r], y2 = acc[3][nj][r];
          acc[0][nj][r] = x1 * c1 - x2 * s1; acc[1][nj][r] = x2 * c1 + x1 * s1;
          acc[2][nj][r] = y1 * c2 - y2 * s2; acc[3][nj][r] = y2 * c2 + y1 * s2;
        }
      }
    }
  }
#pragma unroll
  for (int mi = 0; mi < 4; ++mi)
#pragma unroll
    for (int nj = 0; nj < 4; ++nj) {
      const int j = jt * 128 + wj * 64 + nj * 16 + lr;
      const int i = it * 128 + wi * 64 + mi * 16 + 4 * g;
      const f32x4 a = acc[mi][nj];
      if (EPI == 0 || EPI == 2) {
        u32x2 o = {pk2(a[0], a[1]), pk2(a[2], a[3])};
        *(u32x2*)((bf16_t*)outp + (size_t)j * ld + i) = o;
      } else {
        const int b = j < TL ? (j >> 11) : 16;
        const float4 gt = *(const float4*)(modl + (size_t)b * 6144 + 2 * 1024 + i);
        const float* xs = (j < TL) ? xin_lat + (size_t)j * 1024 + i : xin_ctx + (size_t)(j - TL) * 1024 + i;
        const float4 xv = *(const float4*)xs;
        float4 o = {xv.x + gt.x * a[0], xv.y + gt.y * a[1], xv.z + gt.z * a[2], xv.w + gt.w * a[3]};
        *(float4*)((float*)outp + (size_t)j * 1024 + i) = o;
      }
    }
}

struct TileIter {
  int u, step, total, nf, tpx, x;
  DI void init(int n_tok_tiles, int n_feat_tiles) {
    const int bid = lbid(), nb = lgdim();
    nf = n_feat_tiles;
    if ((nb & 7) == 0 && (n_tok_tiles & 7) == 0) { x = bid & 7; u = bid >> 3; step = nb >> 3; tpx = n_tok_tiles >> 3; }
    else { x = 0; u = bid; step = nb; tpx = n_tok_tiles; }
    total = tpx * nf;
  }
  DI bool valid() const { return u < total; }
  DI void next() { u += step; }
  DI void get(int& tok_tile, int& feat_tile) const {
    const int g = u / (8 * nf), rem = u - g * 8 * nf;
    const int gs = (tpx - 8 * g) < 8 ? (tpx - 8 * g) : 8;
    const int f = rem / gs, tt = rem - f * gs;
    tok_tile = x * tpx + 8 * g + tt; feat_tile = f;
  }
};

DI void phase_gemm_in(const Params& p, int l, unsigned char* lds) {
  const bf16_t* W = (const bf16_t*)(p.ws + OFF_WIN) + (size_t)l * 3200 * 1024;
  const bf16_t* H = (const bf16_t*)(p.ws + OFF_H);
  bf16_t* PN = (bf16_t*)(p.ws + OFF_P);
  bf16_t* VT = (bf16_t*)(p.ws + OFF_VT);
  TileIter ti; ti.init(TT / 128, 25);
  for (; ti.valid(); ti.next()) {
    int jt, f; ti.get(jt, f);
    if (f >= 8 && f < 16) gemm_tile<2>(W, H, f, jt, PN, PN_LD, nullptr, nullptr, nullptr, lds);
    else if (f < 17) gemm_tile<0>(W, H, f, jt, PN, PN_LD, nullptr, nullptr, nullptr, lds);
    else gemm_tile<0>(H, W + (size_t)2176 * 1024, jt, f - 17, VT, TT, nullptr, nullptr, nullptr, lds);
  }
}
DI void phase_gemm_out(const Params& p, int l, int ntok, unsigned char* lds) {
  const bf16_t* W = (const bf16_t*)(p.ws + OFF_WOUT) + (size_t)l * 1024 * 1024;
  const bf16_t* Y = (const bf16_t*)(p.ws + OFF_Y);
  float* xres = (float*)(p.ws + OFF_XRES);
  const float* modl = (const float*)(p.ws + OFF_MOD) + (size_t)l * 17 * 6144;
  const float* xl = (l == 0) ? p.x : xres;
  const float* xc = (l == 0) ? p.ctx : xres + (size_t)TL * 1024;
  TileIter ti; ti.init(ntok / 128, 8);
  for (; ti.valid(); ti.next()) {
    int jt, f; ti.get(jt, f);
    gemm_tile<1>(W, Y, f, jt, xres, 1024, xl, xc, modl, lds);
  }
}
DI void phase_gemm_q(const Params& p, int l, int ntok, unsigned char* lds) {
  const bf16_t* W = (const bf16_t*)(p.ws + OFF_WQ) + (size_t)l * 1024 * 1024;
  const bf16_t* H = (const bf16_t*)(p.ws + OFF_H);
  bf16_t* QP = (bf16_t*)(p.ws + OFF_QP);
  TileIter ti; ti.init(ntok / 128, 8);
  for (; ti.valid(); ti.next()) {
    int jt, f; ti.get(jt, f);
    gemm_tile<0>(W, H, f, jt, QP, 1024, nullptr, nullptr, nullptr, lds);
  }
}

DI void phase_rope(const Params& p, unsigned char* lds) {
  float2* tab = (float2*)lds;
  for (int e = ltid(); e < 1024; e += 256) {
    const int pos = e >> 4, i = e & 15;
    const float inv = exp2f(-(float)i * (13.287712379549449f / 16.f));
    const float ang = (float)pos * inv;
    tab[e] = make_float2(__cosf(ang), __sinf(ang));
  }
  __syncthreads();
  bf16_t* PN = (bf16_t*)(p.ws + OFF_P);
  const int total = TL * 16;
  for (int idx = lbid() * 256 + ltid(); idx < total; idx += lgdim() * 256) {
    const int t = idx >> 4, vec = idx & 15;
    const int col = ((vec >> 3) ? C_DK : C_DQ) + ((vec >> 1) & 3) * 128 + (vec & 1) * 64;
    bf16_t* ptr = PN + (size_t)t * PN_LD + col;
    float xv[64];
#pragma unroll
    for (int q = 0; q < 8; ++q) { const u32x4 v = *(const u32x4*)(ptr + q * 8); unpack8(v, xv + q * 8); }
    const int row = (t & 2047) >> 6, cp = t & 63;
#pragma unroll
    for (int i = 0; i < 16; ++i) {
      const float2 cs = tab[row * 16 + i];
      const float x1 = xv[i], x2 = xv[16 + i];
      xv[i] = x1 * cs.x - x2 * cs.y; xv[16 + i] = x2 * cs.x + x1 * cs.y;
      const float2 cs2 = tab[cp * 16 + i];
      const float y1 = xv[32 + i], y2 = xv[48 + i];
      xv[32 + i] = y1 * cs2.x - y2 * cs2.y; xv[48 + i] = y2 * cs2.x + y1 * cs2.y;
    }
#pragma unroll
    for (int q = 0; q < 8; ++q) {
      u32x4 o = {pk2(xv[q * 8], xv[q * 8 + 1]), pk2(xv[q * 8 + 2], xv[q * 8 + 3]), pk2(xv[q * 8 + 4], xv[q * 8 + 5]), pk2(xv[q * 8 + 6], xv[q * 8 + 7])};
      *(u32x4*)(ptr + q * 8) = o;
    }
  }
}

struct SrcSeg {
  const bf16_t* PN; const bf16_t* VT; int kcol, vrow, t0, n0, t1, n1, lr, g;
  const bf16_t* k0p; const bf16_t* k1p; const bf16_t* vp;
  DI int nsteps() const { return n0 + n1; }
  DI void setup(int st) {
    const int tok0 = st < n0 ? t0 + st * 32 : t1 + (st - n0) * 32;
    const int kap = 8 * (lr >> 2) + (lr & 3);
    k0p = PN + (size_t)(tok0 + kap) * PN_LD + kcol + 8 * g;
    k1p = k0p + (size_t)4 * PN_LD;
    vp = VT + (size_t)(vrow + lr) * TT + tok0 + 8 * g;
  }
  DI bf16x8 kfrag(int m, int kt, int ks) const { return *(const bf16x8*)((kt ? k1p : k0p) + m * 64 + ks * 32); }
  DI bf16x8 vfrag(int dt) const { return *(const bf16x8*)(vp + (size_t)dt * 16 * TT); }
  DI float score(float raw, int kt, int r) const { return raw * SC_LOG2; }
};
struct SrcNat {
  const bf16_t* PN; const bf16_t* VT; int kcol, vrow, b, rq, rs, cs, qc, cstart, lr, g, st_;
  const float* rpbh;
  const bf16_t* k0p; const bf16_t* k1p; const bf16_t* vp;
  DI int nsteps() const { return 16; }
  DI void setup(int st) {
    st_ = st;
    const int tok0 = st < 8 ? b * 2048 + (rs + st) * 64 + cs : TL + b * 256 + (st - 8) * 32;
    const int kap = 8 * (lr >> 2) + (lr & 3);
    k0p = PN + (size_t)(tok0 + kap) * PN_LD + kcol + 8 * g;
    k1p = k0p + (size_t)4 * PN_LD;
    vp = VT + (size_t)(vrow + lr) * TT + tok0 + 8 * g;
  }
  DI bf16x8 kfrag(int m, int kt, int ks) const { return *(const bf16x8*)((kt ? k1p : k0p) + ks * 32); }
  DI bf16x8 vfrag(int dt) const { return *(const bf16x8*)(vp + (size_t)dt * 16 * TT); }
  DI float score(float raw, int kt, int r) const {
    if (st_ >= 8) return raw * SC_LOG2;
    const int kc = cs + 8 * g + 4 * kt + r;
    const bool valid = (kc >= cstart) && (kc < cstart + 16);
    int dc = kc - qc + 15; dc = dc < 0 ? 0 : (dc > 30 ? 30 : dc);
    const float bias = rpbh[(rs + st_ - rq + 7) * 31 + dc];
    return valid ? (raw * 0.125f + bias) * LOG2E : NEG_BIG;
  }
};

template <int MAPS, int DVT, class Src>
DI void flash_wave(Src& S, const bf16_t* qptr  , f32x4 (&o)[MAPS][DVT], float (&ltot)[MAPS]) {
  bf16x8 qf[MAPS][2];
#pragma unroll
  for (int m = 0; m < MAPS; ++m)
#pragma unroll
    for (int ks = 0; ks < 2; ++ks) qf[m][ks] = *(const bf16x8*)(qptr + m * 64 + ks * 32);
  float mrun[MAPS], lrun[MAPS];
#pragma unroll
  for (int m = 0; m < MAPS; ++m) {
    mrun[m] = NEG_BIG; lrun[m] = 0.f;
#pragma unroll
    for (int dt = 0; dt < DVT; ++dt) o[m][dt] = (f32x4){0.f, 0.f, 0.f, 0.f};
  }
  const int ns = S.nsteps();
  for (int st = 0; st < ns; ++st) {
    S.setup(st);
    bf16x8 pf[MAPS];
#pragma unroll
    for (int m = 0; m < MAPS; ++m) {
      f32x4 s[2];
#pragma unroll
      for (int kt = 0; kt < 2; ++kt) {
        s[kt] = (f32x4){0.f, 0.f, 0.f, 0.f};
#pragma unroll
        for (int ks = 0; ks < 2; ++ks) s[kt] = mfma16(S.kfrag(m, kt, ks), qf[m][ks], s[kt]);
      }
      float mt = NEG_BIG;
#pragma unroll
      for (int kt = 0; kt < 2; ++kt)
#pragma unroll
        for (int r = 0; r < 4; ++r) { s[kt][r] = S.score(s[kt][r], kt, r); mt = fmaxf(mt, s[kt][r]); }
      mt = fmaxf(mt, __shfl_xor(mt, 16));
      mt = fmaxf(mt, __shfl_xor(mt, 32));
      const bool need = mt > mrun[m] + 8.f;
      if (__any(need)) {
        const float mnew = need ? mt : mrun[m];
        const float alpha = __builtin_amdgcn_exp2f(mrun[m] - mnew);
        lrun[m] *= alpha;
#pragma unroll
        for (int dt = 0; dt < DVT; ++dt) { o[m][dt][0] *= alpha; o[m][dt][1] *= alpha; o[m][dt][2] *= alpha; o[m][dt][3] *= alpha; }
        mrun[m] = mnew;
      }
      float pv[8];
      float ls = 0.f;
#pragma unroll
      for (int kt = 0; kt < 2; ++kt)
#pragma unroll
        for (int r = 0; r < 4; ++r) { pv[kt * 4 + r] = __builtin_amdgcn_exp2f(s[kt][r] - mrun[m]); ls += pv[kt * 4 + r]; }
      lrun[m] += ls;
      u32x4 pk = {pk2(pv[0], pv[1]), pk2(pv[2], pv[3]), pk2(pv[4], pv[5]), pk2(pv[6], pv[7])};
      pf[m] = __builtin_bit_cast(bf16x8, pk);
    }
#pragma unroll
    for (int dt = 0; dt < DVT; ++dt) {
      const bf16x8 vf = S.vfrag(dt);
#pragma unroll
      for (int m = 0; m < MAPS; ++m) o[m][dt] = mfma16(vf, pf[m], o[m][dt]);
    }
  }
#pragma unroll
  for (int m = 0; m < MAPS; ++m) {
    float l = lrun[m];
    l += __shfl_xor(l, 16);
    l += __shfl_xor(l, 32);
    ltot[m] = l;
  }
}

DI void diff_wave_task(const Params& p, int l, int b, int hd, int qtok0, bool ctx_only) {
  const int lane = ltid() & 63, lr = lane & 15, g = lane >> 4;
  const bf16_t* PN = (const bf16_t*)(p.ws + OFF_P);
  const bf16_t* VT = (const bf16_t*)(p.ws + OFF_VT);
  bf16_t* Y = (bf16_t*)(p.ws + OFF_Y);
  const float* lv = p.dlam + l * 256;
  float sa = lv[lane] * lv[64 + lane], sb = lv[128 + lane] * lv[192 + lane];
  sa = wave_sum(sa); sb = wave_sum(sb);
  const float lam_init = 0.8f - 0.6f * expf(-0.3f * (float)l);
  const float lam = expf(sa) - expf(sb) + lam_init;
  SrcSeg S;
  S.PN = PN; S.VT = VT; S.kcol = C_DK + hd * 128; S.vrow = R_DV + hd * 128; S.lr = lr; S.g = g;
  S.t0 = TL + b * 256; S.n0 = 8; S.t1 = b * 2048; S.n1 = ctx_only ? 0 : 64;
  f32x4 o[2][8];
  float lt[2];
  const int qtok = qtok0 + lr;
  flash_wave<2, 8, SrcSeg>(S, PN + (size_t)qtok * PN_LD + C_DQ + hd * 128 + 8 * g, o, lt);
  const float i0 = 1.f / lt[0], i1 = lam / lt[1];
  float ss = 0.f;
#pragma unroll
  for (int dt = 0; dt < 8; ++dt)
#pragma unroll
    for (int r = 0; r < 4; ++r) { const float v = o[0][dt][r] * i0 - o[1][dt][r] * i1; o[0][dt][r] = v; ss += v * v; }
  ss += __shfl_xor(ss, 16);
  ss += __shfl_xor(ss, 32);
  const float rstd = rsqrtf(ss * (1.f / 128.f) + 1e-6f) * (1.f - lam_init);
  const float* dg = p.diff_g + l * 512 + hd * 128;
#pragma unroll
  for (int dt = 0; dt < 8; ++dt) {
    const float4 gg = *(const float4*)(dg + dt * 16 + 4 * g);
    u32x2 ov = {pk2(o[0][dt][0] * rstd * gg.x, o[0][dt][1] * rstd * gg.y), pk2(o[0][dt][2] * rstd * gg.z, o[0][dt][3] * rstd * gg.w)};
    *(u32x2*)(Y + (size_t)qtok * 1024 + 512 + hd * 128 + dt * 16 + 4 * g) = ov;
  }
}


DI void diff_block_task(const Params& p, int l, int b, int hd, int qtok0, int nsteps, unsigned char* lds) {
  const int tid = ltid(), lane = tid & 63, w = tid >> 6, lr = lane & 15, g = lane >> 4;
  unsigned char* Kb = lds;
  unsigned char* Vb = lds + 16384;
  unsigned char* Qb = lds + 32768;
  const bf16_t* PN = (const bf16_t*)(p.ws + OFF_P);
  const bf16_t* VT = (const bf16_t*)(p.ws + OFF_VT);
  bf16_t* Y = (bf16_t*)(p.ws + OFF_Y);

  __syncthreads();
  {
    const int row = tid >> 1, hf = tid & 1;
    const bf16_t* src = PN + (size_t)(qtok0 + row) * PN_LD + C_DQ + hd * 128 + hf * 64;
#pragma unroll
    for (int c = 0; c < 8; ++c) {
      const u32x4 v = *(const u32x4*)(src + c * 8);
      const int ch = hf * 8 + c;
      *(u32x4*)(Qb + row * 256 + ((ch ^ (row & 15)) << 4)) = v;
    }
  }
  const int wu = __builtin_amdgcn_readfirstlane(w);
  unsigned kofs[2], vofs[2];
#pragma unroll
  for (int jj = 0; jj < 2; ++jj) {
    const int krow = 4 * (2 * w + jj) + (lane >> 4), kpc = lane & 15;
    const int kch = kpc ^ (((krow >> 3) & 3) * 4 + (krow & 3));
    kofs[jj] = (unsigned)(krow * PN_LD + C_DK + hd * 128 + kch * 8);
    const int vrow = 16 * (2 * w + jj) + (lane >> 2), vpc = lane & 3;
    const int vch = vpc ^ ((vrow >> 2) & 3);
    vofs[jj] = (unsigned)((R_DV + hd * 128 + vrow) * TT + vch * 8);
  }
#define DB_DMA(st, bf) do { const int tk = (st) < 8 ? TL + b * 256 + (st) * 32 : b * 2048 + ((st) - 8) * 32; \
    const bf16_t* kb_ = PN + (size_t)tk * PN_LD; const bf16_t* vb_ = VT + tk; \
    _Pragma("unroll") for (int jj = 0; jj < 2; ++jj) { \
      __builtin_amdgcn_global_load_lds((const unsigned*)(kb_ + kofs[jj]), (unsigned*)(Kb + (bf) * 8192 + (2 * wu + jj) * 1024), 16, 0, 0); \
      __builtin_amdgcn_global_load_lds((const unsigned*)(vb_ + vofs[jj]), (unsigned*)(Vb + (bf) * 8192 + (2 * wu + jj) * 1024), 16, 0, 0); } } while (0)
  DB_DMA(0, 0);
  asm volatile("s_waitcnt vmcnt(0)" ::: "memory");
  __syncthreads();

  f32x4 o[2][2][8];
  float mrun[2][2], lrun[2][2];
#pragma unroll
  for (int m = 0; m < 2; ++m)
#pragma unroll
    for (int qt = 0; qt < 2; ++qt) {
      mrun[m][qt] = NEG_BIG; lrun[m][qt] = 0.f;
#pragma unroll
      for (int dt = 0; dt < 8; ++dt) o[m][qt][dt] = (f32x4){0.f, 0.f, 0.f, 0.f};
    }
  const int kfr = 8 * (lr >> 2) + (lr & 3);
  for (int st = 0; st < nsteps; ++st) {
    if (st + 1 < nsteps) DB_DMA(st + 1, (st + 1) & 1);
    const unsigned char* Kt = Kb + (st & 1) * 8192;
    const unsigned char* Vt = Vb + (st & 1) * 8192;
    bf16x8 pf[2][2];
#pragma unroll
    for (int m = 0; m < 2; ++m) {
      bf16x8 kf[2][2];
#pragma unroll
      for (int kt = 0; kt < 2; ++kt)
#pragma unroll
        for (int ks = 0; ks < 2; ++ks) kf[kt][ks] = *(const bf16x8*)(Kt + (kfr + 4 * kt) * 256 + (((m * 8 + ks * 4 + g) ^ lr) << 4));
#pragma unroll
      for (int qt = 0; qt < 2; ++qt) {
        const int qrow = 32 * w + 16 * qt + lr;
        f32x4 s[2];
        s[0] = (f32x4){0.f, 0.f, 0.f, 0.f}; s[1] = s[0];
#pragma unroll
        for (int ks = 0; ks < 2; ++ks) {
          const bf16x8 qf = *(const bf16x8*)(Qb + qrow * 256 + (((m * 8 + ks * 4 + g) ^ lr) << 4));
          s[0] = mfma16(kf[0][ks], qf, s[0]);
          s[1] = mfma16(kf[1][ks], qf, s[1]);
        }
        float mt = NEG_BIG;
#pragma unroll
        for (int kt = 0; kt < 2; ++kt)
#pragma unroll
          for (int r = 0; r < 4; ++r) { s[kt][r] *= SC_LOG2; mt = fmaxf(mt, s[kt][r]); }
        mt = fmaxf(mt, __shfl_xor(mt, 16));
        mt = fmaxf(mt, __shfl_xor(mt, 32));
        const bool need = mt > mrun[m][qt] + 8.f;
        if (__any(need)) {
          const float mnew = need ? mt : mrun[m][qt];
          const float alpha = __builtin_amdgcn_exp2f(mrun[m][qt] - mnew);
          lrun[m][qt] *= alpha;
#pragma unroll
          for (int dt = 0; dt < 8; ++dt) { o[m][qt][dt][0] *= alpha; o[m][qt][dt][1] *= alpha; o[m][qt][dt][2] *= alpha; o[m][qt][dt][3] *= alpha; }
          mrun[m][qt] = mnew;
        }
        float pv[8], ls = 0.f;
#pragma unroll
        for (int kt = 0; kt < 2; ++kt)
#pragma unroll
          for (int r = 0; r < 4; ++r) { pv[kt * 4 + r] = __builtin_amdgcn_exp2f(s[kt][r] - mrun[m][qt]); ls += pv[kt * 4 + r]; }
        lrun[m][qt] += ls;
        u32x4 pk = {pk2(pv[0], pv[1]), pk2(pv[2], pv[3]), pk2(pv[4], pv[5]), pk2(pv[6], pv[7])};
        pf[m][qt] = __builtin_bit_cast(bf16x8, pk);
        __builtin_amdgcn_sched_barrier(0);
      }
    }
#pragma unroll
    for (int dt = 0; dt < 8; ++dt) {
      const int vr = 16 * dt + lr;
      const bf16x8 vf = *(const bf16x8*)(Vt + vr * 64 + ((g ^ ((vr >> 2) & 3)) << 4));
#pragma unroll
      for (int m = 0; m < 2; ++m)
#pragma unroll
        for (int qt = 0; qt < 2; ++qt) o[m][qt][dt] = mfma16(vf, pf[m][qt], o[m][qt][dt]);
      if ((dt & 1) == 1) __builtin_amdgcn_sched_barrier(0);
    }
    asm volatile("s_waitcnt vmcnt(0)" ::: "memory");
    __syncthreads();
  }
#undef DB_DMA
  const float* lv = p.dlam + l * 256;
  float sa = lv[lane] * lv[64 + lane], sb = lv[128 + lane] * lv[192 + lane];
  sa = wave_sum(sa); sb = wave_sum(sb);
  const float lam_init = 0.8f - 0.6f * expf(-0.3f * (float)l);
  const float lam = expf(sa) - expf(sb) + lam_init;
  const float* dg = p.diff_g + l * 512 + hd * 128;
#pragma unroll
  for (int qt = 0; qt < 2; ++qt) {
    float l0 = lrun[0][qt], l1 = lrun[1][qt];
    l0 += __shfl_xor(l0, 16); l0 += __shfl_xor(l0, 32);
    l1 += __shfl_xor(l1, 16); l1 += __shfl_xor(l1, 32);
    const float i0 = 1.f / l0, i1 = lam / l1;
    float ss = 0.f;
#pragma unroll
    for (int dt = 0; dt < 8; ++dt)
#pragma unroll
      for (int r = 0; r < 4; ++r) { const float v = o[0][qt][dt][r] * i0 - o[1][qt][dt][r] * i1; o[0][qt][dt][r] = v; ss += v * v; }
    ss += __shfl_xor(ss, 16);
    ss += __shfl_xor(ss, 32);
    const float rstd = rsqrtf(ss * (1.f / 128.f) + 1e-6f) * (1.f - lam_init);
    const int qtok = qtok0 + 32 * w + 16 * qt + lr;
#pragma unroll
    for (int dt = 0; dt < 8; ++dt) {
      const float4 gg = *(const float4*)(dg + dt * 16 + 4 * g);
      u32x2 ov = {pk2(o[0][qt][dt][0] * rstd * gg.x, o[0][qt][dt][1] * rstd * gg.y), pk2(o[0][qt][dt][2] * rstd * gg.z, o[0][qt][dt][3] * rstd * gg.w)};
      *(u32x2*)(Y + (size_t)qtok * 1024 + 512 + hd * 128 + dt * 16 + 4 * g) = ov;
    }
  }
}

DI void nat_wave_task(const Params& p, int l, int b, int head, int rq, int ct, const float* rpb_lds) {
  const int lane = ltid() & 63, lr = lane & 15, g = lane >> 4;
  const bf16_t* PN = (const bf16_t*)(p.ws + OFF_P);
  const bf16_t* VT = (const bf16_t*)(p.ws + OFF_VT);
  bf16_t* Y = (bf16_t*)(p.ws + OFF_Y);
  SrcNat S;
  S.PN = PN; S.VT = VT; S.kcol = C_NK + head * 64; S.vrow = R_NV + head * 64; S.b = b; S.rq = rq; S.lr = lr; S.g = g;
  int rs = rq - 4; rs = rs < 0 ? 0 : (rs > 24 ? 24 : rs);
  S.rs = rs;
  int cs = 16 * ct - 8; cs = cs < 0 ? 0 : (cs > 32 ? 32 : cs);
  S.cs = cs;
  S.qc = 16 * ct + lr;
  int cst = S.qc - 8; cst = cst < 0 ? 0 : (cst > 48 ? 48 : cst);
  S.cstart = cst;
  S.rpbh = rpb_lds + head * 465;
  f32x4 o[1][4];
  float lt[1];
  const int qtok = b * 2048 + rq * 64 + 16 * ct + lr;
  flash_wave<1, 4, SrcNat>(S, PN + (size_t)qtok * PN_LD + C_NQ + head * 64 + 8 * g, o, lt);
  const float inv = 1.f / lt[0];
#pragma unroll
  for (int dt = 0; dt < 4; ++dt) {
    u32x2 ov = {pk2(o[0][dt][0] * inv, o[0][dt][1] * inv), pk2(o[0][dt][2] * inv, o[0][dt][3] * inv)};
    *(u32x2*)(Y + (size_t)qtok * 1024 + 256 + head * 64 + dt * 16 + 4 * g) = ov;
  }
}
DI void natctx_wave_task(const Params& p, int b, int head, int qt) {
  const int lane = ltid() & 63, lr = lane & 15, g = lane >> 4;
  const bf16_t* PN = (const bf16_t*)(p.ws + OFF_P);
  const bf16_t* VT = (const bf16_t*)(p.ws + OFF_VT);
  bf16_t* Y = (bf16_t*)(p.ws + OFF_Y);
  SrcSeg S;
  S.PN = PN; S.VT = VT; S.kcol = C_NK + head * 64; S.vrow = R_NV + head * 64; S.lr = lr; S.g = g;
  S.t0 = TL + b * 256; S.n0 = 8; S.t1 = 0; S.n1 = 0;
  f32x4 o[1][4];
  float lt[1];
  const int qtok = TL + b * 256 + qt * 16 + lr;
  flash_wave<1, 4, SrcSeg>(S, PN + (size_t)qtok * PN_LD + C_NQ + head * 64 + 8 * g, o, lt);
  const float inv = 1.f / lt[0];
#pragma unroll
  for (int dt = 0; dt < 4; ++dt) {
    u32x2 ov = {pk2(o[0][dt][0] * inv, o[0][dt][1] * inv), pk2(o[0][dt][2] * inv, o[0][dt][3] * inv)};
    *(u32x2*)(Y + (size_t)qtok * 1024 + 256 + head * 64 + dt * 16 + 4 * g) = ov;
  }
}

DI float quad_sum(float v) {
  v += __int_as_float(__builtin_amdgcn_mov_dpp(__float_as_int(v), 0xB1, 0xF, 0xF, true));
  v += __int_as_float(__builtin_amdgcn_mov_dpp(__float_as_int(v), 0x4E, 0xF, 0xF, true));
  return v;
}
DI void gla_task(const Params& p, int l, int task, unsigned char* lds, int var = 0) {
  const int tid = ltid(), lane = tid & 63, w = tid >> 6, vv = lane >> 2, g = lane & 3;
  const int b = task >> 3, h = (task >> 1) & 3, dir = task & 1;
  const bf16_t* PN = (const bf16_t*)(p.ws + OFF_P);
  const bf16_t* VT = (const bf16_t*)(p.ws + OFF_VT);
  float* og = (float*)(p.ws + OFF_H);
  float* Gup = (float*)lds;
  float* Gb = Gup + 512;
  float* As = Gb + 32;
  float* Ks = As + 2048;
  float* Qs = Ks + 2048;
  float* Vs = Qs + 2048;
  __syncthreads();
  for (int e = tid; e < 512; e += 256) { const int r = e >> 5, kd = e & 31; Gup[e] = p.gate_up[((size_t)(l * 2 + dir) * 16 + r) * 128 + h * 32 + kd]; }
  if (tid < 32) Gb[tid] = p.gate_b[(l * 2 + dir) * 128 + h * 32 + tid];
  float S[8];
#pragma unroll
  for (int e = 0; e < 8; ++e) S[e] = 0.f;
  const int si = tid >> 2, part = tid & 3;
  u32x4 rq, rk, rg0, rg1, rv0, rv1;
#define GLA_TOK0(cc) ((cc) < 4 ? TL + b * 256 + (dir == 0 ? (cc) : 3 - (cc)) * 64 : b * 2048 + (dir == 0 ? (cc) - 4 : 35 - (cc)) * 64)
#define GLA_LOAD(cc) do { const int t0_ = GLA_TOK0(cc); const bf16_t* row = PN + (size_t)(t0_ + si) * PN_LD; \
    rq = *(const u32x4*)(row + C_GQ + h * 32 + part * 8); rk = *(const u32x4*)(row + C_GK + h * 32 + part * 8); \
    rg0 = *(const u32x4*)(row + C_GATE + dir * 16); rg1 = *(const u32x4*)(row + C_GATE + dir * 16 + 8); \
    const bf16_t* vp = VT + (size_t)(R_GV + h * 64 + si) * TT + t0_ + part * 16; rv0 = *(const u32x4*)vp; rv1 = *(const u32x4*)(vp + 8); } while (0)
#define GLA_WRITE() do { float gd[16], qf[8], kf[8], vf[16]; \
    unpack8(rg0, gd); unpack8(rg1, gd + 8); unpack8(rq, qf); unpack8(rk, kf); unpack8(rv0, vf); unpack8(rv1, vf + 8); \
    _Pragma("unroll") for (int e = 0; e < 8; ++e) { const int kd = part * 8 + e; float pre = Gb[kd]; \
      _Pragma("unroll") for (int r = 0; r < 16; ++r) pre += gd[r] * Gup[r * 32 + kd]; \
      const float ls = fminf(pre, 0.f) - log1pf(__expf(-fabsf(pre))); \
      As[si * 32 + kd] = __expf(ls * (1.f / 16.f)); Ks[si * 32 + kd] = kf[e]; Qs[si * 32 + kd] = qf[e] * 0.17677669529663687f; } \
    _Pragma("unroll") for (int e = 0; e < 16; ++e) Vs[(part * 16 + e) * 65 + si] = vf[e]; } while (0)
  GLA_LOAD(0);
  __syncthreads();
  GLA_WRITE();
  __syncthreads();
  for (int cc = 0; cc < 36; ++cc) {
    const int tok0 = GLA_TOK0(cc);
    if (cc + 1 < 36) GLA_LOAD(cc + 1);
    float* ob = og + ((size_t)dir * TT + tok0) * 256 + h * 64 + 16 * w + vv;
#pragma unroll 1
    for (int s0 = 0; s0 < (var == 3 ? 4 : 64); s0 += 4) {
      float4 a0[4], a1[4], k0[4], k1[4], q0[4], q1[4];
      float vx[4];
#pragma unroll
      for (int u = 0; u < 4; ++u) {
        const int i = dir == 0 ? s0 + u : 63 - s0 - u;
        a0[u] = *(const float4*)(As + i * 32 + 8 * g); a1[u] = *(const float4*)(As + i * 32 + 8 * g + 4);
        k0[u] = *(const float4*)(Ks + i * 32 + 8 * g); k1[u] = *(const float4*)(Ks + i * 32 + 8 * g + 4);
        q0[u] = *(const float4*)(Qs + i * 32 + 8 * g); q1[u] = *(const float4*)(Qs + i * 32 + 8 * g + 4);
        vx[u] = Vs[i * 65 + 16 * w + vv];
      }
#pragma unroll
      for (int u = 0; u < 4; ++u) {
        const int i = dir == 0 ? s0 + u : 63 - s0 - u;
        const float v = vx[u];
        S[0] = fmaf(a0[u].x, S[0], k0[u].x * v); S[1] = fmaf(a0[u].y, S[1], k0[u].y * v);
        S[2] = fmaf(a0[u].z, S[2], k0[u].z * v); S[3] = fmaf(a0[u].w, S[3], k0[u].w * v);
        S[4] = fmaf(a1[u].x, S[4], k1[u].x * v); S[5] = fmaf(a1[u].y, S[5], k1[u].y * v);
        S[6] = fmaf(a1[u].z, S[6], k1[u].z * v); S[7] = fmaf(a1[u].w, S[7], k1[u].w * v);
        const float oa = fmaf(q0[u].x, S[0], q0[u].y * S[1]), ob2 = fmaf(q0[u].z, S[2], q0[u].w * S[3]);
        const float oc = fmaf(q1[u].x, S[4], q1[u].y * S[5]), od = fmaf(q1[u].z, S[6], q1[u].w * S[7]);
        float o = (oa + ob2) + (oc + od);
        o = quad_sum(o);
        if (var == 1) asm volatile("" :: "v"(o)); else if (g == 0) ob[(size_t)i * 256] = o;
      }
    }
    __syncthreads();
    if (cc + 1 < 36 && var != 2) GLA_WRITE();
    __syncthreads();
  }
#undef GLA_TOK0
#undef GLA_LOAD
#undef GLA_WRITE
}

DI void phase_mixers(const Params& p, int l, bool last, unsigned* ctr, unsigned char* lds, int mask = 7, int gvar = 0) {
  const int tid = ltid(), w = tid >> 6;
  volatile int* slot = (volatile int*)(lds + LDS_BYTES - 16);
  float* rpb_lds = (float*)(lds + 65536);
  for (int e = tid; e < 4 * 465; e += 256) rpb_lds[e] = p.rpb[(size_t)l * 4 * 465 + e];
  const int ntask = 128 + 1024 + 2048 + (last ? 0 : 128 + 256);
  for (;;) {
    __syncthreads();
    if (tid == 0) *slot = (int)atomicAdd(ctr, 1u);
    __syncthreads();
    const int task = *slot;
    if (task >= ntask) break;
    if (task < 128) { if (mask & 1) { __builtin_amdgcn_s_setprio(3); gla_task(p, l, task, lds, gvar); __builtin_amdgcn_s_setprio(0); } }
    else if (!(mask & 2) && (task < 128 + 1024 || (task >= 128 + 1024 + 2048 && task < 128 + 1024 + 2048 + 128))) {}
    else if (!(mask & 4) && ((task >= 128 + 1024 && task < 128 + 1024 + 2048) || task >= 128 + 1024 + 2048 + 128)) {}
    else if (task < 128 + 1024) { const int d = task - 128; const int b = d >> 6; diff_block_task(p, l, b, (d >> 4) & 3, b * 2048 + (d & 15) * 128, 72, lds); }
    else if (task < 128 + 1024 + 2048) { const int wt = (task - 128 - 1024) * 4 + w; nat_wave_task(p, l, wt >> 9, (wt >> 7) & 3, (wt >> 2) & 31, wt & 3, rpb_lds); }
    else if (task < 128 + 1024 + 2048 + 128) { const int d = task - 128 - 1024 - 2048; const int b = d >> 3; diff_block_task(p, l, b, (d >> 1) & 3, TL + b * 256 + (d & 1) * 128, 8, lds); }
    else { const int wt = (task - 128 - 1024 - 2048 - 128) * 4 + w; natctx_wave_task(p, wt >> 6, (wt >> 4) & 3, wt & 15); }
  }
}

DI void phase_gla_fin(const Params& p, int l, int ntok) {
  const int lane = ltid() & 63, gw = lbid() * 4 + (ltid() >> 6), nw = lgdim() * 4;
  const float* og = (const float*)(p.ws + OFF_H);
  const bf16_t* PN = (const bf16_t*)(p.ws + OFF_P);
  bf16_t* Y = (bf16_t*)(p.ws + OFF_Y);
  const float4 gg = *(const float4*)(p.gla_norm_g + l * 256 + 4 * lane);
  for (int t = gw; t < ntok; t += nw) {
    const float4 a = *(const float4*)(og + (size_t)t * 256 + 4 * lane), bq = *(const float4*)(og + ((size_t)TT + t) * 256 + 4 * lane);
    const float o0 = a.x + bq.x, o1 = a.y + bq.y, o2 = a.z + bq.z, o3 = a.w + bq.w;
    float ss = o0 * o0 + o1 * o1 + o2 * o2 + o3 * o3;
    ss += __shfl_xor(ss, 1); ss += __shfl_xor(ss, 2); ss += __shfl_xor(ss, 4); ss += __shfl_xor(ss, 8);
    const float rstd = rsqrtf(ss * (1.f / 64.f) + 1e-6f);
    const u32x2 rv = *(const u32x2*)(PN + (size_t)t * PN_LD + C_GR + 4 * lane);
    const float r0 = bflo(rv.x), r1 = bfhi(rv.x), r2 = bflo(rv.y), r3 = bfhi(rv.y);
    const float y0 = o0 * rstd * gg.x * (r0 / (1.f + __expf(-r0)));
    const float y1 = o1 * rstd * gg.y * (r1 / (1.f + __expf(-r1)));
    const float y2 = o2 * rstd * gg.z * (r2 / (1.f + __expf(-r2)));
    const float y3 = o3 * rstd * gg.w * (r3 / (1.f + __expf(-r3)));
    u32x2 ov = {pk2(y0, y1), pk2(y2, y3)};
    *(u32x2*)(Y + (size_t)t * 1024 + 4 * lane) = ov;
  }
}

struct PairTab { int a[52], b[52]; };
constexpr PairTab make_pairs() {
  PairTab t{};
  int n = 0;
  for (int a = 0; a < 16; ++a)
    for (int b = 0; b < 16; ++b)
      if ((a + 1) * (b + 1) <= 16) { t.a[n] = a; t.b[n] = b; ++n; }
  for (; n < 52; ++n) { t.a[n] = -1; t.b[n] = -1; }
  return t;
}

DI void topk_half(const bf16_t* skh  , const bf16_t* qrow  , int lr, int g, float (&list)[16]) {
  bf16x8 qf[2];
  qf[0] = *(const bf16x8*)(qrow); qf[1] = *(const bf16x8*)(qrow + 32);
  float s[32];
#pragma unroll
  for (int nt = 0; nt < 8; ++nt) {
    f32x4 acc = {0.f, 0.f, 0.f, 0.f};
#pragma unroll
    for (int ks = 0; ks < 2; ++ks) {
      const bf16x8 af = *(const bf16x8*)(skh + (size_t)(nt * 16 + lr) * 64 + ks * 32 + 8 * g);
      acc = mfma16(af, qf[ks], acc);
    }
#pragma unroll
    for (int r = 0; r < 4; ++r) {
      const unsigned n = nt * 16 + 4 * g + r;
      s[nt * 4 + r] = __uint_as_float((__float_as_uint(acc[r]) & ~127u) | n);
    }
  }
#pragma unroll
  for (int k = 0; k < 16; ++k) {
    float m = s[0];
#pragma unroll
    for (int i = 1; i < 32; ++i) m = fmaxf(m, s[i]);
    m = fmaxf(m, __shfl_xor(m, 16));
    m = fmaxf(m, __shfl_xor(m, 32));
    list[k] = m;
#pragma unroll
    for (int i = 0; i < 32; ++i) s[i] = (s[i] == m) ? -3.0e38f : s[i];
  }
}

DI void phase_topk(const Params& p, int l, int ntok) {
  constexpr PairTab PT = make_pairs();
  const int lane = ltid() & 63, lr = lane & 15, g = lane >> 4;
  const int gw = lbid() * 4 + (ltid() >> 6), nw = lgdim() * 4;
  const bf16_t* QP = (const bf16_t*)(p.ws + OFF_QP);
  const bf16_t* sk = (const bf16_t*)(p.ws + OFF_SK) + (size_t)l * 2 * 128 * 64;
  int* eid = (int*)(p.ws + OFF_EID);
  float* gate = (float*)(p.ws + OFF_GATE);
  const int ntask = (ntok / 16) * 8;
  for (int task = gw; task < ntask; task += nw) {
    const int tt = task >> 3, hd = task & 7;
    const int tok = tt * 16 + lr;
    float v1[16], v2[16];
    topk_half(sk, QP + (size_t)tok * 1024 + hd * 128 + 8 * g, lr, g, v1);
    topk_half(sk + 128 * 64, QP + (size_t)tok * 1024 + hd * 128 + 64 + 8 * g, lr, g, v2);
    float cand[13];
    int ceid[13];
#pragma unroll
    for (int c = 0; c < 13; ++c) {
      float sv[4];
      int ev[4];
#pragma unroll
      for (int gi = 0; gi < 4; ++gi) {
        const int pi = 4 * c + gi;
        if (PT.a[pi] >= 0) {
          const float a = v1[PT.a[pi] < 0 ? 0 : PT.a[pi]], bq = v2[PT.b[pi] < 0 ? 0 : PT.b[pi]];
          sv[gi] = __uint_as_float((__float_as_uint(a + bq) & ~63u) | (unsigned)pi);
          ev[gi] = (int)((__float_as_uint(a) & 127u) * 128u + (__float_as_uint(bq) & 127u));
        } else { sv[gi] = -3.0e38f; ev[gi] = 0; }
      }
      cand[c] = g == 0 ? sv[0] : (g == 1 ? sv[1] : (g == 2 ? sv[2] : sv[3]));
      ceid[c] = g == 0 ? ev[0] : (g == 1 ? ev[1] : (g == 2 ? ev[2] : ev[3]));
    }
    float topv[16];
#pragma unroll
    for (int k = 0; k < 16; ++k) {
      float m = cand[0];
#pragma unroll
      for (int c = 1; c < 13; ++c) m = fmaxf(m, cand[c]);
      m = fmaxf(m, __shfl_xor(m, 16));
      m = fmaxf(m, __shfl_xor(m, 32));
      topv[k] = m;
      int my = -1;
#pragma unroll
      for (int c = 0; c < 13; ++c) { if (cand[c] == m) { my = ceid[c]; cand[c] = -3.0e38f; } }
      if (my >= 0) eid[(size_t)tok * 128 + hd * 16 + k] = my;
    }
    if (g == 0) {
      float ex[16], sum = 0.f;
#pragma unroll
      for (int k = 0; k < 16; ++k) { ex[k] = __expf(topv[k] - topv[0]); sum += ex[k]; }
      const float inv = 1.f / sum;
#pragma unroll
      for (int q = 0; q < 4; ++q) {
        float4 o = {ex[4 * q] * inv, ex[4 * q + 1] * inv, ex[4 * q + 2] * inv, ex[4 * q + 3] * inv};
        *(float4*)(gate + (size_t)tok * 128 + hd * 16 + 4 * q) = o;
      }
    }
  }
}

DI float gelu_tanh(float x) {
  const float z = 0.7978845608028654f * (x + 0.044715f * x * x * x);
  const float e = __expf(2.f * z);
  const float th = 1.f - 2.f / (e + 1.f);
  return 0.5f * x * (1.f + th);
}
DI void phase_gather(const Params& p, int l, int ntok, unsigned char* lds, bool dry = false) {
  const int tid = ltid(), lane = tid & 63, w = tid >> 6, lr = lane & 15, g = lane >> 4;
  const int gw = lbid() * 4 + w, nw = lgdim() * 4;
  const unsigned char* U8 = p.ws + OFF_U + (size_t)l * 16384 * 1024;
  const unsigned char* V8 = p.ws + OFF_V + (size_t)l * 16384 * 1024;
  const float* uscl = (const float*)(p.ws + OFF_USCL) + l * 16384;
  const float* vscl = (const float*)(p.ws + OFF_VSCL) + l * 16384;
  const unsigned char* H8 = p.ws + OFF_H8;
  const float* hinv = (const float*)(p.ws + OFF_HINV);
  const int* eid = (const int*)(p.ws + OFF_EID);
  const float* gate = (const float*)(p.ws + OFF_GATE);
  float* xres = (float*)(p.ws + OFF_XRES);
  const float* modbuf = (const float*)(p.ws + OFF_MOD);
  unsigned char* hl = lds + w * 1024;
  for (int t = gw; t < ntok; t += nw) {
    {
      const u32x4 hq = *(const u32x4*)(H8 + (size_t)t * 1024 + lane * 16);
      *(u32x4*)(hl + lane * 16) = hq;
    }
    const float hs = hinv[t];
    const int e0 = eid[(size_t)t * 128 + lane], e1 = eid[(size_t)t * 128 + 64 + lane];
    const float su0 = uscl[e0] * hs, su1 = uscl[e1] * hs;
    const float gv0 = gate[(size_t)t * 128 + lane] * vscl[e0], gv1 = gate[(size_t)t * 128 + 64 + lane] * vscl[e1];
    float out[16];
#pragma unroll
    for (int i = 0; i < 16; ++i) out[i] = 0.f;
#pragma unroll 1
    for (int grp = 0; grp < 8; ++grp) {
      const int esel = grp < 4 ? e0 : e1;
      const float susel = grp < 4 ? su0 : su1, gvsel = grp < 4 ? gv0 : gv1;
      const int lb = (grp & 3) * 16;
      const int erow = __shfl(esel, lb + lr);
      const unsigned char* ur = U8 + (size_t)erow * 1024 + g * 16;
      u32x4 ub[16], va[8];
#pragma unroll
      for (int c = 0; c < 16; ++c) ub[c] = *(const u32x4*)(ur + c * 64);
#pragma unroll
      for (int j = 0; j < 8; ++j) {
        const int ej = __builtin_amdgcn_readlane(esel, lb + j);
        va[j] = *(const u32x4*)(V8 + (size_t)ej * 1024 + lane * 16);
      }
      f32x4 acc = {0.f, 0.f, 0.f, 0.f};
#pragma unroll
      for (int c = 0; c < 16; ++c) {
        const long b0 = *(const long*)(hl + c * 64 + g * 16), b1 = *(const long*)(hl + c * 64 + g * 16 + 8);
        const long a0 = __builtin_bit_cast(long, (u32x2){ub[c].x, ub[c].y}), a1 = __builtin_bit_cast(long, (u32x2){ub[c].z, ub[c].w});
        acc = __builtin_amdgcn_mfma_f32_16x16x32_fp8_fp8(a0, b0, acc, 0, 0, 0);
        acc = __builtin_amdgcn_mfma_f32_16x16x32_fp8_fp8(a1, b1, acc, 0, 0, 0);
        if ((c & 3) == 3) __builtin_amdgcn_sched_barrier(0);
      }
      u32x4 vb[8];
#pragma unroll
      for (int j = 0; j < 8; ++j) {
        const int ej = __builtin_amdgcn_readlane(esel, lb + 8 + j);
        vb[j] = *(const u32x4*)(V8 + (size_t)ej * 1024 + lane * 16);
      }
      float wv[4];
#pragma unroll
      for (int r = 0; r < 4; ++r) {
        const float sur = __shfl(susel, lb + 4 * g + r), gvr = __shfl(gvsel, lb + 4 * g + r);
        wv[r] = gvr * gelu_tanh(acc[r] * sur);
      }
#pragma unroll
      for (int j = 0; j < 16; ++j) {
        const float wj = __int_as_float(__builtin_amdgcn_readlane(__float_as_int(wv[j & 3]), 16 * (j >> 2)));
        const u32x4 vv = j < 8 ? va[j & 7] : vb[j & 7];
#pragma unroll
        for (int q = 0; q < 4; ++q) {
          const f32x2 lo = __builtin_amdgcn_cvt_pk_f32_fp8((int)vv[q], false), hi = __builtin_amdgcn_cvt_pk_f32_fp8((int)vv[q], true);
          out[4 * q + 0] += wj * lo[0]; out[4 * q + 1] += wj * lo[1]; out[4 * q + 2] += wj * hi[0]; out[4 * q + 3] += wj * hi[1];
        }
      }
    }
    const int b = t < TL ? (t >> 11) : 16;
    const float* md = modbuf + ((size_t)l * 17 + b) * 6144 + 5 * 1024 + 16 * lane;
    float* xr = xres + (size_t)t * 1024 + 16 * lane;
    float xn[16];
    float ss = 0.f;
#pragma unroll
    for (int q = 0; q < 4; ++q) {
      const float4 m4 = *(const float4*)(md + 4 * q);
      float4 xv = *(const float4*)(xr + 4 * q);
      xv.x += m4.x * out[4 * q + 0]; xv.y += m4.y * out[4 * q + 1]; xv.z += m4.z * out[4 * q + 2]; xv.w += m4.w * out[4 * q + 3];
      xn[4 * q] = xv.x; xn[4 * q + 1] = xv.y; xn[4 * q + 2] = xv.z; xn[4 * q + 3] = xv.w;
      ss += xv.x * xv.x + xv.y * xv.y + xv.z * xv.z + xv.w * xv.w;
      if (dry) asm volatile("" :: "v"(xv.x), "v"(xv.y), "v"(xv.z), "v"(xv.w));
      else if (l < NL - 1) *(float4*)(xr + 4 * q) = xv;
    }
    if (!dry) {
      ss = wave_sum(ss);
      const float rstd = rsqrtf(ss * (1.f / 1024.f) + 1e-6f);
      if (l == NL - 1) {
        const float* fg = p.final_g + 16 * lane;
        float* orow = p.out + (size_t)t * 1024 + 16 * lane;
#pragma unroll
        for (int q = 0; q < 4; ++q) {
          const float4 g4 = *(const float4*)(fg + 4 * q);
          float4 o = {xn[4 * q] * rstd * g4.x, xn[4 * q + 1] * rstd * g4.y, xn[4 * q + 2] * rstd * g4.z, xn[4 * q + 3] * rstd * g4.w};
          *(float4*)(orow + 4 * q) = o;
        }
      } else {
        const float* gvec = p.norm1_g + (l + 1) * 1024 + 16 * lane;
        const float* mdn = modbuf + ((size_t)(l + 1) * 17 + b) * 6144 + 16 * lane;
        bf16_t* hrow = (bf16_t*)(p.ws + OFF_H) + (size_t)t * 1024 + 16 * lane;
        unsigned pk[8];
#pragma unroll
        for (int q = 0; q < 4; ++q) {
          const float4 g4 = *(const float4*)(gvec + 4 * q), sh = *(const float4*)(mdn + 4 * q), sc = *(const float4*)(mdn + 1024 + 4 * q);
          const float o0 = xn[4 * q] * rstd * g4.x * (1.f + sc.x) + sh.x, o1 = xn[4 * q + 1] * rstd * g4.y * (1.f + sc.y) + sh.y;
          const float o2 = xn[4 * q + 2] * rstd * g4.z * (1.f + sc.z) + sh.z, o3 = xn[4 * q + 3] * rstd * g4.w * (1.f + sc.w) + sh.w;
          pk[2 * q] = pk2(o0, o1); pk[2 * q + 1] = pk2(o2, o3);
        }
        *(u32x4*)hrow = (u32x4){pk[0], pk[1], pk[2], pk[3]};
        *(u32x4*)(hrow + 8) = (u32x4){pk[4], pk[5], pk[6], pk[7]};
      }
    }
  }
}

DI void phase_final(const Params& p) {
  const int lane = ltid() & 63, gw = lbid() * 4 + (ltid() >> 6), nw = lgdim() * 4;
  const float* xres = (const float*)(p.ws + OFF_XRES);
  for (int t = gw; t < TL; t += nw) {
    const float* src = xres + (size_t)t * 1024;
    float4 v[4];
    float ss = 0.f;
#pragma unroll
    for (int i = 0; i < 4; ++i) {
      v[i] = *(const float4*)(src + 4 * lane + 256 * i);
      ss += v[i].x * v[i].x + v[i].y * v[i].y + v[i].z * v[i].z + v[i].w * v[i].w;
    }
    ss = wave_sum(ss);
    const float rstd = rsqrtf(ss * (1.f / 1024.f) + 1e-6f);
#pragma unroll
    for (int i = 0; i < 4; ++i) {
      const int col = 4 * lane + 256 * i;
      const float4 g4 = *(const float4*)(p.final_g + col);
      float4 o = {v[i].x * rstd * g4.x, v[i].y * rstd * g4.y, v[i].z * rstd * g4.z, v[i].w * rstd * g4.w};
      *(float4*)(p.out + (size_t)t * 1024 + col) = o;
    }
  }
}


#define LAS __attribute__((address_space(3)))
#define XB_TMO      128
#define XB_XCNT(j)  (256  + 64 * (j))
#define XB_XSUB(j)  (1280 + 64 * (j))
#define XB_XGEN(j)  (2304 + 64 * (j))
#define XB_TOP      3328
#define XB_TOPGEN   3392
#define XCD_BAR_WORDS 3456
#define XB_SPIN_CAP (1u << 22)
DI unsigned xb_ld(unsigned* p) { return __hip_atomic_load(p, __ATOMIC_RELAXED, __HIP_MEMORY_SCOPE_AGENT); }
DI unsigned xb_add(unsigned* p, unsigned v) { return __hip_atomic_fetch_add(p, v, __ATOMIC_RELAXED, __HIP_MEMORY_SCOPE_AGENT); }
DI unsigned xb_xcc_id() { return (unsigned)__builtin_amdgcn_s_getreg((3 << 11) | 20) & 0xFu; }
#define XB_SPIN(cond, bar) do { unsigned _sp = 0; while (cond) { __builtin_amdgcn_s_sleep(1); \
    if ((++_sp & 255u) == 0u) { if (xb_ld(&(bar)[XB_TMO])) break; if (_sp > XB_SPIN_CAP) { atomicAdd(&(bar)[XB_TMO], 1u); break; } } } } while (0)
struct XcdBarrier { unsigned* bar; unsigned x; volatile unsigned* st; };
DI XcdBarrier xcd_barrier_post(unsigned* bar, volatile unsigned* st) {
  XcdBarrier b; b.bar = bar; b.x = xb_xcc_id(); b.st = st;
  if (threadIdx.x == 0) (void)xb_add(&bar[XB_XCNT(b.x)], 1u);
  return b;
}
DI void xcd_barrier_complete(unsigned* bar, unsigned x, unsigned& nloc, unsigned& nx) {
  const unsigned G = gridDim.x * gridDim.y * gridDim.z;
  unsigned sum, cnt, mine, sp = 0u;
  for (;;) {
    sum = 0u; cnt = 0u; mine = 0u;
#pragma unroll
    for (unsigned j = 0; j < 16; ++j) { const unsigned c = xb_ld(&bar[XB_XCNT(j)]); sum += c; cnt += (c > 0u) ? 1u : 0u; mine = (j == x) ? c : mine; }
    if (sum == G) break;
    __builtin_amdgcn_s_sleep(1);
    if ((++sp & 255u) == 0u) { if (xb_ld(&bar[XB_TMO])) break; if (sp > XB_SPIN_CAP) { atomicAdd(&bar[XB_TMO], 1u); break; } }
  }
  nloc = mine > 0u ? mine : 1u; nx = cnt > 0u ? cnt : 1u;
}
DI void xcd_barrier(const XcdBarrier& b) {
  asm volatile("s_waitcnt vmcnt(0)" ::: "memory");
  __syncthreads();
  if (threadIdx.x == 0) {
    unsigned* bar = b.bar;
    __builtin_amdgcn_s_waitcnt(0);
    unsigned nloc = b.st[0], nx = b.st[1];
    if (nloc == 0u) { xcd_barrier_complete(bar, b.x, nloc, nx); b.st[0] = nloc; b.st[1] = nx; }
    const unsigned old = xb_add(&bar[XB_XSUB(b.x)], 1u);
    const unsigned gen = old / nloc;
    if (old + 1u == (gen + 1u) * nloc) {
      __builtin_amdgcn_fence(__ATOMIC_RELEASE, "agent");
      asm volatile("s_waitcnt vmcnt(0)" ::: "memory");
      const unsigned og = xb_add(&bar[XB_TOP], 1u);
      const unsigned tg = og / nx;
      if (og + 1u == (tg + 1u) * nx) xb_add(&bar[XB_TOPGEN], 1u);
      else XB_SPIN(xb_ld(&bar[XB_TOPGEN]) == tg, bar);
      __builtin_amdgcn_fence(__ATOMIC_ACQUIRE, "agent");
      xb_add(&bar[XB_XGEN(b.x)], 1u);
      asm volatile("s_waitcnt vmcnt(0)" ::: "memory");
    } else {
      XB_SPIN(xb_ld(&bar[XB_XGEN(b.x)]) == gen, bar);
      __builtin_amdgcn_fence(__ATOMIC_ACQUIRE, "agent");
      asm volatile("s_waitcnt vmcnt(0)" ::: "memory");
    }
  }
  __syncthreads();
}

constexpr int PH_PER_LAYER = 10;
constexpr int N_PHASES = 1 + NL * PH_PER_LAYER + 1;

template <int KIND>
DI void run_phase(const Params& p, int ph, unsigned char* lds) {
  unsigned* ctl = (unsigned*)(p.ws + OFF_CTL);
  if (ph == 0) { if (KIND < 0 || KIND == 0) phase_prologue(p, lds); }
  else if (ph == N_PHASES - 1) { if (KIND < 0 || KIND == 11) phase_final(p); }
  else {
    const int l = (ph - 1) / PH_PER_LAYER, s = (ph - 1) % PH_PER_LAYER;
    const bool last = (l == NL - 1);
    const int ntok = last ? TL : TT;
    if (s == 0) { if (KIND < 0 || KIND == 1) phase_norm(p, l, 0, TT); }
    else if (s == 1) { if (KIND < 0 || KIND == 2) phase_gemm_in(p, l, lds); }
    else if (s == 2) { if (KIND < 0 || KIND == 3) phase_rope(p, lds); }
    else if (s == 3) { if (KIND < 0 || KIND == 4) phase_mixers(p, l, last, ctl + 64 * (1 + l), lds); }
    else if (s == 4) { if (KIND < 0 || KIND == 5) phase_gla_fin(p, l, ntok); }
    else if (s == 5) { if (KIND < 0 || KIND == 6) phase_gemm_out(p, l, ntok, lds); }
    else if (s == 6) { if (KIND < 0 || KIND == 7) phase_norm(p, l, 1, ntok); }
    else if (s == 7) { if (KIND < 0 || KIND == 8) phase_gemm_q(p, l, ntok, lds); }
    else if (s == 8) { if (KIND < 0 || KIND == 9) phase_topk(p, l, ntok); }
    else { if (KIND < 0 || KIND == 10) phase_gather(p, l, ntok, lds); }
  }
}

#if N_LAUNCH_MODE == 1
#ifndef PROBE_KIND
#define PROBE_KIND -1
#endif
#ifndef GLA_VAR
#define GLA_VAR 0
#endif
constexpr int CW_BAR = 4096;
__global__ void __launch_bounds__(256, 2) mk_fwd(Params p) {
  __shared__ __attribute__((aligned(16))) unsigned char lds[LDS_BYTES];
  unsigned* ctl = (unsigned*)(p.ws + OFF_CTL);
  volatile unsigned* st = (volatile unsigned*)(lds + LDS_BYTES - 32);
  if (threadIdx.x < 2) st[threadIdx.x] = 0u;
  __syncthreads();
  (void)xcd_barrier_post(ctl + CW_BAR, st);
#define GSYNC() do { XcdBarrier bb; bb.bar = (unsigned*)(p.ws + OFF_CTL) + CW_BAR; bb.x = xb_xcc_id(); bb.st = (volatile unsigned*)(lds + LDS_BYTES - 32); xcd_barrier(bb); } while (0)
  { Params q = p; { size_t z_ = 0; asm volatile("" : "+s"(z_)); q.ws = p.ws + z_; } phase_prologue(q, lds); } cg::this_grid().sync();
  if (PROBE_KIND == 0) { { Params q = p; { size_t z_ = 0; asm volatile("" : "+s"(z_)); q.ws = p.ws + z_; } phase_prologue(q, lds); } GSYNC(); }
  for (int l = 0; l < NL; ++l) {
    const bool last = (l == NL - 1);
    const int ntok = last ? TL : TT;
    if (l == 0) { { Params q = p; { size_t z_ = 0; asm volatile("" : "+s"(z_)); q.ws = p.ws + z_; } phase_norm(q, l, 0, TT); } GSYNC(); }
    if (PROBE_KIND == 1) { { Params q = p; { size_t z_ = 0; asm volatile("" : "+s"(z_)); q.ws = p.ws + z_; } phase_norm(q, l, 0, TT); } GSYNC(); }
    { Params q = p; { size_t z_ = 0; asm volatile("" : "+s"(z_)); q.ws = p.ws + z_; } phase_gemm_in(q, l, lds); } GSYNC();
    if (PROBE_KIND == 2) { { Params q = p; { size_t z_ = 0; asm volatile("" : "+s"(z_)); q.ws = p.ws + z_; } phase_gemm_in(q, l, lds); } GSYNC(); }
    if (PROBE_KIND == 4 || (PROBE_KIND >= 41 && PROBE_KIND <= 47)) { { Params q = p; { size_t z_ = 0; asm volatile("" : "+s"(z_)); q.ws = p.ws + z_; } phase_mixers(q, l, last, ctl + 64 * (1 + l) + 1, lds, PROBE_KIND == 4 ? 7 : PROBE_KIND - 40, GLA_VAR); } GSYNC(); }
    { Params q = p; { size_t z_ = 0; asm volatile("" : "+s"(z_)); q.ws = p.ws + z_; } phase_mixers(q, l, last, ctl + 64 * (1 + l), lds); } GSYNC();
    { Params q = p; { size_t z_ = 0; asm volatile("" : "+s"(z_)); q.ws = p.ws + z_; } phase_gla_fin(q, l, ntok); } GSYNC();
    if (PROBE_KIND == 5) { { Params q = p; { size_t z_ = 0; asm volatile("" : "+s"(z_)); q.ws = p.ws + z_; } phase_gla_fin(q, l, ntok); } GSYNC(); }
    { Params q = p; { size_t z_ = 0; asm volatile("" : "+s"(z_)); q.ws = p.ws + z_; } phase_gemm_out(q, l, ntok, lds); } GSYNC();
    { Params q = p; { size_t z_ = 0; asm volatile("" : "+s"(z_)); q.ws = p.ws + z_; } phase_norm(q, l, 1, ntok); } GSYNC();
    if (PROBE_KIND == 7) { { Params q = p; { size_t z_ = 0; asm volatile("" : "+s"(z_)); q.ws = p.ws + z_; } phase_norm(q, l, 1, ntok); } GSYNC(); }
    { Params q = p; { size_t z_ = 0; asm volatile("" : "+s"(z_)); q.ws = p.ws + z_; } phase_gemm_q(q, l, ntok, lds); } GSYNC();
    if (PROBE_KIND == 8) { { Params q = p; { size_t z_ = 0; asm volatile("" : "+s"(z_)); q.ws = p.ws + z_; } phase_gemm_q(q, l, ntok, lds); } GSYNC(); }
    { Params q = p; { size_t z_ = 0; asm volatile("" : "+s"(z_)); q.ws = p.ws + z_; } phase_topk(q, l, ntok); } GSYNC();
    if (PROBE_KIND == 9) { { Params q = p; { size_t z_ = 0; asm volatile("" : "+s"(z_)); q.ws = p.ws + z_; } phase_topk(q, l, ntok); } GSYNC(); }
    if (PROBE_KIND == 10) { { Params q = p; { size_t z_ = 0; asm volatile("" : "+s"(z_)); q.ws = p.ws + z_; } phase_gather(q, l, ntok, lds, true); } GSYNC(); }
    { Params q = p; { size_t z_ = 0; asm volatile("" : "+s"(z_)); q.ws = p.ws + z_; } phase_gather(q, l, ntok, lds); } if (l + 1 < NL) GSYNC();
  }
}
#else
template <int KIND>
__global__ void __launch_bounds__(256, 2) mk_phase(Params p) {
  __shared__ __attribute__((aligned(16))) unsigned char lds[LDS_BYTES];
  run_phase<KIND>(p, p.ph_lo, lds);
}
#endif

extern "C" void kernel_launch(void* const* d_in, const int* in_sizes, int n_in, void* d_out, int out_size, void* d_ws,
                              size_t ws_size, hipStream_t stream) {
  static int grid = 0;
  if (grid == 0) {
    if (n_in != 21 || ws_size < WS_END || out_size != TL * DM) { fprintf(stderr, "kernel_launch: unexpected shapes (n_in %d ws %zu out %d)\n", n_in, ws_size, out_size); grid = -1; return; }
    int dev = 0, cus = 0, per_cu = 2;
    (void)hipGetDevice(&dev);
    (void)hipDeviceGetAttribute(&cus, hipDeviceAttributeMultiprocessorCount, dev);
#if N_LAUNCH_MODE == 1
    (void)hipOccupancyMaxActiveBlocksPerMultiprocessor(&per_cu, (const void*)mk_fwd, 256, 0);
    if (per_cu < 1) per_cu = 1;
    if (per_cu > 2) per_cu = 2;
#endif
    grid = cus * per_cu;
  }
  if (grid < 0) return;
  (void)hipMemsetAsync((char*)d_ws + OFF_CTL, 0, 65536, stream);
  Params p{};
  const float** pp = (const float**)&p;
  for (int i = 0; i < 21; ++i) pp[i] = (const float*)d_in[i];
  p.out = (float*)d_out;
  p.ws = (unsigned char*)d_ws;
#if N_LAUNCH_MODE == 1
  p.ph_lo = 0; p.ph_hi = N_PHASES;
  void* args[] = {&p};
  hipError_t e = hipLaunchCooperativeKernel((const void*)mk_fwd, dim3(grid), dim3(256), args, 0, stream);
  if (e != hipSuccess) fprintf(stderr, "cooperative launch failed: %s (grid %d)\n", hipGetErrorString(e), grid);
#else
  for (int ph = 0; ph < N_PHASES; ++ph) {
    p.ph_lo = ph; p.ph_hi = ph + 1;
    const int kind = ph == 0 ? 0 : (ph == N_PHASES - 1 ? 11 : 1 + (ph - 1) % PH_PER_LAYER);
    switch (kind) {
      case 0: hipLaunchKernelGGL(mk_phase<0>, dim3(grid), dim3(256), 0, stream, p); break;
      case 1: hipLaunchKernelGGL(mk_phase<1>, dim3(grid), dim3(256), 0, stream, p); break;
      case 2: hipLaunchKernelGGL(mk_phase<2>, dim3(grid), dim3(256), 0, stream, p); break;
      case 3: hipLaunchKernelGGL(mk_phase<3>, dim3(grid), dim3(256), 0, stream, p); break;
      case 4: hipLaunchKernelGGL(mk_phase<4>, dim3(grid), dim3(256), 0, stream, p); break;
      case 5: hipLaunchKernelGGL(mk_phase<5>, dim3(grid), dim3(256), 0, stream, p); break;
      case 6: hipLaunchKernelGGL(mk_phase<6>, dim3(grid), dim3(256), 0, stream, p); break;
      case 7: hipLaunchKernelGGL(mk_phase<7>, dim3(grid), dim3(256), 0, stream, p); break;
      case 8: hipLaunchKernelGGL(mk_phase<8>, dim3(grid), dim3(256), 0, stream, p); break;
      case 9: hipLaunchKernelGGL(mk_phase<9>, dim3(grid), dim3(256), 0, stream, p); break;
      case 10: hipLaunchKernelGGL(mk_phase<10>, dim3(grid), dim3(256), 0, stream, p); break;
      default: hipLaunchKernelGGL(mk_phase<11>, dim3(grid), dim3(256), 0, stream, p); break;
    }
  }
#endif
}
```

```cpp
#include <hip/hip_runtime.h>
#include <hip/hip_cooperative_groups.h>
#include <stdint.h>
#include <stdio.h>
namespace cg = cooperative_groups;

#ifndef N_LAUNCH_MODE
#define N_LAUNCH_MODE 1
#endif

#define DI __device__ __forceinline__
#ifndef GEMM_VAR
#define GEMM_VAR 0
#endif
typedef unsigned short bf16_t;
typedef short bf16x8 __attribute__((ext_vector_type(8)));
typedef float f32x4 __attribute__((ext_vector_type(4)));
typedef float f32x2 __attribute__((ext_vector_type(2)));
typedef float f32x16 __attribute__((ext_vector_type(16)));
typedef float f32x32 __attribute__((ext_vector_type(32)));
typedef unsigned u32x6 __attribute__((ext_vector_type(6)));
typedef int i32x8 __attribute__((ext_vector_type(8)));
typedef unsigned u32x4 __attribute__((ext_vector_type(4)));
typedef unsigned u32x2 __attribute__((ext_vector_type(2)));

constexpr int NB = 16, SEQ = 2048, DM = 1024, NL = 4, CTXL = 256;
constexpr int TL = NB * SEQ;
constexpr int TC = NB * CTXL;
constexpr int TT = TL + TC;
constexpr int PN_LD = 2176;
constexpr int C_GQ = 0, C_GK = 128, C_GR = 256, C_NQ = 512, C_NK = 768, C_DQ = 1024, C_DK = 1536, C_GATE = 2048;
constexpr int R_GV = 0, R_NV = 256, R_DV = 512;
constexpr float LOG2E = 1.4426950408889634f;
constexpr float SC_LOG2 = 0.125f * LOG2E;
constexpr float NEG_BIG = -1e30f;

constexpr size_t MiB = 1u << 20;
constexpr size_t OFF_CTL = 0;
constexpr size_t OFF_MOD = 1 * MiB;
constexpr size_t OFF_WIN = 3 * MiB;
constexpr size_t OFF_WOUT = 28 * MiB;
constexpr size_t OFF_WQ = 36 * MiB;
constexpr size_t OFF_SK = 44 * MiB;
constexpr size_t OFF_USCL = 44 * MiB + 256 * 1024;
constexpr size_t OFF_VSCL = 44 * MiB + 512 * 1024;
constexpr size_t OFF_U = 45 * MiB;
constexpr size_t OFF_V = 109 * MiB;
constexpr int V6_PITCH = 800;
constexpr size_t OFF_XRES = 301 * MiB;
constexpr size_t OFF_H = 445 * MiB;
constexpr size_t OFF_P = 517 * MiB;
constexpr size_t OFF_VT = OFF_P + 153 * MiB;
constexpr size_t OFF_QP = OFF_P;
constexpr size_t OFF_EID = OFF_P + 72 * MiB;
constexpr size_t OFF_GATE = OFF_P + 90 * MiB;
constexpr size_t OFF_H8 = OFF_P + 126 * MiB;
constexpr size_t OFF_HINV = OFF_P + 162 * MiB;
constexpr size_t OFF_Y = 742 * MiB;
constexpr size_t WS_END = 814 * MiB;

constexpr int LDS_BYTES = 65536 + 8192;

struct Params {
  const float *x, *c, *ctx, *c_ctx, *ada_w, *ada_b, *norm1_g, *norm2_g, *w_in, *gate_up, *gate_b, *gla_norm_g,
      *rpb, *dlam, *diff_g, *w_out, *wq, *subkeys, *pu, *pv, *final_g;
  float* out;
  unsigned char* ws;
  int ph_lo, ph_hi;
};

DI int ltid() { int t = threadIdx.x; asm volatile("" : "+v"(t)); return t; }
DI int lbid() { int t = blockIdx.x; asm volatile("" : "+s"(t)); return t; }
DI int lgdim() { int t = gridDim.x; asm volatile("" : "+s"(t)); return t; }

DI unsigned f2bf(float f) { unsigned u = __float_as_uint(f); return (u + 0x7fffu + ((u >> 16) & 1u)) >> 16; }
typedef __bf16 bf16x2_t __attribute__((ext_vector_type(2)));
DI unsigned pk2(float lo, float hi) { f32x2 v = {lo, hi}; return __builtin_bit_cast(unsigned, __builtin_convertvector(v, bf16x2_t)); }
DI float bflo(unsigned u) { return __uint_as_float(u << 16); }
DI float bfhi(unsigned u) { return __uint_as_float(u & 0xffff0000u); }
DI void unpack8(const u32x4 v, float* f) {
  f[0] = bflo(v.x); f[1] = bfhi(v.x); f[2] = bflo(v.y); f[3] = bfhi(v.y);
  f[4] = bflo(v.z); f[5] = bfhi(v.z); f[6] = bflo(v.w); f[7] = bfhi(v.w);
}
DI float wave_sum(float v) {
#pragma unroll
  for (int o = 32; o >= 1; o >>= 1) v += __shfl_xor(v, o);
  return v;
}

DI float rows_max(float x) {
  unsigned u = __float_as_uint(x);
  u32x2 a = __builtin_amdgcn_permlane32_swap(u, u, false, false);
  const float m = fmaxf(__uint_as_float(a[0]), __uint_as_float(a[1]));
  unsigned v = __float_as_uint(m);
  u32x2 b = __builtin_amdgcn_permlane16_swap(v, v, false, false);
  return fmaxf(__uint_as_float(b[0]), __uint_as_float(b[1]));
}
DI float rows_sum(float x) {
  unsigned u = __float_as_uint(x);
  u32x2 a = __builtin_amdgcn_permlane32_swap(u, u, false, false);
  const float m = __uint_as_float(a[0]) + __uint_as_float(a[1]);
  unsigned v = __float_as_uint(m);
  u32x2 b = __builtin_amdgcn_permlane16_swap(v, v, false, false);
  return __uint_as_float(b[0]) + __uint_as_float(b[1]);
}

DI u32x6 mxfp6_pack32(float (&x)[32], unsigned& sbyte) {
  float am = 0.f;
#pragma unroll
  for (int i = 0; i < 32; ++i) am = fmaxf(am, fabsf(x[i]));
  int e = am > 0.f ? (int)ceilf(log2f(am) - 2.906890596f) : -126;
  e = e < -126 ? -126 : (e > 127 ? 127 : e);
  const float sc = __uint_as_float((unsigned)(127 - e) << 23);
  f32x16 lo, hi;
#pragma unroll
  for (int i = 0; i < 16; ++i) { lo[i] = x[2 * i] * sc; hi[i] = x[2 * i + 1] * sc; }
  sbyte = (unsigned)(127 + e);
  return __builtin_amdgcn_cvt_scalef32_2xpk16_fp6_f32(lo, hi, 1.0f);
}
DI int mx_scale_pos(int blk) { return 768 + (blk & 3) * 8 + (blk >> 2); }
DI f32x4 mfma16(bf16x8 a, bf16x8 b, f32x4 c) { return __builtin_amdgcn_mfma_f32_16x16x32_bf16(a, b, c, 0, 0, 0); }

DI int win_src_col(int r) {
  if (r < 256) return r;
  if (r < 512) return r - 256 + 512;
  if (r < 768) return r - 512 + 800;
  if (r < 1024) return r - 768 + 1056;
  if (r < 1536) return r - 1024 + 1568;
  if (r < 2048) return r - 1536 + 2080;
  if (r < 2080) return r - 2048 + 768;
  if (r < 2176) return -1;
  if (r < 2432) return r - 2176 + 256;
  if (r < 2688) return r - 2432 + 1312;
  return r - 2688 + 2592;
}

DI void transpose_item(const float* __restrict__ W, int N, int src, bf16_t* __restrict__ dst, float* lds) {
  const int tid = ltid();
  for (int kc = 0; kc < 8; ++kc) {
    __syncthreads();
#pragma unroll
    for (int i = 0; i < 16; ++i) {
      int k = i * 8 + (tid >> 5), n = tid & 31;
      lds[k * 33 + n] = (src < 0) ? 0.f : W[(size_t)(kc * 128 + k) * N + src + n];
    }
    __syncthreads();
    int row = tid >> 3, k0 = (tid & 7) * 16;
    unsigned o[8];
#pragma unroll
    for (int e = 0; e < 8; ++e) o[e] = pk2(lds[(k0 + 2 * e) * 33 + row], lds[(k0 + 2 * e + 1) * 33 + row]);
    u32x4 a = {o[0], o[1], o[2], o[3]}, b = {o[4], o[5], o[6], o[7]};
    bf16_t* d = dst + (size_t)row * 1024 + kc * 128 + k0;
    *(u32x4*)d = a; *(u32x4*)(d + 8) = b;
  }
}

DI void phase_prologue(const Params& p, unsigned char* lds) {
  const int tid = ltid(), nb = lgdim(), bid = lbid();
  bf16_t* winT = (bf16_t*)(p.ws + OFF_WIN);
  bf16_t* woutT = (bf16_t*)(p.ws + OFF_WOUT);
  bf16_t* wqT = (bf16_t*)(p.ws + OFF_WQ);
  constexpr int PER_LAYER = 100 + 32 + 32;
  for (int item = bid; item < NL * PER_LAYER; item += nb) {
    int l = item / PER_LAYER, r = item % PER_LAYER;
    if (r < 100) {
      int row = r * 32;
      transpose_item(p.w_in + (size_t)l * 1024 * 3104, 3104, win_src_col(row), winT + ((size_t)l * 3200 + row) * 1024, (float*)lds);
    } else if (r < 132) {
      int row = (r - 100) * 32;
      transpose_item(p.w_out + (size_t)l * 1024 * 1024, 1024, row, woutT + ((size_t)l * 1024 + row) * 1024, (float*)lds);
    } else {
      int row = (r - 132) * 32;
      transpose_item(p.wq + (size_t)l * 1024 * 1024, 1024, row, wqT + ((size_t)l * 1024 + row) * 1024, (float*)lds);
    }
  }
  {
    const int lane = tid & 63, gw = bid * 4 + (tid >> 6), nw = nb * 4;
    for (int pr = gw; pr < NL * 16384; pr += nw) {
      const int tab = pr >= NL * 16384 / 2, pq = tab ? pr - NL * 16384 / 2 : pr;
      const int r = 2 * pq + (lane >> 5), blk = lane & 31;
      const float* src = (tab ? p.pv : p.pu) + (size_t)r * 1024 + 32 * blk;
      float x[32];
#pragma unroll
      for (int i = 0; i < 8; ++i) { const float4 a = *(const float4*)(src + 4 * i); x[4 * i] = a.x; x[4 * i + 1] = a.y; x[4 * i + 2] = a.z; x[4 * i + 3] = a.w; }
      unsigned sb;
      const u32x6 q = mxfp6_pack32(x, sb);
      unsigned char* row = p.ws + (tab ? OFF_V : OFF_U) + (size_t)r * V6_PITCH;
      *(u32x2*)(row + 24 * blk) = (u32x2){q[0], q[1]};
      *(u32x2*)(row + 24 * blk + 8) = (u32x2){q[2], q[3]};
      *(u32x2*)(row + 24 * blk + 16) = (u32x2){q[4], q[5]};
      row[mx_scale_pos(blk)] = (unsigned char)sb;
    }
  }
  {
    bf16_t* sk = (bf16_t*)(p.ws + OFF_SK);
    for (int i = bid * 256 + tid; i < NL * 2 * 128 * 64; i += nb * 256) sk[i] = (bf16_t)f2bf(p.subkeys[i]);
  }
  {
    float* modbuf = (float*)(p.ws + OFF_MOD);
    float* sc = (float*)lds;
    float* red = (float*)(lds + 17 * 512 * 4);
    for (int item = bid; item < NL * 96; item += nb) {
      const int l = item / 96, cb = item % 96, col = cb * 64 + (tid & 63), kq = tid >> 6;
      float acc[17];
#pragma unroll
      for (int r = 0; r < 17; ++r) acc[r] = 0.f;
      for (int half = 0; half < 2; ++half) {
        __syncthreads();
        for (int e = tid; e < 17 * 512; e += 256) {
          int r = e >> 9, k = e & 511;
          float cv = (r < 16) ? p.c[r * 1024 + half * 512 + k] : p.c_ctx[half * 512 + k];
          sc[e] = cv / (1.f + __expf(-cv));
        }
        __syncthreads();
        const float* wp = p.ada_w + ((size_t)l * 1024 + half * 512 + kq * 128) * 6144 + col;
        for (int kk = 0; kk < 128; ++kk) {
          const float w = wp[(size_t)kk * 6144];
#pragma unroll
          for (int r = 0; r < 17; ++r) acc[r] += sc[r * 512 + kq * 128 + kk] * w;
        }
      }
#pragma unroll
      for (int r = 0; r < 17; ++r) red[(kq * 17 + r) * 64 + (tid & 63)] = acc[r];
      __syncthreads();
      for (int e = tid; e < 17 * 64; e += 256) {
        int r = e >> 6, cc = e & 63;
        float s = red[(0 * 17 + r) * 64 + cc] + red[(1 * 17 + r) * 64 + cc] + red[(2 * 17 + r) * 64 + cc] + red[(3 * 17 + r) * 64 + cc];
        int colg = cb * 64 + cc;
        modbuf[((size_t)l * 17 + r) * 6144 + colg] = s + p.ada_b[l * 6144 + colg];
      }
      __syncthreads();
    }
  }
}

DI void phase_norm(const Params& p, int l, int which, int ntok) {
  const int lane = ltid() & 63, gw = lbid() * 4 + (ltid() >> 6), nw = lgdim() * 4;
  const float* gvec = (which == 0 ? p.norm1_g : p.norm2_g) + l * 1024;
  const int ish = which == 0 ? 0 : 3, isc = which == 0 ? 1 : 4;
  const float* xres = (const float*)(p.ws + OFF_XRES);
  const float* modbuf = (const float*)(p.ws + OFF_MOD);
  bf16_t* hbuf = (bf16_t*)(p.ws + OFF_H);
  for (int t = gw; t < ntok; t += nw) {
    const float* src = (which == 0 && l == 0) ? (t < TL ? p.x + (size_t)t * 1024 : p.ctx + (size_t)(t - TL) * 1024) : xres + (size_t)t * 1024;
    const int b = t < TL ? (t >> 11) : 16;
    const float* md = modbuf + ((size_t)l * 17 + b) * 6144;
    float4 v[4];
    float ss = 0.f;
#pragma unroll
    for (int i = 0; i < 4; ++i) {
      v[i] = *(const float4*)(src + 4 * lane + 256 * i);
      ss += v[i].x * v[i].x + v[i].y * v[i].y + v[i].z * v[i].z + v[i].w * v[i].w;
    }
    ss = wave_sum(ss);
    const float rstd = rsqrtf(ss * (1.f / 1024.f) + 1e-6f);
    float am = 0.f;
#pragma unroll
    for (int i = 0; i < 4; ++i) {
      const int col = 4 * lane + 256 * i;
      const float4 g4 = *(const float4*)(gvec + col), sh = *(const float4*)(md + ish * 1024 + col), sc = *(const float4*)(md + isc * 1024 + col);
      float o0 = v[i].x * rstd * g4.x * (1.f + sc.x) + sh.x;
      float o1 = v[i].y * rstd * g4.y * (1.f + sc.y) + sh.y;
      float o2 = v[i].z * rstd * g4.z * (1.f + sc.z) + sh.z;
      float o3 = v[i].w * rstd * g4.w * (1.f + sc.w) + sh.w;
      u32x2 o = {pk2(o0, o1), pk2(o2, o3)};
      *(u32x2*)(hbuf + (size_t)t * 1024 + col) = o;
      v[i].x = o0; v[i].y = o1; v[i].z = o2; v[i].w = o3;
      am = fmaxf(am, fmaxf(fmaxf(fabsf(o0), fabsf(o1)), fmaxf(fabsf(o2), fabsf(o3))));
    }
  }
}

DI void phase_norm2(const Params& p, int l, int ntok) {
  const int lane = ltid() & 63, gw = lbid() * 4 + (ltid() >> 6), nw = lgdim() * 4;
  const int half = lane >> 5, blk = lane & 31;
  const float* gvec = p.norm2_g + l * 1024 + 32 * blk;
  const float* xres = (const float*)(p.ws + OFF_XRES);
  const float* modbuf = (const float*)(p.ws + OFF_MOD);
  bf16_t* hbuf = (bf16_t*)(p.ws + OFF_H);
  unsigned char* h6 = p.ws + OFF_H8;
  for (int pr = gw; pr < ntok / 2; pr += nw) {
    const int t = 2 * pr + half;
    const float* src = xres + (size_t)t * 1024 + 32 * blk;
    const int b = t < TL ? (t >> 11) : 16;
    const float* md = modbuf + ((size_t)l * 17 + b) * 6144 + 32 * blk;
    float x[32];
    float ss = 0.f;
#pragma unroll
    for (int i = 0; i < 8; ++i) {
      const float4 a = *(const float4*)(src + 4 * i);
      x[4 * i] = a.x; x[4 * i + 1] = a.y; x[4 * i + 2] = a.z; x[4 * i + 3] = a.w;
      ss += a.x * a.x + a.y * a.y + a.z * a.z + a.w * a.w;
    }
#pragma unroll
    for (int o = 16; o >= 1; o >>= 1) ss += __shfl_xor(ss, o);
    const float rstd = rsqrtf(ss * (1.f / 1024.f) + 1e-6f);
    unsigned pk[16];
#pragma unroll
    for (int i = 0; i < 8; ++i) {
      const float4 g4 = *(const float4*)(gvec + 4 * i), sh = *(const float4*)(md + 3 * 1024 + 4 * i), sc = *(const float4*)(md + 4 * 1024 + 4 * i);
      x[4 * i] = x[4 * i] * rstd * g4.x * (1.f + sc.x) + sh.x;
      x[4 * i + 1] = x[4 * i + 1] * rstd * g4.y * (1.f + sc.y) + sh.y;
      x[4 * i + 2] = x[4 * i + 2] * rstd * g4.z * (1.f + sc.z) + sh.z;
      x[4 * i + 3] = x[4 * i + 3] * rstd * g4.w * (1.f + sc.w) + sh.w;
      pk[2 * i] = pk2(x[4 * i], x[4 * i + 1]); pk[2 * i + 1] = pk2(x[4 * i + 2], x[4 * i + 3]);
    }
    bf16_t* hrow = hbuf + (size_t)t * 1024 + 32 * blk;
#pragma unroll
    for (int i = 0; i < 4; ++i) *(u32x4*)(hrow + 8 * i) = (u32x4){pk[4 * i], pk[4 * i + 1], pk[4 * i + 2], pk[4 * i + 3]};
    unsigned sb;
    const u32x6 q = mxfp6_pack32(x, sb);
    unsigned char* row = h6 + (size_t)t * V6_PITCH;
    *(u32x2*)(row + 24 * blk) = (u32x2){q[0], q[1]};
    *(u32x2*)(row + 24 * blk + 8) = (u32x2){q[2], q[3]};
    *(u32x2*)(row + 24 * blk + 16) = (u32x2){q[4], q[5]};
    row[mx_scale_pos(blk)] = (unsigned char)sb;
  }
}

template <int EPI>
DI void gemm_tile(const bf16_t* __restrict__ P, const bf16_t* __restrict__ Q, int it, int jt, void* outp, int ld,
                  const float* xin_lat, const float* xin_ctx, const float* modl, unsigned char* lds, bool gvar = false) {
  const int tid = ltid(), lane = tid & 63, w = tid >> 6, wi = w >> 1, wj = w & 1, lr = lane & 15, g = lane >> 4;
  const int wu = __builtin_amdgcn_readfirstlane(w);
  f32x4 acc[4][4];
#pragma unroll
  for (int a = 0; a < 4; ++a)
#pragma unroll
    for (int b = 0; b < 4; ++b) acc[a][b] = (f32x4){0.f, 0.f, 0.f, 0.f};
  const unsigned lo0 = (unsigned)((lane >> 3) * 1024 + (((lane & 7) ^ (lane >> 4)) << 3));
  const unsigned lo1 = (unsigned)((lane >> 3) * 1024 + (((lane & 7) ^ (4 + (lane >> 4))) << 3));
  const bf16_t* pg = P + (size_t)(it * 128 + 32 * wu) * 1024;
  const bf16_t* qg = Q + (size_t)(jt * 128 + 32 * wu) * 1024;
#define GT_DMA(kb, bf) do { _Pragma("unroll") for (int jj = 0; jj < 4; ++jj) { const unsigned lo_ = (jj & 1) ? lo1 : lo0; \
      __builtin_amdgcn_global_load_lds((const unsigned*)(pg + (size_t)jj * 8192 + (kb) * 64 + lo_), (unsigned*)(lds + (bf) * 32768 + (4 * wu + jj) * 1024), 16, 0, 0); \
      __builtin_amdgcn_global_load_lds((const unsigned*)(qg + (size_t)jj * 8192 + (kb) * 64 + lo_), (unsigned*)(lds + (bf) * 32768 + 16384 + (4 * wu + jj) * 1024), 16, 0, 0); } } while (0)
  __syncthreads();
  GT_DMA(0, 0);
  asm volatile("s_waitcnt vmcnt(0)" ::: "memory");
  __syncthreads();
  for (int kb = 0; kb < 16; ++kb) {
    if (kb < 15 && !(GEMM_VAR == 1 && gvar)) GT_DMA(kb + 1, (kb + 1) & 1);
    const unsigned char* Ps = lds + (kb & 1) * 32768;
    const unsigned char* Qs = Ps + 16384;
    bf16x8 pf[2][4], qf[2][4];
#pragma unroll
    for (int ks = 0; ks < 2; ++ks) {
      const int ch = ks * 4 + g;
#pragma unroll
      for (int mi = 0; mi < 4; ++mi) { const int row = wi * 64 + mi * 16 + lr; pf[ks][mi] = *(const bf16x8*)(Ps + (row >> 1) * 256 + (((((row & 1) << 3) | ch) ^ ((row >> 1) & 7)) << 4)); }
#pragma unroll
      for (int nj = 0; nj < 4; ++nj) { const int row = wj * 64 + nj * 16 + lr; qf[ks][nj] = *(const bf16x8*)(Qs + (row >> 1) * 256 + (((((row & 1) << 3) | ch) ^ ((row >> 1) & 7)) << 4)); }
    }
    __builtin_amdgcn_sched_barrier(0);
#pragma unroll
    for (int ks = 0; ks < 2; ++ks)
#pragma unroll
      for (int mi = 0; mi < 4; ++mi)
#pragma unroll
        for (int nj = 0; nj < 4; ++nj) { if (GEMM_VAR == 2 && gvar) { asm volatile("" :: "v"(pf[ks][mi]), "v"(qf[ks][nj])); } else acc[mi][nj] = mfma16(pf[ks][mi], qf[ks][nj], acc[mi][nj]); }
    __builtin_amdgcn_sched_barrier(0);
    asm volatile("s_waitcnt vmcnt(0)" ::: "memory");
    __syncthreads();
  }
#undef GT_DMA
  if (EPI == 2) {
    float inv[4];
#pragma unroll
    for (int r = 0; r < 4; ++r) inv[r] = __builtin_amdgcn_exp2f(-(float)(4 * g + r) * (13.287712379549449f / 16.f));
#pragma unroll
    for (int nj = 0; nj < 4; ++nj) {
      const int j = jt * 128 + wj * 64 + nj * 16 + lr;
      if (j < TL) {
        const float prow = (float)((j & 2047) >> 6), pcol = (float)(j & 63);
#pragma unroll
        for (int r = 0; r < 4; ++r) {
          const float a1 = prow * inv[r], a2 = pcol * inv[r];
          const float c1 = __cosf(a1), s1 = __sinf(a1), c2 = __cosf(a2), s2 = __sinf(a2);
          const float x1 = acc[0][nj][r], x2 = acc[1][nj][r], y1 = acc[2][nj][r], y2 = acc[3][nj][r];
          acc[0][nj][r] = x1 * c1 - x2 * s1; acc[1][nj][r] = x2 * c1 + x1 * s1;
          acc[2][nj][r] = y1 * c2 - y2 * s2; acc[3][nj][r] = y2 * c2 + y1 * s2;
        }
      }
    }
  }
#pragma unroll
  for (int mi = 0; mi < 4; ++mi)
#pragma unroll
    for (int nj = 0; nj < 4; ++nj) {
      const int j = jt * 128 + wj * 64 + nj * 16 + lr;
      const int i = it * 128 + wi * 64 + mi * 16 + 4 * g;
      const f32x4 a = acc[mi][nj];
      if (EPI == 0 || EPI == 2) {
        u32x2 o = {pk2(a[0], a[1]), pk2(a[2], a[3])};
        *(u32x2*)((bf16_t*)outp + (size_t)j * ld + i) = o;
      } else {
        const int b = j < TL ? (j >> 11) : 16;
        const float4 gt = *(const float4*)(modl + (size_t)b * 6144 + 2 * 1024 + i);
        const float* xs = (j < TL) ? xin_lat + (size_t)j * 1024 + i : xin_ctx + (size_t)(j - TL) * 1024 + i;
        const float4 xv = *(const float4*)xs;
        float4 o = {xv.x + gt.x * a[0], xv.y + gt.y * a[1], xv.z + gt.z * a[2], xv.w + gt.w * a[3]};
        *(float4*)((float*)outp + (size_t)j * 1024 + i) = o;
      }
    }
}

struct TileIter {
  int u, step, total, nf, tpx, x;
  DI void init(int n_tok_tiles, int n_feat_tiles) {
    const int bid = lbid(), nb = lgdim();
    nf = n_feat_tiles;
    if ((nb & 7) == 0 && (n_tok_tiles & 7) == 0) { x = bid & 7; u = bid >> 3; step = nb >> 3; tpx = n_tok_tiles >> 3; }
    else { x = 0; u = bid; step = nb; tpx = n_tok_tiles; }
    total = tpx * nf;
  }
  DI bool valid() const { return u < total; }
  DI void next() { u += step; }
  DI void get(int& tok_tile, int& feat_tile) const {
    const int g = u / (8 * nf), rem = u - g * 8 * nf;
    const int gs = (tpx - 8 * g) < 8 ? (tpx - 8 * g) : 8;
    const int f = rem / gs, tt = rem - f * gs;
    tok_tile = x * tpx + 8 * g + tt; feat_tile = f;
  }
};

DI void phase_gemm_in(const Params& p, int l, unsigned char* lds, bool gvar = false) {
  const bf16_t* W = (const bf16_t*)(p.ws + OFF_WIN) + (size_t)l * 3200 * 1024;
  const bf16_t* H = (const bf16_t*)(p.ws + OFF_H);
  bf16_t* PN = (bf16_t*)(p.ws + OFF_P);
  bf16_t* VT = (bf16_t*)(p.ws + OFF_VT);
  TileIter ti; ti.init(TT / 128, 25);
  for (; ti.valid(); ti.next()) {
    int jt, f; ti.get(jt, f);
    if (f >= 8 && f < 16) gemm_tile<2>(W, H, f, jt, PN, PN_LD, nullptr, nullptr, nullptr, lds, gvar);
    else if (f < 17) gemm_tile<0>(W, H, f, jt, PN, PN_LD, nullptr, nullptr, nullptr, lds, gvar);
    else gemm_tile<0>(H, W + (size_t)2176 * 1024, jt, f - 17, VT, TT, nullptr, nullptr, nullptr, lds, gvar);
  }
}
DI void phase_gemm_out(const Params& p, int l, int ntok, unsigned char* lds) {
  const bf16_t* W = (const bf16_t*)(p.ws + OFF_WOUT) + (size_t)l * 1024 * 1024;
  const bf16_t* Y = (const bf16_t*)(p.ws + OFF_Y);
  float* xres = (float*)(p.ws + OFF_XRES);
  const float* modl = (const float*)(p.ws + OFF_MOD) + (size_t)l * 17 * 6144;
  const float* xl = (l == 0) ? p.x : xres;
  const float* xc = (l == 0) ? p.ctx : xres + (size_t)TL * 1024;
  TileIter ti; ti.init(ntok / 128, 8);
  for (; ti.valid(); ti.next()) {
    int jt, f; ti.get(jt, f);
    gemm_tile<1>(W, Y, f, jt, xres, 1024, xl, xc, modl, lds);
  }
}
DI void phase_gemm_q(const Params& p, int l, int ntok, unsigned char* lds) {
  const bf16_t* W = (const bf16_t*)(p.ws + OFF_WQ) + (size_t)l * 1024 * 1024;
  const bf16_t* H = (const bf16_t*)(p.ws + OFF_H);
  bf16_t* QP = (bf16_t*)(p.ws + OFF_QP);
  TileIter ti; ti.init(ntok / 128, 8);
  for (; ti.valid(); ti.next()) {
    int jt, f; ti.get(jt, f);
    gemm_tile<0>(W, H, f, jt, QP, 1024, nullptr, nullptr, nullptr, lds);
  }
}

DI void phase_rope(const Params& p, unsigned char* lds) {
  float2* tab = (float2*)lds;
  for (int e = ltid(); e < 1024; e += 256) {
    const int pos = e >> 4, i = e & 15;
    const float inv = exp2f(-(float)i * (13.287712379549449f / 16.f));
    const float ang = (float)pos * inv;
    tab[e] = make_float2(__cosf(ang), __sinf(ang));
  }
  __syncthreads();
  bf16_t* PN = (bf16_t*)(p.ws + OFF_P);
  const int total = TL * 16;
  for (int idx = lbid() * 256 + ltid(); idx < total; idx += lgdim() * 256) {
    const int t = idx >> 4, vec = idx & 15;
    const int col = ((vec >> 3) ? C_DK : C_DQ) + ((vec >> 1) & 3) * 128 + (vec & 1) * 64;
    bf16_t* ptr = PN + (size_t)t * PN_LD + col;
    float xv[64];
#pragma unroll
    for (int q = 0; q < 8; ++q) { const u32x4 v = *(const u32x4*)(ptr + q * 8); unpack8(v, xv + q * 8); }
    const int row = (t & 2047) >> 6, cp = t & 63;
#pragma unroll
    for (int i = 0; i < 16; ++i) {
      const float2 cs = tab[row * 16 + i];
      const float x1 = xv[i], x2 = xv[16 + i];
      xv[i] = x1 * cs.x - x2 * cs.y; xv[16 + i] = x2 * cs.x + x1 * cs.y;
      const float2 cs2 = tab[cp * 16 + i];
      const float y1 = xv[32 + i], y2 = xv[48 + i];
      xv[32 + i] = y1 * cs2.x - y2 * cs2.y; xv[48 + i] = y2 * cs2.x + y1 * cs2.y;
    }
#pragma unroll
    for (int q = 0; q < 8; ++q) {
      u32x4 o = {pk2(xv[q * 8], xv[q * 8 + 1]), pk2(xv[q * 8 + 2], xv[q * 8 + 3]), pk2(xv[q * 8 + 4], xv[q * 8 + 5]), pk2(xv[q * 8 + 6], xv[q * 8 + 7])};
      *(u32x4*)(ptr + q * 8) = o;
    }
  }
}

struct SrcSeg {
  const bf16_t* PN; const bf16_t* VT; int kcol, vrow, t0, n0, t1, n1, lr, g;
  const bf16_t* k0p; const bf16_t* k1p; const bf16_t* vp;
  DI int nsteps() const { return n0 + n1; }
  DI void setup(int st) {
    const int tok0 = st < n0 ? t0 + st * 32 : t1 + (st - n0) * 32;
    const int kap = 8 * (lr >> 2) + (lr & 3);
    k0p = PN + (size_t)(tok0 + kap) * PN_LD + kcol + 8 * g;
    k1p = k0p + (size_t)4 * PN_LD;
    vp = VT + (size_t)(vrow + lr) * TT + tok0 + 8 * g;
  }
  DI bf16x8 kfrag(int m, int kt, int ks) const { return *(const bf16x8*)((kt ? k1p : k0p) + m * 64 + ks * 32); }
  DI bf16x8 vfrag(int dt) const { return *(const bf16x8*)(vp + (size_t)dt * 16 * TT); }
  DI float score(float raw, int kt, int r) const { return raw * SC_LOG2; }
};
struct SrcNat {
  const bf16_t* PN; const bf16_t* VT; int kcol, vrow, b, rq, rs, cs, qc, cstart, lr, g, st_;
  const float* rpbh;
  const bf16_t* k0p; const bf16_t* k1p; const bf16_t* vp;
  DI int nsteps() const { return 16; }
  DI void setup(int st) {
    st_ = st;
    const int tok0 = st < 8 ? b * 2048 + (rs + st) * 64 + cs : TL + b * 256 + (st - 8) * 32;
    const int kap = 8 * (lr >> 2) + (lr & 3);
    k0p = PN + (size_t)(tok0 + kap) * PN_LD + kcol + 8 * g;
    k1p = k0p + (size_t)4 * PN_LD;
    vp = VT + (size_t)(vrow + lr) * TT + tok0 + 8 * g;
  }
  DI bf16x8 kfrag(int m, int kt, int ks) const { return *(const bf16x8*)((kt ? k1p : k0p) + ks * 32); }
  DI bf16x8 vfrag(int dt) const { return *(const bf16x8*)(vp + (size_t)dt * 16 * TT); }
  DI float score(float raw, int kt, int r) const {
    if (st_ >= 8) return raw * SC_LOG2;
    const int kc = cs + 8 * g + 4 * kt + r;
    const bool valid = (kc >= cstart) && (kc < cstart + 16);
    int dc = kc - qc + 15; dc = dc < 0 ? 0 : (dc > 30 ? 30 : dc);
    const float bias = rpbh[(rs + st_ - rq + 7) * 31 + dc];
    return valid ? (raw * 0.125f + bias) * LOG2E : NEG_BIG;
  }
};

template <int MAPS, int DVT, class Src>
DI void flash_wave(Src& S, const bf16_t* qptr  , f32x4 (&o)[MAPS][DVT], float (&ltot)[MAPS]) {
  bf16x8 qf[MAPS][2];
#pragma unroll
  for (int m = 0; m < MAPS; ++m)
#pragma unroll
    for (int ks = 0; ks < 2; ++ks) qf[m][ks] = *(const bf16x8*)(qptr + m * 64 + ks * 32);
  float mrun[MAPS], lrun[MAPS];
#pragma unroll
  for (int m = 0; m < MAPS; ++m) {
    mrun[m] = NEG_BIG; lrun[m] = 0.f;
#pragma unroll
    for (int dt = 0; dt < DVT; ++dt) o[m][dt] = (f32x4){0.f, 0.f, 0.f, 0.f};
  }
  const int ns = S.nsteps();
  for (int st = 0; st < ns; ++st) {
    S.setup(st);
    bf16x8 pf[MAPS];
#pragma unroll
    for (int m = 0; m < MAPS; ++m) {
      f32x4 s[2];
#pragma unroll
      for (int kt = 0; kt < 2; ++kt) {
        s[kt] = (f32x4){0.f, 0.f, 0.f, 0.f};
#pragma unroll
        for (int ks = 0; ks < 2; ++ks) s[kt] = mfma16(S.kfrag(m, kt, ks), qf[m][ks], s[kt]);
      }
      float mt = NEG_BIG;
#pragma unroll
      for (int kt = 0; kt < 2; ++kt)
#pragma unroll
        for (int r = 0; r < 4; ++r) { s[kt][r] = S.score(s[kt][r], kt, r); mt = fmaxf(mt, s[kt][r]); }
      mt = rows_max(mt);
      const bool need = mt > mrun[m] + 8.f;
      if (__any(need)) {
        const float mnew = need ? mt : mrun[m];
        const float alpha = __builtin_amdgcn_exp2f(mrun[m] - mnew);
        lrun[m] *= alpha;
#pragma unroll
        for (int dt = 0; dt < DVT; ++dt) { o[m][dt][0] *= alpha; o[m][dt][1] *= alpha; o[m][dt][2] *= alpha; o[m][dt][3] *= alpha; }
        mrun[m] = mnew;
      }
      float pv[8];
      float ls = 0.f;
#pragma unroll
      for (int kt = 0; kt < 2; ++kt)
#pragma unroll
        for (int r = 0; r < 4; ++r) { pv[kt * 4 + r] = __builtin_amdgcn_exp2f(s[kt][r] - mrun[m]); ls += pv[kt * 4 + r]; }
      lrun[m] += ls;
      u32x4 pk = {pk2(pv[0], pv[1]), pk2(pv[2], pv[3]), pk2(pv[4], pv[5]), pk2(pv[6], pv[7])};
      pf[m] = __builtin_bit_cast(bf16x8, pk);
    }
#pragma unroll
    for (int dt = 0; dt < DVT; ++dt) {
      const bf16x8 vf = S.vfrag(dt);
#pragma unroll
      for (int m = 0; m < MAPS; ++m) o[m][dt] = mfma16(vf, pf[m], o[m][dt]);
    }
  }
#pragma unroll
  for (int m = 0; m < MAPS; ++m) {
    ltot[m] = rows_sum(lrun[m]);
  }
}

DI void diff_wave_task(const Params& p, int l, int b, int hd, int qtok0, bool ctx_only) {
  const int lane = ltid() & 63, lr = lane & 15, g = lane >> 4;
  const bf16_t* PN = (const bf16_t*)(p.ws + OFF_P);
  const bf16_t* VT = (const bf16_t*)(p.ws + OFF_VT);
  bf16_t* Y = (bf16_t*)(p.ws + OFF_Y);
  const float* lv = p.dlam + l * 256;
  float sa = lv[lane] * lv[64 + lane], sb = lv[128 + lane] * lv[192 + lane];
  sa = wave_sum(sa); sb = wave_sum(sb);
  const float lam_init = 0.8f - 0.6f * expf(-0.3f * (float)l);
  const float lam = expf(sa) - expf(sb) + lam_init;
  SrcSeg S;
  S.PN = PN; S.VT = VT; S.kcol = C_DK + hd * 128; S.vrow = R_DV + hd * 128; S.lr = lr; S.g = g;
  S.t0 = TL + b * 256; S.n0 = 8; S.t1 = b * 2048; S.n1 = ctx_only ? 0 : 64;
  f32x4 o[2][8];
  float lt[2];
  const int qtok = qtok0 + lr;
  flash_wave<2, 8, SrcSeg>(S, PN + (size_t)qtok * PN_LD + C_DQ + hd * 128 + 8 * g, o, lt);
  const float i0 = 1.f / lt[0], i1 = lam / lt[1];
  float ss = 0.f;
#pragma unroll
  for (int dt = 0; dt < 8; ++dt)
#pragma unroll
    for (int r = 0; r < 4; ++r) { const float v = o[0][dt][r] * i0 - o[1][dt][r] * i1; o[0][dt][r] = v; ss += v * v; }
  ss += __shfl_xor(ss, 16);
  ss += __shfl_xor(ss, 32);
  const float rstd = rsqrtf(ss * (1.f / 128.f) + 1e-6f) * (1.f - lam_init);
  const float* dg = p.diff_g + l * 512 + hd * 128;
#pragma unroll
  for (int dt = 0; dt < 8; ++dt) {
    const float4 gg = *(const float4*)(dg + dt * 16 + 4 * g);
    u32x2 ov = {pk2(o[0][dt][0] * rstd * gg.x, o[0][dt][1] * rstd * gg.y), pk2(o[0][dt][2] * rstd * gg.z, o[0][dt][3] * rstd * gg.w)};
    *(u32x2*)(Y + (size_t)qtok * 1024 + 512 + hd * 128 + dt * 16 + 4 * g) = ov;
  }
}


DI void diff_block_task(const Params& p, int l, int b, int hd, int qtok0, int nsteps, unsigned char* lds) {
  const int tid = ltid(), lane = tid & 63, w = tid >> 6, lr = lane & 15, g = lane >> 4;
  unsigned char* Kb = lds;
  unsigned char* Vb = lds + 16384;
  unsigned char* Qb = lds + 32768;
  const bf16_t* PN = (const bf16_t*)(p.ws + OFF_P);
  const bf16_t* VT = (const bf16_t*)(p.ws + OFF_VT);
  bf16_t* Y = (bf16_t*)(p.ws + OFF_Y);

  __syncthreads();
  {
    const int row = tid >> 1, hf = tid & 1;
    const bf16_t* src = PN + (size_t)(qtok0 + row) * PN_LD + C_DQ + hd * 128 + hf * 64;
#pragma unroll
    for (int c = 0; c < 8; ++c) {
      const u32x4 v = *(const u32x4*)(src + c * 8);
      const int ch = hf * 8 + c;
      *(u32x4*)(Qb + row * 256 + ((ch ^ (row & 15)) << 4)) = v;
    }
  }
  const int wu = __builtin_amdgcn_readfirstlane(w);
  unsigned kofs[2], vofs[2];
#pragma unroll
  for (int jj = 0; jj < 2; ++jj) {
    const int krow = 4 * (2 * w + jj) + (lane >> 4), kpc = lane & 15;
    const int kch = kpc ^ (((krow >> 3) & 3) * 4 + (krow & 3));
    kofs[jj] = (unsigned)(krow * PN_LD + C_DK + hd * 128 + kch * 8);
    const int vrow = 16 * (2 * w + jj) + (lane >> 2), vpc = lane & 3;
    const int vch = vpc ^ ((vrow >> 2) & 3);
    vofs[jj] = (unsigned)((R_DV + hd * 128 + vrow) * TT + vch * 8);
  }
#define DB_DMA(st, bf) do { const int tk = (st) < 8 ? TL + b * 256 + (st) * 32 : b * 2048 + ((st) - 8) * 32; \
    const bf16_t* kb_ = PN + (size_t)tk * PN_LD; const bf16_t* vb_ = VT + tk; \
    _Pragma("unroll") for (int jj = 0; jj < 2; ++jj) { \
      __builtin_amdgcn_global_load_lds((const unsigned*)(kb_ + kofs[jj]), (unsigned*)(Kb + (bf) * 8192 + (2 * wu + jj) * 1024), 16, 0, 0); \
      __builtin_amdgcn_global_load_lds((const unsigned*)(vb_ + vofs[jj]), (unsigned*)(Vb + (bf) * 8192 + (2 * wu + jj) * 1024), 16, 0, 0); } } while (0)
  DB_DMA(0, 0);
  asm volatile("s_waitcnt vmcnt(0)" ::: "memory");
  __syncthreads();

  f32x4 o[2][2][8];
  float mrun[2][2], lrun[2][2];
#pragma unroll
  for (int m = 0; m < 2; ++m)
#pragma unroll
    for (int qt = 0; qt < 2; ++qt) {
      mrun[m][qt] = NEG_BIG; lrun[m][qt] = 0.f;
#pragma unroll
      for (int dt = 0; dt < 8; ++dt) o[m][qt][dt] = (f32x4){0.f, 0.f, 0.f, 0.f};
    }
  const int kfr = 8 * (lr >> 2) + (lr & 3);
  for (int st = 0; st < nsteps; ++st) {
    if (st + 1 < nsteps) DB_DMA(st + 1, (st + 1) & 1);
    const unsigned char* Kt = Kb + (st & 1) * 8192;
    const unsigned char* Vt = Vb + (st & 1) * 8192;
    bf16x8 pf[2][2];
#pragma unroll
    for (int m = 0; m < 2; ++m) {
      bf16x8 kf[2][2], qf[2][2];
#pragma unroll
      for (int kt = 0; kt < 2; ++kt)
#pragma unroll
        for (int ks = 0; ks < 2; ++ks) kf[kt][ks] = *(const bf16x8*)(Kt + (kfr + 4 * kt) * 256 + (((m * 8 + ks * 4 + g) ^ lr) << 4));
#pragma unroll
      for (int qt = 0; qt < 2; ++qt)
#pragma unroll
        for (int ks = 0; ks < 2; ++ks) qf[qt][ks] = *(const bf16x8*)(Qb + (32 * w + 16 * qt + lr) * 256 + (((m * 8 + ks * 4 + g) ^ lr) << 4));
      __builtin_amdgcn_sched_barrier(0);
      f32x4 s[2][2];
#pragma unroll
      for (int qt = 0; qt < 2; ++qt)
#pragma unroll
        for (int kt = 0; kt < 2; ++kt) {
          s[qt][kt] = (f32x4){0.f, 0.f, 0.f, 0.f};
#pragma unroll
          for (int ks = 0; ks < 2; ++ks) s[qt][kt] = mfma16(kf[kt][ks], qf[qt][ks], s[qt][kt]);
        }
      __builtin_amdgcn_sched_barrier(0);
#pragma unroll
      for (int qt = 0; qt < 2; ++qt) {
        float mt = NEG_BIG;
#pragma unroll
        for (int kt = 0; kt < 2; ++kt)
#pragma unroll
          for (int r = 0; r < 4; ++r) { s[qt][kt][r] *= SC_LOG2; mt = fmaxf(mt, s[qt][kt][r]); }
        mt = rows_max(mt);
        const bool need = mt > mrun[m][qt] + 8.f;
        if (__any(need)) {
          const float mnew = need ? mt : mrun[m][qt];
          const float alpha = __builtin_amdgcn_exp2f(mrun[m][qt] - mnew);
          lrun[m][qt] *= alpha;
#pragma unroll
          for (int dt = 0; dt < 8; ++dt) { o[m][qt][dt][0] *= alpha; o[m][qt][dt][1] *= alpha; o[m][qt][dt][2] *= alpha; o[m][qt][dt][3] *= alpha; }
          mrun[m][qt] = mnew;
        }
        float pv[8], ls = 0.f;
#pragma unroll
        for (int kt = 0; kt < 2; ++kt)
#pragma unroll
          for (int r = 0; r < 4; ++r) { pv[kt * 4 + r] = __builtin_amdgcn_exp2f(s[qt][kt][r] - mrun[m][qt]); ls += pv[kt * 4 + r]; }
        lrun[m][qt] += ls;
        u32x4 pk = {pk2(pv[0], pv[1]), pk2(pv[2], pv[3]), pk2(pv[4], pv[5]), pk2(pv[6], pv[7])};
        pf[m][qt] = __builtin_bit_cast(bf16x8, pk);
      }
      __builtin_amdgcn_sched_barrier(0);
    }
#pragma unroll
    for (int hb = 0; hb < 2; ++hb) {
      bf16x8 vf[4];
#pragma unroll
      for (int d4 = 0; d4 < 4; ++d4) {
        const int vr = 16 * (4 * hb + d4) + lr;
        vf[d4] = *(const bf16x8*)(Vt + vr * 64 + ((g ^ ((vr >> 2) & 3)) << 4));
      }
      __builtin_amdgcn_sched_barrier(0);
#pragma unroll
      for (int d4 = 0; d4 < 4; ++d4)
#pragma unroll
        for (int m = 0; m < 2; ++m)
#pragma unroll
          for (int qt = 0; qt < 2; ++qt) o[m][qt][4 * hb + d4] = mfma16(vf[d4], pf[m][qt], o[m][qt][4 * hb + d4]);
      __builtin_amdgcn_sched_barrier(0);
    }
    asm volatile("s_waitcnt vmcnt(0)" ::: "memory");
    __syncthreads();
  }
#undef DB_DMA
  const float* lv = p.dlam + l * 256;
  float sa = lv[lane] * lv[64 + lane], sb = lv[128 + lane] * lv[192 + lane];
  sa = wave_sum(sa); sb = wave_sum(sb);
  const float lam_init = 0.8f - 0.6f * expf(-0.3f * (float)l);
  const float lam = expf(sa) - expf(sb) + lam_init;
  const float* dg = p.diff_g + l * 512 + hd * 128;
#pragma unroll
  for (int qt = 0; qt < 2; ++qt) {
    float l0 = lrun[0][qt], l1 = lrun[1][qt];
    l0 = rows_sum(l0);
    l1 = rows_sum(l1);
    const float i0 = 1.f / l0, i1 = lam / l1;
    float ss = 0.f;
#pragma unroll
    for (int dt = 0; dt < 8; ++dt)
#pragma unroll
      for (int r = 0; r < 4; ++r) { const float v = o[0][qt][dt][r] * i0 - o[1][qt][dt][r] * i1; o[0][qt][dt][r] = v; ss += v * v; }
    ss = rows_sum(ss);
    const float rstd = rsqrtf(ss * (1.f / 128.f) + 1e-6f) * (1.f - lam_init);
    const int qtok = qtok0 + 32 * w + 16 * qt + lr;
#pragma unroll
    for (int dt = 0; dt < 8; ++dt) {
      const float4 gg = *(const float4*)(dg + dt * 16 + 4 * g);
      u32x2 ov = {pk2(o[0][qt][dt][0] * rstd * gg.x, o[0][qt][dt][1] * rstd * gg.y), pk2(o[0][qt][dt][2] * rstd * gg.z, o[0][qt][dt][3] * rstd * gg.w)};
      *(u32x2*)(Y + (size_t)qtok * 1024 + 512 + hd * 128 + dt * 16 + 4 * g) = ov;
    }
  }
}

DI void nat_wave_task(const Params& p, int l, int b, int head, int rq, int ct, const float* rpb_lds) {
  const int lane = ltid() & 63, lr = lane & 15, g = lane >> 4;
  const bf16_t* PN = (const bf16_t*)(p.ws + OFF_P);
  const bf16_t* VT = (const bf16_t*)(p.ws + OFF_VT);
  bf16_t* Y = (bf16_t*)(p.ws + OFF_Y);
  SrcNat S;
  S.PN = PN; S.VT = VT; S.kcol = C_NK + head * 64; S.vrow = R_NV + head * 64; S.b = b; S.rq = rq; S.lr = lr; S.g = g;
  int rs = rq - 4; rs = rs < 0 ? 0 : (rs > 24 ? 24 : rs);
  S.rs = rs;
  int cs = 16 * ct - 8; cs = cs < 0 ? 0 : (cs > 32 ? 32 : cs);
  S.cs = cs;
  S.qc = 16 * ct + lr;
  int cst = S.qc - 8; cst = cst < 0 ? 0 : (cst > 48 ? 48 : cst);
  S.cstart = cst;
  S.rpbh = rpb_lds + head * 465;
  f32x4 o[1][4];
  float lt[1];
  const int qtok = b * 2048 + rq * 64 + 16 * ct + lr;
  flash_wave<1, 4, SrcNat>(S, PN + (size_t)qtok * PN_LD + C_NQ + head * 64 + 8 * g, o, lt);
  const float inv = 1.f / lt[0];
#pragma unroll
  for (int dt = 0; dt < 4; ++dt) {
    u32x2 ov = {pk2(o[0][dt][0] * inv, o[0][dt][1] * inv), pk2(o[0][dt][2] * inv, o[0][dt][3] * inv)};
    *(u32x2*)(Y + (size_t)qtok * 1024 + 256 + head * 64 + dt * 16 + 4 * g) = ov;
  }
}
DI void natctx_wave_task(const Params& p, int b, int head, int qt) {
  const int lane = ltid() & 63, lr = lane & 15, g = lane >> 4;
  const bf16_t* PN = (const bf16_t*)(p.ws + OFF_P);
  const bf16_t* VT = (const bf16_t*)(p.ws + OFF_VT);
  bf16_t* Y = (bf16_t*)(p.ws + OFF_Y);
  SrcSeg S;
  S.PN = PN; S.VT = VT; S.kcol = C_NK + head * 64; S.vrow = R_NV + head * 64; S.lr = lr; S.g = g;
  S.t0 = TL + b * 256; S.n0 = 8; S.t1 = 0; S.n1 = 0;
  f32x4 o[1][4];
  float lt[1];
  const int qtok = TL + b * 256 + qt * 16 + lr;
  flash_wave<1, 4, SrcSeg>(S, PN + (size_t)qtok * PN_LD + C_NQ + head * 64 + 8 * g, o, lt);
  const float inv = 1.f / lt[0];
#pragma unroll
  for (int dt = 0; dt < 4; ++dt) {
    u32x2 ov = {pk2(o[0][dt][0] * inv, o[0][dt][1] * inv), pk2(o[0][dt][2] * inv, o[0][dt][3] * inv)};
    *(u32x2*)(Y + (size_t)qtok * 1024 + 256 + head * 64 + dt * 16 + 4 * g) = ov;
  }
}

DI float quad_sum(float v) {
  v += __int_as_float(__builtin_amdgcn_mov_dpp(__float_as_int(v), 0xB1, 0xF, 0xF, true));
  v += __int_as_float(__builtin_amdgcn_mov_dpp(__float_as_int(v), 0x4E, 0xF, 0xF, true));
  return v;
}
DI void gla_task(const Params& p, int l, int task, unsigned char* lds, int var = 0) {
  const int tid = ltid(), lane = tid & 63, w = tid >> 6, vv = lane >> 2, g = lane & 3;
  const int b = task >> 3, h = (task >> 1) & 3, dir = task & 1;
  const bf16_t* PN = (const bf16_t*)(p.ws + OFF_P);
  const bf16_t* VT = (const bf16_t*)(p.ws + OFF_VT);
  float* og = (float*)(p.ws + OFF_H);
  float* Gup = (float*)lds;
  float* Gb = Gup + 512;
  float* As = Gb + 32;
  float* Ks = As + 2048;
  float* Qs = Ks + 2048;
  float* Vs = Qs + 2048;
  __syncthreads();
  for (int e = tid; e < 512; e += 256) { const int r = e >> 5, kd = e & 31; Gup[e] = p.gate_up[((size_t)(l * 2 + dir) * 16 + r) * 128 + h * 32 + kd]; }
  if (tid < 32) Gb[tid] = p.gate_b[(l * 2 + dir) * 128 + h * 32 + tid];
  float S[8];
#pragma unroll
  for (int e = 0; e < 8; ++e) S[e] = 0.f;
  const int si = tid >> 2, part = tid & 3;
  u32x4 rq, rk, rg0, rg1, rv0, rv1;
#define GLA_TOK0(cc) ((cc) < 4 ? TL + b * 256 + (dir == 0 ? (cc) : 3 - (cc)) * 64 : b * 2048 + (dir == 0 ? (cc) - 4 : 35 - (cc)) * 64)
#define GLA_LOAD(cc) do { const int t0_ = GLA_TOK0(cc); const bf16_t* row = PN + (size_t)(t0_ + si) * PN_LD; \
    rq = *(const u32x4*)(row + C_GQ + h * 32 + part * 8); rk = *(const u32x4*)(row + C_GK + h * 32 + part * 8); \
    rg0 = *(const u32x4*)(row + C_GATE + dir * 16); rg1 = *(const u32x4*)(row + C_GATE + dir * 16 + 8); \
    const bf16_t* vp = VT + (size_t)(R_GV + h * 64 + si) * TT + t0_ + part * 16; rv0 = *(const u32x4*)vp; rv1 = *(const u32x4*)(vp + 8); } while (0)
#define GLA_WRITE() do { float gd[16], qf[8], kf[8], vf[16]; \
    unpack8(rg0, gd); unpack8(rg1, gd + 8); unpack8(rq, qf); unpack8(rk, kf); unpack8(rv0, vf); unpack8(rv1, vf + 8); \
    _Pragma("unroll") for (int e = 0; e < 8; ++e) { const int kd = part * 8 + e; float pre = Gb[kd]; \
      _Pragma("unroll") for (int r = 0; r < 16; ++r) pre += gd[r] * Gup[r * 32 + kd]; \
      const float ls = fminf(pre, 0.f) - log1pf(__expf(-fabsf(pre))); \
      As[si * 32 + kd] = __expf(ls * (1.f / 16.f)); Ks[si * 32 + kd] = kf[e]; Qs[si * 32 + kd] = qf[e] * 0.17677669529663687f; } \
    _Pragma("unroll") for (int e = 0; e < 16; ++e) Vs[(part * 16 + e) * 65 + si] = vf[e]; } while (0)
  GLA_LOAD(0);
  __syncthreads();
  GLA_WRITE();
  __syncthreads();
  for (int cc = 0; cc < 36; ++cc) {
    const int tok0 = GLA_TOK0(cc);
    if (cc + 1 < 36) GLA_LOAD(cc + 1);
    float* ob = og + ((size_t)dir * TT + tok0) * 256 + h * 64 + 16 * w + vv;
#pragma unroll 1
    for (int s0 = 0; s0 < (var == 3 ? 4 : 64); s0 += 4) {
      float4 a0[4], a1[4], k0[4], k1[4], q0[4], q1[4];
      float vx[4];
#pragma unroll
      for (int u = 0; u < 4; ++u) {
        const int i = dir == 0 ? s0 + u : 63 - s0 - u;
        a0[u] = *(const float4*)(As + i * 32 + 8 * g); a1[u] = *(const float4*)(As + i * 32 + 8 * g + 4);
        k0[u] = *(const float4*)(Ks + i * 32 + 8 * g); k1[u] = *(const float4*)(Ks + i * 32 + 8 * g + 4);
        q0[u] = *(const float4*)(Qs + i * 32 + 8 * g); q1[u] = *(const float4*)(Qs + i * 32 + 8 * g + 4);
        vx[u] = Vs[i * 65 + 16 * w + vv];
      }
#pragma unroll
      for (int u = 0; u < 4; ++u) {
        const int i = dir == 0 ? s0 + u : 63 - s0 - u;
        const float v = vx[u];
        S[0] = fmaf(a0[u].x, S[0], k0[u].x * v); S[1] = fmaf(a0[u].y, S[1], k0[u].y * v);
        S[2] = fmaf(a0[u].z, S[2], k0[u].z * v); S[3] = fmaf(a0[u].w, S[3], k0[u].w * v);
        S[4] = fmaf(a1[u].x, S[4], k1[u].x * v); S[5] = fmaf(a1[u].y, S[5], k1[u].y * v);
        S[6] = fmaf(a1[u].z, S[6], k1[u].z * v); S[7] = fmaf(a1[u].w, S[7], k1[u].w * v);
        const float oa = fmaf(q0[u].x, S[0], q0[u].y * S[1]), ob2 = fmaf(q0[u].z, S[2], q0[u].w * S[3]);
        const float oc = fmaf(q1[u].x, S[4], q1[u].y * S[5]), od = fmaf(q1[u].z, S[6], q1[u].w * S[7]);
        float o = (oa + ob2) + (oc + od);
        o = quad_sum(o);
        if (var == 1) asm volatile("" :: "v"(o)); else if (g == 0) ob[(size_t)i * 256] = o;
      }
    }
    __syncthreads();
    if (cc + 1 < 36 && var != 2) GLA_WRITE();
    __syncthreads();
  }
#undef GLA_TOK0
#undef GLA_LOAD
#undef GLA_WRITE
}

DI void phase_mixers(const Params& p, int l, bool last, unsigned* ctr, unsigned char* lds, int mask = 7, int gvar = 0) {
  const int tid = ltid(), w = tid >> 6;
  volatile int* slot = (volatile int*)(lds + LDS_BYTES - 16);
  float* rpb_lds = (float*)(lds + 65536);
  for (int e = tid; e < 4 * 465; e += 256) rpb_lds[e] = p.rpb[(size_t)l * 4 * 465 + e];
  const int ntask = 128 + 1024 + 2048 + (last ? 0 : 128 + 256);
  for (;;) {
    __syncthreads();
    if (tid == 0) *slot = (int)atomicAdd(ctr, 1u);
    __syncthreads();
    const int task = *slot;
    if (task >= ntask) break;
    if (task < 128) { if (mask & 1) { __builtin_amdgcn_s_setprio(3); gla_task(p, l, task, lds, gvar); __builtin_amdgcn_s_setprio(0); } }
    else if (!(mask & 2) && (task < 128 + 1024 || (task >= 128 + 1024 + 2048 && task < 128 + 1024 + 2048 + 128))) {}
    else if (!(mask & 4) && ((task >= 128 + 1024 && task < 128 + 1024 + 2048) || task >= 128 + 1024 + 2048 + 128)) {}
    else if (task < 128 + 1024) { const int d = task - 128; const int b = d >> 6; diff_block_task(p, l, b, (d >> 4) & 3, b * 2048 + (d & 15) * 128, 72, lds); }
    else if (task < 128 + 1024 + 2048) { const int wt = (task - 128 - 1024) * 4 + w; nat_wave_task(p, l, wt >> 9, (wt >> 7) & 3, (wt >> 2) & 31, wt & 3, rpb_lds); }
    else if (task < 128 + 1024 + 2048 + 128) { const int d = task - 128 - 1024 - 2048; const int b = d >> 3; diff_block_task(p, l, b, (d >> 1) & 3, TL + b * 256 + (d & 1) * 128, 8, lds); }
    else { const int wt = (task - 128 - 1024 - 2048 - 128) * 4 + w; natctx_wave_task(p, wt >> 6, (wt >> 4) & 3, wt & 15); }
  }
}

DI void phase_gla_fin(const Params& p, int l, int ntok) {
  const int lane = ltid() & 63, gw = lbid() * 4 + (ltid() >> 6), nw = lgdim() * 4;
  const float* og = (const float*)(p.ws + OFF_H);
  const bf16_t* PN = (const bf16_t*)(p.ws + OFF_P);
  bf16_t* Y = (bf16_t*)(p.ws + OFF_Y);
  const float4 gg = *(const float4*)(p.gla_norm_g + l * 256 + 4 * lane);
  for (int t = gw; t < ntok; t += nw) {
    const float4 a = *(const float4*)(og + (size_t)t * 256 + 4 * lane), bq = *(const float4*)(og + ((size_t)TT + t) * 256 + 4 * lane);
    const float o0 = a.x + bq.x, o1 = a.y + bq.y, o2 = a.z + bq.z, o3 = a.w + bq.w;
    float ss = o0 * o0 + o1 * o1 + o2 * o2 + o3 * o3;
    ss += __shfl_xor(ss, 1); ss += __shfl_xor(ss, 2); ss += __shfl_xor(ss, 4); ss += __shfl_xor(ss, 8);
    const float rstd = rsqrtf(ss * (1.f / 64.f) + 1e-6f);
    const u32x2 rv = *(const u32x2*)(PN + (size_t)t * PN_LD + C_GR + 4 * lane);
    const float r0 = bflo(rv.x), r1 = bfhi(rv.x), r2 = bflo(rv.y), r3 = bfhi(rv.y);
    const float y0 = o0 * rstd * gg.x * (r0 / (1.f + __expf(-r0)));
    const float y1 = o1 * rstd * gg.y * (r1 / (1.f + __expf(-r1)));
    const float y2 = o2 * rstd * gg.z * (r2 / (1.f + __expf(-r2)));
    const float y3 = o3 * rstd * gg.w * (r3 / (1.f + __expf(-r3)));
    u32x2 ov = {pk2(y0, y1), pk2(y2, y3)};
    *(u32x2*)(Y + (size_t)t * 1024 + 4 * lane) = ov;
  }
}

struct PairTab { int a[52], b[52]; };
constexpr PairTab make_pairs() {
  PairTab t{};
  int n = 0;
  for (int a = 0; a < 16; ++a)
    for (int b = 0; b < 16; ++b)
      if ((a + 1) * (b + 1) <= 16) { t.a[n] = a; t.b[n] = b; ++n; }
  for (; n < 52; ++n) { t.a[n] = -1; t.b[n] = -1; }
  return t;
}

DI void topk_half(const bf16_t* skh  , const bf16_t* qrow  , int lr, int g, float (&list)[16]) {
  bf16x8 qf[2];
  qf[0] = *(const bf16x8*)(qrow); qf[1] = *(const bf16x8*)(qrow + 32);
  float s[32];
#pragma unroll
  for (int nt = 0; nt < 8; ++nt) {
    f32x4 acc = {0.f, 0.f, 0.f, 0.f};
#pragma unroll
    for (int ks = 0; ks < 2; ++ks) {
      const bf16x8 af = *(const bf16x8*)(skh + (size_t)(nt * 16 + lr) * 64 + ks * 32 + 8 * g);
      acc = mfma16(af, qf[ks], acc);
    }
#pragma unroll
    for (int r = 0; r < 4; ++r) {
      const unsigned n = nt * 16 + 4 * g + r;
      s[nt * 4 + r] = __uint_as_float((__float_as_uint(acc[r]) & ~127u) | n);
    }
  }
#pragma unroll
  for (int k = 0; k < 16; ++k) {
    float m = s[0];
#pragma unroll
    for (int i = 1; i < 32; ++i) m = fmaxf(m, s[i]);
    m = fmaxf(m, __shfl_xor(m, 16));
    m = fmaxf(m, __shfl_xor(m, 32));
    list[k] = m;
#pragma unroll
    for (int i = 0; i < 32; ++i) s[i] = (s[i] == m) ? -3.0e38f : s[i];
  }
}

DI void phase_topk(const Params& p, int l, int ntok) {
  constexpr PairTab PT = make_pairs();
  const int lane = ltid() & 63, lr = lane & 15, g = lane >> 4;
  const int gw = lbid() * 4 + (ltid() >> 6), nw = lgdim() * 4;
  const bf16_t* QP = (const bf16_t*)(p.ws + OFF_QP);
  const bf16_t* sk = (const bf16_t*)(p.ws + OFF_SK) + (size_t)l * 2 * 128 * 64;
  int* eid = (int*)(p.ws + OFF_EID);
  float* gate = (float*)(p.ws + OFF_GATE);
  const int ntask = (ntok / 16) * 8;
  for (int task = gw; task < ntask; task += nw) {
    const int tt = task >> 3, hd = task & 7;
    const int tok = tt * 16 + lr;
    float v1[16], v2[16];
    topk_half(sk, QP + (size_t)tok * 1024 + hd * 128 + 8 * g, lr, g, v1);
    topk_half(sk + 128 * 64, QP + (size_t)tok * 1024 + hd * 128 + 64 + 8 * g, lr, g, v2);
    float cand[13];
    int ceid[13];
#pragma unroll
    for (int c = 0; c < 13; ++c) {
      float sv[4];
      int ev[4];
#pragma unroll
      for (int gi = 0; gi < 4; ++gi) {
        const int pi = 4 * c + gi;
        if (PT.a[pi] >= 0) {
          const float a = v1[PT.a[pi] < 0 ? 0 : PT.a[pi]], bq = v2[PT.b[pi] < 0 ? 0 : PT.b[pi]];
          sv[gi] = __uint_as_float((__float_as_uint(a + bq) & ~63u) | (unsigned)pi);
          ev[gi] = (int)((__float_as_uint(a) & 127u) * 128u + (__float_as_uint(bq) & 127u));
        } else { sv[gi] = -3.0e38f; ev[gi] = 0; }
      }
      cand[c] = g == 0 ? sv[0] : (g == 1 ? sv[1] : (g == 2 ? sv[2] : sv[3]));
      ceid[c] = g == 0 ? ev[0] : (g == 1 ? ev[1] : (g == 2 ? ev[2] : ev[3]));
    }
    float topv[16];
#pragma unroll
    for (int k = 0; k < 16; ++k) {
      float m = cand[0];
#pragma unroll
      for (int c = 1; c < 13; ++c) m = fmaxf(m, cand[c]);
      m = fmaxf(m, __shfl_xor(m, 16));
      m = fmaxf(m, __shfl_xor(m, 32));
      topv[k] = m;
      int my = -1;
#pragma unroll
      for (int c = 0; c < 13; ++c) { if (cand[c] == m) { my = ceid[c]; cand[c] = -3.0e38f; } }
      if (my >= 0) eid[(size_t)tok * 128 + hd * 16 + k] = my;
    }
    if (g == 0) {
      float ex[16], sum = 0.f;
#pragma unroll
      for (int k = 0; k < 16; ++k) { ex[k] = __expf(topv[k] - topv[0]); sum += ex[k]; }
      const float inv = 1.f / sum;
#pragma unroll
      for (int q = 0; q < 4; ++q) {
        float4 o = {ex[4 * q] * inv, ex[4 * q + 1] * inv, ex[4 * q + 2] * inv, ex[4 * q + 3] * inv};
        *(float4*)(gate + (size_t)tok * 128 + hd * 16 + 4 * q) = o;
      }
    }
  }
}

DI float gelu_tanh(float x) {
  const float z = 0.7978845608028654f * (x + 0.044715f * x * x * x);
  const float e = __expf(2.f * z);
  const float th = 1.f - 2.f / (e + 1.f);
  return 0.5f * x * (1.f + th);
}
DI void phase_gather(const Params& p, int l, int ntok, unsigned char* lds, bool dry = false) {
  const int tid = ltid(), lane = tid & 63, w = tid >> 6, lr = lane & 15, g = lane >> 4;
  const int gw = lbid() * 4 + w, nw = lgdim() * 4;
  const unsigned char* U6 = p.ws + OFF_U + (size_t)l * 16384 * V6_PITCH;
  const unsigned char* V6 = p.ws + OFF_V + (size_t)l * 16384 * V6_PITCH;
  const int half = lane >> 5, blk = lane & 31;
  const unsigned char* H6 = p.ws + OFF_H8;
  const int* eid = (const int*)(p.ws + OFF_EID);
  const float* gate = (const float*)(p.ws + OFF_GATE);
  float* xres = (float*)(p.ws + OFF_XRES);
  const float* modbuf = (const float*)(p.ws + OFF_MOD);
  unsigned char* hl = lds + w * 2048;
  float* wl = (float*)(lds + w * 2048 + 1024);
  for (int t = gw; t < ntok; t += nw) {
    if (lane < 50) {
      const u32x4 hq = *(const u32x4*)(H6 + (size_t)t * V6_PITCH + lane * 16);
      *(u32x4*)(hl + lane * 16) = hq;
    }
    const int e0 = eid[(size_t)t * 128 + lane], e1 = eid[(size_t)t * 128 + 64 + lane];
    const float gv0 = gate[(size_t)t * 128 + lane], gv1 = gate[(size_t)t * 128 + 64 + lane];
    {
      const u32x2 hsc = *(const u32x2*)(hl + 768 + 8 * g);
#pragma unroll 1
      for (int grp = 0; grp < 8; ++grp) {
        const int er = __shfl(grp < 4 ? e0 : e1, (grp & 3) * 16 + lr);
        const unsigned char* ur = U6 + (size_t)er * V6_PITCH;
        u32x4 ua[8]; u32x2 ub[8];
#pragma unroll
        for (int s = 0; s < 8; ++s) { ua[s] = *(const u32x4*)(ur + 24 * (4 * s + g)); ub[s] = *(const u32x2*)(ur + 24 * (4 * s + g) + 16); }
        const u32x2 usc = *(const u32x2*)(ur + 768 + 8 * g);
        __builtin_amdgcn_sched_barrier(0);
        f32x4 acc = {0.f, 0.f, 0.f, 0.f};
#define G_STEP(s, OS, USC, HSC) do { const unsigned char* hb = hl + 24 * (4 * (s) + g); \
          const u32x2 h0 = *(const u32x2*)hb, h1 = *(const u32x2*)(hb + 8), h2v = *(const u32x2*)(hb + 16); \
          const i32x8 av = {(int)ua[s][0], (int)ua[s][1], (int)ua[s][2], (int)ua[s][3], (int)ub[s][0], (int)ub[s][1], 0, 0}; \
          const i32x8 bv = {(int)h0[0], (int)h0[1], (int)h1[0], (int)h1[1], (int)h2v[0], (int)h2v[1], 0, 0}; \
          acc = __builtin_amdgcn_mfma_scale_f32_16x16x128_f8f6f4(av, bv, acc, 2, 2, OS, (int)(USC), OS, (int)(HSC)); } while (0)
        G_STEP(0, 0, usc[0], hsc[0]); G_STEP(1, 1, usc[0], hsc[0]); G_STEP(2, 2, usc[0], hsc[0]); G_STEP(3, 3, usc[0], hsc[0]);
        G_STEP(4, 0, usc[1], hsc[1]); G_STEP(5, 1, usc[1], hsc[1]); G_STEP(6, 2, usc[1], hsc[1]); G_STEP(7, 3, usc[1], hsc[1]);
#undef G_STEP
        const float gvs = grp < 4 ? gv0 : gv1;
        const int lb_ = (grp & 3) * 16 + 4 * g;
        float4 wv_;
        wv_.x = __shfl(gvs, lb_) * gelu_tanh(acc[0]); wv_.y = __shfl(gvs, lb_ + 1) * gelu_tanh(acc[1]);
        wv_.z = __shfl(gvs, lb_ + 2) * gelu_tanh(acc[2]); wv_.w = __shfl(gvs, lb_ + 3) * gelu_tanh(acc[3]);
        if (lr == 0) *(float4*)(wl + grp * 16 + 4 * g) = wv_;
        __builtin_amdgcn_sched_barrier(0);
      }
    }
    __builtin_amdgcn_sched_barrier(0);
    float out[32];
#pragma unroll
    for (int i = 0; i < 32; ++i) out[i] = 0.f;
#pragma unroll 1
    for (int grp = 0; grp < 8; ++grp) {
      const int esel = grp < 4 ? e0 : e1;
      const int lb = (grp & 3) * 16;
      u32x4 vd4[8]; u32x2 vd2[8]; unsigned vsc[8];
#pragma unroll
      for (int pp = 0; pp < 8; ++pp) {
        const int ea = __builtin_amdgcn_readlane(esel, lb + 2 * pp), eb = __builtin_amdgcn_readlane(esel, lb + 2 * pp + 1);
        const unsigned char* vr = V6 + (size_t)(half ? eb : ea) * V6_PITCH;
        vd4[pp] = *(const u32x4*)(vr + 24 * blk); vd2[pp] = *(const u32x2*)(vr + 24 * blk + 16); vsc[pp] = vr[mx_scale_pos(blk)];
      }
      __builtin_amdgcn_sched_barrier(0);
#pragma unroll
      for (int pp = 0; pp < 8; ++pp) {
        const float wgt = wl[grp * 16 + 2 * pp + half] * __uint_as_float(vsc[pp] << 23);
        unsigned pk0 = vd4[pp][0], pk1 = vd4[pp][1];
        asm volatile("" : "+v"(pk0) : "v"(out[0]), "v"(out[1]), "v"(out[2]), "v"(out[3]), "v"(out[4]), "v"(out[5]), "v"(out[6]), "v"(out[7]),
                     "v"(out[8]), "v"(out[9]), "v"(out[10]), "v"(out[11]), "v"(out[12]), "v"(out[13]), "v"(out[14]), "v"(out[15]));
        asm volatile("" : "+v"(pk1) : "v"(out[16]), "v"(out[17]), "v"(out[18]), "v"(out[19]), "v"(out[20]), "v"(out[21]), "v"(out[22]), "v"(out[23]),
                     "v"(out[24]), "v"(out[25]), "v"(out[26]), "v"(out[27]), "v"(out[28]), "v"(out[29]), "v"(out[30]), "v"(out[31]));
        const u32x6 pk = {pk0, pk1, vd4[pp][2], vd4[pp][3], vd2[pp][0], vd2[pp][1]};
        const f32x32 vals = __builtin_amdgcn_cvt_scalef32_pk32_f32_fp6(pk, 1.0f);
#pragma unroll
        for (int i = 0; i < 32; ++i) out[i] += wgt * vals[i];
        __builtin_amdgcn_sched_barrier(0);
      }
    }
    float o16[16];
#pragma unroll
    for (int i = 0; i < 16; ++i) {
      const u32x2 s0 = __builtin_amdgcn_permlane32_swap(__float_as_uint(out[i]), __float_as_uint(out[i]), false, false);
      const u32x2 s1 = __builtin_amdgcn_permlane32_swap(__float_as_uint(out[16 + i]), __float_as_uint(out[16 + i]), false, false);
      const float t0 = __uint_as_float(s0[0]) + __uint_as_float(s0[1]), t1 = __uint_as_float(s1[0]) + __uint_as_float(s1[1]);
      o16[i] = half ? t1 : t0;
    }
    const int cb = 32 * blk + 16 * half;
    const int b = t < TL ? (t >> 11) : 16;
    const float* md = modbuf + ((size_t)l * 17 + b) * 6144 + 5 * 1024 + cb;
    float* xr = xres + (size_t)t * 1024 + cb;
    float xn[16];
    float ss = 0.f;
#pragma unroll
    for (int q = 0; q < 4; ++q) {
      const float4 m4 = *(const float4*)(md + 4 * q);
      float4 xv = *(const float4*)(xr + 4 * q);
      xv.x += m4.x * o16[4 * q + 0]; xv.y += m4.y * o16[4 * q + 1]; xv.z += m4.z * o16[4 * q + 2]; xv.w += m4.w * o16[4 * q + 3];
      xn[4 * q] = xv.x; xn[4 * q + 1] = xv.y; xn[4 * q + 2] = xv.z; xn[4 * q + 3] = xv.w;
      ss += xv.x * xv.x + xv.y * xv.y + xv.z * xv.z + xv.w * xv.w;
      if (dry) asm volatile("" :: "v"(xv.x), "v"(xv.y), "v"(xv.z), "v"(xv.w));
      else if (l < NL - 1) *(float4*)(xr + 4 * q) = xv;
    }
    if (!dry) {
      ss = wave_sum(ss);
      const float rstd = rsqrtf(ss * (1.f / 1024.f) + 1e-6f);
      if (l == NL - 1) {
        const float* fg = p.final_g + cb;
        float* orow = p.out + (size_t)t * 1024 + cb;
#pragma unroll
        for (int q = 0; q < 4; ++q) {
          const float4 g4 = *(const float4*)(fg + 4 * q);
          float4 o = {xn[4 * q] * rstd * g4.x, xn[4 * q + 1] * rstd * g4.y, xn[4 * q + 2] * rstd * g4.z, xn[4 * q + 3] * rstd * g4.w};
          *(float4*)(orow + 4 * q) = o;
        }
      } else {
        const float* gvec = p.norm1_g + (l + 1) * 1024 + cb;
        const float* mdn = modbuf + ((size_t)(l + 1) * 17 + b) * 6144 + cb;
        bf16_t* hrow = (bf16_t*)(p.ws + OFF_H) + (size_t)t * 1024 + cb;
        unsigned pk[8];
#pragma unroll
        for (int q = 0; q < 4; ++q) {
          const float4 g4 = *(const float4*)(gvec + 4 * q), sh = *(const float4*)(mdn + 4 * q), sc = *(const float4*)(mdn + 1024 + 4 * q);
          const float o0 = xn[4 * q] * rstd * g4.x * (1.f + sc.x) + sh.x, o1 = xn[4 * q + 1] * rstd * g4.y * (1.f + sc.y) + sh.y;
          const float o2 = xn[4 * q + 2] * rstd * g4.z * (1.f + sc.z) + sh.z, o3 = xn[4 * q + 3] * rstd * g4.w * (1.f + sc.w) + sh.w;
          pk[2 * q] = pk2(o0, o1); pk[2 * q + 1] = pk2(o2, o3);
        }
        *(u32x4*)hrow = (u32x4){pk[0], pk[1], pk[2], pk[3]};
        *(u32x4*)(hrow + 8) = (u32x4){pk[4], pk[5], pk[6], pk[7]};
      }
    }
  }
}

DI void phase_final(const Params& p) {
  const int lane = ltid() & 63, gw = lbid() * 4 + (ltid() >> 6), nw = lgdim() * 4;
  const float* xres = (const float*)(p.ws + OFF_XRES);
  for (int t = gw; t < TL; t += nw) {
    const float* src = xres + (size_t)t * 1024;
    float4 v[4];
    float ss = 0.f;
#pragma unroll
    for (int i = 0; i < 4; ++i) {
      v[i] = *(const float4*)(src + 4 * lane + 256 * i);
      ss += v[i].x * v[i].x + v[i].y * v[i].y + v[i].z * v[i].z + v[i].w * v[i].w;
    }
    ss = wave_sum(ss);
    const float rstd = rsqrtf(ss * (1.f / 1024.f) + 1e-6f);
#pragma unroll
    for (int i = 0; i < 4; ++i) {
      const int col = 4 * lane + 256 * i;
      const float4 g4 = *(const float4*)(p.final_g + col);
      float4 o = {v[i].x * rstd * g4.x, v[i].y * rstd * g4.y, v[i].z * rstd * g4.z, v[i].w * rstd * g4.w};
      *(float4*)(p.out + (size_t)t * 1024 + col) = o;
    }
  }
}


#define LAS __attribute__((address_space(3)))
#define XB_TMO      128
#define XB_XCNT(j)  (256  + 64 * (j))
#define XB_XSUB(j)  (1280 + 64 * (j))
#define XB_XGEN(j)  (2304 + 64 * (j))
#define XB_TOP      3328
#define XB_TOPGEN   3392
#define XCD_BAR_WORDS 3456
#define XB_SPIN_CAP (1u << 22)
DI unsigned xb_ld(unsigned* p) { return __hip_atomic_load(p, __ATOMIC_RELAXED, __HIP_MEMORY_SCOPE_AGENT); }
DI unsigned xb_add(unsigned* p, unsigned v) { return __hip_atomic_fetch_add(p, v, __ATOMIC_RELAXED, __HIP_MEMORY_SCOPE_AGENT); }
DI unsigned xb_xcc_id() { return (unsigned)__builtin_amdgcn_s_getreg((3 << 11) | 20) & 0xFu; }
#define XB_SPIN(cond, bar) do { unsigned _sp = 0; while (cond) { __builtin_amdgcn_s_sleep(1); \
    if ((++_sp & 255u) == 0u) { if (xb_ld(&(bar)[XB_TMO])) break; if (_sp > XB_SPIN_CAP) { atomicAdd(&(bar)[XB_TMO], 1u); break; } } } } while (0)
struct XcdBarrier { unsigned* bar; unsigned x; volatile unsigned* st; };
DI XcdBarrier xcd_barrier_post(unsigned* bar, volatile unsigned* st) {
  XcdBarrier b; b.bar = bar; b.x = xb_xcc_id(); b.st = st;
  if (threadIdx.x == 0) (void)xb_add(&bar[XB_XCNT(b.x)], 1u);
  return b;
}
DI void xcd_barrier_complete(unsigned* bar, unsigned x, unsigned& nloc, unsigned& nx) {
  const unsigned G = gridDim.x * gridDim.y * gridDim.z;
  unsigned sum, cnt, mine, sp = 0u;
  for (;;) {
    sum = 0u; cnt = 0u; mine = 0u;
#pragma unroll
    for (unsigned j = 0; j < 16; ++j) { const unsigned c = xb_ld(&bar[XB_XCNT(j)]); sum += c; cnt += (c > 0u) ? 1u : 0u; mine = (j == x) ? c : mine; }
    if (sum == G) break;
    __builtin_amdgcn_s_sleep(1);
    if ((++sp & 255u) == 0u) { if (xb_ld(&bar[XB_TMO])) break; if (sp > XB_SPIN_CAP) { atomicAdd(&bar[XB_TMO], 1u); break; } }
  }
  nloc = mine > 0u ? mine : 1u; nx = cnt > 0u ? cnt : 1u;
}
DI void xcd_barrier(const XcdBarrier& b) {
  asm volatile("s_waitcnt vmcnt(0)" ::: "memory");
  __syncthreads();
  if (threadIdx.x == 0) {
    unsigned* bar = b.bar;
    __builtin_amdgcn_s_waitcnt(0);
    unsigned nloc = b.st[0], nx = b.st[1];
    if (nloc == 0u) { xcd_barrier_complete(bar, b.x, nloc, nx); b.st[0] = nloc; b.st[1] = nx; }
    const unsigned old = xb_add(&bar[XB_XSUB(b.x)], 1u);
    const unsigned gen = old / nloc;
    if (old + 1u == (gen + 1u) * nloc) {
      __builtin_amdgcn_fence(__ATOMIC_RELEASE, "agent");
      asm volatile("s_waitcnt vmcnt(0)" ::: "memory");
      const unsigned og = xb_add(&bar[XB_TOP], 1u);
      const unsigned tg = og / nx;
      if (og + 1u == (tg + 1u) * nx) xb_add(&bar[XB_TOPGEN], 1u);
      else XB_SPIN(xb_ld(&bar[XB_TOPGEN]) == tg, bar);
      __builtin_amdgcn_fence(__ATOMIC_ACQUIRE, "agent");
      xb_add(&bar[XB_XGEN(b.x)], 1u);
      asm volatile("s_waitcnt vmcnt(0)" ::: "memory");
    } else {
      XB_SPIN(xb_ld(&bar[XB_XGEN(b.x)]) == gen, bar);
      __builtin_amdgcn_fence(__ATOMIC_ACQUIRE, "agent");
      asm volatile("s_waitcnt vmcnt(0)" ::: "memory");
    }
  }
  __syncthreads();
}

constexpr int PH_PER_LAYER = 10;
constexpr int N_PHASES = 1 + NL * PH_PER_LAYER + 1;

template <int KIND>
DI void run_phase(const Params& p, int ph, unsigned char* lds) {
  unsigned* ctl = (unsigned*)(p.ws + OFF_CTL);
  if (ph == 0) { if (KIND < 0 || KIND == 0) phase_prologue(p, lds); }
  else if (ph == N_PHASES - 1) { if (KIND < 0 || KIND == 11) phase_final(p); }
  else {
    const int l = (ph - 1) / PH_PER_LAYER, s = (ph - 1) % PH_PER_LAYER;
    const bool last = (l == NL - 1);
    const int ntok = last ? TL : TT;
    if (s == 0) { if (KIND < 0 || KIND == 1) phase_norm(p, l, 0, TT); }
    else if (s == 1) { if (KIND < 0 || KIND == 2) phase_gemm_in(p, l, lds); }
    else if (s == 2) { if (KIND < 0 || KIND == 3) phase_rope(p, lds); }
    else if (s == 3) { if (KIND < 0 || KIND == 4) phase_mixers(p, l, last, ctl + 64 * (1 + l), lds); }
    else if (s == 4) { if (KIND < 0 || KIND == 5) phase_gla_fin(p, l, ntok); }
    else if (s == 5) { if (KIND < 0 || KIND == 6) phase_gemm_out(p, l, ntok, lds); }
    else if (s == 6) { if (KIND < 0 || KIND == 7) phase_norm(p, l, 1, ntok); }
    else if (s == 7) { if (KIND < 0 || KIND == 8) phase_gemm_q(p, l, ntok, lds); }
    else if (s == 8) { if (KIND < 0 || KIND == 9) phase_topk(p, l, ntok); }
    else { if (KIND < 0 || KIND == 10) phase_gather(p, l, ntok, lds); }
  }
}

#if N_LAUNCH_MODE == 1
#ifndef PROBE_KIND
#define PROBE_KIND -1
#endif
#ifndef GLA_VAR
#define GLA_VAR 0
#endif
constexpr int CW_BAR = 4096;
__global__ void __launch_bounds__(256, 2) mk_fwd(Params p) {
  __shared__ __attribute__((aligned(16))) unsigned char lds[LDS_BYTES];
  unsigned* ctl = (unsigned*)(p.ws + OFF_CTL);
  volatile unsigned* st = (volatile unsigned*)(lds + LDS_BYTES - 32);
  if (threadIdx.x < 2) st[threadIdx.x] = 0u;
  __syncthreads();
  (void)xcd_barrier_post(ctl + CW_BAR, st);
#define GSYNC() do { XcdBarrier bb; bb.bar = (unsigned*)(p.ws + OFF_CTL) + CW_BAR; bb.x = xb_xcc_id(); bb.st = (volatile unsigned*)(lds + LDS_BYTES - 32); xcd_barrier(bb); } while (0)
  { Params q = p; { size_t z_ = 0; asm volatile("" : "+s"(z_)); q.ws = p.ws + z_; } phase_prologue(q, lds); } cg::this_grid().sync();
  if (PROBE_KIND == 0) { { Params q = p; { size_t z_ = 0; asm volatile("" : "+s"(z_)); q.ws = p.ws + z_; } phase_prologue(q, lds); } GSYNC(); }
  for (int l = 0; l < NL; ++l) {
    const bool last = (l == NL - 1);
    const int ntok = last ? TL : TT;
    if (l == 0) { { Params q = p; { size_t z_ = 0; asm volatile("" : "+s"(z_)); q.ws = p.ws + z_; } phase_norm(q, l, 0, TT); } GSYNC(); }
    if (PROBE_KIND == 1) { { Params q = p; { size_t z_ = 0; asm volatile("" : "+s"(z_)); q.ws = p.ws + z_; } phase_norm(q, l, 0, TT); } GSYNC(); }
    if (PROBE_KIND == 2) { { Params q = p; { size_t z_ = 0; asm volatile("" : "+s"(z_)); q.ws = p.ws + z_; } phase_gemm_in(q, l, lds, true); } GSYNC(); }
    { Params q = p; { size_t z_ = 0; asm volatile("" : "+s"(z_)); q.ws = p.ws + z_; } phase_gemm_in(q, l, lds); } GSYNC();
    if (PROBE_KIND == 4 || (PROBE_KIND >= 41 && PROBE_KIND <= 47)) { { Params q = p; { size_t z_ = 0; asm volatile("" : "+s"(z_)); q.ws = p.ws + z_; } phase_mixers(q, l, last, ctl + 64 * (1 + l) + 1, lds, PROBE_KIND == 4 ? 7 : PROBE_KIND - 40, GLA_VAR); } GSYNC(); }
    { Params q = p; { size_t z_ = 0; asm volatile("" : "+s"(z_)); q.ws = p.ws + z_; } phase_mixers(q, l, last, ctl + 64 * (1 + l), lds); } GSYNC();
    { Params q = p; { size_t z_ = 0; asm volatile("" : "+s"(z_)); q.ws = p.ws + z_; } phase_gla_fin(q, l, ntok); } GSYNC();
    if (PROBE_KIND == 5) { { Params q = p; { size_t z_ = 0; asm volatile("" : "+s"(z_)); q.ws = p.ws + z_; } phase_gla_fin(q, l, ntok); } GSYNC(); }
    { Params q = p; { size_t z_ = 0; asm volatile("" : "+s"(z_)); q.ws = p.ws + z_; } phase_gemm_out(q, l, ntok, lds); } GSYNC();
    { Params q = p; { size_t z_ = 0; asm volatile("" : "+s"(z_)); q.ws = p.ws + z_; } phase_norm2(q, l, ntok); } GSYNC();
    if (PROBE_KIND == 7) { { Params q = p; { size_t z_ = 0; asm volatile("" : "+s"(z_)); q.ws = p.ws + z_; } phase_norm2(q, l, ntok); } GSYNC(); }
    { Params q = p; { size_t z_ = 0; asm volatile("" : "+s"(z_)); q.ws = p.ws + z_; } phase_gemm_q(q, l, ntok, lds); } GSYNC();
    if (PROBE_KIND == 8) { { Params q = p; { size_t z_ = 0; asm volatile("" : "+s"(z_)); q.ws = p.ws + z_; } phase_gemm_q(q, l, ntok, lds); } GSYNC(); }
    { Params q = p; { size_t z_ = 0; asm volatile("" : "+s"(z_)); q.ws = p.ws + z_; } phase_topk(q, l, ntok); } GSYNC();
    if (PROBE_KIND == 9) { { Params q = p; { size_t z_ = 0; asm volatile("" : "+s"(z_)); q.ws = p.ws + z_; } phase_topk(q, l, ntok); } GSYNC(); }
    if (PROBE_KIND == 10) { { Params q = p; { size_t z_ = 0; asm volatile("" : "+s"(z_)); q.ws = p.ws + z_; } phase_gather(q, l, ntok, lds, true); } GSYNC(); }
    { Params q = p; { size_t z_ = 0; asm volatile("" : "+s"(z_)); q.ws = p.ws + z_; } phase_gather(q, l, ntok, lds); } if (l + 1 < NL) GSYNC();
  }
}
#else
template <int KIND>
__global__ void __launch_bounds__(256, 2) mk_phase(Params p) {
  __shared__ __attribute__((aligned(16))) unsigned char lds[LDS_BYTES];
  run_phase<KIND>(p, p.ph_lo, lds);
}
#endif

extern "C" void kernel_launch(void* const* d_in, const int* in_sizes, int n_in, void* d_out, int out_size, void* d_ws,
                              size_t ws_size, hipStream_t stream) {
  static int grid = 0;
  if (grid == 0) {
    if (n_in != 21 || ws_size < WS_END || out_size != TL * DM) { fprintf(stderr, "kernel_launch: unexpected shapes (n_in %d ws %zu out %d)\n", n_in, ws_size, out_size); grid = -1; return; }
    int dev = 0, cus = 0, per_cu = 2;
    (void)hipGetDevice(&dev);
    (void)hipDeviceGetAttribute(&cus, hipDeviceAttributeMultiprocessorCount, dev);
#if N_LAUNCH_MODE == 1
    (void)hipOccupancyMaxActiveBlocksPerMultiprocessor(&per_cu, (const void*)mk_fwd, 256, 0);
    if (per_cu < 1) per_cu = 1;
    if (per_cu > 2) per_cu = 2;
#endif
    grid = cus * per_cu;
  }
  if (grid < 0) return;
  (void)hipMemsetAsync((char*)d_ws + OFF_CTL, 0, 65536, stream);
  Params p{};
  const float** pp = (const float**)&p;
  for (int i = 0; i < 21; ++i) pp[i] = (const float*)d_in[i];
  p.out = (float*)d_out;
  p.ws = (unsigned char*)d_ws;
#if N_LAUNCH_MODE == 1
  p.ph_lo = 0; p.ph_hi = N_PHASES;
  void* args[] = {&p};
  hipError_t e = hipLaunchCooperativeKernel((const void*)mk_fwd, dim3(grid), dim3(256), args, 0, stream);
  if (e != hipSuccess) fprintf(stderr, "cooperative launch failed: %s (grid %d)\n", hipGetErrorString(e), grid);
#else
  for (int ph = 0; ph < N_PHASES; ++ph) {
    p.ph_lo = ph; p.ph_hi = ph + 1;
    const int kind = ph == 0 ? 0 : (ph == N_PHASES - 1 ? 11 : 1 + (ph - 1) % PH_PER_LAYER);
    switch (kind) {
      case 0: hipLaunchKernelGGL(mk_phase<0>, dim3(grid), dim3(256), 0, stream, p); break;
      case 1: hipLaunchKernelGGL(mk_phase<1>, dim3(grid), dim3(256), 0, stream, p); break;
      case 2: hipLaunchKernelGGL(mk_phase<2>, dim3(grid), dim3(256), 0, stream, p); break;
      case 3: hipLaunchKernelGGL(mk_phase<3>, dim3(grid), dim3(256), 0, stream, p); break;
      case 4: hipLaunchKernelGGL(mk_phase<4>, dim3(grid), dim3(256), 0, stream, p); break;
      case 5: hipLaunchKernelGGL(mk_phase<5>, dim3(grid), dim3(256), 0, stream, p); break;
      case 6: hipLaunchKernelGGL(mk_phase<6>, dim3(grid), dim3(256), 0, stream, p); break;
      case 7: hipLaunchKernelGGL(mk_phase<7>, dim3(grid), dim3(256), 0, stream, p); break;
      case 8: hipLaunchKernelGGL(mk_phase<8>, dim3(grid), dim3(256), 0, stream, p); break;
      case 9: hipLaunchKernelGGL(mk_phase<9>, dim3(grid), dim3(256), 0, stream, p); break;
      case 10: hipLaunchKernelGGL(mk_phase<10>, dim3(grid), dim3(256), 0, stream, p); break;
      default: hipLaunchKernelGGL(mk_phase<11>, dim3(grid), dim3(256), 0, stream, p); break;
    }
  }
#endif
}
```

```cpp
#include <hip/hip_runtime.h>
#include <hip/hip_cooperative_groups.h>
#include <stdint.h>
#include <stdio.h>
namespace cg = cooperative_groups;

#ifndef N_LAUNCH_MODE
#define N_LAUNCH_MODE 1
#endif

#define DI __device__ __forceinline__
#ifndef GEMM_VAR
#define GEMM_VAR 0
#endif
typedef unsigned short bf16_t;
typedef short bf16x8 __attribute__((ext_vector_type(8)));
typedef float f32x4 __attribute__((ext_vector_type(4)));
typedef float f32x2 __attribute__((ext_vector_type(2)));
typedef float f32x16 __attribute__((ext_vector_type(16)));
typedef float f32x32 __attribute__((ext_vector_type(32)));
typedef unsigned u32x6 __attribute__((ext_vector_type(6)));
typedef int i32x8 __attribute__((ext_vector_type(8)));
typedef unsigned u32x4 __attribute__((ext_vector_type(4)));
typedef unsigned u32x2 __attribute__((ext_vector_type(2)));

constexpr int NB = 16, SEQ = 2048, DM = 1024, NL = 4, CTXL = 256;
constexpr int TL = NB * SEQ;
constexpr int TC = NB * CTXL;
constexpr int TT = TL + TC;
constexpr int PN_LD = 2176;
constexpr int C_GQ = 0, C_GK = 128, C_GR = 256, C_NQ = 512, C_NK = 768, C_DQ = 1024, C_DK = 1536, C_GATE = 2048;
constexpr int R_GV = 0, R_NV = 256, R_DV = 512;
constexpr float LOG2E = 1.4426950408889634f;
constexpr float SC_LOG2 = 0.125f * LOG2E;
constexpr float NEG_BIG = -1e30f;

constexpr size_t MiB = 1u << 20;
constexpr size_t OFF_CTL = 0;
constexpr size_t OFF_MOD = 1 * MiB;
constexpr size_t OFF_WIN = 3 * MiB;
constexpr size_t OFF_WOUT = 28 * MiB;
constexpr size_t OFF_WQ = 36 * MiB;
constexpr size_t OFF_SK = 44 * MiB;
constexpr size_t OFF_USCL = 44 * MiB + 256 * 1024;
constexpr size_t OFF_VSCL = 44 * MiB + 512 * 1024;
constexpr size_t OFF_U = 45 * MiB;
constexpr size_t OFF_V = 109 * MiB;
constexpr int V6_PITCH = 800;
constexpr size_t OFF_XRES = 301 * MiB;
constexpr size_t OFF_H = 445 * MiB;
constexpr size_t OFF_P = 517 * MiB;
constexpr size_t OFF_VT = OFF_P + 153 * MiB;
constexpr size_t OFF_QP = OFF_P;
constexpr size_t OFF_EID = OFF_P + 72 * MiB;
constexpr size_t OFF_GATE = OFF_P + 90 * MiB;
constexpr size_t OFF_H8 = OFF_P + 126 * MiB;
constexpr size_t OFF_HINV = OFF_P + 162 * MiB;
constexpr size_t OFF_Y = 742 * MiB;
constexpr size_t WS_END = 814 * MiB;

constexpr int LDS_BYTES = 65536 + 8192;

struct Params {
  const float *x, *c, *ctx, *c_ctx, *ada_w, *ada_b, *norm1_g, *norm2_g, *w_in, *gate_up, *gate_b, *gla_norm_g,
      *rpb, *dlam, *diff_g, *w_out, *wq, *subkeys, *pu, *pv, *final_g;
  float* out;
  unsigned char* ws;
  int ph_lo, ph_hi;
};

DI int ltid() { int t = threadIdx.x; asm volatile("" : "+v"(t)); return t; }
DI int lbid() { int t = blockIdx.x; asm volatile("" : "+s"(t)); return t; }
DI int lgdim() { int t = gridDim.x; asm volatile("" : "+s"(t)); return t; }

DI unsigned f2bf(float f) { unsigned u = __float_as_uint(f); return (u + 0x7fffu + ((u >> 16) & 1u)) >> 16; }
typedef __bf16 bf16x2_t __attribute__((ext_vector_type(2)));
DI unsigned pk2(float lo, float hi) { f32x2 v = {lo, hi}; return __builtin_bit_cast(unsigned, __builtin_convertvector(v, bf16x2_t)); }
DI float bflo(unsigned u) { return __uint_as_float(u << 16); }
DI float bfhi(unsigned u) { return __uint_as_float(u & 0xffff0000u); }
DI void unpack8(const u32x4 v, float* f) {
  f[0] = bflo(v.x); f[1] = bfhi(v.x); f[2] = bflo(v.y); f[3] = bfhi(v.y);
  f[4] = bflo(v.z); f[5] = bfhi(v.z); f[6] = bflo(v.w); f[7] = bfhi(v.w);
}
DI float wave_sum(float v) {
#pragma unroll
  for (int o = 32; o >= 1; o >>= 1) v += __shfl_xor(v, o);
  return v;
}

DI float rows_max(float x) {
  unsigned u = __float_as_uint(x);
  u32x2 a = __builtin_amdgcn_permlane32_swap(u, u, false, false);
  const float m = fmaxf(__uint_as_float(a[0]), __uint_as_float(a[1]));
  unsigned v = __float_as_uint(m);
  u32x2 b = __builtin_amdgcn_permlane16_swap(v, v, false, false);
  return fmaxf(__uint_as_float(b[0]), __uint_as_float(b[1]));
}
DI float rows_sum(float x) {
  unsigned u = __float_as_uint(x);
  u32x2 a = __builtin_amdgcn_permlane32_swap(u, u, false, false);
  const float m = __uint_as_float(a[0]) + __uint_as_float(a[1]);
  unsigned v = __float_as_uint(m);
  u32x2 b = __builtin_amdgcn_permlane16_swap(v, v, false, false);
  return __uint_as_float(b[0]) + __uint_as_float(b[1]);
}

DI u32x6 mxfp6_pack32(float (&x)[32], unsigned& sbyte) {
  float am = 0.f;
#pragma unroll
  for (int i = 0; i < 32; ++i) am = fmaxf(am, fabsf(x[i]));
  int e = am > 0.f ? (int)ceilf(log2f(am) - 2.906890596f) : -126;
  e = e < -126 ? -126 : (e > 127 ? 127 : e);
  const float sc = __uint_as_float((unsigned)(127 - e) << 23);
  f32x16 lo, hi;
#pragma unroll
  for (int i = 0; i < 16; ++i) { lo[i] = x[2 * i] * sc; hi[i] = x[2 * i + 1] * sc; }
  sbyte = (unsigned)(127 + e);
  return __builtin_amdgcn_cvt_scalef32_2xpk16_fp6_f32(lo, hi, 1.0f);
}
DI int mx_scale_pos(int blk) { return 768 + (blk & 3) * 8 + (blk >> 2); }
DI f32x4 mfma16(bf16x8 a, bf16x8 b, f32x4 c) { return __builtin_amdgcn_mfma_f32_16x16x32_bf16(a, b, c, 0, 0, 0); }

DI int win_src_col(int r) {
  if (r < 256) return r;
  if (r < 512) return r - 256 + 512;
  if (r < 768) return r - 512 + 800;
  if (r < 1024) return r - 768 + 1056;
  if (r < 1536) return r - 1024 + 1568;
  if (r < 2048) return r - 1536 + 2080;
  if (r < 2080) return r - 2048 + 768;
  if (r < 2176) return -1;
  if (r < 2432) return r - 2176 + 256;
  if (r < 2688) return r - 2432 + 1312;
  return r - 2688 + 2592;
}

DI void transpose_item(const float* __restrict__ W, int N, int src, bf16_t* __restrict__ dst, float* lds) {
  const int tid = ltid();
  for (int kc = 0; kc < 8; ++kc) {
    __syncthreads();
#pragma unroll
    for (int i = 0; i < 16; ++i) {
      int k = i * 8 + (tid >> 5), n = tid & 31;
      lds[k * 33 + n] = (src < 0) ? 0.f : W[(size_t)(kc * 128 + k) * N + src + n];
    }
    __syncthreads();
    int row = tid >> 3, k0 = (tid & 7) * 16;
    unsigned o[8];
#pragma unroll
    for (int e = 0; e < 8; ++e) o[e] = pk2(lds[(k0 + 2 * e) * 33 + row], lds[(k0 + 2 * e + 1) * 33 + row]);
    u32x4 a = {o[0], o[1], o[2], o[3]}, b = {o[4], o[5], o[6], o[7]};
    bf16_t* d = dst + (size_t)row * 1024 + kc * 128 + k0;
    *(u32x4*)d = a; *(u32x4*)(d + 8) = b;
  }
}

DI void convert_table_pairs(const Params& p, int pr0, int pr1, int wave, int nwave, int lane) {
  for (int pr = pr0 + wave; pr < pr1; pr += nwave) {
    const int tab = pr >= NL * 16384 / 2, pq = tab ? pr - NL * 16384 / 2 : pr;
    const int r = 2 * pq + (lane >> 5), blk = lane & 31;
    const float* src = (tab ? p.pv : p.pu) + (size_t)r * 1024 + 32 * blk;
    float x[32];
#pragma unroll
    for (int i = 0; i < 8; ++i) { const float4 a = *(const float4*)(src + 4 * i); x[4 * i] = a.x; x[4 * i + 1] = a.y; x[4 * i + 2] = a.z; x[4 * i + 3] = a.w; }
    unsigned sb;
    const u32x6 q = mxfp6_pack32(x, sb);
    unsigned char* row = p.ws + (tab ? OFF_V : OFF_U) + (size_t)r * V6_PITCH;
    *(u32x2*)(row + 24 * blk) = (u32x2){q[0], q[1]};
    *(u32x2*)(row + 24 * blk + 8) = (u32x2){q[2], q[3]};
    *(u32x2*)(row + 24 * blk + 16) = (u32x2){q[4], q[5]};
    row[mx_scale_pos(blk)] = (unsigned char)sb;
  }
}

DI void phase_prologue(const Params& p, unsigned char* lds) {
  const int tid = ltid(), nb = lgdim(), bid = lbid();
  bf16_t* winT = (bf16_t*)(p.ws + OFF_WIN);
  bf16_t* woutT = (bf16_t*)(p.ws + OFF_WOUT);
  bf16_t* wqT = (bf16_t*)(p.ws + OFF_WQ);
  constexpr int PER_LAYER = 100 + 32 + 32;
  for (int item = bid; item < NL * PER_LAYER; item += nb) {
    int l = item / PER_LAYER, r = item % PER_LAYER;
    if (r < 100) {
      int row = r * 32;
      transpose_item(p.w_in + (size_t)l * 1024 * 3104, 3104, win_src_col(row), winT + ((size_t)l * 3200 + row) * 1024, (float*)lds);
    } else if (r < 132) {
      int row = (r - 100) * 32;
      transpose_item(p.w_out + (size_t)l * 1024 * 1024, 1024, row, woutT + ((size_t)l * 1024 + row) * 1024, (float*)lds);
    } else {
      int row = (r - 132) * 32;
      transpose_item(p.wq + (size_t)l * 1024 * 1024, 1024, row, wqT + ((size_t)l * 1024 + row) * 1024, (float*)lds);
    }
  }
  {
    bf16_t* sk = (bf16_t*)(p.ws + OFF_SK);
    for (int i = bid * 256 + tid; i < NL * 2 * 128 * 64; i += nb * 256) sk[i] = (bf16_t)f2bf(p.subkeys[i]);
  }
  {
    float* modbuf = (float*)(p.ws + OFF_MOD);
    float* sc = (float*)lds;
    float* red = (float*)(lds + 17 * 512 * 4);
    for (int item = bid; item < NL * 96; item += nb) {
      const int l = item / 96, cb = item % 96, col = cb * 64 + (tid & 63), kq = tid >> 6;
      float acc[17];
#pragma unroll
      for (int r = 0; r < 17; ++r) acc[r] = 0.f;
      for (int half = 0; half < 2; ++half) {
        __syncthreads();
        for (int e = tid; e < 17 * 512; e += 256) {
          int r = e >> 9, k = e & 511;
          float cv = (r < 16) ? p.c[r * 1024 + half * 512 + k] : p.c_ctx[half * 512 + k];
          sc[e] = cv / (1.f + __expf(-cv));
        }
        __syncthreads();
        const float* wp = p.ada_w + ((size_t)l * 1024 + half * 512 + kq * 128) * 6144 + col;
        for (int kk = 0; kk < 128; ++kk) {
          const float w = wp[(size_t)kk * 6144];
#pragma unroll
          for (int r = 0; r < 17; ++r) acc[r] += sc[r * 512 + kq * 128 + kk] * w;
        }
      }
#pragma unroll
      for (int r = 0; r < 17; ++r) red[(kq * 17 + r) * 64 + (tid & 63)] = acc[r];
      __syncthreads();
      for (int e = tid; e < 17 * 64; e += 256) {
        int r = e >> 6, cc = e & 63;
        float s = red[(0 * 17 + r) * 64 + cc] + red[(1 * 17 + r) * 64 + cc] + red[(2 * 17 + r) * 64 + cc] + red[(3 * 17 + r) * 64 + cc];
        int colg = cb * 64 + cc;
        modbuf[((size_t)l * 17 + r) * 6144 + colg] = s + p.ada_b[l * 6144 + colg];
      }
      __syncthreads();
    }
  }
}

DI void phase_norm(const Params& p, int l, int which, int ntok) {
  const int lane = ltid() & 63, gw = lbid() * 4 + (ltid() >> 6), nw = lgdim() * 4;
  const float* gvec = (which == 0 ? p.norm1_g : p.norm2_g) + l * 1024;
  const int ish = which == 0 ? 0 : 3, isc = which == 0 ? 1 : 4;
  const float* xres = (const float*)(p.ws + OFF_XRES);
  const float* modbuf = (const float*)(p.ws + OFF_MOD);
  bf16_t* hbuf = (bf16_t*)(p.ws + OFF_H);
  for (int t = gw; t < ntok; t += nw) {
    const float* src = (which == 0 && l == 0) ? (t < TL ? p.x + (size_t)t * 1024 : p.ctx + (size_t)(t - TL) * 1024) : xres + (size_t)t * 1024;
    const int b = t < TL ? (t >> 11) : 16;
    const float* md = modbuf + ((size_t)l * 17 + b) * 6144;
    float4 v[4];
    float ss = 0.f;
#pragma unroll
    for (int i = 0; i < 4; ++i) {
      v[i] = *(const float4*)(src + 4 * lane + 256 * i);
      ss += v[i].x * v[i].x + v[i].y * v[i].y + v[i].z * v[i].z + v[i].w * v[i].w;
    }
    ss = wave_sum(ss);
    const float rstd = rsqrtf(ss * (1.f / 1024.f) + 1e-6f);
    float am = 0.f;
#pragma unroll
    for (int i = 0; i < 4; ++i) {
      const int col = 4 * lane + 256 * i;
      const float4 g4 = *(const float4*)(gvec + col), sh = *(const float4*)(md + ish * 1024 + col), sc = *(const float4*)(md + isc * 1024 + col);
      float o0 = v[i].x * rstd * g4.x * (1.f + sc.x) + sh.x;
      float o1 = v[i].y * rstd * g4.y * (1.f + sc.y) + sh.y;
      float o2 = v[i].z * rstd * g4.z * (1.f + sc.z) + sh.z;
      float o3 = v[i].w * rstd * g4.w * (1.f + sc.w) + sh.w;
      u32x2 o = {pk2(o0, o1), pk2(o2, o3)};
      *(u32x2*)(hbuf + (size_t)t * 1024 + col) = o;
      v[i].x = o0; v[i].y = o1; v[i].z = o2; v[i].w = o3;
      am = fmaxf(am, fmaxf(fmaxf(fabsf(o0), fabsf(o1)), fmaxf(fabsf(o2), fabsf(o3))));
    }
  }
}

DI void phase_norm2(const Params& p, int l, int ntok) {
  const int lane = ltid() & 63, gw = lbid() * 4 + (ltid() >> 6), nw = lgdim() * 4;
  const int half = lane >> 5, blk = lane & 31;
  const float* gvec = p.norm2_g + l * 1024 + 32 * blk;
  const float* xres = (const float*)(p.ws + OFF_XRES);
  const float* modbuf = (const float*)(p.ws + OFF_MOD);
  bf16_t* hbuf = (bf16_t*)(p.ws + OFF_H);
  unsigned char* h6 = p.ws + OFF_H8;
  for (int pr = gw; pr < ntok / 2; pr += nw) {
    const int t = 2 * pr + half;
    const float* src = xres + (size_t)t * 1024 + 32 * blk;
    const int b = t < TL ? (t >> 11) : 16;
    const float* md = modbuf + ((size_t)l * 17 + b) * 6144 + 32 * blk;
    float x[32];
    float ss = 0.f;
#pragma unroll
    for (int i = 0; i < 8; ++i) {
      const float4 a = *(const float4*)(src + 4 * i);
      x[4 * i] = a.x; x[4 * i + 1] = a.y; x[4 * i + 2] = a.z; x[4 * i + 3] = a.w;
      ss += a.x * a.x + a.y * a.y + a.z * a.z + a.w * a.w;
    }
#pragma unroll
    for (int o = 16; o >= 1; o >>= 1) ss += __shfl_xor(ss, o);
    const float rstd = rsqrtf(ss * (1.f / 1024.f) + 1e-6f);
    unsigned pk[16];
#pragma unroll
    for (int i = 0; i < 8; ++i) {
      const float4 g4 = *(const float4*)(gvec + 4 * i), sh = *(const float4*)(md + 3 * 1024 + 4 * i), sc = *(const float4*)(md + 4 * 1024 + 4 * i);
      x[4 * i] = x[4 * i] * rstd * g4.x * (1.f + sc.x) + sh.x;
      x[4 * i + 1] = x[4 * i + 1] * rstd * g4.y * (1.f + sc.y) + sh.y;
      x[4 * i + 2] = x[4 * i + 2] * rstd * g4.z * (1.f + sc.z) + sh.z;
      x[4 * i + 3] = x[4 * i + 3] * rstd * g4.w * (1.f + sc.w) + sh.w;
      pk[2 * i] = pk2(x[4 * i], x[4 * i + 1]); pk[2 * i + 1] = pk2(x[4 * i + 2], x[4 * i + 3]);
    }
    bf16_t* hrow = hbuf + (size_t)t * 1024 + 32 * blk;
#pragma unroll
    for (int i = 0; i < 4; ++i) *(u32x4*)(hrow + 8 * i) = (u32x4){pk[4 * i], pk[4 * i + 1], pk[4 * i + 2], pk[4 * i + 3]};
    unsigned sb;
    const u32x6 q = mxfp6_pack32(x, sb);
    unsigned char* row = h6 + (size_t)t * V6_PITCH;
    *(u32x2*)(row + 24 * blk) = (u32x2){q[0], q[1]};
    *(u32x2*)(row + 24 * blk + 8) = (u32x2){q[2], q[3]};
    *(u32x2*)(row + 24 * blk + 16) = (u32x2){q[4], q[5]};
    row[mx_scale_pos(blk)] = (unsigned char)sb;
  }
}

template <int EPI>
DI void gemm_tile(const bf16_t* __restrict__ P, const bf16_t* __restrict__ Q, int it, int jt, void* outp, int ld,
                  const float* xin_lat, const float* xin_ctx, const float* modl, unsigned char* lds, bool gvar = false) {
  const int tid = ltid(), lane = tid & 63, w = tid >> 6, wi = w >> 1, wj = w & 1, lr = lane & 15, g = lane >> 4;
  const int wu = __builtin_amdgcn_readfirstlane(w);
  f32x4 acc[4][4];
#pragma unroll
  for (int a = 0; a < 4; ++a)
#pragma unroll
    for (int b = 0; b < 4; ++b) acc[a][b] = (f32x4){0.f, 0.f, 0.f, 0.f};
  const unsigned lo0 = (unsigned)((lane >> 3) * 1024 + (((lane & 7) ^ (lane >> 4)) << 3));
  const unsigned lo1 = (unsigned)((lane >> 3) * 1024 + (((lane & 7) ^ (4 + (lane >> 4))) << 3));
  const bf16_t* pg = P + (size_t)(it * 128 + 32 * wu) * 1024;
  const bf16_t* qg = Q + (size_t)(jt * 128 + 32 * wu) * 1024;
#define GT_DMA(kb, bf) do { _Pragma("unroll") for (int jj = 0; jj < 4; ++jj) { const unsigned lo_ = (jj & 1) ? lo1 : lo0; \
      __builtin_amdgcn_global_load_lds((const unsigned*)(pg + (size_t)jj * 8192 + (kb) * 64 + lo_), (unsigned*)(lds + (bf) * 32768 + (4 * wu + jj) * 1024), 16, 0, 0); \
      __builtin_amdgcn_global_load_lds((const unsigned*)(qg + (size_t)jj * 8192 + (kb) * 64 + lo_), (unsigned*)(lds + (bf) * 32768 + 16384 + (4 * wu + jj) * 1024), 16, 0, 0); } } while (0)
  __syncthreads();
  GT_DMA(0, 0);
  asm volatile("s_waitcnt vmcnt(0)" ::: "memory");
  __syncthreads();
  for (int kb = 0; kb < 16; ++kb) {
    if (kb < 15 && !(GEMM_VAR == 1 && gvar)) GT_DMA(kb + 1, (kb + 1) & 1);
    const unsigned char* Ps = lds + (kb & 1) * 32768;
    const unsigned char* Qs = Ps + 16384;
    bf16x8 pf[2][4], qf[2][4];
#pragma unroll
    for (int ks = 0; ks < 2; ++ks) {
      const int ch = ks * 4 + g;
#pragma unroll
      for (int mi = 0; mi < 4; ++mi) { const int row = wi * 64 + mi * 16 + lr; pf[ks][mi] = *(const bf16x8*)(Ps + (row >> 1) * 256 + (((((row & 1) << 3) | ch) ^ ((row >> 1) & 7)) << 4)); }
#pragma unroll
      for (int nj = 0; nj < 4; ++nj) { const int row = wj * 64 + nj * 16 + lr; qf[ks][nj] = *(const bf16x8*)(Qs + (row >> 1) * 256 + (((((row & 1) << 3) | ch) ^ ((row >> 1) & 7)) << 4)); }
    }
    __builtin_amdgcn_sched_barrier(0);
    __builtin_amdgcn_s_setprio(1);
#pragma unroll
    for (int ks = 0; ks < 2; ++ks)
#pragma unroll
      for (int mi = 0; mi < 4; ++mi)
#pragma unroll
        for (int nj = 0; nj < 4; ++nj) { if (GEMM_VAR == 2 && gvar) { asm volatile("" :: "v"(pf[ks][mi]), "v"(qf[ks][nj])); } else acc[mi][nj] = mfma16(pf[ks][mi], qf[ks][nj], acc[mi][nj]); }
    __builtin_amdgcn_s_setprio(0);
    __builtin_amdgcn_sched_barrier(0);
    asm volatile("s_waitcnt vmcnt(0)" ::: "memory");
    __syncthreads();
  }
#undef GT_DMA
  if (EPI == 2) {
    float inv[4];
#pragma unroll
    for (int r = 0; r < 4; ++r) inv[r] = __builtin_amdgcn_exp2f(-(float)(4 * g + r) * (13.287712379549449f / 16.f));
#pragma unroll
    for (int nj = 0; nj < 4; ++nj) {
      const int j = jt * 128 + wj * 64 + nj * 16 + lr;
      if (j < TL) {
        const float prow = (float)((j & 2047) >> 6), pcol = (float)(j & 63);
#pragma unroll
        for (int r = 0; r < 4; ++r) {
          const float a1 = prow * inv[r], a2 = pcol * inv[r];
          const float c1 = __cosf(a1), s1 = __sinf(a1), c2 = __cosf(a2), s2 = __sinf(a2);
          const float x1 = acc[0][nj][r], x2 = acc[1][nj][r], y1 = acc[2][nj][r], y2 = acc[3][nj][r];
          acc[0][nj][r] = x1 * c1 - x2 * s1; acc[1][nj][r] = x2 * c1 + x1 * s1;
          acc[2][nj][r] = y1 * c2 - y2 * s2; acc[3][nj][r] = y2 * c2 + y1 * s2;
        }
      }
    }
  }
#pragma unroll
  for (int mi = 0; mi < 4; ++mi)
#pragma unroll
    for (int nj = 0; nj < 4; ++nj) {
      const int j = jt * 128 + wj * 64 + nj * 16 + lr;
      const int i = it * 128 + wi * 64 + mi * 16 + 4 * g;
      const f32x4 a = acc[mi][nj];
      if (EPI == 0 || EPI == 2) {
        u32x2 o = {pk2(a[0], a[1]), pk2(a[2], a[3])};
        *(u32x2*)((bf16_t*)outp + (size_t)j * ld + i) = o;
      } else {
        const int b = j < TL ? (j >> 11) : 16;
        const float4 gt = *(const float4*)(modl + (size_t)b * 6144 + 2 * 1024 + i);
        const float* xs = (j < TL) ? xin_lat + (size_t)j * 1024 + i : xin_ctx + (size_t)(j - TL) * 1024 + i;
        const float4 xv = *(const float4*)xs;
        float4 o = {xv.x + gt.x * a[0], xv.y + gt.y * a[1], xv.z + gt.z * a[2], xv.w + gt.w * a[3]};
        *(float4*)((float*)outp + (size_t)j * 1024 + i) = o;
      }
    }
}

struct TileIter {
  int u, step, total, nf, tpx, x;
  DI void init(int n_tok_tiles, int n_feat_tiles) {
    const int bid = lbid(), nb = lgdim();
    nf = n_feat_tiles;
    if ((nb & 7) == 0 && (n_tok_tiles & 7) == 0) { x = bid & 7; u = bid >> 3; step = nb >> 3; tpx = n_tok_tiles >> 3; }
    else { x = 0; u = bid; step = nb; tpx = n_tok_tiles; }
    total = tpx * nf;
  }
  DI bool valid() const { return u < total; }
  DI void next() { u += step; }
  DI void get(int& tok_tile, int& feat_tile) const {
    const int g = u / (8 * nf), rem = u - g * 8 * nf;
    const int gs = (tpx - 8 * g) < 8 ? (tpx - 8 * g) : 8;
    const int f = rem / gs, tt = rem - f * gs;
    tok_tile = x * tpx + 8 * g + tt; feat_tile = f;
  }
};

DI void phase_gemm_in(const Params& p, int l, unsigned char* lds, bool gvar = false) {
  const bf16_t* W = (const bf16_t*)(p.ws + OFF_WIN) + (size_t)l * 3200 * 1024;
  const bf16_t* H = (const bf16_t*)(p.ws + OFF_H);
  bf16_t* PN = (bf16_t*)(p.ws + OFF_P);
  bf16_t* VT = (bf16_t*)(p.ws + OFF_VT);
  TileIter ti; ti.init(TT / 128, 25);
  for (; ti.valid(); ti.next()) {
    int jt, f; ti.get(jt, f);
    if (f >= 8 && f < 16) gemm_tile<2>(W, H, f, jt, PN, PN_LD, nullptr, nullptr, nullptr, lds, gvar);
    else if (f < 17) gemm_tile<0>(W, H, f, jt, PN, PN_LD, nullptr, nullptr, nullptr, lds, gvar);
    else gemm_tile<0>(H, W + (size_t)2176 * 1024, jt, f - 17, VT, TT, nullptr, nullptr, nullptr, lds, gvar);
  }
}
DI void phase_gemm_out(const Params& p, int l, int ntok, unsigned char* lds) {
  const bf16_t* W = (const bf16_t*)(p.ws + OFF_WOUT) + (size_t)l * 1024 * 1024;
  const bf16_t* Y = (const bf16_t*)(p.ws + OFF_Y);
  float* xres = (float*)(p.ws + OFF_XRES);
  const float* modl = (const float*)(p.ws + OFF_MOD) + (size_t)l * 17 * 6144;
  const float* xl = (l == 0) ? p.x : xres;
  const float* xc = (l == 0) ? p.ctx : xres + (size_t)TL * 1024;
  TileIter ti; ti.init(ntok / 128, 8);
  for (; ti.valid(); ti.next()) {
    int jt, f; ti.get(jt, f);
    gemm_tile<1>(W, Y, f, jt, xres, 1024, xl, xc, modl, lds);
  }
}
DI void phase_gemm_q(const Params& p, int l, int ntok, unsigned char* lds) {
  const bf16_t* W = (const bf16_t*)(p.ws + OFF_WQ) + (size_t)l * 1024 * 1024;
  const bf16_t* H = (const bf16_t*)(p.ws + OFF_H);
  bf16_t* QP = (bf16_t*)(p.ws + OFF_QP);
  TileIter ti; ti.init(ntok / 128, 8);
  for (; ti.valid(); ti.next()) {
    int jt, f; ti.get(jt, f);
    gemm_tile<0>(W, H, f, jt, QP, 1024, nullptr, nullptr, nullptr, lds);
  }
}

DI void phase_rope(const Params& p, unsigned char* lds) {
  float2* tab = (float2*)lds;
  for (int e = ltid(); e < 1024; e += 256) {
    const int pos = e >> 4, i = e & 15;
    const float inv = exp2f(-(float)i * (13.287712379549449f / 16.f));
    const float ang = (float)pos * inv;
    tab[e] = make_float2(__cosf(ang), __sinf(ang));
  }
  __syncthreads();
  bf16_t* PN = (bf16_t*)(p.ws + OFF_P);
  const int total = TL * 16;
  for (int idx = lbid() * 256 + ltid(); idx < total; idx += lgdim() * 256) {
    const int t = idx >> 4, vec = idx & 15;
    const int col = ((vec >> 3) ? C_DK : C_DQ) + ((vec >> 1) & 3) * 128 + (vec & 1) * 64;
    bf16_t* ptr = PN + (size_t)t * PN_LD + col;
    float xv[64];
#pragma unroll
    for (int q = 0; q < 8; ++q) { const u32x4 v = *(const u32x4*)(ptr + q * 8); unpack8(v, xv + q * 8); }
    const int row = (t & 2047) >> 6, cp = t & 63;
#pragma unroll
    for (int i = 0; i < 16; ++i) {
      const float2 cs = tab[row * 16 + i];
      const float x1 = xv[i], x2 = xv[16 + i];
      xv[i] = x1 * cs.x - x2 * cs.y; xv[16 + i] = x2 * cs.x + x1 * cs.y;
      const float2 cs2 = tab[cp * 16 + i];
      const float y1 = xv[32 + i], y2 = xv[48 + i];
      xv[32 + i] = y1 * cs2.x - y2 * cs2.y; xv[48 + i] = y2 * cs2.x + y1 * cs2.y;
    }
#pragma unroll
    for (int q = 0; q < 8; ++q) {
      u32x4 o = {pk2(xv[q * 8], xv[q * 8 + 1]), pk2(xv[q * 8 + 2], xv[q * 8 + 3]), pk2(xv[q * 8 + 4], xv[q * 8 + 5]), pk2(xv[q * 8 + 6], xv[q * 8 + 7])};
      *(u32x4*)(ptr + q * 8) = o;
    }
  }
}

struct SrcSeg {
  const bf16_t* PN; const bf16_t* VT; int kcol, vrow, t0, n0, t1, n1, lr, g;
  DI int nsteps() const { return n0 + n1; }
  DI int tok0(int st) const { return st < n0 ? t0 + st * 32 : t1 + (st - n0) * 32; }
  DI float score(float raw, int st, int kt, int r) const { return raw * SC_LOG2; }
};
struct SrcNat {
  const bf16_t* PN; const bf16_t* VT; int kcol, vrow, b, rq, rs, cs, qc, cstart, lr, g;
  const float* rpbh;
  DI int nsteps() const { return 16; }
  DI int tok0(int st) const { return st < 8 ? b * 2048 + (rs + st) * 64 + cs : TL + b * 256 + (st - 8) * 32; }
  DI float score(float raw, int st, int kt, int r) const {
    if (st >= 8) return raw * SC_LOG2;
    const int kc = cs + 8 * g + 4 * kt + r;
    const bool valid = (kc >= cstart) && (kc < cstart + 16);
    int dc = kc - qc + 15; dc = dc < 0 ? 0 : (dc > 30 ? 30 : dc);
    const float bias = rpbh[(rs + st - rq + 7) * 31 + dc];
    return valid ? (raw * 0.125f + bias) * LOG2E : NEG_BIG;
  }
};

template <class Src>
struct FlashFrags { bf16x8 k[2][2]; bf16x8 v[4]; };
template <class Src>
DI void flash_load(const Src& S, int st, FlashFrags<Src>& F) {
  const int tk = S.tok0(st);
  const int kap = 8 * (S.lr >> 2) + (S.lr & 3);
  const bf16_t* k0p = S.PN + (size_t)(tk + kap) * PN_LD + S.kcol + 8 * S.g;
  const bf16_t* vp = S.VT + (size_t)(S.vrow + S.lr) * TT + tk + 8 * S.g;
#pragma unroll
  for (int kt = 0; kt < 2; ++kt)
#pragma unroll
    for (int ks = 0; ks < 2; ++ks) F.k[kt][ks] = *(const bf16x8*)(k0p + (size_t)kt * 4 * PN_LD + ks * 32);
#pragma unroll
  for (int dt = 0; dt < 4; ++dt) F.v[dt] = *(const bf16x8*)(vp + (size_t)dt * 16 * TT);
}
template <class Src>
DI void flash_step(const Src& S, int st, const FlashFrags<Src>& F, const bf16x8 (&qf)[2], f32x4 (&o)[4], float& mrun, float& lrun) {
  f32x4 s[2];
#pragma unroll
  for (int kt = 0; kt < 2; ++kt) {
    s[kt] = (f32x4){0.f, 0.f, 0.f, 0.f};
#pragma unroll
    for (int ks = 0; ks < 2; ++ks) s[kt] = mfma16(F.k[kt][ks], qf[ks], s[kt]);
  }
  float mt = NEG_BIG;
#pragma unroll
  for (int kt = 0; kt < 2; ++kt)
#pragma unroll
    for (int r = 0; r < 4; ++r) { s[kt][r] = S.score(s[kt][r], st, kt, r); mt = fmaxf(mt, s[kt][r]); }
  mt = rows_max(mt);
  const bool need = mt > mrun + 8.f;
  if (__any(need)) {
    const float mnew = need ? mt : mrun;
    const float alpha = __builtin_amdgcn_exp2f(mrun - mnew);
    lrun *= alpha;
#pragma unroll
    for (int dt = 0; dt < 4; ++dt) { o[dt][0] *= alpha; o[dt][1] *= alpha; o[dt][2] *= alpha; o[dt][3] *= alpha; }
    mrun = mnew;
  }
  float pv[8], ls = 0.f;
#pragma unroll
  for (int kt = 0; kt < 2; ++kt)
#pragma unroll
    for (int r = 0; r < 4; ++r) { pv[kt * 4 + r] = __builtin_amdgcn_exp2f(s[kt][r] - mrun); ls += pv[kt * 4 + r]; }
  lrun += ls;
  u32x4 pk = {pk2(pv[0], pv[1]), pk2(pv[2], pv[3]), pk2(pv[4], pv[5]), pk2(pv[6], pv[7])};
  const bf16x8 pf = __builtin_bit_cast(bf16x8, pk);
#pragma unroll
  for (int dt = 0; dt < 4; ++dt) o[dt] = mfma16(F.v[dt], pf, o[dt]);
}
template <class Src>
DI void flash_wave(const Src& S, const bf16_t* qptr  , f32x4 (&o)[4], float& ltot) {
  bf16x8 qf[2];
  qf[0] = *(const bf16x8*)(qptr); qf[1] = *(const bf16x8*)(qptr + 32);
  float mrun = NEG_BIG, lrun = 0.f;
#pragma unroll
  for (int dt = 0; dt < 4; ++dt) o[dt] = (f32x4){0.f, 0.f, 0.f, 0.f};
  const int ns = S.nsteps();
  FlashFrags<Src> f0, f1, f2;
  flash_load(S, 0, f0);
  if (ns > 1) flash_load(S, 1, f1);
  for (int st = 0; st < ns; st += 3) {
    if (st + 2 < ns) flash_load(S, st + 2, f2);
    flash_step(S, st, f0, qf, o, mrun, lrun);
    if (st + 1 < ns) {
      if (st + 3 < ns) flash_load(S, st + 3, f0);
      flash_step(S, st + 1, f1, qf, o, mrun, lrun);
    }
    if (st + 2 < ns) {
      if (st + 4 < ns) flash_load(S, st + 4, f1);
      flash_step(S, st + 2, f2, qf, o, mrun, lrun);
    }
  }
  ltot = rows_sum(lrun);
}

DI void nat_wave_task(const Params& p, int l, int b, int head, int rq, int ct, const float* rpb_lds) {
  const int lane = ltid() & 63, lr = lane & 15, g = lane >> 4;
  const bf16_t* PN = (const bf16_t*)(p.ws + OFF_P);
  const bf16_t* VT = (const bf16_t*)(p.ws + OFF_VT);
  bf16_t* Y = (bf16_t*)(p.ws + OFF_Y);
  SrcNat S;
  S.PN = PN; S.VT = VT; S.kcol = C_NK + head * 64; S.vrow = R_NV + head * 64; S.b = b; S.rq = rq; S.lr = lr; S.g = g;
  int rs = rq - 4; rs = rs < 0 ? 0 : (rs > 24 ? 24 : rs);
  S.rs = rs;
  int cs = 16 * ct - 8; cs = cs < 0 ? 0 : (cs > 32 ? 32 : cs);
  S.cs = cs;
  S.qc = 16 * ct + lr;
  int cst = S.qc - 8; cst = cst < 0 ? 0 : (cst > 48 ? 48 : cst);
  S.cstart = cst;
  S.rpbh = rpb_lds + head * 465;
  f32x4 o[4];
  float lt;
  const int qtok = b * 2048 + rq * 64 + 16 * ct + lr;
  flash_wave<SrcNat>(S, PN + (size_t)qtok * PN_LD + C_NQ + head * 64 + 8 * g, o, lt);
  const float inv = 1.f / lt;
#pragma unroll
  for (int dt = 0; dt < 4; ++dt) {
    u32x2 ov = {pk2(o[dt][0] * inv, o[dt][1] * inv), pk2(o[dt][2] * inv, o[dt][3] * inv)};
    *(u32x2*)(Y + (size_t)qtok * 1024 + 256 + head * 64 + dt * 16 + 4 * g) = ov;
  }
}
DI void natctx_wave_task(const Params& p, int b, int head, int qt) {
  const int lane = ltid() & 63, lr = lane & 15, g = lane >> 4;
  const bf16_t* PN = (const bf16_t*)(p.ws + OFF_P);
  const bf16_t* VT = (const bf16_t*)(p.ws + OFF_VT);
  bf16_t* Y = (bf16_t*)(p.ws + OFF_Y);
  SrcSeg S;
  S.PN = PN; S.VT = VT; S.kcol = C_NK + head * 64; S.vrow = R_NV + head * 64; S.lr = lr; S.g = g;
  S.t0 = TL + b * 256; S.n0 = 8; S.t1 = 0; S.n1 = 0;
  f32x4 o[4];
  float lt;
  const int qtok = TL + b * 256 + qt * 16 + lr;
  flash_wave<SrcSeg>(S, PN + (size_t)qtok * PN_LD + C_NQ + head * 64 + 8 * g, o, lt);
  const float inv = 1.f / lt;
#pragma unroll
  for (int dt = 0; dt < 4; ++dt) {
    u32x2 ov = {pk2(o[dt][0] * inv, o[dt][1] * inv), pk2(o[dt][2] * inv, o[dt][3] * inv)};
    *(u32x2*)(Y + (size_t)qtok * 1024 + 256 + head * 64 + dt * 16 + 4 * g) = ov;
  }
}

DI void diff_block_task(const Params& p, int l, int b, int hd, int qtok0, int nsteps, unsigned char* lds) {
  const int tid = ltid(), lane = tid & 63, w = tid >> 6, lr = lane & 15, g = lane >> 4;
  unsigned char* Kb = lds;
  unsigned char* Vb = lds + 16384;
  unsigned char* Qb = lds + 32768;
  const bf16_t* PN = (const bf16_t*)(p.ws + OFF_P);
  const bf16_t* VT = (const bf16_t*)(p.ws + OFF_VT);
  bf16_t* Y = (bf16_t*)(p.ws + OFF_Y);

  __syncthreads();
  {
    const int row = tid >> 1, hf = tid & 1;
    const bf16_t* src = PN + (size_t)(qtok0 + row) * PN_LD + C_DQ + hd * 128 + hf * 64;
#pragma unroll
    for (int c = 0; c < 8; ++c) {
      const u32x4 v = *(const u32x4*)(src + c * 8);
      const int ch = hf * 8 + c;
      *(u32x4*)(Qb + row * 256 + ((ch ^ (row & 15)) << 4)) = v;
    }
  }
  const int wu = __builtin_amdgcn_readfirstlane(w);
  unsigned kofs[2], vofs[2];
#pragma unroll
  for (int jj = 0; jj < 2; ++jj) {
    const int krow = 4 * (2 * w + jj) + (lane >> 4), kpc = lane & 15;
    const int kch = kpc ^ (((krow >> 3) & 3) * 4 + (krow & 3));
    kofs[jj] = (unsigned)(krow * PN_LD + C_DK + hd * 128 + kch * 8);
    const int vrow = 16 * (2 * w + jj) + (lane >> 2), vpc = lane & 3;
    const int vch = vpc ^ ((vrow >> 2) & 3);
    vofs[jj] = (unsigned)((R_DV + hd * 128 + vrow) * TT + vch * 8);
  }
#define DB_DMA(st, bf) do { const int tk = (st) < 8 ? TL + b * 256 + (st) * 32 : b * 2048 + ((st) - 8) * 32; \
    const bf16_t* kb_ = PN + (size_t)tk * PN_LD; const bf16_t* vb_ = VT + tk; \
    _Pragma("unroll") for (int jj = 0; jj < 2; ++jj) { \
      __builtin_amdgcn_global_load_lds((const unsigned*)(kb_ + kofs[jj]), (unsigned*)(Kb + (bf) * 8192 + (2 * wu + jj) * 1024), 16, 0, 0); \
      __builtin_amdgcn_global_load_lds((const unsigned*)(vb_ + vofs[jj]), (unsigned*)(Vb + (bf) * 8192 + (2 * wu + jj) * 1024), 16, 0, 0); } } while (0)
  DB_DMA(0, 0);
  asm volatile("s_waitcnt vmcnt(0)" ::: "memory");
  __syncthreads();

  f32x4 o[2][2][8];
  float mrun[2][2], lrun[2][2];
#pragma unroll
  for (int m = 0; m < 2; ++m)
#pragma unroll
    for (int qt = 0; qt < 2; ++qt) {
      mrun[m][qt] = NEG_BIG; lrun[m][qt] = 0.f;
#pragma unroll
      for (int dt = 0; dt < 8; ++dt) o[m][qt][dt] = (f32x4){0.f, 0.f, 0.f, 0.f};
    }
  const int kfr = 8 * (lr >> 2) + (lr & 3);
  for (int st = 0; st < nsteps; ++st) {
    if (st + 1 < nsteps) DB_DMA(st + 1, (st + 1) & 1);
    const unsigned char* Kt = Kb + (st & 1) * 8192;
    const unsigned char* Vt = Vb + (st & 1) * 8192;
    bf16x8 pf[2][2];
#pragma unroll
    for (int m = 0; m < 2; ++m) {
      bf16x8 kf[2][2], qf[2][2];
#pragma unroll
      for (int kt = 0; kt < 2; ++kt)
#pragma unroll
        for (int ks = 0; ks < 2; ++ks) kf[kt][ks] = *(const bf16x8*)(Kt + (kfr + 4 * kt) * 256 + (((m * 8 + ks * 4 + g) ^ lr) << 4));
#pragma unroll
      for (int qt = 0; qt < 2; ++qt)
#pragma unroll
        for (int ks = 0; ks < 2; ++ks) qf[qt][ks] = *(const bf16x8*)(Qb + (32 * w + 16 * qt + lr) * 256 + (((m * 8 + ks * 4 + g) ^ lr) << 4));
      __builtin_amdgcn_sched_barrier(0);
      f32x4 s[2][2];
#pragma unroll
      for (int qt = 0; qt < 2; ++qt)
#pragma unroll
        for (int kt = 0; kt < 2; ++kt) {
          s[qt][kt] = (f32x4){0.f, 0.f, 0.f, 0.f};
#pragma unroll
          for (int ks = 0; ks < 2; ++ks) s[qt][kt] = mfma16(kf[kt][ks], qf[qt][ks], s[qt][kt]);
        }
      __builtin_amdgcn_sched_barrier(0);
#pragma unroll
      for (int qt = 0; qt < 2; ++qt) {
        float mt = NEG_BIG;
#pragma unroll
        for (int kt = 0; kt < 2; ++kt)
#pragma unroll
          for (int r = 0; r < 4; ++r) { s[qt][kt][r] *= SC_LOG2; mt = fmaxf(mt, s[qt][kt][r]); }
        mt = rows_max(mt);
        const bool need = mt > mrun[m][qt] + 8.f;
        if (__any(need)) {
          const float mnew = need ? mt : mrun[m][qt];
          const float alpha = __builtin_amdgcn_exp2f(mrun[m][qt] - mnew);
          lrun[m][qt] *= alpha;
#pragma unroll
          for (int dt = 0; dt < 8; ++dt) { o[m][qt][dt][0] *= alpha; o[m][qt][dt][1] *= alpha; o[m][qt][dt][2] *= alpha; o[m][qt][dt][3] *= alpha; }
          mrun[m][qt] = mnew;
        }
        float pv[8], ls = 0.f;
#pragma unroll
        for (int kt = 0; kt < 2; ++kt)
#pragma unroll
          for (int r = 0; r < 4; ++r) { pv[kt * 4 + r] = __builtin_amdgcn_exp2f(s[qt][kt][r] - mrun[m][qt]); ls += pv[kt * 4 + r]; }
        lrun[m][qt] += ls;
        u32x4 pk = {pk2(pv[0], pv[1]), pk2(pv[2], pv[3]), pk2(pv[4], pv[5]), pk2(pv[6], pv[7])};
        pf[m][qt] = __builtin_bit_cast(bf16x8, pk);
      }
      __builtin_amdgcn_sched_barrier(0);
    }
#pragma unroll
    for (int hb = 0; hb < 2; ++hb) {
      bf16x8 vf[4];
#pragma unroll
      for (int d4 = 0; d4 < 4; ++d4) {
        const int vr = 16 * (4 * hb + d4) + lr;
        vf[d4] = *(const bf16x8*)(Vt + vr * 64 + ((g ^ ((vr >> 2) & 3)) << 4));
      }
      __builtin_amdgcn_sched_barrier(0);
#pragma unroll
      for (int d4 = 0; d4 < 4; ++d4)
#pragma unroll
        for (int m = 0; m < 2; ++m)
#pragma unroll
          for (int qt = 0; qt < 2; ++qt) o[m][qt][4 * hb + d4] = mfma16(vf[d4], pf[m][qt], o[m][qt][4 * hb + d4]);
      __builtin_amdgcn_sched_barrier(0);
    }
    asm volatile("s_waitcnt vmcnt(0)" ::: "memory");
    __syncthreads();
  }
#undef DB_DMA
  const float* lv = p.dlam + l * 256;
  float sa = lv[lane] * lv[64 + lane], sb = lv[128 + lane] * lv[192 + lane];
  sa = wave_sum(sa); sb = wave_sum(sb);
  const float lam_init = 0.8f - 0.6f * expf(-0.3f * (float)l);
  const float lam = expf(sa) - expf(sb) + lam_init;
  const float* dg = p.diff_g + l * 512 + hd * 128;
#pragma unroll
  for (int qt = 0; qt < 2; ++qt) {
    float l0 = lrun[0][qt], l1 = lrun[1][qt];
    l0 = rows_sum(l0);
    l1 = rows_sum(l1);
    const float i0 = 1.f / l0, i1 = lam / l1;
    float ss = 0.f;
#pragma unroll
    for (int dt = 0; dt < 8; ++dt)
#pragma unroll
      for (int r = 0; r < 4; ++r) { const float v = o[0][qt][dt][r] * i0 - o[1][qt][dt][r] * i1; o[0][qt][dt][r] = v; ss += v * v; }
    ss = rows_sum(ss);
    const float rstd = rsqrtf(ss * (1.f / 128.f) + 1e-6f) * (1.f - lam_init);
    const int qtok = qtok0 + 32 * w + 16 * qt + lr;
#pragma unroll
    for (int dt = 0; dt < 8; ++dt) {
      const float4 gg = *(const float4*)(dg + dt * 16 + 4 * g);
      u32x2 ov = {pk2(o[0][qt][dt][0] * rstd * gg.x, o[0][qt][dt][1] * rstd * gg.y), pk2(o[0][qt][dt][2] * rstd * gg.z, o[0][qt][dt][3] * rstd * gg.w)};
      *(u32x2*)(Y + (size_t)qtok * 1024 + 512 + hd * 128 + dt * 16 + 4 * g) = ov;
    }
  }
}


DI void nat_block_task(const Params& p, int l, int b, int head, int rq, const float* rpb_lds, unsigned char* lds) {
  const int tid = ltid(), lane = tid & 63, w = tid >> 6, lr = lane & 15, g = lane >> 4;
  const int wu = __builtin_amdgcn_readfirstlane(w);
  unsigned char* Kb = lds;
  unsigned char* Vb = lds + 16384;
  const bf16_t* PN = (const bf16_t*)(p.ws + OFF_P);
  const bf16_t* VT = (const bf16_t*)(p.ws + OFF_VT);
  bf16_t* Y = (bf16_t*)(p.ws + OFF_Y);
  int rs = rq - 4; rs = rs < 0 ? 0 : (rs > 24 ? 24 : rs);
  const int ct = w;
  int cs = 16 * ct - 8; cs = cs < 0 ? 0 : (cs > 32 ? 32 : cs);
  const int qc = 16 * ct + lr;
  int cstart = qc - 8; cstart = cstart < 0 ? 0 : (cstart > 48 ? 48 : cstart);
  const float* rpbh = rpb_lds + head * 465;
  const int qtok = b * 2048 + rq * 64 + qc;
  bf16x8 qf[2];
  { const bf16_t* qp = PN + (size_t)qtok * PN_LD + C_NQ + head * 64 + 8 * g; qf[0] = *(const bf16x8*)qp; qf[1] = *(const bf16x8*)(qp + 32); }
  unsigned kofs[2], vofs[2];
#pragma unroll
  for (int jj = 0; jj < 2; ++jj) {
    const int pidx = 2 * w + jj, row = 8 * pidx + (lane >> 3);
    const int kch = (lane & 7) ^ ((((row >> 3) & 3) << 1) | ((row >> 1) & 1));
    kofs[jj] = (unsigned)(row * PN_LD + C_NK + head * 64 + kch * 8);
    const int vch = (lane & 7) ^ ((row >> 1) & 7);
    vofs[jj] = (unsigned)((R_NV + head * 64 + row) * TT + vch * 8);
  }
#define NB_DMA(st, bf) do { const int tk = (st) < 8 ? b * 2048 + (rs + (st)) * 64 : TL + b * 256 + ((st) - 8) * 64; \
    const bf16_t* kb_ = PN + (size_t)tk * PN_LD; const bf16_t* vb_ = VT + tk; \
    _Pragma("unroll") for (int jj = 0; jj < 2; ++jj) { \
      __builtin_amdgcn_global_load_lds((const unsigned*)(kb_ + kofs[jj]), (unsigned*)(Kb + (bf) * 8192 + (2 * wu + jj) * 1024), 16, 0, 0); \
      __builtin_amdgcn_global_load_lds((const unsigned*)(vb_ + vofs[jj]), (unsigned*)(Vb + (bf) * 8192 + (2 * wu + jj) * 1024), 16, 0, 0); } } while (0)
  __syncthreads();
  NB_DMA(0, 0);
  asm volatile("s_waitcnt vmcnt(0)" ::: "memory");
  __syncthreads();
  f32x4 o[4];
#pragma unroll
  for (int dt = 0; dt < 4; ++dt) o[dt] = (f32x4){0.f, 0.f, 0.f, 0.f};
  float mrun = NEG_BIG, lrun = 0.f;
  const int kap = 8 * (lr >> 2) + (lr & 3);
  for (int st = 0; st < 12; ++st) {
    if (st + 1 < 12) NB_DMA(st + 1, (st + 1) & 1);
    const unsigned char* Kt = Kb + (st & 1) * 8192;
    const unsigned char* Vt = Vb + (st & 1) * 8192;
    const int nsub = st < 8 ? 1 : 2;
    for (int sub = 0; sub < nsub; ++sub) {
      const int koff = st < 8 ? cs : 32 * sub;
      bf16x8 kf[2][2], vf[4];
#pragma unroll
      for (int kt = 0; kt < 2; ++kt) {
        const int row = koff + kap + 4 * kt;
        const int sw = (((row >> 3) & 3) << 1) | ((row >> 1) & 1);
#pragma unroll
        for (int ks = 0; ks < 2; ++ks) kf[kt][ks] = *(const bf16x8*)(Kt + (row >> 1) * 256 + ((((row & 1) << 3) | ((ks * 4 + g) ^ sw)) << 4));
      }
#pragma unroll
      for (int dt = 0; dt < 4; ++dt) {
        const int row = 16 * dt + lr, ch = (koff >> 3) + g;
        vf[dt] = *(const bf16x8*)(Vt + (row >> 1) * 256 + (((((row & 1) << 3) | ch) ^ ((row >> 1) & 7)) << 4));
      }
      f32x4 s[2];
#pragma unroll
      for (int kt = 0; kt < 2; ++kt) {
        s[kt] = (f32x4){0.f, 0.f, 0.f, 0.f};
#pragma unroll
        for (int ks = 0; ks < 2; ++ks) s[kt] = mfma16(kf[kt][ks], qf[ks], s[kt]);
      }
      float mt = NEG_BIG;
#pragma unroll
      for (int kt = 0; kt < 2; ++kt)
#pragma unroll
        for (int r = 0; r < 4; ++r) {
          float sv;
          if (st < 8) {
            const int kc = cs + 8 * g + 4 * kt + r;
            const bool valid = (kc >= cstart) && (kc < cstart + 16);
            int dc = kc - qc + 15; dc = dc < 0 ? 0 : (dc > 30 ? 30 : dc);
            const float bias = rpbh[(rs + st - rq + 7) * 31 + dc];
            sv = valid ? (s[kt][r] * 0.125f + bias) * LOG2E : NEG_BIG;
          } else sv = s[kt][r] * SC_LOG2;
          s[kt][r] = sv; mt = fmaxf(mt, sv);
        }
      mt = rows_max(mt);
      const bool need = mt > mrun + 8.f;
      if (__any(need)) {
        const float mnew = need ? mt : mrun;
        const float alpha = __builtin_amdgcn_exp2f(mrun - mnew);
        lrun *= alpha;
#pragma unroll
        for (int dt = 0; dt < 4; ++dt) { o[dt][0] *= alpha; o[dt][1] *= alpha; o[dt][2] *= alpha; o[dt][3] *= alpha; }
        mrun = mnew;
      }
      float pv[8], ls = 0.f;
#pragma unroll
      for (int kt = 0; kt < 2; ++kt)
#pragma unroll
        for (int r = 0; r < 4; ++r) { pv[kt * 4 + r] = __builtin_amdgcn_exp2f(s[kt][r] - mrun); ls += pv[kt * 4 + r]; }
      lrun += ls;
      u32x4 pk = {pk2(pv[0], pv[1]), pk2(pv[2], pv[3]), pk2(pv[4], pv[5]), pk2(pv[6], pv[7])};
      const bf16x8 pf = __builtin_bit_cast(bf16x8, pk);
#pragma unroll
      for (int dt = 0; dt < 4; ++dt) o[dt] = mfma16(vf[dt], pf, o[dt]);
    }
    asm volatile("s_waitcnt vmcnt(0)" ::: "memory");
    __syncthreads();
  }
#undef NB_DMA
  const float inv = 1.f / rows_sum(lrun);
#pragma unroll
  for (int dt = 0; dt < 4; ++dt) {
    u32x2 ov = {pk2(o[dt][0] * inv, o[dt][1] * inv), pk2(o[dt][2] * inv, o[dt][3] * inv)};
    *(u32x2*)(Y + (size_t)qtok * 1024 + 256 + head * 64 + dt * 16 + 4 * g) = ov;
  }
}

DI float quad_sum(float v) {
  v += __int_as_float(__builtin_amdgcn_mov_dpp(__float_as_int(v), 0xB1, 0xF, 0xF, true));
  v += __int_as_float(__builtin_amdgcn_mov_dpp(__float_as_int(v), 0x4E, 0xF, 0xF, true));
  return v;
}
DI void gla_task(const Params& p, int l, int task, unsigned char* lds, int var = 0) {
  const int tid = ltid(), lane = tid & 63, w = tid >> 6, vv = lane >> 2, g = lane & 3;
  const int b = task >> 3, h = (task >> 1) & 3, dir = task & 1;
  const bf16_t* PN = (const bf16_t*)(p.ws + OFF_P);
  const bf16_t* VT = (const bf16_t*)(p.ws + OFF_VT);
  float* og = (float*)(p.ws + OFF_H);
  float* Gup = (float*)lds;
  float* Gb = Gup + 512;
  float* As = Gb + 32;
  float* Ks = As + 2048;
  float* Qs = Ks + 2048;
  float* Vs = Qs + 2048;
  __syncthreads();
  for (int e = tid; e < 512; e += 256) { const int r = e >> 5, kd = e & 31; Gup[e] = p.gate_up[((size_t)(l * 2 + dir) * 16 + r) * 128 + h * 32 + kd]; }
  if (tid < 32) Gb[tid] = p.gate_b[(l * 2 + dir) * 128 + h * 32 + tid];
  float S[8];
#pragma unroll
  for (int e = 0; e < 8; ++e) S[e] = 0.f;
  const int si = tid >> 2, part = tid & 3;
  u32x4 rq, rk, rg0, rg1, rv0, rv1;
#define GLA_TOK0(cc) ((cc) < 4 ? TL + b * 256 + (dir == 0 ? (cc) : 3 - (cc)) * 64 : b * 2048 + (dir == 0 ? (cc) - 4 : 35 - (cc)) * 64)
#define GLA_LOAD(cc) do { const int t0_ = GLA_TOK0(cc); const bf16_t* row = PN + (size_t)(t0_ + si) * PN_LD; \
    rq = *(const u32x4*)(row + C_GQ + h * 32 + part * 8); rk = *(const u32x4*)(row + C_GK + h * 32 + part * 8); \
    rg0 = *(const u32x4*)(row + C_GATE + dir * 16); rg1 = *(const u32x4*)(row + C_GATE + dir * 16 + 8); \
    const bf16_t* vp = VT + (size_t)(R_GV + h * 64 + si) * TT + t0_ + part * 16; rv0 = *(const u32x4*)vp; rv1 = *(const u32x4*)(vp + 8); } while (0)
#define GLA_WRITE() do { float gd[16], qf[8], kf[8], vf[16]; \
    unpack8(rg0, gd); unpack8(rg1, gd + 8); unpack8(rq, qf); unpack8(rk, kf); unpack8(rv0, vf); unpack8(rv1, vf + 8); \
    _Pragma("unroll") for (int e = 0; e < 8; ++e) { const int kd = part * 8 + e; float pre = Gb[kd]; \
      _Pragma("unroll") for (int r = 0; r < 16; ++r) pre += gd[r] * Gup[r * 32 + kd]; \
      const float ls = fminf(pre, 0.f) - log1pf(__expf(-fabsf(pre))); \
      As[si * 32 + kd] = __expf(ls * (1.f / 16.f)); Ks[si * 32 + kd] = kf[e]; Qs[si * 32 + kd] = qf[e] * 0.17677669529663687f; } \
    _Pragma("unroll") for (int e = 0; e < 16; ++e) Vs[(part * 16 + e) * 65 + si] = vf[e]; } while (0)
  GLA_LOAD(0);
  __syncthreads();
  GLA_WRITE();
  __syncthreads();
  for (int cc = 0; cc < 36; ++cc) {
    const int tok0 = GLA_TOK0(cc);
    if (cc + 1 < 36) GLA_LOAD(cc + 1);
    float* ob = og + ((size_t)dir * TT + tok0) * 256 + h * 64 + 16 * w + vv;
#pragma unroll 1
    for (int s0 = 0; s0 < (var == 3 ? 4 : 64); s0 += 4) {
      float4 a0[4], a1[4], k0[4], k1[4], q0[4], q1[4];
      float vx[4];
#pragma unroll
      for (int u = 0; u < 4; ++u) {
        const int i = dir == 0 ? s0 + u : 63 - s0 - u;
        a0[u] = *(const float4*)(As + i * 32 + 8 * g); a1[u] = *(const float4*)(As + i * 32 + 8 * g + 4);
        k0[u] = *(const float4*)(Ks + i * 32 + 8 * g); k1[u] = *(const float4*)(Ks + i * 32 + 8 * g + 4);
        q0[u] = *(const float4*)(Qs + i * 32 + 8 * g); q1[u] = *(const float4*)(Qs + i * 32 + 8 * g + 4);
        vx[u] = Vs[i * 65 + 16 * w + vv];
      }
#pragma unroll
      for (int u = 0; u < 4; ++u) {
        const int i = dir == 0 ? s0 + u : 63 - s0 - u;
        const float v = vx[u];
        S[0] = fmaf(a0[u].x, S[0], k0[u].x * v); S[1] = fmaf(a0[u].y, S[1], k0[u].y * v);
        S[2] = fmaf(a0[u].z, S[2], k0[u].z * v); S[3] = fmaf(a0[u].w, S[3], k0[u].w * v);
        S[4] = fmaf(a1[u].x, S[4], k1[u].x * v); S[5] = fmaf(a1[u].y, S[5], k1[u].y * v);
        S[6] = fmaf(a1[u].z, S[6], k1[u].z * v); S[7] = fmaf(a1[u].w, S[7], k1[u].w * v);
        const float oa = fmaf(q0[u].x, S[0], q0[u].y * S[1]), ob2 = fmaf(q0[u].z, S[2], q0[u].w * S[3]);
        const float oc = fmaf(q1[u].x, S[4], q1[u].y * S[5]), od = fmaf(q1[u].z, S[6], q1[u].w * S[7]);
        float o = (oa + ob2) + (oc + od);
        o = quad_sum(o);
        if (var == 1) asm volatile("" :: "v"(o)); else if (g == 0) ob[(size_t)i * 256] = o;
      }
    }
    __syncthreads();
    if (cc + 1 < 36 && var != 2) GLA_WRITE();
    __syncthreads();
  }
#undef GLA_TOK0
#undef GLA_LOAD
#undef GLA_WRITE
}

DI void phase_mixers(const Params& p, int l, bool last, unsigned* ctr, unsigned char* lds, int mask = 15, int gvar = 0) {
  const int tid = ltid(), w = tid >> 6;
  volatile int* slot = (volatile int*)(lds + LDS_BYTES - 16);
  float* rpb_lds = (float*)(lds + 65536);
  for (int e = tid; e < 4 * 465; e += 256) rpb_lds[e] = p.rpb[(size_t)l * 4 * 465 + e];
  const int nconv = (l == 0 && (mask & 8)) ? 1024 : 0;
  const int t1 = 128 + nconv, t2 = t1 + 1024, t3 = t2 + 2048, t4 = t3 + 128;
  const int ntask = last ? t3 : t4 + 256;
  for (;;) {
    __syncthreads();
    if (tid == 0) *slot = (int)atomicAdd(ctr, 1u);
    __syncthreads();
    const int task = *slot;
    if (task >= ntask) break;
    if (task < 128) { if (mask & 1) { __builtin_amdgcn_s_setprio(3); gla_task(p, l, task, lds, gvar); __builtin_amdgcn_s_setprio(0); } }
    else if (nconv && task < t2 && ((task - 128) & 1)) { const int c = (task - 128) >> 1; convert_table_pairs(p, c * 64, c * 64 + 64, w, 4, tid & 63); }
    else if (!(mask & 2) && (task < t2 || (task >= t3 && task < t4))) {}
    else if (!(mask & 4) && ((task >= t2 && task < t3) || task >= t4)) {}
    else if (task < t2) { const int d = nconv ? (task - 128) >> 1 : task - 128; const int b = d >> 6; diff_block_task(p, l, b, (d >> 4) & 3, b * 2048 + (d & 15) * 128, 72, lds); }
    else if (task < t3) { const int d = task - t2; nat_block_task(p, l, d >> 7, (d >> 5) & 3, d & 31, rpb_lds, lds); }
    else if (task < t4) { const int d = task - t3; const int b = d >> 3; diff_block_task(p, l, b, (d >> 1) & 3, TL + b * 256 + (d & 1) * 128, 8, lds); }
    else { const int wt = (task - t4) * 4 + w; natctx_wave_task(p, wt >> 6, (wt >> 4) & 3, wt & 15); }
  }
}

DI void phase_gla_fin(const Params& p, int l, int ntok) {
  const int lane = ltid() & 63, gw = lbid() * 4 + (ltid() >> 6), nw = lgdim() * 4;
  const float* og = (const float*)(p.ws + OFF_H);
  const bf16_t* PN = (const bf16_t*)(p.ws + OFF_P);
  bf16_t* Y = (bf16_t*)(p.ws + OFF_Y);
  const float4 gg = *(const float4*)(p.gla_norm_g + l * 256 + 4 * lane);
  for (int t = gw; t < ntok; t += nw) {
    const float4 a = *(const float4*)(og + (size_t)t * 256 + 4 * lane), bq = *(const float4*)(og + ((size_t)TT + t) * 256 + 4 * lane);
    const float o0 = a.x + bq.x, o1 = a.y + bq.y, o2 = a.z + bq.z, o3 = a.w + bq.w;
    float ss = o0 * o0 + o1 * o1 + o2 * o2 + o3 * o3;
    ss += __shfl_xor(ss, 1); ss += __shfl_xor(ss, 2); ss += __shfl_xor(ss, 4); ss += __shfl_xor(ss, 8);
    const float rstd = rsqrtf(ss * (1.f / 64.f) + 1e-6f);
    const u32x2 rv = *(const u32x2*)(PN + (size_t)t * PN_LD + C_GR + 4 * lane);
    const float r0 = bflo(rv.x), r1 = bfhi(rv.x), r2 = bflo(rv.y), r3 = bfhi(rv.y);
    const float y0 = o0 * rstd * gg.x * (r0 / (1.f + __expf(-r0)));
    const float y1 = o1 * rstd * gg.y * (r1 / (1.f + __expf(-r1)));
    const float y2 = o2 * rstd * gg.z * (r2 / (1.f + __expf(-r2)));
    const float y3 = o3 * rstd * gg.w * (r3 / (1.f + __expf(-r3)));
    u32x2 ov = {pk2(y0, y1), pk2(y2, y3)};
    *(u32x2*)(Y + (size_t)t * 1024 + 4 * lane) = ov;
  }
}

struct PairTab { int a[52], b[52]; };
constexpr PairTab make_pairs() {
  PairTab t{};
  int n = 0;
  for (int a = 0; a < 16; ++a)
    for (int b = 0; b < 16; ++b)
      if ((a + 1) * (b + 1) <= 16) { t.a[n] = a; t.b[n] = b; ++n; }
  for (; n < 52; ++n) { t.a[n] = -1; t.b[n] = -1; }
  return t;
}

DI void topk_half(const bf16_t* skh  , const bf16_t* qrow  , int lr, int g, float (&list)[16]) {
  bf16x8 qf[2];
  qf[0] = *(const bf16x8*)(qrow); qf[1] = *(const bf16x8*)(qrow + 32);
  float s[32];
#pragma unroll
  for (int nt = 0; nt < 8; ++nt) {
    f32x4 acc = {0.f, 0.f, 0.f, 0.f};
#pragma unroll
    for (int ks = 0; ks < 2; ++ks) {
      const bf16x8 af = *(const bf16x8*)(skh + (size_t)(nt * 16 + lr) * 64 + ks * 32 + 8 * g);
      acc = mfma16(af, qf[ks], acc);
    }
#pragma unroll
    for (int r = 0; r < 4; ++r) {
      const unsigned n = nt * 16 + 4 * g + r;
      s[nt * 4 + r] = __uint_as_float((__float_as_uint(acc[r]) & ~127u) | n);
    }
  }
#pragma unroll
  for (int k = 0; k < 16; ++k) {
    float m = s[0];
#pragma unroll
    for (int i = 1; i < 32; ++i) m = fmaxf(m, s[i]);
    m = fmaxf(m, __shfl_xor(m, 16));
    m = fmaxf(m, __shfl_xor(m, 32));
    list[k] = m;
#pragma unroll
    for (int i = 0; i < 32; ++i) s[i] = (s[i] == m) ? -3.0e38f : s[i];
  }
}

DI void phase_topk(const Params& p, int l, int ntok) {
  constexpr PairTab PT = make_pairs();
  const int lane = ltid() & 63, lr = lane & 15, g = lane >> 4;
  const int gw = lbid() * 4 + (ltid() >> 6), nw = lgdim() * 4;
  const bf16_t* QP = (const bf16_t*)(p.ws + OFF_QP);
  const bf16_t* sk = (const bf16_t*)(p.ws + OFF_SK) + (size_t)l * 2 * 128 * 64;
  int* eid = (int*)(p.ws + OFF_EID);
  float* gate = (float*)(p.ws + OFF_GATE);
  const int ntask = (ntok / 16) * 8;
  for (int task = gw; task < ntask; task += nw) {
    const int tt = task >> 3, hd = task & 7;
    const int tok = tt * 16 + lr;
    float v1[16], v2[16];
    topk_half(sk, QP + (size_t)tok * 1024 + hd * 128 + 8 * g, lr, g, v1);
    topk_half(sk + 128 * 64, QP + (size_t)tok * 1024 + hd * 128 + 64 + 8 * g, lr, g, v2);
    float cand[13];
    int ceid[13];
#pragma unroll
    for (int c = 0; c < 13; ++c) {
      float sv[4];
      int ev[4];
#pragma unroll
      for (int gi = 0; gi < 4; ++gi) {
        const int pi = 4 * c + gi;
        if (PT.a[pi] >= 0) {
          const float a = v1[PT.a[pi] < 0 ? 0 : PT.a[pi]], bq = v2[PT.b[pi] < 0 ? 0 : PT.b[pi]];
          sv[gi] = __uint_as_float((__float_as_uint(a + bq) & ~63u) | (unsigned)pi);
          ev[gi] = (int)((__float_as_uint(a) & 127u) * 128u + (__float_as_uint(bq) & 127u));
        } else { sv[gi] = -3.0e38f; ev[gi] = 0; }
      }
      cand[c] = g == 0 ? sv[0] : (g == 1 ? sv[1] : (g == 2 ? sv[2] : sv[3]));
      ceid[c] = g == 0 ? ev[0] : (g == 1 ? ev[1] : (g == 2 ? ev[2] : ev[3]));
    }
    float topv[16];
#pragma unroll
    for (int k = 0; k < 16; ++k) {
      float m = cand[0];
#pragma unroll
      for (int c = 1; c < 13; ++c) m = fmaxf(m, cand[c]);
      m = fmaxf(m, __shfl_xor(m, 16));
      m = fmaxf(m, __shfl_xor(m, 32));
      topv[k] = m;
      int my = -1;
#pragma unroll
      for (int c = 0; c < 13; ++c) { if (cand[c] == m) { my = ceid[c]; cand[c] = -3.0e38f; } }
      if (my >= 0) eid[(size_t)tok * 128 + hd * 16 + k] = my;
    }
    if (g == 0) {
      float ex[16], sum = 0.f;
#pragma unroll
      for (int k = 0; k < 16; ++k) { ex[k] = __expf(topv[k] - topv[0]); sum += ex[k]; }
      const float inv = 1.f / sum;
#pragma unroll
      for (int q = 0; q < 4; ++q) {
        float4 o = {ex[4 * q] * inv, ex[4 * q + 1] * inv, ex[4 * q + 2] * inv, ex[4 * q + 3] * inv};
        *(float4*)(gate + (size_t)tok * 128 + hd * 16 + 4 * q) = o;
      }
    }
  }
}

DI float gelu_tanh(float x) {
  const float z = 0.7978845608028654f * (x + 0.044715f * x * x * x);
  const float e = __expf(2.f * z);
  const float th = 1.f - 2.f / (e + 1.f);
  return 0.5f * x * (1.f + th);
}
DI void phase_gather(const Params& p, int l, int ntok, unsigned char* lds, bool dry = false) {
  const int tid = ltid(), lane = tid & 63, w = tid >> 6, lr = lane & 15, g = lane >> 4;
  const int gw = lbid() * 4 + w, nw = lgdim() * 4;
  const unsigned char* U6 = p.ws + OFF_U + (size_t)l * 16384 * V6_PITCH;
  const unsigned char* V6 = p.ws + OFF_V + (size_t)l * 16384 * V6_PITCH;
  const int half = lane >> 5, blk = lane & 31;
  const unsigned char* H6 = p.ws + OFF_H8;
  const int* eid = (const int*)(p.ws + OFF_EID);
  const float* gate = (const float*)(p.ws + OFF_GATE);
  float* xres = (float*)(p.ws + OFF_XRES);
  const float* modbuf = (const float*)(p.ws + OFF_MOD);
  unsigned char* hl = lds + w * 2048;
  float* wl = (float*)(lds + w * 2048 + 1024);
  for (int t = gw; t < ntok; t += nw) {
    if (lane < 50) {
      const u32x4 hq = *(const u32x4*)(H6 + (size_t)t * V6_PITCH + lane * 16);
      *(u32x4*)(hl + lane * 16) = hq;
    }
    const int e0 = eid[(size_t)t * 128 + lane], e1 = eid[(size_t)t * 128 + 64 + lane];
    const float gv0 = gate[(size_t)t * 128 + lane], gv1 = gate[(size_t)t * 128 + 64 + lane];
    {
      const u32x2 hsc = *(const u32x2*)(hl + 768 + 8 * g);
#pragma unroll 1
      for (int grp = 0; grp < 8; ++grp) {
        const int er = __shfl(grp < 4 ? e0 : e1, (grp & 3) * 16 + lr);
        const unsigned char* ur = U6 + (size_t)er * V6_PITCH;
        u32x4 ua[8]; u32x2 ub[8];
#pragma unroll
        for (int s = 0; s < 8; ++s) { ua[s] = *(const u32x4*)(ur + 24 * (4 * s + g)); ub[s] = *(const u32x2*)(ur + 24 * (4 * s + g) + 16); }
        const u32x2 usc = *(const u32x2*)(ur + 768 + 8 * g);
        __builtin_amdgcn_sched_barrier(0);
        f32x4 acc = {0.f, 0.f, 0.f, 0.f};
#define G_STEP(s, OS, USC, HSC) do { const unsigned char* hb = hl + 24 * (4 * (s) + g); \
          const u32x2 h0 = *(const u32x2*)hb, h1 = *(const u32x2*)(hb + 8), h2v = *(const u32x2*)(hb + 16); \
          const i32x8 av = {(int)ua[s][0], (int)ua[s][1], (int)ua[s][2], (int)ua[s][3], (int)ub[s][0], (int)ub[s][1], 0, 0}; \
          const i32x8 bv = {(int)h0[0], (int)h0[1], (int)h1[0], (int)h1[1], (int)h2v[0], (int)h2v[1], 0, 0}; \
          acc = __builtin_amdgcn_mfma_scale_f32_16x16x128_f8f6f4(av, bv, acc, 2, 2, OS, (int)(USC), OS, (int)(HSC)); } while (0)
        G_STEP(0, 0, usc[0], hsc[0]); G_STEP(1, 1, usc[0], hsc[0]); G_STEP(2, 2, usc[0], hsc[0]); G_STEP(3, 3, usc[0], hsc[0]);
        G_STEP(4, 0, usc[1], hsc[1]); G_STEP(5, 1, usc[1], hsc[1]); G_STEP(6, 2, usc[1], hsc[1]); G_STEP(7, 3, usc[1], hsc[1]);
#undef G_STEP
        const float gvs = grp < 4 ? gv0 : gv1;
        const int lb_ = (grp & 3) * 16 + 4 * g;
        float4 wv_;
        wv_.x = __shfl(gvs, lb_) * gelu_tanh(acc[0]); wv_.y = __shfl(gvs, lb_ + 1) * gelu_tanh(acc[1]);
        wv_.z = __shfl(gvs, lb_ + 2) * gelu_tanh(acc[2]); wv_.w = __shfl(gvs, lb_ + 3) * gelu_tanh(acc[3]);
        if (lr == 0) *(float4*)(wl + grp * 16 + 4 * g) = wv_;
        __builtin_amdgcn_sched_barrier(0);
      }
    }
    __builtin_amdgcn_sched_barrier(0);
    float out[32];
#pragma unroll
    for (int i = 0; i < 32; ++i) out[i] = 0.f;
#pragma unroll 1
    for (int grp = 0; grp < 8; ++grp) {
      const int esel = grp < 4 ? e0 : e1;
      const int lb = (grp & 3) * 16;
      u32x4 vd4[8]; u32x2 vd2[8]; unsigned vsc[8];
#pragma unroll
      for (int pp = 0; pp < 8; ++pp) {
        const int ea = __builtin_amdgcn_readlane(esel, lb + 2 * pp), eb = __builtin_amdgcn_readlane(esel, lb + 2 * pp + 1);
        const unsigned char* vr = V6 + (size_t)(half ? eb : ea) * V6_PITCH;
        vd4[pp] = *(const u32x4*)(vr + 24 * blk); vd2[pp] = *(const u32x2*)(vr + 24 * blk + 16); vsc[pp] = vr[mx_scale_pos(blk)];
      }
      __builtin_amdgcn_sched_barrier(0);
#pragma unroll
      for (int pp = 0; pp < 8; ++pp) {
        const float wgt = wl[grp * 16 + 2 * pp + half] * __uint_as_float(vsc[pp] << 23);
        unsigned pk0 = vd4[pp][0], pk1 = vd4[pp][1];
        asm volatile("" : "+v"(pk0) : "v"(out[0]), "v"(out[1]), "v"(out[2]), "v"(out[3]), "v"(out[4]), "v"(out[5]), "v"(out[6]), "v"(out[7]),
                     "v"(out[8]), "v"(out[9]), "v"(out[10]), "v"(out[11]), "v"(out[12]), "v"(out[13]), "v"(out[14]), "v"(out[15]));
        asm volatile("" : "+v"(pk1) : "v"(out[16]), "v"(out[17]), "v"(out[18]), "v"(out[19]), "v"(out[20]), "v"(out[21]), "v"(out[22]), "v"(out[23]),
                     "v"(out[24]), "v"(out[25]), "v"(out[26]), "v"(out[27]), "v"(out[28]), "v"(out[29]), "v"(out[30]), "v"(out[31]));
        const u32x6 pk = {pk0, pk1, vd4[pp][2], vd4[pp][3], vd2[pp][0], vd2[pp][1]};
        const f32x32 vals = __builtin_amdgcn_cvt_scalef32_pk32_f32_fp6(pk, 1.0f);
#pragma unroll
        for (int i = 0; i < 32; ++i) out[i] += wgt * vals[i];
        __builtin_amdgcn_sched_barrier(0);
      }
    }
    float o16[16];
#pragma unroll
    for (int i = 0; i < 16; ++i) {
      const u32x2 s0 = __builtin_amdgcn_permlane32_swap(__float_as_uint(out[i]), __float_as_uint(out[i]), false, false);
      const u32x2 s1 = __builtin_amdgcn_permlane32_swap(__float_as_uint(out[16 + i]), __float_as_uint(out[16 + i]), false, false);
      const float t0 = __uint_as_float(s0[0]) + __uint_as_float(s0[1]), t1 = __uint_as_float(s1[0]) + __uint_as_float(s1[1]);
      o16[i] = half ? t1 : t0;
    }
    const int cb = 32 * blk + 16 * half;
    const int b = t < TL ? (t >> 11) : 16;
    const float* md = modbuf + ((size_t)l * 17 + b) * 6144 + 5 * 1024 + cb;
    float* xr = xres + (size_t)t * 1024 + cb;
    float xn[16];
    float ss = 0.f;
#pragma unroll
    for (int q = 0; q < 4; ++q) {
      const float4 m4 = *(const float4*)(md + 4 * q);
      float4 xv = *(const float4*)(xr + 4 * q);
      xv.x += m4.x * o16[4 * q + 0]; xv.y += m4.y * o16[4 * q + 1]; xv.z += m4.z * o16[4 * q + 2]; xv.w += m4.w * o16[4 * q + 3];
      xn[4 * q] = xv.x; xn[4 * q + 1] = xv.y; xn[4 * q + 2] = xv.z; xn[4 * q + 3] = xv.w;
      ss += xv.x * xv.x + xv.y * xv.y + xv.z * xv.z + xv.w * xv.w;
      if (dry) asm volatile("" :: "v"(xv.x), "v"(xv.y), "v"(xv.z), "v"(xv.w));
      else if (l < NL - 1) *(float4*)(xr + 4 * q) = xv;
    }
    if (!dry) {
      ss = wave_sum(ss);
      const float rstd = rsqrtf(ss * (1.f / 1024.f) + 1e-6f);
      if (l == NL - 1) {
        const float* fg = p.final_g + cb;
        float* orow = p.out + (size_t)t * 1024 + cb;
#pragma unroll
        for (int q = 0; q < 4; ++q) {
          const float4 g4 = *(const float4*)(fg + 4 * q);
          float4 o = {xn[4 * q] * rstd * g4.x, xn[4 * q + 1] * rstd * g4.y, xn[4 * q + 2] * rstd * g4.z, xn[4 * q + 3] * rstd * g4.w};
          *(float4*)(orow + 4 * q) = o;
        }
      } else {
        const float* gvec = p.norm1_g + (l + 1) * 1024 + cb;
        const float* mdn = modbuf + ((size_t)(l + 1) * 17 + b) * 6144 + cb;
        bf16_t* hrow = (bf16_t*)(p.ws + OFF_H) + (size_t)t * 1024 + cb;
        unsigned pk[8];
#pragma unroll
        for (int q = 0; q < 4; ++q) {
          const float4 g4 = *(const float4*)(gvec + 4 * q), sh = *(const float4*)(mdn + 4 * q), sc = *(const float4*)(mdn + 1024 + 4 * q);
          const float o0 = xn[4 * q] * rstd * g4.x * (1.f + sc.x) + sh.x, o1 = xn[4 * q + 1] * rstd * g4.y * (1.f + sc.y) + sh.y;
          const float o2 = xn[4 * q + 2] * rstd * g4.z * (1.f + sc.z) + sh.z, o3 = xn[4 * q + 3] * rstd * g4.w * (1.f + sc.w) + sh.w;
          pk[2 * q] = pk2(o0, o1); pk[2 * q + 1] = pk2(o2, o3);
        }
        *(u32x4*)hrow = (u32x4){pk[0], pk[1], pk[2], pk[3]};
        *(u32x4*)(hrow + 8) = (u32x4){pk[4], pk[5], pk[6], pk[7]};
      }
    }
  }
}

DI void phase_final(const Params& p) {
  const int lane = ltid() & 63, gw = lbid() * 4 + (ltid() >> 6), nw = lgdim() * 4;
  const float* xres = (const float*)(p.ws + OFF_XRES);
  for (int t = gw; t < TL; t += nw) {
    const float* src = xres + (size_t)t * 1024;
    float4 v[4];
    float ss = 0.f;
#pragma unroll
    for (int i = 0; i < 4; ++i) {
      v[i] = *(const float4*)(src + 4 * lane + 256 * i);
      ss += v[i].x * v[i].x + v[i].y * v[i].y + v[i].z * v[i].z + v[i].w * v[i].w;
    }
    ss = wave_sum(ss);
    const float rstd = rsqrtf(ss * (1.f / 1024.f) + 1e-6f);
#pragma unroll
    for (int i = 0; i < 4; ++i) {
      const int col = 4 * lane + 256 * i;
      const float4 g4 = *(const float4*)(p.final_g + col);
      float4 o = {v[i].x * rstd * g4.x, v[i].y * rstd * g4.y, v[i].z * rstd * g4.z, v[i].w * rstd * g4.w};
      *(float4*)(p.out + (size_t)t * 1024 + col) = o;
    }
  }
}


#define LAS __attribute__((address_space(3)))
#define XB_TMO      128
#define XB_XCNT(j)  (256  + 64 * (j))
#define XB_XSUB(j)  (1280 + 64 * (j))
#define XB_XGEN(j)  (2304 + 64 * (j))
#define XB_TOP      3328
#define XB_TOPGEN   3392
#define XCD_BAR_WORDS 3456
#define XB_SPIN_CAP (1u << 22)
DI unsigned xb_ld(unsigned* p) { return __hip_atomic_load(p, __ATOMIC_RELAXED, __HIP_MEMORY_SCOPE_AGENT); }
DI unsigned xb_add(unsigned* p, unsigned v) { return __hip_atomic_fetch_add(p, v, __ATOMIC_RELAXED, __HIP_MEMORY_SCOPE_AGENT); }
DI unsigned xb_xcc_id() { return (unsigned)__builtin_amdgcn_s_getreg((3 << 11) | 20) & 0xFu; }
#define XB_SPIN(cond, bar) do { unsigned _sp = 0; while (cond) { __builtin_amdgcn_s_sleep(1); \
    if ((++_sp & 255u) == 0u) { if (xb_ld(&(bar)[XB_TMO])) break; if (_sp > XB_SPIN_CAP) { atomicAdd(&(bar)[XB_TMO], 1u); break; } } } } while (0)
struct XcdBarrier { unsigned* bar; unsigned x; volatile unsigned* st; };
DI XcdBarrier xcd_barrier_post(unsigned* bar, volatile unsigned* st) {
  XcdBarrier b; b.bar = bar; b.x = xb_xcc_id(); b.st = st;
  if (threadIdx.x == 0) (void)xb_add(&bar[XB_XCNT(b.x)], 1u);
  return b;
}
DI void xcd_barrier_complete(unsigned* bar, unsigned x, unsigned& nloc, unsigned& nx) {
  const unsigned G = gridDim.x * gridDim.y * gridDim.z;
  unsigned sum, cnt, mine, sp = 0u;
  for (;;) {
    sum = 0u; cnt = 0u; mine = 0u;
#pragma unroll 1
    for (unsigned j = 0; j < 16; ++j) { const unsigned c = xb_ld(&bar[XB_XCNT(j)]); sum += c; cnt += (c > 0u) ? 1u : 0u; mine = (j == x) ? c : mine; }
    if (sum == G) break;
    __builtin_amdgcn_s_sleep(1);
    if ((++sp & 255u) == 0u) { if (xb_ld(&bar[XB_TMO])) break; if (sp > XB_SPIN_CAP) { atomicAdd(&bar[XB_TMO], 1u); break; } }
  }
  nloc = mine > 0u ? mine : 1u; nx = cnt > 0u ? cnt : 1u;
}
DI void xcd_barrier(const XcdBarrier& b) {
  asm volatile("s_waitcnt vmcnt(0)" ::: "memory");
  __syncthreads();
  if (threadIdx.x == 0) {
    unsigned* bar = b.bar;
    __builtin_amdgcn_s_waitcnt(0);
    unsigned nloc = b.st[0], nx = b.st[1];
    if (nloc == 0u) { xcd_barrier_complete(bar, b.x, nloc, nx); b.st[0] = nloc; b.st[1] = nx; }
    const unsigned old = xb_add(&bar[XB_XSUB(b.x)], 1u);
    const unsigned gen = old / nloc;
    if (old + 1u == (gen + 1u) * nloc) {
      __builtin_amdgcn_fence(__ATOMIC_RELEASE, "agent");
      asm volatile("s_waitcnt vmcnt(0)" ::: "memory");
      const unsigned og = xb_add(&bar[XB_TOP], 1u);
      const unsigned tg = og / nx;
      if (og + 1u == (tg + 1u) * nx) xb_add(&bar[XB_TOPGEN], 1u);
      else XB_SPIN(xb_ld(&bar[XB_TOPGEN]) == tg, bar);
      __builtin_amdgcn_fence(__ATOMIC_ACQUIRE, "agent");
      xb_add(&bar[XB_XGEN(b.x)], 1u);
      asm volatile("s_waitcnt vmcnt(0)" ::: "memory");
    } else {
      XB_SPIN(xb_ld(&bar[XB_XGEN(b.x)]) == gen, bar);
      __builtin_amdgcn_fence(__ATOMIC_ACQUIRE, "agent");
      asm volatile("s_waitcnt vmcnt(0)" ::: "memory");
    }
  }
  __syncthreads();
}

constexpr int PH_PER_LAYER = 10;
constexpr int N_PHASES = 1 + NL * PH_PER_LAYER + 1;

template <int KIND>
DI void run_phase(const Params& p, int ph, unsigned char* lds) {
  unsigned* ctl = (unsigned*)(p.ws + OFF_CTL);
  if (ph == 0) { if (KIND < 0 || KIND == 0) phase_prologue(p, lds); }
  else if (ph == N_PHASES - 1) { if (KIND < 0 || KIND == 11) phase_final(p); }
  else {
    const int l = (ph - 1) / PH_PER_LAYER, s = (ph - 1) % PH_PER_LAYER;
    const bool last = (l == NL - 1);
    const int ntok = last ? TL : TT;
    if (s == 0) { if (KIND < 0 || KIND == 1) phase_norm(p, l, 0, TT); }
    else if (s == 1) { if (KIND < 0 || KIND == 2) phase_gemm_in(p, l, lds); }
    else if (s == 2) { if (KIND < 0 || KIND == 3) phase_rope(p, lds); }
    else if (s == 3) { if (KIND < 0 || KIND == 4) phase_mixers(p, l, last, ctl + 64 * (1 + l), lds); }
    else if (s == 4) { if (KIND < 0 || KIND == 5) phase_gla_fin(p, l, ntok); }
    else if (s == 5) { if (KIND < 0 || KIND == 6) phase_gemm_out(p, l, ntok, lds); }
    else if (s == 6) { if (KIND < 0 || KIND == 7) phase_norm(p, l, 1, ntok); }
    else if (s == 7) { if (KIND < 0 || KIND == 8) phase_gemm_q(p, l, ntok, lds); }
    else if (s == 8) { if (KIND < 0 || KIND == 9) phase_topk(p, l, ntok); }
    else { if (KIND < 0 || KIND == 10) phase_gather(p, l, ntok, lds); }
  }
}

#if N_LAUNCH_MODE == 1
#ifndef PROBE_KIND
#define PROBE_KIND -1
#endif
#ifndef GLA_VAR
#define GLA_VAR 0
#endif
constexpr int CW_BAR = 4096;
template <int l>
DI void run_layer(const Params& p, unsigned char* lds) {
  unsigned* ctl = (unsigned*)(p.ws + OFF_CTL);
#define GSYNC() do { XcdBarrier bb; bb.bar = (unsigned*)(p.ws + OFF_CTL) + CW_BAR; bb.x = xb_xcc_id(); bb.st = (volatile unsigned*)(lds + LDS_BYTES - 32); xcd_barrier(bb); } while (0)

    const bool last = (l == NL - 1);
    const int ntok = last ? TL : TT;
    if (l == 0) { { Params q = p; { size_t z_ = 0; asm volatile("" : "+s"(z_)); q.ws = p.ws + z_; } phase_norm(q, l, 0, TT); } GSYNC(); }
    if (PROBE_KIND == 1) { { Params q = p; { size_t z_ = 0; asm volatile("" : "+s"(z_)); q.ws = p.ws + z_; } phase_norm(q, l, 0, TT); } GSYNC(); }
    if (PROBE_KIND == 2) { { Params q = p; { size_t z_ = 0; asm volatile("" : "+s"(z_)); q.ws = p.ws + z_; } phase_gemm_in(q, l, lds, true); } GSYNC(); }
    { Params q = p; { size_t z_ = 0; asm volatile("" : "+s"(z_)); q.ws = p.ws + z_; } phase_gemm_in(q, l, lds); } GSYNC();
    if (PROBE_KIND == 4 || (PROBE_KIND >= 41 && PROBE_KIND <= 47)) { { Params q = p; { size_t z_ = 0; asm volatile("" : "+s"(z_)); q.ws = p.ws + z_; } phase_mixers(q, l, last, ctl + 64 * (1 + l) + 1, lds, PROBE_KIND == 4 ? 15 : PROBE_KIND - 40, GLA_VAR); } GSYNC(); }
    { Params q = p; { size_t z_ = 0; asm volatile("" : "+s"(z_)); q.ws = p.ws + z_; } phase_mixers(q, l, last, ctl + 64 * (1 + l), lds); } GSYNC();
    { Params q = p; { size_t z_ = 0; asm volatile("" : "+s"(z_)); q.ws = p.ws + z_; } phase_gla_fin(q, l, ntok); } GSYNC();
    if (PROBE_KIND == 5) { { Params q = p; { size_t z_ = 0; asm volatile("" : "+s"(z_)); q.ws = p.ws + z_; } phase_gla_fin(q, l, ntok); } GSYNC(); }
    { Params q = p; { size_t z_ = 0; asm volatile("" : "+s"(z_)); q.ws = p.ws + z_; } phase_gemm_out(q, l, ntok, lds); } GSYNC();
    { Params q = p; { size_t z_ = 0; asm volatile("" : "+s"(z_)); q.ws = p.ws + z_; } phase_norm2(q, l, ntok); } GSYNC();
    if (PROBE_KIND == 7) { { Params q = p; { size_t z_ = 0; asm volatile("" : "+s"(z_)); q.ws = p.ws + z_; } phase_norm2(q, l, ntok); } GSYNC(); }
    { Params q = p; { size_t z_ = 0; asm volatile("" : "+s"(z_)); q.ws = p.ws + z_; } phase_gemm_q(q, l, ntok, lds); } GSYNC();
    if (PROBE_KIND == 8) { { Params q = p; { size_t z_ = 0; asm volatile("" : "+s"(z_)); q.ws = p.ws + z_; } phase_gemm_q(q, l, ntok, lds); } GSYNC(); }
    { Params q = p; { size_t z_ = 0; asm volatile("" : "+s"(z_)); q.ws = p.ws + z_; } phase_topk(q, l, ntok); } GSYNC();
    if (PROBE_KIND == 9) { { Params q = p; { size_t z_ = 0; asm volatile("" : "+s"(z_)); q.ws = p.ws + z_; } phase_topk(q, l, ntok); } GSYNC(); }
    if (PROBE_KIND == 10) { { Params q = p; { size_t z_ = 0; asm volatile("" : "+s"(z_)); q.ws = p.ws + z_; } phase_gather(q, l, ntok, lds, true); } GSYNC(); }
    { Params q = p; { size_t z_ = 0; asm volatile("" : "+s"(z_)); q.ws = p.ws + z_; } phase_gather(q, l, ntok, lds); } if (l + 1 < NL) GSYNC();
}
__global__ void __launch_bounds__(256, 2) mk_fwd(Params p) {
  __shared__ __attribute__((aligned(16))) unsigned char lds[LDS_BYTES];
  unsigned* ctl = (unsigned*)(p.ws + OFF_CTL);
  volatile unsigned* st = (volatile unsigned*)(lds + LDS_BYTES - 32);
  if (threadIdx.x < 2) st[threadIdx.x] = 0u;
  __syncthreads();
  (void)xcd_barrier_post(ctl + CW_BAR, st);
#define GSYNC() do { XcdBarrier bb; bb.bar = (unsigned*)(p.ws + OFF_CTL) + CW_BAR; bb.x = xb_xcc_id(); bb.st = (volatile unsigned*)(lds + LDS_BYTES - 32); xcd_barrier(bb); } while (0)
  { Params q = p; { size_t z_ = 0; asm volatile("" : "+s"(z_)); q.ws = p.ws + z_; } phase_prologue(q, lds); } cg::this_grid().sync();
  if (PROBE_KIND == 0) { { Params q = p; { size_t z_ = 0; asm volatile("" : "+s"(z_)); q.ws = p.ws + z_; } phase_prologue(q, lds); } GSYNC(); }
  run_layer<0>(p, lds); run_layer<1>(p, lds); run_layer<2>(p, lds); run_layer<3>(p, lds);
}
#else
template <int KIND>
__global__ void __launch_bounds__(256, 2) mk_phase(Params p) {
  __shared__ __attribute__((aligned(16))) unsigned char lds[LDS_BYTES];
  run_phase<KIND>(p, p.ph_lo, lds);
}
#endif

extern "C" void kernel_launch(void* const* d_in, const int* in_sizes, int n_in, void* d_out, int out_size, void* d_ws,
                              size_t ws_size, hipStream_t stream) {
  static int grid = 0;
  if (grid == 0) {
    if (n_in != 21 || ws_size < WS_END || out_size != TL * DM) { fprintf(stderr, "kernel_launch: unexpected shapes (n_in %d ws %zu out %d)\n", n_in, ws_size, out_size); grid = -1; return; }
    int dev = 0, cus = 0, per_cu = 2;
    (void)hipGetDevice(&dev);
    (void)hipDeviceGetAttribute(&cus, hipDeviceAttributeMultiprocessorCount, dev);
#if N_LAUNCH_MODE == 1
    (void)hipOccupancyMaxActiveBlocksPerMultiprocessor(&per_cu, (const void*)mk_fwd, 256, 0);
    if (per_cu < 1) per_cu = 1;
    if (per_cu > 2) per_cu = 2;
#endif
    grid = cus * per_cu;
  }
  if (grid < 0) return;
  (void)hipMemsetAsync((char*)d_ws + OFF_CTL, 0, 65536, stream);
  Params p{};
  const float** pp = (const float**)&p;
  for (int i = 0; i < 21; ++i) pp[i] = (const float*)d_in[i];
  p.out = (float*)d_out;
  p.ws = (unsigned char*)d_ws;
#if N_LAUNCH_MODE == 1
  p.ph_lo = 0; p.ph_hi = N_PHASES;
  void* args[] = {&p};
  hipError_t e = hipLaunchCooperativeKernel((const void*)mk_fwd, dim3(grid), dim3(256), args, 0, stream);
  if (e != hipSuccess) fprintf(stderr, "cooperative launch failed: %s (grid %d)\n", hipGetErrorString(e), grid);
#else
  for (int ph = 0; ph < N_PHASES; ++ph) {
    p.ph_lo = ph; p.ph_hi = ph + 1;
    const int kind = ph == 0 ? 0 : (ph == N_PHASES - 1 ? 11 : 1 + (ph - 1) % PH_PER_LAYER);
    switch (kind) {
      case 0: hipLaunchKernelGGL(mk_phase<0>, dim3(grid), dim3(256), 0, stream, p); break;
      case 1: hipLaunchKernelGGL(mk_phase<1>, dim3(grid), dim3(256), 0, stream, p); break;
      case 2: hipLaunchKernelGGL(mk_phase<2>, dim3(grid), dim3(256), 0, stream, p); break;
      case 3: hipLaunchKernelGGL(mk_phase<3>, dim3(grid), dim3(256), 0, stream, p); break;
      case 4: hipLaunchKernelGGL(mk_phase<4>, dim3(grid), dim3(256), 0, stream, p); break;
      case 5: hipLaunchKernelGGL(mk_phase<5>, dim3(grid), dim3(256), 0, stream, p); break;
      case 6: hipLaunchKernelGGL(mk_phase<6>, dim3(grid), dim3(256), 0, stream, p); break;
      case 7: hipLaunchKernelGGL(mk_phase<7>, dim3(grid), dim3(256), 0, stream, p); break;
      case 8: hipLaunchKernelGGL(mk_phase<8>, dim3(grid), dim3(256), 0, stream, p); break;
      case 9: hipLaunchKernelGGL(mk_phase<9>, dim3(grid), dim3(256), 0, stream, p); break;
      case 10: hipLaunchKernelGGL(mk_phase<10>, dim3(grid), dim3(256), 0, stream, p); break;
      default: hipLaunchKernelGGL(mk_phase<11>, dim3(grid), dim3(256), 0, stream, p); break;
    }
  }
#endif
}
```

```cpp
#include <hip/hip_runtime.h>
#include <hip/hip_cooperative_groups.h>
#include <stdint.h>
#include <stdio.h>
namespace cg = cooperative_groups;

#ifndef N_LAUNCH_MODE
#define N_LAUNCH_MODE 1
#endif

#define DI __device__ __forceinline__
#ifndef GEMM_VAR
#define GEMM_VAR 0
#endif
typedef unsigned short bf16_t;
typedef short bf16x8 __attribute__((ext_vector_type(8)));
typedef float f32x4 __attribute__((ext_vector_type(4)));
typedef float f32x2 __attribute__((ext_vector_type(2)));
typedef float f32x16 __attribute__((ext_vector_type(16)));
typedef float f32x32 __attribute__((ext_vector_type(32)));
typedef unsigned u32x6 __attribute__((ext_vector_type(6)));
typedef int i32x8 __attribute__((ext_vector_type(8)));
typedef unsigned u32x4 __attribute__((ext_vector_type(4)));
typedef unsigned u32x2 __attribute__((ext_vector_type(2)));

constexpr int NB = 16, SEQ = 2048, DM = 1024, NL = 4, CTXL = 256;
constexpr int TL = NB * SEQ;
constexpr int TC = NB * CTXL;
constexpr int TT = TL + TC;
constexpr int PN_LD = 2176;
constexpr int C_GQ = 0, C_GK = 128, C_GR = 256, C_NQ = 512, C_NK = 768, C_DQ = 1024, C_DK = 1536, C_GATE = 2048;
constexpr int R_GV = 0, R_NV = 256, R_DV = 512;
constexpr float LOG2E = 1.4426950408889634f;
constexpr float SC_LOG2 = 0.125f * LOG2E;
constexpr float NEG_BIG = -1e30f;

constexpr size_t MiB = 1u << 20;
constexpr size_t OFF_CTL = 0;
constexpr size_t OFF_MOD = 1 * MiB;
constexpr size_t OFF_WIN = 3 * MiB;
constexpr size_t OFF_WOUT = 28 * MiB;
constexpr size_t OFF_WQ = 36 * MiB;
constexpr size_t OFF_SK = 44 * MiB;
constexpr size_t OFF_USCL = 44 * MiB + 256 * 1024;
constexpr size_t OFF_VSCL = 44 * MiB + 512 * 1024;
constexpr size_t OFF_U = 45 * MiB;
constexpr size_t OFF_V = 109 * MiB;
constexpr int V6_PITCH = 800;
constexpr size_t OFF_XRES = 301 * MiB;
constexpr size_t OFF_H = 445 * MiB;
constexpr size_t OFF_P = 517 * MiB;
constexpr size_t OFF_VT = OFF_P + 153 * MiB;
constexpr size_t OFF_QP = OFF_P;
constexpr size_t OFF_EID = OFF_P + 72 * MiB;
constexpr size_t OFF_GATE = OFF_P + 90 * MiB;
constexpr size_t OFF_H8 = OFF_P + 126 * MiB;
constexpr size_t OFF_HINV = OFF_P + 162 * MiB;
constexpr size_t OFF_Y = 742 * MiB;
constexpr size_t WS_END = 814 * MiB;

constexpr int LDS_BYTES = 65536 + 8192;

struct Params {
  const float *x, *c, *ctx, *c_ctx, *ada_w, *ada_b, *norm1_g, *norm2_g, *w_in, *gate_up, *gate_b, *gla_norm_g,
      *rpb, *dlam, *diff_g, *w_out, *wq, *subkeys, *pu, *pv, *final_g;
  float* out;
  unsigned char* ws;
  int ph_lo, ph_hi;
};

DI int ltid() { int t = threadIdx.x; asm volatile("" : "+v"(t)); return t; }
DI int lbid() { int t = blockIdx.x; asm volatile("" : "+s"(t)); return t; }
DI int lgdim() { int t = gridDim.x; asm volatile("" : "+s"(t)); return t; }

DI unsigned f2bf(float f) { unsigned u = __float_as_uint(f); return (u + 0x7fffu + ((u >> 16) & 1u)) >> 16; }
typedef __bf16 bf16x2_t __attribute__((ext_vector_type(2)));
DI unsigned pk2(float lo, float hi) { f32x2 v = {lo, hi}; return __builtin_bit_cast(unsigned, __builtin_convertvector(v, bf16x2_t)); }
DI float bflo(unsigned u) { return __uint_as_float(u << 16); }
DI float bfhi(unsigned u) { return __uint_as_float(u & 0xffff0000u); }
DI void unpack8(const u32x4 v, float* f) {
  f[0] = bflo(v.x); f[1] = bfhi(v.x); f[2] = bflo(v.y); f[3] = bfhi(v.y);
  f[4] = bflo(v.z); f[5] = bfhi(v.z); f[6] = bflo(v.w); f[7] = bfhi(v.w);
}
DI float wave_sum(float v) {
#pragma unroll
  for (int o = 32; o >= 1; o >>= 1) v += __shfl_xor(v, o);
  return v;
}

DI float rows_max(float x) {
  unsigned u = __float_as_uint(x);
  u32x2 a = __builtin_amdgcn_permlane32_swap(u, u, false, false);
  const float m = fmaxf(__uint_as_float(a[0]), __uint_as_float(a[1]));
  unsigned v = __float_as_uint(m);
  u32x2 b = __builtin_amdgcn_permlane16_swap(v, v, false, false);
  return fmaxf(__uint_as_float(b[0]), __uint_as_float(b[1]));
}
DI float rows_sum(float x) {
  unsigned u = __float_as_uint(x);
  u32x2 a = __builtin_amdgcn_permlane32_swap(u, u, false, false);
  const float m = __uint_as_float(a[0]) + __uint_as_float(a[1]);
  unsigned v = __float_as_uint(m);
  u32x2 b = __builtin_amdgcn_permlane16_swap(v, v, false, false);
  return __uint_as_float(b[0]) + __uint_as_float(b[1]);
}

DI u32x6 mxfp6_pack32(float (&x)[32], unsigned& sbyte) {
  float am = 0.f;
#pragma unroll
  for (int i = 0; i < 32; ++i) am = fmaxf(am, fabsf(x[i]));
  int e = am > 0.f ? (int)ceilf(log2f(am) - 2.906890596f) : -126;
  e = e < -126 ? -126 : (e > 127 ? 127 : e);
  const float sc = __uint_as_float((unsigned)(127 - e) << 23);
  f32x16 lo, hi;
#pragma unroll
  for (int i = 0; i < 16; ++i) { lo[i] = x[2 * i] * sc; hi[i] = x[2 * i + 1] * sc; }
  sbyte = (unsigned)(127 + e);
  return __builtin_amdgcn_cvt_scalef32_2xpk16_fp6_f32(lo, hi, 1.0f);
}
DI int mx_scale_pos(int blk) { return 768 + (blk & 3) * 8 + (blk >> 2); }
DI f32x4 mfma16(bf16x8 a, bf16x8 b, f32x4 c) { return __builtin_amdgcn_mfma_f32_16x16x32_bf16(a, b, c, 0, 0, 0); }

DI int win_src_col(int r) {
  if (r < 256) return r;
  if (r < 512) return r - 256 + 512;
  if (r < 768) return r - 512 + 800;
  if (r < 1024) return r - 768 + 1056;
  if (r < 1536) return r - 1024 + 1568;
  if (r < 2048) return r - 1536 + 2080;
  if (r < 2080) return r - 2048 + 768;
  if (r < 2176) return -1;
  if (r < 2432) return r - 2176 + 256;
  if (r < 2688) return r - 2432 + 1312;
  return r - 2688 + 2592;
}

DI void transpose_item(const float* __restrict__ W, int N, int src, bf16_t* __restrict__ dst, float* lds) {
  const int tid = ltid();
  for (int kc = 0; kc < 8; ++kc) {
    __syncthreads();
#pragma unroll
    for (int i = 0; i < 16; ++i) {
      int k = i * 8 + (tid >> 5), n = tid & 31;
      lds[k * 33 + n] = (src < 0) ? 0.f : W[(size_t)(kc * 128 + k) * N + src + n];
    }
    __syncthreads();
    int row = tid >> 3, k0 = (tid & 7) * 16;
    unsigned o[8];
#pragma unroll
    for (int e = 0; e < 8; ++e) o[e] = pk2(lds[(k0 + 2 * e) * 33 + row], lds[(k0 + 2 * e + 1) * 33 + row]);
    u32x4 a = {o[0], o[1], o[2], o[3]}, b = {o[4], o[5], o[6], o[7]};
    bf16_t* d = dst + (size_t)row * 1024 + kc * 128 + k0;
    *(u32x4*)d = a; *(u32x4*)(d + 8) = b;
  }
}

DI void convert_table_pairs(const Params& p, int pr0, int pr1, int wave, int nwave, int lane) {
  for (int pr = pr0 + wave; pr < pr1; pr += nwave) {
    const int tab = pr >= NL * 16384 / 2, pq = tab ? pr - NL * 16384 / 2 : pr;
    const int r = 2 * pq + (lane >> 5), blk = lane & 31;
    const float* src = (tab ? p.pv : p.pu) + (size_t)r * 1024 + 32 * blk;
    float x[32];
#pragma unroll
    for (int i = 0; i < 8; ++i) { const float4 a = *(const float4*)(src + 4 * i); x[4 * i] = a.x; x[4 * i + 1] = a.y; x[4 * i + 2] = a.z; x[4 * i + 3] = a.w; }
    unsigned sb;
    const u32x6 q = mxfp6_pack32(x, sb);
    unsigned char* row = p.ws + (tab ? OFF_V : OFF_U) + (size_t)r * V6_PITCH;
    *(u32x2*)(row + 24 * blk) = (u32x2){q[0], q[1]};
    *(u32x2*)(row + 24 * blk + 8) = (u32x2){q[2], q[3]};
    *(u32x2*)(row + 24 * blk + 16) = (u32x2){q[4], q[5]};
    row[mx_scale_pos(blk)] = (unsigned char)sb;
  }
}

DI void phase_prologue(const Params& p, unsigned char* lds) {
  const int tid = ltid(), nb = lgdim(), bid = lbid();
  bf16_t* winT = (bf16_t*)(p.ws + OFF_WIN);
  bf16_t* woutT = (bf16_t*)(p.ws + OFF_WOUT);
  bf16_t* wqT = (bf16_t*)(p.ws + OFF_WQ);
  constexpr int PER_LAYER = 100 + 32 + 32;
  for (int item = bid; item < NL * PER_LAYER; item += nb) {
    int l = item / PER_LAYER, r = item % PER_LAYER;
    if (r < 100) {
      int row = r * 32;
      transpose_item(p.w_in + (size_t)l * 1024 * 3104, 3104, win_src_col(row), winT + ((size_t)l * 3200 + row) * 1024, (float*)lds);
    } else if (r < 132) {
      int row = (r - 100) * 32;
      transpose_item(p.w_out + (size_t)l * 1024 * 1024, 1024, row, woutT + ((size_t)l * 1024 + row) * 1024, (float*)lds);
    } else {
      int row = (r - 132) * 32;
      transpose_item(p.wq + (size_t)l * 1024 * 1024, 1024, row, wqT + ((size_t)l * 1024 + row) * 1024, (float*)lds);
    }
  }
  {
    bf16_t* sk = (bf16_t*)(p.ws + OFF_SK);
    for (int i = bid * 256 + tid; i < NL * 2 * 128 * 64; i += nb * 256) sk[i] = (bf16_t)f2bf(p.subkeys[i]);
  }
  {
    float* modbuf = (float*)(p.ws + OFF_MOD);
    float* sc = (float*)lds;
    float* red = (float*)(lds + 17 * 512 * 4);
    for (int item = bid; item < NL * 96; item += nb) {
      const int l = item / 96, cb = item % 96, col = cb * 64 + (tid & 63), kq = tid >> 6;
      float acc[17];
#pragma unroll
      for (int r = 0; r < 17; ++r) acc[r] = 0.f;
      for (int half = 0; half < 2; ++half) {
        __syncthreads();
        for (int e = tid; e < 17 * 512; e += 256) {
          int r = e >> 9, k = e & 511;
          float cv = (r < 16) ? p.c[r * 1024 + half * 512 + k] : p.c_ctx[half * 512 + k];
          sc[e] = cv / (1.f + __expf(-cv));
        }
        __syncthreads();
        const float* wp = p.ada_w + ((size_t)l * 1024 + half * 512 + kq * 128) * 6144 + col;
        for (int kk = 0; kk < 128; ++kk) {
          const float w = wp[(size_t)kk * 6144];
#pragma unroll
          for (int r = 0; r < 17; ++r) acc[r] += sc[r * 512 + kq * 128 + kk] * w;
        }
      }
#pragma unroll
      for (int r = 0; r < 17; ++r) red[(kq * 17 + r) * 64 + (tid & 63)] = acc[r];
      __syncthreads();
      for (int e = tid; e < 17 * 64; e += 256) {
        int r = e >> 6, cc = e & 63;
        float s = red[(0 * 17 + r) * 64 + cc] + red[(1 * 17 + r) * 64 + cc] + red[(2 * 17 + r) * 64 + cc] + red[(3 * 17 + r) * 64 + cc];
        int colg = cb * 64 + cc;
        modbuf[((size_t)l * 17 + r) * 6144 + colg] = s + p.ada_b[l * 6144 + colg];
      }
      __syncthreads();
    }
  }
}

DI void phase_norm(const Params& p, int l, int which, int ntok) {
  const int lane = ltid() & 63, gw = lbid() * 4 + (ltid() >> 6), nw = lgdim() * 4;
  const float* gvec = (which == 0 ? p.norm1_g : p.norm2_g) + l * 1024;
  const int ish = which == 0 ? 0 : 3, isc = which == 0 ? 1 : 4;
  const float* xres = (const float*)(p.ws + OFF_XRES);
  const float* modbuf = (const float*)(p.ws + OFF_MOD);
  bf16_t* hbuf = (bf16_t*)(p.ws + OFF_H);
  for (int t = gw; t < ntok; t += nw) {
    const float* src = (which == 0 && l == 0) ? (t < TL ? p.x + (size_t)t * 1024 : p.ctx + (size_t)(t - TL) * 1024) : xres + (size_t)t * 1024;
    const int b = t < TL ? (t >> 11) : 16;
    const float* md = modbuf + ((size_t)l * 17 + b) * 6144;
    float4 v[4];
    float ss = 0.f;
#pragma unroll
    for (int i = 0; i < 4; ++i) {
      v[i] = *(const float4*)(src + 4 * lane + 256 * i);
      ss += v[i].x * v[i].x + v[i].y * v[i].y + v[i].z * v[i].z + v[i].w * v[i].w;
    }
    ss = wave_sum(ss);
    const float rstd = rsqrtf(ss * (1.f / 1024.f) + 1e-6f);
    float am = 0.f;
#pragma unroll
    for (int i = 0; i < 4; ++i) {
      const int col = 4 * lane + 256 * i;
      const float4 g4 = *(const float4*)(gvec + col), sh = *(const float4*)(md + ish * 1024 + col), sc = *(const float4*)(md + isc * 1024 + col);
      float o0 = v[i].x * rstd * g4.x * (1.f + sc.x) + sh.x;
      float o1 = v[i].y * rstd * g4.y * (1.f + sc.y) + sh.y;
      float o2 = v[i].z * rstd * g4.z * (1.f + sc.z) + sh.z;
      float o3 = v[i].w * rstd * g4.w * (1.f + sc.w) + sh.w;
      u32x2 o = {pk2(o0, o1), pk2(o2, o3)};
      *(u32x2*)(hbuf + (size_t)t * 1024 + col) = o;
      v[i].x = o0; v[i].y = o1; v[i].z = o2; v[i].w = o3;
      am = fmaxf(am, fmaxf(fmaxf(fabsf(o0), fabsf(o1)), fmaxf(fabsf(o2), fabsf(o3))));
    }
  }
}

DI void phase_norm2(const Params& p, int l, int ntok) {
  const int lane = ltid() & 63, gw = lbid() * 4 + (ltid() >> 6), nw = lgdim() * 4;
  const int half = lane >> 5, blk = lane & 31;
  const float* gvec = p.norm2_g + l * 1024 + 32 * blk;
  const float* xres = (const float*)(p.ws + OFF_XRES);
  const float* modbuf = (const float*)(p.ws + OFF_MOD);
  bf16_t* hbuf = (bf16_t*)(p.ws + OFF_H);
  unsigned char* h6 = p.ws + OFF_H8;
  for (int pr = gw; pr < ntok / 2; pr += nw) {
    const int t = 2 * pr + half;
    const float* src = xres + (size_t)t * 1024 + 32 * blk;
    const int b = t < TL ? (t >> 11) : 16;
    const float* md = modbuf + ((size_t)l * 17 + b) * 6144 + 32 * blk;
    float x[32];
    float ss = 0.f;
#pragma unroll
    for (int i = 0; i < 8; ++i) {
      const float4 a = *(const float4*)(src + 4 * i);
      x[4 * i] = a.x; x[4 * i + 1] = a.y; x[4 * i + 2] = a.z; x[4 * i + 3] = a.w;
      ss += a.x * a.x + a.y * a.y + a.z * a.z + a.w * a.w;
    }
#pragma unroll
    for (int o = 16; o >= 1; o >>= 1) ss += __shfl_xor(ss, o);
    const float rstd = rsqrtf(ss * (1.f / 1024.f) + 1e-6f);
    unsigned pk[16];
#pragma unroll
    for (int i = 0; i < 8; ++i) {
      const float4 g4 = *(const float4*)(gvec + 4 * i), sh = *(const float4*)(md + 3 * 1024 + 4 * i), sc = *(const float4*)(md + 4 * 1024 + 4 * i);
      x[4 * i] = x[4 * i] * rstd * g4.x * (1.f + sc.x) + sh.x;
      x[4 * i + 1] = x[4 * i + 1] * rstd * g4.y * (1.f + sc.y) + sh.y;
      x[4 * i + 2] = x[4 * i + 2] * rstd * g4.z * (1.f + sc.z) + sh.z;
      x[4 * i + 3] = x[4 * i + 3] * rstd * g4.w * (1.f + sc.w) + sh.w;
      pk[2 * i] = pk2(x[4 * i], x[4 * i + 1]); pk[2 * i + 1] = pk2(x[4 * i + 2], x[4 * i + 3]);
    }
    bf16_t* hrow = hbuf + (size_t)t * 1024 + 32 * blk;
#pragma unroll
    for (int i = 0; i < 4; ++i) *(u32x4*)(hrow + 8 * i) = (u32x4){pk[4 * i], pk[4 * i + 1], pk[4 * i + 2], pk[4 * i + 3]};
    unsigned sb;
    const u32x6 q = mxfp6_pack32(x, sb);
    unsigned char* row = h6 + (size_t)t * V6_PITCH;
    *(u32x2*)(row + 24 * blk) = (u32x2){q[0], q[1]};
    *(u32x2*)(row + 24 * blk + 8) = (u32x2){q[2], q[3]};
    *(u32x2*)(row + 24 * blk + 16) = (u32x2){q[4], q[5]};
    row[mx_scale_pos(blk)] = (unsigned char)sb;
  }
}

template <int EPI>
DI void gemm_tile(const bf16_t* __restrict__ P, const bf16_t* __restrict__ Q, int it, int jt, void* outp, int ld,
                  const float* xin_lat, const float* xin_ctx, const float* modl, unsigned char* lds, bool gvar = false) {
  const int tid = ltid(), lane = tid & 63, w = tid >> 6, wi = w >> 1, wj = w & 1, lr = lane & 15, g = lane >> 4;
  const int wu = __builtin_amdgcn_readfirstlane(w);
  f32x4 acc[4][4];
#pragma unroll
  for (int a = 0; a < 4; ++a)
#pragma unroll
    for (int b = 0; b < 4; ++b) acc[a][b] = (f32x4){0.f, 0.f, 0.f, 0.f};
  const unsigned lo0 = (unsigned)((lane >> 3) * 1024 + (((lane & 7) ^ (lane >> 4)) << 3));
  const unsigned lo1 = (unsigned)((lane >> 3) * 1024 + (((lane & 7) ^ (4 + (lane >> 4))) << 3));
  const bf16_t* pg = P + (size_t)(it * 128 + 32 * wu) * 1024;
  const bf16_t* qg = Q + (size_t)(jt * 128 + 32 * wu) * 1024;
#define GT_DMA(kb, bf) do { _Pragma("unroll") for (int jj = 0; jj < 4; ++jj) { const unsigned lo_ = (jj & 1) ? lo1 : lo0; \
      __builtin_amdgcn_global_load_lds((const unsigned*)(pg + (size_t)jj * 8192 + (kb) * 64 + lo_), (unsigned*)(lds + (bf) * 32768 + (4 * wu + jj) * 1024), 16, 0, 0); \
      __builtin_amdgcn_global_load_lds((const unsigned*)(qg + (size_t)jj * 8192 + (kb) * 64 + lo_), (unsigned*)(lds + (bf) * 32768 + 16384 + (4 * wu + jj) * 1024), 16, 0, 0); } } while (0)
  __syncthreads();
  GT_DMA(0, 0);
  asm volatile("s_waitcnt vmcnt(0)" ::: "memory");
  __syncthreads();
  for (int kb = 0; kb < 16; ++kb) {
    if (kb < 15 && !(GEMM_VAR == 1 && gvar)) GT_DMA(kb + 1, (kb + 1) & 1);
    const unsigned char* Ps = lds + (kb & 1) * 32768;
    const unsigned char* Qs = Ps + 16384;
    bf16x8 pf[2][4], qf[2][4];
#pragma unroll
    for (int ks = 0; ks < 2; ++ks) {
      const int ch = ks * 4 + g;
#pragma unroll
      for (int mi = 0; mi < 4; ++mi) { const int row = wi * 64 + mi * 16 + lr; pf[ks][mi] = *(const bf16x8*)(Ps + (row >> 1) * 256 + (((((row & 1) << 3) | ch) ^ ((row >> 1) & 7)) << 4)); }
#pragma unroll
      for (int nj = 0; nj < 4; ++nj) { const int row = wj * 64 + nj * 16 + lr; qf[ks][nj] = *(const bf16x8*)(Qs + (row >> 1) * 256 + (((((row & 1) << 3) | ch) ^ ((row >> 1) & 7)) << 4)); }
    }
    __builtin_amdgcn_sched_barrier(0);
    __builtin_amdgcn_s_setprio(1);
#pragma unroll
    for (int ks = 0; ks < 2; ++ks)
#pragma unroll
      for (int mi = 0; mi < 4; ++mi)
#pragma unroll
        for (int nj = 0; nj < 4; ++nj) { if (GEMM_VAR == 2 && gvar) { asm volatile("" :: "v"(pf[ks][mi]), "v"(qf[ks][nj])); } else acc[mi][nj] = mfma16(pf[ks][mi], qf[ks][nj], acc[mi][nj]); }
    __builtin_amdgcn_s_setprio(0);
    __builtin_amdgcn_sched_barrier(0);
    asm volatile("s_waitcnt vmcnt(0)" ::: "memory");
    __syncthreads();
  }
#undef GT_DMA
  if (EPI == 2) {
    float inv[4];
#pragma unroll
    for (int r = 0; r < 4; ++r) inv[r] = __builtin_amdgcn_exp2f(-(float)(4 * g + r) * (13.287712379549449f / 16.f));
#pragma unroll
    for (int nj = 0; nj < 4; ++nj) {
      const int j = jt * 128 + wj * 64 + nj * 16 + lr;
      if (j < TL) {
        const float prow = (float)((j & 2047) >> 6), pcol = (float)(j & 63);
#pragma unroll
        for (int r = 0; r < 4; ++r) {
          const float a1 = prow * inv[r], a2 = pcol * inv[r];
          const float c1 = __cosf(a1), s1 = __sinf(a1), c2 = __cosf(a2), s2 = __sinf(a2);
          const float x1 = acc[0][nj][r], x2 = acc[1][nj][r], y1 = acc[2][nj][r], y2 = acc[3][nj][r];
          acc[0][nj][r] = x1 * c1 - x2 * s1; acc[1][nj][r] = x2 * c1 + x1 * s1;
          acc[2][nj][r] = y1 * c2 - y2 * s2; acc[3][nj][r] = y2 * c2 + y1 * s2;
        }
      }
    }
  }
#pragma unroll
  for (int mi = 0; mi < 4; ++mi)
#pragma unroll
    for (int nj = 0; nj < 4; ++nj) {
      const int j = jt * 128 + wj * 64 + nj * 16 + lr;
      const int i = it * 128 + wi * 64 + mi * 16 + 4 * g;
      const f32x4 a = acc[mi][nj];
      if (EPI == 0 || EPI == 2) {
        u32x2 o = {pk2(a[0], a[1]), pk2(a[2], a[3])};
        *(u32x2*)((bf16_t*)outp + (size_t)j * ld + i) = o;
      } else {
        const int b = j < TL ? (j >> 11) : 16;
        const float4 gt = *(const float4*)(modl + (size_t)b * 6144 + 2 * 1024 + i);
        const float* xs = (j < TL) ? xin_lat + (size_t)j * 1024 + i : xin_ctx + (size_t)(j - TL) * 1024 + i;
        const float4 xv = *(const float4*)xs;
        float4 o = {xv.x + gt.x * a[0], xv.y + gt.y * a[1], xv.z + gt.z * a[2], xv.w + gt.w * a[3]};
        *(float4*)((float*)outp + (size_t)j * 1024 + i) = o;
      }
    }
}

struct TileIter {
  int u, step, total, nf, tpx, x;
  DI void init(int n_tok_tiles, int n_feat_tiles) {
    const int bid = lbid(), nb = lgdim();
    nf = n_feat_tiles;
    if ((nb & 7) == 0 && (n_tok_tiles & 7) == 0) { x = bid & 7; u = bid >> 3; step = nb >> 3; tpx = n_tok_tiles >> 3; }
    else { x = 0; u = bid; step = nb; tpx = n_tok_tiles; }
    total = tpx * nf;
  }
  DI bool valid() const { return u < total; }
  DI void next() { u += step; }
  DI void get(int& tok_tile, int& feat_tile) const {
    const int g = u / (8 * nf), rem = u - g * 8 * nf;
    const int gs = (tpx - 8 * g) < 8 ? (tpx - 8 * g) : 8;
    const int f = rem / gs, tt = rem - f * gs;
    tok_tile = x * tpx + 8 * g + tt; feat_tile = f;
  }
};

DI void phase_gemm_in(const Params& p, int l, unsigned char* lds, bool gvar = false) {
  const bf16_t* W = (const bf16_t*)(p.ws + OFF_WIN) + (size_t)l * 3200 * 1024;
  const bf16_t* H = (const bf16_t*)(p.ws + OFF_H);
  bf16_t* PN = (bf16_t*)(p.ws + OFF_P);
  bf16_t* VT = (bf16_t*)(p.ws + OFF_VT);
  TileIter ti; ti.init(TT / 128, 25);
  for (; ti.valid(); ti.next()) {
    int jt, f; ti.get(jt, f);
    if (f >= 8 && f < 16) gemm_tile<2>(W, H, f, jt, PN, PN_LD, nullptr, nullptr, nullptr, lds, gvar);
    else if (f < 17) gemm_tile<0>(W, H, f, jt, PN, PN_LD, nullptr, nullptr, nullptr, lds, gvar);
    else gemm_tile<0>(H, W + (size_t)2176 * 1024, jt, f - 17, VT, TT, nullptr, nullptr, nullptr, lds, gvar);
  }
}
DI void phase_gemm_out(const Params& p, int l, int ntok, unsigned char* lds) {
  const bf16_t* W = (const bf16_t*)(p.ws + OFF_WOUT) + (size_t)l * 1024 * 1024;
  const bf16_t* Y = (const bf16_t*)(p.ws + OFF_Y);
  float* xres = (float*)(p.ws + OFF_XRES);
  const float* modl = (const float*)(p.ws + OFF_MOD) + (size_t)l * 17 * 6144;
  const float* xl = (l == 0) ? p.x : xres;
  const float* xc = (l == 0) ? p.ctx : xres + (size_t)TL * 1024;
  TileIter ti; ti.init(ntok / 128, 8);
  for (; ti.valid(); ti.next()) {
    int jt, f; ti.get(jt, f);
    gemm_tile<1>(W, Y, f, jt, xres, 1024, xl, xc, modl, lds);
  }
}
DI void phase_gemm_q(const Params& p, int l, int ntok, unsigned char* lds) {
  const bf16_t* W = (const bf16_t*)(p.ws + OFF_WQ) + (size_t)l * 1024 * 1024;
  const bf16_t* H = (const bf16_t*)(p.ws + OFF_H);
  bf16_t* QP = (bf16_t*)(p.ws + OFF_QP);
  TileIter ti; ti.init(ntok / 128, 8);
  for (; ti.valid(); ti.next()) {
    int jt, f; ti.get(jt, f);
    gemm_tile<0>(W, H, f, jt, QP, 1024, nullptr, nullptr, nullptr, lds);
  }
}

DI void phase_rope(const Params& p, unsigned char* lds) {
  float2* tab = (float2*)lds;
  for (int e = ltid(); e < 1024; e += 256) {
    const int pos = e >> 4, i = e & 15;
    const float inv = exp2f(-(float)i * (13.287712379549449f / 16.f));
    const float ang = (float)pos * inv;
    tab[e] = make_float2(__cosf(ang), __sinf(ang));
  }
  __syncthreads();
  bf16_t* PN = (bf16_t*)(p.ws + OFF_P);
  const int total = TL * 16;
  for (int idx = lbid() * 256 + ltid(); idx < total; idx += lgdim() * 256) {
    const int t = idx >> 4, vec = idx & 15;
    const int col = ((vec >> 3) ? C_DK : C_DQ) + ((vec >> 1) & 3) * 128 + (vec & 1) * 64;
    bf16_t* ptr = PN + (size_t)t * PN_LD + col;
    float xv[64];
#pragma unroll
    for (int q = 0; q < 8; ++q) { const u32x4 v = *(const u32x4*)(ptr + q * 8); unpack8(v, xv + q * 8); }
    const int row = (t & 2047) >> 6, cp = t & 63;
#pragma unroll
    for (int i = 0; i < 16; ++i) {
      const float2 cs = tab[row * 16 + i];
      const float x1 = xv[i], x2 = xv[16 + i];
      xv[i] = x1 * cs.x - x2 * cs.y; xv[16 + i] = x2 * cs.x + x1 * cs.y;
      const float2 cs2 = tab[cp * 16 + i];
      const float y1 = xv[32 + i], y2 = xv[48 + i];
      xv[32 + i] = y1 * cs2.x - y2 * cs2.y; xv[48 + i] = y2 * cs2.x + y1 * cs2.y;
    }
#pragma unroll
    for (int q = 0; q < 8; ++q) {
      u32x4 o = {pk2(xv[q * 8], xv[q * 8 + 1]), pk2(xv[q * 8 + 2], xv[q * 8 + 3]), pk2(xv[q * 8 + 4], xv[q * 8 + 5]), pk2(xv[q * 8 + 6], xv[q * 8 + 7])};
      *(u32x4*)(ptr + q * 8) = o;
    }
  }
}

struct SrcSeg {
  const bf16_t* PN; const bf16_t* VT; int kcol, vrow, t0, n0, t1, n1, lr, g;
  DI int nsteps() const { return n0 + n1; }
  DI int tok0(int st) const { return st < n0 ? t0 + st * 32 : t1 + (st - n0) * 32; }
  DI float score(float raw, int st, int kt, int r) const { return raw * SC_LOG2; }
};
struct SrcNat {
  const bf16_t* PN; const bf16_t* VT; int kcol, vrow, b, rq, rs, cs, qc, cstart, lr, g;
  const float* rpbh;
  DI int nsteps() const { return 16; }
  DI int tok0(int st) const { return st < 8 ? b * 2048 + (rs + st) * 64 + cs : TL + b * 256 + (st - 8) * 32; }
  DI float score(float raw, int st, int kt, int r) const {
    if (st >= 8) return raw * SC_LOG2;
    const int kc = cs + 8 * g + 4 * kt + r;
    const bool valid = (kc >= cstart) && (kc < cstart + 16);
    int dc = kc - qc + 15; dc = dc < 0 ? 0 : (dc > 30 ? 30 : dc);
    const float bias = rpbh[(rs + st - rq + 7) * 31 + dc];
    return valid ? (raw * 0.125f + bias) * LOG2E : NEG_BIG;
  }
};

template <class Src>
struct FlashFrags { bf16x8 k[2][2]; bf16x8 v[4]; };
template <class Src>
DI void flash_load(const Src& S, int st, FlashFrags<Src>& F) {
  const int tk = S.tok0(st);
  const int kap = 8 * (S.lr >> 2) + (S.lr & 3);
  const bf16_t* k0p = S.PN + (size_t)(tk + kap) * PN_LD + S.kcol + 8 * S.g;
  const bf16_t* vp = S.VT + (size_t)(S.vrow + S.lr) * TT + tk + 8 * S.g;
#pragma unroll
  for (int kt = 0; kt < 2; ++kt)
#pragma unroll
    for (int ks = 0; ks < 2; ++ks) F.k[kt][ks] = *(const bf16x8*)(k0p + (size_t)kt * 4 * PN_LD + ks * 32);
#pragma unroll
  for (int dt = 0; dt < 4; ++dt) F.v[dt] = *(const bf16x8*)(vp + (size_t)dt * 16 * TT);
}
template <class Src>
DI void flash_step(const Src& S, int st, const FlashFrags<Src>& F, const bf16x8 (&qf)[2], f32x4 (&o)[4], float& mrun, float& lrun) {
  f32x4 s[2];
#pragma unroll
  for (int kt = 0; kt < 2; ++kt) {
    s[kt] = (f32x4){0.f, 0.f, 0.f, 0.f};
#pragma unroll
    for (int ks = 0; ks < 2; ++ks) s[kt] = mfma16(F.k[kt][ks], qf[ks], s[kt]);
  }
  float mt = NEG_BIG;
#pragma unroll
  for (int kt = 0; kt < 2; ++kt)
#pragma unroll
    for (int r = 0; r < 4; ++r) { s[kt][r] = S.score(s[kt][r], st, kt, r); mt = fmaxf(mt, s[kt][r]); }
  mt = rows_max(mt);
  const bool need = mt > mrun + 8.f;
  if (__any(need)) {
    const float mnew = need ? mt : mrun;
    const float alpha = __builtin_amdgcn_exp2f(mrun - mnew);
    lrun *= alpha;
#pragma unroll
    for (int dt = 0; dt < 4; ++dt) { o[dt][0] *= alpha; o[dt][1] *= alpha; o[dt][2] *= alpha; o[dt][3] *= alpha; }
    mrun = mnew;
  }
  float pv[8], ls = 0.f;
#pragma unroll
  for (int kt = 0; kt < 2; ++kt)
#pragma unroll
    for (int r = 0; r < 4; ++r) { pv[kt * 4 + r] = __builtin_amdgcn_exp2f(s[kt][r] - mrun); ls += pv[kt * 4 + r]; }
  lrun += ls;
  u32x4 pk = {pk2(pv[0], pv[1]), pk2(pv[2], pv[3]), pk2(pv[4], pv[5]), pk2(pv[6], pv[7])};
  const bf16x8 pf = __builtin_bit_cast(bf16x8, pk);
#pragma unroll
  for (int dt = 0; dt < 4; ++dt) o[dt] = mfma16(F.v[dt], pf, o[dt]);
}
template <class Src>
DI void flash_wave(const Src& S, const bf16_t* qptr  , f32x4 (&o)[4], float& ltot) {
  bf16x8 qf[2];
  qf[0] = *(const bf16x8*)(qptr); qf[1] = *(const bf16x8*)(qptr + 32);
  float mrun = NEG_BIG, lrun = 0.f;
#pragma unroll
  for (int dt = 0; dt < 4; ++dt) o[dt] = (f32x4){0.f, 0.f, 0.f, 0.f};
  const int ns = S.nsteps();
  FlashFrags<Src> f0, f1, f2;
  flash_load(S, 0, f0);
  if (ns > 1) flash_load(S, 1, f1);
  for (int st = 0; st < ns; st += 3) {
    if (st + 2 < ns) flash_load(S, st + 2, f2);
    flash_step(S, st, f0, qf, o, mrun, lrun);
    if (st + 1 < ns) {
      if (st + 3 < ns) flash_load(S, st + 3, f0);
      flash_step(S, st + 1, f1, qf, o, mrun, lrun);
    }
    if (st + 2 < ns) {
      if (st + 4 < ns) flash_load(S, st + 4, f1);
      flash_step(S, st + 2, f2, qf, o, mrun, lrun);
    }
  }
  ltot = rows_sum(lrun);
}

DI void nat_wave_task(const Params& p, int l, int b, int head, int rq, int ct, const float* rpb_lds) {
  const int lane = ltid() & 63, lr = lane & 15, g = lane >> 4;
  const bf16_t* PN = (const bf16_t*)(p.ws + OFF_P);
  const bf16_t* VT = (const bf16_t*)(p.ws + OFF_VT);
  bf16_t* Y = (bf16_t*)(p.ws + OFF_Y);
  SrcNat S;
  S.PN = PN; S.VT = VT; S.kcol = C_NK + head * 64; S.vrow = R_NV + head * 64; S.b = b; S.rq = rq; S.lr = lr; S.g = g;
  int rs = rq - 4; rs = rs < 0 ? 0 : (rs > 24 ? 24 : rs);
  S.rs = rs;
  int cs = 16 * ct - 8; cs = cs < 0 ? 0 : (cs > 32 ? 32 : cs);
  S.cs = cs;
  S.qc = 16 * ct + lr;
  int cst = S.qc - 8; cst = cst < 0 ? 0 : (cst > 48 ? 48 : cst);
  S.cstart = cst;
  S.rpbh = rpb_lds + head * 465;
  f32x4 o[4];
  float lt;
  const int qtok = b * 2048 + rq * 64 + 16 * ct + lr;
  flash_wave<SrcNat>(S, PN + (size_t)qtok * PN_LD + C_NQ + head * 64 + 8 * g, o, lt);
  const float inv = 1.f / lt;
#pragma unroll
  for (int dt = 0; dt < 4; ++dt) {
    u32x2 ov = {pk2(o[dt][0] * inv, o[dt][1] * inv), pk2(o[dt][2] * inv, o[dt][3] * inv)};
    *(u32x2*)(Y + (size_t)qtok * 1024 + 256 + head * 64 + dt * 16 + 4 * g) = ov;
  }
}
DI void natctx_wave_task(const Params& p, int b, int head, int qt) {
  const int lane = ltid() & 63, lr = lane & 15, g = lane >> 4;
  const bf16_t* PN = (const bf16_t*)(p.ws + OFF_P);
  const bf16_t* VT = (const bf16_t*)(p.ws + OFF_VT);
  bf16_t* Y = (bf16_t*)(p.ws + OFF_Y);
  SrcSeg S;
  S.PN = PN; S.VT = VT; S.kcol = C_NK + head * 64; S.vrow = R_NV + head * 64; S.lr = lr; S.g = g;
  S.t0 = TL + b * 256; S.n0 = 8; S.t1 = 0; S.n1 = 0;
  f32x4 o[4];
  float lt;
  const int qtok = TL + b * 256 + qt * 16 + lr;
  flash_wave<SrcSeg>(S, PN + (size_t)qtok * PN_LD + C_NQ + head * 64 + 8 * g, o, lt);
  const float inv = 1.f / lt;
#pragma unroll
  for (int dt = 0; dt < 4; ++dt) {
    u32x2 ov = {pk2(o[dt][0] * inv, o[dt][1] * inv), pk2(o[dt][2] * inv, o[dt][3] * inv)};
    *(u32x2*)(Y + (size_t)qtok * 1024 + 256 + head * 64 + dt * 16 + 4 * g) = ov;
  }
}

DI void diff_block_task(const Params& p, int l, int b, int hd, int qtok0, int nsteps, unsigned char* lds, int dvar = 0) {
  const int tid = ltid(), lane = tid & 63, w = tid >> 6, lr = lane & 15, g = lane >> 4;
  unsigned char* Kb = lds;
  unsigned char* Vb = lds + 8192;
  const bf16_t* PN = (const bf16_t*)(p.ws + OFF_P);
  const bf16_t* VT = (const bf16_t*)(p.ws + OFF_VT);
  bf16_t* Y = (bf16_t*)(p.ws + OFF_Y);
  bf16x8 qf[2][2][2];
#pragma unroll
  for (int qt = 0; qt < 2; ++qt) {
    const bf16_t* qp = PN + (size_t)(qtok0 + 32 * w + 16 * qt + lr) * PN_LD + C_DQ + hd * 128 + 8 * g;
#pragma unroll
    for (int m = 0; m < 2; ++m)
#pragma unroll
      for (int ks = 0; ks < 2; ++ks) {
        const u32x4 raw = *(const u32x4*)(qp + m * 64 + ks * 32);
        float f[8];
        unpack8(raw, f);
        u32x4 sc = {pk2(f[0] * SC_LOG2, f[1] * SC_LOG2), pk2(f[2] * SC_LOG2, f[3] * SC_LOG2), pk2(f[4] * SC_LOG2, f[5] * SC_LOG2), pk2(f[6] * SC_LOG2, f[7] * SC_LOG2)};
        qf[m][qt][ks] = __builtin_bit_cast(bf16x8, sc);
      }
  }
  const int wu = __builtin_amdgcn_readfirstlane(w);
  unsigned kofs[2], vofs[2];
#pragma unroll
  for (int jj = 0; jj < 2; ++jj) {
    const int krow = 4 * (2 * w + jj) + (lane >> 4), kpc = lane & 15;
    const int kch = kpc ^ (((krow >> 3) & 3) * 4 + (krow & 3));
    kofs[jj] = (unsigned)(krow * PN_LD + C_DK + hd * 128 + kch * 8);
    const int vrow = 16 * (2 * w + jj) + (lane >> 2), vpc = lane & 3;
    const int vch = vpc ^ ((vrow >> 2) & 3);
    vofs[jj] = (unsigned)((R_DV + hd * 128 + vrow) * TT + vch * 8);
  }
#define DB_DMA(st, sl) do { const int tk = (st) < 8 ? TL + b * 256 + (st) * 32 : b * 2048 + ((st) - 8) * 32; \
    const bf16_t* kb_ = PN + (size_t)tk * PN_LD; const bf16_t* vb_ = VT + tk; \
    _Pragma("unroll") for (int jj = 0; jj < 2; ++jj) { \
      __builtin_amdgcn_global_load_lds((const unsigned*)(kb_ + kofs[jj]), (unsigned*)(Kb + (sl) * 16384 + (2 * wu + jj) * 1024), 16, 0, 0); \
      __builtin_amdgcn_global_load_lds((const unsigned*)(vb_ + vofs[jj]), (unsigned*)(Vb + (sl) * 16384 + (2 * wu + jj) * 1024), 16, 0, 0); } } while (0)
  asm volatile("s_waitcnt vmcnt(0)" ::: "memory");
  __syncthreads();
  DB_DMA(0, 0);
  DB_DMA(nsteps > 1 ? 1 : 0, 1);
  DB_DMA(nsteps > 2 ? 2 : nsteps - 1, 2);
  asm volatile("s_waitcnt vmcnt(8)" ::: "memory");
  __builtin_amdgcn_s_barrier();

  f32x4 o[2][2][8];
  float mrun[2][2], lrun[2][2];
#pragma unroll
  for (int m = 0; m < 2; ++m)
#pragma unroll
    for (int qt = 0; qt < 2; ++qt) {
      mrun[m][qt] = NEG_BIG; lrun[m][qt] = 0.f;
#pragma unroll
      for (int dt = 0; dt < 8; ++dt) o[m][qt][dt] = (f32x4){0.f, 0.f, 0.f, 0.f};
    }
  const int kfr = 8 * (lr >> 2) + (lr & 3);
  for (int st = 0; st < nsteps; ++st) {
    if (dvar != 1) { const int sn = st + 3 < nsteps ? st + 3 : nsteps - 1; DB_DMA(sn, (st + 3) & 3); }
    const unsigned char* Kt = Kb + (st & 3) * 16384;
    const unsigned char* Vt = Vb + (st & 3) * 16384;
    bf16x8 pf[2][2];
#pragma unroll
    for (int m = 0; m < 2; ++m) {
      bf16x8 kf[2][2];
#pragma unroll
      for (int kt = 0; kt < 2; ++kt)
#pragma unroll
        for (int ks = 0; ks < 2; ++ks) kf[kt][ks] = *(const bf16x8*)(Kt + (kfr + 4 * kt) * 256 + (((m * 8 + ks * 4 + g) ^ lr) << 4));
      __builtin_amdgcn_sched_barrier(0);
      f32x4 s[2][2];
#pragma unroll
      for (int qt = 0; qt < 2; ++qt)
#pragma unroll
        for (int kt = 0; kt < 2; ++kt) {
          s[qt][kt] = (f32x4){0.f, 0.f, 0.f, 0.f};
#pragma unroll
          for (int ks = 0; ks < 2; ++ks) s[qt][kt] = mfma16(kf[kt][ks], qf[m][qt][ks], s[qt][kt]);
        }
      __builtin_amdgcn_sched_barrier(0);
#pragma unroll
      for (int qt = 0; qt < 2; ++qt) {
        if (dvar == 2) {
          u32x4 pk = {pk2(s[qt][0][0], s[qt][0][1]), pk2(s[qt][0][2], s[qt][0][3]), pk2(s[qt][1][0], s[qt][1][1]), pk2(s[qt][1][2], s[qt][1][3])};
          pf[m][qt] = __builtin_bit_cast(bf16x8, pk);
          continue;
        }
        float mt = NEG_BIG;
#pragma unroll
        for (int kt = 0; kt < 2; ++kt)
#pragma unroll
          for (int r = 0; r < 4; ++r) mt = fmaxf(mt, s[qt][kt][r]);
        mt = rows_max(mt);
        const bool need = mt > mrun[m][qt] + 8.f;
        if (__any(need)) {
          const float mnew = need ? mt : mrun[m][qt];
          const float alpha = __builtin_amdgcn_exp2f(mrun[m][qt] - mnew);
          lrun[m][qt] *= alpha;
#pragma unroll
          for (int dt = 0; dt < 8; ++dt) { o[m][qt][dt][0] *= alpha; o[m][qt][dt][1] *= alpha; o[m][qt][dt][2] *= alpha; o[m][qt][dt][3] *= alpha; }
          mrun[m][qt] = mnew;
        }
        float pv[8], ls = 0.f;
#pragma unroll
        for (int kt = 0; kt < 2; ++kt)
#pragma unroll
          for (int r = 0; r < 4; ++r) { pv[kt * 4 + r] = __builtin_amdgcn_exp2f(s[qt][kt][r] - mrun[m][qt]); ls += pv[kt * 4 + r]; }
        lrun[m][qt] += ls;
        u32x4 pk = {pk2(pv[0], pv[1]), pk2(pv[2], pv[3]), pk2(pv[4], pv[5]), pk2(pv[6], pv[7])};
        pf[m][qt] = __builtin_bit_cast(bf16x8, pk);
      }
      __builtin_amdgcn_sched_barrier(0);
    }
#pragma unroll
    for (int hb = 0; hb < 2; ++hb) {
      bf16x8 vf[4];
#pragma unroll
      for (int d4 = 0; d4 < 4; ++d4) {
        const int vr = 16 * (4 * hb + d4) + lr;
        vf[d4] = *(const bf16x8*)(Vt + vr * 64 + ((g ^ ((vr >> 2) & 3)) << 4));
      }
      __builtin_amdgcn_sched_barrier(0);
#pragma unroll
      for (int d4 = 0; d4 < 4; ++d4)
#pragma unroll
        for (int m = 0; m < 2; ++m)
#pragma unroll
          for (int qt = 0; qt < 2; ++qt) { if (dvar == 3) asm volatile("" :: "v"(vf[d4]), "v"(pf[m][qt])); else o[m][qt][4 * hb + d4] = mfma16(vf[d4], pf[m][qt], o[m][qt][4 * hb + d4]); }
      __builtin_amdgcn_sched_barrier(0);
    }
    asm volatile("s_waitcnt vmcnt(8)" ::: "memory");
    __builtin_amdgcn_s_barrier();
  }
  asm volatile("s_waitcnt vmcnt(0)" ::: "memory");
#undef DB_DMA
  const float* lv = p.dlam + l * 256;
  float sa = lv[lane] * lv[64 + lane], sb = lv[128 + lane] * lv[192 + lane];
  sa = wave_sum(sa); sb = wave_sum(sb);
  const float lam_init = 0.8f - 0.6f * expf(-0.3f * (float)l);
  const float lam = expf(sa) - expf(sb) + lam_init;
  const float* dg = p.diff_g + l * 512 + hd * 128;
#pragma unroll
  for (int qt = 0; qt < 2; ++qt) {
    float l0 = lrun[0][qt], l1 = lrun[1][qt];
    l0 = rows_sum(l0);
    l1 = rows_sum(l1);
    const float i0 = 1.f / l0, i1 = lam / l1;
    float ss = 0.f;
#pragma unroll
    for (int dt = 0; dt < 8; ++dt)
#pragma unroll
      for (int r = 0; r < 4; ++r) { const float v = o[0][qt][dt][r] * i0 - o[1][qt][dt][r] * i1; o[0][qt][dt][r] = v; ss += v * v; }
    ss = rows_sum(ss);
    const float rstd = rsqrtf(ss * (1.f / 128.f) + 1e-6f) * (1.f - lam_init);
    const int qtok = qtok0 + 32 * w + 16 * qt + lr;
#pragma unroll
    for (int dt = 0; dt < 8; ++dt) {
      const float4 gg = *(const float4*)(dg + dt * 16 + 4 * g);
      u32x2 ov = {pk2(o[0][qt][dt][0] * rstd * gg.x, o[0][qt][dt][1] * rstd * gg.y), pk2(o[0][qt][dt][2] * rstd * gg.z, o[0][qt][dt][3] * rstd * gg.w)};
      *(u32x2*)(Y + (size_t)qtok * 1024 + 512 + hd * 128 + dt * 16 + 4 * g) = ov;
    }
  }
}


DI void nat_block_task(const Params& p, int l, int b, int head, int rq, const float* rpb_lds, unsigned char* lds) {
  const int tid = ltid(), lane = tid & 63, w = tid >> 6, lr = lane & 15, g = lane >> 4;
  const int wu = __builtin_amdgcn_readfirstlane(w);
  unsigned char* Kb = lds;
  unsigned char* Vb = lds + 16384;
  const bf16_t* PN = (const bf16_t*)(p.ws + OFF_P);
  const bf16_t* VT = (const bf16_t*)(p.ws + OFF_VT);
  bf16_t* Y = (bf16_t*)(p.ws + OFF_Y);
  int rs = rq - 4; rs = rs < 0 ? 0 : (rs > 24 ? 24 : rs);
  const int ct = w;
  int cs = 16 * ct - 8; cs = cs < 0 ? 0 : (cs > 32 ? 32 : cs);
  const int qc = 16 * ct + lr;
  int cstart = qc - 8; cstart = cstart < 0 ? 0 : (cstart > 48 ? 48 : cstart);
  const float* rpbh = rpb_lds + head * 465;
  const int qtok = b * 2048 + rq * 64 + qc;
  bf16x8 qf[2];
  { const bf16_t* qp = PN + (size_t)qtok * PN_LD + C_NQ + head * 64 + 8 * g; qf[0] = *(const bf16x8*)qp; qf[1] = *(const bf16x8*)(qp + 32); }
  unsigned kofs[2], vofs[2];
#pragma unroll
  for (int jj = 0; jj < 2; ++jj) {
    const int pidx = 2 * w + jj, row = 8 * pidx + (lane >> 3);
    const int kch = (lane & 7) ^ ((((row >> 3) & 3) << 1) | ((row >> 1) & 1));
    kofs[jj] = (unsigned)(row * PN_LD + C_NK + head * 64 + kch * 8);
    const int vch = (lane & 7) ^ ((row >> 1) & 7);
    vofs[jj] = (unsigned)((R_NV + head * 64 + row) * TT + vch * 8);
  }
#define NB_DMA(st, bf) do { const int tk = (st) < 8 ? b * 2048 + (rs + (st)) * 64 : TL + b * 256 + ((st) - 8) * 64; \
    const bf16_t* kb_ = PN + (size_t)tk * PN_LD; const bf16_t* vb_ = VT + tk; \
    _Pragma("unroll") for (int jj = 0; jj < 2; ++jj) { \
      __builtin_amdgcn_global_load_lds((const unsigned*)(kb_ + kofs[jj]), (unsigned*)(Kb + (bf) * 8192 + (2 * wu + jj) * 1024), 16, 0, 0); \
      __builtin_amdgcn_global_load_lds((const unsigned*)(vb_ + vofs[jj]), (unsigned*)(Vb + (bf) * 8192 + (2 * wu + jj) * 1024), 16, 0, 0); } } while (0)
  __syncthreads();
  NB_DMA(0, 0);
  asm volatile("s_waitcnt vmcnt(0)" ::: "memory");
  __syncthreads();
  f32x4 o[4];
#pragma unroll
  for (int dt = 0; dt < 4; ++dt) o[dt] = (f32x4){0.f, 0.f, 0.f, 0.f};
  float mrun = NEG_BIG, lrun = 0.f;
  const int kap = 8 * (lr >> 2) + (lr & 3);
  for (int st = 0; st < 12; ++st) {
    if (st + 1 < 12) NB_DMA(st + 1, (st + 1) & 1);
    const unsigned char* Kt = Kb + (st & 1) * 8192;
    const unsigned char* Vt = Vb + (st & 1) * 8192;
    const int nsub = st < 8 ? 1 : 2;
    for (int sub = 0; sub < nsub; ++sub) {
      const int koff = st < 8 ? cs : 32 * sub;
      bf16x8 kf[2][2], vf[4];
#pragma unroll
      for (int kt = 0; kt < 2; ++kt) {
        const int row = koff + kap + 4 * kt;
        const int sw = (((row >> 3) & 3) << 1) | ((row >> 1) & 1);
#pragma unroll
        for (int ks = 0; ks < 2; ++ks) kf[kt][ks] = *(const bf16x8*)(Kt + (row >> 1) * 256 + ((((row & 1) << 3) | ((ks * 4 + g) ^ sw)) << 4));
      }
#pragma unroll
      for (int dt = 0; dt < 4; ++dt) {
        const int row = 16 * dt + lr, ch = (koff >> 3) + g;
        vf[dt] = *(const bf16x8*)(Vt + (row >> 1) * 256 + (((((row & 1) << 3) | ch) ^ ((row >> 1) & 7)) << 4));
      }
      f32x4 s[2];
#pragma unroll
      for (int kt = 0; kt < 2; ++kt) {
        s[kt] = (f32x4){0.f, 0.f, 0.f, 0.f};
#pragma unroll
        for (int ks = 0; ks < 2; ++ks) s[kt] = mfma16(kf[kt][ks], qf[ks], s[kt]);
      }
      float mt = NEG_BIG;
#pragma unroll
      for (int kt = 0; kt < 2; ++kt)
#pragma unroll
        for (int r = 0; r < 4; ++r) {
          float sv;
          if (st < 8) {
            const int kc = cs + 8 * g + 4 * kt + r;
            const bool valid = (kc >= cstart) && (kc < cstart + 16);
            int dc = kc - qc + 15; dc = dc < 0 ? 0 : (dc > 30 ? 30 : dc);
            const float bias = rpbh[(rs + st - rq + 7) * 31 + dc];
            sv = valid ? (s[kt][r] * 0.125f + bias) * LOG2E : NEG_BIG;
          } else sv = s[kt][r] * SC_LOG2;
          s[kt][r] = sv; mt = fmaxf(mt, sv);
        }
      mt = rows_max(mt);
      const bool need = mt > mrun + 8.f;
      if (__any(need)) {
        const float mnew = need ? mt : mrun;
        const float alpha = __builtin_amdgcn_exp2f(mrun - mnew);
        lrun *= alpha;
#pragma unroll
        for (int dt = 0; dt < 4; ++dt) { o[dt][0] *= alpha; o[dt][1] *= alpha; o[dt][2] *= alpha; o[dt][3] *= alpha; }
        mrun = mnew;
      }
      float pv[8], ls = 0.f;
#pragma unroll
      for (int kt = 0; kt < 2; ++kt)
#pragma unroll
        for (int r = 0; r < 4; ++r) { pv[kt * 4 + r] = __builtin_amdgcn_exp2f(s[kt][r] - mrun); ls += pv[kt * 4 + r]; }
      lrun += ls;
      u32x4 pk = {pk2(pv[0], pv[1]), pk2(pv[2], pv[3]), pk2(pv[4], pv[5]), pk2(pv[6], pv[7])};
      const bf16x8 pf = __builtin_bit_cast(bf16x8, pk);
#pragma unroll
      for (int dt = 0; dt < 4; ++dt) o[dt] = mfma16(vf[dt], pf, o[dt]);
    }
    asm volatile("s_waitcnt vmcnt(0)" ::: "memory");
    __syncthreads();
  }
#undef NB_DMA
  const float inv = 1.f / rows_sum(lrun);
#pragma unroll
  for (int dt = 0; dt < 4; ++dt) {
    u32x2 ov = {pk2(o[dt][0] * inv, o[dt][1] * inv), pk2(o[dt][2] * inv, o[dt][3] * inv)};
    *(u32x2*)(Y + (size_t)qtok * 1024 + 256 + head * 64 + dt * 16 + 4 * g) = ov;
  }
}

DI float quad_sum(float v) {
  v += __int_as_float(__builtin_amdgcn_mov_dpp(__float_as_int(v), 0xB1, 0xF, 0xF, true));
  v += __int_as_float(__builtin_amdgcn_mov_dpp(__float_as_int(v), 0x4E, 0xF, 0xF, true));
  return v;
}
DI void gla_task(const Params& p, int l, int task, unsigned char* lds, int var = 0) {
  const int tid = ltid(), lane = tid & 63, w = tid >> 6, vv = lane >> 2, g = lane & 3;
  const int b = task >> 3, h = (task >> 1) & 3, dir = task & 1;
  const bf16_t* PN = (const bf16_t*)(p.ws + OFF_P);
  const bf16_t* VT = (const bf16_t*)(p.ws + OFF_VT);
  float* og = (float*)(p.ws + OFF_H);
  float* Gup = (float*)lds;
  float* Gb = Gup + 512;
  float* As = Gb + 32;
  float* Ks = As + 2048;
  float* Qs = Ks + 2048;
  float* Vs = Qs + 2048;
  __syncthreads();
  for (int e = tid; e < 512; e += 256) { const int r = e >> 5, kd = e & 31; Gup[e] = p.gate_up[((size_t)(l * 2 + dir) * 16 + r) * 128 + h * 32 + kd]; }
  if (tid < 32) Gb[tid] = p.gate_b[(l * 2 + dir) * 128 + h * 32 + tid];
  float S[8];
#pragma unroll
  for (int e = 0; e < 8; ++e) S[e] = 0.f;
  const int si = tid >> 2, part = tid & 3;
  u32x4 rq, rk, rg0, rg1, rv0, rv1;
#define GLA_TOK0(cc) ((cc) < 4 ? TL + b * 256 + (dir == 0 ? (cc) : 3 - (cc)) * 64 : b * 2048 + (dir == 0 ? (cc) - 4 : 35 - (cc)) * 64)
#define GLA_LOAD(cc) do { const int t0_ = GLA_TOK0(cc); const bf16_t* row = PN + (size_t)(t0_ + si) * PN_LD; \
    rq = *(const u32x4*)(row + C_GQ + h * 32 + part * 8); rk = *(const u32x4*)(row + C_GK + h * 32 + part * 8); \
    rg0 = *(const u32x4*)(row + C_GATE + dir * 16); rg1 = *(const u32x4*)(row + C_GATE + dir * 16 + 8); \
    const bf16_t* vp = VT + (size_t)(R_GV + h * 64 + si) * TT + t0_ + part * 16; rv0 = *(const u32x4*)vp; rv1 = *(const u32x4*)(vp + 8); } while (0)
#define GLA_WRITE() do { float gd[16], qf[8], kf[8], vf[16]; \
    unpack8(rg0, gd); unpack8(rg1, gd + 8); unpack8(rq, qf); unpack8(rk, kf); unpack8(rv0, vf); unpack8(rv1, vf + 8); \
    _Pragma("unroll") for (int e = 0; e < 8; ++e) { const int kd = part * 8 + e; float pre = Gb[kd]; \
      _Pragma("unroll") for (int r = 0; r < 16; ++r) pre += gd[r] * Gup[r * 32 + kd]; \
      const float ls = fminf(pre, 0.f) - log1pf(__expf(-fabsf(pre))); \
      As[si * 32 + kd] = __expf(ls * (1.f / 16.f)); Ks[si * 32 + kd] = kf[e]; Qs[si * 32 + kd] = qf[e] * 0.17677669529663687f; } \
    _Pragma("unroll") for (int e = 0; e < 16; ++e) Vs[(part * 16 + e) * 65 + si] = vf[e]; } while (0)
  GLA_LOAD(0);
  __syncthreads();
  GLA_WRITE();
  __syncthreads();
  for (int cc = 0; cc < 36; ++cc) {
    const int tok0 = GLA_TOK0(cc);
    if (cc + 1 < 36) GLA_LOAD(cc + 1);
    float* ob = og + ((size_t)dir * TT + tok0) * 256 + h * 64 + 16 * w + vv;
#pragma unroll 1
    for (int s0 = 0; s0 < (var == 3 ? 4 : 64); s0 += 4) {
      float4 a0[4], a1[4], k0[4], k1[4], q0[4], q1[4];
      float vx[4];
#pragma unroll
      for (int u = 0; u < 4; ++u) {
        const int i = dir == 0 ? s0 + u : 63 - s0 - u;
        a0[u] = *(const float4*)(As + i * 32 + 8 * g); a1[u] = *(const float4*)(As + i * 32 + 8 * g + 4);
        k0[u] = *(const float4*)(Ks + i * 32 + 8 * g); k1[u] = *(const float4*)(Ks + i * 32 + 8 * g + 4);
        q0[u] = *(const float4*)(Qs + i * 32 + 8 * g); q1[u] = *(const float4*)(Qs + i * 32 + 8 * g + 4);
        vx[u] = Vs[i * 65 + 16 * w + vv];
      }
#pragma unroll
      for (int u = 0; u < 4; ++u) {
        const int i = dir == 0 ? s0 + u : 63 - s0 - u;
        const float v = vx[u];
        S[0] = fmaf(a0[u].x, S[0], k0[u].x * v); S[1] = fmaf(a0[u].y, S[1], k0[u].y * v);
        S[2] = fmaf(a0[u].z, S[2], k0[u].z * v); S[3] = fmaf(a0[u].w, S[3], k0[u].w * v);
        S[4] = fmaf(a1[u].x, S[4], k1[u].x * v); S[5] = fmaf(a1[u].y, S[5], k1[u].y * v);
        S[6] = fmaf(a1[u].z, S[6], k1[u].z * v); S[7] = fmaf(a1[u].w, S[7], k1[u].w * v);
        const float oa = fmaf(q0[u].x, S[0], q0[u].y * S[1]), ob2 = fmaf(q0[u].z, S[2], q0[u].w * S[3]);
        const float oc = fmaf(q1[u].x, S[4], q1[u].y * S[5]), od = fmaf(q1[u].z, S[6], q1[u].w * S[7]);
        float o = (oa + ob2) + (oc + od);
        o = quad_sum(o);
        if (var == 1) asm volatile("" :: "v"(o)); else if (g == 0) ob[(size_t)i * 256] = o;
      }
    }
    __syncthreads();
    if (cc + 1 < 36 && var != 2) GLA_WRITE();
    __syncthreads();
  }
#undef GLA_TOK0
#undef GLA_LOAD
#undef GLA_WRITE
}

DI void phase_mixers(const Params& p, int l, bool last, unsigned* ctr, unsigned char* lds, int mask = 15, int gvar = 0) {
  const int tid = ltid(), w = tid >> 6;
  volatile int* slot = (volatile int*)(lds + LDS_BYTES - 16);
  float* rpb_lds = (float*)(lds + 65536);
  for (int e = tid; e < 4 * 465; e += 256) rpb_lds[e] = p.rpb[(size_t)l * 4 * 465 + e];
  const int nconv = (l == 0 && (mask & 8)) ? 1024 : 0;
  const int t1 = 128 + nconv, t2 = t1 + 1024, t3 = t2 + 2048, t4 = t3 + 128;
  const int ntask = last ? t3 : t4 + 256;
  for (;;) {
    __syncthreads();
    if (tid == 0) *slot = (int)atomicAdd(ctr, 1u);
    __syncthreads();
    const int task = *slot;
    if (task >= ntask) break;
    if (task < 128) { if (mask & 1) { __builtin_amdgcn_s_setprio(3); gla_task(p, l, task, lds, gvar); __builtin_amdgcn_s_setprio(0); } }
    else if (nconv && task < t2 && ((task - 128) & 1)) { const int c = (task - 128) >> 1; convert_table_pairs(p, c * 64, c * 64 + 64, w, 4, tid & 63); }
    else if (!(mask & 2) && (task < t2 || (task >= t3 && task < t4))) {}
    else if (!(mask & 4) && ((task >= t2 && task < t3) || task >= t4)) {}
    else if (task < t2) { const int d = nconv ? (task - 128) >> 1 : task - 128; const int b = d >> 6; diff_block_task(p, l, b, (d >> 4) & 3, b * 2048 + (d & 15) * 128, 72, lds, gvar); }
    else if (task < t3) { const int d = task - t2; nat_block_task(p, l, d >> 7, (d >> 5) & 3, d & 31, rpb_lds, lds); }
    else if (task < t4) { const int d = task - t3; const int b = d >> 3; diff_block_task(p, l, b, (d >> 1) & 3, TL + b * 256 + (d & 1) * 128, 8, lds); }
    else { const int wt = (task - t4) * 4 + w; natctx_wave_task(p, wt >> 6, (wt >> 4) & 3, wt & 15); }
  }
}

DI void phase_gla_fin(const Params& p, int l, int ntok) {
  const int lane = ltid() & 63, gw = lbid() * 4 + (ltid() >> 6), nw = lgdim() * 4;
  const float* og = (const float*)(p.ws + OFF_H);
  const bf16_t* PN = (const bf16_t*)(p.ws + OFF_P);
  bf16_t* Y = (bf16_t*)(p.ws + OFF_Y);
  const float4 gg = *(const float4*)(p.gla_norm_g + l * 256 + 4 * lane);
  for (int t = gw; t < ntok; t += nw) {
    const float4 a = *(const float4*)(og + (size_t)t * 256 + 4 * lane), bq = *(const float4*)(og + ((size_t)TT + t) * 256 + 4 * lane);
    const float o0 = a.x + bq.x, o1 = a.y + bq.y, o2 = a.z + bq.z, o3 = a.w + bq.w;
    float ss = o0 * o0 + o1 * o1 + o2 * o2 + o3 * o3;
    ss += __shfl_xor(ss, 1); ss += __shfl_xor(ss, 2); ss += __shfl_xor(ss, 4); ss += __shfl_xor(ss, 8);
    const float rstd = rsqrtf(ss * (1.f / 64.f) + 1e-6f);
    const u32x2 rv = *(const u32x2*)(PN + (size_t)t * PN_LD + C_GR + 4 * lane);
    const float r0 = bflo(rv.x), r1 = bfhi(rv.x), r2 = bflo(rv.y), r3 = bfhi(rv.y);
    const float y0 = o0 * rstd * gg.x * (r0 / (1.f + __expf(-r0)));
    const float y1 = o1 * rstd * gg.y * (r1 / (1.f + __expf(-r1)));
    const float y2 = o2 * rstd * gg.z * (r2 / (1.f + __expf(-r2)));
    const float y3 = o3 * rstd * gg.w * (r3 / (1.f + __expf(-r3)));
    u32x2 ov = {pk2(y0, y1), pk2(y2, y3)};
    *(u32x2*)(Y + (size_t)t * 1024 + 4 * lane) = ov;
  }
}

struct PairTab { int a[52], b[52]; };
constexpr PairTab make_pairs() {
  PairTab t{};
  int n = 0;
  for (int a = 0; a < 16; ++a)
    for (int b = 0; b < 16; ++b)
      if ((a + 1) * (b + 1) <= 16) { t.a[n] = a; t.b[n] = b; ++n; }
  for (; n < 52; ++n) { t.a[n] = -1; t.b[n] = -1; }
  return t;
}

DI void topk_half(const bf16_t* skh  , const bf16_t* qrow  , int lr, int g, float (&list)[16]) {
  bf16x8 qf[2];
  qf[0] = *(const bf16x8*)(qrow); qf[1] = *(const bf16x8*)(qrow + 32);
  float s[32];
#pragma unroll
  for (int nt = 0; nt < 8; ++nt) {
    f32x4 acc = {0.f, 0.f, 0.f, 0.f};
#pragma unroll
    for (int ks = 0; ks < 2; ++ks) {
      const bf16x8 af = *(const bf16x8*)(skh + (size_t)(nt * 16 + lr) * 64 + ks * 32 + 8 * g);
      acc = mfma16(af, qf[ks], acc);
    }
#pragma unroll
    for (int r = 0; r < 4; ++r) {
      const unsigned n = nt * 16 + 4 * g + r;
      s[nt * 4 + r] = __uint_as_float((__float_as_uint(acc[r]) & ~127u) | n);
    }
  }
#pragma unroll
  for (int k = 0; k < 16; ++k) {
    float m = s[0];
#pragma unroll
    for (int i = 1; i < 32; ++i) m = fmaxf(m, s[i]);
    m = fmaxf(m, __shfl_xor(m, 16));
    m = fmaxf(m, __shfl_xor(m, 32));
    list[k] = m;
#pragma unroll
    for (int i = 0; i < 32; ++i) s[i] = (s[i] == m) ? -3.0e38f : s[i];
  }
}

DI void topk_tile(const bf16_t* QP, const bf16_t* sk, int tt, int hd, int* eid_rows, float* gate_rows, int lr, int g) {
  constexpr PairTab PT = make_pairs();
  {
    const int tok = tt * 16 + lr;
    float v1[16], v2[16];
    topk_half(sk, QP + (size_t)tok * 1024 + hd * 128 + 8 * g, lr, g, v1);
    __builtin_amdgcn_sched_barrier(0);
    topk_half(sk + 128 * 64, QP + (size_t)tok * 1024 + hd * 128 + 64 + 8 * g, lr, g, v2);
    __builtin_amdgcn_sched_barrier(0);
    float cand[13];
    int ceid[13];
#pragma unroll
    for (int c = 0; c < 13; ++c) {
      float sv[4];
      int ev[4];
#pragma unroll
      for (int gi = 0; gi < 4; ++gi) {
        const int pi = 4 * c + gi;
        if (PT.a[pi] >= 0) {
          const float a = v1[PT.a[pi] < 0 ? 0 : PT.a[pi]], bq = v2[PT.b[pi] < 0 ? 0 : PT.b[pi]];
          sv[gi] = __uint_as_float((__float_as_uint(a + bq) & ~63u) | (unsigned)pi);
          ev[gi] = (int)((__float_as_uint(a) & 127u) * 128u + (__float_as_uint(bq) & 127u));
        } else { sv[gi] = -3.0e38f; ev[gi] = 0; }
      }
      cand[c] = g == 0 ? sv[0] : (g == 1 ? sv[1] : (g == 2 ? sv[2] : sv[3]));
      ceid[c] = g == 0 ? ev[0] : (g == 1 ? ev[1] : (g == 2 ? ev[2] : ev[3]));
    }
    float topv[16];
#pragma unroll
    for (int k = 0; k < 16; ++k) {
      float m = cand[0];
#pragma unroll
      for (int c = 1; c < 13; ++c) m = fmaxf(m, cand[c]);
      m = fmaxf(m, __shfl_xor(m, 16));
      m = fmaxf(m, __shfl_xor(m, 32));
      topv[k] = m;
      int my = -1;
#pragma unroll
      for (int c = 0; c < 13; ++c) { if (cand[c] == m) { my = ceid[c]; cand[c] = -3.0e38f; } }
      if (my >= 0) eid_rows[lr * 128 + hd * 16 + k] = my;
    }
    if (g == 0) {
      float ex[16], sum = 0.f;
#pragma unroll
      for (int k = 0; k < 16; ++k) { ex[k] = __expf(topv[k] - topv[0]); sum += ex[k]; }
      const float inv = 1.f / sum;
#pragma unroll
      for (int q = 0; q < 4; ++q) {
        float4 o = {ex[4 * q] * inv, ex[4 * q + 1] * inv, ex[4 * q + 2] * inv, ex[4 * q + 3] * inv};
        *(float4*)(gate_rows + lr * 128 + hd * 16 + 4 * q) = o;
      }
    }
  }
}

DI float gelu_tanh(float x) {
  const float z = 0.7978845608028654f * (x + 0.044715f * x * x * x);
  const float e = __expf(2.f * z);
  const float th = 1.f - 2.f / (e + 1.f);
  return 0.5f * x * (1.f + th);
}
DI void gather_token(const Params& p, int l, int t, const int* eid_row, const float* gate_row, unsigned char* hl, float* wl, bool dry) {
  const int lane = ltid() & 63, lr = lane & 15, g = lane >> 4;
  const unsigned char* U6 = p.ws + OFF_U + (size_t)l * 16384 * V6_PITCH;
  const unsigned char* V6 = p.ws + OFF_V + (size_t)l * 16384 * V6_PITCH;
  const int half = lane >> 5, blk = lane & 31;
  const unsigned char* H6 = p.ws + OFF_H8;
  float* xres = (float*)(p.ws + OFF_XRES);
  const float* modbuf = (const float*)(p.ws + OFF_MOD);
  {
    if (lane < 50) {
      const u32x4 hq = *(const u32x4*)(H6 + (size_t)t * V6_PITCH + lane * 16);
      *(u32x4*)(hl + lane * 16) = hq;
    }
    const int e0 = eid_row[lane], e1 = eid_row[64 + lane];
    const float gv0 = gate_row[lane], gv1 = gate_row[64 + lane];
    {
      const u32x2 hsc = *(const u32x2*)(hl + 768 + 8 * g);
#pragma unroll 1
      for (int grp = 0; grp < 8; ++grp) {
        const int er = __shfl(grp < 4 ? e0 : e1, (grp & 3) * 16 + lr);
        const unsigned char* ur = U6 + (size_t)er * V6_PITCH;
        u32x4 ua[8]; u32x2 ub[8];
#pragma unroll
        for (int s = 0; s < 8; ++s) { ua[s] = *(const u32x4*)(ur + 24 * (4 * s + g)); ub[s] = *(const u32x2*)(ur + 24 * (4 * s + g) + 16); }
        const u32x2 usc = *(const u32x2*)(ur + 768 + 8 * g);
        __builtin_amdgcn_sched_barrier(0);
        f32x4 acc = {0.f, 0.f, 0.f, 0.f};
#define G_STEP(s, OS, USC, HSC) do { const unsigned char* hb = hl + 24 * (4 * (s) + g); \
          const u32x2 h0 = *(const u32x2*)hb, h1 = *(const u32x2*)(hb + 8), h2v = *(const u32x2*)(hb + 16); \
          const i32x8 av = {(int)ua[s][0], (int)ua[s][1], (int)ua[s][2], (int)ua[s][3], (int)ub[s][0], (int)ub[s][1], 0, 0}; \
          const i32x8 bv = {(int)h0[0], (int)h0[1], (int)h1[0], (int)h1[1], (int)h2v[0], (int)h2v[1], 0, 0}; \
          acc = __builtin_amdgcn_mfma_scale_f32_16x16x128_f8f6f4(av, bv, acc, 2, 2, OS, (int)(USC), OS, (int)(HSC)); } while (0)
        G_STEP(0, 0, usc[0], hsc[0]); G_STEP(1, 1, usc[0], hsc[0]); G_STEP(2, 2, usc[0], hsc[0]); G_STEP(3, 3, usc[0], hsc[0]);
        G_STEP(4, 0, usc[1], hsc[1]); G_STEP(5, 1, usc[1], hsc[1]); G_STEP(6, 2, usc[1], hsc[1]); G_STEP(7, 3, usc[1], hsc[1]);
#undef G_STEP
        const float gvs = grp < 4 ? gv0 : gv1;
        const int lb_ = (grp & 3) * 16 + 4 * g;
        float4 wv_;
        wv_.x = __shfl(gvs, lb_) * gelu_tanh(acc[0]); wv_.y = __shfl(gvs, lb_ + 1) * gelu_tanh(acc[1]);
        wv_.z = __shfl(gvs, lb_ + 2) * gelu_tanh(acc[2]); wv_.w = __shfl(gvs, lb_ + 3) * gelu_tanh(acc[3]);
        if (lr == 0) *(float4*)(wl + grp * 16 + 4 * g) = wv_;
        __builtin_amdgcn_sched_barrier(0);
      }
    }
    __builtin_amdgcn_sched_barrier(0);
    float out[32];
#pragma unroll
    for (int i = 0; i < 32; ++i) out[i] = 0.f;
#pragma unroll 1
    for (int grp = 0; grp < 8; ++grp) {
      const int esel = grp < 4 ? e0 : e1;
      const int lb = (grp & 3) * 16;
      u32x4 vd4[8]; u32x2 vd2[8]; unsigned vsc[8];
#pragma unroll
      for (int pp = 0; pp < 8; ++pp) {
        const int ea = __builtin_amdgcn_readlane(esel, lb + 2 * pp), eb = __builtin_amdgcn_readlane(esel, lb + 2 * pp + 1);
        const unsigned char* vr = V6 + (size_t)(half ? eb : ea) * V6_PITCH;
        vd4[pp] = *(const u32x4*)(vr + 24 * blk); vd2[pp] = *(const u32x2*)(vr + 24 * blk + 16); vsc[pp] = vr[mx_scale_pos(blk)];
      }
      __builtin_amdgcn_sched_barrier(0);
#pragma unroll
      for (int pp = 0; pp < 8; ++pp) {
        const float wgt = wl[grp * 16 + 2 * pp + half] * __uint_as_float(vsc[pp] << 23);
        unsigned pk0 = vd4[pp][0], pk1 = vd4[pp][1];
        asm volatile("" : "+v"(pk0) : "v"(out[0]), "v"(out[1]), "v"(out[2]), "v"(out[3]), "v"(out[4]), "v"(out[5]), "v"(out[6]), "v"(out[7]),
                     "v"(out[8]), "v"(out[9]), "v"(out[10]), "v"(out[11]), "v"(out[12]), "v"(out[13]), "v"(out[14]), "v"(out[15]));
        asm volatile("" : "+v"(pk1) : "v"(out[16]), "v"(out[17]), "v"(out[18]), "v"(out[19]), "v"(out[20]), "v"(out[21]), "v"(out[22]), "v"(out[23]),
                     "v"(out[24]), "v"(out[25]), "v"(out[26]), "v"(out[27]), "v"(out[28]), "v"(out[29]), "v"(out[30]), "v"(out[31]));
        const u32x6 pk = {pk0, pk1, vd4[pp][2], vd4[pp][3], vd2[pp][0], vd2[pp][1]};
        const f32x32 vals = __builtin_amdgcn_cvt_scalef32_pk32_f32_fp6(pk, 1.0f);
#pragma unroll
        for (int i = 0; i < 32; ++i) out[i] += wgt * vals[i];
        __builtin_amdgcn_sched_barrier(0);
      }
    }
    float o16[16];
#pragma unroll
    for (int i = 0; i < 16; ++i) {
      const u32x2 s0 = __builtin_amdgcn_permlane32_swap(__float_as_uint(out[i]), __float_as_uint(out[i]), false, false);
      const u32x2 s1 = __builtin_amdgcn_permlane32_swap(__float_as_uint(out[16 + i]), __float_as_uint(out[16 + i]), false, false);
      const float t0 = __uint_as_float(s0[0]) + __uint_as_float(s0[1]), t1 = __uint_as_float(s1[0]) + __uint_as_float(s1[1]);
      o16[i] = half ? t1 : t0;
    }
    const int cb = 32 * blk + 16 * half;
    const int b = t < TL ? (t >> 11) : 16;
    const float* md = modbuf + ((size_t)l * 17 + b) * 6144 + 5 * 1024 + cb;
    float* xr = xres + (size_t)t * 1024 + cb;
    float xn[16];
    float ss = 0.f;
#pragma unroll
    for (int q = 0; q < 4; ++q) {
      const float4 m4 = *(const float4*)(md + 4 * q);
      float4 xv = *(const float4*)(xr + 4 * q);
      xv.x += m4.x * o16[4 * q + 0]; xv.y += m4.y * o16[4 * q + 1]; xv.z += m4.z * o16[4 * q + 2]; xv.w += m4.w * o16[4 * q + 3];
      xn[4 * q] = xv.x; xn[4 * q + 1] = xv.y; xn[4 * q + 2] = xv.z; xn[4 * q + 3] = xv.w;
      ss += xv.x * xv.x + xv.y * xv.y + xv.z * xv.z + xv.w * xv.w;
      if (dry) asm volatile("" :: "v"(xv.x), "v"(xv.y), "v"(xv.z), "v"(xv.w));
      else if (l < NL - 1) *(float4*)(xr + 4 * q) = xv;
    }
    if (!dry) {
      ss = wave_sum(ss);
      const float rstd = rsqrtf(ss * (1.f / 1024.f) + 1e-6f);
      if (l == NL - 1) {
        const float* fg = p.final_g + cb;
        float* orow = p.out + (size_t)t * 1024 + cb;
#pragma unroll
        for (int q = 0; q < 4; ++q) {
          const float4 g4 = *(const float4*)(fg + 4 * q);
          float4 o = {xn[4 * q] * rstd * g4.x, xn[4 * q + 1] * rstd * g4.y, xn[4 * q + 2] * rstd * g4.z, xn[4 * q + 3] * rstd * g4.w};
          *(float4*)(orow + 4 * q) = o;
        }
      } else {
        const float* gvec = p.norm1_g + (l + 1) * 1024 + cb;
        const float* mdn = modbuf + ((size_t)(l + 1) * 17 + b) * 6144 + cb;
        bf16_t* hrow = (bf16_t*)(p.ws + OFF_H) + (size_t)t * 1024 + cb;
        unsigned pk[8];
#pragma unroll
        for (int q = 0; q < 4; ++q) {
          const float4 g4 = *(const float4*)(gvec + 4 * q), sh = *(const float4*)(mdn + 4 * q), sc = *(const float4*)(mdn + 1024 + 4 * q);
          const float o0 = xn[4 * q] * rstd * g4.x * (1.f + sc.x) + sh.x, o1 = xn[4 * q + 1] * rstd * g4.y * (1.f + sc.y) + sh.y;
          const float o2 = xn[4 * q + 2] * rstd * g4.z * (1.f + sc.z) + sh.z, o3 = xn[4 * q + 3] * rstd * g4.w * (1.f + sc.w) + sh.w;
          pk[2 * q] = pk2(o0, o1); pk[2 * q + 1] = pk2(o2, o3);
        }
        *(u32x4*)hrow = (u32x4){pk[0], pk[1], pk[2], pk[3]};
        *(u32x4*)(hrow + 8) = (u32x4){pk[4], pk[5], pk[6], pk[7]};
      }
    }
  }
}


DI void phase_topk_gather(const Params& p, int l, int ntok, unsigned* ctr, unsigned char* lds, bool dry = false) {
  const int tid = ltid(), lane = tid & 63, w = tid >> 6, lr = lane & 15, g = lane >> 4;
  const bf16_t* QP = (const bf16_t*)(p.ws + OFF_QP);
  const bf16_t* sk = (const bf16_t*)(p.ws + OFF_SK) + (size_t)l * 2 * 128 * 64;
  int* eid_l = (int*)lds;
  float* gate_l = (float*)(lds + 8192);
  unsigned char* hl = lds + 16384 + w * 2048;
  float* wl = (float*)(hl + 1024);
  volatile int* slot = (volatile int*)(lds + LDS_BYTES - 16);
  const int ntile = ntok / 16;
  for (;;) {
    __syncthreads();
    if (tid == 0) *slot = (int)atomicAdd(ctr, 1u);
    __syncthreads();
    const int tile = *slot;
    if (tile >= ntile) break;
#pragma unroll 1
    for (int hh = 0; hh < 2; ++hh) {
      topk_tile(QP, sk, tile, 2 * w + hh, eid_l, gate_l, lr, g);
      __builtin_amdgcn_sched_barrier(0);
    }
    __syncthreads();
#pragma unroll 1
    for (int q = 0; q < 4; ++q) {
      const int r = 4 * w + q;
      gather_token(p, l, tile * 16 + r, eid_l + r * 128, gate_l + r * 128, hl, wl, dry);
    }
  }
}

DI void phase_final(const Params& p) {
  const int lane = ltid() & 63, gw = lbid() * 4 + (ltid() >> 6), nw = lgdim() * 4;
  const float* xres = (const float*)(p.ws + OFF_XRES);
  for (int t = gw; t < TL; t += nw) {
    const float* src = xres + (size_t)t * 1024;
    float4 v[4];
    float ss = 0.f;
#pragma unroll
    for (int i = 0; i < 4; ++i) {
      v[i] = *(const float4*)(src + 4 * lane + 256 * i);
      ss += v[i].x * v[i].x + v[i].y * v[i].y + v[i].z * v[i].z + v[i].w * v[i].w;
    }
    ss = wave_sum(ss);
    const float rstd = rsqrtf(ss * (1.f / 1024.f) + 1e-6f);
#pragma unroll
    for (int i = 0; i < 4; ++i) {
      const int col = 4 * lane + 256 * i;
      const float4 g4 = *(const float4*)(p.final_g + col);
      float4 o = {v[i].x * rstd * g4.x, v[i].y * rstd * g4.y, v[i].z * rstd * g4.z, v[i].w * rstd * g4.w};
      *(float4*)(p.out + (size_t)t * 1024 + col) = o;
    }
  }
}


#define LAS __attribute__((address_space(3)))
#define XB_TMO      128
#define XB_XCNT(j)  (256  + 64 * (j))
#define XB_XSUB(j)  (1280 + 64 * (j))
#define XB_XGEN(j)  (2304 + 64 * (j))
#define XB_TOP      3328
#define XB_TOPGEN   3392
#define XCD_BAR_WORDS 3456
#define XB_SPIN_CAP (1u << 22)
DI unsigned xb_ld(unsigned* p) { return __hip_atomic_load(p, __ATOMIC_RELAXED, __HIP_MEMORY_SCOPE_AGENT); }
DI unsigned xb_add(unsigned* p, unsigned v) { return __hip_atomic_fetch_add(p, v, __ATOMIC_RELAXED, __HIP_MEMORY_SCOPE_AGENT); }
DI unsigned xb_xcc_id() { return (unsigned)__builtin_amdgcn_s_getreg((3 << 11) | 20) & 0xFu; }
#define XB_SPIN(cond, bar) do { unsigned _sp = 0; while (cond) { __builtin_amdgcn_s_sleep(1); \
    if ((++_sp & 255u) == 0u) { if (xb_ld(&(bar)[XB_TMO])) break; if (_sp > XB_SPIN_CAP) { atomicAdd(&(bar)[XB_TMO], 1u); break; } } } } while (0)
struct XcdBarrier { unsigned* bar; unsigned x; volatile unsigned* st; };
DI XcdBarrier xcd_barrier_post(unsigned* bar, volatile unsigned* st) {
  XcdBarrier b; b.bar = bar; b.x = xb_xcc_id(); b.st = st;
  if (threadIdx.x == 0) (void)xb_add(&bar[XB_XCNT(b.x)], 1u);
  return b;
}
DI void xcd_barrier_complete(unsigned* bar, unsigned x, unsigned& nloc, unsigned& nx) {
  const unsigned G = gridDim.x * gridDim.y * gridDim.z;
  unsigned sum, cnt, mine, sp = 0u;
  for (;;) {
    sum = 0u; cnt = 0u; mine = 0u;
#pragma unroll 1
    for (unsigned j = 0; j < 16; ++j) { const unsigned c = xb_ld(&bar[XB_XCNT(j)]); sum += c; cnt += (c > 0u) ? 1u : 0u; mine = (j == x) ? c : mine; }
    if (sum == G) break;
    __builtin_amdgcn_s_sleep(1);
    if ((++sp & 255u) == 0u) { if (xb_ld(&bar[XB_TMO])) break; if (sp > XB_SPIN_CAP) { atomicAdd(&bar[XB_TMO], 1u); break; } }
  }
  nloc = mine > 0u ? mine : 1u; nx = cnt > 0u ? cnt : 1u;
}
DI void xcd_barrier(const XcdBarrier& b) {
  asm volatile("s_waitcnt vmcnt(0)" ::: "memory");
  __syncthreads();
  if (threadIdx.x == 0) {
    unsigned* bar = b.bar;
    __builtin_amdgcn_s_waitcnt(0);
    unsigned nloc = b.st[0], nx = b.st[1];
    if (nloc == 0u) { xcd_barrier_complete(bar, b.x, nloc, nx); b.st[0] = nloc; b.st[1] = nx; }
    const unsigned old = xb_add(&bar[XB_XSUB(b.x)], 1u);
    const unsigned gen = old / nloc;
    if (old + 1u == (gen + 1u) * nloc) {
      __builtin_amdgcn_fence(__ATOMIC_RELEASE, "agent");
      asm volatile("s_waitcnt vmcnt(0)" ::: "memory");
      const unsigned og = xb_add(&bar[XB_TOP], 1u);
      const unsigned tg = og / nx;
      if (og + 1u == (tg + 1u) * nx) xb_add(&bar[XB_TOPGEN], 1u);
      else XB_SPIN(xb_ld(&bar[XB_TOPGEN]) == tg, bar);
      __builtin_amdgcn_fence(__ATOMIC_ACQUIRE, "agent");
      xb_add(&bar[XB_XGEN(b.x)], 1u);
      asm volatile("s_waitcnt vmcnt(0)" ::: "memory");
    } else {
      XB_SPIN(xb_ld(&bar[XB_XGEN(b.x)]) == gen, bar);
      __builtin_amdgcn_fence(__ATOMIC_ACQUIRE, "agent");
      asm volatile("s_waitcnt vmcnt(0)" ::: "memory");
    }
  }
  __syncthreads();
}

constexpr int PH_PER_LAYER = 10;
constexpr int N_PHASES = 1 + NL * PH_PER_LAYER + 1;

template <int KIND>
DI void run_phase(const Params& p, int ph, unsigned char* lds) {
  unsigned* ctl = (unsigned*)(p.ws + OFF_CTL);
  if (ph == 0) { if (KIND < 0 || KIND == 0) phase_prologue(p, lds); }
  else if (ph == N_PHASES - 1) { if (KIND < 0 || KIND == 11) phase_final(p); }
  else {
    const int l = (ph - 1) / PH_PER_LAYER, s = (ph - 1) % PH_PER_LAYER;
    const bool last = (l == NL - 1);
    const int ntok = last ? TL : TT;
    if (s == 0) { if (KIND < 0 || KIND == 1) phase_norm(p, l, 0, TT); }
    else if (s == 1) { if (KIND < 0 || KIND == 2) phase_gemm_in(p, l, lds); }
    else if (s == 2) { if (KIND < 0 || KIND == 3) phase_rope(p, lds); }
    else if (s == 3) { if (KIND < 0 || KIND == 4) phase_mixers(p, l, last, ctl + 64 * (1 + l), lds); }
    else if (s == 4) { if (KIND < 0 || KIND == 5) phase_gla_fin(p, l, ntok); }
    else if (s == 5) { if (KIND < 0 || KIND == 6) phase_gemm_out(p, l, ntok, lds); }
    else if (s == 6) { if (KIND < 0 || KIND == 7) phase_norm(p, l, 1, ntok); }
    else if (s == 7) { if (KIND < 0 || KIND == 8) phase_gemm_q(p, l, ntok, lds); }
    else if (s == 8) { }
    else { if (KIND < 0 || KIND == 10) phase_topk_gather(p, l, ntok, (unsigned*)(p.ws + OFF_CTL) + 64 * (8 + l), lds); }
  }
}

#if N_LAUNCH_MODE == 1
#ifndef PROBE_KIND
#define PROBE_KIND -1
#endif
#ifndef GLA_VAR
#define GLA_VAR 0
#endif
constexpr int CW_BAR = 4096;
template <int l>
DI void run_layer(const Params& p, unsigned char* lds) {
  unsigned* ctl = (unsigned*)(p.ws + OFF_CTL);
#define GSYNC() do { XcdBarrier bb; bb.bar = (unsigned*)(p.ws + OFF_CTL) + CW_BAR; bb.x = xb_xcc_id(); bb.st = (volatile unsigned*)(lds + LDS_BYTES - 32); xcd_barrier(bb); } while (0)

    const bool last = (l == NL - 1);
    const int ntok = last ? TL : TT;
    if (l == 0) { { Params q = p; { size_t z_ = 0; asm volatile("" : "+s"(z_)); q.ws = p.ws + z_; } phase_norm(q, l, 0, TT); } GSYNC(); }
    if (PROBE_KIND == 1) { { Params q = p; { size_t z_ = 0; asm volatile("" : "+s"(z_)); q.ws = p.ws + z_; } phase_norm(q, l, 0, TT); } GSYNC(); }
    if (PROBE_KIND == 2) { { Params q = p; { size_t z_ = 0; asm volatile("" : "+s"(z_)); q.ws = p.ws + z_; } phase_gemm_in(q, l, lds, true); } GSYNC(); }
    { Params q = p; { size_t z_ = 0; asm volatile("" : "+s"(z_)); q.ws = p.ws + z_; } phase_gemm_in(q, l, lds); } GSYNC();
    if (PROBE_KIND == 4 || (PROBE_KIND >= 41 && PROBE_KIND <= 47)) { { Params q = p; { size_t z_ = 0; asm volatile("" : "+s"(z_)); q.ws = p.ws + z_; } phase_mixers(q, l, last, ctl + 64 * (1 + l) + 1, lds, PROBE_KIND == 4 ? 15 : PROBE_KIND - 40, GLA_VAR); } GSYNC(); }
    { Params q = p; { size_t z_ = 0; asm volatile("" : "+s"(z_)); q.ws = p.ws + z_; } phase_mixers(q, l, last, ctl + 64 * (1 + l), lds); } GSYNC();
    { Params q = p; { size_t z_ = 0; asm volatile("" : "+s"(z_)); q.ws = p.ws + z_; } phase_gla_fin(q, l, ntok); } GSYNC();
    if (PROBE_KIND == 5) { { Params q = p; { size_t z_ = 0; asm volatile("" : "+s"(z_)); q.ws = p.ws + z_; } phase_gla_fin(q, l, ntok); } GSYNC(); }
    { Params q = p; { size_t z_ = 0; asm volatile("" : "+s"(z_)); q.ws = p.ws + z_; } phase_gemm_out(q, l, ntok, lds); } GSYNC();
    { Params q = p; { size_t z_ = 0; asm volatile("" : "+s"(z_)); q.ws = p.ws + z_; } phase_norm2(q, l, ntok); } GSYNC();
    if (PROBE_KIND == 7) { { Params q = p; { size_t z_ = 0; asm volatile("" : "+s"(z_)); q.ws = p.ws + z_; } phase_norm2(q, l, ntok); } GSYNC(); }
    { Params q = p; { size_t z_ = 0; asm volatile("" : "+s"(z_)); q.ws = p.ws + z_; } phase_gemm_q(q, l, ntok, lds); } GSYNC();
    if (PROBE_KIND == 8) { { Params q = p; { size_t z_ = 0; asm volatile("" : "+s"(z_)); q.ws = p.ws + z_; } phase_gemm_q(q, l, ntok, lds); } GSYNC(); }
    if (PROBE_KIND == 11) { { Params q = p; { size_t z_ = 0; asm volatile("" : "+s"(z_)); q.ws = p.ws + z_; } phase_topk_gather(q, l, ntok, ctl + 64 * (8 + l) + 1, lds, true); } GSYNC(); }
    { Params q = p; { size_t z_ = 0; asm volatile("" : "+s"(z_)); q.ws = p.ws + z_; } phase_topk_gather(q, l, ntok, ctl + 64 * (8 + l), lds); } if (l + 1 < NL) GSYNC();
}
__global__ void __launch_bounds__(256, 2) mk_fwd(Params p) {
  __shared__ __attribute__((aligned(16))) unsigned char lds[LDS_BYTES];
  unsigned* ctl = (unsigned*)(p.ws + OFF_CTL);
  volatile unsigned* st = (volatile unsigned*)(lds + LDS_BYTES - 32);
  if (threadIdx.x < 2) st[threadIdx.x] = 0u;
  __syncthreads();
  (void)xcd_barrier_post(ctl + CW_BAR, st);
#define GSYNC() do { XcdBarrier bb; bb.bar = (unsigned*)(p.ws + OFF_CTL) + CW_BAR; bb.x = xb_xcc_id(); bb.st = (volatile unsigned*)(lds + LDS_BYTES - 32); xcd_barrier(bb); } while (0)
  { Params q = p; { size_t z_ = 0; asm volatile("" : "+s"(z_)); q.ws = p.ws + z_; } phase_prologue(q, lds); } cg::this_grid().sync();
  if (PROBE_KIND == 0) { { Params q = p; { size_t z_ = 0; asm volatile("" : "+s"(z_)); q.ws = p.ws + z_; } phase_prologue(q, lds); } GSYNC(); }
  run_layer<0>(p, lds); run_layer<1>(p, lds); run_layer<2>(p, lds); run_layer<3>(p, lds);
}
#else
template <int KIND>
__global__ void __launch_bounds__(256, 2) mk_phase(Params p) {
  __shared__ __attribute__((aligned(16))) unsigned char lds[LDS_BYTES];
  run_phase<KIND>(p, p.ph_lo, lds);
}
#endif

extern "C" void kernel_launch(void* const* d_in, const int* in_sizes, int n_in, void* d_out, int out_size, void* d_ws,
                              size_t ws_size, hipStream_t stream) {
  static int grid = 0;
  if (grid == 0) {
    if (n_in != 21 || ws_size < WS_END || out_size != TL * DM) { fprintf(stderr, "kernel_launch: unexpected shapes (n_in %d ws %zu out %d)\n", n_in, ws_size, out_size); grid = -1; return; }
    int dev = 0, cus = 0, per_cu = 2;
    (void)hipGetDevice(&dev);
    (void)hipDeviceGetAttribute(&cus, hipDeviceAttributeMultiprocessorCount, dev);
#if N_LAUNCH_MODE == 1
    (void)hipOccupancyMaxActiveBlocksPerMultiprocessor(&per_cu, (const void*)mk_fwd, 256, 0);
    if (per_cu < 1) per_cu = 1;
    if (per_cu > 2) per_cu = 2;
#endif
    grid = cus * per_cu;
  }
  if (grid < 0) return;
  (void)hipMemsetAsync((char*)d_ws + OFF_CTL, 0, 65536, stream);
  Params p{};
  const float** pp = (const float**)&p;
  for (int i = 0; i < 21; ++i) pp[i] = (const float*)d_in[i];
  p.out = (float*)d_out;
  p.ws = (unsigned char*)d_ws;
#if N_LAUNCH_MODE == 1
  p.ph_lo = 0; p.ph_hi = N_PHASES;
  void* args[] = {&p};
  hipError_t e = hipLaunchCooperativeKernel((const void*)mk_fwd, dim3(grid), dim3(256), args, 0, stream);
  if (e != hipSuccess) fprintf(stderr, "cooperative launch failed: %s (grid %d)\n", hipGetErrorString(e), grid);
#else
  for (int ph = 0; ph < N_PHASES; ++ph) {
    p.ph_lo = ph; p.ph_hi = ph + 1;
    const int kind = ph == 0 ? 0 : (ph == N_PHASES - 1 ? 11 : 1 + (ph - 1) % PH_PER_LAYER);
    switch (kind) {
      case 0: hipLaunchKernelGGL(mk_phase<0>, dim3(grid), dim3(256), 0, stream, p); break;
      case 1: hipLaunchKernelGGL(mk_phase<1>, dim3(grid), dim3(256), 0, stream, p); break;
      case 2: hipLaunchKernelGGL(mk_phase<2>, dim3(grid), dim3(256), 0, stream, p); break;
      case 3: hipLaunchKernelGGL(mk_phase<3>, dim3(grid), dim3(256), 0, stream, p); break;
      case 4: hipLaunchKernelGGL(mk_phase<4>, dim3(grid), dim3(256), 0, stream, p); break;
      case 5: hipLaunchKernelGGL(mk_phase<5>, dim3(grid), dim3(256), 0, stream, p); break;
      case 6: hipLaunchKernelGGL(mk_phase<6>, dim3(grid), dim3(256), 0, stream, p); break;
      case 7: hipLaunchKernelGGL(mk_phase<7>, dim3(grid), dim3(256), 0, stream, p); break;
      case 8: hipLaunchKernelGGL(mk_phase<8>, dim3(grid), dim3(256), 0, stream, p); break;
      case 9: hipLaunchKernelGGL(mk_phase<9>, dim3(grid), dim3(256), 0, stream, p); break;
      case 10: hipLaunchKernelGGL(mk_phase<10>, dim3(grid), dim3(256), 0, stream, p); break;
      default: hipLaunchKernelGGL(mk_phase<11>, dim3(grid), dim3(256), 0, stream, p); break;
    }
  }
#endif
}
```

```cpp
#include <hip/hip_runtime.h>
#include <hip/hip_cooperative_groups.h>
#include <stdint.h>
#include <stdio.h>
namespace cg = cooperative_groups;

#ifndef N_LAUNCH_MODE
#define N_LAUNCH_MODE 1
#endif

#define DI __device__ __forceinline__
#ifndef GEMM_VAR
#define GEMM_VAR 0
#endif
typedef unsigned short bf16_t;
typedef short bf16x8 __attribute__((ext_vector_type(8)));
typedef float f32x4 __attribute__((ext_vector_type(4)));
typedef float f32x2 __attribute__((ext_vector_type(2)));
typedef float f32x16 __attribute__((ext_vector_type(16)));
typedef float f32x32 __attribute__((ext_vector_type(32)));
typedef unsigned u32x6 __attribute__((ext_vector_type(6)));
typedef int i32x8 __attribute__((ext_vector_type(8)));
typedef unsigned u32x4 __attribute__((ext_vector_type(4)));
typedef unsigned u32x2 __attribute__((ext_vector_type(2)));

constexpr int NB = 16, SEQ = 2048, DM = 1024, NL = 4, CTXL = 256;
constexpr int TL = NB * SEQ;
constexpr int TC = NB * CTXL;
constexpr int TT = TL + TC;
constexpr int PN_LD = 2176;
constexpr int C_GQ = 0, C_GK = 128, C_GR = 256, C_NQ = 512, C_NK = 768, C_DQ = 1024, C_DK = 1536, C_GATE = 2048;
constexpr int R_GV = 0, R_NV = 256, R_DV = 512;
constexpr float LOG2E = 1.4426950408889634f;
constexpr float SC_LOG2 = 0.125f * LOG2E;
constexpr float NEG_BIG = -1e30f;

constexpr size_t MiB = 1u << 20;
constexpr size_t OFF_CTL = 0;
constexpr size_t OFF_MOD = 1 * MiB;
constexpr size_t OFF_WIN = 3 * MiB;
constexpr size_t OFF_WOUT = 28 * MiB;
constexpr size_t OFF_WQ = 36 * MiB;
constexpr size_t OFF_SK = 44 * MiB;
constexpr size_t OFF_USCL = 44 * MiB + 256 * 1024;
constexpr size_t OFF_VSCL = 44 * MiB + 512 * 1024;
constexpr size_t OFF_U = 45 * MiB;
constexpr size_t OFF_V = 109 * MiB;
constexpr int V6_PITCH = 800;
#ifndef U_FP4
#define U_FP4 1
#endif
#ifndef V_FP4
#define V_FP4 1
#endif
constexpr int P4_PITCH = 544;
constexpr int U_PITCH = U_FP4 ? P4_PITCH : V6_PITCH, V_PITCH = V_FP4 ? P4_PITCH : V6_PITCH;
constexpr size_t OFF_XRES = 301 * MiB;
constexpr size_t OFF_H = 445 * MiB;
constexpr size_t OFF_P = 517 * MiB;
constexpr size_t OFF_VT = OFF_P + 153 * MiB;
constexpr size_t OFF_QP = OFF_P;
constexpr size_t OFF_EID = OFF_P + 72 * MiB;
constexpr size_t OFF_GATE = OFF_P + 90 * MiB;
constexpr size_t OFF_H8 = OFF_P + 126 * MiB;
constexpr size_t OFF_HINV = OFF_P + 162 * MiB;
constexpr size_t OFF_Y = 742 * MiB;
constexpr size_t WS_END = 814 * MiB;

constexpr int LDS_BYTES = 65536 + 8192;

struct Params {
  const float *x, *c, *ctx, *c_ctx, *ada_w, *ada_b, *norm1_g, *norm2_g, *w_in, *gate_up, *gate_b, *gla_norm_g,
      *rpb, *dlam, *diff_g, *w_out, *wq, *subkeys, *pu, *pv, *final_g;
  float* out;
  unsigned char* ws;
  int ph_lo, ph_hi;
};

DI int ltid() { int t = threadIdx.x; asm volatile("" : "+v"(t)); return t; }
DI int lbid() { int t = blockIdx.x; asm volatile("" : "+s"(t)); return t; }
DI int lgdim() { int t = gridDim.x; asm volatile("" : "+s"(t)); return t; }

DI unsigned f2bf(float f) { unsigned u = __float_as_uint(f); return (u + 0x7fffu + ((u >> 16) & 1u)) >> 16; }
typedef __bf16 bf16x2_t __attribute__((ext_vector_type(2)));
DI unsigned pk2(float lo, float hi) { f32x2 v = {lo, hi}; return __builtin_bit_cast(unsigned, __builtin_convertvector(v, bf16x2_t)); }
DI float bflo(unsigned u) { return __uint_as_float(u << 16); }
DI float bfhi(unsigned u) { return __uint_as_float(u & 0xffff0000u); }
DI void unpack8(const u32x4 v, float* f) {
  f[0] = bflo(v.x); f[1] = bfhi(v.x); f[2] = bflo(v.y); f[3] = bfhi(v.y);
  f[4] = bflo(v.z); f[5] = bfhi(v.z); f[6] = bflo(v.w); f[7] = bfhi(v.w);
}
DI float wave_sum(float v) {
#pragma unroll
  for (int o = 32; o >= 1; o >>= 1) v += __shfl_xor(v, o);
  return v;
}

DI float rows_max(float x) {
  unsigned u = __float_as_uint(x);
  u32x2 a = __builtin_amdgcn_permlane32_swap(u, u, false, false);
  const float m = fmaxf(__uint_as_float(a[0]), __uint_as_float(a[1]));
  unsigned v = __float_as_uint(m);
  u32x2 b = __builtin_amdgcn_permlane16_swap(v, v, false, false);
  return fmaxf(__uint_as_float(b[0]), __uint_as_float(b[1]));
}
DI float rows_sum(float x) {
  unsigned u = __float_as_uint(x);
  u32x2 a = __builtin_amdgcn_permlane32_swap(u, u, false, false);
  const float m = __uint_as_float(a[0]) + __uint_as_float(a[1]);
  unsigned v = __float_as_uint(m);
  u32x2 b = __builtin_amdgcn_permlane16_swap(v, v, false, false);
  return __uint_as_float(b[0]) + __uint_as_float(b[1]);
}

DI u32x6 mxfp6_pack32(float (&x)[32], unsigned& sbyte) {
  float am = 0.f;
#pragma unroll
  for (int i = 0; i < 32; ++i) am = fmaxf(am, fabsf(x[i]));
  int e = am > 0.f ? (int)ceilf(log2f(am) - 2.906890596f) : -126;
  e = e < -126 ? -126 : (e > 127 ? 127 : e);
  const float sc = __uint_as_float((unsigned)(127 - e) << 23);
  f32x16 lo, hi;
#pragma unroll
  for (int i = 0; i < 16; ++i) { lo[i] = x[2 * i] * sc; hi[i] = x[2 * i + 1] * sc; }
  sbyte = (unsigned)(127 + e);
  return __builtin_amdgcn_cvt_scalef32_2xpk16_fp6_f32(lo, hi, 1.0f);
}

DI u32x4 mxfp4_pack32(float (&x)[32], unsigned& sbyte) {
  float am = 0.f;
#pragma unroll
  for (int i = 0; i < 32; ++i) am = fmaxf(am, fabsf(x[i]));
  int e = am > 0.f ? (int)ceilf(log2f(am) - 2.584962501f) : -126;
  e = e < -126 ? -126 : (e > 127 ? 127 : e);
  const float sc = __uint_as_float((unsigned)(127 - e) << 23);
  sbyte = (unsigned)(127 + e);
  u32x4 q;
#pragma unroll
  for (int d = 0; d < 4; ++d) {
    unsigned v = 0;
    v = __builtin_amdgcn_cvt_scalef32_pk_fp4_f32(v, x[8 * d + 0] * sc, x[8 * d + 1] * sc, 1.0f, 0);
    v = __builtin_amdgcn_cvt_scalef32_pk_fp4_f32(v, x[8 * d + 2] * sc, x[8 * d + 3] * sc, 1.0f, 1);
    v = __builtin_amdgcn_cvt_scalef32_pk_fp4_f32(v, x[8 * d + 4] * sc, x[8 * d + 5] * sc, 1.0f, 2);
    v = __builtin_amdgcn_cvt_scalef32_pk_fp4_f32(v, x[8 * d + 6] * sc, x[8 * d + 7] * sc, 1.0f, 3);
    q[d] = v;
  }
  return q;
}
DI int mx4_scale_pos(int blk) { return 512 + (blk & 3) * 8 + (blk >> 2); }
DI int mx_scale_pos(int blk) { return 768 + (blk & 3) * 8 + (blk >> 2); }
DI f32x4 mfma16(bf16x8 a, bf16x8 b, f32x4 c) { return __builtin_amdgcn_mfma_f32_16x16x32_bf16(a, b, c, 0, 0, 0); }

DI int win_src_col(int r) {
  if (r < 256) return r;
  if (r < 512) return r - 256 + 512;
  if (r < 768) return r - 512 + 800;
  if (r < 1024) return r - 768 + 1056;
  if (r < 1536) return r - 1024 + 1568;
  if (r < 2048) return r - 1536 + 2080;
  if (r < 2080) return r - 2048 + 768;
  if (r < 2176) return -1;
  if (r < 2432) return r - 2176 + 256;
  if (r < 2688) return r - 2432 + 1312;
  return r - 2688 + 2592;
}

DI void transpose_item(const float* __restrict__ W, int N, int src, bf16_t* __restrict__ dst, float* lds) {
  const int tid = ltid();
  for (int kc = 0; kc < 8; ++kc) {
    __syncthreads();
#pragma unroll
    for (int i = 0; i < 16; ++i) {
      int k = i * 8 + (tid >> 5), n = tid & 31;
      lds[k * 33 + n] = (src < 0) ? 0.f : W[(size_t)(kc * 128 + k) * N + src + n];
    }
    __syncthreads();
    int row = tid >> 3, k0 = (tid & 7) * 16;
    unsigned o[8];
#pragma unroll
    for (int e = 0; e < 8; ++e) o[e] = pk2(lds[(k0 + 2 * e) * 33 + row], lds[(k0 + 2 * e + 1) * 33 + row]);
    u32x4 a = {o[0], o[1], o[2], o[3]}, b = {o[4], o[5], o[6], o[7]};
    bf16_t* d = dst + (size_t)row * 1024 + kc * 128 + k0;
    *(u32x4*)d = a; *(u32x4*)(d + 8) = b;
  }
}

DI void convert_table_pairs(const Params& p, int pr0, int pr1, int wave, int nwave, int lane) {
  for (int pr = pr0 + wave; pr < pr1; pr += nwave) {
    const int tab = pr >= NL * 16384 / 2, pq = tab ? pr - NL * 16384 / 2 : pr;
    const int r = 2 * pq + (lane >> 5), blk = lane & 31;
    const float* src = (tab ? p.pv : p.pu) + (size_t)r * 1024 + 32 * blk;
    float x[32];
#pragma unroll
    for (int i = 0; i < 8; ++i) { const float4 a = *(const float4*)(src + 4 * i); x[4 * i] = a.x; x[4 * i + 1] = a.y; x[4 * i + 2] = a.z; x[4 * i + 3] = a.w; }
    unsigned sb;
    if (tab ? V_FP4 : U_FP4) {
      const u32x4 q = mxfp4_pack32(x, sb);
      unsigned char* row = p.ws + (tab ? OFF_V : OFF_U) + (size_t)r * P4_PITCH;
      *(u32x4*)(row + 16 * blk) = q;
      row[mx4_scale_pos(blk)] = (unsigned char)sb;
    } else {
      const u32x6 q = mxfp6_pack32(x, sb);
      unsigned char* row = p.ws + (tab ? OFF_V : OFF_U) + (size_t)r * V6_PITCH;
      *(u32x2*)(row + 24 * blk) = (u32x2){q[0], q[1]};
      *(u32x2*)(row + 24 * blk + 8) = (u32x2){q[2], q[3]};
      *(u32x2*)(row + 24 * blk + 16) = (u32x2){q[4], q[5]};
      row[mx_scale_pos(blk)] = (unsigned char)sb;
    }
  }
}

DI void phase_prologue(const Params& p, unsigned char* lds) {
  const int tid = ltid(), nb = lgdim(), bid = lbid();
  bf16_t* winT = (bf16_t*)(p.ws + OFF_WIN);
  bf16_t* woutT = (bf16_t*)(p.ws + OFF_WOUT);
  bf16_t* wqT = (bf16_t*)(p.ws + OFF_WQ);
  constexpr int PER_LAYER = 100 + 32 + 32;
  for (int item = bid; item < NL * PER_LAYER; item += nb) {
    int l = item / PER_LAYER, r = item % PER_LAYER;
    if (r < 100) {
      int row = r * 32;
      transpose_item(p.w_in + (size_t)l * 1024 * 3104, 3104, win_src_col(row), winT + ((size_t)l * 3200 + row) * 1024, (float*)lds);
    } else if (r < 132) {
      int row = (r - 100) * 32;
      transpose_item(p.w_out + (size_t)l * 1024 * 1024, 1024, row, woutT + ((size_t)l * 1024 + row) * 1024, (float*)lds);
    } else {
      int row = (r - 132) * 32;
      transpose_item(p.wq + (size_t)l * 1024 * 1024, 1024, row, wqT + ((size_t)l * 1024 + row) * 1024, (float*)lds);
    }
  }
  {
    bf16_t* sk = (bf16_t*)(p.ws + OFF_SK);
    for (int i = bid * 256 + tid; i < NL * 2 * 128 * 64; i += nb * 256) sk[i] = (bf16_t)f2bf(p.subkeys[i]);
  }
  {
    float* modbuf = (float*)(p.ws + OFF_MOD);
    float* sc = (float*)lds;
    float* red = (float*)(lds + 17 * 512 * 4);
    for (int item = bid; item < NL * 96; item += nb) {
      const int l = item / 96, cb = item % 96, col = cb * 64 + (tid & 63), kq = tid >> 6;
      float acc[17];
#pragma unroll
      for (int r = 0; r < 17; ++r) acc[r] = 0.f;
      for (int half = 0; half < 2; ++half) {
        __syncthreads();
        for (int e = tid; e < 17 * 512; e += 256) {
          int r = e >> 9, k = e & 511;
          float cv = (r < 16) ? p.c[r * 1024 + half * 512 + k] : p.c_ctx[half * 512 + k];
          sc[e] = cv / (1.f + __expf(-cv));
        }
        __syncthreads();
        const float* wp = p.ada_w + ((size_t)l * 1024 + half * 512 + kq * 128) * 6144 + col;
        for (int kk = 0; kk < 128; ++kk) {
          const float w = wp[(size_t)kk * 6144];
#pragma unroll
          for (int r = 0; r < 17; ++r) acc[r] += sc[r * 512 + kq * 128 + kk] * w;
        }
      }
#pragma unroll
      for (int r = 0; r < 17; ++r) red[(kq * 17 + r) * 64 + (tid & 63)] = acc[r];
      __syncthreads();
      for (int e = tid; e < 17 * 64; e += 256) {
        int r = e >> 6, cc = e & 63;
        float s = red[(0 * 17 + r) * 64 + cc] + red[(1 * 17 + r) * 64 + cc] + red[(2 * 17 + r) * 64 + cc] + red[(3 * 17 + r) * 64 + cc];
        int colg = cb * 64 + cc;
        modbuf[((size_t)l * 17 + r) * 6144 + colg] = s + p.ada_b[l * 6144 + colg];
      }
      __syncthreads();
    }
  }
}

DI void phase_norm(const Params& p, int l, int which, int ntok) {
  const int lane = ltid() & 63, gw = lbid() * 4 + (ltid() >> 6), nw = lgdim() * 4;
  const float* gvec = (which == 0 ? p.norm1_g : p.norm2_g) + l * 1024;
  const int ish = which == 0 ? 0 : 3, isc = which == 0 ? 1 : 4;
  const float* xres = (const float*)(p.ws + OFF_XRES);
  const float* modbuf = (const float*)(p.ws + OFF_MOD);
  bf16_t* hbuf = (bf16_t*)(p.ws + OFF_H);
  for (int t = gw; t < ntok; t += nw) {
    const float* src = (which == 0 && l == 0) ? (t < TL ? p.x + (size_t)t * 1024 : p.ctx + (size_t)(t - TL) * 1024) : xres + (size_t)t * 1024;
    const int b = t < TL ? (t >> 11) : 16;
    const float* md = modbuf + ((size_t)l * 17 + b) * 6144;
    float4 v[4];
    float ss = 0.f;
#pragma unroll
    for (int i = 0; i < 4; ++i) {
      v[i] = *(const float4*)(src + 4 * lane + 256 * i);
      ss += v[i].x * v[i].x + v[i].y * v[i].y + v[i].z * v[i].z + v[i].w * v[i].w;
    }
    ss = wave_sum(ss);
    const float rstd = rsqrtf(ss * (1.f / 1024.f) + 1e-6f);
    float am = 0.f;
#pragma unroll
    for (int i = 0; i < 4; ++i) {
      const int col = 4 * lane + 256 * i;
      const float4 g4 = *(const float4*)(gvec + col), sh = *(const float4*)(md + ish * 1024 + col), sc = *(const float4*)(md + isc * 1024 + col);
      float o0 = v[i].x * rstd * g4.x * (1.f + sc.x) + sh.x;
      float o1 = v[i].y * rstd * g4.y * (1.f + sc.y) + sh.y;
      float o2 = v[i].z * rstd * g4.z * (1.f + sc.z) + sh.z;
      float o3 = v[i].w * rstd * g4.w * (1.f + sc.w) + sh.w;
      u32x2 o = {pk2(o0, o1), pk2(o2, o3)};
      *(u32x2*)(hbuf + (size_t)t * 1024 + col) = o;
      v[i].x = o0; v[i].y = o1; v[i].z = o2; v[i].w = o3;
      am = fmaxf(am, fmaxf(fmaxf(fabsf(o0), fabsf(o1)), fmaxf(fabsf(o2), fabsf(o3))));
    }
  }
}

DI void phase_norm2(const Params& p, int l, int ntok) {
  const int lane = ltid() & 63, gw = lbid() * 4 + (ltid() >> 6), nw = lgdim() * 4;
  const int half = lane >> 5, blk = lane & 31;
  const float* gvec = p.norm2_g + l * 1024 + 32 * blk;
  const float* xres = (const float*)(p.ws + OFF_XRES);
  const float* modbuf = (const float*)(p.ws + OFF_MOD);
  bf16_t* hbuf = (bf16_t*)(p.ws + OFF_H);
  unsigned char* h6 = p.ws + OFF_H8;
  for (int pr = gw; pr < ntok / 2; pr += nw) {
    const int t = 2 * pr + half;
    const float* src = xres + (size_t)t * 1024 + 32 * blk;
    const int b = t < TL ? (t >> 11) : 16;
    const float* md = modbuf + ((size_t)l * 17 + b) * 6144 + 32 * blk;
    float x[32];
    float ss = 0.f;
#pragma unroll
    for (int i = 0; i < 8; ++i) {
      const float4 a = *(const float4*)(src + 4 * i);
      x[4 * i] = a.x; x[4 * i + 1] = a.y; x[4 * i + 2] = a.z; x[4 * i + 3] = a.w;
      ss += a.x * a.x + a.y * a.y + a.z * a.z + a.w * a.w;
    }
#pragma unroll
    for (int o = 16; o >= 1; o >>= 1) ss += __shfl_xor(ss, o);
    const float rstd = rsqrtf(ss * (1.f / 1024.f) + 1e-6f);
    unsigned pk[16];
#pragma unroll
    for (int i = 0; i < 8; ++i) {
      const float4 g4 = *(const float4*)(gvec + 4 * i), sh = *(const float4*)(md + 3 * 1024 + 4 * i), sc = *(const float4*)(md + 4 * 1024 + 4 * i);
      x[4 * i] = x[4 * i] * rstd * g4.x * (1.f + sc.x) + sh.x;
      x[4 * i + 1] = x[4 * i + 1] * rstd * g4.y * (1.f + sc.y) + sh.y;
      x[4 * i + 2] = x[4 * i + 2] * rstd * g4.z * (1.f + sc.z) + sh.z;
      x[4 * i + 3] = x[4 * i + 3] * rstd * g4.w * (1.f + sc.w) + sh.w;
      pk[2 * i] = pk2(x[4 * i], x[4 * i + 1]); pk[2 * i + 1] = pk2(x[4 * i + 2], x[4 * i + 3]);
    }
    bf16_t* hrow = hbuf + (size_t)t * 1024 + 32 * blk;
#pragma unroll
    for (int i = 0; i < 4; ++i) *(u32x4*)(hrow + 8 * i) = (u32x4){pk[4 * i], pk[4 * i + 1], pk[4 * i + 2], pk[4 * i + 3]};
    unsigned sb;
    const u32x6 q = mxfp6_pack32(x, sb);
    unsigned char* row = h6 + (size_t)t * V6_PITCH;
    *(u32x2*)(row + 24 * blk) = (u32x2){q[0], q[1]};
    *(u32x2*)(row + 24 * blk + 8) = (u32x2){q[2], q[3]};
    *(u32x2*)(row + 24 * blk + 16) = (u32x2){q[4], q[5]};
    row[mx_scale_pos(blk)] = (unsigned char)sb;
  }
}

template <int EPI>
DI void gemm_tile(const bf16_t* __restrict__ P, const bf16_t* __restrict__ Q, int it, int jt, void* outp, int ld,
                  const float* xin_lat, const float* xin_ctx, const float* modl, unsigned char* lds, bool gvar = false) {
  const int tid = ltid(), lane = tid & 63, w = tid >> 6, wi = w >> 1, wj = w & 1, lr = lane & 15, g = lane >> 4;
  const int wu = __builtin_amdgcn_readfirstlane(w);
  f32x4 acc[4][4];
#pragma unroll
  for (int a = 0; a < 4; ++a)
#pragma unroll
    for (int b = 0; b < 4; ++b) acc[a][b] = (f32x4){0.f, 0.f, 0.f, 0.f};
  const unsigned lo0 = (unsigned)((lane >> 3) * 1024 + (((lane & 7) ^ (lane >> 4)) << 3));
  const unsigned lo1 = (unsigned)((lane >> 3) * 1024 + (((lane & 7) ^ (4 + (lane >> 4))) << 3));
  const bf16_t* pg = P + (size_t)(it * 128 + 32 * wu) * 1024;
  const bf16_t* qg = Q + (size_t)(jt * 128 + 32 * wu) * 1024;
#define GT_DMA(kb, bf) do { _Pragma("unroll") for (int jj = 0; jj < 4; ++jj) { const unsigned lo_ = (jj & 1) ? lo1 : lo0; \
      __builtin_amdgcn_global_load_lds((const unsigned*)(pg + (size_t)jj * 8192 + (kb) * 64 + lo_), (unsigned*)(lds + (bf) * 32768 + (4 * wu + jj) * 1024), 16, 0, 0); \
      __builtin_amdgcn_global_load_lds((const unsigned*)(qg + (size_t)jj * 8192 + (kb) * 64 + lo_), (unsigned*)(lds + (bf) * 32768 + 16384 + (4 * wu + jj) * 1024), 16, 0, 0); } } while (0)
  __syncthreads();
  GT_DMA(0, 0);
  asm volatile("s_waitcnt vmcnt(0)" ::: "memory");
  __syncthreads();
  for (int kb = 0; kb < 16; ++kb) {
    if (kb < 15 && !(GEMM_VAR == 1 && gvar)) GT_DMA(kb + 1, (kb + 1) & 1);
    const unsigned char* Ps = lds + (kb & 1) * 32768;
    const unsigned char* Qs = Ps + 16384;
    bf16x8 pf[2][4], qf[2][4];
#pragma unroll
    for (int ks = 0; ks < 2; ++ks) {
      const int ch = ks * 4 + g;
#pragma unroll
      for (int mi = 0; mi < 4; ++mi) { const int row = wi * 64 + mi * 16 + lr; pf[ks][mi] = *(const bf16x8*)(Ps + (row >> 1) * 256 + (((((row & 1) << 3) | ch) ^ ((row >> 1) & 7)) << 4)); }
#pragma unroll
      for (int nj = 0; nj < 4; ++nj) { const int row = wj * 64 + nj * 16 + lr; qf[ks][nj] = *(const bf16x8*)(Qs + (row >> 1) * 256 + (((((row & 1) << 3) | ch) ^ ((row >> 1) & 7)) << 4)); }
    }
    __builtin_amdgcn_sched_barrier(0);
    __builtin_amdgcn_s_setprio(1);
#pragma unroll
    for (int ks = 0; ks < 2; ++ks)
#pragma unroll
      for (int mi = 0; mi < 4; ++mi)
#pragma unroll
        for (int nj = 0; nj < 4; ++nj) { if (GEMM_VAR == 2 && gvar) { asm volatile("" :: "v"(pf[ks][mi]), "v"(qf[ks][nj])); } else acc[mi][nj] = mfma16(pf[ks][mi], qf[ks][nj], acc[mi][nj]); }
    __builtin_amdgcn_s_setprio(0);
    __builtin_amdgcn_sched_barrier(0);
    asm volatile("s_waitcnt vmcnt(0)" ::: "memory");
    __syncthreads();
  }
#undef GT_DMA
  if (EPI == 2) {
    float inv[4];
#pragma unroll
    for (int r = 0; r < 4; ++r) inv[r] = __builtin_amdgcn_exp2f(-(float)(4 * g + r) * (13.287712379549449f / 16.f));
#pragma unroll
    for (int nj = 0; nj < 4; ++nj) {
      const int j = jt * 128 + wj * 64 + nj * 16 + lr;
      if (j < TL) {
        const float prow = (float)((j & 2047) >> 6), pcol = (float)(j & 63);
#pragma unroll
        for (int r = 0; r < 4; ++r) {
          const float a1 = prow * inv[r], a2 = pcol * inv[r];
          const float c1 = __cosf(a1), s1 = __sinf(a1), c2 = __cosf(a2), s2 = __sinf(a2);
          const float x1 = acc[0][nj][r], x2 = acc[1][nj][r], y1 = acc[2][nj][r], y2 = acc[3][nj][r];
          acc[0][nj][r] = x1 * c1 - x2 * s1; acc[1][nj][r] = x2 * c1 + x1 * s1;
          acc[2][nj][r] = y1 * c2 - y2 * s2; acc[3][nj][r] = y2 * c2 + y1 * s2;
        }
      }
    }
  }
#pragma unroll
  for (int mi = 0; mi < 4; ++mi)
#pragma unroll
    for (int nj = 0; nj < 4; ++nj) {
      const int j = jt * 128 + wj * 64 + nj * 16 + lr;
      const int i = it * 128 + wi * 64 + mi * 16 + 4 * g;
      const f32x4 a = acc[mi][nj];
      if (EPI == 0 || EPI == 2) {
        u32x2 o = {pk2(a[0], a[1]), pk2(a[2], a[3])};
        *(u32x2*)((bf16_t*)outp + (size_t)j * ld + i) = o;
      } else {
        const int b = j < TL ? (j >> 11) : 16;
        const float4 gt = *(const float4*)(modl + (size_t)b * 6144 + 2 * 1024 + i);
        const float* xs = (j < TL) ? xin_lat + (size_t)j * 1024 + i : xin_ctx + (size_t)(j - TL) * 1024 + i;
        const float4 xv = *(const float4*)xs;
        float4 o = {xv.x + gt.x * a[0], xv.y + gt.y * a[1], xv.z + gt.z * a[2], xv.w + gt.w * a[3]};
        *(float4*)((float*)outp + (size_t)j * 1024 + i) = o;
      }
    }
}

struct TileIter {
  int u, step, total, nf, tpx, x;
  DI void init(int n_tok_tiles, int n_feat_tiles) {
    const int bid = lbid(), nb = lgdim();
    nf = n_feat_tiles;
    if ((nb & 7) == 0 && (n_tok_tiles & 7) == 0) { x = bid & 7; u = bid >> 3; step = nb >> 3; tpx = n_tok_tiles >> 3; }
    else { x = 0; u = bid; step = nb; tpx = n_tok_tiles; }
    total = tpx * nf;
  }
  DI bool valid() const { return u < total; }
  DI void next() { u += step; }
  DI void get(int& tok_tile, int& feat_tile) const {
    const int g = u / (8 * nf), rem = u - g * 8 * nf;
    const int gs = (tpx - 8 * g) < 8 ? (tpx - 8 * g) : 8;
    const int f = rem / gs, tt = rem - f * gs;
    tok_tile = x * tpx + 8 * g + tt; feat_tile = f;
  }
};

DI void phase_gemm_in(const Params& p, int l, unsigned char* lds, bool gvar = false) {
  const bf16_t* W = (const bf16_t*)(p.ws + OFF_WIN) + (size_t)l * 3200 * 1024;
  const bf16_t* H = (const bf16_t*)(p.ws + OFF_H);
  bf16_t* PN = (bf16_t*)(p.ws + OFF_P);
  bf16_t* VT = (bf16_t*)(p.ws + OFF_VT);
  TileIter ti; ti.init(TT / 128, 25);
  for (; ti.valid(); ti.next()) {
    int jt, f; ti.get(jt, f);
    if (f >= 8 && f < 16) gemm_tile<2>(W, H, f, jt, PN, PN_LD, nullptr, nullptr, nullptr, lds, gvar);
    else if (f < 17) gemm_tile<0>(W, H, f, jt, PN, PN_LD, nullptr, nullptr, nullptr, lds, gvar);
    else gemm_tile<0>(H, W + (size_t)2176 * 1024, jt, f - 17, VT, TT, nullptr, nullptr, nullptr, lds, gvar);
  }
}
DI void phase_gemm_out(const Params& p, int l, int ntok, unsigned char* lds) {
  const bf16_t* W = (const bf16_t*)(p.ws + OFF_WOUT) + (size_t)l * 1024 * 1024;
  const bf16_t* Y = (const bf16_t*)(p.ws + OFF_Y);
  float* xres = (float*)(p.ws + OFF_XRES);
  const float* modl = (const float*)(p.ws + OFF_MOD) + (size_t)l * 17 * 6144;
  const float* xl = (l == 0) ? p.x : xres;
  const float* xc = (l == 0) ? p.ctx : xres + (size_t)TL * 1024;
  TileIter ti; ti.init(ntok / 128, 8);
  for (; ti.valid(); ti.next()) {
    int jt, f; ti.get(jt, f);
    gemm_tile<1>(W, Y, f, jt, xres, 1024, xl, xc, modl, lds);
  }
}
DI void phase_gemm_q(const Params& p, int l, int ntok, unsigned char* lds) {
  const bf16_t* W = (const bf16_t*)(p.ws + OFF_WQ) + (size_t)l * 1024 * 1024;
  const bf16_t* H = (const bf16_t*)(p.ws + OFF_H);
  bf16_t* QP = (bf16_t*)(p.ws + OFF_QP);
  TileIter ti; ti.init(ntok / 128, 8);
  for (; ti.valid(); ti.next()) {
    int jt, f; ti.get(jt, f);
    gemm_tile<0>(W, H, f, jt, QP, 1024, nullptr, nullptr, nullptr, lds);
  }
}

DI void phase_rope(const Params& p, unsigned char* lds) {
  float2* tab = (float2*)lds;
  for (int e = ltid(); e < 1024; e += 256) {
    const int pos = e >> 4, i = e & 15;
    const float inv = exp2f(-(float)i * (13.287712379549449f / 16.f));
    const float ang = (float)pos * inv;
    tab[e] = make_float2(__cosf(ang), __sinf(ang));
  }
  __syncthreads();
  bf16_t* PN = (bf16_t*)(p.ws + OFF_P);
  const int total = TL * 16;
  for (int idx = lbid() * 256 + ltid(); idx < total; idx += lgdim() * 256) {
    const int t = idx >> 4, vec = idx & 15;
    const int col = ((vec >> 3) ? C_DK : C_DQ) + ((vec >> 1) & 3) * 128 + (vec & 1) * 64;
    bf16_t* ptr = PN + (size_t)t * PN_LD + col;
    float xv[64];
#pragma unroll
    for (int q = 0; q < 8; ++q) { const u32x4 v = *(const u32x4*)(ptr + q * 8); unpack8(v, xv + q * 8); }
    const int row = (t & 2047) >> 6, cp = t & 63;
#pragma unroll
    for (int i = 0; i < 16; ++i) {
      const float2 cs = tab[row * 16 + i];
      const float x1 = xv[i], x2 = xv[16 + i];
      xv[i] = x1 * cs.x - x2 * cs.y; xv[16 + i] = x2 * cs.x + x1 * cs.y;
      const float2 cs2 = tab[cp * 16 + i];
      const float y1 = xv[32 + i], y2 = xv[48 + i];
      xv[32 + i] = y1 * cs2.x - y2 * cs2.y; xv[48 + i] = y2 * cs2.x + y1 * cs2.y;
    }
#pragma unroll
    for (int q = 0; q < 8; ++q) {
      u32x4 o = {pk2(xv[q * 8], xv[q * 8 + 1]), pk2(xv[q * 8 + 2], xv[q * 8 + 3]), pk2(xv[q * 8 + 4], xv[q * 8 + 5]), pk2(xv[q * 8 + 6], xv[q * 8 + 7])};
      *(u32x4*)(ptr + q * 8) = o;
    }
  }
}

struct SrcSeg {
  const bf16_t* PN; const bf16_t* VT; int kcol, vrow, t0, n0, t1, n1, lr, g;
  DI int nsteps() const { return n0 + n1; }
  DI int tok0(int st) const { return st < n0 ? t0 + st * 32 : t1 + (st - n0) * 32; }
  DI float score(float raw, int st, int kt, int r) const { return raw * SC_LOG2; }
};
struct SrcNat {
  const bf16_t* PN; const bf16_t* VT; int kcol, vrow, b, rq, rs, cs, qc, cstart, lr, g;
  const float* rpbh;
  DI int nsteps() const { return 16; }
  DI int tok0(int st) const { return st < 8 ? b * 2048 + (rs + st) * 64 + cs : TL + b * 256 + (st - 8) * 32; }
  DI float score(float raw, int st, int kt, int r) const {
    if (st >= 8) return raw * SC_LOG2;
    const int kc = cs + 8 * g + 4 * kt + r;
    const bool valid = (kc >= cstart) && (kc < cstart + 16);
    int dc = kc - qc + 15; dc = dc < 0 ? 0 : (dc > 30 ? 30 : dc);
    const float bias = rpbh[(rs + st - rq + 7) * 31 + dc];
    return valid ? (raw * 0.125f + bias) * LOG2E : NEG_BIG;
  }
};

template <class Src>
struct FlashFrags { bf16x8 k[2][2]; bf16x8 v[4]; };
template <class Src>
DI void flash_load(const Src& S, int st, FlashFrags<Src>& F) {
  const int tk = S.tok0(st);
  const int kap = 8 * (S.lr >> 2) + (S.lr & 3);
  const bf16_t* k0p = S.PN + (size_t)(tk + kap) * PN_LD + S.kcol + 8 * S.g;
  const bf16_t* vp = S.VT + (size_t)(S.vrow + S.lr) * TT + tk + 8 * S.g;
#pragma unroll
  for (int kt = 0; kt < 2; ++kt)
#pragma unroll
    for (int ks = 0; ks < 2; ++ks) F.k[kt][ks] = *(const bf16x8*)(k0p + (size_t)kt * 4 * PN_LD + ks * 32);
#pragma unroll
  for (int dt = 0; dt < 4; ++dt) F.v[dt] = *(const bf16x8*)(vp + (size_t)dt * 16 * TT);
}
template <class Src>
DI void flash_step(const Src& S, int st, const FlashFrags<Src>& F, const bf16x8 (&qf)[2], f32x4 (&o)[4], float& mrun, float& lrun) {
  f32x4 s[2];
#pragma unroll
  for (int kt = 0; kt < 2; ++kt) {
    s[kt] = (f32x4){0.f, 0.f, 0.f, 0.f};
#pragma unroll
    for (int ks = 0; ks < 2; ++ks) s[kt] = mfma16(F.k[kt][ks], qf[ks], s[kt]);
  }
  float mt = NEG_BIG;
#pragma unroll
  for (int kt = 0; kt < 2; ++kt)
#pragma unroll
    for (int r = 0; r < 4; ++r) { s[kt][r] = S.score(s[kt][r], st, kt, r); mt = fmaxf(mt, s[kt][r]); }
  mt = rows_max(mt);
  const bool need = mt > mrun + 8.f;
  if (__any(need)) {
    const float mnew = need ? mt : mrun;
    const float alpha = __builtin_amdgcn_exp2f(mrun - mnew);
    lrun *= alpha;
#pragma unroll
    for (int dt = 0; dt < 4; ++dt) { o[dt][0] *= alpha; o[dt][1] *= alpha; o[dt][2] *= alpha; o[dt][3] *= alpha; }
    mrun = mnew;
  }
  float pv[8], ls = 0.f;
#pragma unroll
  for (int kt = 0; kt < 2; ++kt)
#pragma unroll
    for (int r = 0; r < 4; ++r) { pv[kt * 4 + r] = __builtin_amdgcn_exp2f(s[kt][r] - mrun); ls += pv[kt * 4 + r]; }
  lrun += ls;
  u32x4 pk = {pk2(pv[0], pv[1]), pk2(pv[2], pv[3]), pk2(pv[4], pv[5]), pk2(pv[6], pv[7])};
  const bf16x8 pf = __builtin_bit_cast(bf16x8, pk);
#pragma unroll
  for (int dt = 0; dt < 4; ++dt) o[dt] = mfma16(F.v[dt], pf, o[dt]);
}
template <class Src>
DI void flash_wave(const Src& S, const bf16_t* qptr  , f32x4 (&o)[4], float& ltot) {
  bf16x8 qf[2];
  qf[0] = *(const bf16x8*)(qptr); qf[1] = *(const bf16x8*)(qptr + 32);
  float mrun = NEG_BIG, lrun = 0.f;
#pragma unroll
  for (int dt = 0; dt < 4; ++dt) o[dt] = (f32x4){0.f, 0.f, 0.f, 0.f};
  const int ns = S.nsteps();
  FlashFrags<Src> f0, f1, f2;
  flash_load(S, 0, f0);
  if (ns > 1) flash_load(S, 1, f1);
  for (int st = 0; st < ns; st += 3) {
    if (st + 2 < ns) flash_load(S, st + 2, f2);
    flash_step(S, st, f0, qf, o, mrun, lrun);
    if (st + 1 < ns) {
      if (st + 3 < ns) flash_load(S, st + 3, f0);
      flash_step(S, st + 1, f1, qf, o, mrun, lrun);
    }
    if (st + 2 < ns) {
      if (st + 4 < ns) flash_load(S, st + 4, f1);
      flash_step(S, st + 2, f2, qf, o, mrun, lrun);
    }
  }
  ltot = rows_sum(lrun);
}

DI void nat_wave_task(const Params& p, int l, int b, int head, int rq, int ct, const float* rpb_lds) {
  const int lane = ltid() & 63, lr = lane & 15, g = lane >> 4;
  const bf16_t* PN = (const bf16_t*)(p.ws + OFF_P);
  const bf16_t* VT = (const bf16_t*)(p.ws + OFF_VT);
  bf16_t* Y = (bf16_t*)(p.ws + OFF_Y);
  SrcNat S;
  S.PN = PN; S.VT = VT; S.kcol = C_NK + head * 64; S.vrow = R_NV + head * 64; S.b = b; S.rq = rq; S.lr = lr; S.g = g;
  int rs = rq - 4; rs = rs < 0 ? 0 : (rs > 24 ? 24 : rs);
  S.rs = rs;
  int cs = 16 * ct - 8; cs = cs < 0 ? 0 : (cs > 32 ? 32 : cs);
  S.cs = cs;
  S.qc = 16 * ct + lr;
  int cst = S.qc - 8; cst = cst < 0 ? 0 : (cst > 48 ? 48 : cst);
  S.cstart = cst;
  S.rpbh = rpb_lds + head * 465;
  f32x4 o[4];
  float lt;
  const int qtok = b * 2048 + rq * 64 + 16 * ct + lr;
  flash_wave<SrcNat>(S, PN + (size_t)qtok * PN_LD + C_NQ + head * 64 + 8 * g, o, lt);
  const float inv = 1.f / lt;
#pragma unroll
  for (int dt = 0; dt < 4; ++dt) {
    u32x2 ov = {pk2(o[dt][0] * inv, o[dt][1] * inv), pk2(o[dt][2] * inv, o[dt][3] * inv)};
    *(u32x2*)(Y + (size_t)qtok * 1024 + 256 + head * 64 + dt * 16 + 4 * g) = ov;
  }
}
DI void natctx_wave_task(const Params& p, int b, int head, int qt) {
  const int lane = ltid() & 63, lr = lane & 15, g = lane >> 4;
  const bf16_t* PN = (const bf16_t*)(p.ws + OFF_P);
  const bf16_t* VT = (const bf16_t*)(p.ws + OFF_VT);
  bf16_t* Y = (bf16_t*)(p.ws + OFF_Y);
  SrcSeg S;
  S.PN = PN; S.VT = VT; S.kcol = C_NK + head * 64; S.vrow = R_NV + head * 64; S.lr = lr; S.g = g;
  S.t0 = TL + b * 256; S.n0 = 8; S.t1 = 0; S.n1 = 0;
  f32x4 o[4];
  float lt;
  const int qtok = TL + b * 256 + qt * 16 + lr;
  flash_wave<SrcSeg>(S, PN + (size_t)qtok * PN_LD + C_NQ + head * 64 + 8 * g, o, lt);
  const float inv = 1.f / lt;
#pragma unroll
  for (int dt = 0; dt < 4; ++dt) {
    u32x2 ov = {pk2(o[dt][0] * inv, o[dt][1] * inv), pk2(o[dt][2] * inv, o[dt][3] * inv)};
    *(u32x2*)(Y + (size_t)qtok * 1024 + 256 + head * 64 + dt * 16 + 4 * g) = ov;
  }
}

DI void diff_block_task(const Params& p, int l, int b, int hd, int qtok0, int nsteps, unsigned char* lds, int dvar = 0) {
  const int tid = ltid(), lane = tid & 63, w = tid >> 6, lr = lane & 15, g = lane >> 4;
  unsigned char* Kb = lds;
  unsigned char* Vb = lds + 8192;
  const bf16_t* PN = (const bf16_t*)(p.ws + OFF_P);
  const bf16_t* VT = (const bf16_t*)(p.ws + OFF_VT);
  bf16_t* Y = (bf16_t*)(p.ws + OFF_Y);
  bf16x8 qf[2][2][2];
#pragma unroll
  for (int qt = 0; qt < 2; ++qt) {
    const bf16_t* qp = PN + (size_t)(qtok0 + 32 * w + 16 * qt + lr) * PN_LD + C_DQ + hd * 128 + 8 * g;
#pragma unroll
    for (int m = 0; m < 2; ++m)
#pragma unroll
      for (int ks = 0; ks < 2; ++ks) {
        const u32x4 raw = *(const u32x4*)(qp + m * 64 + ks * 32);
        float f[8];
        unpack8(raw, f);
        u32x4 sc = {pk2(f[0] * SC_LOG2, f[1] * SC_LOG2), pk2(f[2] * SC_LOG2, f[3] * SC_LOG2), pk2(f[4] * SC_LOG2, f[5] * SC_LOG2), pk2(f[6] * SC_LOG2, f[7] * SC_LOG2)};
        qf[m][qt][ks] = __builtin_bit_cast(bf16x8, sc);
      }
  }
  const int wu = __builtin_amdgcn_readfirstlane(w);
  unsigned kofs[2], vofs[2];
#pragma unroll
  for (int jj = 0; jj < 2; ++jj) {
    const int krow = 4 * (2 * w + jj) + (lane >> 4), kpc = lane & 15;
    const int kch = kpc ^ (((krow >> 3) & 3) * 4 + (krow & 3));
    kofs[jj] = (unsigned)(krow * PN_LD + C_DK + hd * 128 + kch * 8);
    const int vrow = 16 * (2 * w + jj) + (lane >> 2), vpc = lane & 3;
    const int vch = vpc ^ ((vrow >> 2) & 3);
    vofs[jj] = (unsigned)((R_DV + hd * 128 + vrow) * TT + vch * 8);
  }
#define DB_DMA(st, sl) do { const int tk = (st) < 8 ? TL + b * 256 + (st) * 32 : b * 2048 + ((st) - 8) * 32; \
    const bf16_t* kb_ = PN + (size_t)tk * PN_LD; const bf16_t* vb_ = VT + tk; \
    _Pragma("unroll") for (int jj = 0; jj < 2; ++jj) { \
      __builtin_amdgcn_global_load_lds((const unsigned*)(kb_ + kofs[jj]), (unsigned*)(Kb + (sl) * 16384 + (2 * wu + jj) * 1024), 16, 0, 0); \
      __builtin_amdgcn_global_load_lds((const unsigned*)(vb_ + vofs[jj]), (unsigned*)(Vb + (sl) * 16384 + (2 * wu + jj) * 1024), 16, 0, 0); } } while (0)
  asm volatile("s_waitcnt vmcnt(0)" ::: "memory");
  __syncthreads();
  DB_DMA(0, 0);
  DB_DMA(nsteps > 1 ? 1 : 0, 1);
  DB_DMA(nsteps > 2 ? 2 : nsteps - 1, 2);
  asm volatile("s_waitcnt vmcnt(8)" ::: "memory");
  __builtin_amdgcn_s_barrier();

  f32x4 o[2][2][8];
  float mrun[2][2], lrun[2][2];
#pragma unroll
  for (int m = 0; m < 2; ++m)
#pragma unroll
    for (int qt = 0; qt < 2; ++qt) {
      mrun[m][qt] = NEG_BIG; lrun[m][qt] = 0.f;
#pragma unroll
      for (int dt = 0; dt < 8; ++dt) o[m][qt][dt] = (f32x4){0.f, 0.f, 0.f, 0.f};
    }
  const int kfr = 8 * (lr >> 2) + (lr & 3);
  for (int st = 0; st < nsteps; ++st) {
    if (dvar != 1) { const int sn = st + 3 < nsteps ? st + 3 : nsteps - 1; DB_DMA(sn, (st + 3) & 3); }
    const unsigned char* Kt = Kb + (st & 3) * 16384;
    const unsigned char* Vt = Vb + (st & 3) * 16384;
    bf16x8 pf[2][2];
#pragma unroll
    for (int m = 0; m < 2; ++m) {
      bf16x8 kf[2][2];
#pragma unroll
      for (int kt = 0; kt < 2; ++kt)
#pragma unroll
        for (int ks = 0; ks < 2; ++ks) kf[kt][ks] = *(const bf16x8*)(Kt + (kfr + 4 * kt) * 256 + (((m * 8 + ks * 4 + g) ^ lr) << 4));
      __builtin_amdgcn_sched_barrier(0);
      f32x4 s[2][2];
#pragma unroll
      for (int qt = 0; qt < 2; ++qt)
#pragma unroll
        for (int kt = 0; kt < 2; ++kt) {
          s[qt][kt] = (f32x4){0.f, 0.f, 0.f, 0.f};
#pragma unroll
          for (int ks = 0; ks < 2; ++ks) s[qt][kt] = mfma16(kf[kt][ks], qf[m][qt][ks], s[qt][kt]);
        }
      __builtin_amdgcn_sched_barrier(0);
#pragma unroll
      for (int qt = 0; qt < 2; ++qt) {
        if (dvar == 2) {
          u32x4 pk = {pk2(s[qt][0][0], s[qt][0][1]), pk2(s[qt][0][2], s[qt][0][3]), pk2(s[qt][1][0], s[qt][1][1]), pk2(s[qt][1][2], s[qt][1][3])};
          pf[m][qt] = __builtin_bit_cast(bf16x8, pk);
          continue;
        }
        float mt = NEG_BIG;
#pragma unroll
        for (int kt = 0; kt < 2; ++kt)
#pragma unroll
          for (int r = 0; r < 4; ++r) mt = fmaxf(mt, s[qt][kt][r]);
        mt = rows_max(mt);
        const bool need = mt > mrun[m][qt] + 8.f;
        if (__any(need)) {
          const float mnew = need ? mt : mrun[m][qt];
          const float alpha = __builtin_amdgcn_exp2f(mrun[m][qt] - mnew);
          lrun[m][qt] *= alpha;
#pragma unroll
          for (int dt = 0; dt < 8; ++dt) { o[m][qt][dt][0] *= alpha; o[m][qt][dt][1] *= alpha; o[m][qt][dt][2] *= alpha; o[m][qt][dt][3] *= alpha; }
          mrun[m][qt] = mnew;
        }
        float pv[8], ls = 0.f;
#pragma unroll
        for (int kt = 0; kt < 2; ++kt)
#pragma unroll
          for (int r = 0; r < 4; ++r) { pv[kt * 4 + r] = __builtin_amdgcn_exp2f(s[qt][kt][r] - mrun[m][qt]); ls += pv[kt * 4 + r]; }
        lrun[m][qt] += ls;
        u32x4 pk = {pk2(pv[0], pv[1]), pk2(pv[2], pv[3]), pk2(pv[4], pv[5]), pk2(pv[6], pv[7])};
        pf[m][qt] = __builtin_bit_cast(bf16x8, pk);
      }
      __builtin_amdgcn_sched_barrier(0);
    }
#pragma unroll
    for (int hb = 0; hb < 2; ++hb) {
      bf16x8 vf[4];
#pragma unroll
      for (int d4 = 0; d4 < 4; ++d4) {
        const int vr = 16 * (4 * hb + d4) + lr;
        vf[d4] = *(const bf16x8*)(Vt + vr * 64 + ((g ^ ((vr >> 2) & 3)) << 4));
      }
      __builtin_amdgcn_sched_barrier(0);
#pragma unroll
      for (int d4 = 0; d4 < 4; ++d4)
#pragma unroll
        for (int m = 0; m < 2; ++m)
#pragma unroll
          for (int qt = 0; qt < 2; ++qt) { if (dvar == 3) asm volatile("" :: "v"(vf[d4]), "v"(pf[m][qt])); else o[m][qt][4 * hb + d4] = mfma16(vf[d4], pf[m][qt], o[m][qt][4 * hb + d4]); }
      __builtin_amdgcn_sched_barrier(0);
    }
    asm volatile("s_waitcnt vmcnt(8)" ::: "memory");
    __builtin_amdgcn_s_barrier();
  }
  asm volatile("s_waitcnt vmcnt(0)" ::: "memory");
#undef DB_DMA
  const float* lv = p.dlam + l * 256;
  float sa = lv[lane] * lv[64 + lane], sb = lv[128 + lane] * lv[192 + lane];
  sa = wave_sum(sa); sb = wave_sum(sb);
  const float lam_init = 0.8f - 0.6f * expf(-0.3f * (float)l);
  const float lam = expf(sa) - expf(sb) + lam_init;
  const float* dg = p.diff_g + l * 512 + hd * 128;
#pragma unroll
  for (int qt = 0; qt < 2; ++qt) {
    float l0 = lrun[0][qt], l1 = lrun[1][qt];
    l0 = rows_sum(l0);
    l1 = rows_sum(l1);
    const float i0 = 1.f / l0, i1 = lam / l1;
    float ss = 0.f;
#pragma unroll
    for (int dt = 0; dt < 8; ++dt)
#pragma unroll
      for (int r = 0; r < 4; ++r) { const float v = o[0][qt][dt][r] * i0 - o[1][qt][dt][r] * i1; o[0][qt][dt][r] = v; ss += v * v; }
    ss = rows_sum(ss);
    const float rstd = rsqrtf(ss * (1.f / 128.f) + 1e-6f) * (1.f - lam_init);
    const int qtok = qtok0 + 32 * w + 16 * qt + lr;
#pragma unroll
    for (int dt = 0; dt < 8; ++dt) {
      const float4 gg = *(const float4*)(dg + dt * 16 + 4 * g);
      u32x2 ov = {pk2(o[0][qt][dt][0] * rstd * gg.x, o[0][qt][dt][1] * rstd * gg.y), pk2(o[0][qt][dt][2] * rstd * gg.z, o[0][qt][dt][3] * rstd * gg.w)};
      *(u32x2*)(Y + (size_t)qtok * 1024 + 512 + hd * 128 + dt * 16 + 4 * g) = ov;
    }
  }
}


DI void nat_block_task(const Params& p, int l, int b, int head, int rq, const float* rpb_lds, unsigned char* lds) {
  const int tid = ltid(), lane = tid & 63, w = tid >> 6, lr = lane & 15, g = lane >> 4;
  const int wu = __builtin_amdgcn_readfirstlane(w);
  unsigned char* Kb = lds;
  unsigned char* Vb = lds + 16384;
  const bf16_t* PN = (const bf16_t*)(p.ws + OFF_P);
  const bf16_t* VT = (const bf16_t*)(p.ws + OFF_VT);
  bf16_t* Y = (bf16_t*)(p.ws + OFF_Y);
  int rs = rq - 4; rs = rs < 0 ? 0 : (rs > 24 ? 24 : rs);
  const int ct = w;
  int cs = 16 * ct - 8; cs = cs < 0 ? 0 : (cs > 32 ? 32 : cs);
  const int qc = 16 * ct + lr;
  int cstart = qc - 8; cstart = cstart < 0 ? 0 : (cstart > 48 ? 48 : cstart);
  const float* rpbh = rpb_lds + head * 465;
  const int qtok = b * 2048 + rq * 64 + qc;
  bf16x8 qf[2];
  { const bf16_t* qp = PN + (size_t)qtok * PN_LD + C_NQ + head * 64 + 8 * g; qf[0] = *(const bf16x8*)qp; qf[1] = *(const bf16x8*)(qp + 32); }
  unsigned kofs[2], vofs[2];
#pragma unroll
  for (int jj = 0; jj < 2; ++jj) {
    const int pidx = 2 * w + jj, row = 8 * pidx + (lane >> 3);
    const int kch = (lane & 7) ^ ((((row >> 3) & 3) << 1) | ((row >> 1) & 1));
    kofs[jj] = (unsigned)(row * PN_LD + C_NK + head * 64 + kch * 8);
    const int vch = (lane & 7) ^ ((row >> 1) & 7);
    vofs[jj] = (unsigned)((R_NV + head * 64 + row) * TT + vch * 8);
  }
#define NB_DMA(st, bf) do { const int tk = (st) < 8 ? b * 2048 + (rs + (st)) * 64 : TL + b * 256 + ((st) - 8) * 64; \
    const bf16_t* kb_ = PN + (size_t)tk * PN_LD; const bf16_t* vb_ = VT + tk; \
    _Pragma("unroll") for (int jj = 0; jj < 2; ++jj) { \
      __builtin_amdgcn_global_load_lds((const unsigned*)(kb_ + kofs[jj]), (unsigned*)(Kb + (bf) * 8192 + (2 * wu + jj) * 1024), 16, 0, 0); \
      __builtin_amdgcn_global_load_lds((const unsigned*)(vb_ + vofs[jj]), (unsigned*)(Vb + (bf) * 8192 + (2 * wu + jj) * 1024), 16, 0, 0); } } while (0)
  __syncthreads();
  NB_DMA(0, 0);
  asm volatile("s_waitcnt vmcnt(0)" ::: "memory");
  __syncthreads();
  f32x4 o[4];
#pragma unroll
  for (int dt = 0; dt < 4; ++dt) o[dt] = (f32x4){0.f, 0.f, 0.f, 0.f};
  float mrun = NEG_BIG, lrun = 0.f;
  const int kap = 8 * (lr >> 2) + (lr & 3);
  for (int st = 0; st < 12; ++st) {
    if (st + 1 < 12) NB_DMA(st + 1, (st + 1) & 1);
    const unsigned char* Kt = Kb + (st & 1) * 8192;
    const unsigned char* Vt = Vb + (st & 1) * 8192;
    const int nsub = st < 8 ? 1 : 2;
    for (int sub = 0; sub < nsub; ++sub) {
      const int koff = st < 8 ? cs : 32 * sub;
      bf16x8 kf[2][2], vf[4];
#pragma unroll
      for (int kt = 0; kt < 2; ++kt) {
        const int row = koff + kap + 4 * kt;
        const int sw = (((row >> 3) & 3) << 1) | ((row >> 1) & 1);
#pragma unroll
        for (int ks = 0; ks < 2; ++ks) kf[kt][ks] = *(const bf16x8*)(Kt + (row >> 1) * 256 + ((((row & 1) << 3) | ((ks * 4 + g) ^ sw)) << 4));
      }
#pragma unroll
      for (int dt = 0; dt < 4; ++dt) {
        const int row = 16 * dt + lr, ch = (koff >> 3) + g;
        vf[dt] = *(const bf16x8*)(Vt + (row >> 1) * 256 + (((((row & 1) << 3) | ch) ^ ((row >> 1) & 7)) << 4));
      }
      f32x4 s[2];
#pragma unroll
      for (int kt = 0; kt < 2; ++kt) {
        s[kt] = (f32x4){0.f, 0.f, 0.f, 0.f};
#pragma unroll
        for (int ks = 0; ks < 2; ++ks) s[kt] = mfma16(kf[kt][ks], qf[ks], s[kt]);
      }
      float mt = NEG_BIG;
#pragma unroll
      for (int kt = 0; kt < 2; ++kt)
#pragma unroll
        for (int r = 0; r < 4; ++r) {
          float sv;
          if (st < 8) {
            const int kc = cs + 8 * g + 4 * kt + r;
            const bool valid = (kc >= cstart) && (kc < cstart + 16);
            int dc = kc - qc + 15; dc = dc < 0 ? 0 : (dc > 30 ? 30 : dc);
            const float bias = rpbh[(rs + st - rq + 7) * 31 + dc];
            sv = valid ? (s[kt][r] * 0.125f + bias) * LOG2E : NEG_BIG;
          } else sv = s[kt][r] * SC_LOG2;
          s[kt][r] = sv; mt = fmaxf(mt, sv);
        }
      mt = rows_max(mt);
      const bool need = mt > mrun + 8.f;
      if (__any(need)) {
        const float mnew = need ? mt : mrun;
        const float alpha = __builtin_amdgcn_exp2f(mrun - mnew);
        lrun *= alpha;
#pragma unroll
        for (int dt = 0; dt < 4; ++dt) { o[dt][0] *= alpha; o[dt][1] *= alpha; o[dt][2] *= alpha; o[dt][3] *= alpha; }
        mrun = mnew;
      }
      float pv[8], ls = 0.f;
#pragma unroll
      for (int kt = 0; kt < 2; ++kt)
#pragma unroll
        for (int r = 0; r < 4; ++r) { pv[kt * 4 + r] = __builtin_amdgcn_exp2f(s[kt][r] - mrun); ls += pv[kt * 4 + r]; }
      lrun += ls;
      u32x4 pk = {pk2(pv[0], pv[1]), pk2(pv[2], pv[3]), pk2(pv[4], pv[5]), pk2(pv[6], pv[7])};
      const bf16x8 pf = __builtin_bit_cast(bf16x8, pk);
#pragma unroll
      for (int dt = 0; dt < 4; ++dt) o[dt] = mfma16(vf[dt], pf, o[dt]);
    }
    asm volatile("s_waitcnt vmcnt(0)" ::: "memory");
    __syncthreads();
  }
#undef NB_DMA
  const float inv = 1.f / rows_sum(lrun);
#pragma unroll
  for (int dt = 0; dt < 4; ++dt) {
    u32x2 ov = {pk2(o[dt][0] * inv, o[dt][1] * inv), pk2(o[dt][2] * inv, o[dt][3] * inv)};
    *(u32x2*)(Y + (size_t)qtok * 1024 + 256 + head * 64 + dt * 16 + 4 * g) = ov;
  }
}

DI float quad_sum(float v) {
  v += __int_as_float(__builtin_amdgcn_mov_dpp(__float_as_int(v), 0xB1, 0xF, 0xF, true));
  v += __int_as_float(__builtin_amdgcn_mov_dpp(__float_as_int(v), 0x4E, 0xF, 0xF, true));
  return v;
}
DI void gla_task(const Params& p, int l, int task, unsigned char* lds, int var = 0) {
  const int tid = ltid(), lane = tid & 63, w = tid >> 6, vv = lane >> 2, g = lane & 3;
  const int b = task >> 3, h = (task >> 1) & 3, dir = task & 1;
  const bf16_t* PN = (const bf16_t*)(p.ws + OFF_P);
  const bf16_t* VT = (const bf16_t*)(p.ws + OFF_VT);
  float* og = (float*)(p.ws + OFF_H);
  float* Gup = (float*)lds;
  float* Gb = Gup + 512;
  float* As = Gb + 32;
  float* Ks = As + 2048;
  float* Qs = Ks + 2048;
  float* Vs = Qs + 2048;
  __syncthreads();
  for (int e = tid; e < 512; e += 256) { const int r = e >> 5, kd = e & 31; Gup[e] = p.gate_up[((size_t)(l * 2 + dir) * 16 + r) * 128 + h * 32 + kd]; }
  if (tid < 32) Gb[tid] = p.gate_b[(l * 2 + dir) * 128 + h * 32 + tid];
  float S[8];
#pragma unroll
  for (int e = 0; e < 8; ++e) S[e] = 0.f;
  const int si = tid >> 2, part = tid & 3;
  u32x4 rq, rk, rg0, rg1, rv0, rv1;
#define GLA_TOK0(cc) ((cc) < 4 ? TL + b * 256 + (dir == 0 ? (cc) : 3 - (cc)) * 64 : b * 2048 + (dir == 0 ? (cc) - 4 : 35 - (cc)) * 64)
#define GLA_LOAD(cc) do { const int t0_ = GLA_TOK0(cc); const bf16_t* row = PN + (size_t)(t0_ + si) * PN_LD; \
    rq = *(const u32x4*)(row + C_GQ + h * 32 + part * 8); rk = *(const u32x4*)(row + C_GK + h * 32 + part * 8); \
    rg0 = *(const u32x4*)(row + C_GATE + dir * 16); rg1 = *(const u32x4*)(row + C_GATE + dir * 16 + 8); \
    const bf16_t* vp = VT + (size_t)(R_GV + h * 64 + si) * TT + t0_ + part * 16; rv0 = *(const u32x4*)vp; rv1 = *(const u32x4*)(vp + 8); } while (0)
#define GLA_WRITE() do { float gd[16], qf[8], kf[8], vf[16]; \
    unpack8(rg0, gd); unpack8(rg1, gd + 8); unpack8(rq, qf); unpack8(rk, kf); unpack8(rv0, vf); unpack8(rv1, vf + 8); \
    _Pragma("unroll") for (int e = 0; e < 8; ++e) { const int kd = part * 8 + e; float pre = Gb[kd]; \
      _Pragma("unroll") for (int r = 0; r < 16; ++r) pre += gd[r] * Gup[r * 32 + kd]; \
      const float ls = fminf(pre, 0.f) - log1pf(__expf(-fabsf(pre))); \
      As[si * 32 + kd] = __expf(ls * (1.f / 16.f)); Ks[si * 32 + kd] = kf[e]; Qs[si * 32 + kd] = qf[e] * 0.17677669529663687f; } \
    _Pragma("unroll") for (int e = 0; e < 16; ++e) Vs[(part * 16 + e) * 65 + si] = vf[e]; } while (0)
  GLA_LOAD(0);
  __syncthreads();
  GLA_WRITE();
  __syncthreads();
  for (int cc = 0; cc < 36; ++cc) {
    const int tok0 = GLA_TOK0(cc);
    if (cc + 1 < 36) GLA_LOAD(cc + 1);
    float* ob = og + ((size_t)dir * TT + tok0) * 256 + h * 64 + 16 * w + vv;
#pragma unroll 1
    for (int s0 = 0; s0 < (var == 3 ? 4 : 64); s0 += 4) {
      float4 a0[4], a1[4], k0[4], k1[4], q0[4], q1[4];
      float vx[4];
#pragma unroll
      for (int u = 0; u < 4; ++u) {
        const int i = dir == 0 ? s0 + u : 63 - s0 - u;
        a0[u] = *(const float4*)(As + i * 32 + 8 * g); a1[u] = *(const float4*)(As + i * 32 + 8 * g + 4);
        k0[u] = *(const float4*)(Ks + i * 32 + 8 * g); k1[u] = *(const float4*)(Ks + i * 32 + 8 * g + 4);
        q0[u] = *(const float4*)(Qs + i * 32 + 8 * g); q1[u] = *(const float4*)(Qs + i * 32 + 8 * g + 4);
        vx[u] = Vs[i * 65 + 16 * w + vv];
      }
#pragma unroll
      for (int u = 0; u < 4; ++u) {
        const int i = dir == 0 ? s0 + u : 63 - s0 - u;
        const float v = vx[u];
        S[0] = fmaf(a0[u].x, S[0], k0[u].x * v); S[1] = fmaf(a0[u].y, S[1], k0[u].y * v);
        S[2] = fmaf(a0[u].z, S[2], k0[u].z * v); S[3] = fmaf(a0[u].w, S[3], k0[u].w * v);
        S[4] = fmaf(a1[u].x, S[4], k1[u].x * v); S[5] = fmaf(a1[u].y, S[5], k1[u].y * v);
        S[6] = fmaf(a1[u].z, S[6], k1[u].z * v); S[7] = fmaf(a1[u].w, S[7], k1[u].w * v);
        const float oa = fmaf(q0[u].x, S[0], q0[u].y * S[1]), ob2 = fmaf(q0[u].z, S[2], q0[u].w * S[3]);
        const float oc = fmaf(q1[u].x, S[4], q1[u].y * S[5]), od = fmaf(q1[u].z, S[6], q1[u].w * S[7]);
        float o = (oa + ob2) + (oc + od);
        o = quad_sum(o);
        if (var == 1) asm volatile("" :: "v"(o)); else if (g == 0) ob[(size_t)i * 256] = o;
      }
    }
    __syncthreads();
    if (cc + 1 < 36 && var != 2) GLA_WRITE();
    __syncthreads();
  }
#undef GLA_TOK0
#undef GLA_LOAD
#undef GLA_WRITE
}

DI void phase_mixers(const Params& p, int l, bool last, unsigned* ctr, unsigned char* lds, int mask = 15, int gvar = 0) {
  const int tid = ltid(), w = tid >> 6;
  volatile int* slot = (volatile int*)(lds + LDS_BYTES - 16);
  float* rpb_lds = (float*)(lds + 65536);
  for (int e = tid; e < 4 * 465; e += 256) rpb_lds[e] = p.rpb[(size_t)l * 4 * 465 + e];
  const int nconv = (l == 0 && (mask & 8)) ? 1024 : 0;
  const int t1 = 128 + nconv, t2 = t1 + 1024, t3 = t2 + 2048, t4 = t3 + 128;
  const int ntask = last ? t3 : t4 + 256;
  for (;;) {
    __syncthreads();
    if (tid == 0) *slot = (int)atomicAdd(ctr, 1u);
    __syncthreads();
    const int task = *slot;
    if (task >= ntask) break;
    if (task < 128) { if (mask & 1) { __builtin_amdgcn_s_setprio(3); gla_task(p, l, task, lds, gvar); __builtin_amdgcn_s_setprio(0); } }
    else if (nconv && task < t2 && ((task - 128) & 1)) { const int c = (task - 128) >> 1; convert_table_pairs(p, c * 64, c * 64 + 64, w, 4, tid & 63); }
    else if (!(mask & 2) && (task < t2 || (task >= t3 && task < t4))) {}
    else if (!(mask & 4) && ((task >= t2 && task < t3) || task >= t4)) {}
    else if (task < t2) { const int d = nconv ? (task - 128) >> 1 : task - 128; const int b = d >> 6; diff_block_task(p, l, b, (d >> 4) & 3, b * 2048 + (d & 15) * 128, 72, lds, gvar); }
    else if (task < t3) { const int d = task - t2; nat_block_task(p, l, d >> 7, (d >> 5) & 3, d & 31, rpb_lds, lds); }
    else if (task < t4) { const int d = task - t3; const int b = d >> 3; diff_block_task(p, l, b, (d >> 1) & 3, TL + b * 256 + (d & 1) * 128, 8, lds); }
    else { const int wt = (task - t4) * 4 + w; natctx_wave_task(p, wt >> 6, (wt >> 4) & 3, wt & 15); }
  }
}

DI void phase_gla_fin(const Params& p, int l, int ntok) {
  const int lane = ltid() & 63, gw = lbid() * 4 + (ltid() >> 6), nw = lgdim() * 4;
  const float* og = (const float*)(p.ws + OFF_H);
  const bf16_t* PN = (const bf16_t*)(p.ws + OFF_P);
  bf16_t* Y = (bf16_t*)(p.ws + OFF_Y);
  const float4 gg = *(const float4*)(p.gla_norm_g + l * 256 + 4 * lane);
  for (int t = gw; t < ntok; t += nw) {
    const float4 a = *(const float4*)(og + (size_t)t * 256 + 4 * lane), bq = *(const float4*)(og + ((size_t)TT + t) * 256 + 4 * lane);
    const float o0 = a.x + bq.x, o1 = a.y + bq.y, o2 = a.z + bq.z, o3 = a.w + bq.w;
    float ss = o0 * o0 + o1 * o1 + o2 * o2 + o3 * o3;
    ss += __shfl_xor(ss, 1); ss += __shfl_xor(ss, 2); ss += __shfl_xor(ss, 4); ss += __shfl_xor(ss, 8);
    const float rstd = rsqrtf(ss * (1.f / 64.f) + 1e-6f);
    const u32x2 rv = *(const u32x2*)(PN + (size_t)t * PN_LD + C_GR + 4 * lane);
    const float r0 = bflo(rv.x), r1 = bfhi(rv.x), r2 = bflo(rv.y), r3 = bfhi(rv.y);
    const float y0 = o0 * rstd * gg.x * (r0 / (1.f + __expf(-r0)));
    const float y1 = o1 * rstd * gg.y * (r1 / (1.f + __expf(-r1)));
    const float y2 = o2 * rstd * gg.z * (r2 / (1.f + __expf(-r2)));
    const float y3 = o3 * rstd * gg.w * (r3 / (1.f + __expf(-r3)));
    u32x2 ov = {pk2(y0, y1), pk2(y2, y3)};
    *(u32x2*)(Y + (size_t)t * 1024 + 4 * lane) = ov;
  }
}

struct PairTab { int a[52], b[52]; };
constexpr PairTab make_pairs() {
  PairTab t{};
  int n = 0;
  for (int a = 0; a < 16; ++a)
    for (int b = 0; b < 16; ++b)
      if ((a + 1) * (b + 1) <= 16) { t.a[n] = a; t.b[n] = b; ++n; }
  for (; n < 52; ++n) { t.a[n] = -1; t.b[n] = -1; }
  return t;
}

DI void topk_half(const bf16_t* skh  , const bf16_t* qrow  , int lr, int g, float (&list)[16]) {
  bf16x8 qf[2];
  qf[0] = *(const bf16x8*)(qrow); qf[1] = *(const bf16x8*)(qrow + 32);
  float s[32];
#pragma unroll
  for (int nt = 0; nt < 8; ++nt) {
    f32x4 acc = {0.f, 0.f, 0.f, 0.f};
#pragma unroll
    for (int ks = 0; ks < 2; ++ks) {
      const bf16x8 af = *(const bf16x8*)(skh + (size_t)(nt * 16 + lr) * 64 + ks * 32 + 8 * g);
      acc = mfma16(af, qf[ks], acc);
    }
#pragma unroll
    for (int r = 0; r < 4; ++r) {
      const unsigned n = nt * 16 + 4 * g + r;
      s[nt * 4 + r] = __uint_as_float((__float_as_uint(acc[r]) & ~127u) | n);
    }
  }
#pragma unroll
  for (int k = 0; k < 16; ++k) {
    float m = s[0];
#pragma unroll
    for (int i = 1; i < 32; ++i) m = fmaxf(m, s[i]);
    m = fmaxf(m, __shfl_xor(m, 16));
    m = fmaxf(m, __shfl_xor(m, 32));
    list[k] = m;
#pragma unroll
    for (int i = 0; i < 32; ++i) s[i] = (s[i] == m) ? -3.0e38f : s[i];
  }
}

DI void topk_tile(const bf16_t* QP, const bf16_t* sk, int tt, int hd, int* eid_rows, float* gate_rows, int lr, int g) {
  constexpr PairTab PT = make_pairs();
  {
    const int tok = tt * 16 + lr;
    float v1[16], v2[16];
    topk_half(sk, QP + (size_t)tok * 1024 + hd * 128 + 8 * g, lr, g, v1);
    __builtin_amdgcn_sched_barrier(0);
    topk_half(sk + 128 * 64, QP + (size_t)tok * 1024 + hd * 128 + 64 + 8 * g, lr, g, v2);
    __builtin_amdgcn_sched_barrier(0);
    float cand[13];
    int ceid[13];
#pragma unroll
    for (int c = 0; c < 13; ++c) {
      float sv[4];
      int ev[4];
#pragma unroll
      for (int gi = 0; gi < 4; ++gi) {
        const int pi = 4 * c + gi;
        if (PT.a[pi] >= 0) {
          const float a = v1[PT.a[pi] < 0 ? 0 : PT.a[pi]], bq = v2[PT.b[pi] < 0 ? 0 : PT.b[pi]];
          sv[gi] = __uint_as_float((__float_as_uint(a + bq) & ~63u) | (unsigned)pi);
          ev[gi] = (int)((__float_as_uint(a) & 127u) * 128u + (__float_as_uint(bq) & 127u));
        } else { sv[gi] = -3.0e38f; ev[gi] = 0; }
      }
      cand[c] = g == 0 ? sv[0] : (g == 1 ? sv[1] : (g == 2 ? sv[2] : sv[3]));
      ceid[c] = g == 0 ? ev[0] : (g == 1 ? ev[1] : (g == 2 ? ev[2] : ev[3]));
    }
    float topv[16];
#pragma unroll
    for (int k = 0; k < 16; ++k) {
      float m = cand[0];
#pragma unroll
      for (int c = 1; c < 13; ++c) m = fmaxf(m, cand[c]);
      m = fmaxf(m, __shfl_xor(m, 16));
      m = fmaxf(m, __shfl_xor(m, 32));
      topv[k] = m;
      int my = -1;
#pragma unroll
      for (int c = 0; c < 13; ++c) { if (cand[c] == m) { my = ceid[c]; cand[c] = -3.0e38f; } }
      if (my >= 0) eid_rows[lr * 128 + hd * 16 + k] = my;
    }
    if (g == 0) {
      float ex[16], sum = 0.f;
#pragma unroll
      for (int k = 0; k < 16; ++k) { ex[k] = __expf(topv[k] - topv[0]); sum += ex[k]; }
      const float inv = 1.f / sum;
#pragma unroll
      for (int q = 0; q < 4; ++q) {
        float4 o = {ex[4 * q] * inv, ex[4 * q + 1] * inv, ex[4 * q + 2] * inv, ex[4 * q + 3] * inv};
        *(float4*)(gate_rows + lr * 128 + hd * 16 + 4 * q) = o;
      }
    }
  }
}

DI float gelu_tanh(float x) {
  const float z = 0.7978845608028654f * (x + 0.044715f * x * x * x);
  const float e = __expf(2.f * z);
  const float th = 1.f - 2.f / (e + 1.f);
  return 0.5f * x * (1.f + th);
}
DI void gather_token(const Params& p, int l, int t, const int* eid_row, const float* gate_row, unsigned char* hl, float* wl, bool dry) {
  const int lane = ltid() & 63, lr = lane & 15, g = lane >> 4;
  const unsigned char* U6 = p.ws + OFF_U + (size_t)l * 16384 * U_PITCH;
  const unsigned char* V6 = p.ws + OFF_V + (size_t)l * 16384 * V_PITCH;
  const int half = lane >> 5, blk = lane & 31;
  const unsigned char* H6 = p.ws + OFF_H8;
  float* xres = (float*)(p.ws + OFF_XRES);
  const float* modbuf = (const float*)(p.ws + OFF_MOD);
  {
    if (lane < 50) {
      const u32x4 hq = *(const u32x4*)(H6 + (size_t)t * V6_PITCH + lane * 16);
      *(u32x4*)(hl + lane * 16) = hq;
    }
    const int e0 = eid_row[lane], e1 = eid_row[64 + lane];
    const float gv0 = gate_row[lane], gv1 = gate_row[64 + lane];
    {
      const u32x2 hsc = *(const u32x2*)(hl + 768 + 8 * g);
#pragma unroll 1
      for (int grp = 0; grp < 8; ++grp) {
        const int er = __shfl(grp < 4 ? e0 : e1, (grp & 3) * 16 + lr);
        const unsigned char* ur = U6 + (size_t)er * U_PITCH;
        u32x4 ua[8]; u32x2 ub[8];
#pragma unroll
        for (int s = 0; s < 8; ++s) {
          if (U_FP4) { ua[s] = *(const u32x4*)(ur + 16 * (4 * s + g)); ub[s] = (u32x2){0u, 0u}; }
          else { ua[s] = *(const u32x4*)(ur + 24 * (4 * s + g)); ub[s] = *(const u32x2*)(ur + 24 * (4 * s + g) + 16); }
        }
        const u32x2 usc = *(const u32x2*)(ur + (U_FP4 ? 512 : 768) + 8 * g);
        __builtin_amdgcn_sched_barrier(0);
        f32x4 acc = {0.f, 0.f, 0.f, 0.f};
#define G_STEP(s, OS, USC, HSC) do { const unsigned char* hb = hl + 24 * (4 * (s) + g); \
          const u32x2 h0 = *(const u32x2*)hb, h1 = *(const u32x2*)(hb + 8), h2v = *(const u32x2*)(hb + 16); \
          const i32x8 av = {(int)ua[s][0], (int)ua[s][1], (int)ua[s][2], (int)ua[s][3], (int)ub[s][0], (int)ub[s][1], 0, 0}; \
          const i32x8 bv = {(int)h0[0], (int)h0[1], (int)h1[0], (int)h1[1], (int)h2v[0], (int)h2v[1], 0, 0}; \
          acc = __builtin_amdgcn_mfma_scale_f32_16x16x128_f8f6f4(av, bv, acc, U_FP4 ? 4 : 2, 2, OS, (int)(USC), OS, (int)(HSC)); } while (0)
        G_STEP(0, 0, usc[0], hsc[0]); G_STEP(1, 1, usc[0], hsc[0]); G_STEP(2, 2, usc[0], hsc[0]); G_STEP(3, 3, usc[0], hsc[0]);
        G_STEP(4, 0, usc[1], hsc[1]); G_STEP(5, 1, usc[1], hsc[1]); G_STEP(6, 2, usc[1], hsc[1]); G_STEP(7, 3, usc[1], hsc[1]);
#undef G_STEP
        const float gvs = grp < 4 ? gv0 : gv1;
        const int lb_ = (grp & 3) * 16 + 4 * g;
        float4 wv_;
        wv_.x = __shfl(gvs, lb_) * gelu_tanh(acc[0]); wv_.y = __shfl(gvs, lb_ + 1) * gelu_tanh(acc[1]);
        wv_.z = __shfl(gvs, lb_ + 2) * gelu_tanh(acc[2]); wv_.w = __shfl(gvs, lb_ + 3) * gelu_tanh(acc[3]);
        if (lr == 0) *(float4*)(wl + grp * 16 + 4 * g) = wv_;
        __builtin_amdgcn_sched_barrier(0);
      }
    }
    __builtin_amdgcn_sched_barrier(0);
    float out[32];
#pragma unroll
    for (int i = 0; i < 32; ++i) out[i] = 0.f;
#pragma unroll 1
    for (int grp = 0; grp < 8; ++grp) {
      const int esel = grp < 4 ? e0 : e1;
      const int lb = (grp & 3) * 16;
      u32x4 vd4[8]; u32x2 vd2[8]; unsigned vsc[8];
#pragma unroll
      for (int pp = 0; pp < 8; ++pp) {
        const int ea = __builtin_amdgcn_readlane(esel, lb + 2 * pp), eb = __builtin_amdgcn_readlane(esel, lb + 2 * pp + 1);
        const unsigned char* vr = V6 + (size_t)(half ? eb : ea) * V_PITCH;
        if (V_FP4) { vd4[pp] = *(const u32x4*)(vr + 16 * blk); vd2[pp] = (u32x2){0u, 0u}; vsc[pp] = vr[mx4_scale_pos(blk)]; }
        else { vd4[pp] = *(const u32x4*)(vr + 24 * blk); vd2[pp] = *(const u32x2*)(vr + 24 * blk + 16); vsc[pp] = vr[mx_scale_pos(blk)]; }
      }
      __builtin_amdgcn_sched_barrier(0);
#pragma unroll
      for (int pp = 0; pp < 8; ++pp) {
        const float wgt = wl[grp * 16 + 2 * pp + half] * __uint_as_float(vsc[pp] << 23);
        if (V_FP4) {
          unsigned q0 = vd4[pp][0], q1 = vd4[pp][1], q2 = vd4[pp][2], q3 = vd4[pp][3];
          asm volatile("" : "+v"(q0), "+v"(q1) : "v"(out[0]), "v"(out[1]), "v"(out[2]), "v"(out[3]), "v"(out[4]), "v"(out[5]), "v"(out[6]), "v"(out[7]),
                       "v"(out[8]), "v"(out[9]), "v"(out[10]), "v"(out[11]), "v"(out[12]), "v"(out[13]), "v"(out[14]), "v"(out[15]));
          asm volatile("" : "+v"(q2), "+v"(q3) : "v"(out[16]), "v"(out[17]), "v"(out[18]), "v"(out[19]), "v"(out[20]), "v"(out[21]), "v"(out[22]), "v"(out[23]),
                       "v"(out[24]), "v"(out[25]), "v"(out[26]), "v"(out[27]), "v"(out[28]), "v"(out[29]), "v"(out[30]), "v"(out[31]));
          const u32x4 qd = {q0, q1, q2, q3};
#pragma unroll
          for (int d = 0; d < 4; ++d) {
            const f32x2 t0 = __builtin_amdgcn_cvt_scalef32_pk_f32_fp4(qd[d], 1.0f, 0), t1 = __builtin_amdgcn_cvt_scalef32_pk_f32_fp4(qd[d], 1.0f, 1);
            const f32x2 t2 = __builtin_amdgcn_cvt_scalef32_pk_f32_fp4(qd[d], 1.0f, 2), t3 = __builtin_amdgcn_cvt_scalef32_pk_f32_fp4(qd[d], 1.0f, 3);
            out[8 * d + 0] += wgt * t0[0]; out[8 * d + 1] += wgt * t0[1]; out[8 * d + 2] += wgt * t1[0]; out[8 * d + 3] += wgt * t1[1];
            out[8 * d + 4] += wgt * t2[0]; out[8 * d + 5] += wgt * t2[1]; out[8 * d + 6] += wgt * t3[0]; out[8 * d + 7] += wgt * t3[1];
          }
        } else {
          unsigned pk0 = vd4[pp][0], pk1 = vd4[pp][1];
          asm volatile("" : "+v"(pk0) : "v"(out[0]), "v"(out[1]), "v"(out[2]), "v"(out[3]), "v"(out[4]), "v"(out[5]), "v"(out[6]), "v"(out[7]),
                       "v"(out[8]), "v"(out[9]), "v"(out[10]), "v"(out[11]), "v"(out[12]), "v"(out[13]), "v"(out[14]), "v"(out[15]));
          asm volatile("" : "+v"(pk1) : "v"(out[16]), "v"(out[17]), "v"(out[18]), "v"(out[19]), "v"(out[20]), "v"(out[21]), "v"(out[22]), "v"(out[23]),
                       "v"(out[24]), "v"(out[25]), "v"(out[26]), "v"(out[27]), "v"(out[28]), "v"(out[29]), "v"(out[30]), "v"(out[31]));
          const u32x6 pk = {pk0, pk1, vd4[pp][2], vd4[pp][3], vd2[pp][0], vd2[pp][1]};
          const f32x32 vals = __builtin_amdgcn_cvt_scalef32_pk32_f32_fp6(pk, 1.0f);
  #pragma unroll
          for (int i = 0; i < 32; ++i) out[i] += wgt * vals[i];
        }
        __builtin_amdgcn_sched_barrier(0);
      }
    }
    float o16[16];
#pragma unroll
    for (int i = 0; i < 16; ++i) {
      const u32x2 s0 = __builtin_amdgcn_permlane32_swap(__float_as_uint(out[i]), __float_as_uint(out[i]), false, false);
      const u32x2 s1 = __builtin_amdgcn_permlane32_swap(__float_as_uint(out[16 + i]), __float_as_uint(out[16 + i]), false, false);
      const float t0 = __uint_as_float(s0[0]) + __uint_as_float(s0[1]), t1 = __uint_as_float(s1[0]) + __uint_as_float(s1[1]);
      o16[i] = half ? t1 : t0;
    }
    const int cb = 32 * blk + 16 * half;
    const int b = t < TL ? (t >> 11) : 16;
    const float* md = modbuf + ((size_t)l * 17 + b) * 6144 + 5 * 1024 + cb;
    float* xr = xres + (size_t)t * 1024 + cb;
    float xn[16];
    float ss = 0.f;
#pragma unroll
    for (int q = 0; q < 4; ++q) {
      const float4 m4 = *(const float4*)(md + 4 * q);
      float4 xv = *(const float4*)(xr + 4 * q);
      xv.x += m4.x * o16[4 * q + 0]; xv.y += m4.y * o16[4 * q + 1]; xv.z += m4.z * o16[4 * q + 2]; xv.w += m4.w * o16[4 * q + 3];
      xn[4 * q] = xv.x; xn[4 * q + 1] = xv.y; xn[4 * q + 2] = xv.z; xn[4 * q + 3] = xv.w;
      ss += xv.x * xv.x + xv.y * xv.y + xv.z * xv.z + xv.w * xv.w;
      if (dry) asm volatile("" :: "v"(xv.x), "v"(xv.y), "v"(xv.z), "v"(xv.w));
      else if (l < NL - 1) *(float4*)(xr + 4 * q) = xv;
    }
    if (!dry) {
      ss = wave_sum(ss);
      const float rstd = rsqrtf(ss * (1.f / 1024.f) + 1e-6f);
      if (l == NL - 1) {
        const float* fg = p.final_g + cb;
        float* orow = p.out + (size_t)t * 1024 + cb;
#pragma unroll
        for (int q = 0; q < 4; ++q) {
          const float4 g4 = *(const float4*)(fg + 4 * q);
          float4 o = {xn[4 * q] * rstd * g4.x, xn[4 * q + 1] * rstd * g4.y, xn[4 * q + 2] * rstd * g4.z, xn[4 * q + 3] * rstd * g4.w};
          *(float4*)(orow + 4 * q) = o;
        }
      } else {
        const float* gvec = p.norm1_g + (l + 1) * 1024 + cb;
        const float* mdn = modbuf + ((size_t)(l + 1) * 17 + b) * 6144 + cb;
        bf16_t* hrow = (bf16_t*)(p.ws + OFF_H) + (size_t)t * 1024 + cb;
        unsigned pk[8];
#pragma unroll
        for (int q = 0; q < 4; ++q) {
          const float4 g4 = *(const float4*)(gvec + 4 * q), sh = *(const float4*)(mdn + 4 * q), sc = *(const float4*)(mdn + 1024 + 4 * q);
          const float o0 = xn[4 * q] * rstd * g4.x * (1.f + sc.x) + sh.x, o1 = xn[4 * q + 1] * rstd * g4.y * (1.f + sc.y) + sh.y;
          const float o2 = xn[4 * q + 2] * rstd * g4.z * (1.f + sc.z) + sh.z, o3 = xn[4 * q + 3] * rstd * g4.w * (1.f + sc.w) + sh.w;
          pk[2 * q] = pk2(o0, o1); pk[2 * q + 1] = pk2(o2, o3);
        }
        *(u32x4*)hrow = (u32x4){pk[0], pk[1], pk[2], pk[3]};
        *(u32x4*)(hrow + 8) = (u32x4){pk[4], pk[5], pk[6], pk[7]};
      }
    }
  }
}


DI void phase_topk_gather(const Params& p, int l, int ntok, unsigned* ctr, unsigned char* lds, bool dry = false) {
  const int tid = ltid(), lane = tid & 63, w = tid >> 6, lr = lane & 15, g = lane >> 4;
  const bf16_t* QP = (const bf16_t*)(p.ws + OFF_QP);
  const bf16_t* sk = (const bf16_t*)(p.ws + OFF_SK) + (size_t)l * 2 * 128 * 64;
  int* eid_l = (int*)lds;
  float* gate_l = (float*)(lds + 8192);
  unsigned char* hl = lds + 16384 + w * 2048;
  float* wl = (float*)(hl + 1024);
  volatile int* slot = (volatile int*)(lds + LDS_BYTES - 16);
  const int ntile = ntok / 16;
  for (;;) {
    __syncthreads();
    if (tid == 0) *slot = (int)atomicAdd(ctr, 1u);
    __syncthreads();
    const int tile = *slot;
    if (tile >= ntile) break;
#pragma unroll 1
    for (int hh = 0; hh < 2; ++hh) {
      topk_tile(QP, sk, tile, 2 * w + hh, eid_l, gate_l, lr, g);
      __builtin_amdgcn_sched_barrier(0);
    }
    __syncthreads();
#pragma unroll 1
    for (int q = 0; q < 4; ++q) {
      const int r = 4 * w + q;
      gather_token(p, l, tile * 16 + r, eid_l + r * 128, gate_l + r * 128, hl, wl, dry);
    }
  }
}

DI void phase_final(const Params& p) {
  const int lane = ltid() & 63, gw = lbid() * 4 + (ltid() >> 6), nw = lgdim() * 4;
  const float* xres = (const float*)(p.ws + OFF_XRES);
  for (int t = gw; t < TL; t += nw) {
    const float* src = xres + (size_t)t * 1024;
    float4 v[4];
    float ss = 0.f;
#pragma unroll
    for (int i = 0; i < 4; ++i) {
      v[i] = *(const float4*)(src + 4 * lane + 256 * i);
      ss += v[i].x * v[i].x + v[i].y * v[i].y + v[i].z * v[i].z + v[i].w * v[i].w;
    }
    ss = wave_sum(ss);
    const float rstd = rsqrtf(ss * (1.f / 1024.f) + 1e-6f);
#pragma unroll
    for (int i = 0; i < 4; ++i) {
      const int col = 4 * lane + 256 * i;
      const float4 g4 = *(const float4*)(p.final_g + col);
      float4 o = {v[i].x * rstd * g4.x, v[i].y * rstd * g4.y, v[i].z * rstd * g4.z, v[i].w * rstd * g4.w};
      *(float4*)(p.out + (size_t)t * 1024 + col) = o;
    }
  }
}


#define LAS __attribute__((address_space(3)))
#define XB_TMO      128
#define XB_XCNT(j)  (256  + 64 * (j))
#define XB_XSUB(j)  (1280 + 64 * (j))
#define XB_XGEN(j)  (2304 + 64 * (j))
#define XB_TOP      3328
#define XB_TOPGEN   3392
#define XCD_BAR_WORDS 3456
#define XB_SPIN_CAP (1u << 22)
DI unsigned xb_ld(unsigned* p) { return __hip_atomic_load(p, __ATOMIC_RELAXED, __HIP_MEMORY_SCOPE_AGENT); }
DI unsigned xb_add(unsigned* p, unsigned v) { return __hip_atomic_fetch_add(p, v, __ATOMIC_RELAXED, __HIP_MEMORY_SCOPE_AGENT); }
DI unsigned xb_xcc_id() { return (unsigned)__builtin_amdgcn_s_getreg((3 << 11) | 20) & 0xFu; }
#define XB_SPIN(cond, bar) do { unsigned _sp = 0; while (cond) { __builtin_amdgcn_s_sleep(1); \
    if ((++_sp & 255u) == 0u) { if (xb_ld(&(bar)[XB_TMO])) break; if (_sp > XB_SPIN_CAP) { atomicAdd(&(bar)[XB_TMO], 1u); break; } } } } while (0)
struct XcdBarrier { unsigned* bar; unsigned x; volatile unsigned* st; };
DI XcdBarrier xcd_barrier_post(unsigned* bar, volatile unsigned* st) {
  XcdBarrier b; b.bar = bar; b.x = xb_xcc_id(); b.st = st;
  if (threadIdx.x == 0) (void)xb_add(&bar[XB_XCNT(b.x)], 1u);
  return b;
}
DI void xcd_barrier_complete(unsigned* bar, unsigned x, unsigned& nloc, unsigned& nx) {
  const unsigned G = gridDim.x * gridDim.y * gridDim.z;
  unsigned sum, cnt, mine, sp = 0u;
  for (;;) {
    sum = 0u; cnt = 0u; mine = 0u;
#pragma unroll 1
    for (unsigned j = 0; j < 16; ++j) { const unsigned c = xb_ld(&bar[XB_XCNT(j)]); sum += c; cnt += (c > 0u) ? 1u : 0u; mine = (j == x) ? c : mine; }
    if (sum == G) break;
    __builtin_amdgcn_s_sleep(1);
    if ((++sp & 255u) == 0u) { if (xb_ld(&bar[XB_TMO])) break; if (sp > XB_SPIN_CAP) { atomicAdd(&bar[XB_TMO], 1u); break; } }
  }
  nloc = mine > 0u ? mine : 1u; nx = cnt > 0u ? cnt : 1u;
}
DI void xcd_barrier(const XcdBarrier& b) {
  asm volatile("s_waitcnt vmcnt(0)" ::: "memory");
  __syncthreads();
  if (threadIdx.x == 0) {
    unsigned* bar = b.bar;
    __builtin_amdgcn_s_waitcnt(0);
    unsigned nloc = b.st[0], nx = b.st[1];
    if (nloc == 0u) { xcd_barrier_complete(bar, b.x, nloc, nx); b.st[0] = nloc; b.st[1] = nx; }
    const unsigned old = xb_add(&bar[XB_XSUB(b.x)], 1u);
    const unsigned gen = old / nloc;
    if (old + 1u == (gen + 1u) * nloc) {
      __builtin_amdgcn_fence(__ATOMIC_RELEASE, "agent");
      asm volatile("s_waitcnt vmcnt(0)" ::: "memory");
      const unsigned og = xb_add(&bar[XB_TOP], 1u);
      const unsigned tg = og / nx;
      if (og + 1u == (tg + 1u) * nx) xb_add(&bar[XB_TOPGEN], 1u);
      else XB_SPIN(xb_ld(&bar[XB_TOPGEN]) == tg, bar);
      __builtin_amdgcn_fence(__ATOMIC_ACQUIRE, "agent");
      xb_add(&bar[XB_XGEN(b.x)], 1u);
      asm volatile("s_waitcnt vmcnt(0)" ::: "memory");
    } else {
      XB_SPIN(xb_ld(&bar[XB_XGEN(b.x)]) == gen, bar);
      __builtin_amdgcn_fence(__ATOMIC_ACQUIRE, "agent");
      asm volatile("s_waitcnt vmcnt(0)" ::: "memory");
    }
  }
  __syncthreads();
}

constexpr int PH_PER_LAYER = 10;
constexpr int N_PHASES = 1 + NL * PH_PER_LAYER + 1;

template <int KIND>
DI void run_phase(const Params& p, int ph, unsigned char* lds) {
  unsigned* ctl = (unsigned*)(p.ws + OFF_CTL);
  if (ph == 0) { if (KIND < 0 || KIND == 0) phase_prologue(p, lds); }
  else if (ph == N_PHASES - 1) { if (KIND < 0 || KIND == 11) phase_final(p); }
  else {
    const int l = (ph - 1) / PH_PER_LAYER, s = (ph - 1) % PH_PER_LAYER;
    const bool last = (l == NL - 1);
    const int ntok = last ? TL : TT;
    if (s == 0) { if (KIND < 0 || KIND == 1) phase_norm(p, l, 0, TT); }
    else if (s == 1) { if (KIND < 0 || KIND == 2) phase_gemm_in(p, l, lds); }
    else if (s == 2) { if (KIND < 0 || KIND == 3) phase_rope(p, lds); }
    else if (s == 3) { if (KIND < 0 || KIND == 4) phase_mixers(p, l, last, ctl + 64 * (1 + l), lds); }
    else if (s == 4) { if (KIND < 0 || KIND == 5) phase_gla_fin(p, l, ntok); }
    else if (s == 5) { if (KIND < 0 || KIND == 6) phase_gemm_out(p, l, ntok, lds); }
    else if (s == 6) { if (KIND < 0 || KIND == 7) phase_norm(p, l, 1, ntok); }
    else if (s == 7) { if (KIND < 0 || KIND == 8) phase_gemm_q(p, l, ntok, lds); }
    else if (s == 8) { }
    else { if (KIND < 0 || KIND == 10) phase_topk_gather(p, l, ntok, (unsigned*)(p.ws + OFF_CTL) + 64 * (8 + l), lds); }
  }
}

#if N_LAUNCH_MODE == 1
#ifndef PROBE_KIND
#define PROBE_KIND -1
#endif
#ifndef GLA_VAR
#define GLA_VAR 0
#endif
constexpr int CW_BAR = 4096;
template <int l>
DI void run_layer(const Params& p, unsigned char* lds) {
  unsigned* ctl = (unsigned*)(p.ws + OFF_CTL);
#define GSYNC() do { XcdBarrier bb; bb.bar = (unsigned*)(p.ws + OFF_CTL) + CW_BAR; bb.x = xb_xcc_id(); bb.st = (volatile unsigned*)(lds + LDS_BYTES - 32); xcd_barrier(bb); } while (0)

    const bool last = (l == NL - 1);
    const int ntok = last ? TL : TT;
    if (l == 0) { { Params q = p; { size_t z_ = 0; asm volatile("" : "+s"(z_)); q.ws = p.ws + z_; } phase_norm(q, l, 0, TT); } GSYNC(); }
    if (PROBE_KIND == 1) { { Params q = p; { size_t z_ = 0; asm volatile("" : "+s"(z_)); q.ws = p.ws + z_; } phase_norm(q, l, 0, TT); } GSYNC(); }
    if (PROBE_KIND == 2) { { Params q = p; { size_t z_ = 0; asm volatile("" : "+s"(z_)); q.ws = p.ws + z_; } phase_gemm_in(q, l, lds, true); } GSYNC(); }
    { Params q = p; { size_t z_ = 0; asm volatile("" : "+s"(z_)); q.ws = p.ws + z_; } phase_gemm_in(q, l, lds); } GSYNC();
    if (PROBE_KIND == 4 || (PROBE_KIND >= 41 && PROBE_KIND <= 47)) { { Params q = p; { size_t z_ = 0; asm volatile("" : "+s"(z_)); q.ws = p.ws + z_; } phase_mixers(q, l, last, ctl + 64 * (1 + l) + 1, lds, PROBE_KIND == 4 ? 15 : PROBE_KIND - 40, GLA_VAR); } GSYNC(); }
    { Params q = p; { size_t z_ = 0; asm volatile("" : "+s"(z_)); q.ws = p.ws + z_; } phase_mixers(q, l, last, ctl + 64 * (1 + l), lds); } GSYNC();
    { Params q = p; { size_t z_ = 0; asm volatile("" : "+s"(z_)); q.ws = p.ws + z_; } phase_gla_fin(q, l, ntok); } GSYNC();
    if (PROBE_KIND == 5) { { Params q = p; { size_t z_ = 0; asm volatile("" : "+s"(z_)); q.ws = p.ws + z_; } phase_gla_fin(q, l, ntok); } GSYNC(); }
    { Params q = p; { size_t z_ = 0; asm volatile("" : "+s"(z_)); q.ws = p.ws + z_; } phase_gemm_out(q, l, ntok, lds); } GSYNC();
    { Params q = p; { size_t z_ = 0; asm volatile("" : "+s"(z_)); q.ws = p.ws + z_; } phase_norm2(q, l, ntok); } GSYNC();
    if (PROBE_KIND == 7) { { Params q = p; { size_t z_ = 0; asm volatile("" : "+s"(z_)); q.ws = p.ws + z_; } phase_norm2(q, l, ntok); } GSYNC(); }
    { Params q = p; { size_t z_ = 0; asm volatile("" : "+s"(z_)); q.ws = p.ws + z_; } phase_gemm_q(q, l, ntok, lds); } GSYNC();
    if (PROBE_KIND == 8) { { Params q = p; { size_t z_ = 0; asm volatile("" : "+s"(z_)); q.ws = p.ws + z_; } phase_gemm_q(q, l, ntok, lds); } GSYNC(); }
    if (PROBE_KIND == 11) { { Params q = p; { size_t z_ = 0; asm volatile("" : "+s"(z_)); q.ws = p.ws + z_; } phase_topk_gather(q, l, ntok, ctl + 64 * (8 + l) + 1, lds, true); } GSYNC(); }
    { Params q = p; { size_t z_ = 0; asm volatile("" : "+s"(z_)); q.ws = p.ws + z_; } phase_topk_gather(q, l, ntok, ctl + 64 * (8 + l), lds); } if (l + 1 < NL) GSYNC();
}
__global__ void __launch_bounds__(256, 2) mk_fwd(Params p) {
  __shared__ __attribute__((aligned(16))) unsigned char lds[LDS_BYTES];
  unsigned* ctl = (unsigned*)(p.ws + OFF_CTL);
  volatile unsigned* st = (volatile unsigned*)(lds + LDS_BYTES - 32);
  if (threadIdx.x < 2) st[threadIdx.x] = 0u;
  __syncthreads();
  (void)xcd_barrier_post(ctl + CW_BAR, st);
#define GSYNC() do { XcdBarrier bb; bb.bar = (unsigned*)(p.ws + OFF_CTL) + CW_BAR; bb.x = xb_xcc_id(); bb.st = (volatile unsigned*)(lds + LDS_BYTES - 32); xcd_barrier(bb); } while (0)
  { Params q = p; { size_t z_ = 0; asm volatile("" : "+s"(z_)); q.ws = p.ws + z_; } phase_prologue(q, lds); } cg::this_grid().sync();
  if (PROBE_KIND == 0) { { Params q = p; { size_t z_ = 0; asm volatile("" : "+s"(z_)); q.ws = p.ws + z_; } phase_prologue(q, lds); } GSYNC(); }
  run_layer<0>(p, lds); run_layer<1>(p, lds); run_layer<2>(p, lds); run_layer<3>(p, lds);
}
#else
template <int KIND>
__global__ void __launch_bounds__(256, 2) mk_phase(Params p) {
  __shared__ __attribute__((aligned(16))) unsigned char lds[LDS_BYTES];
  run_phase<KIND>(p, p.ph_lo, lds);
}
#endif

extern "C" void kernel_launch(void* const* d_in, const int* in_sizes, int n_in, void* d_out, int out_size, void* d_ws,
                              size_t ws_size, hipStream_t stream) {
  static int grid = 0;
  if (grid == 0) {
    if (n_in != 21 || ws_size < WS_END || out_size != TL * DM) { fprintf(stderr, "kernel_launch: unexpected shapes (n_in %d ws %zu out %d)\n", n_in, ws_size, out_size); grid = -1; return; }
    int dev = 0, cus = 0, per_cu = 2;
    (void)hipGetDevice(&dev);
    (void)hipDeviceGetAttribute(&cus, hipDeviceAttributeMultiprocessorCount, dev);
#if N_LAUNCH_MODE == 1
    (void)hipOccupancyMaxActiveBlocksPerMultiprocessor(&per_cu, (const void*)mk_fwd, 256, 0);
    if (per_cu < 1) per_cu = 1;
    if (per_cu > 2) per_cu = 2;
#endif
    grid = cus * per_cu;
  }
  if (grid < 0) return;
  (void)hipMemsetAsync((char*)d_ws + OFF_CTL, 0, 65536, stream);
  Params p{};
  const float** pp = (const float**)&p;
  for (int i = 0; i < 21; ++i) pp[i] = (const float*)d_in[i];
  p.out = (float*)d_out;
  p.ws = (unsigned char*)d_ws;
#if N_LAUNCH_MODE == 1
  p.ph_lo = 0; p.ph_hi = N_PHASES;
  void* args[] = {&p};
  hipError_t e = hipLaunchCooperativeKernel((const void*)mk_fwd, dim3(grid), dim3(256), args, 0, stream);
  if (e != hipSuccess) fprintf(stderr, "cooperative launch failed: %s (grid %d)\n", hipGetErrorString(e), grid);
#else
  for (int ph = 0; ph < N_PHASES; ++ph) {
    p.ph_lo = ph; p.ph_hi = ph + 1;
    const int kind = ph == 0 ? 0 : (ph == N_PHASES - 1 ? 11 : 1 + (ph - 1) % PH_PER_LAYER);
    switch (kind) {
      case 0: hipLaunchKernelGGL(mk_phase<0>, dim3(grid), dim3(256), 0, stream, p); break;
      case 1: hipLaunchKernelGGL(mk_phase<1>, dim3(grid), dim3(256), 0, stream, p); break;
      case 2: hipLaunchKernelGGL(mk_phase<2>, dim3(grid), dim3(256), 0, stream, p); break;
      case 3: hipLaunchKernelGGL(mk_phase<3>, dim3(grid), dim3(256), 0, stream, p); break;
      case 4: hipLaunchKernelGGL(mk_phase<4>, dim3(grid), dim3(256), 0, stream, p); break;
      case 5: hipLaunchKernelGGL(mk_phase<5>, dim3(grid), dim3(256), 0, stream, p); break;
      case 6: hipLaunchKernelGGL(mk_phase<6>, dim3(grid), dim3(256), 0, stream, p); break;
      case 7: hipLaunchKernelGGL(mk_phase<7>, dim3(grid), dim3(256), 0, stream, p); break;
      case 8: hipLaunchKernelGGL(mk_phase<8>, dim3(grid), dim3(256), 0, stream, p); break;
      case 9: hipLaunchKernelGGL(mk_phase<9>, dim3(grid), dim3(256), 0, stream, p); break;
      case 10: hipLaunchKernelGGL(mk_phase<10>, dim3(grid), dim3(256), 0, stream, p); break;
      default: hipLaunchKernelGGL(mk_phase<11>, dim3(grid), dim3(256), 0, stream, p); break;
    }
  }
#endif
}
```

```cpp
#include <hip/hip_runtime.h>
#include <hip/hip_cooperative_groups.h>
#include <stdint.h>
#include <stdio.h>
namespace cg = cooperative_groups;

#ifndef N_LAUNCH_MODE
#define N_LAUNCH_MODE 1
#endif

#define DI __device__ __forceinline__
#ifndef GEMM_VAR
#define GEMM_VAR 0
#endif
typedef unsigned short bf16_t;
typedef short bf16x8 __attribute__((ext_vector_type(8)));
typedef float f32x4 __attribute__((ext_vector_type(4)));
typedef float f32x2 __attribute__((ext_vector_type(2)));
typedef float f32x16 __attribute__((ext_vector_type(16)));
typedef float f32x32 __attribute__((ext_vector_type(32)));
typedef unsigned u32x6 __attribute__((ext_vector_type(6)));
typedef int i32x8 __attribute__((ext_vector_type(8)));
typedef unsigned u32x4 __attribute__((ext_vector_type(4)));
typedef unsigned u32x2 __attribute__((ext_vector_type(2)));

constexpr int NB = 16, SEQ = 2048, DM = 1024, NL = 4, CTXL = 256;
constexpr int TL = NB * SEQ;
constexpr int TC = NB * CTXL;
constexpr int TT = TL + TC;
constexpr int PN_LD = 2176;
constexpr int C_GQ = 0, C_GK = 128, C_GR = 256, C_NQ = 512, C_NK = 768, C_DQ = 1024, C_DK = 1536, C_GATE = 2048;
constexpr int R_GV = 0, R_NV = 256, R_DV = 512;
constexpr float LOG2E = 1.4426950408889634f;
constexpr float SC_LOG2 = 0.125f * LOG2E;
constexpr float NEG_BIG = -1e30f;

constexpr size_t MiB = 1u << 20;
constexpr size_t OFF_CTL = 0;
constexpr size_t OFF_MOD = 1 * MiB;
constexpr size_t OFF_WIN = 3 * MiB;
constexpr size_t OFF_WOUT = 28 * MiB;
constexpr size_t OFF_WQ = 36 * MiB;
constexpr size_t OFF_SK = 44 * MiB;
constexpr size_t OFF_USCL = 44 * MiB + 256 * 1024;
constexpr size_t OFF_VSCL = 44 * MiB + 512 * 1024;
constexpr size_t OFF_U = 45 * MiB;
constexpr size_t OFF_V = 109 * MiB;
constexpr int V6_PITCH = 800;
#ifndef U_FP4
#define U_FP4 1
#endif
#ifndef V_FP4
#define V_FP4 1
#endif
constexpr int P4_PITCH = 544;
constexpr int U_PITCH = U_FP4 ? P4_PITCH : V6_PITCH, V_PITCH = V_FP4 ? P4_PITCH : V6_PITCH;
constexpr size_t OFF_XRES = 301 * MiB;
constexpr size_t OFF_H = 445 * MiB;
constexpr size_t OFF_P = 517 * MiB;
constexpr size_t OFF_VT = OFF_P + 153 * MiB;
constexpr size_t OFF_QP = OFF_P;
constexpr size_t OFF_EID = OFF_P + 72 * MiB;
constexpr size_t OFF_GATE = OFF_P + 90 * MiB;
constexpr size_t OFF_H8 = OFF_P + 126 * MiB;
constexpr size_t OFF_HINV = OFF_P + 162 * MiB;
constexpr size_t OFF_Y = 742 * MiB;
constexpr size_t WS_END = 814 * MiB;

constexpr int LDS_BYTES = 65536 + 8192;

struct Params {
  const float *x, *c, *ctx, *c_ctx, *ada_w, *ada_b, *norm1_g, *norm2_g, *w_in, *gate_up, *gate_b, *gla_norm_g,
      *rpb, *dlam, *diff_g, *w_out, *wq, *subkeys, *pu, *pv, *final_g;
  float* out;
  unsigned char* ws;
  int ph_lo, ph_hi;
};

DI int ltid() { int t = threadIdx.x; asm volatile("" : "+v"(t)); return t; }
DI int lbid() { int t = blockIdx.x; asm volatile("" : "+s"(t)); return t; }
DI int lgdim() { int t = gridDim.x; asm volatile("" : "+s"(t)); return t; }

DI unsigned f2bf(float f) { unsigned u = __float_as_uint(f); return (u + 0x7fffu + ((u >> 16) & 1u)) >> 16; }
typedef __bf16 bf16x2_t __attribute__((ext_vector_type(2)));
DI unsigned pk2(float lo, float hi) { f32x2 v = {lo, hi}; return __builtin_bit_cast(unsigned, __builtin_convertvector(v, bf16x2_t)); }
DI float bflo(unsigned u) { return __uint_as_float(u << 16); }
DI float bfhi(unsigned u) { return __uint_as_float(u & 0xffff0000u); }
DI void unpack8(const u32x4 v, float* f) {
  f[0] = bflo(v.x); f[1] = bfhi(v.x); f[2] = bflo(v.y); f[3] = bfhi(v.y);
  f[4] = bflo(v.z); f[5] = bfhi(v.z); f[6] = bflo(v.w); f[7] = bfhi(v.w);
}
DI float wave_sum(float v) {
#pragma unroll
  for (int o = 32; o >= 1; o >>= 1) v += __shfl_xor(v, o);
  return v;
}

DI float rows_max(float x) {
  unsigned u = __float_as_uint(x);
  u32x2 a = __builtin_amdgcn_permlane32_swap(u, u, false, false);
  const float m = fmaxf(__uint_as_float(a[0]), __uint_as_float(a[1]));
  unsigned v = __float_as_uint(m);
  u32x2 b = __builtin_amdgcn_permlane16_swap(v, v, false, false);
  return fmaxf(__uint_as_float(b[0]), __uint_as_float(b[1]));
}
DI float rows_sum(float x) {
  unsigned u = __float_as_uint(x);
  u32x2 a = __builtin_amdgcn_permlane32_swap(u, u, false, false);
  const float m = __uint_as_float(a[0]) + __uint_as_float(a[1]);
  unsigned v = __float_as_uint(m);
  u32x2 b = __builtin_amdgcn_permlane16_swap(v, v, false, false);
  return __uint_as_float(b[0]) + __uint_as_float(b[1]);
}

DI u32x6 mxfp6_pack32(float (&x)[32], unsigned& sbyte) {
  float am = 0.f;
#pragma unroll
  for (int i = 0; i < 32; ++i) am = fmaxf(am, fabsf(x[i]));
  int e = am > 0.f ? (int)ceilf(log2f(am) - 2.906890596f) : -126;
  e = e < -126 ? -126 : (e > 127 ? 127 : e);
  const float sc = __uint_as_float((unsigned)(127 - e) << 23);
  f32x16 lo, hi;
#pragma unroll
  for (int i = 0; i < 16; ++i) { lo[i] = x[2 * i] * sc; hi[i] = x[2 * i + 1] * sc; }
  sbyte = (unsigned)(127 + e);
  return __builtin_amdgcn_cvt_scalef32_2xpk16_fp6_f32(lo, hi, 1.0f);
}

DI u32x4 mxfp4_pack32(float (&x)[32], unsigned& sbyte) {
  float am = 0.f;
#pragma unroll
  for (int i = 0; i < 32; ++i) am = fmaxf(am, fabsf(x[i]));
  int e = am > 0.f ? (int)ceilf(log2f(am) - 2.584962501f) : -126;
  e = e < -126 ? -126 : (e > 127 ? 127 : e);
  const float sc = __uint_as_float((unsigned)(127 - e) << 23);
  sbyte = (unsigned)(127 + e);
  u32x4 q;
#pragma unroll
  for (int d = 0; d < 4; ++d) {
    unsigned v = 0;
    v = __builtin_amdgcn_cvt_scalef32_pk_fp4_f32(v, x[8 * d + 0] * sc, x[8 * d + 1] * sc, 1.0f, 0);
    v = __builtin_amdgcn_cvt_scalef32_pk_fp4_f32(v, x[8 * d + 2] * sc, x[8 * d + 3] * sc, 1.0f, 1);
    v = __builtin_amdgcn_cvt_scalef32_pk_fp4_f32(v, x[8 * d + 4] * sc, x[8 * d + 5] * sc, 1.0f, 2);
    v = __builtin_amdgcn_cvt_scalef32_pk_fp4_f32(v, x[8 * d + 6] * sc, x[8 * d + 7] * sc, 1.0f, 3);
    q[d] = v;
  }
  return q;
}
DI int mx4_scale_pos(int blk) { return 512 + (blk & 3) * 8 + (blk >> 2); }
DI int mx_scale_pos(int blk) { return 768 + (blk & 3) * 8 + (blk >> 2); }
DI f32x4 mfma16(bf16x8 a, bf16x8 b, f32x4 c) { return __builtin_amdgcn_mfma_f32_16x16x32_bf16(a, b, c, 0, 0, 0); }

DI int win_src_col(int r) {
  if (r < 256) return r;
  if (r < 512) return r - 256 + 512;
  if (r < 768) return r - 512 + 800;
  if (r < 1024) return r - 768 + 1056;
  if (r < 1536) return r - 1024 + 1568;
  if (r < 2048) return r - 1536 + 2080;
  if (r < 2080) return r - 2048 + 768;
  if (r < 2176) return -1;
  if (r < 2432) return r - 2176 + 256;
  if (r < 2688) return r - 2432 + 1312;
  return r - 2688 + 2592;
}

DI void transpose_item(const float* __restrict__ W, int N, int src, bf16_t* __restrict__ dst, float* lds) {
  const int tid = ltid();
  for (int kc = 0; kc < 8; ++kc) {
    __syncthreads();
#pragma unroll
    for (int i = 0; i < 16; ++i) {
      int k = i * 8 + (tid >> 5), n = tid & 31;
      lds[k * 33 + n] = (src < 0) ? 0.f : W[(size_t)(kc * 128 + k) * N + src + n];
    }
    __syncthreads();
    int row = tid >> 3, k0 = (tid & 7) * 16;
    unsigned o[8];
#pragma unroll
    for (int e = 0; e < 8; ++e) o[e] = pk2(lds[(k0 + 2 * e) * 33 + row], lds[(k0 + 2 * e + 1) * 33 + row]);
    u32x4 a = {o[0], o[1], o[2], o[3]}, b = {o[4], o[5], o[6], o[7]};
    bf16_t* d = dst + (size_t)row * 1024 + kc * 128 + k0;
    *(u32x4*)d = a; *(u32x4*)(d + 8) = b;
  }
}

DI void convert_table_pairs(const Params& p, int pr0, int pr1, int wave, int nwave, int lane) {
  for (int pr = pr0 + wave; pr < pr1; pr += nwave) {
    const int tab = pr >= NL * 16384 / 2, pq = tab ? pr - NL * 16384 / 2 : pr;
    const int r = 2 * pq + (lane >> 5), blk = lane & 31;
    const float* src = (tab ? p.pv : p.pu) + (size_t)r * 1024 + 32 * blk;
    float x[32];
#pragma unroll
    for (int i = 0; i < 8; ++i) { const float4 a = *(const float4*)(src + 4 * i); x[4 * i] = a.x; x[4 * i + 1] = a.y; x[4 * i + 2] = a.z; x[4 * i + 3] = a.w; }
    unsigned sb;
    if (tab ? V_FP4 : U_FP4) {
      const u32x4 q = mxfp4_pack32(x, sb);
      unsigned char* row = p.ws + (tab ? OFF_V : OFF_U) + (size_t)r * P4_PITCH;
      *(u32x4*)(row + 16 * blk) = q;
      row[mx4_scale_pos(blk)] = (unsigned char)sb;
    } else {
      const u32x6 q = mxfp6_pack32(x, sb);
      unsigned char* row = p.ws + (tab ? OFF_V : OFF_U) + (size_t)r * V6_PITCH;
      *(u32x2*)(row + 24 * blk) = (u32x2){q[0], q[1]};
      *(u32x2*)(row + 24 * blk + 8) = (u32x2){q[2], q[3]};
      *(u32x2*)(row + 24 * blk + 16) = (u32x2){q[4], q[5]};
      row[mx_scale_pos(blk)] = (unsigned char)sb;
    }
  }
}

DI void phase_prologue(const Params& p, unsigned char* lds) {
  const int tid = ltid(), nb = lgdim(), bid = lbid();
  bf16_t* winT = (bf16_t*)(p.ws + OFF_WIN);
  bf16_t* woutT = (bf16_t*)(p.ws + OFF_WOUT);
  bf16_t* wqT = (bf16_t*)(p.ws + OFF_WQ);
  constexpr int PER_LAYER = 100 + 32 + 32;
  for (int item = bid; item < NL * PER_LAYER; item += nb) {
    int l = item / PER_LAYER, r = item % PER_LAYER;
    if (r < 100) {
      int row = r * 32;
      transpose_item(p.w_in + (size_t)l * 1024 * 3104, 3104, win_src_col(row), winT + ((size_t)l * 3200 + row) * 1024, (float*)lds);
    } else if (r < 132) {
      int row = (r - 100) * 32;
      transpose_item(p.w_out + (size_t)l * 1024 * 1024, 1024, row, woutT + ((size_t)l * 1024 + row) * 1024, (float*)lds);
    } else {
      int row = (r - 132) * 32;
      transpose_item(p.wq + (size_t)l * 1024 * 1024, 1024, row, wqT + ((size_t)l * 1024 + row) * 1024, (float*)lds);
    }
  }
  {
    bf16_t* sk = (bf16_t*)(p.ws + OFF_SK);
    for (int i = bid * 256 + tid; i < NL * 2 * 128 * 64; i += nb * 256) sk[i] = (bf16_t)f2bf(p.subkeys[i]);
  }
  {
    float* modbuf = (float*)(p.ws + OFF_MOD);
    float* sc = (float*)lds;
    float* red = (float*)(lds + 17 * 512 * 4);
    for (int item = bid; item < NL * 96; item += nb) {
      const int l = item / 96, cb = item % 96, col = cb * 64 + (tid & 63), kq = tid >> 6;
      float acc[17];
#pragma unroll
      for (int r = 0; r < 17; ++r) acc[r] = 0.f;
      for (int half = 0; half < 2; ++half) {
        __syncthreads();
        for (int e = tid; e < 17 * 512; e += 256) {
          int r = e >> 9, k = e & 511;
          float cv = (r < 16) ? p.c[r * 1024 + half * 512 + k] : p.c_ctx[half * 512 + k];
          sc[e] = cv / (1.f + __expf(-cv));
        }
        __syncthreads();
        const float* wp = p.ada_w + ((size_t)l * 1024 + half * 512 + kq * 128) * 6144 + col;
        for (int kk = 0; kk < 128; ++kk) {
          const float w = wp[(size_t)kk * 6144];
#pragma unroll
          for (int r = 0; r < 17; ++r) acc[r] += sc[r * 512 + kq * 128 + kk] * w;
        }
      }
#pragma unroll
      for (int r = 0; r < 17; ++r) red[(kq * 17 + r) * 64 + (tid & 63)] = acc[r];
      __syncthreads();
      for (int e = tid; e < 17 * 64; e += 256) {
        int r = e >> 6, cc = e & 63;
        float s = red[(0 * 17 + r) * 64 + cc] + red[(1 * 17 + r) * 64 + cc] + red[(2 * 17 + r) * 64 + cc] + red[(3 * 17 + r) * 64 + cc];
        int colg = cb * 64 + cc;
        modbuf[((size_t)l * 17 + r) * 6144 + colg] = s + p.ada_b[l * 6144 + colg];
      }
      __syncthreads();
    }
  }
}

DI void phase_norm(const Params& p, int l, int which, int ntok) {
  const int lane = ltid() & 63, gw = lbid() * 4 + (ltid() >> 6), nw = lgdim() * 4;
  const float* gvec = (which == 0 ? p.norm1_g : p.norm2_g) + l * 1024;
  const int ish = which == 0 ? 0 : 3, isc = which == 0 ? 1 : 4;
  const float* xres = (const float*)(p.ws + OFF_XRES);
  const float* modbuf = (const float*)(p.ws + OFF_MOD);
  bf16_t* hbuf = (bf16_t*)(p.ws + OFF_H);
  for (int t = gw; t < ntok; t += nw) {
    const float* src = (which == 0 && l == 0) ? (t < TL ? p.x + (size_t)t * 1024 : p.ctx + (size_t)(t - TL) * 1024) : xres + (size_t)t * 1024;
    const int b = t < TL ? (t >> 11) : 16;
    const float* md = modbuf + ((size_t)l * 17 + b) * 6144;
    float4 v[4];
    float ss = 0.f;
#pragma unroll
    for (int i = 0; i < 4; ++i) {
      v[i] = *(const float4*)(src + 4 * lane + 256 * i);
      ss += v[i].x * v[i].x + v[i].y * v[i].y + v[i].z * v[i].z + v[i].w * v[i].w;
    }
    ss = wave_sum(ss);
    const float rstd = rsqrtf(ss * (1.f / 1024.f) + 1e-6f);
    float am = 0.f;
#pragma unroll
    for (int i = 0; i < 4; ++i) {
      const int col = 4 * lane + 256 * i;
      const float4 g4 = *(const float4*)(gvec + col), sh = *(const float4*)(md + ish * 1024 + col), sc = *(const float4*)(md + isc * 1024 + col);
      float o0 = v[i].x * rstd * g4.x * (1.f + sc.x) + sh.x;
      float o1 = v[i].y * rstd * g4.y * (1.f + sc.y) + sh.y;
      float o2 = v[i].z * rstd * g4.z * (1.f + sc.z) + sh.z;
      float o3 = v[i].w * rstd * g4.w * (1.f + sc.w) + sh.w;
      u32x2 o = {pk2(o0, o1), pk2(o2, o3)};
      *(u32x2*)(hbuf + (size_t)t * 1024 + col) = o;
      v[i].x = o0; v[i].y = o1; v[i].z = o2; v[i].w = o3;
      am = fmaxf(am, fmaxf(fmaxf(fabsf(o0), fabsf(o1)), fmaxf(fabsf(o2), fabsf(o3))));
    }
  }
}

DI void phase_norm2(const Params& p, int l, int ntok) {
  const int lane = ltid() & 63, gw = lbid() * 4 + (ltid() >> 6), nw = lgdim() * 4;
  const int half = lane >> 5, blk = lane & 31;
  const float* gvec = p.norm2_g + l * 1024 + 32 * blk;
  const float* xres = (const float*)(p.ws + OFF_XRES);
  const float* modbuf = (const float*)(p.ws + OFF_MOD);
  bf16_t* hbuf = (bf16_t*)(p.ws + OFF_H);
  unsigned char* h6 = p.ws + OFF_H8;
  for (int pr = gw; pr < ntok / 2; pr += nw) {
    const int t = 2 * pr + half;
    const float* src = xres + (size_t)t * 1024 + 32 * blk;
    const int b = t < TL ? (t >> 11) : 16;
    const float* md = modbuf + ((size_t)l * 17 + b) * 6144 + 32 * blk;
    float x[32];
    float ss = 0.f;
#pragma unroll
    for (int i = 0; i < 8; ++i) {
      const float4 a = *(const float4*)(src + 4 * i);
      x[4 * i] = a.x; x[4 * i + 1] = a.y; x[4 * i + 2] = a.z; x[4 * i + 3] = a.w;
      ss += a.x * a.x + a.y * a.y + a.z * a.z + a.w * a.w;
    }
#pragma unroll
    for (int o = 16; o >= 1; o >>= 1) ss += __shfl_xor(ss, o);
    const float rstd = rsqrtf(ss * (1.f / 1024.f) + 1e-6f);
    unsigned pk[16];
#pragma unroll
    for (int i = 0; i < 8; ++i) {
      const float4 g4 = *(const float4*)(gvec + 4 * i), sh = *(const float4*)(md + 3 * 1024 + 4 * i), sc = *(const float4*)(md + 4 * 1024 + 4 * i);
      x[4 * i] = x[4 * i] * rstd * g4.x * (1.f + sc.x) + sh.x;
      x[4 * i + 1] = x[4 * i + 1] * rstd * g4.y * (1.f + sc.y) + sh.y;
      x[4 * i + 2] = x[4 * i + 2] * rstd * g4.z * (1.f + sc.z) + sh.z;
      x[4 * i + 3] = x[4 * i + 3] * rstd * g4.w * (1.f + sc.w) + sh.w;
      pk[2 * i] = pk2(x[4 * i], x[4 * i + 1]); pk[2 * i + 1] = pk2(x[4 * i + 2], x[4 * i + 3]);
    }
    bf16_t* hrow = hbuf + (size_t)t * 1024 + 32 * blk;
#pragma unroll
    for (int i = 0; i < 4; ++i) *(u32x4*)(hrow + 8 * i) = (u32x4){pk[4 * i], pk[4 * i + 1], pk[4 * i + 2], pk[4 * i + 3]};
    unsigned sb;
    const u32x6 q = mxfp6_pack32(x, sb);
    unsigned char* row = h6 + (size_t)t * V6_PITCH;
    *(u32x2*)(row + 24 * blk) = (u32x2){q[0], q[1]};
    *(u32x2*)(row + 24 * blk + 8) = (u32x2){q[2], q[3]};
    *(u32x2*)(row + 24 * blk + 16) = (u32x2){q[4], q[5]};
    row[mx_scale_pos(blk)] = (unsigned char)sb;
  }
}

template <int EPI>
DI void gemm_tile(const bf16_t* __restrict__ P, const bf16_t* __restrict__ Q, int it, int jt, void* outp, int ld,
                  const float* xin_lat, const float* xin_ctx, const float* modl, unsigned char* lds, bool gvar = false) {
  const int tid = ltid(), lane = tid & 63, w = tid >> 6, wi = w >> 1, wj = w & 1, lr = lane & 15, g = lane >> 4;
  const int wu = __builtin_amdgcn_readfirstlane(w);
  f32x4 acc[4][4];
#pragma unroll
  for (int a = 0; a < 4; ++a)
#pragma unroll
    for (int b = 0; b < 4; ++b) acc[a][b] = (f32x4){0.f, 0.f, 0.f, 0.f};
  const unsigned lo0 = (unsigned)((lane >> 3) * 1024 + (((lane & 7) ^ (lane >> 4)) << 3));
  const unsigned lo1 = (unsigned)((lane >> 3) * 1024 + (((lane & 7) ^ (4 + (lane >> 4))) << 3));
  const bf16_t* pg = P + (size_t)(it * 128 + 32 * wu) * 1024;
  const bf16_t* qg = Q + (size_t)(jt * 128 + 32 * wu) * 1024;
#define GT_DMA(kb, bf) do { _Pragma("unroll") for (int jj = 0; jj < 4; ++jj) { const unsigned lo_ = (jj & 1) ? lo1 : lo0; \
      __builtin_amdgcn_global_load_lds((const unsigned*)(pg + (size_t)jj * 8192 + (kb) * 64 + lo_), (unsigned*)(lds + (bf) * 32768 + (4 * wu + jj) * 1024), 16, 0, 0); \
      __builtin_amdgcn_global_load_lds((const unsigned*)(qg + (size_t)jj * 8192 + (kb) * 64 + lo_), (unsigned*)(lds + (bf) * 32768 + 16384 + (4 * wu + jj) * 1024), 16, 0, 0); } } while (0)
  __syncthreads();
  GT_DMA(0, 0);
  asm volatile("s_waitcnt vmcnt(0)" ::: "memory");
  __syncthreads();
  for (int kb = 0; kb < 16; ++kb) {
    if (kb < 15 && !(GEMM_VAR == 1 && gvar)) GT_DMA(kb + 1, (kb + 1) & 1);
    const unsigned char* Ps = lds + (kb & 1) * 32768;
    const unsigned char* Qs = Ps + 16384;
    bf16x8 pf[2][4], qf[2][4];
#pragma unroll
    for (int ks = 0; ks < 2; ++ks) {
      const int ch = ks * 4 + g;
#pragma unroll
      for (int mi = 0; mi < 4; ++mi) { const int row = wi * 64 + mi * 16 + lr; pf[ks][mi] = *(const bf16x8*)(Ps + (row >> 1) * 256 + (((((row & 1) << 3) | ch) ^ ((row >> 1) & 7)) << 4)); }
#pragma unroll
      for (int nj = 0; nj < 4; ++nj) { const int row = wj * 64 + nj * 16 + lr; qf[ks][nj] = *(const bf16x8*)(Qs + (row >> 1) * 256 + (((((row & 1) << 3) | ch) ^ ((row >> 1) & 7)) << 4)); }
    }
    __builtin_amdgcn_sched_barrier(0);
    __builtin_amdgcn_s_setprio(1);
#pragma unroll
    for (int ks = 0; ks < 2; ++ks)
#pragma unroll
      for (int mi = 0; mi < 4; ++mi)
#pragma unroll
        for (int nj = 0; nj < 4; ++nj) { if (GEMM_VAR == 2 && gvar) { asm volatile("" :: "v"(pf[ks][mi]), "v"(qf[ks][nj])); } else acc[mi][nj] = mfma16(pf[ks][mi], qf[ks][nj], acc[mi][nj]); }
    __builtin_amdgcn_s_setprio(0);
    __builtin_amdgcn_sched_barrier(0);
    asm volatile("s_waitcnt vmcnt(0)" ::: "memory");
    __syncthreads();
  }
#undef GT_DMA
  if (EPI == 2) {
    float inv[4];
#pragma unroll
    for (int r = 0; r < 4; ++r) inv[r] = __builtin_amdgcn_exp2f(-(float)(4 * g + r) * (13.287712379549449f / 16.f));
#pragma unroll
    for (int nj = 0; nj < 4; ++nj) {
      const int j = jt * 128 + wj * 64 + nj * 16 + lr;
      if (j < TL) {
        const float prow = (float)((j & 2047) >> 6), pcol = (float)(j & 63);
#pragma unroll
        for (int r = 0; r < 4; ++r) {
          const float a1 = prow * inv[r], a2 = pcol * inv[r];
          const float c1 = __cosf(a1), s1 = __sinf(a1), c2 = __cosf(a2), s2 = __sinf(a2);
          const float x1 = acc[0][nj][r], x2 = acc[1][nj][r], y1 = acc[2][nj][r], y2 = acc[3][nj][r];
          acc[0][nj][r] = x1 * c1 - x2 * s1; acc[1][nj][r] = x2 * c1 + x1 * s1;
          acc[2][nj][r] = y1 * c2 - y2 * s2; acc[3][nj][r] = y2 * c2 + y1 * s2;
        }
      }
    }
  }
#pragma unroll
  for (int mi = 0; mi < 4; ++mi)
#pragma unroll
    for (int nj = 0; nj < 4; ++nj) {
      const int j = jt * 128 + wj * 64 + nj * 16 + lr;
      const int i = it * 128 + wi * 64 + mi * 16 + 4 * g;
      const f32x4 a = acc[mi][nj];
      if (EPI == 0 || EPI == 2) {
        u32x2 o = {pk2(a[0], a[1]), pk2(a[2], a[3])};
        *(u32x2*)((bf16_t*)outp + (size_t)j * ld + i) = o;
      } else {
        const int b = j < TL ? (j >> 11) : 16;
        const float4 gt = *(const float4*)(modl + (size_t)b * 6144 + 2 * 1024 + i);
        const float* xs = (j < TL) ? xin_lat + (size_t)j * 1024 + i : xin_ctx + (size_t)(j - TL) * 1024 + i;
        const float4 xv = *(const float4*)xs;
        float4 o = {xv.x + gt.x * a[0], xv.y + gt.y * a[1], xv.z + gt.z * a[2], xv.w + gt.w * a[3]};
        *(float4*)((float*)outp + (size_t)j * 1024 + i) = o;
      }
    }
}

struct TileIter {
  int u, step, total, nf, tpx, x;
  DI void init(int n_tok_tiles, int n_feat_tiles) {
    const int bid = lbid(), nb = lgdim();
    nf = n_feat_tiles;
    if ((nb & 7) == 0 && (n_tok_tiles & 7) == 0) { x = bid & 7; u = bid >> 3; step = nb >> 3; tpx = n_tok_tiles >> 3; }
    else { x = 0; u = bid; step = nb; tpx = n_tok_tiles; }
    total = tpx * nf;
  }
  DI bool valid() const { return u < total; }
  DI void next() { u += step; }
  DI void get(int& tok_tile, int& feat_tile) const {
    const int g = u / (8 * nf), rem = u - g * 8 * nf;
    const int gs = (tpx - 8 * g) < 8 ? (tpx - 8 * g) : 8;
    const int f = rem / gs, tt = rem - f * gs;
    tok_tile = x * tpx + 8 * g + tt; feat_tile = f;
  }
};

DI void phase_gemm_in(const Params& p, int l, unsigned char* lds, bool gvar = false) {
  const bf16_t* W = (const bf16_t*)(p.ws + OFF_WIN) + (size_t)l * 3200 * 1024;
  const bf16_t* H = (const bf16_t*)(p.ws + OFF_H);
  bf16_t* PN = (bf16_t*)(p.ws + OFF_P);
  bf16_t* VT = (bf16_t*)(p.ws + OFF_VT);
  TileIter ti; ti.init(TT / 128, 25);
  for (; ti.valid(); ti.next()) {
    int jt, f; ti.get(jt, f);
    if (f >= 8 && f < 16) gemm_tile<2>(W, H, f, jt, PN, PN_LD, nullptr, nullptr, nullptr, lds, gvar);
    else if (f < 17) gemm_tile<0>(W, H, f, jt, PN, PN_LD, nullptr, nullptr, nullptr, lds, gvar);
    else gemm_tile<0>(H, W + (size_t)2176 * 1024, jt, f - 17, VT, TT, nullptr, nullptr, nullptr, lds, gvar);
  }
}
DI void phase_gemm_out(const Params& p, int l, int ntok, unsigned char* lds) {
  const bf16_t* W = (const bf16_t*)(p.ws + OFF_WOUT) + (size_t)l * 1024 * 1024;
  const bf16_t* Y = (const bf16_t*)(p.ws + OFF_Y);
  float* xres = (float*)(p.ws + OFF_XRES);
  const float* modl = (const float*)(p.ws + OFF_MOD) + (size_t)l * 17 * 6144;
  const float* xl = (l == 0) ? p.x : xres;
  const float* xc = (l == 0) ? p.ctx : xres + (size_t)TL * 1024;
  TileIter ti; ti.init(ntok / 128, 8);
  for (; ti.valid(); ti.next()) {
    int jt, f; ti.get(jt, f);
    gemm_tile<1>(W, Y, f, jt, xres, 1024, xl, xc, modl, lds);
  }
}
DI void phase_gemm_q(const Params& p, int l, int ntok, unsigned char* lds) {
  const bf16_t* W = (const bf16_t*)(p.ws + OFF_WQ) + (size_t)l * 1024 * 1024;
  const bf16_t* H = (const bf16_t*)(p.ws + OFF_H);
  bf16_t* QP = (bf16_t*)(p.ws + OFF_QP);
  TileIter ti; ti.init(ntok / 128, 8);
  for (; ti.valid(); ti.next()) {
    int jt, f; ti.get(jt, f);
    gemm_tile<0>(W, H, f, jt, QP, 1024, nullptr, nullptr, nullptr, lds);
  }
}

DI void phase_rope(const Params& p, unsigned char* lds) {
  float2* tab = (float2*)lds;
  for (int e = ltid(); e < 1024; e += 256) {
    const int pos = e >> 4, i = e & 15;
    const float inv = exp2f(-(float)i * (13.287712379549449f / 16.f));
    const float ang = (float)pos * inv;
    tab[e] = make_float2(__cosf(ang), __sinf(ang));
  }
  __syncthreads();
  bf16_t* PN = (bf16_t*)(p.ws + OFF_P);
  const int total = TL * 16;
  for (int idx = lbid() * 256 + ltid(); idx < total; idx += lgdim() * 256) {
    const int t = idx >> 4, vec = idx & 15;
    const int col = ((vec >> 3) ? C_DK : C_DQ) + ((vec >> 1) & 3) * 128 + (vec & 1) * 64;
    bf16_t* ptr = PN + (size_t)t * PN_LD + col;
    float xv[64];
#pragma unroll
    for (int q = 0; q < 8; ++q) { const u32x4 v = *(const u32x4*)(ptr + q * 8); unpack8(v, xv + q * 8); }
    const int row = (t & 2047) >> 6, cp = t & 63;
#pragma unroll
    for (int i = 0; i < 16; ++i) {
      const float2 cs = tab[row * 16 + i];
      const float x1 = xv[i], x2 = xv[16 + i];
      xv[i] = x1 * cs.x - x2 * cs.y; xv[16 + i] = x2 * cs.x + x1 * cs.y;
      const float2 cs2 = tab[cp * 16 + i];
      const float y1 = xv[32 + i], y2 = xv[48 + i];
      xv[32 + i] = y1 * cs2.x - y2 * cs2.y; xv[48 + i] = y2 * cs2.x + y1 * cs2.y;
    }
#pragma unroll
    for (int q = 0; q < 8; ++q) {
      u32x4 o = {pk2(xv[q * 8], xv[q * 8 + 1]), pk2(xv[q * 8 + 2], xv[q * 8 + 3]), pk2(xv[q * 8 + 4], xv[q * 8 + 5]), pk2(xv[q * 8 + 6], xv[q * 8 + 7])};
      *(u32x4*)(ptr + q * 8) = o;
    }
  }
}

struct SrcSeg {
  const bf16_t* PN; const bf16_t* VT; int kcol, vrow, t0, n0, t1, n1, lr, g;
  DI int nsteps() const { return n0 + n1; }
  DI int tok0(int st) const { return st < n0 ? t0 + st * 32 : t1 + (st - n0) * 32; }
  DI float score(float raw, int st, int kt, int r) const { return raw * SC_LOG2; }
};
struct SrcNat {
  const bf16_t* PN; const bf16_t* VT; int kcol, vrow, b, rq, rs, cs, qc, cstart, lr, g;
  const float* rpbh;
  DI int nsteps() const { return 16; }
  DI int tok0(int st) const { return st < 8 ? b * 2048 + (rs + st) * 64 + cs : TL + b * 256 + (st - 8) * 32; }
  DI float score(float raw, int st, int kt, int r) const {
    if (st >= 8) return raw * SC_LOG2;
    const int kc = cs + 8 * g + 4 * kt + r;
    const bool valid = (kc >= cstart) && (kc < cstart + 16);
    int dc = kc - qc + 15; dc = dc < 0 ? 0 : (dc > 30 ? 30 : dc);
    const float bias = rpbh[(rs + st - rq + 7) * 31 + dc];
    return valid ? (raw * 0.125f + bias) * LOG2E : NEG_BIG;
  }
};

template <class Src>
struct FlashFrags { bf16x8 k[2][2]; bf16x8 v[4]; };
template <class Src>
DI void flash_load(const Src& S, int st, FlashFrags<Src>& F) {
  const int tk = S.tok0(st);
  const int kap = 8 * (S.lr >> 2) + (S.lr & 3);
  const bf16_t* k0p = S.PN + (size_t)(tk + kap) * PN_LD + S.kcol + 8 * S.g;
  const bf16_t* vp = S.VT + (size_t)(S.vrow + S.lr) * TT + tk + 8 * S.g;
#pragma unroll
  for (int kt = 0; kt < 2; ++kt)
#pragma unroll
    for (int ks = 0; ks < 2; ++ks) F.k[kt][ks] = *(const bf16x8*)(k0p + (size_t)kt * 4 * PN_LD + ks * 32);
#pragma unroll
  for (int dt = 0; dt < 4; ++dt) F.v[dt] = *(const bf16x8*)(vp + (size_t)dt * 16 * TT);
}
template <class Src>
DI void flash_step(const Src& S, int st, const FlashFrags<Src>& F, const bf16x8 (&qf)[2], f32x4 (&o)[4], float& mrun, float& lrun) {
  f32x4 s[2];
#pragma unroll
  for (int kt = 0; kt < 2; ++kt) {
    s[kt] = (f32x4){0.f, 0.f, 0.f, 0.f};
#pragma unroll
    for (int ks = 0; ks < 2; ++ks) s[kt] = mfma16(F.k[kt][ks], qf[ks], s[kt]);
  }
  float mt = NEG_BIG;
#pragma unroll
  for (int kt = 0; kt < 2; ++kt)
#pragma unroll
    for (int r = 0; r < 4; ++r) { s[kt][r] = S.score(s[kt][r], st, kt, r); mt = fmaxf(mt, s[kt][r]); }
  mt = rows_max(mt);
  const bool need = mt > mrun + 8.f;
  if (__any(need)) {
    const float mnew = need ? mt : mrun;
    const float alpha = __builtin_amdgcn_exp2f(mrun - mnew);
    lrun *= alpha;
#pragma unroll
    for (int dt = 0; dt < 4; ++dt) { o[dt][0] *= alpha; o[dt][1] *= alpha; o[dt][2] *= alpha; o[dt][3] *= alpha; }
    mrun = mnew;
  }
  float pv[8], ls = 0.f;
#pragma unroll
  for (int kt = 0; kt < 2; ++kt)
#pragma unroll
    for (int r = 0; r < 4; ++r) { pv[kt * 4 + r] = __builtin_amdgcn_exp2f(s[kt][r] - mrun); ls += pv[kt * 4 + r]; }
  lrun += ls;
  u32x4 pk = {pk2(pv[0], pv[1]), pk2(pv[2], pv[3]), pk2(pv[4], pv[5]), pk2(pv[6], pv[7])};
  const bf16x8 pf = __builtin_bit_cast(bf16x8, pk);
#pragma unroll
  for (int dt = 0; dt < 4; ++dt) o[dt] = mfma16(F.v[dt], pf, o[dt]);
}
template <class Src>
DI void flash_wave(const Src& S, const bf16_t* qptr  , f32x4 (&o)[4], float& ltot) {
  bf16x8 qf[2];
  qf[0] = *(const bf16x8*)(qptr); qf[1] = *(const bf16x8*)(qptr + 32);
  float mrun = NEG_BIG, lrun = 0.f;
#pragma unroll
  for (int dt = 0; dt < 4; ++dt) o[dt] = (f32x4){0.f, 0.f, 0.f, 0.f};
  const int ns = S.nsteps();
  FlashFrags<Src> f0, f1, f2;
  flash_load(S, 0, f0);
  if (ns > 1) flash_load(S, 1, f1);
  for (int st = 0; st < ns; st += 3) {
    if (st + 2 < ns) flash_load(S, st + 2, f2);
    flash_step(S, st, f0, qf, o, mrun, lrun);
    if (st + 1 < ns) {
      if (st + 3 < ns) flash_load(S, st + 3, f0);
      flash_step(S, st + 1, f1, qf, o, mrun, lrun);
    }
    if (st + 2 < ns) {
      if (st + 4 < ns) flash_load(S, st + 4, f1);
      flash_step(S, st + 2, f2, qf, o, mrun, lrun);
    }
  }
  ltot = rows_sum(lrun);
}

DI void nat_wave_task(const Params& p, int l, int b, int head, int rq, int ct, const float* rpb_lds) {
  const int lane = ltid() & 63, lr = lane & 15, g = lane >> 4;
  const bf16_t* PN = (const bf16_t*)(p.ws + OFF_P);
  const bf16_t* VT = (const bf16_t*)(p.ws + OFF_VT);
  bf16_t* Y = (bf16_t*)(p.ws + OFF_Y);
  SrcNat S;
  S.PN = PN; S.VT = VT; S.kcol = C_NK + head * 64; S.vrow = R_NV + head * 64; S.b = b; S.rq = rq; S.lr = lr; S.g = g;
  int rs = rq - 4; rs = rs < 0 ? 0 : (rs > 24 ? 24 : rs);
  S.rs = rs;
  int cs = 16 * ct - 8; cs = cs < 0 ? 0 : (cs > 32 ? 32 : cs);
  S.cs = cs;
  S.qc = 16 * ct + lr;
  int cst = S.qc - 8; cst = cst < 0 ? 0 : (cst > 48 ? 48 : cst);
  S.cstart = cst;
  S.rpbh = rpb_lds + head * 465;
  f32x4 o[4];
  float lt;
  const int qtok = b * 2048 + rq * 64 + 16 * ct + lr;
  flash_wave<SrcNat>(S, PN + (size_t)qtok * PN_LD + C_NQ + head * 64 + 8 * g, o, lt);
  const float inv = 1.f / lt;
#pragma unroll
  for (int dt = 0; dt < 4; ++dt) {
    u32x2 ov = {pk2(o[dt][0] * inv, o[dt][1] * inv), pk2(o[dt][2] * inv, o[dt][3] * inv)};
    *(u32x2*)(Y + (size_t)qtok * 1024 + 256 + head * 64 + dt * 16 + 4 * g) = ov;
  }
}
DI void natctx_wave_task(const Params& p, int b, int head, int qt) {
  const int lane = ltid() & 63, lr = lane & 15, g = lane >> 4;
  const bf16_t* PN = (const bf16_t*)(p.ws + OFF_P);
  const bf16_t* VT = (const bf16_t*)(p.ws + OFF_VT);
  bf16_t* Y = (bf16_t*)(p.ws + OFF_Y);
  SrcSeg S;
  S.PN = PN; S.VT = VT; S.kcol = C_NK + head * 64; S.vrow = R_NV + head * 64; S.lr = lr; S.g = g;
  S.t0 = TL + b * 256; S.n0 = 8; S.t1 = 0; S.n1 = 0;
  f32x4 o[4];
  float lt;
  const int qtok = TL + b * 256 + qt * 16 + lr;
  flash_wave<SrcSeg>(S, PN + (size_t)qtok * PN_LD + C_NQ + head * 64 + 8 * g, o, lt);
  const float inv = 1.f / lt;
#pragma unroll
  for (int dt = 0; dt < 4; ++dt) {
    u32x2 ov = {pk2(o[dt][0] * inv, o[dt][1] * inv), pk2(o[dt][2] * inv, o[dt][3] * inv)};
    *(u32x2*)(Y + (size_t)qtok * 1024 + 256 + head * 64 + dt * 16 + 4 * g) = ov;
  }
}

DI void diff_block_task(const Params& p, int l, int b, int hd, int qtok0, int nsteps, unsigned char* lds, int dvar = 0) {
  const int tid = ltid(), lane = tid & 63, w = tid >> 6, lr = lane & 15, g = lane >> 4;
  unsigned char* Kb = lds;
  unsigned char* Vb = lds + 8192;
  const bf16_t* PN = (const bf16_t*)(p.ws + OFF_P);
  const bf16_t* VT = (const bf16_t*)(p.ws + OFF_VT);
  bf16_t* Y = (bf16_t*)(p.ws + OFF_Y);
  bf16x8 qf[2][2][2];
#pragma unroll
  for (int qt = 0; qt < 2; ++qt) {
    const bf16_t* qp = PN + (size_t)(qtok0 + 32 * w + 16 * qt + lr) * PN_LD + C_DQ + hd * 128 + 8 * g;
#pragma unroll
    for (int m = 0; m < 2; ++m)
#pragma unroll
      for (int ks = 0; ks < 2; ++ks) {
        const u32x4 raw = *(const u32x4*)(qp + m * 64 + ks * 32);
        float f[8];
        unpack8(raw, f);
        u32x4 sc = {pk2(f[0] * SC_LOG2, f[1] * SC_LOG2), pk2(f[2] * SC_LOG2, f[3] * SC_LOG2), pk2(f[4] * SC_LOG2, f[5] * SC_LOG2), pk2(f[6] * SC_LOG2, f[7] * SC_LOG2)};
        qf[m][qt][ks] = __builtin_bit_cast(bf16x8, sc);
      }
  }
  const int wu = __builtin_amdgcn_readfirstlane(w);
  unsigned kofs[2], vofs[2];
#pragma unroll
  for (int jj = 0; jj < 2; ++jj) {
    const int krow = 4 * (2 * w + jj) + (lane >> 4), kpc = lane & 15;
    const int kch = kpc ^ (((krow >> 3) & 3) * 4 + (krow & 3));
    kofs[jj] = (unsigned)(krow * PN_LD + C_DK + hd * 128 + kch * 8);
    const int vrow = 16 * (2 * w + jj) + (lane >> 2), vpc = lane & 3;
    const int vch = vpc ^ ((vrow >> 2) & 3);
    vofs[jj] = (unsigned)((R_DV + hd * 128 + vrow) * TT + vch * 8);
  }
#define DB_DMA(st, sl) do { const int tk = (st) < 8 ? TL + b * 256 + (st) * 32 : b * 2048 + ((st) - 8) * 32; \
    const bf16_t* kb_ = PN + (size_t)tk * PN_LD; const bf16_t* vb_ = VT + tk; \
    _Pragma("unroll") for (int jj = 0; jj < 2; ++jj) { \
      __builtin_amdgcn_global_load_lds((const unsigned*)(kb_ + kofs[jj]), (unsigned*)(Kb + (sl) * 16384 + (2 * wu + jj) * 1024), 16, 0, 0); \
      __builtin_amdgcn_global_load_lds((const unsigned*)(vb_ + vofs[jj]), (unsigned*)(Vb + (sl) * 16384 + (2 * wu + jj) * 1024), 16, 0, 0); } } while (0)
  asm volatile("s_waitcnt vmcnt(0)" ::: "memory");
  __syncthreads();
  DB_DMA(0, 0);
  DB_DMA(nsteps > 1 ? 1 : 0, 1);
  DB_DMA(nsteps > 2 ? 2 : nsteps - 1, 2);
  asm volatile("s_waitcnt vmcnt(8)" ::: "memory");
  __builtin_amdgcn_s_barrier();

  f32x4 o[2][2][8];
  float mrun[2][2], lrun[2][2];
#pragma unroll
  for (int m = 0; m < 2; ++m)
#pragma unroll
    for (int qt = 0; qt < 2; ++qt) {
      mrun[m][qt] = NEG_BIG; lrun[m][qt] = 0.f;
#pragma unroll
      for (int dt = 0; dt < 8; ++dt) o[m][qt][dt] = (f32x4){0.f, 0.f, 0.f, 0.f};
    }
  const int kfr = 8 * (lr >> 2) + (lr & 3);
  for (int st = 0; st < nsteps; ++st) {
    if (dvar != 1) { const int sn = st + 3 < nsteps ? st + 3 : nsteps - 1; DB_DMA(sn, (st + 3) & 3); }
    const unsigned char* Kt = Kb + (st & 3) * 16384;
    const unsigned char* Vt = Vb + (st & 3) * 16384;
    bf16x8 pf[2][2];
#pragma unroll
    for (int m = 0; m < 2; ++m) {
      bf16x8 kf[2][2];
#pragma unroll
      for (int kt = 0; kt < 2; ++kt)
#pragma unroll
        for (int ks = 0; ks < 2; ++ks) kf[kt][ks] = *(const bf16x8*)(Kt + (kfr + 4 * kt) * 256 + (((m * 8 + ks * 4 + g) ^ lr) << 4));
      __builtin_amdgcn_sched_barrier(0);
      f32x4 s[2][2];
#pragma unroll
      for (int qt = 0; qt < 2; ++qt)
#pragma unroll
        for (int kt = 0; kt < 2; ++kt) {
          s[qt][kt] = (f32x4){0.f, 0.f, 0.f, 0.f};
#pragma unroll
          for (int ks = 0; ks < 2; ++ks) s[qt][kt] = mfma16(kf[kt][ks], qf[m][qt][ks], s[qt][kt]);
        }
      __builtin_amdgcn_sched_barrier(0);
#pragma unroll
      for (int qt = 0; qt < 2; ++qt) {
        if (dvar == 2) {
          u32x4 pk = {pk2(s[qt][0][0], s[qt][0][1]), pk2(s[qt][0][2], s[qt][0][3]), pk2(s[qt][1][0], s[qt][1][1]), pk2(s[qt][1][2], s[qt][1][3])};
          pf[m][qt] = __builtin_bit_cast(bf16x8, pk);
          continue;
        }
        float mt = NEG_BIG;
#pragma unroll
        for (int kt = 0; kt < 2; ++kt)
#pragma unroll
          for (int r = 0; r < 4; ++r) mt = fmaxf(mt, s[qt][kt][r]);
        mt = rows_max(mt);
        const bool need = mt > mrun[m][qt] + 8.f;
        if (__any(need)) {
          const float mnew = need ? mt : mrun[m][qt];
          const float alpha = __builtin_amdgcn_exp2f(mrun[m][qt] - mnew);
          lrun[m][qt] *= alpha;
#pragma unroll
          for (int dt = 0; dt < 8; ++dt) { o[m][qt][dt][0] *= alpha; o[m][qt][dt][1] *= alpha; o[m][qt][dt][2] *= alpha; o[m][qt][dt][3] *= alpha; }
          mrun[m][qt] = mnew;
        }
        float pv[8], ls = 0.f;
#pragma unroll
        for (int kt = 0; kt < 2; ++kt)
#pragma unroll
          for (int r = 0; r < 4; ++r) { pv[kt * 4 + r] = __builtin_amdgcn_exp2f(s[qt][kt][r] - mrun[m][qt]); ls += pv[kt * 4 + r]; }
        lrun[m][qt] += ls;
        u32x4 pk = {pk2(pv[0], pv[1]), pk2(pv[2], pv[3]), pk2(pv[4], pv[5]), pk2(pv[6], pv[7])};
        pf[m][qt] = __builtin_bit_cast(bf16x8, pk);
      }
      __builtin_amdgcn_sched_barrier(0);
    }
#pragma unroll
    for (int hb = 0; hb < 2; ++hb) {
      bf16x8 vf[4];
#pragma unroll
      for (int d4 = 0; d4 < 4; ++d4) {
        const int vr = 16 * (4 * hb + d4) + lr;
        vf[d4] = *(const bf16x8*)(Vt + vr * 64 + ((g ^ ((vr >> 2) & 3)) << 4));
      }
      __builtin_amdgcn_sched_barrier(0);
#pragma unroll
      for (int d4 = 0; d4 < 4; ++d4)
#pragma unroll
        for (int m = 0; m < 2; ++m)
#pragma unroll
          for (int qt = 0; qt < 2; ++qt) { if (dvar == 3) asm volatile("" :: "v"(vf[d4]), "v"(pf[m][qt])); else o[m][qt][4 * hb + d4] = mfma16(vf[d4], pf[m][qt], o[m][qt][4 * hb + d4]); }
      __builtin_amdgcn_sched_barrier(0);
    }
    asm volatile("s_waitcnt vmcnt(8)" ::: "memory");
    __builtin_amdgcn_s_barrier();
  }
  asm volatile("s_waitcnt vmcnt(0)" ::: "memory");
#undef DB_DMA
  const float* lv = p.dlam + l * 256;
  float sa = lv[lane] * lv[64 + lane], sb = lv[128 + lane] * lv[192 + lane];
  sa = wave_sum(sa); sb = wave_sum(sb);
  const float lam_init = 0.8f - 0.6f * expf(-0.3f * (float)l);
  const float lam = expf(sa) - expf(sb) + lam_init;
  const float* dg = p.diff_g + l * 512 + hd * 128;
#pragma unroll
  for (int qt = 0; qt < 2; ++qt) {
    float l0 = lrun[0][qt], l1 = lrun[1][qt];
    l0 = rows_sum(l0);
    l1 = rows_sum(l1);
    const float i0 = 1.f / l0, i1 = lam / l1;
    float ss = 0.f;
#pragma unroll
    for (int dt = 0; dt < 8; ++dt)
#pragma unroll
      for (int r = 0; r < 4; ++r) { const float v = o[0][qt][dt][r] * i0 - o[1][qt][dt][r] * i1; o[0][qt][dt][r] = v; ss += v * v; }
    ss = rows_sum(ss);
    const float rstd = rsqrtf(ss * (1.f / 128.f) + 1e-6f) * (1.f - lam_init);
    const int qtok = qtok0 + 32 * w + 16 * qt + lr;
#pragma unroll
    for (int dt = 0; dt < 8; ++dt) {
      const float4 gg = *(const float4*)(dg + dt * 16 + 4 * g);
      u32x2 ov = {pk2(o[0][qt][dt][0] * rstd * gg.x, o[0][qt][dt][1] * rstd * gg.y), pk2(o[0][qt][dt][2] * rstd * gg.z, o[0][qt][dt][3] * rstd * gg.w)};
      *(u32x2*)(Y + (size_t)qtok * 1024 + 512 + hd * 128 + dt * 16 + 4 * g) = ov;
    }
  }
}


DI void nat_block_task(const Params& p, int l, int b, int head, int rq, const float* rpb_lds, unsigned char* lds) {
  const int tid = ltid(), lane = tid & 63, w = tid >> 6, lr = lane & 15, g = lane >> 4;
  const int wu = __builtin_amdgcn_readfirstlane(w);
  unsigned char* Kb = lds;
  unsigned char* Vb = lds + 8192;
  const bf16_t* PN = (const bf16_t*)(p.ws + OFF_P);
  const bf16_t* VT = (const bf16_t*)(p.ws + OFF_VT);
  bf16_t* Y = (bf16_t*)(p.ws + OFF_Y);
  int rs = rq - 4; rs = rs < 0 ? 0 : (rs > 24 ? 24 : rs);
  const int ct = w;
  int cs = 16 * ct - 8; cs = cs < 0 ? 0 : (cs > 32 ? 32 : cs);
  const int qc = 16 * ct + lr;
  int cstart = qc - 8; cstart = cstart < 0 ? 0 : (cstart > 48 ? 48 : cstart);
  const float* rpbh = rpb_lds + head * 465;
  const int qtok = b * 2048 + rq * 64 + qc;
  bf16x8 qf[2];
  { const bf16_t* qp = PN + (size_t)qtok * PN_LD + C_NQ + head * 64 + 8 * g; qf[0] = *(const bf16x8*)qp; qf[1] = *(const bf16x8*)(qp + 32); }
  unsigned kofs[2], vofs[2];
#pragma unroll
  for (int jj = 0; jj < 2; ++jj) {
    const int pidx = 2 * w + jj, row = 8 * pidx + (lane >> 3);
    const int kch = (lane & 7) ^ ((((row >> 3) & 3) << 1) | ((row >> 1) & 1));
    kofs[jj] = (unsigned)(row * PN_LD + C_NK + head * 64 + kch * 8);
    const int vch = (lane & 7) ^ ((row >> 1) & 7);
    vofs[jj] = (unsigned)((R_NV + head * 64 + row) * TT + vch * 8);
  }
#define NB_DMA(st, bf) do { const int tk = (st) < 8 ? b * 2048 + (rs + (st)) * 64 : TL + b * 256 + ((st) - 8) * 64; \
    const bf16_t* kb_ = PN + (size_t)tk * PN_LD; const bf16_t* vb_ = VT + tk; \
    _Pragma("unroll") for (int jj = 0; jj < 2; ++jj) { \
      __builtin_amdgcn_global_load_lds((const unsigned*)(kb_ + kofs[jj]), (unsigned*)(Kb + (bf) * 16384 + (2 * wu + jj) * 1024), 16, 0, 0); \
      __builtin_amdgcn_global_load_lds((const unsigned*)(vb_ + vofs[jj]), (unsigned*)(Vb + (bf) * 16384 + (2 * wu + jj) * 1024), 16, 0, 0); } } while (0)
  asm volatile("s_waitcnt vmcnt(0)" ::: "memory");
  __syncthreads();
  NB_DMA(0, 0); NB_DMA(1, 1); NB_DMA(2, 2);
  asm volatile("s_waitcnt vmcnt(8)" ::: "memory");
  __builtin_amdgcn_s_barrier();
  f32x4 o[4];
#pragma unroll
  for (int dt = 0; dt < 4; ++dt) o[dt] = (f32x4){0.f, 0.f, 0.f, 0.f};
  float mrun = NEG_BIG, lrun = 0.f;
  const int kap = 8 * (lr >> 2) + (lr & 3);
  for (int st = 0; st < 12; ++st) {
    { const int sn = st + 3 < 12 ? st + 3 : 11; NB_DMA(sn, (st + 3) & 3); }
    const unsigned char* Kt = Kb + (st & 3) * 16384;
    const unsigned char* Vt = Vb + (st & 3) * 16384;
    const int nsub = st < 8 ? 1 : 2;
    for (int sub = 0; sub < nsub; ++sub) {
      const int koff = st < 8 ? cs : 32 * sub;
      bf16x8 kf[2][2], vf[4];
#pragma unroll
      for (int kt = 0; kt < 2; ++kt) {
        const int row = koff + kap + 4 * kt;
        const int sw = (((row >> 3) & 3) << 1) | ((row >> 1) & 1);
#pragma unroll
        for (int ks = 0; ks < 2; ++ks) kf[kt][ks] = *(const bf16x8*)(Kt + (row >> 1) * 256 + ((((row & 1) << 3) | ((ks * 4 + g) ^ sw)) << 4));
      }
#pragma unroll
      for (int dt = 0; dt < 4; ++dt) {
        const int row = 16 * dt + lr, ch = (koff >> 3) + g;
        vf[dt] = *(const bf16x8*)(Vt + (row >> 1) * 256 + (((((row & 1) << 3) | ch) ^ ((row >> 1) & 7)) << 4));
      }
      f32x4 s[2];
#pragma unroll
      for (int kt = 0; kt < 2; ++kt) {
        s[kt] = (f32x4){0.f, 0.f, 0.f, 0.f};
#pragma unroll
        for (int ks = 0; ks < 2; ++ks) s[kt] = mfma16(kf[kt][ks], qf[ks], s[kt]);
      }
      float mt = NEG_BIG;
#pragma unroll
      for (int kt = 0; kt < 2; ++kt)
#pragma unroll
        for (int r = 0; r < 4; ++r) {
          float sv;
          if (st < 8) {
            const int kc = cs + 8 * g + 4 * kt + r;
            const bool valid = (kc >= cstart) && (kc < cstart + 16);
            int dc = kc - qc + 15; dc = dc < 0 ? 0 : (dc > 30 ? 30 : dc);
            const float bias = rpbh[(rs + st - rq + 7) * 31 + dc];
            sv = valid ? (s[kt][r] * 0.125f + bias) * LOG2E : NEG_BIG;
          } else sv = s[kt][r] * SC_LOG2;
          s[kt][r] = sv; mt = fmaxf(mt, sv);
        }
      mt = rows_max(mt);
      const bool need = mt > mrun + 8.f;
      if (__any(need)) {
        const float mnew = need ? mt : mrun;
        const float alpha = __builtin_amdgcn_exp2f(mrun - mnew);
        lrun *= alpha;
#pragma unroll
        for (int dt = 0; dt < 4; ++dt) { o[dt][0] *= alpha; o[dt][1] *= alpha; o[dt][2] *= alpha; o[dt][3] *= alpha; }
        mrun = mnew;
      }
      float pv[8], ls = 0.f;
#pragma unroll
      for (int kt = 0; kt < 2; ++kt)
#pragma unroll
        for (int r = 0; r < 4; ++r) { pv[kt * 4 + r] = __builtin_amdgcn_exp2f(s[kt][r] - mrun); ls += pv[kt * 4 + r]; }
      lrun += ls;
      u32x4 pk = {pk2(pv[0], pv[1]), pk2(pv[2], pv[3]), pk2(pv[4], pv[5]), pk2(pv[6], pv[7])};
      const bf16x8 pf = __builtin_bit_cast(bf16x8, pk);
#pragma unroll
      for (int dt = 0; dt < 4; ++dt) o[dt] = mfma16(vf[dt], pf, o[dt]);
    }
    asm volatile("s_waitcnt vmcnt(8)" ::: "memory");
    __builtin_amdgcn_s_barrier();
  }
  asm volatile("s_waitcnt vmcnt(0)" ::: "memory");
#undef NB_DMA
  const float inv = 1.f / rows_sum(lrun);
#pragma unroll
  for (int dt = 0; dt < 4; ++dt) {
    u32x2 ov = {pk2(o[dt][0] * inv, o[dt][1] * inv), pk2(o[dt][2] * inv, o[dt][3] * inv)};
    *(u32x2*)(Y + (size_t)qtok * 1024 + 256 + head * 64 + dt * 16 + 4 * g) = ov;
  }
}

DI float quad_sum(float v) {
  v += __int_as_float(__builtin_amdgcn_mov_dpp(__float_as_int(v), 0xB1, 0xF, 0xF, true));
  v += __int_as_float(__builtin_amdgcn_mov_dpp(__float_as_int(v), 0x4E, 0xF, 0xF, true));
  return v;
}
DI void gla_task(const Params& p, int l, int task, unsigned char* lds, int var = 0) {
  const int tid = ltid(), lane = tid & 63, w = tid >> 6, vv = lane >> 2, g = lane & 3;
  const int b = task >> 3, h = (task >> 1) & 3, dir = task & 1;
  const bf16_t* PN = (const bf16_t*)(p.ws + OFF_P);
  const bf16_t* VT = (const bf16_t*)(p.ws + OFF_VT);
  float* og = (float*)(p.ws + OFF_H);
  float* Gup = (float*)lds;
  float* Gb = Gup + 512;
  float* As = Gb + 32;
  float* Ks = As + 2048;
  float* Qs = Ks + 2048;
  float* Vs = Qs + 2048;
  __syncthreads();
  for (int e = tid; e < 512; e += 256) { const int r = e >> 5, kd = e & 31; Gup[e] = p.gate_up[((size_t)(l * 2 + dir) * 16 + r) * 128 + h * 32 + kd]; }
  if (tid < 32) Gb[tid] = p.gate_b[(l * 2 + dir) * 128 + h * 32 + tid];
  float S[8];
#pragma unroll
  for (int e = 0; e < 8; ++e) S[e] = 0.f;
  const int si = tid >> 2, part = tid & 3;
  u32x4 rq, rk, rg0, rg1, rv0, rv1;
#define GLA_TOK0(cc) ((cc) < 4 ? TL + b * 256 + (dir == 0 ? (cc) : 3 - (cc)) * 64 : b * 2048 + (dir == 0 ? (cc) - 4 : 35 - (cc)) * 64)
#define GLA_LOAD(cc) do { const int t0_ = GLA_TOK0(cc); const bf16_t* row = PN + (size_t)(t0_ + si) * PN_LD; \
    rq = *(const u32x4*)(row + C_GQ + h * 32 + part * 8); rk = *(const u32x4*)(row + C_GK + h * 32 + part * 8); \
    rg0 = *(const u32x4*)(row + C_GATE + dir * 16); rg1 = *(const u32x4*)(row + C_GATE + dir * 16 + 8); \
    const bf16_t* vp = VT + (size_t)(R_GV + h * 64 + si) * TT + t0_ + part * 16; rv0 = *(const u32x4*)vp; rv1 = *(const u32x4*)(vp + 8); } while (0)
#define GLA_WRITE() do { float gd[16], qf[8], kf[8], vf[16]; \
    unpack8(rg0, gd); unpack8(rg1, gd + 8); unpack8(rq, qf); unpack8(rk, kf); unpack8(rv0, vf); unpack8(rv1, vf + 8); \
    _Pragma("unroll") for (int e = 0; e < 8; ++e) { const int kd = part * 8 + e; float pre = Gb[kd]; \
      _Pragma("unroll") for (int r = 0; r < 16; ++r) pre += gd[r] * Gup[r * 32 + kd]; \
      const float ls = fminf(pre, 0.f) - log1pf(__expf(-fabsf(pre))); \
      As[si * 32 + kd] = __expf(ls * (1.f / 16.f)); Ks[si * 32 + kd] = kf[e]; Qs[si * 32 + kd] = qf[e] * 0.17677669529663687f; } \
    _Pragma("unroll") for (int e = 0; e < 16; ++e) Vs[(part * 16 + e) * 65 + si] = vf[e]; } while (0)
  GLA_LOAD(0);
  __syncthreads();
  GLA_WRITE();
  __syncthreads();
  for (int cc = 0; cc < 36; ++cc) {
    const int tok0 = GLA_TOK0(cc);
    if (cc + 1 < 36) GLA_LOAD(cc + 1);
    float* ob = og + ((size_t)dir * TT + tok0) * 256 + h * 64 + 16 * w + vv;
#pragma unroll 1
    for (int s0 = 0; s0 < (var == 3 ? 4 : 64); s0 += 4) {
      float4 a0[4], a1[4], k0[4], k1[4], q0[4], q1[4];
      float vx[4];
#pragma unroll
      for (int u = 0; u < 4; ++u) {
        const int i = dir == 0 ? s0 + u : 63 - s0 - u;
        a0[u] = *(const float4*)(As + i * 32 + 8 * g); a1[u] = *(const float4*)(As + i * 32 + 8 * g + 4);
        k0[u] = *(const float4*)(Ks + i * 32 + 8 * g); k1[u] = *(const float4*)(Ks + i * 32 + 8 * g + 4);
        q0[u] = *(const float4*)(Qs + i * 32 + 8 * g); q1[u] = *(const float4*)(Qs + i * 32 + 8 * g + 4);
        vx[u] = Vs[i * 65 + 16 * w + vv];
      }
#pragma unroll
      for (int u = 0; u < 4; ++u) {
        const int i = dir == 0 ? s0 + u : 63 - s0 - u;
        const float v = vx[u];
        S[0] = fmaf(a0[u].x, S[0], k0[u].x * v); S[1] = fmaf(a0[u].y, S[1], k0[u].y * v);
        S[2] = fmaf(a0[u].z, S[2], k0[u].z * v); S[3] = fmaf(a0[u].w, S[3], k0[u].w * v);
        S[4] = fmaf(a1[u].x, S[4], k1[u].x * v); S[5] = fmaf(a1[u].y, S[5], k1[u].y * v);
        S[6] = fmaf(a1[u].z, S[6], k1[u].z * v); S[7] = fmaf(a1[u].w, S[7], k1[u].w * v);
        const float oa = fmaf(q0[u].x, S[0], q0[u].y * S[1]), ob2 = fmaf(q0[u].z, S[2], q0[u].w * S[3]);
        const float oc = fmaf(q1[u].x, S[4], q1[u].y * S[5]), od = fmaf(q1[u].z, S[6], q1[u].w * S[7]);
        float o = (oa + ob2) + (oc + od);
        o = quad_sum(o);
        if (var == 1) asm volatile("" :: "v"(o)); else if (g == 0) ob[(size_t)i * 256] = o;
      }
    }
    __syncthreads();
    if (cc + 1 < 36 && var != 2) GLA_WRITE();
    __syncthreads();
  }
#undef GLA_TOK0
#undef GLA_LOAD
#undef GLA_WRITE
}

DI void phase_mixers(const Params& p, int l, bool last, unsigned* ctr, unsigned char* lds, int mask = 15, int gvar = 0) {
  const int tid = ltid(), w = tid >> 6;
  volatile int* slot = (volatile int*)(lds + LDS_BYTES - 16);
  float* rpb_lds = (float*)(lds + 65536);
  for (int e = tid; e < 4 * 465; e += 256) rpb_lds[e] = p.rpb[(size_t)l * 4 * 465 + e];
  const int nconv = (l == 0 && (mask & 8)) ? 1024 : 0;
  const int t1 = 128 + nconv, t2 = t1 + 1024, t3 = t2 + 2048, t4 = t3 + 128;
  const int ntask = last ? t3 : t4 + 256;
  for (;;) {
    __syncthreads();
    if (tid == 0) *slot = (int)atomicAdd(ctr, 1u);
    __syncthreads();
    const int task = *slot;
    if (task >= ntask) break;
    if (task < 128) { if (mask & 1) { __builtin_amdgcn_s_setprio(3); gla_task(p, l, task, lds, gvar); __builtin_amdgcn_s_setprio(0); } }
    else if (nconv && task < t2 && ((task - 128) & 1)) { const int c = (task - 128) >> 1; convert_table_pairs(p, c * 64, c * 64 + 64, w, 4, tid & 63); }
    else if (!(mask & 2) && (task < t2 || (task >= t3 && task < t4))) {}
    else if (!(mask & 4) && ((task >= t2 && task < t3) || task >= t4)) {}
    else if (task < t2) { const int d = nconv ? (task - 128) >> 1 : task - 128; const int b = d >> 6; diff_block_task(p, l, b, (d >> 4) & 3, b * 2048 + (d & 15) * 128, 72, lds, gvar); }
    else if (task < t3) { const int d = task - t2; nat_block_task(p, l, d >> 7, (d >> 5) & 3, d & 31, rpb_lds, lds); }
    else if (task < t4) { const int d = task - t3; const int b = d >> 3; diff_block_task(p, l, b, (d >> 1) & 3, TL + b * 256 + (d & 1) * 128, 8, lds); }
    else { const int wt = (task - t4) * 4 + w; natctx_wave_task(p, wt >> 6, (wt >> 4) & 3, wt & 15); }
  }
}

DI void phase_gla_fin(const Params& p, int l, int ntok) {
  const int lane = ltid() & 63, gw = lbid() * 4 + (ltid() >> 6), nw = lgdim() * 4;
  const float* og = (const float*)(p.ws + OFF_H);
  const bf16_t* PN = (const bf16_t*)(p.ws + OFF_P);
  bf16_t* Y = (bf16_t*)(p.ws + OFF_Y);
  const float4 gg = *(const float4*)(p.gla_norm_g + l * 256 + 4 * lane);
  for (int t = gw; t < ntok; t += nw) {
    const float4 a = *(const float4*)(og + (size_t)t * 256 + 4 * lane), bq = *(const float4*)(og + ((size_t)TT + t) * 256 + 4 * lane);
    const float o0 = a.x + bq.x, o1 = a.y + bq.y, o2 = a.z + bq.z, o3 = a.w + bq.w;
    float ss = o0 * o0 + o1 * o1 + o2 * o2 + o3 * o3;
    ss += __shfl_xor(ss, 1); ss += __shfl_xor(ss, 2); ss += __shfl_xor(ss, 4); ss += __shfl_xor(ss, 8);
    const float rstd = rsqrtf(ss * (1.f / 64.f) + 1e-6f);
    const u32x2 rv = *(const u32x2*)(PN + (size_t)t * PN_LD + C_GR + 4 * lane);
    const float r0 = bflo(rv.x), r1 = bfhi(rv.x), r2 = bflo(rv.y), r3 = bfhi(rv.y);
    const float y0 = o0 * rstd * gg.x * (r0 / (1.f + __expf(-r0)));
    const float y1 = o1 * rstd * gg.y * (r1 / (1.f + __expf(-r1)));
    const float y2 = o2 * rstd * gg.z * (r2 / (1.f + __expf(-r2)));
    const float y3 = o3 * rstd * gg.w * (r3 / (1.f + __expf(-r3)));
    u32x2 ov = {pk2(y0, y1), pk2(y2, y3)};
    *(u32x2*)(Y + (size_t)t * 1024 + 4 * lane) = ov;
  }
}


DI void ce_desc(float& a, float& b) {
  float hi, lo;
  asm("v_max_f32 %0, %2, %3\n\tv_min_f32 %1, %2, %3" : "=&v"(hi), "=&v"(lo) : "v"(a), "v"(b));
  a = hi; b = lo;
}
DI float vmaxf(float a, float b) { float r; asm("v_max_f32 %0, %1, %2" : "=v"(r) : "v"(a), "v"(b)); return r; }
template <int N>
DI void bitonic_sort_desc(float (&x)[N]) {
#pragma unroll
  for (int k = 2; k <= N; k <<= 1)
#pragma unroll
    for (int j = k >> 1; j > 0; j >>= 1)
#pragma unroll
      for (int i = 0; i < N; ++i) {
        const int l = i ^ j;
        if (l > i) { if ((i & k) == 0) ce_desc(x[i], x[l]); else ce_desc(x[l], x[i]); }
      }
}
template <int N>
DI void bitonic_merge_desc(float (&x)[N]) {
#pragma unroll
  for (int j = N >> 1; j > 0; j >>= 1)
#pragma unroll
    for (int i = 0; i < N; ++i) { const int l = i ^ j; if (l > i) ce_desc(x[i], x[l]); }
}
DI void rows_merge_top16(float (&L)[16]) {
  {
    float A0[16], A1[16];
#pragma unroll
    for (int i = 0; i < 16; ++i) { const u32x2 s = __builtin_amdgcn_permlane32_swap(__float_as_uint(L[i]), __float_as_uint(L[i]), false, false); A0[i] = __uint_as_float(s[0]); A1[i] = __uint_as_float(s[1]); }
#pragma unroll
    for (int i = 0; i < 16; ++i) L[i] = vmaxf(A0[i], A1[15 - i]);
    bitonic_merge_desc<16>(L);
  }
  {
    float A0[16], A1[16];
#pragma unroll
    for (int i = 0; i < 16; ++i) { const u32x2 s = __builtin_amdgcn_permlane16_swap(__float_as_uint(L[i]), __float_as_uint(L[i]), false, false); A0[i] = __uint_as_float(s[0]); A1[i] = __uint_as_float(s[1]); }
#pragma unroll
    for (int i = 0; i < 16; ++i) L[i] = vmaxf(A0[i], A1[15 - i]);
    bitonic_merge_desc<16>(L);
  }
}

struct PairTab { int a[52], b[52]; };
constexpr PairTab make_pairs() {
  PairTab t{};
  int n = 0;
  for (int a = 0; a < 16; ++a)
    for (int b = 0; b < 16; ++b)
      if ((a + 1) * (b + 1) <= 16) { t.a[n] = a; t.b[n] = b; ++n; }
  for (; n < 52; ++n) { t.a[n] = -1; t.b[n] = -1; }
  return t;
}

DI void topk_half(const bf16_t* skh  , const bf16_t* qrow  , int lr, int g, float (&list)[16]) {
  bf16x8 qf[2];
  qf[0] = *(const bf16x8*)(qrow); qf[1] = *(const bf16x8*)(qrow + 32);
  float s[32];
#pragma unroll
  for (int nt = 0; nt < 8; ++nt) {
    f32x4 acc = {0.f, 0.f, 0.f, 0.f};
#pragma unroll
    for (int ks = 0; ks < 2; ++ks) {
      const bf16x8 af = *(const bf16x8*)(skh + (size_t)(nt * 16 + lr) * 64 + ks * 32 + 8 * g);
      acc = mfma16(af, qf[ks], acc);
    }
#pragma unroll
    for (int r = 0; r < 4; ++r) {
      const unsigned n = nt * 16 + 4 * g + r;
      s[nt * 4 + r] = __uint_as_float((__float_as_uint(acc[r]) & ~127u) | n);
    }
  }
  float a[16], bq[16];
#pragma unroll
  for (int i = 0; i < 16; ++i) { a[i] = s[i]; bq[i] = s[16 + i]; }
  bitonic_sort_desc<16>(a);
  bitonic_sort_desc<16>(bq);
#pragma unroll
  for (int i = 0; i < 16; ++i) list[i] = vmaxf(a[i], bq[15 - i]);
  bitonic_merge_desc<16>(list);
  rows_merge_top16(list);
}

DI void topk_tile(const bf16_t* QP, const bf16_t* sk, int tt, int hd, int* eid_rows, float* gate_rows, int lr, int g) {
  constexpr PairTab PT = make_pairs();
  {
    const int tok = tt * 16 + lr;
    float v1[16], v2[16];
    topk_half(sk, QP + (size_t)tok * 1024 + hd * 128 + 8 * g, lr, g, v1);
    __builtin_amdgcn_sched_barrier(0);
    topk_half(sk + 128 * 64, QP + (size_t)tok * 1024 + hd * 128 + 64 + 8 * g, lr, g, v2);
    __builtin_amdgcn_sched_barrier(0);
    float cand[13];
#pragma unroll
    for (int c = 0; c < 13; ++c) {
      float sv[4];
#pragma unroll
      for (int gi = 0; gi < 4; ++gi) {
        const int pi = 4 * c + gi;
        if (PT.a[pi] >= 0) {
          const float a = v1[PT.a[pi] < 0 ? 0 : PT.a[pi]], bq = v2[PT.b[pi] < 0 ? 0 : PT.b[pi]];
          sv[gi] = __uint_as_float((__float_as_uint(a + bq) & ~255u) | (unsigned)(PT.a[pi] * 16 + PT.b[pi]));
        } else { sv[gi] = -3.0e38f; }
      }
      cand[c] = g == 0 ? sv[0] : (g == 1 ? sv[1] : (g == 2 ? sv[2] : sv[3]));
    }
    float topv[16];
#pragma unroll
    for (int c = 0; c < 13; ++c) topv[c] = cand[c];
    topv[13] = -3.0e38f; topv[14] = -3.1e38f; topv[15] = -3.2e38f;
    bitonic_sort_desc<16>(topv);
    rows_merge_top16(topv);
#pragma unroll
    for (int q = 0; q < 4; ++q) {
      const float wv = g == 0 ? topv[q] : (g == 1 ? topv[4 + q] : (g == 2 ? topv[8 + q] : topv[12 + q]));
      const int ia = (int)((__float_as_uint(wv) >> 4) & 15u), ib = (int)(__float_as_uint(wv) & 15u);
      unsigned e1 = 0, e2 = 0;
#pragma unroll
      for (int c = 0; c < 16; ++c) { if (ia == c) e1 = __float_as_uint(v1[c]) & 127u; if (ib == c) e2 = __float_as_uint(v2[c]) & 127u; }
      eid_rows[lr * 128 + hd * 16 + 4 * g + q] = (int)(e1 * 128u + e2);
    }
    if (g == 0) {
      float ex[16], sum = 0.f;
#pragma unroll
      for (int k = 0; k < 16; ++k) { ex[k] = __expf(topv[k] - topv[0]); sum += ex[k]; }
      const float inv = 1.f / sum;
#pragma unroll
      for (int q = 0; q < 4; ++q) {
        float4 o = {ex[4 * q] * inv, ex[4 * q + 1] * inv, ex[4 * q + 2] * inv, ex[4 * q + 3] * inv};
        *(float4*)(gate_rows + lr * 128 + hd * 16 + 4 * q) = o;
      }
    }
  }
}

DI float gelu_tanh(float x) {
  const float z = 0.7978845608028654f * (x + 0.044715f * x * x * x);
  const float e = __expf(2.f * z);
  const float th = 1.f - 2.f / (e + 1.f);
  return 0.5f * x * (1.f + th);
}
DI void gather_token(const Params& p, int l, int t, const int* eid_row, const float* gate_row, unsigned char* hl, float* wl, bool dry) {
  const int lane = ltid() & 63, lr = lane & 15, g = lane >> 4;
  const unsigned char* U6 = p.ws + OFF_U + (size_t)l * 16384 * U_PITCH;
  const unsigned char* V6 = p.ws + OFF_V + (size_t)l * 16384 * V_PITCH;
  const int half = lane >> 5, blk = lane & 31;
  const unsigned char* H6 = p.ws + OFF_H8;
  float* xres = (float*)(p.ws + OFF_XRES);
  const float* modbuf = (const float*)(p.ws + OFF_MOD);
  {
    if (lane < 50) {
      const u32x4 hq = *(const u32x4*)(H6 + (size_t)t * V6_PITCH + lane * 16);
      *(u32x4*)(hl + lane * 16) = hq;
    }
    const int e0 = eid_row[lane], e1 = eid_row[64 + lane];
    const float gv0 = gate_row[lane], gv1 = gate_row[64 + lane];
    {
      const u32x2 hsc = *(const u32x2*)(hl + 768 + 8 * g);
#pragma unroll 1
      for (int grp = 0; grp < 8; ++grp) {
        const int er = __shfl(grp < 4 ? e0 : e1, (grp & 3) * 16 + lr);
        const unsigned char* ur = U6 + (size_t)er * U_PITCH;
        u32x4 ua[8]; u32x2 ub[8];
#pragma unroll
        for (int s = 0; s < 8; ++s) {
          if (U_FP4) { ua[s] = *(const u32x4*)(ur + 16 * (4 * s + g)); ub[s] = (u32x2){0u, 0u}; }
          else { ua[s] = *(const u32x4*)(ur + 24 * (4 * s + g)); ub[s] = *(const u32x2*)(ur + 24 * (4 * s + g) + 16); }
        }
        const u32x2 usc = *(const u32x2*)(ur + (U_FP4 ? 512 : 768) + 8 * g);
        __builtin_amdgcn_sched_barrier(0);
        f32x4 acc = {0.f, 0.f, 0.f, 0.f};
#define G_STEP(s, OS, USC, HSC) do { const unsigned char* hb = hl + 24 * (4 * (s) + g); \
          const u32x2 h0 = *(const u32x2*)hb, h1 = *(const u32x2*)(hb + 8), h2v = *(const u32x2*)(hb + 16); \
          const i32x8 av = {(int)ua[s][0], (int)ua[s][1], (int)ua[s][2], (int)ua[s][3], (int)ub[s][0], (int)ub[s][1], 0, 0}; \
          const i32x8 bv = {(int)h0[0], (int)h0[1], (int)h1[0], (int)h1[1], (int)h2v[0], (int)h2v[1], 0, 0}; \
          acc = __builtin_amdgcn_mfma_scale_f32_16x16x128_f8f6f4(av, bv, acc, U_FP4 ? 4 : 2, 2, OS, (int)(USC), OS, (int)(HSC)); } while (0)
        G_STEP(0, 0, usc[0], hsc[0]); G_STEP(1, 1, usc[0], hsc[0]); G_STEP(2, 2, usc[0], hsc[0]); G_STEP(3, 3, usc[0], hsc[0]);
        G_STEP(4, 0, usc[1], hsc[1]); G_STEP(5, 1, usc[1], hsc[1]); G_STEP(6, 2, usc[1], hsc[1]); G_STEP(7, 3, usc[1], hsc[1]);
#undef G_STEP
        const float gvs = grp < 4 ? gv0 : gv1;
        const int lb_ = (grp & 3) * 16 + 4 * g;
        float4 wv_;
        wv_.x = __shfl(gvs, lb_) * gelu_tanh(acc[0]); wv_.y = __shfl(gvs, lb_ + 1) * gelu_tanh(acc[1]);
        wv_.z = __shfl(gvs, lb_ + 2) * gelu_tanh(acc[2]); wv_.w = __shfl(gvs, lb_ + 3) * gelu_tanh(acc[3]);
        if (lr == 0) *(float4*)(wl + grp * 16 + 4 * g) = wv_;
        __builtin_amdgcn_sched_barrier(0);
      }
    }
    __builtin_amdgcn_sched_barrier(0);
    float out[32];
#pragma unroll
    for (int i = 0; i < 32; ++i) out[i] = 0.f;
#pragma unroll 1
    for (int grp = 0; grp < 8; ++grp) {
      const int esel = grp < 4 ? e0 : e1;
      const int lb = (grp & 3) * 16;
      u32x4 vd4[8]; u32x2 vd2[8]; unsigned vsc[8];
#pragma unroll
      for (int pp = 0; pp < 8; ++pp) {
        const int ea = __builtin_amdgcn_readlane(esel, lb + 2 * pp), eb = __builtin_amdgcn_readlane(esel, lb + 2 * pp + 1);
        const unsigned char* vr = V6 + (size_t)(half ? eb : ea) * V_PITCH;
        if (V_FP4) { vd4[pp] = *(const u32x4*)(vr + 16 * blk); vd2[pp] = (u32x2){0u, 0u}; vsc[pp] = vr[mx4_scale_pos(blk)]; }
        else { vd4[pp] = *(const u32x4*)(vr + 24 * blk); vd2[pp] = *(const u32x2*)(vr + 24 * blk + 16); vsc[pp] = vr[mx_scale_pos(blk)]; }
      }
      __builtin_amdgcn_sched_barrier(0);
#pragma unroll
      for (int pp = 0; pp < 8; ++pp) {
        const float wgt = wl[grp * 16 + 2 * pp + half] * __uint_as_float(vsc[pp] << 23);
        if (V_FP4) {
          unsigned q0 = vd4[pp][0], q1 = vd4[pp][1], q2 = vd4[pp][2], q3 = vd4[pp][3];
          asm volatile("" : "+v"(q0), "+v"(q1) : "v"(out[0]), "v"(out[1]), "v"(out[2]), "v"(out[3]), "v"(out[4]), "v"(out[5]), "v"(out[6]), "v"(out[7]),
                       "v"(out[8]), "v"(out[9]), "v"(out[10]), "v"(out[11]), "v"(out[12]), "v"(out[13]), "v"(out[14]), "v"(out[15]));
          asm volatile("" : "+v"(q2), "+v"(q3) : "v"(out[16]), "v"(out[17]), "v"(out[18]), "v"(out[19]), "v"(out[20]), "v"(out[21]), "v"(out[22]), "v"(out[23]),
                       "v"(out[24]), "v"(out[25]), "v"(out[26]), "v"(out[27]), "v"(out[28]), "v"(out[29]), "v"(out[30]), "v"(out[31]));
          const u32x4 qd = {q0, q1, q2, q3};
#pragma unroll
          for (int d = 0; d < 4; ++d) {
            const f32x2 t0 = __builtin_amdgcn_cvt_scalef32_pk_f32_fp4(qd[d], 1.0f, 0), t1 = __builtin_amdgcn_cvt_scalef32_pk_f32_fp4(qd[d], 1.0f, 1);
            const f32x2 t2 = __builtin_amdgcn_cvt_scalef32_pk_f32_fp4(qd[d], 1.0f, 2), t3 = __builtin_amdgcn_cvt_scalef32_pk_f32_fp4(qd[d], 1.0f, 3);
            out[8 * d + 0] += wgt * t0[0]; out[8 * d + 1] += wgt * t0[1]; out[8 * d + 2] += wgt * t1[0]; out[8 * d + 3] += wgt * t1[1];
            out[8 * d + 4] += wgt * t2[0]; out[8 * d + 5] += wgt * t2[1]; out[8 * d + 6] += wgt * t3[0]; out[8 * d + 7] += wgt * t3[1];
          }
        } else {
          unsigned pk0 = vd4[pp][0], pk1 = vd4[pp][1];
          asm volatile("" : "+v"(pk0) : "v"(out[0]), "v"(out[1]), "v"(out[2]), "v"(out[3]), "v"(out[4]), "v"(out[5]), "v"(out[6]), "v"(out[7]),
                       "v"(out[8]), "v"(out[9]), "v"(out[10]), "v"(out[11]), "v"(out[12]), "v"(out[13]), "v"(out[14]), "v"(out[15]));
          asm volatile("" : "+v"(pk1) : "v"(out[16]), "v"(out[17]), "v"(out[18]), "v"(out[19]), "v"(out[20]), "v"(out[21]), "v"(out[22]), "v"(out[23]),
                       "v"(out[24]), "v"(out[25]), "v"(out[26]), "v"(out[27]), "v"(out[28]), "v"(out[29]), "v"(out[30]), "v"(out[31]));
          const u32x6 pk = {pk0, pk1, vd4[pp][2], vd4[pp][3], vd2[pp][0], vd2[pp][1]};
          const f32x32 vals = __builtin_amdgcn_cvt_scalef32_pk32_f32_fp6(pk, 1.0f);
  #pragma unroll
          for (int i = 0; i < 32; ++i) out[i] += wgt * vals[i];
        }
        __builtin_amdgcn_sched_barrier(0);
      }
    }
    float o16[16];
#pragma unroll
    for (int i = 0; i < 16; ++i) {
      const u32x2 s0 = __builtin_amdgcn_permlane32_swap(__float_as_uint(out[i]), __float_as_uint(out[i]), false, false);
      const u32x2 s1 = __builtin_amdgcn_permlane32_swap(__float_as_uint(out[16 + i]), __float_as_uint(out[16 + i]), false, false);
      const float t0 = __uint_as_float(s0[0]) + __uint_as_float(s0[1]), t1 = __uint_as_float(s1[0]) + __uint_as_float(s1[1]);
      o16[i] = half ? t1 : t0;
    }
    const int cb = 32 * blk + 16 * half;
    const int b = t < TL ? (t >> 11) : 16;
    const float* md = modbuf + ((size_t)l * 17 + b) * 6144 + 5 * 1024 + cb;
    float* xr = xres + (size_t)t * 1024 + cb;
    float xn[16];
    float ss = 0.f;
#pragma unroll
    for (int q = 0; q < 4; ++q) {
      const float4 m4 = *(const float4*)(md + 4 * q);
      float4 xv = *(const float4*)(xr + 4 * q);
      xv.x += m4.x * o16[4 * q + 0]; xv.y += m4.y * o16[4 * q + 1]; xv.z += m4.z * o16[4 * q + 2]; xv.w += m4.w * o16[4 * q + 3];
      xn[4 * q] = xv.x; xn[4 * q + 1] = xv.y; xn[4 * q + 2] = xv.z; xn[4 * q + 3] = xv.w;
      ss += xv.x * xv.x + xv.y * xv.y + xv.z * xv.z + xv.w * xv.w;
      if (dry) asm volatile("" :: "v"(xv.x), "v"(xv.y), "v"(xv.z), "v"(xv.w));
      else if (l < NL - 1) *(float4*)(xr + 4 * q) = xv;
    }
    if (!dry) {
      ss = wave_sum(ss);
      const float rstd = rsqrtf(ss * (1.f / 1024.f) + 1e-6f);
      if (l == NL - 1) {
        const float* fg = p.final_g + cb;
        float* orow = p.out + (size_t)t * 1024 + cb;
#pragma unroll
        for (int q = 0; q < 4; ++q) {
          const float4 g4 = *(const float4*)(fg + 4 * q);
          float4 o = {xn[4 * q] * rstd * g4.x, xn[4 * q + 1] * rstd * g4.y, xn[4 * q + 2] * rstd * g4.z, xn[4 * q + 3] * rstd * g4.w};
          *(float4*)(orow + 4 * q) = o;
        }
      } else {
        const float* gvec = p.norm1_g + (l + 1) * 1024 + cb;
        const float* mdn = modbuf + ((size_t)(l + 1) * 17 + b) * 6144 + cb;
        bf16_t* hrow = (bf16_t*)(p.ws + OFF_H) + (size_t)t * 1024 + cb;
        unsigned pk[8];
#pragma unroll
        for (int q = 0; q < 4; ++q) {
          const float4 g4 = *(const float4*)(gvec + 4 * q), sh = *(const float4*)(mdn + 4 * q), sc = *(const float4*)(mdn + 1024 + 4 * q);
          const float o0 = xn[4 * q] * rstd * g4.x * (1.f + sc.x) + sh.x, o1 = xn[4 * q + 1] * rstd * g4.y * (1.f + sc.y) + sh.y;
          const float o2 = xn[4 * q + 2] * rstd * g4.z * (1.f + sc.z) + sh.z, o3 = xn[4 * q + 3] * rstd * g4.w * (1.f + sc.w) + sh.w;
          pk[2 * q] = pk2(o0, o1); pk[2 * q + 1] = pk2(o2, o3);
        }
        *(u32x4*)hrow = (u32x4){pk[0], pk[1], pk[2], pk[3]};
        *(u32x4*)(hrow + 8) = (u32x4){pk[4], pk[5], pk[6], pk[7]};
      }
    }
  }
}


DI void phase_topk_gather(const Params& p, int l, int ntok, unsigned* ctr, unsigned char* lds, bool dry = false) {
  const int tid = ltid(), lane = tid & 63, w = tid >> 6, lr = lane & 15, g = lane >> 4;
  const bf16_t* QP = (const bf16_t*)(p.ws + OFF_QP);
  const bf16_t* sk = (const bf16_t*)(p.ws + OFF_SK) + (size_t)l * 2 * 128 * 64;
  int* eid_l = (int*)lds;
  float* gate_l = (float*)(lds + 8192);
  unsigned char* hl = lds + 16384 + w * 2048;
  float* wl = (float*)(hl + 1024);
  volatile int* slot = (volatile int*)(lds + LDS_BYTES - 16);
  const int ntile = ntok / 16;
  for (;;) {
    __syncthreads();
    if (tid == 0) *slot = (int)atomicAdd(ctr, 1u);
    __syncthreads();
    const int tile = *slot;
    if (tile >= ntile) break;
#pragma unroll 1
    for (int hh = 0; hh < 2; ++hh) {
      topk_tile(QP, sk, tile, 2 * w + hh, eid_l, gate_l, lr, g);
      __builtin_amdgcn_sched_barrier(0);
    }
    __syncthreads();
#pragma unroll 1
    for (int q = 0; q < 4; ++q) {
      const int r = 4 * w + q;
      gather_token(p, l, tile * 16 + r, eid_l + r * 128, gate_l + r * 128, hl, wl, dry);
    }
  }
}

DI void phase_final(const Params& p) {
  const int lane = ltid() & 63, gw = lbid() * 4 + (ltid() >> 6), nw = lgdim() * 4;
  const float* xres = (const float*)(p.ws + OFF_XRES);
  for (int t = gw; t < TL; t += nw) {
    const float* src = xres + (size_t)t * 1024;
    float4 v[4];
    float ss = 0.f;
#pragma unroll
    for (int i = 0; i < 4; ++i) {
      v[i] = *(const float4*)(src + 4 * lane + 256 * i);
      ss += v[i].x * v[i].x + v[i].y * v[i].y + v[i].z * v[i].z + v[i].w * v[i].w;
    }
    ss = wave_sum(ss);
    const float rstd = rsqrtf(ss * (1.f / 1024.f) + 1e-6f);
#pragma unroll
    for (int i = 0; i < 4; ++i) {
      const int col = 4 * lane + 256 * i;
      const float4 g4 = *(const float4*)(p.final_g + col);
      float4 o = {v[i].x * rstd * g4.x, v[i].y * rstd * g4.y, v[i].z * rstd * g4.z, v[i].w * rstd * g4.w};
      *(float4*)(p.out + (size_t)t * 1024 + col) = o;
    }
  }
}


#define LAS __attribute__((address_space(3)))
#define XB_TMO      128
#define XB_XCNT(j)  (256  + 64 * (j))
#define XB_XSUB(j)  (1280 + 64 * (j))
#define XB_XGEN(j)  (2304 + 64 * (j))
#define XB_TOP      3328
#define XB_TOPGEN   3392
#define XCD_BAR_WORDS 3456
#define XB_SPIN_CAP (1u << 22)
DI unsigned xb_ld(unsigned* p) { return __hip_atomic_load(p, __ATOMIC_RELAXED, __HIP_MEMORY_SCOPE_AGENT); }
DI unsigned xb_add(unsigned* p, unsigned v) { return __hip_atomic_fetch_add(p, v, __ATOMIC_RELAXED, __HIP_MEMORY_SCOPE_AGENT); }
DI unsigned xb_xcc_id() { return (unsigned)__builtin_amdgcn_s_getreg((3 << 11) | 20) & 0xFu; }
#define XB_SPIN(cond, bar) do { unsigned _sp = 0; while (cond) { __builtin_amdgcn_s_sleep(1); \
    if ((++_sp & 255u) == 0u) { if (xb_ld(&(bar)[XB_TMO])) break; if (_sp > XB_SPIN_CAP) { atomicAdd(&(bar)[XB_TMO], 1u); break; } } } } while (0)
struct XcdBarrier { unsigned* bar; unsigned x; volatile unsigned* st; };
DI XcdBarrier xcd_barrier_post(unsigned* bar, volatile unsigned* st) {
  XcdBarrier b; b.bar = bar; b.x = xb_xcc_id(); b.st = st;
  if (threadIdx.x == 0) (void)xb_add(&bar[XB_XCNT(b.x)], 1u);
  return b;
}
DI void xcd_barrier_complete(unsigned* bar, unsigned x, unsigned& nloc, unsigned& nx) {
  const unsigned G = gridDim.x * gridDim.y * gridDim.z;
  unsigned sum, cnt, mine, sp = 0u;
  for (;;) {
    sum = 0u; cnt = 0u; mine = 0u;
#pragma unroll 1
    for (unsigned j = 0; j < 16; ++j) { const unsigned c = xb_ld(&bar[XB_XCNT(j)]); sum += c; cnt += (c > 0u) ? 1u : 0u; mine = (j == x) ? c : mine; }
    if (sum == G) break;
    __builtin_amdgcn_s_sleep(1);
    if ((++sp & 255u) == 0u) { if (xb_ld(&bar[XB_TMO])) break; if (sp > XB_SPIN_CAP) { atomicAdd(&bar[XB_TMO], 1u); break; } }
  }
  nloc = mine > 0u ? mine : 1u; nx = cnt > 0u ? cnt : 1u;
}
DI void xcd_barrier(const XcdBarrier& b) {
  asm volatile("s_waitcnt vmcnt(0)" ::: "memory");
  __syncthreads();
  if (threadIdx.x == 0) {
    unsigned* bar = b.bar;
    __builtin_amdgcn_s_waitcnt(0);
    unsigned nloc = b.st[0], nx = b.st[1];
    if (nloc == 0u) { xcd_barrier_complete(bar, b.x, nloc, nx); b.st[0] = nloc; b.st[1] = nx; }
    const unsigned old = xb_add(&bar[XB_XSUB(b.x)], 1u);
    const unsigned gen = old / nloc;
    if (old + 1u == (gen + 1u) * nloc) {
      __builtin_amdgcn_fence(__ATOMIC_RELEASE, "agent");
      asm volatile("s_waitcnt vmcnt(0)" ::: "memory");
      const unsigned og = xb_add(&bar[XB_TOP], 1u);
      const unsigned tg = og / nx;
      if (og + 1u == (tg + 1u) * nx) xb_add(&bar[XB_TOPGEN], 1u);
      else XB_SPIN(xb_ld(&bar[XB_TOPGEN]) == tg, bar);
      __builtin_amdgcn_fence(__ATOMIC_ACQUIRE, "agent");
      xb_add(&bar[XB_XGEN(b.x)], 1u);
      asm volatile("s_waitcnt vmcnt(0)" ::: "memory");
    } else {
      XB_SPIN(xb_ld(&bar[XB_XGEN(b.x)]) == gen, bar);
      __builtin_amdgcn_fence(__ATOMIC_ACQUIRE, "agent");
      asm volatile("s_waitcnt vmcnt(0)" ::: "memory");
    }
  }
  __syncthreads();
}

constexpr int PH_PER_LAYER = 10;
constexpr int N_PHASES = 1 + NL * PH_PER_LAYER + 1;

template <int KIND>
DI void run_phase(const Params& p, int ph, unsigned char* lds) {
  unsigned* ctl = (unsigned*)(p.ws + OFF_CTL);
  if (ph == 0) { if (KIND < 0 || KIND == 0) phase_prologue(p, lds); }
  else if (ph == N_PHASES - 1) { if (KIND < 0 || KIND == 11) phase_final(p); }
  else {
    const int l = (ph - 1) / PH_PER_LAYER, s = (ph - 1) % PH_PER_LAYER;
    const bool last = (l == NL - 1);
    const int ntok = last ? TL : TT;
    if (s == 0) { if (KIND < 0 || KIND == 1) phase_norm(p, l, 0, TT); }
    else if (s == 1) { if (KIND < 0 || KIND == 2) phase_gemm_in(p, l, lds); }
    else if (s == 2) { if (KIND < 0 || KIND == 3) phase_rope(p, lds); }
    else if (s == 3) { if (KIND < 0 || KIND == 4) phase_mixers(p, l, last, ctl + 64 * (1 + l), lds); }
    else if (s == 4) { if (KIND < 0 || KIND == 5) phase_gla_fin(p, l, ntok); }
    else if (s == 5) { if (KIND < 0 || KIND == 6) phase_gemm_out(p, l, ntok, lds); }
    else if (s == 6) { if (KIND < 0 || KIND == 7) phase_norm(p, l, 1, ntok); }
    else if (s == 7) { if (KIND < 0 || KIND == 8) phase_gemm_q(p, l, ntok, lds); }
    else if (s == 8) { }
    else { if (KIND < 0 || KIND == 10) phase_topk_gather(p, l, ntok, (unsigned*)(p.ws + OFF_CTL) + 64 * (8 + l), lds); }
  }
}

#if N_LAUNCH_MODE == 1
#ifndef PROBE_KIND
#define PROBE_KIND -1
#endif
#ifndef GLA_VAR
#define GLA_VAR 0
#endif
constexpr int CW_BAR = 4096;
template <int l>
DI void run_layer(const Params& p, unsigned char* lds) {
  unsigned* ctl = (unsigned*)(p.ws + OFF_CTL);
#define GSYNC() do { XcdBarrier bb; bb.bar = (unsigned*)(p.ws + OFF_CTL) + CW_BAR; bb.x = xb_xcc_id(); bb.st = (volatile unsigned*)(lds + LDS_BYTES - 32); xcd_barrier(bb); } while (0)

    const bool last = (l == NL - 1);
    const int ntok = last ? TL : TT;
    if (l == 0) { { Params q = p; { size_t z_ = 0; asm volatile("" : "+s"(z_)); q.ws = p.ws + z_; } phase_norm(q, l, 0, TT); } GSYNC(); }
    if (PROBE_KIND == 1) { { Params q = p; { size_t z_ = 0; asm volatile("" : "+s"(z_)); q.ws = p.ws + z_; } phase_norm(q, l, 0, TT); } GSYNC(); }
    if (PROBE_KIND == 2) { { Params q = p; { size_t z_ = 0; asm volatile("" : "+s"(z_)); q.ws = p.ws + z_; } phase_gemm_in(q, l, lds, true); } GSYNC(); }
    { Params q = p; { size_t z_ = 0; asm volatile("" : "+s"(z_)); q.ws = p.ws + z_; } phase_gemm_in(q, l, lds); } GSYNC();
    if (PROBE_KIND == 4 || (PROBE_KIND >= 41 && PROBE_KIND <= 47)) { { Params q = p; { size_t z_ = 0; asm volatile("" : "+s"(z_)); q.ws = p.ws + z_; } phase_mixers(q, l, last, ctl + 64 * (1 + l) + 1, lds, PROBE_KIND == 4 ? 15 : PROBE_KIND - 40, GLA_VAR); } GSYNC(); }
    { Params q = p; { size_t z_ = 0; asm volatile("" : "+s"(z_)); q.ws = p.ws + z_; } phase_mixers(q, l, last, ctl + 64 * (1 + l), lds); } GSYNC();
    { Params q = p; { size_t z_ = 0; asm volatile("" : "+s"(z_)); q.ws = p.ws + z_; } phase_gla_fin(q, l, ntok); } GSYNC();
    if (PROBE_KIND == 5) { { Params q = p; { size_t z_ = 0; asm volatile("" : "+s"(z_)); q.ws = p.ws + z_; } phase_gla_fin(q, l, ntok); } GSYNC(); }
    { Params q = p; { size_t z_ = 0; asm volatile("" : "+s"(z_)); q.ws = p.ws + z_; } phase_gemm_out(q, l, ntok, lds); } GSYNC();
    { Params q = p; { size_t z_ = 0; asm volatile("" : "+s"(z_)); q.ws = p.ws + z_; } phase_norm2(q, l, ntok); } GSYNC();
    if (PROBE_KIND == 7) { { Params q = p; { size_t z_ = 0; asm volatile("" : "+s"(z_)); q.ws = p.ws + z_; } phase_norm2(q, l, ntok); } GSYNC(); }
    { Params q = p; { size_t z_ = 0; asm volatile("" : "+s"(z_)); q.ws = p.ws + z_; } phase_gemm_q(q, l, ntok, lds); } GSYNC();
    if (PROBE_KIND == 8) { { Params q = p; { size_t z_ = 0; asm volatile("" : "+s"(z_)); q.ws = p.ws + z_; } phase_gemm_q(q, l, ntok, lds); } GSYNC(); }
    if (PROBE_KIND == 11) { { Params q = p; { size_t z_ = 0; asm volatile("" : "+s"(z_)); q.ws = p.ws + z_; } phase_topk_gather(q, l, ntok, ctl + 64 * (8 + l) + 1, lds, true); } GSYNC(); }
    { Params q = p; { size_t z_ = 0; asm volatile("" : "+s"(z_)); q.ws = p.ws + z_; } phase_topk_gather(q, l, ntok, ctl + 64 * (8 + l), lds); } if (l + 1 < NL) GSYNC();
}
__global__ void __launch_bounds__(256, 2) mk_fwd(Params p) {
  __shared__ __attribute__((aligned(16))) unsigned char lds[LDS_BYTES];
  unsigned* ctl = (unsigned*)(p.ws + OFF_CTL);
  volatile unsigned* st = (volatile unsigned*)(lds + LDS_BYTES - 32);
  if (threadIdx.x < 2) st[threadIdx.x] = 0u;
  __syncthreads();
  (void)xcd_barrier_post(ctl + CW_BAR, st);
#define GSYNC() do { XcdBarrier bb; bb.bar = (unsigned*)(p.ws + OFF_CTL) + CW_BAR; bb.x = xb_xcc_id(); bb.st = (volatile unsigned*)(lds + LDS_BYTES - 32); xcd_barrier(bb); } while (0)
  { Params q = p; { size_t z_ = 0; asm volatile("" : "+s"(z_)); q.ws = p.ws + z_; } phase_prologue(q, lds); } cg::this_grid().sync();
  if (PROBE_KIND == 0) { { Params q = p; { size_t z_ = 0; asm volatile("" : "+s"(z_)); q.ws = p.ws + z_; } phase_prologue(q, lds); } GSYNC(); }
  run_layer<0>(p, lds); run_layer<1>(p, lds); run_layer<2>(p, lds); run_layer<3>(p, lds);
}
#else
template <int KIND>
__global__ void __launch_bounds__(256, 2) mk_phase(Params p) {
  __shared__ __attribute__((aligned(16))) unsigned char lds[LDS_BYTES];
  run_phase<KIND>(p, p.ph_lo, lds);
}
#endif

extern "C" void kernel_launch(void* const* d_in, const int* in_sizes, int n_in, void* d_out, int out_size, void* d_ws,
                              size_t ws_size, hipStream_t stream) {
  static int grid = 0;
  if (grid == 0) {
    if (n_in != 21 || ws_size < WS_END || out_size != TL * DM) { fprintf(stderr, "kernel_launch: unexpected shapes (n_in %d ws %zu out %d)\n", n_in, ws_size, out_size); grid = -1; return; }
    int dev = 0, cus = 0, per_cu = 2;
    (void)hipGetDevice(&dev);
    (void)hipDeviceGetAttribute(&cus, hipDeviceAttributeMultiprocessorCount, dev);
#if N_LAUNCH_MODE == 1
    (void)hipOccupancyMaxActiveBlocksPerMultiprocessor(&per_cu, (const void*)mk_fwd, 256, 0);
    if (per_cu < 1) per_cu = 1;
    if (per_cu > 2) per_cu = 2;
#endif
    grid = cus * per_cu;
  }
  if (grid < 0) return;
  (void)hipMemsetAsync((char*)d_ws + OFF_CTL, 0, 65536, stream);
  Params p{};
  const float** pp = (const float**)&p;
  for (int i = 0; i < 21; ++i) pp[i] = (const float*)d_in[i];
  p.out = (float*)d_out;
  p.ws = (unsigned char*)d_ws;
#if N_LAUNCH_MODE == 1
  p.ph_lo = 0; p.ph_hi = N_PHASES;
  void* args[] = {&p};
  hipError_t e = hipLaunchCooperativeKernel((const void*)mk_fwd, dim3(grid), dim3(256), args, 0, stream);
  if (e != hipSuccess) fprintf(stderr, "cooperative launch failed: %s (grid %d)\n", hipGetErrorString(e), grid);
#else
  for (int ph = 0; ph < N_PHASES; ++ph) {
    p.ph_lo = ph; p.ph_hi = ph + 1;
    const int kind = ph == 0 ? 0 : (ph == N_PHASES - 1 ? 11 : 1 + (ph - 1) % PH_PER_LAYER);
    switch (kind) {
      case 0: hipLaunchKernelGGL(mk_phase<0>, dim3(grid), dim3(256), 0, stream, p); break;
      case 1: hipLaunchKernelGGL(mk_phase<1>, dim3(grid), dim3(256), 0, stream, p); break;
      case 2: hipLaunchKernelGGL(mk_phase<2>, dim3(grid), dim3(256), 0, stream, p); break;
      case 3: hipLaunchKernelGGL(mk_phase<3>, dim3(grid), dim3(256), 0, stream, p); break;
      case 4: hipLaunchKernelGGL(mk_phase<4>, dim3(grid), dim3(256), 0, stream, p); break;
      case 5: hipLaunchKernelGGL(mk_phase<5>, dim3(grid), dim3(256), 0, stream, p); break;
      case 6: hipLaunchKernelGGL(mk_phase<6>, dim3(grid), dim3(256), 0, stream, p); break;
      case 7: hipLaunchKernelGGL(mk_phase<7>, dim3(grid), dim3(256), 0, stream, p); break;
      case 8: hipLaunchKernelGGL(mk_phase<8>, dim3(grid), dim3(256), 0, stream, p); break;
      case 9: hipLaunchKernelGGL(mk_phase<9>, dim3(grid), dim3(256), 0, stream, p); break;
      case 10: hipLaunchKernelGGL(mk_phase<10>, dim3(grid), dim3(256), 0, stream, p); break;
      default: hipLaunchKernelGGL(mk_phase<11>, dim3(grid), dim3(256), 0, stream, p); break;
    }
  }
#endif
}
```

```cpp
#include <hip/hip_runtime.h>
#include <hip/hip_cooperative_groups.h>
#include <stdint.h>
#include <stdio.h>
namespace cg = cooperative_groups;

#ifndef N_LAUNCH_MODE
#define N_LAUNCH_MODE 1
#endif

#define DI __device__ __forceinline__
#ifndef GEMM_VAR
#define GEMM_VAR 0
#endif
typedef unsigned short bf16_t;
typedef short bf16x8 __attribute__((ext_vector_type(8)));
typedef float f32x4 __attribute__((ext_vector_type(4)));
typedef float f32x2 __attribute__((ext_vector_type(2)));
typedef float f32x16 __attribute__((ext_vector_type(16)));
typedef float f32x32 __attribute__((ext_vector_type(32)));
typedef unsigned u32x6 __attribute__((ext_vector_type(6)));
typedef int i32x8 __attribute__((ext_vector_type(8)));
typedef unsigned u32x4 __attribute__((ext_vector_type(4)));
typedef unsigned u32x2 __attribute__((ext_vector_type(2)));

constexpr int NB = 16, SEQ = 2048, DM = 1024, NL = 4, CTXL = 256;
constexpr int TL = NB * SEQ;
constexpr int TC = NB * CTXL;
constexpr int TT = TL + TC;
constexpr int PN_LD = 2176;
constexpr int C_GQ = 0, C_GK = 128, C_GR = 256, C_NQ = 512, C_NK = 768, C_DQ = 1024, C_DK = 1536, C_GATE = 2048;
constexpr int R_GV = 0, R_NV = 256, R_DV = 512;
constexpr float LOG2E = 1.4426950408889634f;
constexpr float SC_LOG2 = 0.125f * LOG2E;
constexpr float NEG_BIG = -1e30f;

constexpr size_t MiB = 1u << 20;
constexpr size_t OFF_CTL = 0;
constexpr size_t OFF_MOD = 1 * MiB;
constexpr size_t OFF_WIN = 3 * MiB;
constexpr size_t OFF_WOUT = 28 * MiB;
constexpr size_t OFF_WQ = 36 * MiB;
constexpr size_t OFF_SK = 44 * MiB;
constexpr size_t OFF_USCL = 44 * MiB + 256 * 1024;
constexpr size_t OFF_VSCL = 44 * MiB + 512 * 1024;
constexpr size_t OFF_U = 45 * MiB;
constexpr size_t OFF_V = 109 * MiB;
constexpr int V6_PITCH = 800;
#ifndef U_FP4
#define U_FP4 1
#endif
#ifndef V_FP4
#define V_FP4 1
#endif
constexpr int P4_PITCH = 544;
constexpr int U_PITCH = U_FP4 ? P4_PITCH : V6_PITCH, V_PITCH = V_FP4 ? P4_PITCH : V6_PITCH;
constexpr size_t OFF_XRES = 301 * MiB;
constexpr size_t OFF_H = 445 * MiB;
constexpr size_t OFF_P = 517 * MiB;
constexpr size_t OFF_VT = OFF_P + 153 * MiB;
constexpr size_t OFF_QP = OFF_P;
constexpr size_t OFF_EID = OFF_P + 72 * MiB;
constexpr size_t OFF_GATE = OFF_P + 90 * MiB;
constexpr size_t OFF_H8 = OFF_P + 126 * MiB;
constexpr size_t OFF_HINV = OFF_P + 162 * MiB;
constexpr size_t OFF_Y = 742 * MiB;
constexpr size_t WS_END = 814 * MiB;

constexpr int LDS_BYTES = 65536 + 8192;

struct Params {
  const float *x, *c, *ctx, *c_ctx, *ada_w, *ada_b, *norm1_g, *norm2_g, *w_in, *gate_up, *gate_b, *gla_norm_g,
      *rpb, *dlam, *diff_g, *w_out, *wq, *subkeys, *pu, *pv, *final_g;
  float* out;
  unsigned char* ws;
  int ph_lo, ph_hi;
};

DI int ltid() { int t = threadIdx.x; asm volatile("" : "+v"(t)); return t; }
DI int lbid() { int t = blockIdx.x; asm volatile("" : "+s"(t)); return t; }
DI int lgdim() { int t = gridDim.x; asm volatile("" : "+s"(t)); return t; }

DI unsigned f2bf(float f) { unsigned u = __float_as_uint(f); return (u + 0x7fffu + ((u >> 16) & 1u)) >> 16; }
typedef __bf16 bf16x2_t __attribute__((ext_vector_type(2)));
DI unsigned pk2(float lo, float hi) { f32x2 v = {lo, hi}; return __builtin_bit_cast(unsigned, __builtin_convertvector(v, bf16x2_t)); }
DI float bflo(unsigned u) { return __uint_as_float(u << 16); }
DI float bfhi(unsigned u) { return __uint_as_float(u & 0xffff0000u); }
DI void unpack8(const u32x4 v, float* f) {
  f[0] = bflo(v.x); f[1] = bfhi(v.x); f[2] = bflo(v.y); f[3] = bfhi(v.y);
  f[4] = bflo(v.z); f[5] = bfhi(v.z); f[6] = bflo(v.w); f[7] = bfhi(v.w);
}
DI float wave_sum(float v) {
#pragma unroll
  for (int o = 32; o >= 1; o >>= 1) v += __shfl_xor(v, o);
  return v;
}

DI float rows_max(float x) {
  unsigned u = __float_as_uint(x);
  u32x2 a = __builtin_amdgcn_permlane32_swap(u, u, false, false);
  const float m = fmaxf(__uint_as_float(a[0]), __uint_as_float(a[1]));
  unsigned v = __float_as_uint(m);
  u32x2 b = __builtin_amdgcn_permlane16_swap(v, v, false, false);
  return fmaxf(__uint_as_float(b[0]), __uint_as_float(b[1]));
}
DI float rows_sum(float x) {
  unsigned u = __float_as_uint(x);
  u32x2 a = __builtin_amdgcn_permlane32_swap(u, u, false, false);
  const float m = __uint_as_float(a[0]) + __uint_as_float(a[1]);
  unsigned v = __float_as_uint(m);
  u32x2 b = __builtin_amdgcn_permlane16_swap(v, v, false, false);
  return __uint_as_float(b[0]) + __uint_as_float(b[1]);
}

DI u32x6 mxfp6_pack32(float (&x)[32], unsigned& sbyte) {
  float am = 0.f;
#pragma unroll
  for (int i = 0; i < 32; ++i) am = fmaxf(am, fabsf(x[i]));
  int e = am > 0.f ? (int)ceilf(log2f(am) - 2.906890596f) : -126;
  e = e < -126 ? -126 : (e > 127 ? 127 : e);
  const float sc = __uint_as_float((unsigned)(127 - e) << 23);
  f32x16 lo, hi;
#pragma unroll
  for (int i = 0; i < 16; ++i) { lo[i] = x[2 * i] * sc; hi[i] = x[2 * i + 1] * sc; }
  sbyte = (unsigned)(127 + e);
  return __builtin_amdgcn_cvt_scalef32_2xpk16_fp6_f32(lo, hi, 1.0f);
}

DI u32x4 mxfp4_pack32(float (&x)[32], unsigned& sbyte) {
  float am = 0.f;
#pragma unroll
  for (int i = 0; i < 32; ++i) am = fmaxf(am, fabsf(x[i]));
  int e = am > 0.f ? (int)ceilf(log2f(am) - 2.584962501f) : -126;
  e = e < -126 ? -126 : (e > 127 ? 127 : e);
  const float sc = __uint_as_float((unsigned)(127 - e) << 23);
  sbyte = (unsigned)(127 + e);
  u32x4 q;
#pragma unroll
  for (int d = 0; d < 4; ++d) {
    unsigned v = 0;
    v = __builtin_amdgcn_cvt_scalef32_pk_fp4_f32(v, x[8 * d + 0] * sc, x[8 * d + 1] * sc, 1.0f, 0);
    v = __builtin_amdgcn_cvt_scalef32_pk_fp4_f32(v, x[8 * d + 2] * sc, x[8 * d + 3] * sc, 1.0f, 1);
    v = __builtin_amdgcn_cvt_scalef32_pk_fp4_f32(v, x[8 * d + 4] * sc, x[8 * d + 5] * sc, 1.0f, 2);
    v = __builtin_amdgcn_cvt_scalef32_pk_fp4_f32(v, x[8 * d + 6] * sc, x[8 * d + 7] * sc, 1.0f, 3);
    q[d] = v;
  }
  return q;
}
DI int mx4_scale_pos(int blk) { return 512 + (blk & 3) * 8 + (blk >> 2); }
DI int mx_scale_pos(int blk) { return 768 + (blk & 3) * 8 + (blk >> 2); }
DI f32x4 mfma16(bf16x8 a, bf16x8 b, f32x4 c) { return __builtin_amdgcn_mfma_f32_16x16x32_bf16(a, b, c, 0, 0, 0); }

DI int win_src_col(int r) {
  if (r < 256) return r;
  if (r < 512) return r - 256 + 512;
  if (r < 768) return r - 512 + 800;
  if (r < 1024) return r - 768 + 1056;
  if (r < 1536) return r - 1024 + 1568;
  if (r < 2048) return r - 1536 + 2080;
  if (r < 2080) return r - 2048 + 768;
  if (r < 2176) return -1;
  if (r < 2432) return r - 2176 + 256;
  if (r < 2688) return r - 2432 + 1312;
  return r - 2688 + 2592;
}

DI void transpose_item(const float* __restrict__ W, int N, int src, bf16_t* __restrict__ dst, float* lds) {
  const int tid = ltid();
  for (int kc = 0; kc < 8; ++kc) {
    __syncthreads();
#pragma unroll
    for (int i = 0; i < 16; ++i) {
      int k = i * 8 + (tid >> 5), n = tid & 31;
      lds[k * 33 + n] = (src < 0) ? 0.f : W[(size_t)(kc * 128 + k) * N + src + n];
    }
    __syncthreads();
    int row = tid >> 3, k0 = (tid & 7) * 16;
    unsigned o[8];
#pragma unroll
    for (int e = 0; e < 8; ++e) o[e] = pk2(lds[(k0 + 2 * e) * 33 + row], lds[(k0 + 2 * e + 1) * 33 + row]);
    u32x4 a = {o[0], o[1], o[2], o[3]}, b = {o[4], o[5], o[6], o[7]};
    bf16_t* d = dst + (size_t)row * 1024 + kc * 128 + k0;
    *(u32x4*)d = a; *(u32x4*)(d + 8) = b;
  }
}

DI void convert_table_pairs(const Params& p, int pr0, int pr1, int wave, int nwave, int lane) {
  for (int pr = pr0 + wave; pr < pr1; pr += nwave) {
    const int tab = pr >= NL * 16384 / 2, pq = tab ? pr - NL * 16384 / 2 : pr;
    const int r = 2 * pq + (lane >> 5), blk = lane & 31;
    const float* src = (tab ? p.pv : p.pu) + (size_t)r * 1024 + 32 * blk;
    float x[32];
#pragma unroll
    for (int i = 0; i < 8; ++i) { const float4 a = *(const float4*)(src + 4 * i); x[4 * i] = a.x; x[4 * i + 1] = a.y; x[4 * i + 2] = a.z; x[4 * i + 3] = a.w; }
    unsigned sb;
    if (tab ? V_FP4 : U_FP4) {
      const u32x4 q = mxfp4_pack32(x, sb);
      unsigned char* row = p.ws + (tab ? OFF_V : OFF_U) + (size_t)r * P4_PITCH;
      *(u32x4*)(row + 16 * blk) = q;
      row[mx4_scale_pos(blk)] = (unsigned char)sb;
    } else {
      const u32x6 q = mxfp6_pack32(x, sb);
      unsigned char* row = p.ws + (tab ? OFF_V : OFF_U) + (size_t)r * V6_PITCH;
      *(u32x2*)(row + 24 * blk) = (u32x2){q[0], q[1]};
      *(u32x2*)(row + 24 * blk + 8) = (u32x2){q[2], q[3]};
      *(u32x2*)(row + 24 * blk + 16) = (u32x2){q[4], q[5]};
      row[mx_scale_pos(blk)] = (unsigned char)sb;
    }
  }
}

DI void phase_prologue(const Params& p, unsigned char* lds) {
  const int tid = ltid(), nb = lgdim(), bid = lbid();
  bf16_t* winT = (bf16_t*)(p.ws + OFF_WIN);
  bf16_t* woutT = (bf16_t*)(p.ws + OFF_WOUT);
  bf16_t* wqT = (bf16_t*)(p.ws + OFF_WQ);
  constexpr int PER_LAYER = 100 + 32 + 32;
  for (int item = bid; item < NL * PER_LAYER; item += nb) {
    int l = item / PER_LAYER, r = item % PER_LAYER;
    if (r < 100) {
      int row = r * 32;
      transpose_item(p.w_in + (size_t)l * 1024 * 3104, 3104, win_src_col(row), winT + ((size_t)l * 3200 + row) * 1024, (float*)lds);
    } else if (r < 132) {
      int row = (r - 100) * 32;
      transpose_item(p.w_out + (size_t)l * 1024 * 1024, 1024, row, woutT + ((size_t)l * 1024 + row) * 1024, (float*)lds);
    } else {
      int row = (r - 132) * 32;
      transpose_item(p.wq + (size_t)l * 1024 * 1024, 1024, row, wqT + ((size_t)l * 1024 + row) * 1024, (float*)lds);
    }
  }
  {
    bf16_t* sk = (bf16_t*)(p.ws + OFF_SK);
    for (int i = bid * 256 + tid; i < NL * 2 * 128 * 64; i += nb * 256) sk[i] = (bf16_t)f2bf(p.subkeys[i]);
  }
  {
    float* modbuf = (float*)(p.ws + OFF_MOD);
    float* sc = (float*)lds;
    float* red = (float*)(lds + 17 * 512 * 4);
    for (int item = bid; item < NL * 96; item += nb) {
      const int l = item / 96, cb = item % 96, col = cb * 64 + (tid & 63), kq = tid >> 6;
      float acc[17];
#pragma unroll
      for (int r = 0; r < 17; ++r) acc[r] = 0.f;
      for (int half = 0; half < 2; ++half) {
        __syncthreads();
        for (int e = tid; e < 17 * 512; e += 256) {
          int r = e >> 9, k = e & 511;
          float cv = (r < 16) ? p.c[r * 1024 + half * 512 + k] : p.c_ctx[half * 512 + k];
          sc[e] = cv / (1.f + __expf(-cv));
        }
        __syncthreads();
        const float* wp = p.ada_w + ((size_t)l * 1024 + half * 512 + kq * 128) * 6144 + col;
        for (int kk = 0; kk < 128; ++kk) {
          const float w = wp[(size_t)kk * 6144];
#pragma unroll
          for (int r = 0; r < 17; ++r) acc[r] += sc[r * 512 + kq * 128 + kk] * w;
        }
      }
#pragma unroll
      for (int r = 0; r < 17; ++r) red[(kq * 17 + r) * 64 + (tid & 63)] = acc[r];
      __syncthreads();
      for (int e = tid; e < 17 * 64; e += 256) {
        int r = e >> 6, cc = e & 63;
        float s = red[(0 * 17 + r) * 64 + cc] + red[(1 * 17 + r) * 64 + cc] + red[(2 * 17 + r) * 64 + cc] + red[(3 * 17 + r) * 64 + cc];
        int colg = cb * 64 + cc;
        modbuf[((size_t)l * 17 + r) * 6144 + colg] = s + p.ada_b[l * 6144 + colg];
      }
      __syncthreads();
    }
  }
}

DI void phase_norm(const Params& p, int l, int which, int ntok) {
  const int lane = ltid() & 63, gw = lbid() * 4 + (ltid() >> 6), nw = lgdim() * 4;
  const float* gvec = (which == 0 ? p.norm1_g : p.norm2_g) + l * 1024;
  const int ish = which == 0 ? 0 : 3, isc = which == 0 ? 1 : 4;
  const float* xres = (const float*)(p.ws + OFF_XRES);
  const float* modbuf = (const float*)(p.ws + OFF_MOD);
  bf16_t* hbuf = (bf16_t*)(p.ws + OFF_H);
  for (int t = gw; t < ntok; t += nw) {
    const float* src = (which == 0 && l == 0) ? (t < TL ? p.x + (size_t)t * 1024 : p.ctx + (size_t)(t - TL) * 1024) : xres + (size_t)t * 1024;
    const int b = t < TL ? (t >> 11) : 16;
    const float* md = modbuf + ((size_t)l * 17 + b) * 6144;
    float4 v[4];
    float ss = 0.f;
#pragma unroll
    for (int i = 0; i < 4; ++i) {
      v[i] = *(const float4*)(src + 4 * lane + 256 * i);
      ss += v[i].x * v[i].x + v[i].y * v[i].y + v[i].z * v[i].z + v[i].w * v[i].w;
    }
    ss = wave_sum(ss);
    const float rstd = rsqrtf(ss * (1.f / 1024.f) + 1e-6f);
    float am = 0.f;
#pragma unroll
    for (int i = 0; i < 4; ++i) {
      const int col = 4 * lane + 256 * i;
      const float4 g4 = *(const float4*)(gvec + col), sh = *(const float4*)(md + ish * 1024 + col), sc = *(const float4*)(md + isc * 1024 + col);
      float o0 = v[i].x * rstd * g4.x * (1.f + sc.x) + sh.x;
      float o1 = v[i].y * rstd * g4.y * (1.f + sc.y) + sh.y;
      float o2 = v[i].z * rstd * g4.z * (1.f + sc.z) + sh.z;
      float o3 = v[i].w * rstd * g4.w * (1.f + sc.w) + sh.w;
      u32x2 o = {pk2(o0, o1), pk2(o2, o3)};
      *(u32x2*)(hbuf + (size_t)t * 1024 + col) = o;
      v[i].x = o0; v[i].y = o1; v[i].z = o2; v[i].w = o3;
      am = fmaxf(am, fmaxf(fmaxf(fabsf(o0), fabsf(o1)), fmaxf(fabsf(o2), fabsf(o3))));
    }
  }
}

DI void phase_norm2(const Params& p, int l, int ntok) {
  const int lane = ltid() & 63, gw = lbid() * 4 + (ltid() >> 6), nw = lgdim() * 4;
  const int half = lane >> 5, blk = lane & 31;
  const float* gvec = p.norm2_g + l * 1024 + 32 * blk;
  const bf16_t* xres = (const bf16_t*)(p.ws + OFF_XRES);
  const float* modbuf = (const float*)(p.ws + OFF_MOD);
  bf16_t* hbuf = (bf16_t*)(p.ws + OFF_H);
  unsigned char* h6 = p.ws + OFF_H8;
  for (int pr = gw; pr < ntok / 2; pr += nw) {
    const int t = 2 * pr + half;
    const bf16_t* src = xres + (size_t)t * 1024 + 32 * blk;
    const int b = t < TL ? (t >> 11) : 16;
    const float* md = modbuf + ((size_t)l * 17 + b) * 6144 + 32 * blk;
    float x[32];
    float ss = 0.f;
#pragma unroll
    for (int i = 0; i < 4; ++i) { const u32x4 a = *(const u32x4*)(src + 8 * i); unpack8(a, x + 8 * i); }
#pragma unroll
    for (int i = 0; i < 32; ++i) ss += x[i] * x[i];
#pragma unroll
    for (int o = 16; o >= 1; o >>= 1) ss += __shfl_xor(ss, o);
    const float rstd = rsqrtf(ss * (1.f / 1024.f) + 1e-6f);
    unsigned pk[16];
#pragma unroll
    for (int i = 0; i < 8; ++i) {
      const float4 g4 = *(const float4*)(gvec + 4 * i), sh = *(const float4*)(md + 3 * 1024 + 4 * i), sc = *(const float4*)(md + 4 * 1024 + 4 * i);
      x[4 * i] = x[4 * i] * rstd * g4.x * (1.f + sc.x) + sh.x;
      x[4 * i + 1] = x[4 * i + 1] * rstd * g4.y * (1.f + sc.y) + sh.y;
      x[4 * i + 2] = x[4 * i + 2] * rstd * g4.z * (1.f + sc.z) + sh.z;
      x[4 * i + 3] = x[4 * i + 3] * rstd * g4.w * (1.f + sc.w) + sh.w;
      pk[2 * i] = pk2(x[4 * i], x[4 * i + 1]); pk[2 * i + 1] = pk2(x[4 * i + 2], x[4 * i + 3]);
    }
    bf16_t* hrow = hbuf + (size_t)t * 1024 + 32 * blk;
#pragma unroll
    for (int i = 0; i < 4; ++i) *(u32x4*)(hrow + 8 * i) = (u32x4){pk[4 * i], pk[4 * i + 1], pk[4 * i + 2], pk[4 * i + 3]};
    unsigned sb;
    const u32x6 q = mxfp6_pack32(x, sb);
    unsigned char* row = h6 + (size_t)t * V6_PITCH;
    *(u32x2*)(row + 24 * blk) = (u32x2){q[0], q[1]};
    *(u32x2*)(row + 24 * blk + 8) = (u32x2){q[2], q[3]};
    *(u32x2*)(row + 24 * blk + 16) = (u32x2){q[4], q[5]};
    row[mx_scale_pos(blk)] = (unsigned char)sb;
  }
}

template <int EPI>
DI void gemm_tile(const bf16_t* __restrict__ P, const bf16_t* __restrict__ Q, int it, int jt, void* outp, int ld,
                  const float* xin_lat, const float* xin_ctx, const float* modl, unsigned char* lds, bool gvar = false) {
  const int tid = ltid(), lane = tid & 63, w = tid >> 6, wi = w >> 1, wj = w & 1, lr = lane & 15, g = lane >> 4;
  const int wu = __builtin_amdgcn_readfirstlane(w);
  f32x4 acc[4][4];
#pragma unroll
  for (int a = 0; a < 4; ++a)
#pragma unroll
    for (int b = 0; b < 4; ++b) acc[a][b] = (f32x4){0.f, 0.f, 0.f, 0.f};
  const unsigned lo0 = (unsigned)((lane >> 3) * 1024 + (((lane & 7) ^ (lane >> 4)) << 3));
  const unsigned lo1 = (unsigned)((lane >> 3) * 1024 + (((lane & 7) ^ (4 + (lane >> 4))) << 3));
  const bf16_t* pg = P + (size_t)(it * 128 + 32 * wu) * 1024;
  const bf16_t* qg = Q + (size_t)(jt * 128 + 32 * wu) * 1024;
#define GT_DMA(kb, bf) do { _Pragma("unroll") for (int jj = 0; jj < 4; ++jj) { const unsigned lo_ = (jj & 1) ? lo1 : lo0; \
      __builtin_amdgcn_global_load_lds((const unsigned*)(pg + (size_t)jj * 8192 + (kb) * 64 + lo_), (unsigned*)(lds + (bf) * 32768 + (4 * wu + jj) * 1024), 16, 0, 0); \
      __builtin_amdgcn_global_load_lds((const unsigned*)(qg + (size_t)jj * 8192 + (kb) * 64 + lo_), (unsigned*)(lds + (bf) * 32768 + 16384 + (4 * wu + jj) * 1024), 16, 0, 0); } } while (0)
  __syncthreads();
  GT_DMA(0, 0);
  asm volatile("s_waitcnt vmcnt(0)" ::: "memory");
  __syncthreads();
  for (int kb = 0; kb < 16; ++kb) {
    if (kb < 15 && !(GEMM_VAR == 1 && gvar)) GT_DMA(kb + 1, (kb + 1) & 1);
    const unsigned char* Ps = lds + (kb & 1) * 32768;
    const unsigned char* Qs = Ps + 16384;
    bf16x8 pf[2][4], qf[2][4];
#pragma unroll
    for (int ks = 0; ks < 2; ++ks) {
      const int ch = ks * 4 + g;
#pragma unroll
      for (int mi = 0; mi < 4; ++mi) { const int row = wi * 64 + mi * 16 + lr; pf[ks][mi] = *(const bf16x8*)(Ps + (row >> 1) * 256 + (((((row & 1) << 3) | ch) ^ ((row >> 1) & 7)) << 4)); }
#pragma unroll
      for (int nj = 0; nj < 4; ++nj) { const int row = wj * 64 + nj * 16 + lr; qf[ks][nj] = *(const bf16x8*)(Qs + (row >> 1) * 256 + (((((row & 1) << 3) | ch) ^ ((row >> 1) & 7)) << 4)); }
    }
    __builtin_amdgcn_sched_barrier(0);
    __builtin_amdgcn_s_setprio(1);
#pragma unroll
    for (int ks = 0; ks < 2; ++ks)
#pragma unroll
      for (int mi = 0; mi < 4; ++mi)
#pragma unroll
        for (int nj = 0; nj < 4; ++nj) { if (GEMM_VAR == 2 && gvar) { asm volatile("" :: "v"(pf[ks][mi]), "v"(qf[ks][nj])); } else acc[mi][nj] = mfma16(pf[ks][mi], qf[ks][nj], acc[mi][nj]); }
    __builtin_amdgcn_s_setprio(0);
    __builtin_amdgcn_sched_barrier(0);
    asm volatile("s_waitcnt vmcnt(0)" ::: "memory");
    __syncthreads();
  }
#undef GT_DMA
  if (EPI == 2) {
    float inv[4];
#pragma unroll
    for (int r = 0; r < 4; ++r) inv[r] = __builtin_amdgcn_exp2f(-(float)(4 * g + r) * (13.287712379549449f / 16.f));
#pragma unroll
    for (int nj = 0; nj < 4; ++nj) {
      const int j = jt * 128 + wj * 64 + nj * 16 + lr;
      if (j < TL) {
        const float prow = (float)((j & 2047) >> 6), pcol = (float)(j & 63);
#pragma unroll
        for (int r = 0; r < 4; ++r) {
          const float a1 = prow * inv[r], a2 = pcol * inv[r];
          const float c1 = __cosf(a1), s1 = __sinf(a1), c2 = __cosf(a2), s2 = __sinf(a2);
          const float x1 = acc[0][nj][r], x2 = acc[1][nj][r], y1 = acc[2][nj][r], y2 = acc[3][nj][r];
          acc[0][nj][r] = x1 * c1 - x2 * s1; acc[1][nj][r] = x2 * c1 + x1 * s1;
          acc[2][nj][r] = y1 * c2 - y2 * s2; acc[3][nj][r] = y2 * c2 + y1 * s2;
        }
      }
    }
  }
#pragma unroll
  for (int mi = 0; mi < 4; ++mi)
#pragma unroll
    for (int nj = 0; nj < 4; ++nj) {
      const int j = jt * 128 + wj * 64 + nj * 16 + lr;
      const int i = it * 128 + wi * 64 + mi * 16 + 4 * g;
      const f32x4 a = acc[mi][nj];
      if (EPI == 0 || EPI == 2) {
        u32x2 o = {pk2(a[0], a[1]), pk2(a[2], a[3])};
        *(u32x2*)((bf16_t*)outp + (size_t)j * ld + i) = o;
      } else {
        const int b = j < TL ? (j >> 11) : 16;
        const float4 gt = *(const float4*)(modl + (size_t)b * 6144 + 2 * 1024 + i);
        float4 xv;
        if (xin_lat) {
          const float* xs = (j < TL) ? xin_lat + (size_t)j * 1024 + i : xin_ctx + (size_t)(j - TL) * 1024 + i;
          xv = *(const float4*)xs;
        } else {
          const u32x2 r = *(const u32x2*)((const bf16_t*)outp + (size_t)j * 1024 + i);
          xv = (float4){bflo(r.x), bfhi(r.x), bflo(r.y), bfhi(r.y)};
        }
        u32x2 o = {pk2(xv.x + gt.x * a[0], xv.y + gt.y * a[1]), pk2(xv.z + gt.z * a[2], xv.w + gt.w * a[3])};
        *(u32x2*)((bf16_t*)outp + (size_t)j * 1024 + i) = o;
      }
    }
}

struct TileIter {
  int u, step, total, nf, tpx, x;
  DI void init(int n_tok_tiles, int n_feat_tiles) {
    const int bid = lbid(), nb = lgdim();
    nf = n_feat_tiles;
    if ((nb & 7) == 0 && (n_tok_tiles & 7) == 0) { x = bid & 7; u = bid >> 3; step = nb >> 3; tpx = n_tok_tiles >> 3; }
    else { x = 0; u = bid; step = nb; tpx = n_tok_tiles; }
    total = tpx * nf;
  }
  DI bool valid() const { return u < total; }
  DI void next() { u += step; }
  DI void get(int& tok_tile, int& feat_tile) const {
    const int g = u / (8 * nf), rem = u - g * 8 * nf;
    const int gs = (tpx - 8 * g) < 8 ? (tpx - 8 * g) : 8;
    const int f = rem / gs, tt = rem - f * gs;
    tok_tile = x * tpx + 8 * g + tt; feat_tile = f;
  }
};

DI void phase_gemm_in(const Params& p, int l, unsigned char* lds, bool gvar = false) {
  const bf16_t* W = (const bf16_t*)(p.ws + OFF_WIN) + (size_t)l * 3200 * 1024;
  const bf16_t* H = (const bf16_t*)(p.ws + OFF_H);
  bf16_t* PN = (bf16_t*)(p.ws + OFF_P);
  bf16_t* VT = (bf16_t*)(p.ws + OFF_VT);
  TileIter ti; ti.init(TT / 128, 25);
  for (; ti.valid(); ti.next()) {
    int jt, f; ti.get(jt, f);
    if (f >= 8 && f < 16) gemm_tile<2>(W, H, f, jt, PN, PN_LD, nullptr, nullptr, nullptr, lds, gvar);
    else if (f < 17) gemm_tile<0>(W, H, f, jt, PN, PN_LD, nullptr, nullptr, nullptr, lds, gvar);
    else gemm_tile<0>(H, W + (size_t)2176 * 1024, jt, f - 17, VT, TT, nullptr, nullptr, nullptr, lds, gvar);
  }
}
DI void phase_gemm_out(const Params& p, int l, int ntok, unsigned char* lds) {
  const bf16_t* W = (const bf16_t*)(p.ws + OFF_WOUT) + (size_t)l * 1024 * 1024;
  const bf16_t* Y = (const bf16_t*)(p.ws + OFF_Y);
  bf16_t* xres = (bf16_t*)(p.ws + OFF_XRES);
  const float* modl = (const float*)(p.ws + OFF_MOD) + (size_t)l * 17 * 6144;
  const float* xl = (l == 0) ? p.x : nullptr;
  const float* xc = (l == 0) ? p.ctx : nullptr;
  TileIter ti; ti.init(ntok / 128, 8);
  for (; ti.valid(); ti.next()) {
    int jt, f; ti.get(jt, f);
    gemm_tile<1>(W, Y, f, jt, xres, 1024, xl, xc, modl, lds);
  }
}
DI void phase_gemm_q(const Params& p, int l, int ntok, unsigned char* lds) {
  const bf16_t* W = (const bf16_t*)(p.ws + OFF_WQ) + (size_t)l * 1024 * 1024;
  const bf16_t* H = (const bf16_t*)(p.ws + OFF_H);
  bf16_t* QP = (bf16_t*)(p.ws + OFF_QP);
  TileIter ti; ti.init(ntok / 128, 8);
  for (; ti.valid(); ti.next()) {
    int jt, f; ti.get(jt, f);
    gemm_tile<0>(W, H, f, jt, QP, 1024, nullptr, nullptr, nullptr, lds);
  }
}

DI void phase_rope(const Params& p, unsigned char* lds) {
  float2* tab = (float2*)lds;
  for (int e = ltid(); e < 1024; e += 256) {
    const int pos = e >> 4, i = e & 15;
    const float inv = exp2f(-(float)i * (13.287712379549449f / 16.f));
    const float ang = (float)pos * inv;
    tab[e] = make_float2(__cosf(ang), __sinf(ang));
  }
  __syncthreads();
  bf16_t* PN = (bf16_t*)(p.ws + OFF_P);
  const int total = TL * 16;
  for (int idx = lbid() * 256 + ltid(); idx < total; idx += lgdim() * 256) {
    const int t = idx >> 4, vec = idx & 15;
    const int col = ((vec >> 3) ? C_DK : C_DQ) + ((vec >> 1) & 3) * 128 + (vec & 1) * 64;
    bf16_t* ptr = PN + (size_t)t * PN_LD + col;
    float xv[64];
#pragma unroll
    for (int q = 0; q < 8; ++q) { const u32x4 v = *(const u32x4*)(ptr + q * 8); unpack8(v, xv + q * 8); }
    const int row = (t & 2047) >> 6, cp = t & 63;
#pragma unroll
    for (int i = 0; i < 16; ++i) {
      const float2 cs = tab[row * 16 + i];
      const float x1 = xv[i], x2 = xv[16 + i];
      xv[i] = x1 * cs.x - x2 * cs.y; xv[16 + i] = x2 * cs.x + x1 * cs.y;
      const float2 cs2 = tab[cp * 16 + i];
      const float y1 = xv[32 + i], y2 = xv[48 + i];
      xv[32 + i] = y1 * cs2.x - y2 * cs2.y; xv[48 + i] = y2 * cs2.x + y1 * cs2.y;
    }
#pragma unroll
    for (int q = 0; q < 8; ++q) {
      u32x4 o = {pk2(xv[q * 8], xv[q * 8 + 1]), pk2(xv[q * 8 + 2], xv[q * 8 + 3]), pk2(xv[q * 8 + 4], xv[q * 8 + 5]), pk2(xv[q * 8 + 6], xv[q * 8 + 7])};
      *(u32x4*)(ptr + q * 8) = o;
    }
  }
}

struct SrcSeg {
  const bf16_t* PN; const bf16_t* VT; int kcol, vrow, t0, n0, t1, n1, lr, g;
  DI int nsteps() const { return n0 + n1; }
  DI int tok0(int st) const { return st < n0 ? t0 + st * 32 : t1 + (st - n0) * 32; }
  DI float score(float raw, int st, int kt, int r) const { return raw * SC_LOG2; }
};
struct SrcNat {
  const bf16_t* PN; const bf16_t* VT; int kcol, vrow, b, rq, rs, cs, qc, cstart, lr, g;
  const float* rpbh;
  DI int nsteps() const { return 16; }
  DI int tok0(int st) const { return st < 8 ? b * 2048 + (rs + st) * 64 + cs : TL + b * 256 + (st - 8) * 32; }
  DI float score(float raw, int st, int kt, int r) const {
    if (st >= 8) return raw * SC_LOG2;
    const int kc = cs + 8 * g + 4 * kt + r;
    const bool valid = (kc >= cstart) && (kc < cstart + 16);
    int dc = kc - qc + 15; dc = dc < 0 ? 0 : (dc > 30 ? 30 : dc);
    const float bias = rpbh[(rs + st - rq + 7) * 31 + dc];
    return valid ? (raw * 0.125f + bias) * LOG2E : NEG_BIG;
  }
};

template <class Src>
struct FlashFrags { bf16x8 k[2][2]; bf16x8 v[4]; };
template <class Src>
DI void flash_load(const Src& S, int st, FlashFrags<Src>& F) {
  const int tk = S.tok0(st);
  const int kap = 8 * (S.lr >> 2) + (S.lr & 3);
  const bf16_t* k0p = S.PN + (size_t)(tk + kap) * PN_LD + S.kcol + 8 * S.g;
  const bf16_t* vp = S.VT + (size_t)(S.vrow + S.lr) * TT + tk + 8 * S.g;
#pragma unroll
  for (int kt = 0; kt < 2; ++kt)
#pragma unroll
    for (int ks = 0; ks < 2; ++ks) F.k[kt][ks] = *(const bf16x8*)(k0p + (size_t)kt * 4 * PN_LD + ks * 32);
#pragma unroll
  for (int dt = 0; dt < 4; ++dt) F.v[dt] = *(const bf16x8*)(vp + (size_t)dt * 16 * TT);
}
template <class Src>
DI void flash_step(const Src& S, int st, const FlashFrags<Src>& F, const bf16x8 (&qf)[2], f32x4 (&o)[4], float& mrun, float& lrun) {
  f32x4 s[2];
#pragma unroll
  for (int kt = 0; kt < 2; ++kt) {
    s[kt] = (f32x4){0.f, 0.f, 0.f, 0.f};
#pragma unroll
    for (int ks = 0; ks < 2; ++ks) s[kt] = mfma16(F.k[kt][ks], qf[ks], s[kt]);
  }
  float mt = NEG_BIG;
#pragma unroll
  for (int kt = 0; kt < 2; ++kt)
#pragma unroll
    for (int r = 0; r < 4; ++r) { s[kt][r] = S.score(s[kt][r], st, kt, r); mt = fmaxf(mt, s[kt][r]); }
  mt = rows_max(mt);
  const bool need = mt > mrun + 8.f;
  if (__any(need)) {
    const float mnew = need ? mt : mrun;
    const float alpha = __builtin_amdgcn_exp2f(mrun - mnew);
    lrun *= alpha;
#pragma unroll
    for (int dt = 0; dt < 4; ++dt) { o[dt][0] *= alpha; o[dt][1] *= alpha; o[dt][2] *= alpha; o[dt][3] *= alpha; }
    mrun = mnew;
  }
  float pv[8], ls = 0.f;
#pragma unroll
  for (int kt = 0; kt < 2; ++kt)
#pragma unroll
    for (int r = 0; r < 4; ++r) { pv[kt * 4 + r] = __builtin_amdgcn_exp2f(s[kt][r] - mrun); ls += pv[kt * 4 + r]; }
  lrun += ls;
  u32x4 pk = {pk2(pv[0], pv[1]), pk2(pv[2], pv[3]), pk2(pv[4], pv[5]), pk2(pv[6], pv[7])};
  const bf16x8 pf = __builtin_bit_cast(bf16x8, pk);
#pragma unroll
  for (int dt = 0; dt < 4; ++dt) o[dt] = mfma16(F.v[dt], pf, o[dt]);
}
template <class Src>
DI void flash_wave(const Src& S, const bf16_t* qptr  , f32x4 (&o)[4], float& ltot) {
  bf16x8 qf[2];
  qf[0] = *(const bf16x8*)(qptr); qf[1] = *(const bf16x8*)(qptr + 32);
  float mrun = NEG_BIG, lrun = 0.f;
#pragma unroll
  for (int dt = 0; dt < 4; ++dt) o[dt] = (f32x4){0.f, 0.f, 0.f, 0.f};
  const int ns = S.nsteps();
  FlashFrags<Src> f0, f1, f2;
  flash_load(S, 0, f0);
  if (ns > 1) flash_load(S, 1, f1);
  for (int st = 0; st < ns; st += 3) {
    if (st + 2 < ns) flash_load(S, st + 2, f2);
    flash_step(S, st, f0, qf, o, mrun, lrun);
    if (st + 1 < ns) {
      if (st + 3 < ns) flash_load(S, st + 3, f0);
      flash_step(S, st + 1, f1, qf, o, mrun, lrun);
    }
    if (st + 2 < ns) {
      if (st + 4 < ns) flash_load(S, st + 4, f1);
      flash_step(S, st + 2, f2, qf, o, mrun, lrun);
    }
  }
  ltot = rows_sum(lrun);
}

DI void nat_wave_task(const Params& p, int l, int b, int head, int rq, int ct, const float* rpb_lds) {
  const int lane = ltid() & 63, lr = lane & 15, g = lane >> 4;
  const bf16_t* PN = (const bf16_t*)(p.ws + OFF_P);
  const bf16_t* VT = (const bf16_t*)(p.ws + OFF_VT);
  bf16_t* Y = (bf16_t*)(p.ws + OFF_Y);
  SrcNat S;
  S.PN = PN; S.VT = VT; S.kcol = C_NK + head * 64; S.vrow = R_NV + head * 64; S.b = b; S.rq = rq; S.lr = lr; S.g = g;
  int rs = rq - 4; rs = rs < 0 ? 0 : (rs > 24 ? 24 : rs);
  S.rs = rs;
  int cs = 16 * ct - 8; cs = cs < 0 ? 0 : (cs > 32 ? 32 : cs);
  S.cs = cs;
  S.qc = 16 * ct + lr;
  int cst = S.qc - 8; cst = cst < 0 ? 0 : (cst > 48 ? 48 : cst);
  S.cstart = cst;
  S.rpbh = rpb_lds + head * 465;
  f32x4 o[4];
  float lt;
  const int qtok = b * 2048 + rq * 64 + 16 * ct + lr;
  flash_wave<SrcNat>(S, PN + (size_t)qtok * PN_LD + C_NQ + head * 64 + 8 * g, o, lt);
  const float inv = 1.f / lt;
#pragma unroll
  for (int dt = 0; dt < 4; ++dt) {
    u32x2 ov = {pk2(o[dt][0] * inv, o[dt][1] * inv), pk2(o[dt][2] * inv, o[dt][3] * inv)};
    *(u32x2*)(Y + (size_t)qtok * 1024 + 256 + head * 64 + dt * 16 + 4 * g) = ov;
  }
}
DI void natctx_wave_task(const Params& p, int b, int head, int qt) {
  const int lane = ltid() & 63, lr = lane & 15, g = lane >> 4;
  const bf16_t* PN = (const bf16_t*)(p.ws + OFF_P);
  const bf16_t* VT = (const bf16_t*)(p.ws + OFF_VT);
  bf16_t* Y = (bf16_t*)(p.ws + OFF_Y);
  SrcSeg S;
  S.PN = PN; S.VT = VT; S.kcol = C_NK + head * 64; S.vrow = R_NV + head * 64; S.lr = lr; S.g = g;
  S.t0 = TL + b * 256; S.n0 = 8; S.t1 = 0; S.n1 = 0;
  f32x4 o[4];
  float lt;
  const int qtok = TL + b * 256 + qt * 16 + lr;
  flash_wave<SrcSeg>(S, PN + (size_t)qtok * PN_LD + C_NQ + head * 64 + 8 * g, o, lt);
  const float inv = 1.f / lt;
#pragma unroll
  for (int dt = 0; dt < 4; ++dt) {
    u32x2 ov = {pk2(o[dt][0] * inv, o[dt][1] * inv), pk2(o[dt][2] * inv, o[dt][3] * inv)};
    *(u32x2*)(Y + (size_t)qtok * 1024 + 256 + head * 64 + dt * 16 + 4 * g) = ov;
  }
}

DI void diff_block_task(const Params& p, int l, int b, int hd, int qtok0, int nsteps, unsigned char* lds, int dvar = 0) {
  const int tid = ltid(), lane = tid & 63, w = tid >> 6, lr = lane & 15, g = lane >> 4;
  unsigned char* Kb = lds;
  unsigned char* Vb = lds + 8192;
  const bf16_t* PN = (const bf16_t*)(p.ws + OFF_P);
  const bf16_t* VT = (const bf16_t*)(p.ws + OFF_VT);
  bf16_t* Y = (bf16_t*)(p.ws + OFF_Y);
  bf16x8 qf[2][2][2];
#pragma unroll
  for (int qt = 0; qt < 2; ++qt) {
    const bf16_t* qp = PN + (size_t)(qtok0 + 32 * w + 16 * qt + lr) * PN_LD + C_DQ + hd * 128 + 8 * g;
#pragma unroll
    for (int m = 0; m < 2; ++m)
#pragma unroll
      for (int ks = 0; ks < 2; ++ks) {
        const u32x4 raw = *(const u32x4*)(qp + m * 64 + ks * 32);
        float f[8];
        unpack8(raw, f);
        u32x4 sc = {pk2(f[0] * SC_LOG2, f[1] * SC_LOG2), pk2(f[2] * SC_LOG2, f[3] * SC_LOG2), pk2(f[4] * SC_LOG2, f[5] * SC_LOG2), pk2(f[6] * SC_LOG2, f[7] * SC_LOG2)};
        qf[m][qt][ks] = __builtin_bit_cast(bf16x8, sc);
      }
  }
  const int wu = __builtin_amdgcn_readfirstlane(w);
  unsigned kofs[2], vofs[2];
#pragma unroll
  for (int jj = 0; jj < 2; ++jj) {
    const int krow = 4 * (2 * w + jj) + (lane >> 4), kpc = lane & 15;
    const int kch = kpc ^ (((krow >> 3) & 3) * 4 + (krow & 3));
    kofs[jj] = (unsigned)(krow * PN_LD + C_DK + hd * 128 + kch * 8);
    const int vrow = 16 * (2 * w + jj) + (lane >> 2), vpc = lane & 3;
    const int vch = vpc ^ ((vrow >> 2) & 3);
    vofs[jj] = (unsigned)((R_DV + hd * 128 + vrow) * TT + vch * 8);
  }
#define DB_DMA(st, sl) do { const int tk = (st) < 8 ? TL + b * 256 + (st) * 32 : b * 2048 + ((st) - 8) * 32; \
    const bf16_t* kb_ = PN + (size_t)tk * PN_LD; const bf16_t* vb_ = VT + tk; \
    _Pragma("unroll") for (int jj = 0; jj < 2; ++jj) { \
      __builtin_amdgcn_global_load_lds((const unsigned*)(kb_ + kofs[jj]), (unsigned*)(Kb + (sl) * 16384 + (2 * wu + jj) * 1024), 16, 0, 0); \
      __builtin_amdgcn_global_load_lds((const unsigned*)(vb_ + vofs[jj]), (unsigned*)(Vb + (sl) * 16384 + (2 * wu + jj) * 1024), 16, 0, 0); } } while (0)
  asm volatile("s_waitcnt vmcnt(0)" ::: "memory");
  __syncthreads();
  DB_DMA(0, 0);
  DB_DMA(nsteps > 1 ? 1 : 0, 1);
  DB_DMA(nsteps > 2 ? 2 : nsteps - 1, 2);
  asm volatile("s_waitcnt vmcnt(8)" ::: "memory");
  __builtin_amdgcn_s_barrier();

  f32x4 o[2][2][8];
  float mrun[2][2], lrun[2][2];
#pragma unroll
  for (int m = 0; m < 2; ++m)
#pragma unroll
    for (int qt = 0; qt < 2; ++qt) {
      mrun[m][qt] = NEG_BIG; lrun[m][qt] = 0.f;
#pragma unroll
      for (int dt = 0; dt < 8; ++dt) o[m][qt][dt] = (f32x4){0.f, 0.f, 0.f, 0.f};
    }
  const int kfr = 8 * (lr >> 2) + (lr & 3);
  for (int st = 0; st < nsteps; ++st) {
    if (dvar != 1) { const int sn = st + 3 < nsteps ? st + 3 : nsteps - 1; DB_DMA(sn, (st + 3) & 3); }
    const unsigned char* Kt = Kb + (st & 3) * 16384;
    const unsigned char* Vt = Vb + (st & 3) * 16384;
    bf16x8 pf[2][2];
#pragma unroll
    for (int m = 0; m < 2; ++m) {
      bf16x8 kf[2][2];
#pragma unroll
      for (int kt = 0; kt < 2; ++kt)
#pragma unroll
        for (int ks = 0; ks < 2; ++ks) kf[kt][ks] = *(const bf16x8*)(Kt + (kfr + 4 * kt) * 256 + (((m * 8 + ks * 4 + g) ^ lr) << 4));
      __builtin_amdgcn_sched_barrier(0);
      f32x4 s[2][2];
#pragma unroll
      for (int qt = 0; qt < 2; ++qt)
#pragma unroll
        for (int kt = 0; kt < 2; ++kt) {
          s[qt][kt] = (f32x4){0.f, 0.f, 0.f, 0.f};
#pragma unroll
          for (int ks = 0; ks < 2; ++ks) s[qt][kt] = mfma16(kf[kt][ks], qf[m][qt][ks], s[qt][kt]);
        }
      __builtin_amdgcn_sched_barrier(0);
#pragma unroll
      for (int qt = 0; qt < 2; ++qt) {
        if (dvar == 2) {
          u32x4 pk = {pk2(s[qt][0][0], s[qt][0][1]), pk2(s[qt][0][2], s[qt][0][3]), pk2(s[qt][1][0], s[qt][1][1]), pk2(s[qt][1][2], s[qt][1][3])};
          pf[m][qt] = __builtin_bit_cast(bf16x8, pk);
          continue;
        }
        float mt = NEG_BIG;
#pragma unroll
        for (int kt = 0; kt < 2; ++kt)
#pragma unroll
          for (int r = 0; r < 4; ++r) mt = fmaxf(mt, s[qt][kt][r]);
        mt = rows_max(mt);
        const bool need = mt > mrun[m][qt] + 8.f;
        if (__any(need)) {
          const float mnew = need ? mt : mrun[m][qt];
          const float alpha = __builtin_amdgcn_exp2f(mrun[m][qt] - mnew);
          lrun[m][qt] *= alpha;
#pragma unroll
          for (int dt = 0; dt < 8; ++dt) { o[m][qt][dt][0] *= alpha; o[m][qt][dt][1] *= alpha; o[m][qt][dt][2] *= alpha; o[m][qt][dt][3] *= alpha; }
          mrun[m][qt] = mnew;
        }
        float pv[8], ls = 0.f;
#pragma unroll
        for (int kt = 0; kt < 2; ++kt)
#pragma unroll
          for (int r = 0; r < 4; ++r) { pv[kt * 4 + r] = __builtin_amdgcn_exp2f(s[qt][kt][r] - mrun[m][qt]); ls += pv[kt * 4 + r]; }
        lrun[m][qt] += ls;
        u32x4 pk = {pk2(pv[0], pv[1]), pk2(pv[2], pv[3]), pk2(pv[4], pv[5]), pk2(pv[6], pv[7])};
        pf[m][qt] = __builtin_bit_cast(bf16x8, pk);
      }
      __builtin_amdgcn_sched_barrier(0);
    }
#pragma unroll
    for (int hb = 0; hb < 2; ++hb) {
      bf16x8 vf[4];
#pragma unroll
      for (int d4 = 0; d4 < 4; ++d4) {
        const int vr = 16 * (4 * hb + d4) + lr;
        vf[d4] = *(const bf16x8*)(Vt + vr * 64 + ((g ^ ((vr >> 2) & 3)) << 4));
      }
      __builtin_amdgcn_sched_barrier(0);
#pragma unroll
      for (int d4 = 0; d4 < 4; ++d4)
#pragma unroll
        for (int m = 0; m < 2; ++m)
#pragma unroll
          for (int qt = 0; qt < 2; ++qt) { if (dvar == 3) asm volatile("" :: "v"(vf[d4]), "v"(pf[m][qt])); else o[m][qt][4 * hb + d4] = mfma16(vf[d4], pf[m][qt], o[m][qt][4 * hb + d4]); }
      __builtin_amdgcn_sched_barrier(0);
    }
    asm volatile("s_waitcnt vmcnt(8)" ::: "memory");
    __builtin_amdgcn_s_barrier();
  }
  asm volatile("s_waitcnt vmcnt(0)" ::: "memory");
#undef DB_DMA
  const float* lv = p.dlam + l * 256;
  float sa = lv[lane] * lv[64 + lane], sb = lv[128 + lane] * lv[192 + lane];
  sa = wave_sum(sa); sb = wave_sum(sb);
  const float lam_init = 0.8f - 0.6f * expf(-0.3f * (float)l);
  const float lam = expf(sa) - expf(sb) + lam_init;
  const float* dg = p.diff_g + l * 512 + hd * 128;
#pragma unroll
  for (int qt = 0; qt < 2; ++qt) {
    float l0 = lrun[0][qt], l1 = lrun[1][qt];
    l0 = rows_sum(l0);
    l1 = rows_sum(l1);
    const float i0 = 1.f / l0, i1 = lam / l1;
    float ss = 0.f;
#pragma unroll
    for (int dt = 0; dt < 8; ++dt)
#pragma unroll
      for (int r = 0; r < 4; ++r) { const float v = o[0][qt][dt][r] * i0 - o[1][qt][dt][r] * i1; o[0][qt][dt][r] = v; ss += v * v; }
    ss = rows_sum(ss);
    const float rstd = rsqrtf(ss * (1.f / 128.f) + 1e-6f) * (1.f - lam_init);
    const int qtok = qtok0 + 32 * w + 16 * qt + lr;
#pragma unroll
    for (int dt = 0; dt < 8; ++dt) {
      const float4 gg = *(const float4*)(dg + dt * 16 + 4 * g);
      u32x2 ov = {pk2(o[0][qt][dt][0] * rstd * gg.x, o[0][qt][dt][1] * rstd * gg.y), pk2(o[0][qt][dt][2] * rstd * gg.z, o[0][qt][dt][3] * rstd * gg.w)};
      *(u32x2*)(Y + (size_t)qtok * 1024 + 512 + hd * 128 + dt * 16 + 4 * g) = ov;
    }
  }
}


DI void nat_block_task(const Params& p, int l, int b, int head, int rq, const float* rpb_lds, unsigned char* lds) {
  const int tid = ltid(), lane = tid & 63, w = tid >> 6, lr = lane & 15, g = lane >> 4;
  const int wu = __builtin_amdgcn_readfirstlane(w);
  unsigned char* Kb = lds;
  unsigned char* Vb = lds + 8192;
  const bf16_t* PN = (const bf16_t*)(p.ws + OFF_P);
  const bf16_t* VT = (const bf16_t*)(p.ws + OFF_VT);
  bf16_t* Y = (bf16_t*)(p.ws + OFF_Y);
  int rs = rq - 4; rs = rs < 0 ? 0 : (rs > 24 ? 24 : rs);
  const int ct = w;
  int cs = 16 * ct - 8; cs = cs < 0 ? 0 : (cs > 32 ? 32 : cs);
  const int qc = 16 * ct + lr;
  int cstart = qc - 8; cstart = cstart < 0 ? 0 : (cstart > 48 ? 48 : cstart);
  const float* rpbh = rpb_lds + head * 465;
  const int qtok = b * 2048 + rq * 64 + qc;
  bf16x8 qf[2];
  { const bf16_t* qp = PN + (size_t)qtok * PN_LD + C_NQ + head * 64 + 8 * g; qf[0] = *(const bf16x8*)qp; qf[1] = *(const bf16x8*)(qp + 32); }
  unsigned kofs[2], vofs[2];
#pragma unroll
  for (int jj = 0; jj < 2; ++jj) {
    const int pidx = 2 * w + jj, row = 8 * pidx + (lane >> 3);
    const int kch = (lane & 7) ^ ((((row >> 3) & 3) << 1) | ((row >> 1) & 1));
    kofs[jj] = (unsigned)(row * PN_LD + C_NK + head * 64 + kch * 8);
    const int vch = (lane & 7) ^ ((row >> 1) & 7);
    vofs[jj] = (unsigned)((R_NV + head * 64 + row) * TT + vch * 8);
  }
#define NB_DMA(st, bf) do { const int tk = (st) < 8 ? b * 2048 + (rs + (st)) * 64 : TL + b * 256 + ((st) - 8) * 64; \
    const bf16_t* kb_ = PN + (size_t)tk * PN_LD; const bf16_t* vb_ = VT + tk; \
    _Pragma("unroll") for (int jj = 0; jj < 2; ++jj) { \
      __builtin_amdgcn_global_load_lds((const unsigned*)(kb_ + kofs[jj]), (unsigned*)(Kb + (bf) * 16384 + (2 * wu + jj) * 1024), 16, 0, 0); \
      __builtin_amdgcn_global_load_lds((const unsigned*)(vb_ + vofs[jj]), (unsigned*)(Vb + (bf) * 16384 + (2 * wu + jj) * 1024), 16, 0, 0); } } while (0)
  asm volatile("s_waitcnt vmcnt(0)" ::: "memory");
  __syncthreads();
  NB_DMA(0, 0); NB_DMA(1, 1); NB_DMA(2, 2);
  asm volatile("s_waitcnt vmcnt(8)" ::: "memory");
  __builtin_amdgcn_s_barrier();
  f32x4 o[4];
#pragma unroll
  for (int dt = 0; dt < 4; ++dt) o[dt] = (f32x4){0.f, 0.f, 0.f, 0.f};
  float mrun = NEG_BIG, lrun = 0.f;
  const int kap = 8 * (lr >> 2) + (lr & 3);
  for (int st = 0; st < 12; ++st) {
    { const int sn = st + 3 < 12 ? st + 3 : 11; NB_DMA(sn, (st + 3) & 3); }
    const unsigned char* Kt = Kb + (st & 3) * 16384;
    const unsigned char* Vt = Vb + (st & 3) * 16384;
    const int nsub = st < 8 ? 1 : 2;
    for (int sub = 0; sub < nsub; ++sub) {
      const int koff = st < 8 ? cs : 32 * sub;
      bf16x8 kf[2][2], vf[4];
#pragma unroll
      for (int kt = 0; kt < 2; ++kt) {
        const int row = koff + kap + 4 * kt;
        const int sw = (((row >> 3) & 3) << 1) | ((row >> 1) & 1);
#pragma unroll
        for (int ks = 0; ks < 2; ++ks) kf[kt][ks] = *(const bf16x8*)(Kt + (row >> 1) * 256 + ((((row & 1) << 3) | ((ks * 4 + g) ^ sw)) << 4));
      }
#pragma unroll
      for (int dt = 0; dt < 4; ++dt) {
        const int row = 16 * dt + lr, ch = (koff >> 3) + g;
        vf[dt] = *(const bf16x8*)(Vt + (row >> 1) * 256 + (((((row & 1) << 3) | ch) ^ ((row >> 1) & 7)) << 4));
      }
      f32x4 s[2];
#pragma unroll
      for (int kt = 0; kt < 2; ++kt) {
        s[kt] = (f32x4){0.f, 0.f, 0.f, 0.f};
#pragma unroll
        for (int ks = 0; ks < 2; ++ks) s[kt] = mfma16(kf[kt][ks], qf[ks], s[kt]);
      }
      float mt = NEG_BIG;
#pragma unroll
      for (int kt = 0; kt < 2; ++kt)
#pragma unroll
        for (int r = 0; r < 4; ++r) {
          float sv;
          if (st < 8) {
            const int kc = cs + 8 * g + 4 * kt + r;
            const bool valid = (kc >= cstart) && (kc < cstart + 16);
            int dc = kc - qc + 15; dc = dc < 0 ? 0 : (dc > 30 ? 30 : dc);
            const float bias = rpbh[(rs + st - rq + 7) * 31 + dc];
            sv = valid ? (s[kt][r] * 0.125f + bias) * LOG2E : NEG_BIG;
          } else sv = s[kt][r] * SC_LOG2;
          s[kt][r] = sv; mt = fmaxf(mt, sv);
        }
      mt = rows_max(mt);
      const bool need = mt > mrun + 8.f;
      if (__any(need)) {
        const float mnew = need ? mt : mrun;
        const float alpha = __builtin_amdgcn_exp2f(mrun - mnew);
        lrun *= alpha;
#pragma unroll
        for (int dt = 0; dt < 4; ++dt) { o[dt][0] *= alpha; o[dt][1] *= alpha; o[dt][2] *= alpha; o[dt][3] *= alpha; }
        mrun = mnew;
      }
      float pv[8], ls = 0.f;
#pragma unroll
      for (int kt = 0; kt < 2; ++kt)
#pragma unroll
        for (int r = 0; r < 4; ++r) { pv[kt * 4 + r] = __builtin_amdgcn_exp2f(s[kt][r] - mrun); ls += pv[kt * 4 + r]; }
      lrun += ls;
      u32x4 pk = {pk2(pv[0], pv[1]), pk2(pv[2], pv[3]), pk2(pv[4], pv[5]), pk2(pv[6], pv[7])};
      const bf16x8 pf = __builtin_bit_cast(bf16x8, pk);
#pragma unroll
      for (int dt = 0; dt < 4; ++dt) o[dt] = mfma16(vf[dt], pf, o[dt]);
    }
    asm volatile("s_waitcnt vmcnt(8)" ::: "memory");
    __builtin_amdgcn_s_barrier();
  }
  asm volatile("s_waitcnt vmcnt(0)" ::: "memory");
#undef NB_DMA
  const float inv = 1.f / rows_sum(lrun);
#pragma unroll
  for (int dt = 0; dt < 4; ++dt) {
    u32x2 ov = {pk2(o[dt][0] * inv, o[dt][1] * inv), pk2(o[dt][2] * inv, o[dt][3] * inv)};
    *(u32x2*)(Y + (size_t)qtok * 1024 + 256 + head * 64 + dt * 16 + 4 * g) = ov;
  }
}

DI float quad_sum(float v) {
  v += __int_as_float(__builtin_amdgcn_mov_dpp(__float_as_int(v), 0xB1, 0xF, 0xF, true));
  v += __int_as_float(__builtin_amdgcn_mov_dpp(__float_as_int(v), 0x4E, 0xF, 0xF, true));
  return v;
}
DI void gla_task(const Params& p, int l, int task, unsigned char* lds, int var = 0) {
  const int tid = ltid(), lane = tid & 63, w = tid >> 6, vv = lane >> 2, g = lane & 3;
  const int b = task >> 3, h = (task >> 1) & 3, dir = task & 1;
  const bf16_t* PN = (const bf16_t*)(p.ws + OFF_P);
  const bf16_t* VT = (const bf16_t*)(p.ws + OFF_VT);
  float* og = (float*)(p.ws + OFF_H);
  float* Gup = (float*)lds;
  float* Gb = Gup + 512;
  float* As = Gb + 32;
  float* Ks = As + 2048;
  float* Qs = Ks + 2048;
  float* Vs = Qs + 2048;
  __syncthreads();
  for (int e = tid; e < 512; e += 256) { const int r = e >> 5, kd = e & 31; Gup[e] = p.gate_up[((size_t)(l * 2 + dir) * 16 + r) * 128 + h * 32 + kd]; }
  if (tid < 32) Gb[tid] = p.gate_b[(l * 2 + dir) * 128 + h * 32 + tid];
  float S[8];
#pragma unroll
  for (int e = 0; e < 8; ++e) S[e] = 0.f;
  const int si = tid >> 2, part = tid & 3;
  u32x4 rq, rk, rg0, rg1, rv0, rv1;
#define GLA_TOK0(cc) ((cc) < 4 ? TL + b * 256 + (dir == 0 ? (cc) : 3 - (cc)) * 64 : b * 2048 + (dir == 0 ? (cc) - 4 : 35 - (cc)) * 64)
#define GLA_LOAD(cc) do { const int t0_ = GLA_TOK0(cc); const bf16_t* row = PN + (size_t)(t0_ + si) * PN_LD; \
    rq = *(const u32x4*)(row + C_GQ + h * 32 + part * 8); rk = *(const u32x4*)(row + C_GK + h * 32 + part * 8); \
    rg0 = *(const u32x4*)(row + C_GATE + dir * 16); rg1 = *(const u32x4*)(row + C_GATE + dir * 16 + 8); \
    const bf16_t* vp = VT + (size_t)(R_GV + h * 64 + si) * TT + t0_ + part * 16; rv0 = *(const u32x4*)vp; rv1 = *(const u32x4*)(vp + 8); } while (0)
#define GLA_WRITE() do { float gd[16], qf[8], kf[8], vf[16]; \
    unpack8(rg0, gd); unpack8(rg1, gd + 8); unpack8(rq, qf); unpack8(rk, kf); unpack8(rv0, vf); unpack8(rv1, vf + 8); \
    _Pragma("unroll") for (int e = 0; e < 8; ++e) { const int kd = part * 8 + e; float pre = Gb[kd]; \
      _Pragma("unroll") for (int r = 0; r < 16; ++r) pre += gd[r] * Gup[r * 32 + kd]; \
      const float ls = fminf(pre, 0.f) - log1pf(__expf(-fabsf(pre))); \
      As[si * 32 + kd] = __expf(ls * (1.f / 16.f)); Ks[si * 32 + kd] = kf[e]; Qs[si * 32 + kd] = qf[e] * 0.17677669529663687f; } \
    _Pragma("unroll") for (int e = 0; e < 16; ++e) Vs[(part * 16 + e) * 65 + si] = vf[e]; } while (0)
  GLA_LOAD(0);
  __syncthreads();
  GLA_WRITE();
  __syncthreads();
  for (int cc = 0; cc < 36; ++cc) {
    const int tok0 = GLA_TOK0(cc);
    if (cc + 1 < 36) GLA_LOAD(cc + 1);
    float* ob = og + ((size_t)dir * TT + tok0) * 256 + h * 64 + 16 * w + vv;
#pragma unroll 1
    for (int s0 = 0; s0 < (var == 3 ? 4 : 64); s0 += 4) {
      float4 a0[4], a1[4], k0[4], k1[4], q0[4], q1[4];
      float vx[4];
#pragma unroll
      for (int u = 0; u < 4; ++u) {
        const int i = dir == 0 ? s0 + u : 63 - s0 - u;
        a0[u] = *(const float4*)(As + i * 32 + 8 * g); a1[u] = *(const float4*)(As + i * 32 + 8 * g + 4);
        k0[u] = *(const float4*)(Ks + i * 32 + 8 * g); k1[u] = *(const float4*)(Ks + i * 32 + 8 * g + 4);
        q0[u] = *(const float4*)(Qs + i * 32 + 8 * g); q1[u] = *(const float4*)(Qs + i * 32 + 8 * g + 4);
        vx[u] = Vs[i * 65 + 16 * w + vv];
      }
#pragma unroll
      for (int u = 0; u < 4; ++u) {
        const int i = dir == 0 ? s0 + u : 63 - s0 - u;
        const float v = vx[u];
        S[0] = fmaf(a0[u].x, S[0], k0[u].x * v); S[1] = fmaf(a0[u].y, S[1], k0[u].y * v);
        S[2] = fmaf(a0[u].z, S[2], k0[u].z * v); S[3] = fmaf(a0[u].w, S[3], k0[u].w * v);
        S[4] = fmaf(a1[u].x, S[4], k1[u].x * v); S[5] = fmaf(a1[u].y, S[5], k1[u].y * v);
        S[6] = fmaf(a1[u].z, S[6], k1[u].z * v); S[7] = fmaf(a1[u].w, S[7], k1[u].w * v);
        const float oa = fmaf(q0[u].x, S[0], q0[u].y * S[1]), ob2 = fmaf(q0[u].z, S[2], q0[u].w * S[3]);
        const float oc = fmaf(q1[u].x, S[4], q1[u].y * S[5]), od = fmaf(q1[u].z, S[6], q1[u].w * S[7]);
        float o = (oa + ob2) + (oc + od);
        o = quad_sum(o);
        if (var == 1) asm volatile("" :: "v"(o)); else if (g == 0) ob[(size_t)i * 256] = o;
      }
    }
    __syncthreads();
    if (cc + 1 < 36 && var != 2) GLA_WRITE();
    __syncthreads();
  }
#undef GLA_TOK0
#undef GLA_LOAD
#undef GLA_WRITE
}

DI void phase_mixers(const Params& p, int l, bool last, unsigned* ctr, unsigned char* lds, int mask = 15, int gvar = 0) {
  const int tid = ltid(), w = tid >> 6;
  volatile int* slot = (volatile int*)(lds + LDS_BYTES - 16);
  float* rpb_lds = (float*)(lds + 65536);
  for (int e = tid; e < 4 * 465; e += 256) rpb_lds[e] = p.rpb[(size_t)l * 4 * 465 + e];
  const int nconv = (l == 0 && (mask & 8)) ? 1024 : 0;
  const int t1 = 128 + nconv, t2 = t1 + 1024, t3 = t2 + 2048, t4 = t3 + 128;
  const int ntask = last ? t3 : t4 + 256;
  for (;;) {
    __syncthreads();
    if (tid == 0) *slot = (int)atomicAdd(ctr, 1u);
    __syncthreads();
    const int task = *slot;
    if (task >= ntask) break;
    if (task < 128) { if (mask & 1) { __builtin_amdgcn_s_setprio(3); gla_task(p, l, task, lds, gvar); __builtin_amdgcn_s_setprio(0); } }
    else if (nconv && task < t2 && ((task - 128) & 1)) { const int c = (task - 128) >> 1; convert_table_pairs(p, c * 64, c * 64 + 64, w, 4, tid & 63); }
    else if (!(mask & 2) && (task < t2 || (task >= t3 && task < t4))) {}
    else if (!(mask & 4) && ((task >= t2 && task < t3) || task >= t4)) {}
    else if (task < t2) { const int d = nconv ? (task - 128) >> 1 : task - 128; const int b = d >> 6; diff_block_task(p, l, b, (d >> 4) & 3, b * 2048 + (d & 15) * 128, 72, lds, gvar); }
    else if (task < t3) { const int d = task - t2; nat_block_task(p, l, d >> 7, (d >> 5) & 3, d & 31, rpb_lds, lds); }
    else if (task < t4) { const int d = task - t3; const int b = d >> 3; diff_block_task(p, l, b, (d >> 1) & 3, TL + b * 256 + (d & 1) * 128, 8, lds); }
    else { const int wt = (task - t4) * 4 + w; natctx_wave_task(p, wt >> 6, (wt >> 4) & 3, wt & 15); }
  }
}

DI void phase_gla_fin(const Params& p, int l, int ntok) {
  const int lane = ltid() & 63, gw = lbid() * 4 + (ltid() >> 6), nw = lgdim() * 4;
  const float* og = (const float*)(p.ws + OFF_H);
  const bf16_t* PN = (const bf16_t*)(p.ws + OFF_P);
  bf16_t* Y = (bf16_t*)(p.ws + OFF_Y);
  const float4 gg = *(const float4*)(p.gla_norm_g + l * 256 + 4 * lane);
  for (int t = gw; t < ntok; t += nw) {
    const float4 a = *(const float4*)(og + (size_t)t * 256 + 4 * lane), bq = *(const float4*)(og + ((size_t)TT + t) * 256 + 4 * lane);
    const float o0 = a.x + bq.x, o1 = a.y + bq.y, o2 = a.z + bq.z, o3 = a.w + bq.w;
    float ss = o0 * o0 + o1 * o1 + o2 * o2 + o3 * o3;
    ss += __shfl_xor(ss, 1); ss += __shfl_xor(ss, 2); ss += __shfl_xor(ss, 4); ss += __shfl_xor(ss, 8);
    const float rstd = rsqrtf(ss * (1.f / 64.f) + 1e-6f);
    const u32x2 rv = *(const u32x2*)(PN + (size_t)t * PN_LD + C_GR + 4 * lane);
    const float r0 = bflo(rv.x), r1 = bfhi(rv.x), r2 = bflo(rv.y), r3 = bfhi(rv.y);
    const float y0 = o0 * rstd * gg.x * (r0 / (1.f + __expf(-r0)));
    const float y1 = o1 * rstd * gg.y * (r1 / (1.f + __expf(-r1)));
    const float y2 = o2 * rstd * gg.z * (r2 / (1.f + __expf(-r2)));
    const float y3 = o3 * rstd * gg.w * (r3 / (1.f + __expf(-r3)));
    u32x2 ov = {pk2(y0, y1), pk2(y2, y3)};
    *(u32x2*)(Y + (size_t)t * 1024 + 4 * lane) = ov;
  }
}


DI void ce_desc(float& a, float& b) {
  float hi, lo;
  asm("v_max_f32 %0, %2, %3\n\tv_min_f32 %1, %2, %3" : "=&v"(hi), "=&v"(lo) : "v"(a), "v"(b));
  a = hi; b = lo;
}
DI float vmaxf(float a, float b) { float r; asm("v_max_f32 %0, %1, %2" : "=v"(r) : "v"(a), "v"(b)); return r; }
template <int N>
DI void bitonic_sort_desc(float (&x)[N]) {
#pragma unroll
  for (int k = 2; k <= N; k <<= 1)
#pragma unroll
    for (int j = k >> 1; j > 0; j >>= 1)
#pragma unroll
      for (int i = 0; i < N; ++i) {
        const int l = i ^ j;
        if (l > i) { if ((i & k) == 0) ce_desc(x[i], x[l]); else ce_desc(x[l], x[i]); }
      }
}
template <int N>
DI void bitonic_merge_desc(float (&x)[N]) {
#pragma unroll
  for (int j = N >> 1; j > 0; j >>= 1)
#pragma unroll
    for (int i = 0; i < N; ++i) { const int l = i ^ j; if (l > i) ce_desc(x[i], x[l]); }
}
DI void rows_merge_top16(float (&L)[16]) {
  {
    float A0[16], A1[16];
#pragma unroll
    for (int i = 0; i < 16; ++i) { const u32x2 s = __builtin_amdgcn_permlane32_swap(__float_as_uint(L[i]), __float_as_uint(L[i]), false, false); A0[i] = __uint_as_float(s[0]); A1[i] = __uint_as_float(s[1]); }
#pragma unroll
    for (int i = 0; i < 16; ++i) L[i] = vmaxf(A0[i], A1[15 - i]);
    bitonic_merge_desc<16>(L);
  }
  {
    float A0[16], A1[16];
#pragma unroll
    for (int i = 0; i < 16; ++i) { const u32x2 s = __builtin_amdgcn_permlane16_swap(__float_as_uint(L[i]), __float_as_uint(L[i]), false, false); A0[i] = __uint_as_float(s[0]); A1[i] = __uint_as_float(s[1]); }
#pragma unroll
    for (int i = 0; i < 16; ++i) L[i] = vmaxf(A0[i], A1[15 - i]);
    bitonic_merge_desc<16>(L);
  }
}

struct PairTab { int a[52], b[52]; };
constexpr PairTab make_pairs() {
  PairTab t{};
  int n = 0;
  for (int a = 0; a < 16; ++a)
    for (int b = 0; b < 16; ++b)
      if ((a + 1) * (b + 1) <= 16) { t.a[n] = a; t.b[n] = b; ++n; }
  for (; n < 52; ++n) { t.a[n] = -1; t.b[n] = -1; }
  return t;
}

DI void topk_half(const bf16_t* skh  , const bf16_t* qrow  , int lr, int g, float (&list)[16]) {
  bf16x8 qf[2];
  qf[0] = *(const bf16x8*)(qrow); qf[1] = *(const bf16x8*)(qrow + 32);
  float s[32];
#pragma unroll
  for (int nt = 0; nt < 8; ++nt) {
    f32x4 acc = {0.f, 0.f, 0.f, 0.f};
#pragma unroll
    for (int ks = 0; ks < 2; ++ks) {
      const bf16x8 af = *(const bf16x8*)(skh + (size_t)(nt * 16 + lr) * 64 + ks * 32 + 8 * g);
      acc = mfma16(af, qf[ks], acc);
    }
#pragma unroll
    for (int r = 0; r < 4; ++r) {
      const unsigned n = nt * 16 + 4 * g + r;
      s[nt * 4 + r] = __uint_as_float((__float_as_uint(acc[r]) & ~127u) | n);
    }
  }
  float a[16], bq[16];
#pragma unroll
  for (int i = 0; i < 16; ++i) { a[i] = s[i]; bq[i] = s[16 + i]; }
  bitonic_sort_desc<16>(a);
  bitonic_sort_desc<16>(bq);
#pragma unroll
  for (int i = 0; i < 16; ++i) list[i] = vmaxf(a[i], bq[15 - i]);
  bitonic_merge_desc<16>(list);
  rows_merge_top16(list);
}

DI void topk_tile(const bf16_t* QP, const bf16_t* sk, int tt, int hd, int* eid_rows, float* gate_rows, int lr, int g) {
  constexpr PairTab PT = make_pairs();
  {
    const int tok = tt * 16 + lr;
    float v1[16], v2[16];
    topk_half(sk, QP + (size_t)tok * 1024 + hd * 128 + 8 * g, lr, g, v1);
    __builtin_amdgcn_sched_barrier(0);
    topk_half(sk + 128 * 64, QP + (size_t)tok * 1024 + hd * 128 + 64 + 8 * g, lr, g, v2);
    __builtin_amdgcn_sched_barrier(0);
    float cand[13];
#pragma unroll
    for (int c = 0; c < 13; ++c) {
      float sv[4];
#pragma unroll
      for (int gi = 0; gi < 4; ++gi) {
        const int pi = 4 * c + gi;
        if (PT.a[pi] >= 0) {
          const float a = v1[PT.a[pi] < 0 ? 0 : PT.a[pi]], bq = v2[PT.b[pi] < 0 ? 0 : PT.b[pi]];
          sv[gi] = __uint_as_float((__float_as_uint(a + bq) & ~255u) | (unsigned)(PT.a[pi] * 16 + PT.b[pi]));
        } else { sv[gi] = -3.0e38f; }
      }
      cand[c] = g == 0 ? sv[0] : (g == 1 ? sv[1] : (g == 2 ? sv[2] : sv[3]));
    }
    float topv[16];
#pragma unroll
    for (int c = 0; c < 13; ++c) topv[c] = cand[c];
    topv[13] = -3.0e38f; topv[14] = -3.1e38f; topv[15] = -3.2e38f;
    bitonic_sort_desc<16>(topv);
    rows_merge_top16(topv);
#pragma unroll
    for (int q = 0; q < 4; ++q) {
      const float wv = g == 0 ? topv[q] : (g == 1 ? topv[4 + q] : (g == 2 ? topv[8 + q] : topv[12 + q]));
      const int ia = (int)((__float_as_uint(wv) >> 4) & 15u), ib = (int)(__float_as_uint(wv) & 15u);
      unsigned e1 = 0, e2 = 0;
#pragma unroll
      for (int c = 0; c < 16; ++c) { if (ia == c) e1 = __float_as_uint(v1[c]) & 127u; if (ib == c) e2 = __float_as_uint(v2[c]) & 127u; }
      eid_rows[lr * 128 + hd * 16 + 4 * g + q] = (int)(e1 * 128u + e2);
    }
    if (g == 0) {
      float ex[16], sum = 0.f;
#pragma unroll
      for (int k = 0; k < 16; ++k) { ex[k] = __expf(topv[k] - topv[0]); sum += ex[k]; }
      const float inv = 1.f / sum;
#pragma unroll
      for (int q = 0; q < 4; ++q) {
        float4 o = {ex[4 * q] * inv, ex[4 * q + 1] * inv, ex[4 * q + 2] * inv, ex[4 * q + 3] * inv};
        *(float4*)(gate_rows + lr * 128 + hd * 16 + 4 * q) = o;
      }
    }
  }
}

DI float gelu_tanh(float x) {
  const float z = 0.7978845608028654f * (x + 0.044715f * x * x * x);
  const float e = __expf(2.f * z);
  const float th = 1.f - 2.f / (e + 1.f);
  return 0.5f * x * (1.f + th);
}
DI void gather_token(const Params& p, int l, int t, const int* eid_row, const float* gate_row, unsigned char* hl, float* wl, bool dry) {
  const int lane = ltid() & 63, lr = lane & 15, g = lane >> 4;
  const unsigned char* U6 = p.ws + OFF_U + (size_t)l * 16384 * U_PITCH;
  const unsigned char* V6 = p.ws + OFF_V + (size_t)l * 16384 * V_PITCH;
  const int half = lane >> 5, blk = lane & 31;
  const unsigned char* H6 = p.ws + OFF_H8;
  bf16_t* xres = (bf16_t*)(p.ws + OFF_XRES);
  const float* modbuf = (const float*)(p.ws + OFF_MOD);
  {
    if (lane < 50) {
      const u32x4 hq = *(const u32x4*)(H6 + (size_t)t * V6_PITCH + lane * 16);
      *(u32x4*)(hl + lane * 16) = hq;
    }
    const int e0 = eid_row[lane], e1 = eid_row[64 + lane];
    const float gv0 = gate_row[lane], gv1 = gate_row[64 + lane];
    {
      const u32x2 hsc = *(const u32x2*)(hl + 768 + 8 * g);
#pragma unroll 1
      for (int grp = 0; grp < 8; ++grp) {
        const int er = __shfl(grp < 4 ? e0 : e1, (grp & 3) * 16 + lr);
        const unsigned char* ur = U6 + (size_t)er * U_PITCH;
        u32x4 ua[8]; u32x2 ub[8];
#pragma unroll
        for (int s = 0; s < 8; ++s) {
          if (U_FP4) { ua[s] = *(const u32x4*)(ur + 16 * (4 * s + g)); ub[s] = (u32x2){0u, 0u}; }
          else { ua[s] = *(const u32x4*)(ur + 24 * (4 * s + g)); ub[s] = *(const u32x2*)(ur + 24 * (4 * s + g) + 16); }
        }
        const u32x2 usc = *(const u32x2*)(ur + (U_FP4 ? 512 : 768) + 8 * g);
        __builtin_amdgcn_sched_barrier(0);
        f32x4 acc = {0.f, 0.f, 0.f, 0.f};
#define G_STEP(s, OS, USC, HSC) do { const unsigned char* hb = hl + 24 * (4 * (s) + g); \
          const u32x2 h0 = *(const u32x2*)hb, h1 = *(const u32x2*)(hb + 8), h2v = *(const u32x2*)(hb + 16); \
          const i32x8 av = {(int)ua[s][0], (int)ua[s][1], (int)ua[s][2], (int)ua[s][3], (int)ub[s][0], (int)ub[s][1], 0, 0}; \
          const i32x8 bv = {(int)h0[0], (int)h0[1], (int)h1[0], (int)h1[1], (int)h2v[0], (int)h2v[1], 0, 0}; \
          acc = __builtin_amdgcn_mfma_scale_f32_16x16x128_f8f6f4(av, bv, acc, U_FP4 ? 4 : 2, 2, OS, (int)(USC), OS, (int)(HSC)); } while (0)
        G_STEP(0, 0, usc[0], hsc[0]); G_STEP(1, 1, usc[0], hsc[0]); G_STEP(2, 2, usc[0], hsc[0]); G_STEP(3, 3, usc[0], hsc[0]);
        G_STEP(4, 0, usc[1], hsc[1]); G_STEP(5, 1, usc[1], hsc[1]); G_STEP(6, 2, usc[1], hsc[1]); G_STEP(7, 3, usc[1], hsc[1]);
#undef G_STEP
        const float gvs = grp < 4 ? gv0 : gv1;
        const int lb_ = (grp & 3) * 16 + 4 * g;
        float4 wv_;
        wv_.x = __shfl(gvs, lb_) * gelu_tanh(acc[0]); wv_.y = __shfl(gvs, lb_ + 1) * gelu_tanh(acc[1]);
        wv_.z = __shfl(gvs, lb_ + 2) * gelu_tanh(acc[2]); wv_.w = __shfl(gvs, lb_ + 3) * gelu_tanh(acc[3]);
        if (lr == 0) *(float4*)(wl + grp * 16 + 4 * g) = wv_;
        __builtin_amdgcn_sched_barrier(0);
      }
    }
    __builtin_amdgcn_sched_barrier(0);
    float out[32];
#pragma unroll
    for (int i = 0; i < 32; ++i) out[i] = 0.f;
#pragma unroll 1
    for (int grp = 0; grp < 8; ++grp) {
      const int esel = grp < 4 ? e0 : e1;
      const int lb = (grp & 3) * 16;
      u32x4 vd4[8]; u32x2 vd2[8]; unsigned vsc[8];
#pragma unroll
      for (int pp = 0; pp < 8; ++pp) {
        const int ea = __builtin_amdgcn_readlane(esel, lb + 2 * pp), eb = __builtin_amdgcn_readlane(esel, lb + 2 * pp + 1);
        const unsigned char* vr = V6 + (size_t)(half ? eb : ea) * V_PITCH;
        if (V_FP4) { vd4[pp] = *(const u32x4*)(vr + 16 * blk); vd2[pp] = (u32x2){0u, 0u}; vsc[pp] = vr[mx4_scale_pos(blk)]; }
        else { vd4[pp] = *(const u32x4*)(vr + 24 * blk); vd2[pp] = *(const u32x2*)(vr + 24 * blk + 16); vsc[pp] = vr[mx_scale_pos(blk)]; }
      }
      __builtin_amdgcn_sched_barrier(0);
#pragma unroll
      for (int pp = 0; pp < 8; ++pp) {
        const float wgt = wl[grp * 16 + 2 * pp + half] * __uint_as_float(vsc[pp] << 23);
        if (V_FP4) {
          unsigned q0 = vd4[pp][0], q1 = vd4[pp][1], q2 = vd4[pp][2], q3 = vd4[pp][3];
          asm volatile("" : "+v"(q0), "+v"(q1) : "v"(out[0]), "v"(out[1]), "v"(out[2]), "v"(out[3]), "v"(out[4]), "v"(out[5]), "v"(out[6]), "v"(out[7]),
                       "v"(out[8]), "v"(out[9]), "v"(out[10]), "v"(out[11]), "v"(out[12]), "v"(out[13]), "v"(out[14]), "v"(out[15]));
          asm volatile("" : "+v"(q2), "+v"(q3) : "v"(out[16]), "v"(out[17]), "v"(out[18]), "v"(out[19]), "v"(out[20]), "v"(out[21]), "v"(out[22]), "v"(out[23]),
                       "v"(out[24]), "v"(out[25]), "v"(out[26]), "v"(out[27]), "v"(out[28]), "v"(out[29]), "v"(out[30]), "v"(out[31]));
          const u32x4 qd = {q0, q1, q2, q3};
#pragma unroll
          for (int d = 0; d < 4; ++d) {
            const f32x2 t0 = __builtin_amdgcn_cvt_scalef32_pk_f32_fp4(qd[d], 1.0f, 0), t1 = __builtin_amdgcn_cvt_scalef32_pk_f32_fp4(qd[d], 1.0f, 1);
            const f32x2 t2 = __builtin_amdgcn_cvt_scalef32_pk_f32_fp4(qd[d], 1.0f, 2), t3 = __builtin_amdgcn_cvt_scalef32_pk_f32_fp4(qd[d], 1.0f, 3);
            out[8 * d + 0] += wgt * t0[0]; out[8 * d + 1] += wgt * t0[1]; out[8 * d + 2] += wgt * t1[0]; out[8 * d + 3] += wgt * t1[1];
            out[8 * d + 4] += wgt * t2[0]; out[8 * d + 5] += wgt * t2[1]; out[8 * d + 6] += wgt * t3[0]; out[8 * d + 7] += wgt * t3[1];
          }
        } else {
          unsigned pk0 = vd4[pp][0], pk1 = vd4[pp][1];
          asm volatile("" : "+v"(pk0) : "v"(out[0]), "v"(out[1]), "v"(out[2]), "v"(out[3]), "v"(out[4]), "v"(out[5]), "v"(out[6]), "v"(out[7]),
                       "v"(out[8]), "v"(out[9]), "v"(out[10]), "v"(out[11]), "v"(out[12]), "v"(out[13]), "v"(out[14]), "v"(out[15]));
          asm volatile("" : "+v"(pk1) : "v"(out[16]), "v"(out[17]), "v"(out[18]), "v"(out[19]), "v"(out[20]), "v"(out[21]), "v"(out[22]), "v"(out[23]),
                       "v"(out[24]), "v"(out[25]), "v"(out[26]), "v"(out[27]), "v"(out[28]), "v"(out[29]), "v"(out[30]), "v"(out[31]));
          const u32x6 pk = {pk0, pk1, vd4[pp][2], vd4[pp][3], vd2[pp][0], vd2[pp][1]};
          const f32x32 vals = __builtin_amdgcn_cvt_scalef32_pk32_f32_fp6(pk, 1.0f);
  #pragma unroll
          for (int i = 0; i < 32; ++i) out[i] += wgt * vals[i];
        }
        __builtin_amdgcn_sched_barrier(0);
      }
    }
    float o16[16];
#pragma unroll
    for (int i = 0; i < 16; ++i) {
      const u32x2 s0 = __builtin_amdgcn_permlane32_swap(__float_as_uint(out[i]), __float_as_uint(out[i]), false, false);
      const u32x2 s1 = __builtin_amdgcn_permlane32_swap(__float_as_uint(out[16 + i]), __float_as_uint(out[16 + i]), false, false);
      const float t0 = __uint_as_float(s0[0]) + __uint_as_float(s0[1]), t1 = __uint_as_float(s1[0]) + __uint_as_float(s1[1]);
      o16[i] = half ? t1 : t0;
    }
    const int cb = 32 * blk + 16 * half;
    const int b = t < TL ? (t >> 11) : 16;
    const float* md = modbuf + ((size_t)l * 17 + b) * 6144 + 5 * 1024 + cb;
    bf16_t* xr = xres + (size_t)t * 1024 + cb;
    float xn[16];
    float ss = 0.f;
    {
      const u32x4 r0 = *(const u32x4*)xr, r1 = *(const u32x4*)(xr + 8);
      unpack8(r0, xn); unpack8(r1, xn + 8);
    }
    unsigned xp[8];
#pragma unroll
    for (int q = 0; q < 4; ++q) {
      const float4 m4 = *(const float4*)(md + 4 * q);
      xn[4 * q] += m4.x * o16[4 * q + 0]; xn[4 * q + 1] += m4.y * o16[4 * q + 1]; xn[4 * q + 2] += m4.z * o16[4 * q + 2]; xn[4 * q + 3] += m4.w * o16[4 * q + 3];
      ss += xn[4 * q] * xn[4 * q] + xn[4 * q + 1] * xn[4 * q + 1] + xn[4 * q + 2] * xn[4 * q + 2] + xn[4 * q + 3] * xn[4 * q + 3];
      xp[2 * q] = pk2(xn[4 * q], xn[4 * q + 1]); xp[2 * q + 1] = pk2(xn[4 * q + 2], xn[4 * q + 3]);
    }
    if (dry) asm volatile("" :: "v"(xp[0]), "v"(xp[7]));
    else if (l < NL - 1) { *(u32x4*)xr = (u32x4){xp[0], xp[1], xp[2], xp[3]}; *(u32x4*)(xr + 8) = (u32x4){xp[4], xp[5], xp[6], xp[7]}; }
    if (!dry) {
      ss = wave_sum(ss);
      const float rstd = rsqrtf(ss * (1.f / 1024.f) + 1e-6f);
      if (l == NL - 1) {
        const float* fg = p.final_g + cb;
        float* orow = p.out + (size_t)t * 1024 + cb;
#pragma unroll
        for (int q = 0; q < 4; ++q) {
          const float4 g4 = *(const float4*)(fg + 4 * q);
          float4 o = {xn[4 * q] * rstd * g4.x, xn[4 * q + 1] * rstd * g4.y, xn[4 * q + 2] * rstd * g4.z, xn[4 * q + 3] * rstd * g4.w};
          *(float4*)(orow + 4 * q) = o;
        }
      } else {
        const float* gvec = p.norm1_g + (l + 1) * 1024 + cb;
        const float* mdn = modbuf + ((size_t)(l + 1) * 17 + b) * 6144 + cb;
        bf16_t* hrow = (bf16_t*)(p.ws + OFF_H) + (size_t)t * 1024 + cb;
        unsigned pk[8];
#pragma unroll
        for (int q = 0; q < 4; ++q) {
          const float4 g4 = *(const float4*)(gvec + 4 * q), sh = *(const float4*)(mdn + 4 * q), sc = *(const float4*)(mdn + 1024 + 4 * q);
          const float o0 = xn[4 * q] * rstd * g4.x * (1.f + sc.x) + sh.x, o1 = xn[4 * q + 1] * rstd * g4.y * (1.f + sc.y) + sh.y;
          const float o2 = xn[4 * q + 2] * rstd * g4.z * (1.f + sc.z) + sh.z, o3 = xn[4 * q + 3] * rstd * g4.w * (1.f + sc.w) + sh.w;
          pk[2 * q] = pk2(o0, o1); pk[2 * q + 1] = pk2(o2, o3);
        }
        *(u32x4*)hrow = (u32x4){pk[0], pk[1], pk[2], pk[3]};
        *(u32x4*)(hrow + 8) = (u32x4){pk[4], pk[5], pk[6], pk[7]};
      }
    }
  }
}


DI void phase_topk_gather(const Params& p, int l, int ntok, unsigned* ctr, unsigned char* lds, bool dry = false) {
  const int tid = ltid(), lane = tid & 63, w = tid >> 6, lr = lane & 15, g = lane >> 4;
  const bf16_t* QP = (const bf16_t*)(p.ws + OFF_QP);
  const bf16_t* sk = (const bf16_t*)(p.ws + OFF_SK) + (size_t)l * 2 * 128 * 64;
  int* eid_l = (int*)lds;
  float* gate_l = (float*)(lds + 8192);
  unsigned char* hl = lds + 16384 + w * 2048;
  float* wl = (float*)(hl + 1024);
  volatile int* slot = (volatile int*)(lds + LDS_BYTES - 16);
  const int ntile = ntok / 16;
  for (;;) {
    __syncthreads();
    if (tid == 0) *slot = (int)atomicAdd(ctr, 1u);
    __syncthreads();
    const int tile = *slot;
    if (tile >= ntile) break;
#pragma unroll 1
    for (int hh = 0; hh < 2; ++hh) {
      topk_tile(QP, sk, tile, 2 * w + hh, eid_l, gate_l, lr, g);
      __builtin_amdgcn_sched_barrier(0);
    }
    __syncthreads();
#pragma unroll 1
    for (int q = 0; q < 4; ++q) {
      const int r = 4 * w + q;
      gather_token(p, l, tile * 16 + r, eid_l + r * 128, gate_l + r * 128, hl, wl, dry);
    }
  }
}

DI void phase_final(const Params& p) {
  const int lane = ltid() & 63, gw = lbid() * 4 + (ltid() >> 6), nw = lgdim() * 4;
  const float* xres = (const float*)(p.ws + OFF_XRES);
  for (int t = gw; t < TL; t += nw) {
    const float* src = xres + (size_t)t * 1024;
    float4 v[4];
    float ss = 0.f;
#pragma unroll
    for (int i = 0; i < 4; ++i) {
      v[i] = *(const float4*)(src + 4 * lane + 256 * i);
      ss += v[i].x * v[i].x + v[i].y * v[i].y + v[i].z * v[i].z + v[i].w * v[i].w;
    }
    ss = wave_sum(ss);
    const float rstd = rsqrtf(ss * (1.f / 1024.f) + 1e-6f);
#pragma unroll
    for (int i = 0; i < 4; ++i) {
      const int col = 4 * lane + 256 * i;
      const float4 g4 = *(const float4*)(p.final_g + col);
      float4 o = {v[i].x * rstd * g4.x, v[i].y * rstd * g4.y, v[i].z * rstd * g4.z, v[i].w * rstd * g4.w};
      *(float4*)(p.out + (size_t)t * 1024 + col) = o;
    }
  }
}


#define LAS __attribute__((address_space(3)))
#define XB_TMO      128
#define XB_XCNT(j)  (256  + 64 * (j))
#define XB_XSUB(j)  (1280 + 64 * (j))
#define XB_XGEN(j)  (2304 + 64 * (j))
#define XB_TOP      3328
#define XB_TOPGEN   3392
#define XCD_BAR_WORDS 3456
#define XB_SPIN_CAP (1u << 22)
DI unsigned xb_ld(unsigned* p) { return __hip_atomic_load(p, __ATOMIC_RELAXED, __HIP_MEMORY_SCOPE_AGENT); }
DI unsigned xb_add(unsigned* p, unsigned v) { return __hip_atomic_fetch_add(p, v, __ATOMIC_RELAXED, __HIP_MEMORY_SCOPE_AGENT); }
DI unsigned xb_xcc_id() { return (unsigned)__builtin_amdgcn_s_getreg((3 << 11) | 20) & 0xFu; }
#define XB_SPIN(cond, bar) do { unsigned _sp = 0; while (cond) { __builtin_amdgcn_s_sleep(1); \
    if ((++_sp & 255u) == 0u) { if (xb_ld(&(bar)[XB_TMO])) break; if (_sp > XB_SPIN_CAP) { atomicAdd(&(bar)[XB_TMO], 1u); break; } } } } while (0)
struct XcdBarrier { unsigned* bar; unsigned x; volatile unsigned* st; };
DI XcdBarrier xcd_barrier_post(unsigned* bar, volatile unsigned* st) {
  XcdBarrier b; b.bar = bar; b.x = xb_xcc_id(); b.st = st;
  if (threadIdx.x == 0) (void)xb_add(&bar[XB_XCNT(b.x)], 1u);
  return b;
}
DI void xcd_barrier_complete(unsigned* bar, unsigned x, unsigned& nloc, unsigned& nx) {
  const unsigned G = gridDim.x * gridDim.y * gridDim.z;
  unsigned sum, cnt, mine, sp = 0u;
  for (;;) {
    sum = 0u; cnt = 0u; mine = 0u;
#pragma unroll 1
    for (unsigned j = 0; j < 16; ++j) { const unsigned c = xb_ld(&bar[XB_XCNT(j)]); sum += c; cnt += (c > 0u) ? 1u : 0u; mine = (j == x) ? c : mine; }
    if (sum == G) break;
    __builtin_amdgcn_s_sleep(1);
    if ((++sp & 255u) == 0u) { if (xb_ld(&bar[XB_TMO])) break; if (sp > XB_SPIN_CAP) { atomicAdd(&bar[XB_TMO], 1u); break; } }
  }
  nloc = mine > 0u ? mine : 1u; nx = cnt > 0u ? cnt : 1u;
}
DI void xcd_barrier(const XcdBarrier& b) {
  asm volatile("s_waitcnt vmcnt(0)" ::: "memory");
  __syncthreads();
  if (threadIdx.x == 0) {
    unsigned* bar = b.bar;
    __builtin_amdgcn_s_waitcnt(0);
    unsigned nloc = b.st[0], nx = b.st[1];
    if (nloc == 0u) { xcd_barrier_complete(bar, b.x, nloc, nx); b.st[0] = nloc; b.st[1] = nx; }
    const unsigned old = xb_add(&bar[XB_XSUB(b.x)], 1u);
    const unsigned gen = old / nloc;
    if (old + 1u == (gen + 1u) * nloc) {
      __builtin_amdgcn_fence(__ATOMIC_RELEASE, "agent");
      asm volatile("s_waitcnt vmcnt(0)" ::: "memory");
      const unsigned og = xb_add(&bar[XB_TOP], 1u);
      const unsigned tg = og / nx;
      if (og + 1u == (tg + 1u) * nx) xb_add(&bar[XB_TOPGEN], 1u);
      else XB_SPIN(xb_ld(&bar[XB_TOPGEN]) == tg, bar);
      __builtin_amdgcn_fence(__ATOMIC_ACQUIRE, "agent");
      xb_add(&bar[XB_XGEN(b.x)], 1u);
      asm volatile("s_waitcnt vmcnt(0)" ::: "memory");
    } else {
      XB_SPIN(xb_ld(&bar[XB_XGEN(b.x)]) == gen, bar);
      __builtin_amdgcn_fence(__ATOMIC_ACQUIRE, "agent");
      asm volatile("s_waitcnt vmcnt(0)" ::: "memory");
    }
  }
  __syncthreads();
}

constexpr int PH_PER_LAYER = 10;
constexpr int N_PHASES = 1 + NL * PH_PER_LAYER + 1;

template <int KIND>
DI void run_phase(const Params& p, int ph, unsigned char* lds) {
  unsigned* ctl = (unsigned*)(p.ws + OFF_CTL);
  if (ph == 0) { if (KIND < 0 || KIND == 0) phase_prologue(p, lds); }
  else if (ph == N_PHASES - 1) { if (KIND < 0 || KIND == 11) phase_final(p); }
  else {
    const int l = (ph - 1) / PH_PER_LAYER, s = (ph - 1) % PH_PER_LAYER;
    const bool last = (l == NL - 1);
    const int ntok = last ? TL : TT;
    if (s == 0) { if (KIND < 0 || KIND == 1) phase_norm(p, l, 0, TT); }
    else if (s == 1) { if (KIND < 0 || KIND == 2) phase_gemm_in(p, l, lds); }
    else if (s == 2) { if (KIND < 0 || KIND == 3) phase_rope(p, lds); }
    else if (s == 3) { if (KIND < 0 || KIND == 4) phase_mixers(p, l, last, ctl + 64 * (1 + l), lds); }
    else if (s == 4) { if (KIND < 0 || KIND == 5) phase_gla_fin(p, l, ntok); }
    else if (s == 5) { if (KIND < 0 || KIND == 6) phase_gemm_out(p, l, ntok, lds); }
    else if (s == 6) { if (KIND < 0 || KIND == 7) phase_norm(p, l, 1, ntok); }
    else if (s == 7) { if (KIND < 0 || KIND == 8) phase_gemm_q(p, l, ntok, lds); }
    else if (s == 8) { }
    else { if (KIND < 0 || KIND == 10) phase_topk_gather(p, l, ntok, (unsigned*)(p.ws + OFF_CTL) + 64 * (8 + l), lds); }
  }
}

#if N_LAUNCH_MODE == 1
#ifndef PROBE_KIND
#define PROBE_KIND -1
#endif
#ifndef GLA_VAR
#define GLA_VAR 0
#endif
constexpr int CW_BAR = 4096;
template <int l>
DI void run_layer(const Params& p, unsigned char* lds) {
  unsigned* ctl = (unsigned*)(p.ws + OFF_CTL);
#define GSYNC() do { XcdBarrier bb; bb.bar = (unsigned*)(p.ws + OFF_CTL) + CW_BAR; bb.x = xb_xcc_id(); bb.st = (volatile unsigned*)(lds + LDS_BYTES - 32); xcd_barrier(bb); } while (0)

    const bool last = (l == NL - 1);
    const int ntok = last ? TL : TT;
    if (l == 0) { { Params q = p; { size_t z_ = 0; asm volatile("" : "+s"(z_)); q.ws = p.ws + z_; } phase_norm(q, l, 0, TT); } GSYNC(); }
    if (PROBE_KIND == 1) { { Params q = p; { size_t z_ = 0; asm volatile("" : "+s"(z_)); q.ws = p.ws + z_; } phase_norm(q, l, 0, TT); } GSYNC(); }
    if (PROBE_KIND == 2) { { Params q = p; { size_t z_ = 0; asm volatile("" : "+s"(z_)); q.ws = p.ws + z_; } phase_gemm_in(q, l, lds, true); } GSYNC(); }
    { Params q = p; { size_t z_ = 0; asm volatile("" : "+s"(z_)); q.ws = p.ws + z_; } phase_gemm_in(q, l, lds); } GSYNC();
    if (PROBE_KIND == 4 || (PROBE_KIND >= 41 && PROBE_KIND <= 47)) { { Params q = p; { size_t z_ = 0; asm volatile("" : "+s"(z_)); q.ws = p.ws + z_; } phase_mixers(q, l, last, ctl + 64 * (1 + l) + 1, lds, PROBE_KIND == 4 ? 15 : PROBE_KIND - 40, GLA_VAR); } GSYNC(); }
    { Params q = p; { size_t z_ = 0; asm volatile("" : "+s"(z_)); q.ws = p.ws + z_; } phase_mixers(q, l, last, ctl + 64 * (1 + l), lds); } GSYNC();
    { Params q = p; { size_t z_ = 0; asm volatile("" : "+s"(z_)); q.ws = p.ws + z_; } phase_gla_fin(q, l, ntok); } GSYNC();
    if (PROBE_KIND == 5) { { Params q = p; { size_t z_ = 0; asm volatile("" : "+s"(z_)); q.ws = p.ws + z_; } phase_gla_fin(q, l, ntok); } GSYNC(); }
    { Params q = p; { size_t z_ = 0; asm volatile("" : "+s"(z_)); q.ws = p.ws + z_; } phase_gemm_out(q, l, ntok, lds); } GSYNC();
    { Params q = p; { size_t z_ = 0; asm volatile("" : "+s"(z_)); q.ws = p.ws + z_; } phase_norm2(q, l, ntok); } GSYNC();
    if (PROBE_KIND == 7) { { Params q = p; { size_t z_ = 0; asm volatile("" : "+s"(z_)); q.ws = p.ws + z_; } phase_norm2(q, l, ntok); } GSYNC(); }
    { Params q = p; { size_t z_ = 0; asm volatile("" : "+s"(z_)); q.ws = p.ws + z_; } phase_gemm_q(q, l, ntok, lds); } GSYNC();
    if (PROBE_KIND == 8) { { Params q = p; { size_t z_ = 0; asm volatile("" : "+s"(z_)); q.ws = p.ws + z_; } phase_gemm_q(q, l, ntok, lds); } GSYNC(); }
    if (PROBE_KIND == 11) { { Params q = p; { size_t z_ = 0; asm volatile("" : "+s"(z_)); q.ws = p.ws + z_; } phase_topk_gather(q, l, ntok, ctl + 64 * (8 + l) + 1, lds, true); } GSYNC(); }
    { Params q = p; { size_t z_ = 0; asm volatile("" : "+s"(z_)); q.ws = p.ws + z_; } phase_topk_gather(q, l, ntok, ctl + 64 * (8 + l), lds); } if (l + 1 < NL) GSYNC();
}
__global__ void __launch_bounds__(256, 2) mk_fwd(Params p) {
  __shared__ __attribute__((aligned(16))) unsigned char lds[LDS_BYTES];
  unsigned* ctl = (unsigned*)(p.ws + OFF_CTL);
  volatile unsigned* st = (volatile unsigned*)(lds + LDS_BYTES - 32);
  if (threadIdx.x < 2) st[threadIdx.x] = 0u;
  __syncthreads();
  (void)xcd_barrier_post(ctl + CW_BAR, st);
#define GSYNC() do { XcdBarrier bb; bb.bar = (unsigned*)(p.ws + OFF_CTL) + CW_BAR; bb.x = xb_xcc_id(); bb.st = (volatile unsigned*)(lds + LDS_BYTES - 32); xcd_barrier(bb); } while (0)
  { Params q = p; { size_t z_ = 0; asm volatile("" : "+s"(z_)); q.ws = p.ws + z_; } phase_prologue(q, lds); } cg::this_grid().sync();
  if (PROBE_KIND == 0) { { Params q = p; { size_t z_ = 0; asm volatile("" : "+s"(z_)); q.ws = p.ws + z_; } phase_prologue(q, lds); } GSYNC(); }
  run_layer<0>(p, lds); run_layer<1>(p, lds); run_layer<2>(p, lds); run_layer<3>(p, lds);
}
#else
template <int KIND>
__global__ void __launch_bounds__(256, 2) mk_phase(Params p) {
  __shared__ __attribute__((aligned(16))) unsigned char lds[LDS_BYTES];
  run_phase<KIND>(p, p.ph_lo, lds);
}
#endif

extern "C" void kernel_launch(void* const* d_in, const int* in_sizes, int n_in, void* d_out, int out_size, void* d_ws,
                              size_t ws_size, hipStream_t stream) {
  static int grid = 0;
  if (grid == 0) {
    if (n_in != 21 || ws_size < WS_END || out_size != TL * DM) { fprintf(stderr, "kernel_launch: unexpected shapes (n_in %d ws %zu out %d)\n", n_in, ws_size, out_size); grid = -1; return; }
    int dev = 0, cus = 0, per_cu = 2;
    (void)hipGetDevice(&dev);
    (void)hipDeviceGetAttribute(&cus, hipDeviceAttributeMultiprocessorCount, dev);
#if N_LAUNCH_MODE == 1
    (void)hipOccupancyMaxActiveBlocksPerMultiprocessor(&per_cu, (const void*)mk_fwd, 256, 0);
    if (per_cu < 1) per_cu = 1;
    if (per_cu > 2) per_cu = 2;
#endif
    grid = cus * per_cu;
  }
  if (grid < 0) return;
  (void)hipMemsetAsync((char*)d_ws + OFF_CTL, 0, 65536, stream);
  Params p{};
  const float** pp = (const float**)&p;
  for (int i = 0; i < 21; ++i) pp[i] = (const float*)d_in[i];
  p.out = (float*)d_out;
  p.ws = (unsigned char*)d_ws;
#if N_LAUNCH_MODE == 1
  p.ph_lo = 0; p.ph_hi = N_PHASES;
  void* args[] = {&p};
  hipError_t e = hipLaunchCooperativeKernel((const void*)mk_fwd, dim3(grid), dim3(256), args, 0, stream);
  if (e != hipSuccess) fprintf(stderr, "cooperative launch failed: %s (grid %d)\n", hipGetErrorString(e), grid);
#else
  for (int ph = 0; ph < N_PHASES; ++ph) {
    p.ph_lo = ph; p.ph_hi = ph + 1;
    const int kind = ph == 0 ? 0 : (ph == N_PHASES - 1 ? 11 : 1 + (ph - 1) % PH_PER_LAYER);
    switch (kind) {
      case 0: hipLaunchKernelGGL(mk_phase<0>, dim3(grid), dim3(256), 0, stream, p); break;
      case 1: hipLaunchKernelGGL(mk_phase<1>, dim3(grid), dim3(256), 0, stream, p); break;
      case 2: hipLaunchKernelGGL(mk_phase<2>, dim3(grid), dim3(256), 0, stream, p); break;
      case 3: hipLaunchKernelGGL(mk_phase<3>, dim3(grid), dim3(256), 0, stream, p); break;
      case 4: hipLaunchKernelGGL(mk_phase<4>, dim3(grid), dim3(256), 0, stream, p); break;
      case 5: hipLaunchKernelGGL(mk_phase<5>, dim3(grid), dim3(256), 0, stream, p); break;
      case 6: hipLaunchKernelGGL(mk_phase<6>, dim3(grid), dim3(256), 0, stream, p); break;
      case 7: hipLaunchKernelGGL(mk_phase<7>, dim3(grid), dim3(256), 0, stream, p); break;
      case 8: hipLaunchKernelGGL(mk_phase<8>, dim3(grid), dim3(256), 0, stream, p); break;
      case 9: hipLaunchKernelGGL(mk_phase<9>, dim3(grid), dim3(256), 0, stream, p); break;
      case 10: hipLaunchKernelGGL(mk_phase<10>, dim3(grid), dim3(256), 0, stream, p); break;
      default: hipLaunchKernelGGL(mk_phase<11>, dim3(grid), dim3(256), 0, stream, p); break;
    }
  }
#endif
}
```

```cpp
#include <hip/hip_runtime.h>
#include <hip/hip_cooperative_groups.h>
#include <stdint.h>
#include <stdio.h>
namespace cg = cooperative_groups;

#ifndef N_LAUNCH_MODE
#define N_LAUNCH_MODE 1
#endif

#define DI __device__ __forceinline__
#ifndef GEMM_VAR
#define GEMM_VAR 0
#endif
typedef unsigned short bf16_t;
typedef short bf16x8 __attribute__((ext_vector_type(8)));
typedef float f32x4 __attribute__((ext_vector_type(4)));
typedef float f32x2 __attribute__((ext_vector_type(2)));
typedef float f32x16 __attribute__((ext_vector_type(16)));
typedef float f32x32 __attribute__((ext_vector_type(32)));
typedef unsigned u32x6 __attribute__((ext_vector_type(6)));
typedef int i32x8 __attribute__((ext_vector_type(8)));
typedef unsigned u32x4 __attribute__((ext_vector_type(4)));
typedef unsigned u32x2 __attribute__((ext_vector_type(2)));

constexpr int NB = 16, SEQ = 2048, DM = 1024, NL = 4, CTXL = 256;
constexpr int TL = NB * SEQ;
constexpr int TC = NB * CTXL;
constexpr int TT = TL + TC;
constexpr int PN_LD = 2176;
constexpr int C_GQ = 0, C_GK = 128, C_GR = 256, C_NQ = 512, C_NK = 768, C_DQ = 1024, C_DK = 1536, C_GATE = 2048;
constexpr int R_GV = 0, R_NV = 256, R_DV = 512;
constexpr float LOG2E = 1.4426950408889634f;
constexpr float SC_LOG2 = 0.125f * LOG2E;
constexpr float NEG_BIG = -1e30f;

constexpr size_t MiB = 1u << 20;
constexpr size_t OFF_CTL = 0;
constexpr size_t OFF_MOD = 1 * MiB;
constexpr size_t OFF_WIN = 3 * MiB;
constexpr size_t OFF_WOUT = 28 * MiB;
constexpr size_t OFF_WQ = 36 * MiB;
constexpr size_t OFF_SK = 44 * MiB;
constexpr size_t OFF_USCL = 44 * MiB + 256 * 1024;
constexpr size_t OFF_VSCL = 44 * MiB + 512 * 1024;
constexpr size_t OFF_U = 45 * MiB;
constexpr size_t OFF_V = 109 * MiB;
constexpr int V6_PITCH = 800;
#ifndef U_FP4
#define U_FP4 1
#endif
#ifndef V_FP4
#define V_FP4 1
#endif
constexpr int P4_PITCH = 544;
constexpr int U_PITCH = U_FP4 ? P4_PITCH : V6_PITCH, V_PITCH = V_FP4 ? P4_PITCH : V6_PITCH;
constexpr size_t OFF_XRES = 301 * MiB;
constexpr size_t OFF_H = 445 * MiB;
constexpr size_t OFF_P = 517 * MiB;
constexpr size_t OFF_VT = OFF_P + 153 * MiB;
constexpr size_t OFF_QP = OFF_P;
constexpr size_t OFF_EID = OFF_P + 72 * MiB;
constexpr size_t OFF_GATE = OFF_P + 90 * MiB;
constexpr size_t OFF_H8 = OFF_P + 126 * MiB;
constexpr size_t OFF_HINV = OFF_P + 162 * MiB;
constexpr size_t OFF_Y = 742 * MiB;
constexpr size_t WS_END = 814 * MiB;

constexpr int LDS_BYTES = 65536 + 8192;

struct Params {
  const float *x, *c, *ctx, *c_ctx, *ada_w, *ada_b, *norm1_g, *norm2_g, *w_in, *gate_up, *gate_b, *gla_norm_g,
      *rpb, *dlam, *diff_g, *w_out, *wq, *subkeys, *pu, *pv, *final_g;
  float* out;
  unsigned char* ws;
  int ph_lo, ph_hi;
};

DI int ltid() { int t = threadIdx.x; asm volatile("" : "+v"(t)); return t; }
DI int lbid() { int t = blockIdx.x; asm volatile("" : "+s"(t)); return t; }
DI int lgdim() { int t = gridDim.x; asm volatile("" : "+s"(t)); return t; }

DI unsigned f2bf(float f) { unsigned u = __float_as_uint(f); return (u + 0x7fffu + ((u >> 16) & 1u)) >> 16; }
typedef __bf16 bf16x2_t __attribute__((ext_vector_type(2)));
DI unsigned pk2(float lo, float hi) { f32x2 v = {lo, hi}; return __builtin_bit_cast(unsigned, __builtin_convertvector(v, bf16x2_t)); }
DI float bflo(unsigned u) { return __uint_as_float(u << 16); }
DI float bfhi(unsigned u) { return __uint_as_float(u & 0xffff0000u); }
DI void unpack8(const u32x4 v, float* f) {
  f[0] = bflo(v.x); f[1] = bfhi(v.x); f[2] = bflo(v.y); f[3] = bfhi(v.y);
  f[4] = bflo(v.z); f[5] = bfhi(v.z); f[6] = bflo(v.w); f[7] = bfhi(v.w);
}
DI float wave_sum(float v) {
#pragma unroll
  for (int o = 32; o >= 1; o >>= 1) v += __shfl_xor(v, o);
  return v;
}

DI float rows_max(float x) {
  unsigned u = __float_as_uint(x);
  u32x2 a = __builtin_amdgcn_permlane32_swap(u, u, false, false);
  const float m = fmaxf(__uint_as_float(a[0]), __uint_as_float(a[1]));
  unsigned v = __float_as_uint(m);
  u32x2 b = __builtin_amdgcn_permlane16_swap(v, v, false, false);
  return fmaxf(__uint_as_float(b[0]), __uint_as_float(b[1]));
}
DI float rows_sum(float x) {
  unsigned u = __float_as_uint(x);
  u32x2 a = __builtin_amdgcn_permlane32_swap(u, u, false, false);
  const float m = __uint_as_float(a[0]) + __uint_as_float(a[1]);
  unsigned v = __float_as_uint(m);
  u32x2 b = __builtin_amdgcn_permlane16_swap(v, v, false, false);
  return __uint_as_float(b[0]) + __uint_as_float(b[1]);
}

DI u32x6 mxfp6_pack32(float (&x)[32], unsigned& sbyte) {
  float am = 0.f;
#pragma unroll
  for (int i = 0; i < 32; ++i) am = fmaxf(am, fabsf(x[i]));
  const unsigned ab = __float_as_uint(am);
  int e = am > 0.f ? (int)(ab >> 23) - 127 - 2 + ((ab & 0x7fffffu) > 0x700000u ? 1 : 0) : -126;
  e = e < -126 ? -126 : (e > 127 ? 127 : e);
  const float sc = __uint_as_float((unsigned)(127 - e) << 23);
  f32x16 lo, hi;
#pragma unroll
  for (int i = 0; i < 16; ++i) { lo[i] = x[2 * i] * sc; hi[i] = x[2 * i + 1] * sc; }
  sbyte = (unsigned)(127 + e);
  return __builtin_amdgcn_cvt_scalef32_2xpk16_fp6_f32(lo, hi, 1.0f);
}

DI u32x4 mxfp4_pack32(float (&x)[32], unsigned& sbyte) {
  float am = 0.f;
#pragma unroll
  for (int i = 0; i < 32; ++i) am = fmaxf(am, fabsf(x[i]));
  const unsigned ab = __float_as_uint(am);
  int e = am > 0.f ? (int)(ab >> 23) - 127 - 2 + ((ab & 0x7fffffu) > 0x400000u ? 1 : 0) : -126;
  e = e < -126 ? -126 : (e > 127 ? 127 : e);
  const float sc = __uint_as_float((unsigned)(127 - e) << 23);
  sbyte = (unsigned)(127 + e);
  u32x4 q;
#pragma unroll
  for (int d = 0; d < 4; ++d) {
    unsigned v = 0;
    v = __builtin_amdgcn_cvt_scalef32_pk_fp4_f32(v, x[8 * d + 0] * sc, x[8 * d + 1] * sc, 1.0f, 0);
    v = __builtin_amdgcn_cvt_scalef32_pk_fp4_f32(v, x[8 * d + 2] * sc, x[8 * d + 3] * sc, 1.0f, 1);
    v = __builtin_amdgcn_cvt_scalef32_pk_fp4_f32(v, x[8 * d + 4] * sc, x[8 * d + 5] * sc, 1.0f, 2);
    v = __builtin_amdgcn_cvt_scalef32_pk_fp4_f32(v, x[8 * d + 6] * sc, x[8 * d + 7] * sc, 1.0f, 3);
    q[d] = v;
  }
  return q;
}
DI int mx4_scale_pos(int blk) { return 512 + (blk & 3) * 8 + (blk >> 2); }
DI int mx_scale_pos(int blk) { return 768 + (blk & 3) * 8 + (blk >> 2); }
DI f32x4 mfma16(bf16x8 a, bf16x8 b, f32x4 c) { return __builtin_amdgcn_mfma_f32_16x16x32_bf16(a, b, c, 0, 0, 0); }

DI int win_src_col(int r) {
  if (r < 256) return r;
  if (r < 512) return r - 256 + 512;
  if (r < 768) return r - 512 + 800;
  if (r < 1024) return r - 768 + 1056;
  if (r < 1536) return r - 1024 + 1568;
  if (r < 2048) return r - 1536 + 2080;
  if (r < 2080) return r - 2048 + 768;
  if (r < 2176) return -1;
  if (r < 2432) return r - 2176 + 256;
  if (r < 2688) return r - 2432 + 1312;
  return r - 2688 + 2592;
}

DI void transpose_item(const float* __restrict__ W, int N, int src, bf16_t* __restrict__ dst, float* lds) {
  const int tid = ltid();
  for (int kc = 0; kc < 8; ++kc) {
    __syncthreads();
#pragma unroll
    for (int i = 0; i < 16; ++i) {
      int k = i * 8 + (tid >> 5), n = tid & 31;
      lds[k * 33 + n] = (src < 0) ? 0.f : W[(size_t)(kc * 128 + k) * N + src + n];
    }
    __syncthreads();
    int row = tid >> 3, k0 = (tid & 7) * 16;
    unsigned o[8];
#pragma unroll
    for (int e = 0; e < 8; ++e) o[e] = pk2(lds[(k0 + 2 * e) * 33 + row], lds[(k0 + 2 * e + 1) * 33 + row]);
    u32x4 a = {o[0], o[1], o[2], o[3]}, b = {o[4], o[5], o[6], o[7]};
    bf16_t* d = dst + (size_t)row * 1024 + kc * 128 + k0;
    *(u32x4*)d = a; *(u32x4*)(d + 8) = b;
  }
}

DI void convert_table_pairs(const Params& p, int pr0, int pr1, int wave, int nwave, int lane) {
  for (int pr = pr0 + __builtin_amdgcn_readfirstlane(wave); pr < pr1; pr += nwave) {
    const int tab = pr >= NL * 16384 / 2, pq = tab ? pr - NL * 16384 / 2 : pr;
    const int r = 2 * pq + (lane >> 5), blk = lane & 31;
    const float* src = (tab ? p.pv : p.pu) + (size_t)r * 1024 + 32 * blk;
    float x[32];
#pragma unroll
    for (int i = 0; i < 8; ++i) { const float4 a = *(const float4*)(src + 4 * i); x[4 * i] = a.x; x[4 * i + 1] = a.y; x[4 * i + 2] = a.z; x[4 * i + 3] = a.w; }
    unsigned sb;
    if (tab ? V_FP4 : U_FP4) {
      const u32x4 q = mxfp4_pack32(x, sb);
      unsigned char* row = p.ws + (tab ? OFF_V : OFF_U) + (size_t)r * P4_PITCH;
      *(u32x4*)(row + 16 * blk) = q;
      row[mx4_scale_pos(blk)] = (unsigned char)sb;
    } else {
      const u32x6 q = mxfp6_pack32(x, sb);
      unsigned char* row = p.ws + (tab ? OFF_V : OFF_U) + (size_t)r * V6_PITCH;
      *(u32x2*)(row + 24 * blk) = (u32x2){q[0], q[1]};
      *(u32x2*)(row + 24 * blk + 8) = (u32x2){q[2], q[3]};
      *(u32x2*)(row + 24 * blk + 16) = (u32x2){q[4], q[5]};
      row[mx_scale_pos(blk)] = (unsigned char)sb;
    }
  }
}

DI void phase_prologue(const Params& p, unsigned char* lds) {
  const int tid = ltid(), nb = lgdim(), bid = lbid();
  bf16_t* winT = (bf16_t*)(p.ws + OFF_WIN);
  bf16_t* woutT = (bf16_t*)(p.ws + OFF_WOUT);
  bf16_t* wqT = (bf16_t*)(p.ws + OFF_WQ);
  constexpr int PER_LAYER = 100 + 32 + 32;
  for (int item = bid; item < NL * PER_LAYER; item += nb) {
    int l = item / PER_LAYER, r = item % PER_LAYER;
    if (r < 100) {
      int row = r * 32;
      transpose_item(p.w_in + (size_t)l * 1024 * 3104, 3104, win_src_col(row), winT + ((size_t)l * 3200 + row) * 1024, (float*)lds);
    } else if (r < 132) {
      int row = (r - 100) * 32;
      transpose_item(p.w_out + (size_t)l * 1024 * 1024, 1024, row, woutT + ((size_t)l * 1024 + row) * 1024, (float*)lds);
    } else {
      int row = (r - 132) * 32;
      transpose_item(p.wq + (size_t)l * 1024 * 1024, 1024, row, wqT + ((size_t)l * 1024 + row) * 1024, (float*)lds);
    }
  }
  {
    bf16_t* sk = (bf16_t*)(p.ws + OFF_SK);
    for (int i = bid * 256 + tid; i < NL * 2 * 128 * 64; i += nb * 256) sk[i] = (bf16_t)f2bf(p.subkeys[i]);
  }
  {
    float* modbuf = (float*)(p.ws + OFF_MOD);
    float* sc = (float*)lds;
    float* red = (float*)(lds + 17 * 512 * 4);
    for (int item = bid; item < NL * 96; item += nb) {
      const int l = item / 96, cb = item % 96, col = cb * 64 + (tid & 63), kq = tid >> 6;
      float acc[17];
#pragma unroll
      for (int r = 0; r < 17; ++r) acc[r] = 0.f;
      for (int half = 0; half < 2; ++half) {
        __syncthreads();
        for (int e = tid; e < 17 * 512; e += 256) {
          int r = e >> 9, k = e & 511;
          float cv = (r < 16) ? p.c[r * 1024 + half * 512 + k] : p.c_ctx[half * 512 + k];
          sc[e] = cv / (1.f + __expf(-cv));
        }
        __syncthreads();
        const float* wp = p.ada_w + ((size_t)l * 1024 + half * 512 + kq * 128) * 6144 + col;
        for (int kk = 0; kk < 128; ++kk) {
          const float w = wp[(size_t)kk * 6144];
#pragma unroll
          for (int r = 0; r < 17; ++r) acc[r] += sc[r * 512 + kq * 128 + kk] * w;
        }
      }
#pragma unroll
      for (int r = 0; r < 17; ++r) red[(kq * 17 + r) * 64 + (tid & 63)] = acc[r];
      __syncthreads();
      for (int e = tid; e < 17 * 64; e += 256) {
        int r = e >> 6, cc = e & 63;
        float s = red[(0 * 17 + r) * 64 + cc] + red[(1 * 17 + r) * 64 + cc] + red[(2 * 17 + r) * 64 + cc] + red[(3 * 17 + r) * 64 + cc];
        int colg = cb * 64 + cc;
        modbuf[((size_t)l * 17 + r) * 6144 + colg] = s + p.ada_b[l * 6144 + colg];
      }
      __syncthreads();
    }
  }
}

DI void phase_norm(const Params& p, int l, int which, int ntok) {
  const int lane = ltid() & 63, gw = lbid() * 4 + (ltid() >> 6), nw = lgdim() * 4;
  const float* gvec = (which == 0 ? p.norm1_g : p.norm2_g) + l * 1024;
  const int ish = which == 0 ? 0 : 3, isc = which == 0 ? 1 : 4;
  const float* xres = (const float*)(p.ws + OFF_XRES);
  const float* modbuf = (const float*)(p.ws + OFF_MOD);
  bf16_t* hbuf = (bf16_t*)(p.ws + OFF_H);
  for (int t = gw; t < ntok; t += nw) {
    const float* src = (which == 0 && l == 0) ? (t < TL ? p.x + (size_t)t * 1024 : p.ctx + (size_t)(t - TL) * 1024) : xres + (size_t)t * 1024;
    const int b = t < TL ? (t >> 11) : 16;
    const float* md = modbuf + ((size_t)l * 17 + b) * 6144;
    float4 v[4];
    float ss = 0.f;
#pragma unroll
    for (int i = 0; i < 4; ++i) {
      v[i] = *(const float4*)(src + 4 * lane + 256 * i);
      ss += v[i].x * v[i].x + v[i].y * v[i].y + v[i].z * v[i].z + v[i].w * v[i].w;
    }
    ss = wave_sum(ss);
    const float rstd = rsqrtf(ss * (1.f / 1024.f) + 1e-6f);
    float am = 0.f;
#pragma unroll
    for (int i = 0; i < 4; ++i) {
      const int col = 4 * lane + 256 * i;
      const float4 g4 = *(const float4*)(gvec + col), sh = *(const float4*)(md + ish * 1024 + col), sc = *(const float4*)(md + isc * 1024 + col);
      float o0 = v[i].x * rstd * g4.x * (1.f + sc.x) + sh.x;
      float o1 = v[i].y * rstd * g4.y * (1.f + sc.y) + sh.y;
      float o2 = v[i].z * rstd * g4.z * (1.f + sc.z) + sh.z;
      float o3 = v[i].w * rstd * g4.w * (1.f + sc.w) + sh.w;
      u32x2 o = {pk2(o0, o1), pk2(o2, o3)};
      *(u32x2*)(hbuf + (size_t)t * 1024 + col) = o;
      v[i].x = o0; v[i].y = o1; v[i].z = o2; v[i].w = o3;
      am = fmaxf(am, fmaxf(fmaxf(fabsf(o0), fabsf(o1)), fmaxf(fabsf(o2), fabsf(o3))));
    }
  }
}

DI void phase_norm2(const Params& p, int l, int ntok) {
  const int lane = ltid() & 63, gw = lbid() * 4 + (ltid() >> 6), nw = lgdim() * 4;
  const int half = lane >> 5, blk = lane & 31;
  const float* gvec = p.norm2_g + l * 1024 + 32 * blk;
  const bf16_t* xres = (const bf16_t*)(p.ws + OFF_XRES);
  const float* modbuf = (const float*)(p.ws + OFF_MOD);
  bf16_t* hbuf = (bf16_t*)(p.ws + OFF_H);
  unsigned char* h6 = p.ws + OFF_H8;
  for (int pr = gw; pr < ntok / 2; pr += nw) {
    const int t = 2 * pr + half;
    const bf16_t* src = xres + (size_t)t * 1024 + 32 * blk;
    const int b = t < TL ? (t >> 11) : 16;
    const float* md = modbuf + ((size_t)l * 17 + b) * 6144 + 32 * blk;
    float x[32];
    float ss = 0.f;
#pragma unroll
    for (int i = 0; i < 4; ++i) { const u32x4 a = *(const u32x4*)(src + 8 * i); unpack8(a, x + 8 * i); }
#pragma unroll
    for (int i = 0; i < 32; ++i) ss += x[i] * x[i];
#pragma unroll
    for (int o = 16; o >= 1; o >>= 1) ss += __shfl_xor(ss, o);
    const float rstd = rsqrtf(ss * (1.f / 1024.f) + 1e-6f);
    unsigned pk[16];
#pragma unroll
    for (int i = 0; i < 8; ++i) {
      const float4 g4 = *(const float4*)(gvec + 4 * i), sh = *(const float4*)(md + 3 * 1024 + 4 * i), sc = *(const float4*)(md + 4 * 1024 + 4 * i);
      x[4 * i] = x[4 * i] * rstd * g4.x * (1.f + sc.x) + sh.x;
      x[4 * i + 1] = x[4 * i + 1] * rstd * g4.y * (1.f + sc.y) + sh.y;
      x[4 * i + 2] = x[4 * i + 2] * rstd * g4.z * (1.f + sc.z) + sh.z;
      x[4 * i + 3] = x[4 * i + 3] * rstd * g4.w * (1.f + sc.w) + sh.w;
      pk[2 * i] = pk2(x[4 * i], x[4 * i + 1]); pk[2 * i + 1] = pk2(x[4 * i + 2], x[4 * i + 3]);
    }
    bf16_t* hrow = hbuf + (size_t)t * 1024 + 32 * blk;
#pragma unroll
    for (int i = 0; i < 4; ++i) *(u32x4*)(hrow + 8 * i) = (u32x4){pk[4 * i], pk[4 * i + 1], pk[4 * i + 2], pk[4 * i + 3]};
    unsigned sb;
    const u32x6 q = mxfp6_pack32(x, sb);
    unsigned char* row = h6 + (size_t)t * V6_PITCH;
    *(u32x2*)(row + 24 * blk) = (u32x2){q[0], q[1]};
    *(u32x2*)(row + 24 * blk + 8) = (u32x2){q[2], q[3]};
    *(u32x2*)(row + 24 * blk + 16) = (u32x2){q[4], q[5]};
    row[mx_scale_pos(blk)] = (unsigned char)sb;
  }
}

template <int EPI>
DI void gemm_tile(const bf16_t* __restrict__ P, const bf16_t* __restrict__ Q, int it, int jt, void* outp, int ld,
                  const float* xin_lat, const float* xin_ctx, const float* modl, unsigned char* lds, bool gvar = false) {
  const int tid = ltid(), lane = tid & 63, w = tid >> 6, wi = w >> 1, wj = w & 1, lr = lane & 15, g = lane >> 4;
  const int wu = __builtin_amdgcn_readfirstlane(w);
  f32x4 acc[4][4];
#pragma unroll
  for (int a = 0; a < 4; ++a)
#pragma unroll
    for (int b = 0; b < 4; ++b) acc[a][b] = (f32x4){0.f, 0.f, 0.f, 0.f};
  const unsigned lo0 = (unsigned)((lane >> 3) * 1024 + (((lane & 7) ^ (lane >> 4)) << 3));
  const unsigned lo1 = (unsigned)((lane >> 3) * 1024 + (((lane & 7) ^ (4 + (lane >> 4))) << 3));
  const bf16_t* pg = P + (size_t)(it * 128 + 32 * wu) * 1024;
  const bf16_t* qg = Q + (size_t)(jt * 128 + 32 * wu) * 1024;
#define GT_DMA(kb, bf) do { _Pragma("unroll") for (int jj = 0; jj < 4; ++jj) { const unsigned lo_ = (jj & 1) ? lo1 : lo0; \
      __builtin_amdgcn_global_load_lds((const unsigned*)(pg + (size_t)jj * 8192 + (kb) * 64 + lo_), (unsigned*)(lds + (bf) * 32768 + (4 * wu + jj) * 1024), 16, 0, 0); \
      __builtin_amdgcn_global_load_lds((const unsigned*)(qg + (size_t)jj * 8192 + (kb) * 64 + lo_), (unsigned*)(lds + (bf) * 32768 + 16384 + (4 * wu + jj) * 1024), 16, 0, 0); } } while (0)
  __syncthreads();
  GT_DMA(0, 0);
  asm volatile("s_waitcnt vmcnt(0)" ::: "memory");
  __syncthreads();
  for (int kb = 0; kb < 16; ++kb) {
    if (kb < 15 && !(GEMM_VAR == 1 && gvar)) GT_DMA(kb + 1, (kb + 1) & 1);
    const unsigned char* Ps = lds + (kb & 1) * 32768;
    const unsigned char* Qs = Ps + 16384;
    bf16x8 pf[2][4], qf[2][4];
#pragma unroll
    for (int ks = 0; ks < 2; ++ks) {
      const int ch = ks * 4 + g;
#pragma unroll
      for (int mi = 0; mi < 4; ++mi) { const int row = wi * 64 + mi * 16 + lr; pf[ks][mi] = *(const bf16x8*)(Ps + (row >> 1) * 256 + (((((row & 1) << 3) | ch) ^ ((row >> 1) & 7)) << 4)); }
#pragma unroll
      for (int nj = 0; nj < 4; ++nj) { const int row = wj * 64 + nj * 16 + lr; qf[ks][nj] = *(const bf16x8*)(Qs + (row >> 1) * 256 + (((((row & 1) << 3) | ch) ^ ((row >> 1) & 7)) << 4)); }
    }
    __builtin_amdgcn_sched_barrier(0);
    __builtin_amdgcn_s_setprio(1);
#pragma unroll
    for (int ks = 0; ks < 2; ++ks)
#pragma unroll
      for (int mi = 0; mi < 4; ++mi)
#pragma unroll
        for (int nj = 0; nj < 4; ++nj) { if (GEMM_VAR == 2 && gvar) { asm volatile("" :: "v"(pf[ks][mi]), "v"(qf[ks][nj])); } else acc[mi][nj] = mfma16(pf[ks][mi], qf[ks][nj], acc[mi][nj]); }
    __builtin_amdgcn_s_setprio(0);
    __builtin_amdgcn_sched_barrier(0);
    asm volatile("s_waitcnt vmcnt(0)" ::: "memory");
    __syncthreads();
  }
#undef GT_DMA
  if (EPI == 2) {
    float inv[4];
#pragma unroll
    for (int r = 0; r < 4; ++r) inv[r] = __builtin_amdgcn_exp2f(-(float)(4 * g + r) * (13.287712379549449f / 16.f));
#pragma unroll
    for (int nj = 0; nj < 4; ++nj) {
      const int j = jt * 128 + wj * 64 + nj * 16 + lr;
      if (j < TL) {
        const float prow = (float)((j & 2047) >> 6), pcol = (float)(j & 63);
#pragma unroll
        for (int r = 0; r < 4; ++r) {
          const float a1 = prow * inv[r], a2 = pcol * inv[r];
          const float c1 = __cosf(a1), s1 = __sinf(a1), c2 = __cosf(a2), s2 = __sinf(a2);
          const float x1 = acc[0][nj][r], x2 = acc[1][nj][r], y1 = acc[2][nj][r], y2 = acc[3][nj][r];
          acc[0][nj][r] = x1 * c1 - x2 * s1; acc[1][nj][r] = x2 * c1 + x1 * s1;
          acc[2][nj][r] = y1 * c2 - y2 * s2; acc[3][nj][r] = y2 * c2 + y1 * s2;
        }
      }
    }
  }
#pragma unroll
  for (int mi = 0; mi < 4; ++mi)
#pragma unroll
    for (int nj = 0; nj < 4; ++nj) {
      const int j = jt * 128 + wj * 64 + nj * 16 + lr;
      const int i = it * 128 + wi * 64 + mi * 16 + 4 * g;
      const f32x4 a = acc[mi][nj];
      if (EPI == 0 || EPI == 2) {
        u32x2 o = {pk2(a[0], a[1]), pk2(a[2], a[3])};
        *(u32x2*)((bf16_t*)outp + (size_t)j * ld + i) = o;
      } else {
        const int b = j < TL ? (j >> 11) : 16;
        const float4 gt = *(const float4*)(modl + (size_t)b * 6144 + 2 * 1024 + i);
        float4 xv;
        if (xin_lat) {
          const float* xs = (j < TL) ? xin_lat + (size_t)j * 1024 + i : xin_ctx + (size_t)(j - TL) * 1024 + i;
          xv = *(const float4*)xs;
        } else {
          const u32x2 r = *(const u32x2*)((const bf16_t*)outp + (size_t)j * 1024 + i);
          xv = (float4){bflo(r.x), bfhi(r.x), bflo(r.y), bfhi(r.y)};
        }
        u32x2 o = {pk2(xv.x + gt.x * a[0], xv.y + gt.y * a[1]), pk2(xv.z + gt.z * a[2], xv.w + gt.w * a[3])};
        *(u32x2*)((bf16_t*)outp + (size_t)j * 1024 + i) = o;
      }
    }
}

struct TileIter {
  int u, step, total, nf, tpx, x;
  DI void init(int n_tok_tiles, int n_feat_tiles) {
    const int bid = lbid(), nb = lgdim();
    nf = n_feat_tiles;
    if ((nb & 7) == 0 && (n_tok_tiles & 7) == 0) { x = bid & 7; u = bid >> 3; step = nb >> 3; tpx = n_tok_tiles >> 3; }
    else { x = 0; u = bid; step = nb; tpx = n_tok_tiles; }
    total = tpx * nf;
  }
  DI bool valid() const { return u < total; }
  DI void next() { u += step; }
  DI void get(int& tok_tile, int& feat_tile) const {
    const int g = u / (8 * nf), rem = u - g * 8 * nf;
    const int gs = (tpx - 8 * g) < 8 ? (tpx - 8 * g) : 8;
    const int f = rem / gs, tt = rem - f * gs;
    tok_tile = x * tpx + 8 * g + tt; feat_tile = f;
  }
};

DI void phase_gemm_in(const Params& p, int l, unsigned char* lds, bool gvar = false) {
  const bf16_t* W = (const bf16_t*)(p.ws + OFF_WIN) + (size_t)l * 3200 * 1024;
  const bf16_t* H = (const bf16_t*)(p.ws + OFF_H);
  bf16_t* PN = (bf16_t*)(p.ws + OFF_P);
  bf16_t* VT = (bf16_t*)(p.ws + OFF_VT);
  TileIter ti; ti.init(TT / 128, 25);
  for (; ti.valid(); ti.next()) {
    int jt, f; ti.get(jt, f);
    if (f >= 8 && f < 16) gemm_tile<2>(W, H, f, jt, PN, PN_LD, nullptr, nullptr, nullptr, lds, gvar);
    else if (f < 17) gemm_tile<0>(W, H, f, jt, PN, PN_LD, nullptr, nullptr, nullptr, lds, gvar);
    else gemm_tile<0>(H, W + (size_t)2176 * 1024, jt, f - 17, VT, TT, nullptr, nullptr, nullptr, lds, gvar);
  }
}
DI void phase_gemm_out(const Params& p, int l, int ntok, unsigned char* lds) {
  const bf16_t* W = (const bf16_t*)(p.ws + OFF_WOUT) + (size_t)l * 1024 * 1024;
  const bf16_t* Y = (const bf16_t*)(p.ws + OFF_Y);
  bf16_t* xres = (bf16_t*)(p.ws + OFF_XRES);
  const float* modl = (const float*)(p.ws + OFF_MOD) + (size_t)l * 17 * 6144;
  const float* xl = (l == 0) ? p.x : nullptr;
  const float* xc = (l == 0) ? p.ctx : nullptr;
  TileIter ti; ti.init(ntok / 128, 8);
  for (; ti.valid(); ti.next()) {
    int jt, f; ti.get(jt, f);
    gemm_tile<1>(W, Y, f, jt, xres, 1024, xl, xc, modl, lds);
  }
}
DI void phase_gemm_q(const Params& p, int l, int ntok, unsigned char* lds) {
  const bf16_t* W = (const bf16_t*)(p.ws + OFF_WQ) + (size_t)l * 1024 * 1024;
  const bf16_t* H = (const bf16_t*)(p.ws + OFF_H);
  bf16_t* QP = (bf16_t*)(p.ws + OFF_QP);
  TileIter ti; ti.init(ntok / 128, 8);
  for (; ti.valid(); ti.next()) {
    int jt, f; ti.get(jt, f);
    gemm_tile<0>(W, H, f, jt, QP, 1024, nullptr, nullptr, nullptr, lds);
  }
}

DI void phase_rope(const Params& p, unsigned char* lds) {
  float2* tab = (float2*)lds;
  for (int e = ltid(); e < 1024; e += 256) {
    const int pos = e >> 4, i = e & 15;
    const float inv = exp2f(-(float)i * (13.287712379549449f / 16.f));
    const float ang = (float)pos * inv;
    tab[e] = make_float2(__cosf(ang), __sinf(ang));
  }
  __syncthreads();
  bf16_t* PN = (bf16_t*)(p.ws + OFF_P);
  const int total = TL * 16;
  for (int idx = lbid() * 256 + ltid(); idx < total; idx += lgdim() * 256) {
    const int t = idx >> 4, vec = idx & 15;
    const int col = ((vec >> 3) ? C_DK : C_DQ) + ((vec >> 1) & 3) * 128 + (vec & 1) * 64;
    bf16_t* ptr = PN + (size_t)t * PN_LD + col;
    float xv[64];
#pragma unroll
    for (int q = 0; q < 8; ++q) { const u32x4 v = *(const u32x4*)(ptr + q * 8); unpack8(v, xv + q * 8); }
    const int row = (t & 2047) >> 6, cp = t & 63;
#pragma unroll
    for (int i = 0; i < 16; ++i) {
      const float2 cs = tab[row * 16 + i];
      const float x1 = xv[i], x2 = xv[16 + i];
      xv[i] = x1 * cs.x - x2 * cs.y; xv[16 + i] = x2 * cs.x + x1 * cs.y;
      const float2 cs2 = tab[cp * 16 + i];
      const float y1 = xv[32 + i], y2 = xv[48 + i];
      xv[32 + i] = y1 * cs2.x - y2 * cs2.y; xv[48 + i] = y2 * cs2.x + y1 * cs2.y;
    }
#pragma unroll
    for (int q = 0; q < 8; ++q) {
      u32x4 o = {pk2(xv[q * 8], xv[q * 8 + 1]), pk2(xv[q * 8 + 2], xv[q * 8 + 3]), pk2(xv[q * 8 + 4], xv[q * 8 + 5]), pk2(xv[q * 8 + 6], xv[q * 8 + 7])};
      *(u32x4*)(ptr + q * 8) = o;
    }
  }
}

struct SrcSeg {
  const bf16_t* PN; const bf16_t* VT; int kcol, vrow, t0, n0, t1, n1, lr, g;
  DI int nsteps() const { return n0 + n1; }
  DI int tok0(int st) const { return st < n0 ? t0 + st * 32 : t1 + (st - n0) * 32; }
  DI float score(float raw, int st, int kt, int r) const { return raw * SC_LOG2; }
};
struct SrcNat {
  const bf16_t* PN; const bf16_t* VT; int kcol, vrow, b, rq, rs, cs, qc, cstart, lr, g;
  const float* rpbh;
  DI int nsteps() const { return 16; }
  DI int tok0(int st) const { return st < 8 ? b * 2048 + (rs + st) * 64 + cs : TL + b * 256 + (st - 8) * 32; }
  DI float score(float raw, int st, int kt, int r) const {
    if (st >= 8) return raw * SC_LOG2;
    const int kc = cs + 8 * g + 4 * kt + r;
    const bool valid = (kc >= cstart) && (kc < cstart + 16);
    int dc = kc - qc + 15; dc = dc < 0 ? 0 : (dc > 30 ? 30 : dc);
    const float bias = rpbh[(rs + st - rq + 7) * 31 + dc];
    return valid ? (raw * 0.125f + bias) * LOG2E : NEG_BIG;
  }
};

template <class Src>
struct FlashFrags { bf16x8 k[2][2]; bf16x8 v[4]; };
template <class Src>
DI void flash_load(const Src& S, int st, FlashFrags<Src>& F) {
  const int tk = S.tok0(st);
  const int kap = 8 * (S.lr >> 2) + (S.lr & 3);
  const bf16_t* k0p = S.PN + (size_t)(tk + kap) * PN_LD + S.kcol + 8 * S.g;
  const bf16_t* vp = S.VT + (size_t)(S.vrow + S.lr) * TT + tk + 8 * S.g;
#pragma unroll
  for (int kt = 0; kt < 2; ++kt)
#pragma unroll
    for (int ks = 0; ks < 2; ++ks) F.k[kt][ks] = *(const bf16x8*)(k0p + (size_t)kt * 4 * PN_LD + ks * 32);
#pragma unroll
  for (int dt = 0; dt < 4; ++dt) F.v[dt] = *(const bf16x8*)(vp + (size_t)dt * 16 * TT);
}
template <class Src>
DI void flash_step(const Src& S, int st, const FlashFrags<Src>& F, const bf16x8 (&qf)[2], f32x4 (&o)[4], float& mrun, float& lrun) {
  f32x4 s[2];
#pragma unroll
  for (int kt = 0; kt < 2; ++kt) {
    s[kt] = (f32x4){0.f, 0.f, 0.f, 0.f};
#pragma unroll
    for (int ks = 0; ks < 2; ++ks) s[kt] = mfma16(F.k[kt][ks], qf[ks], s[kt]);
  }
  float mt = NEG_BIG;
#pragma unroll
  for (int kt = 0; kt < 2; ++kt)
#pragma unroll
    for (int r = 0; r < 4; ++r) { s[kt][r] = S.score(s[kt][r], st, kt, r); mt = fmaxf(mt, s[kt][r]); }
  mt = rows_max(mt);
  const bool need = mt > mrun + 8.f;
  if (__any(need)) {
    const float mnew = need ? mt : mrun;
    const float alpha = __builtin_amdgcn_exp2f(mrun - mnew);
    lrun *= alpha;
#pragma unroll
    for (int dt = 0; dt < 4; ++dt) { o[dt][0] *= alpha; o[dt][1] *= alpha; o[dt][2] *= alpha; o[dt][3] *= alpha; }
    mrun = mnew;
  }
  float pv[8], ls = 0.f;
#pragma unroll
  for (int kt = 0; kt < 2; ++kt)
#pragma unroll
    for (int r = 0; r < 4; ++r) { pv[kt * 4 + r] = __builtin_amdgcn_exp2f(s[kt][r] - mrun); ls += pv[kt * 4 + r]; }
  lrun += ls;
  u32x4 pk = {pk2(pv[0], pv[1]), pk2(pv[2], pv[3]), pk2(pv[4], pv[5]), pk2(pv[6], pv[7])};
  const bf16x8 pf = __builtin_bit_cast(bf16x8, pk);
#pragma unroll
  for (int dt = 0; dt < 4; ++dt) o[dt] = mfma16(F.v[dt], pf, o[dt]);
}
template <class Src>
DI void flash_wave(const Src& S, const bf16_t* qptr  , f32x4 (&o)[4], float& ltot) {
  bf16x8 qf[2];
  qf[0] = *(const bf16x8*)(qptr); qf[1] = *(const bf16x8*)(qptr + 32);
  float mrun = NEG_BIG, lrun = 0.f;
#pragma unroll
  for (int dt = 0; dt < 4; ++dt) o[dt] = (f32x4){0.f, 0.f, 0.f, 0.f};
  const int ns = S.nsteps();
  FlashFrags<Src> f0, f1, f2;
  flash_load(S, 0, f0);
  if (ns > 1) flash_load(S, 1, f1);
  for (int st = 0; st < ns; st += 3) {
    if (st + 2 < ns) flash_load(S, st + 2, f2);
    flash_step(S, st, f0, qf, o, mrun, lrun);
    if (st + 1 < ns) {
      if (st + 3 < ns) flash_load(S, st + 3, f0);
      flash_step(S, st + 1, f1, qf, o, mrun, lrun);
    }
    if (st + 2 < ns) {
      if (st + 4 < ns) flash_load(S, st + 4, f1);
      flash_step(S, st + 2, f2, qf, o, mrun, lrun);
    }
  }
  ltot = rows_sum(lrun);
}

DI void nat_wave_task(const Params& p, int l, int b, int head, int rq, int ct, const float* rpb_lds) {
  const int lane = ltid() & 63, lr = lane & 15, g = lane >> 4;
  const bf16_t* PN = (const bf16_t*)(p.ws + OFF_P);
  const bf16_t* VT = (const bf16_t*)(p.ws + OFF_VT);
  bf16_t* Y = (bf16_t*)(p.ws + OFF_Y);
  SrcNat S;
  S.PN = PN; S.VT = VT; S.kcol = C_NK + head * 64; S.vrow = R_NV + head * 64; S.b = b; S.rq = rq; S.lr = lr; S.g = g;
  int rs = rq - 4; rs = rs < 0 ? 0 : (rs > 24 ? 24 : rs);
  S.rs = rs;
  int cs = 16 * ct - 8; cs = cs < 0 ? 0 : (cs > 32 ? 32 : cs);
  S.cs = cs;
  S.qc = 16 * ct + lr;
  int cst = S.qc - 8; cst = cst < 0 ? 0 : (cst > 48 ? 48 : cst);
  S.cstart = cst;
  S.rpbh = rpb_lds + head * 465;
  f32x4 o[4];
  float lt;
  const int qtok = b * 2048 + rq * 64 + 16 * ct + lr;
  flash_wave<SrcNat>(S, PN + (size_t)qtok * PN_LD + C_NQ + head * 64 + 8 * g, o, lt);
  const float inv = 1.f / lt;
#pragma unroll
  for (int dt = 0; dt < 4; ++dt) {
    u32x2 ov = {pk2(o[dt][0] * inv, o[dt][1] * inv), pk2(o[dt][2] * inv, o[dt][3] * inv)};
    *(u32x2*)(Y + (size_t)qtok * 1024 + 256 + head * 64 + dt * 16 + 4 * g) = ov;
  }
}
DI void natctx_wave_task(const Params& p, int b, int head, int qt) {
  const int lane = ltid() & 63, lr = lane & 15, g = lane >> 4;
  const bf16_t* PN = (const bf16_t*)(p.ws + OFF_P);
  const bf16_t* VT = (const bf16_t*)(p.ws + OFF_VT);
  bf16_t* Y = (bf16_t*)(p.ws + OFF_Y);
  SrcSeg S;
  S.PN = PN; S.VT = VT; S.kcol = C_NK + head * 64; S.vrow = R_NV + head * 64; S.lr = lr; S.g = g;
  S.t0 = TL + b * 256; S.n0 = 8; S.t1 = 0; S.n1 = 0;
  f32x4 o[4];
  float lt;
  const int qtok = TL + b * 256 + qt * 16 + lr;
  flash_wave<SrcSeg>(S, PN + (size_t)qtok * PN_LD + C_NQ + head * 64 + 8 * g, o, lt);
  const float inv = 1.f / lt;
#pragma unroll
  for (int dt = 0; dt < 4; ++dt) {
    u32x2 ov = {pk2(o[dt][0] * inv, o[dt][1] * inv), pk2(o[dt][2] * inv, o[dt][3] * inv)};
    *(u32x2*)(Y + (size_t)qtok * 1024 + 256 + head * 64 + dt * 16 + 4 * g) = ov;
  }
}

DI void diff_block_task(const Params& p, int l, int b, int hd, int qtok0, int nsteps, unsigned char* lds, int dvar = 0) {
  const int tid = ltid(), lane = tid & 63, w = tid >> 6, lr = lane & 15, g = lane >> 4;
  unsigned char* Kb = lds;
  unsigned char* Vb = lds + 8192;
  const bf16_t* PN = (const bf16_t*)(p.ws + OFF_P);
  const bf16_t* VT = (const bf16_t*)(p.ws + OFF_VT);
  bf16_t* Y = (bf16_t*)(p.ws + OFF_Y);
  bf16x8 qf[2][2][2];
#pragma unroll
  for (int qt = 0; qt < 2; ++qt) {
    const bf16_t* qp = PN + (size_t)(qtok0 + 32 * w + 16 * qt + lr) * PN_LD + C_DQ + hd * 128 + 8 * g;
#pragma unroll
    for (int m = 0; m < 2; ++m)
#pragma unroll
      for (int ks = 0; ks < 2; ++ks) {
        const u32x4 raw = *(const u32x4*)(qp + m * 64 + ks * 32);
        float f[8];
        unpack8(raw, f);
        u32x4 sc = {pk2(f[0] * SC_LOG2, f[1] * SC_LOG2), pk2(f[2] * SC_LOG2, f[3] * SC_LOG2), pk2(f[4] * SC_LOG2, f[5] * SC_LOG2), pk2(f[6] * SC_LOG2, f[7] * SC_LOG2)};
        qf[m][qt][ks] = __builtin_bit_cast(bf16x8, sc);
      }
  }
  const int wu = __builtin_amdgcn_readfirstlane(w);
  unsigned kofs[2], vofs[2];
#pragma unroll
  for (int jj = 0; jj < 2; ++jj) {
    const int krow = 4 * (2 * w + jj) + (lane >> 4), kpc = lane & 15;
    const int kch = kpc ^ (((krow >> 3) & 3) * 4 + (krow & 3));
    kofs[jj] = (unsigned)(krow * PN_LD + C_DK + hd * 128 + kch * 8);
    const int vrow = 16 * (2 * w + jj) + (lane >> 2), vpc = lane & 3;
    const int vch = vpc ^ ((vrow >> 2) & 3);
    vofs[jj] = (unsigned)((R_DV + hd * 128 + vrow) * TT + vch * 8);
  }
#define DB_DMA(st, sl) do { const int tk = (st) < 8 ? TL + b * 256 + (st) * 32 : b * 2048 + ((st) - 8) * 32; \
    const bf16_t* kb_ = PN + (size_t)tk * PN_LD; const bf16_t* vb_ = VT + tk; \
    _Pragma("unroll") for (int jj = 0; jj < 2; ++jj) { \
      __builtin_amdgcn_global_load_lds((const unsigned*)(kb_ + kofs[jj]), (unsigned*)(Kb + (sl) * 16384 + (2 * wu + jj) * 1024), 16, 0, 0); \
      __builtin_amdgcn_global_load_lds((const unsigned*)(vb_ + vofs[jj]), (unsigned*)(Vb + (sl) * 16384 + (2 * wu + jj) * 1024), 16, 0, 0); } } while (0)
  asm volatile("s_waitcnt vmcnt(0)" ::: "memory");
  __syncthreads();
  DB_DMA(0, 0);
  DB_DMA(nsteps > 1 ? 1 : 0, 1);
  DB_DMA(nsteps > 2 ? 2 : nsteps - 1, 2);
  asm volatile("s_waitcnt vmcnt(8)" ::: "memory");
  __builtin_amdgcn_s_barrier();

  f32x4 o[2][2][8];
  float mrun[2][2], lrun[2][2];
#pragma unroll
  for (int m = 0; m < 2; ++m)
#pragma unroll
    for (int qt = 0; qt < 2; ++qt) {
      mrun[m][qt] = NEG_BIG; lrun[m][qt] = 0.f;
#pragma unroll
      for (int dt = 0; dt < 8; ++dt) o[m][qt][dt] = (f32x4){0.f, 0.f, 0.f, 0.f};
    }
  const int kfr = 8 * (lr >> 2) + (lr & 3);
  for (int st = 0; st < nsteps; ++st) {
    if (dvar != 1) { const int sn = st + 3 < nsteps ? st + 3 : nsteps - 1; DB_DMA(sn, (st + 3) & 3); }
    const unsigned char* Kt = Kb + (st & 3) * 16384;
    const unsigned char* Vt = Vb + (st & 3) * 16384;
    bf16x8 pf[2][2];
#pragma unroll
    for (int m = 0; m < 2; ++m) {
      bf16x8 kf[2][2];
#pragma unroll
      for (int kt = 0; kt < 2; ++kt)
#pragma unroll
        for (int ks = 0; ks < 2; ++ks) kf[kt][ks] = *(const bf16x8*)(Kt + (kfr + 4 * kt) * 256 + (((m * 8 + ks * 4 + g) ^ lr) << 4));
      __builtin_amdgcn_sched_barrier(0);
      f32x4 s[2][2];
#pragma unroll
      for (int qt = 0; qt < 2; ++qt)
#pragma unroll
        for (int kt = 0; kt < 2; ++kt) {
          s[qt][kt] = (f32x4){0.f, 0.f, 0.f, 0.f};
#pragma unroll
          for (int ks = 0; ks < 2; ++ks) s[qt][kt] = mfma16(kf[kt][ks], qf[m][qt][ks], s[qt][kt]);
        }
      __builtin_amdgcn_sched_barrier(0);
#pragma unroll
      for (int qt = 0; qt < 2; ++qt) {
        if (dvar == 2) {
          u32x4 pk = {pk2(s[qt][0][0], s[qt][0][1]), pk2(s[qt][0][2], s[qt][0][3]), pk2(s[qt][1][0], s[qt][1][1]), pk2(s[qt][1][2], s[qt][1][3])};
          pf[m][qt] = __builtin_bit_cast(bf16x8, pk);
          continue;
        }
        float mt = NEG_BIG;
#pragma unroll
        for (int kt = 0; kt < 2; ++kt)
#pragma unroll
          for (int r = 0; r < 4; ++r) mt = fmaxf(mt, s[qt][kt][r]);
        mt = rows_max(mt);
        const bool need = mt > mrun[m][qt] + 8.f;
        if (__any(need)) {
          const float mnew = need ? mt : mrun[m][qt];
          const float alpha = __builtin_amdgcn_exp2f(mrun[m][qt] - mnew);
          lrun[m][qt] *= alpha;
#pragma unroll
          for (int dt = 0; dt < 8; ++dt) { o[m][qt][dt][0] *= alpha; o[m][qt][dt][1] *= alpha; o[m][qt][dt][2] *= alpha; o[m][qt][dt][3] *= alpha; }
          mrun[m][qt] = mnew;
        }
        float pv[8], ls = 0.f;
#pragma unroll
        for (int kt = 0; kt < 2; ++kt)
#pragma unroll
          for (int r = 0; r < 4; ++r) { pv[kt * 4 + r] = __builtin_amdgcn_exp2f(s[qt][kt][r] - mrun[m][qt]); ls += pv[kt * 4 + r]; }
        lrun[m][qt] += ls;
        u32x4 pk = {pk2(pv[0], pv[1]), pk2(pv[2], pv[3]), pk2(pv[4], pv[5]), pk2(pv[6], pv[7])};
        pf[m][qt] = __builtin_bit_cast(bf16x8, pk);
      }
      __builtin_amdgcn_sched_barrier(0);
    }
#pragma unroll
    for (int hb = 0; hb < 2; ++hb) {
      bf16x8 vf[4];
#pragma unroll
      for (int d4 = 0; d4 < 4; ++d4) {
        const int vr = 16 * (4 * hb + d4) + lr;
        vf[d4] = *(const bf16x8*)(Vt + vr * 64 + ((g ^ ((vr >> 2) & 3)) << 4));
      }
      __builtin_amdgcn_sched_barrier(0);
#pragma unroll
      for (int d4 = 0; d4 < 4; ++d4)
#pragma unroll
        for (int m = 0; m < 2; ++m)
#pragma unroll
          for (int qt = 0; qt < 2; ++qt) { if (dvar == 3) asm volatile("" :: "v"(vf[d4]), "v"(pf[m][qt])); else o[m][qt][4 * hb + d4] = mfma16(vf[d4], pf[m][qt], o[m][qt][4 * hb + d4]); }
      __builtin_amdgcn_sched_barrier(0);
    }
    asm volatile("s_waitcnt vmcnt(8)" ::: "memory");
    __builtin_amdgcn_s_barrier();
  }
  asm volatile("s_waitcnt vmcnt(0)" ::: "memory");
#undef DB_DMA
  const float* lv = p.dlam + l * 256;
  float sa = lv[lane] * lv[64 + lane], sb = lv[128 + lane] * lv[192 + lane];
  sa = wave_sum(sa); sb = wave_sum(sb);
  const float lam_init = 0.8f - 0.6f * expf(-0.3f * (float)l);
  const float lam = expf(sa) - expf(sb) + lam_init;
  const float* dg = p.diff_g + l * 512 + hd * 128;
#pragma unroll
  for (int qt = 0; qt < 2; ++qt) {
    float l0 = lrun[0][qt], l1 = lrun[1][qt];
    l0 = rows_sum(l0);
    l1 = rows_sum(l1);
    const float i0 = 1.f / l0, i1 = lam / l1;
    float ss = 0.f;
#pragma unroll
    for (int dt = 0; dt < 8; ++dt)
#pragma unroll
      for (int r = 0; r < 4; ++r) { const float v = o[0][qt][dt][r] * i0 - o[1][qt][dt][r] * i1; o[0][qt][dt][r] = v; ss += v * v; }
    ss = rows_sum(ss);
    const float rstd = rsqrtf(ss * (1.f / 128.f) + 1e-6f) * (1.f - lam_init);
    const int qtok = qtok0 + 32 * w + 16 * qt + lr;
#pragma unroll
    for (int dt = 0; dt < 8; ++dt) {
      const float4 gg = *(const float4*)(dg + dt * 16 + 4 * g);
      u32x2 ov = {pk2(o[0][qt][dt][0] * rstd * gg.x, o[0][qt][dt][1] * rstd * gg.y), pk2(o[0][qt][dt][2] * rstd * gg.z, o[0][qt][dt][3] * rstd * gg.w)};
      *(u32x2*)(Y + (size_t)qtok * 1024 + 512 + hd * 128 + dt * 16 + 4 * g) = ov;
    }
  }
}


DI void nat_block_task(const Params& p, int l, int b, int head, int rq, const float* rpb_lds, unsigned char* lds) {
  const int tid = ltid(), lane = tid & 63, w = tid >> 6, lr = lane & 15, g = lane >> 4;
  const int wu = __builtin_amdgcn_readfirstlane(w);
  unsigned char* Kb = lds;
  unsigned char* Vb = lds + 8192;
  const bf16_t* PN = (const bf16_t*)(p.ws + OFF_P);
  const bf16_t* VT = (const bf16_t*)(p.ws + OFF_VT);
  bf16_t* Y = (bf16_t*)(p.ws + OFF_Y);
  int rs = rq - 4; rs = rs < 0 ? 0 : (rs > 24 ? 24 : rs);
  const int ct = w;
  int cs = 16 * ct - 8; cs = cs < 0 ? 0 : (cs > 32 ? 32 : cs);
  const int qc = 16 * ct + lr;
  int cstart = qc - 8; cstart = cstart < 0 ? 0 : (cstart > 48 ? 48 : cstart);
  const float* rpbh = rpb_lds + head * 465;
  const int qtok = b * 2048 + rq * 64 + qc;
  bf16x8 qf[2];
  { const bf16_t* qp = PN + (size_t)qtok * PN_LD + C_NQ + head * 64 + 8 * g; qf[0] = *(const bf16x8*)qp; qf[1] = *(const bf16x8*)(qp + 32); }
  unsigned kofs[2], vofs[2];
#pragma unroll
  for (int jj = 0; jj < 2; ++jj) {
    const int pidx = 2 * w + jj, row = 8 * pidx + (lane >> 3);
    const int kch = (lane & 7) ^ ((((row >> 3) & 3) << 1) | ((row >> 1) & 1));
    kofs[jj] = (unsigned)(row * PN_LD + C_NK + head * 64 + kch * 8);
    const int vch = (lane & 7) ^ ((row >> 1) & 7);
    vofs[jj] = (unsigned)((R_NV + head * 64 + row) * TT + vch * 8);
  }
#define NB_DMA(st, bf) do { const int tk = (st) < 8 ? b * 2048 + (rs + (st)) * 64 : TL + b * 256 + ((st) - 8) * 64; \
    const bf16_t* kb_ = PN + (size_t)tk * PN_LD; const bf16_t* vb_ = VT + tk; \
    _Pragma("unroll") for (int jj = 0; jj < 2; ++jj) { \
      __builtin_amdgcn_global_load_lds((const unsigned*)(kb_ + kofs[jj]), (unsigned*)(Kb + (bf) * 16384 + (2 * wu + jj) * 1024), 16, 0, 0); \
      __builtin_amdgcn_global_load_lds((const unsigned*)(vb_ + vofs[jj]), (unsigned*)(Vb + (bf) * 16384 + (2 * wu + jj) * 1024), 16, 0, 0); } } while (0)
  asm volatile("s_waitcnt vmcnt(0)" ::: "memory");
  __syncthreads();
  NB_DMA(0, 0); NB_DMA(1, 1); NB_DMA(2, 2);
  asm volatile("s_waitcnt vmcnt(8)" ::: "memory");
  __builtin_amdgcn_s_barrier();
  f32x4 o[4];
#pragma unroll
  for (int dt = 0; dt < 4; ++dt) o[dt] = (f32x4){0.f, 0.f, 0.f, 0.f};
  float mrun = NEG_BIG, lrun = 0.f;
  const int kap = 8 * (lr >> 2) + (lr & 3);
  for (int st = 0; st < 12; ++st) {
    { const int sn = st + 3 < 12 ? st + 3 : 11; NB_DMA(sn, (st + 3) & 3); }
    const unsigned char* Kt = Kb + (st & 3) * 16384;
    const unsigned char* Vt = Vb + (st & 3) * 16384;
    const int nsub = st < 8 ? 1 : 2;
    for (int sub = 0; sub < nsub; ++sub) {
      const int koff = st < 8 ? cs : 32 * sub;
      bf16x8 kf[2][2], vf[4];
#pragma unroll
      for (int kt = 0; kt < 2; ++kt) {
        const int row = koff + kap + 4 * kt;
        const int sw = (((row >> 3) & 3) << 1) | ((row >> 1) & 1);
#pragma unroll
        for (int ks = 0; ks < 2; ++ks) kf[kt][ks] = *(const bf16x8*)(Kt + (row >> 1) * 256 + ((((row & 1) << 3) | ((ks * 4 + g) ^ sw)) << 4));
      }
#pragma unroll
      for (int dt = 0; dt < 4; ++dt) {
        const int row = 16 * dt + lr, ch = (koff >> 3) + g;
        vf[dt] = *(const bf16x8*)(Vt + (row >> 1) * 256 + (((((row & 1) << 3) | ch) ^ ((row >> 1) & 7)) << 4));
      }
      f32x4 s[2];
#pragma unroll
      for (int kt = 0; kt < 2; ++kt) {
        s[kt] = (f32x4){0.f, 0.f, 0.f, 0.f};
#pragma unroll
        for (int ks = 0; ks < 2; ++ks) s[kt] = mfma16(kf[kt][ks], qf[ks], s[kt]);
      }
      float mt = NEG_BIG;
#pragma unroll
      for (int kt = 0; kt < 2; ++kt)
#pragma unroll
        for (int r = 0; r < 4; ++r) {
          float sv;
          if (st < 8) {
            const int kc = cs + 8 * g + 4 * kt + r;
            const bool valid = (kc >= cstart) && (kc < cstart + 16);
            int dc = kc - qc + 15; dc = dc < 0 ? 0 : (dc > 30 ? 30 : dc);
            const float bias = rpbh[(rs + st - rq + 7) * 31 + dc];
            sv = valid ? (s[kt][r] * 0.125f + bias) * LOG2E : NEG_BIG;
          } else sv = s[kt][r] * SC_LOG2;
          s[kt][r] = sv; mt = fmaxf(mt, sv);
        }
      mt = rows_max(mt);
      const bool need = mt > mrun + 8.f;
      if (__any(need)) {
        const float mnew = need ? mt : mrun;
        const float alpha = __builtin_amdgcn_exp2f(mrun - mnew);
        lrun *= alpha;
#pragma unroll
        for (int dt = 0; dt < 4; ++dt) { o[dt][0] *= alpha; o[dt][1] *= alpha; o[dt][2] *= alpha; o[dt][3] *= alpha; }
        mrun = mnew;
      }
      float pv[8], ls = 0.f;
#pragma unroll
      for (int kt = 0; kt < 2; ++kt)
#pragma unroll
        for (int r = 0; r < 4; ++r) { pv[kt * 4 + r] = __builtin_amdgcn_exp2f(s[kt][r] - mrun); ls += pv[kt * 4 + r]; }
      lrun += ls;
      u32x4 pk = {pk2(pv[0], pv[1]), pk2(pv[2], pv[3]), pk2(pv[4], pv[5]), pk2(pv[6], pv[7])};
      const bf16x8 pf = __builtin_bit_cast(bf16x8, pk);
#pragma unroll
      for (int dt = 0; dt < 4; ++dt) o[dt] = mfma16(vf[dt], pf, o[dt]);
    }
    asm volatile("s_waitcnt vmcnt(8)" ::: "memory");
    __builtin_amdgcn_s_barrier();
  }
  asm volatile("s_waitcnt vmcnt(0)" ::: "memory");
#undef NB_DMA
  const float inv = 1.f / rows_sum(lrun);
#pragma unroll
  for (int dt = 0; dt < 4; ++dt) {
    u32x2 ov = {pk2(o[dt][0] * inv, o[dt][1] * inv), pk2(o[dt][2] * inv, o[dt][3] * inv)};
    *(u32x2*)(Y + (size_t)qtok * 1024 + 256 + head * 64 + dt * 16 + 4 * g) = ov;
  }
}

DI float quad_sum(float v) {
  v += __int_as_float(__builtin_amdgcn_mov_dpp(__float_as_int(v), 0xB1, 0xF, 0xF, true));
  v += __int_as_float(__builtin_amdgcn_mov_dpp(__float_as_int(v), 0x4E, 0xF, 0xF, true));
  return v;
}
DI void gla_task(const Params& p, int l, int task, unsigned char* lds, int var = 0) {
  const int tid = ltid(), lane = tid & 63, w = tid >> 6, vv = lane >> 2, g = lane & 3;
  const int b = task >> 3, h = (task >> 1) & 3, dir = task & 1;
  const bf16_t* PN = (const bf16_t*)(p.ws + OFF_P);
  const bf16_t* VT = (const bf16_t*)(p.ws + OFF_VT);
  float* og = (float*)(p.ws + OFF_H);
  float* Gup = (float*)lds;
  float* Gb = Gup + 512;
  float* As = Gb + 32;
  float* Ks = As + 2048;
  float* Qs = Ks + 2048;
  float* Vs = Qs + 2048;
  __syncthreads();
  for (int e = tid; e < 512; e += 256) { const int r = e >> 5, kd = e & 31; Gup[e] = p.gate_up[((size_t)(l * 2 + dir) * 16 + r) * 128 + h * 32 + kd]; }
  if (tid < 32) Gb[tid] = p.gate_b[(l * 2 + dir) * 128 + h * 32 + tid];
  float S[8];
#pragma unroll
  for (int e = 0; e < 8; ++e) S[e] = 0.f;
  const int si = tid >> 2, part = tid & 3;
  u32x4 rq, rk, rg0, rg1, rv0, rv1;
#define GLA_TOK0(cc) ((cc) < 4 ? TL + b * 256 + (dir == 0 ? (cc) : 3 - (cc)) * 64 : b * 2048 + (dir == 0 ? (cc) - 4 : 35 - (cc)) * 64)
#define GLA_LOAD(cc) do { const int t0_ = GLA_TOK0(cc); const bf16_t* row = PN + (size_t)(t0_ + si) * PN_LD; \
    rq = *(const u32x4*)(row + C_GQ + h * 32 + part * 8); rk = *(const u32x4*)(row + C_GK + h * 32 + part * 8); \
    rg0 = *(const u32x4*)(row + C_GATE + dir * 16); rg1 = *(const u32x4*)(row + C_GATE + dir * 16 + 8); \
    const bf16_t* vp = VT + (size_t)(R_GV + h * 64 + si) * TT + t0_ + part * 16; rv0 = *(const u32x4*)vp; rv1 = *(const u32x4*)(vp + 8); } while (0)
#define GLA_WRITE() do { float gd[16], qf[8], kf[8], vf[16], pre[8]; \
    unpack8(rg0, gd); unpack8(rg1, gd + 8); unpack8(rq, qf); unpack8(rk, kf); unpack8(rv0, vf); unpack8(rv1, vf + 8); \
    { const float4 b0 = *(const float4*)(Gb + part * 8), b1 = *(const float4*)(Gb + part * 8 + 4); \
      pre[0] = b0.x; pre[1] = b0.y; pre[2] = b0.z; pre[3] = b0.w; pre[4] = b1.x; pre[5] = b1.y; pre[6] = b1.z; pre[7] = b1.w; } \
    _Pragma("unroll") for (int r = 0; r < 16; ++r) { const float4 u0 = *(const float4*)(Gup + r * 32 + part * 8), u1 = *(const float4*)(Gup + r * 32 + part * 8 + 4); \
      pre[0] += gd[r] * u0.x; pre[1] += gd[r] * u0.y; pre[2] += gd[r] * u0.z; pre[3] += gd[r] * u0.w; \
      pre[4] += gd[r] * u1.x; pre[5] += gd[r] * u1.y; pre[6] += gd[r] * u1.z; pre[7] += gd[r] * u1.w; } \
    float av[8]; \
    _Pragma("unroll") for (int e = 0; e < 8; ++e) { const float ls = fminf(pre[e], 0.f) - __logf(1.f + __expf(-fabsf(pre[e]))); av[e] = __expf(ls * (1.f / 16.f)); } \
    *(float4*)(As + si * 32 + part * 8) = (float4){av[0], av[1], av[2], av[3]}; *(float4*)(As + si * 32 + part * 8 + 4) = (float4){av[4], av[5], av[6], av[7]}; \
    *(float4*)(Ks + si * 32 + part * 8) = (float4){kf[0], kf[1], kf[2], kf[3]}; *(float4*)(Ks + si * 32 + part * 8 + 4) = (float4){kf[4], kf[5], kf[6], kf[7]}; \
    { const float qs_ = 0.17677669529663687f; \
      *(float4*)(Qs + si * 32 + part * 8) = (float4){qf[0] * qs_, qf[1] * qs_, qf[2] * qs_, qf[3] * qs_}; *(float4*)(Qs + si * 32 + part * 8 + 4) = (float4){qf[4] * qs_, qf[5] * qs_, qf[6] * qs_, qf[7] * qs_}; } \
      \
    _Pragma("unroll") for (int e = 0; e < 4; ++e) *(float4*)(Vs + si * 68 + part * 16 + 4 * e) = (float4){vf[4 * e], vf[4 * e + 1], vf[4 * e + 2], vf[4 * e + 3]}; } while (0)
  GLA_LOAD(0);
  __syncthreads();
  GLA_WRITE();
  __syncthreads();
  for (int cc = 0; cc < 36; ++cc) {
    const int tok0 = GLA_TOK0(cc);
    if (cc + 1 < 36) GLA_LOAD(cc + 1);
    float* ob = og + ((size_t)dir * TT + tok0) * 256 + h * 64 + 16 * w + vv;
#pragma unroll 1
    for (int s0 = 0; s0 < 64; s0 += 4) {
      float4 a0[4], a1[4], k0[4], k1[4], q0[4], q1[4];
      float vx[4];
      const int ib = dir == 0 ? s0 : 63 - s0, di = dir == 0 ? 1 : -1;
#pragma unroll
      for (int u = 0; u < 4; ++u) {
        const int i = ib + di * u;
        a0[u] = *(const float4*)(As + i * 32 + 8 * g); a1[u] = *(const float4*)(As + i * 32 + 8 * g + 4);
        k0[u] = *(const float4*)(Ks + i * 32 + 8 * g); k1[u] = *(const float4*)(Ks + i * 32 + 8 * g + 4);
        q0[u] = *(const float4*)(Qs + i * 32 + 8 * g); q1[u] = *(const float4*)(Qs + i * 32 + 8 * g + 4);
        vx[u] = Vs[(16 * w + vv) * 68 + i];
      }
      float* op = ob + (ptrdiff_t)ib * 256;
#pragma unroll
      for (int u = 0; u < 4; ++u) {
        const float v = vx[u];
        S[0] = fmaf(a0[u].x, S[0], k0[u].x * v); S[1] = fmaf(a0[u].y, S[1], k0[u].y * v);
        S[2] = fmaf(a0[u].z, S[2], k0[u].z * v); S[3] = fmaf(a0[u].w, S[3], k0[u].w * v);
        S[4] = fmaf(a1[u].x, S[4], k1[u].x * v); S[5] = fmaf(a1[u].y, S[5], k1[u].y * v);
        S[6] = fmaf(a1[u].z, S[6], k1[u].z * v); S[7] = fmaf(a1[u].w, S[7], k1[u].w * v);
        const float oa = fmaf(q0[u].x, S[0], q0[u].y * S[1]), ob2 = fmaf(q0[u].z, S[2], q0[u].w * S[3]);
        const float oc = fmaf(q1[u].x, S[4], q1[u].y * S[5]), od = fmaf(q1[u].z, S[6], q1[u].w * S[7]);
        float o = (oa + ob2) + (oc + od);
        o = quad_sum(o);
        op[(ptrdiff_t)(di * u) * 256] = o;
      }
    }
    __syncthreads();
    if (cc + 1 < 36) GLA_WRITE();
    __syncthreads();
  }
#undef GLA_TOK0
#undef GLA_LOAD
#undef GLA_WRITE
}

DI void phase_mixers(const Params& p, int l, bool last, unsigned* ctr, unsigned char* lds, int mask = 15, int gvar = 0) {
  const int tid = ltid(), w = tid >> 6;
  volatile int* slot = (volatile int*)(lds + LDS_BYTES - 16);
  float* rpb_lds = (float*)(lds + 65536);
  for (int e = tid; e < 4 * 465; e += 256) rpb_lds[e] = p.rpb[(size_t)l * 4 * 465 + e];
  const int nconv = (l == 0 && (mask & 8)) ? 1024 : 0;
  const int t1 = 128 + nconv, t2 = t1 + 1024, t3 = t2 + 2048, t4 = t3 + 128;
  const int ntask = last ? t3 : t4 + 256;
  for (;;) {
    __syncthreads();
    if (tid == 0) *slot = (int)atomicAdd(ctr, 1u);
    __syncthreads();
    const int task = *slot;
    if (task >= ntask) break;
    if (task < 128) { if (mask & 1) { __builtin_amdgcn_s_setprio(3); gla_task(p, l, task, lds, gvar); __builtin_amdgcn_s_setprio(0); } }
    else if (nconv && task < t2 && ((task - 128) & 1)) { const int c = (task - 128) >> 1; convert_table_pairs(p, c * 64, c * 64 + 64, w, 4, tid & 63); }
    else if (!(mask & 2) && (task < t2 || (task >= t3 && task < t4))) {}
    else if (!(mask & 4) && ((task >= t2 && task < t3) || task >= t4)) {}
    else if (task < t2) { const int d = nconv ? (task - 128) >> 1 : task - 128; const int b = d >> 6; diff_block_task(p, l, b, (d >> 4) & 3, b * 2048 + (d & 15) * 128, 72, lds, gvar); }
    else if (task < t3) { const int d = task - t2; nat_block_task(p, l, d >> 7, (d >> 5) & 3, d & 31, rpb_lds, lds); }
    else if (task < t4) { const int d = task - t3; const int b = d >> 3; diff_block_task(p, l, b, (d >> 1) & 3, TL + b * 256 + (d & 1) * 128, 8, lds); }
    else { const int wt = (task - t4) * 4 + w; natctx_wave_task(p, wt >> 6, (wt >> 4) & 3, wt & 15); }
  }
}

DI void phase_gla_fin(const Params& p, int l, int ntok) {
  const int lane = ltid() & 63, gw = lbid() * 4 + (ltid() >> 6), nw = lgdim() * 4;
  const float* og = (const float*)(p.ws + OFF_H);
  const bf16_t* PN = (const bf16_t*)(p.ws + OFF_P);
  bf16_t* Y = (bf16_t*)(p.ws + OFF_Y);
  const float4 gg = *(const float4*)(p.gla_norm_g + l * 256 + 4 * lane);
  for (int t = gw; t < ntok; t += nw) {
    const float4 a = *(const float4*)(og + (size_t)t * 256 + 4 * lane), bq = *(const float4*)(og + ((size_t)TT + t) * 256 + 4 * lane);
    const float o0 = a.x + bq.x, o1 = a.y + bq.y, o2 = a.z + bq.z, o3 = a.w + bq.w;
    float ss = o0 * o0 + o1 * o1 + o2 * o2 + o3 * o3;
    ss += __shfl_xor(ss, 1); ss += __shfl_xor(ss, 2); ss += __shfl_xor(ss, 4); ss += __shfl_xor(ss, 8);
    const float rstd = rsqrtf(ss * (1.f / 64.f) + 1e-6f);
    const u32x2 rv = *(const u32x2*)(PN + (size_t)t * PN_LD + C_GR + 4 * lane);
    const float r0 = bflo(rv.x), r1 = bfhi(rv.x), r2 = bflo(rv.y), r3 = bfhi(rv.y);
    const float y0 = o0 * rstd * gg.x * (r0 / (1.f + __expf(-r0)));
    const float y1 = o1 * rstd * gg.y * (r1 / (1.f + __expf(-r1)));
    const float y2 = o2 * rstd * gg.z * (r2 / (1.f + __expf(-r2)));
    const float y3 = o3 * rstd * gg.w * (r3 / (1.f + __expf(-r3)));
    u32x2 ov = {pk2(y0, y1), pk2(y2, y3)};
    *(u32x2*)(Y + (size_t)t * 1024 + 4 * lane) = ov;
  }
}


DI void ce_desc(float& a, float& b) {
  float hi, lo;
  asm("v_max_f32 %0, %2, %3\n\tv_min_f32 %1, %2, %3" : "=&v"(hi), "=&v"(lo) : "v"(a), "v"(b));
  a = hi; b = lo;
}
DI float vmaxf(float a, float b) { float r; asm("v_max_f32 %0, %1, %2" : "=v"(r) : "v"(a), "v"(b)); return r; }
template <int N>
DI void bitonic_sort_desc(float (&x)[N]) {
#pragma unroll
  for (int k = 2; k <= N; k <<= 1)
#pragma unroll
    for (int j = k >> 1; j > 0; j >>= 1)
#pragma unroll
      for (int i = 0; i < N; ++i) {
        const int l = i ^ j;
        if (l > i) { if ((i & k) == 0) ce_desc(x[i], x[l]); else ce_desc(x[l], x[i]); }
      }
}
template <int N>
DI void bitonic_merge_desc(float (&x)[N]) {
#pragma unroll
  for (int j = N >> 1; j > 0; j >>= 1)
#pragma unroll
    for (int i = 0; i < N; ++i) { const int l = i ^ j; if (l > i) ce_desc(x[i], x[l]); }
}
DI void rows_merge_top16(float (&L)[16]) {
  {
    float A0[16], A1[16];
#pragma unroll
    for (int i = 0; i < 16; ++i) { const u32x2 s = __builtin_amdgcn_permlane32_swap(__float_as_uint(L[i]), __float_as_uint(L[i]), false, false); A0[i] = __uint_as_float(s[0]); A1[i] = __uint_as_float(s[1]); }
#pragma unroll
    for (int i = 0; i < 16; ++i) L[i] = vmaxf(A0[i], A1[15 - i]);
    bitonic_merge_desc<16>(L);
  }
  {
    float A0[16], A1[16];
#pragma unroll
    for (int i = 0; i < 16; ++i) { const u32x2 s = __builtin_amdgcn_permlane16_swap(__float_as_uint(L[i]), __float_as_uint(L[i]), false, false); A0[i] = __uint_as_float(s[0]); A1[i] = __uint_as_float(s[1]); }
#pragma unroll
    for (int i = 0; i < 16; ++i) L[i] = vmaxf(A0[i], A1[15 - i]);
    bitonic_merge_desc<16>(L);
  }
}

struct PairTab { int a[52], b[52]; };
constexpr PairTab make_pairs() {
  PairTab t{};
  int n = 0;
  for (int a = 0; a < 16; ++a)
    for (int b = 0; b < 16; ++b)
      if ((a + 1) * (b + 1) <= 16) { t.a[n] = a; t.b[n] = b; ++n; }
  for (; n < 52; ++n) { t.a[n] = -1; t.b[n] = -1; }
  return t;
}

DI void topk_half(const bf16_t* skh  , const bf16_t* qrow  , int lr, int g, float (&list)[16]) {
  bf16x8 qf[2];
  qf[0] = *(const bf16x8*)(qrow); qf[1] = *(const bf16x8*)(qrow + 32);
  float s[32];
#pragma unroll
  for (int nt = 0; nt < 8; ++nt) {
    f32x4 acc = {0.f, 0.f, 0.f, 0.f};
#pragma unroll
    for (int ks = 0; ks < 2; ++ks) {
      const bf16x8 af = *(const bf16x8*)(skh + (size_t)(nt * 16 + lr) * 64 + ks * 32 + 8 * g);
      acc = mfma16(af, qf[ks], acc);
    }
#pragma unroll
    for (int r = 0; r < 4; ++r) {
      const unsigned n = nt * 16 + 4 * g + r;
      s[nt * 4 + r] = __uint_as_float((__float_as_uint(acc[r]) & ~127u) | n);
    }
  }
  float a[16], bq[16];
#pragma unroll
  for (int i = 0; i < 16; ++i) { a[i] = s[i]; bq[i] = s[16 + i]; }
  bitonic_sort_desc<16>(a);
  bitonic_sort_desc<16>(bq);
#pragma unroll
  for (int i = 0; i < 16; ++i) list[i] = vmaxf(a[i], bq[15 - i]);
  bitonic_merge_desc<16>(list);
  rows_merge_top16(list);
}

DI void topk_tile(const bf16_t* QP, const bf16_t* sk, int tt, int hd, int* eid_rows, float* gate_rows, int lr, int g) {
  constexpr PairTab PT = make_pairs();
  {
    const int tok = tt * 16 + lr;
    float v1[16], v2[16];
    topk_half(sk, QP + (size_t)tok * 1024 + hd * 128 + 8 * g, lr, g, v1);
    __builtin_amdgcn_sched_barrier(0);
    topk_half(sk + 128 * 64, QP + (size_t)tok * 1024 + hd * 128 + 64 + 8 * g, lr, g, v2);
    __builtin_amdgcn_sched_barrier(0);
    float cand[13];
#pragma unroll
    for (int c = 0; c < 13; ++c) {
      float sv[4];
#pragma unroll
      for (int gi = 0; gi < 4; ++gi) {
        const int pi = 4 * c + gi;
        if (PT.a[pi] >= 0) {
          const float a = v1[PT.a[pi] < 0 ? 0 : PT.a[pi]], bq = v2[PT.b[pi] < 0 ? 0 : PT.b[pi]];
          sv[gi] = __uint_as_float((__float_as_uint(a + bq) & ~255u) | (unsigned)(PT.a[pi] * 16 + PT.b[pi]));
        } else { sv[gi] = -3.0e38f; }
      }
      cand[c] = g == 0 ? sv[0] : (g == 1 ? sv[1] : (g == 2 ? sv[2] : sv[3]));
    }
    float topv[16];
#pragma unroll
    for (int c = 0; c < 13; ++c) topv[c] = cand[c];
    topv[13] = -3.0e38f; topv[14] = -3.1e38f; topv[15] = -3.2e38f;
    bitonic_sort_desc<16>(topv);
    rows_merge_top16(topv);
#pragma unroll
    for (int q = 0; q < 4; ++q) {
      const float wv = g == 0 ? topv[q] : (g == 1 ? topv[4 + q] : (g == 2 ? topv[8 + q] : topv[12 + q]));
      const int ia = (int)((__float_as_uint(wv) >> 4) & 15u), ib = (int)(__float_as_uint(wv) & 15u);
      unsigned e1 = 0, e2 = 0;
#pragma unroll
      for (int c = 0; c < 16; ++c) { if (ia == c) e1 = __float_as_uint(v1[c]) & 127u; if (ib == c) e2 = __float_as_uint(v2[c]) & 127u; }
      eid_rows[lr * 128 + hd * 16 + 4 * g + q] = (int)(e1 * 128u + e2);
    }
    if (g == 0) {
      float ex[16], sum = 0.f;
#pragma unroll
      for (int k = 0; k < 16; ++k) { ex[k] = __expf(topv[k] - topv[0]); sum += ex[k]; }
      const float inv = 1.f / sum;
#pragma unroll
      for (int q = 0; q < 4; ++q) {
        float4 o = {ex[4 * q] * inv, ex[4 * q + 1] * inv, ex[4 * q + 2] * inv, ex[4 * q + 3] * inv};
        *(float4*)(gate_rows + lr * 128 + hd * 16 + 4 * q) = o;
      }
    }
  }
}

DI float gelu_tanh(float x) {
  const float z = 0.7978845608028654f * (x + 0.044715f * x * x * x);
  const float e = __expf(2.f * z);
  const float th = 1.f - 2.f / (e + 1.f);
  return 0.5f * x * (1.f + th);
}
DI void gather_token(const Params& p, int l, int t, const int* eid_row, const float* gate_row, unsigned char* hl, float* wl, bool dry) {
  const int lane = ltid() & 63, lr = lane & 15, g = lane >> 4;
  const unsigned char* U6 = p.ws + OFF_U + (size_t)l * 16384 * U_PITCH;
  const unsigned char* V6 = p.ws + OFF_V + (size_t)l * 16384 * V_PITCH;
  const int half = lane >> 5, blk = lane & 31;
  const unsigned char* H6 = p.ws + OFF_H8;
  bf16_t* xres = (bf16_t*)(p.ws + OFF_XRES);
  const float* modbuf = (const float*)(p.ws + OFF_MOD);
  {
    if (lane < 50) {
      const u32x4 hq = *(const u32x4*)(H6 + (size_t)t * V6_PITCH + lane * 16);
      *(u32x4*)(hl + lane * 16) = hq;
    }
    const int e0 = eid_row[lane], e1 = eid_row[64 + lane];
    const float gv0 = gate_row[lane], gv1 = gate_row[64 + lane];
    {
      const u32x2 hsc = *(const u32x2*)(hl + 768 + 8 * g);
#pragma unroll 1
      for (int grp = 0; grp < 8; ++grp) {
        const int er = __shfl(grp < 4 ? e0 : e1, (grp & 3) * 16 + lr);
        const unsigned char* ur = U6 + (size_t)er * U_PITCH;
        u32x4 ua[8]; u32x2 ub[8];
#pragma unroll
        for (int s = 0; s < 8; ++s) {
          if (U_FP4) { ua[s] = *(const u32x4*)(ur + 16 * (4 * s + g)); ub[s] = (u32x2){0u, 0u}; }
          else { ua[s] = *(const u32x4*)(ur + 24 * (4 * s + g)); ub[s] = *(const u32x2*)(ur + 24 * (4 * s + g) + 16); }
        }
        const u32x2 usc = *(const u32x2*)(ur + (U_FP4 ? 512 : 768) + 8 * g);
        __builtin_amdgcn_sched_barrier(0);
        f32x4 acc = {0.f, 0.f, 0.f, 0.f};
#define G_STEP(s, OS, USC, HSC) do { const unsigned char* hb = hl + 24 * (4 * (s) + g); \
          const u32x2 h0 = *(const u32x2*)hb, h1 = *(const u32x2*)(hb + 8), h2v = *(const u32x2*)(hb + 16); \
          const i32x8 av = {(int)ua[s][0], (int)ua[s][1], (int)ua[s][2], (int)ua[s][3], (int)ub[s][0], (int)ub[s][1], 0, 0}; \
          const i32x8 bv = {(int)h0[0], (int)h0[1], (int)h1[0], (int)h1[1], (int)h2v[0], (int)h2v[1], 0, 0}; \
          acc = __builtin_amdgcn_mfma_scale_f32_16x16x128_f8f6f4(av, bv, acc, U_FP4 ? 4 : 2, 2, OS, (int)(USC), OS, (int)(HSC)); } while (0)
        G_STEP(0, 0, usc[0], hsc[0]); G_STEP(1, 1, usc[0], hsc[0]); G_STEP(2, 2, usc[0], hsc[0]); G_STEP(3, 3, usc[0], hsc[0]);
        G_STEP(4, 0, usc[1], hsc[1]); G_STEP(5, 1, usc[1], hsc[1]); G_STEP(6, 2, usc[1], hsc[1]); G_STEP(7, 3, usc[1], hsc[1]);
#undef G_STEP
        const float gvs = grp < 4 ? gv0 : gv1;
        const int lb_ = (grp & 3) * 16 + 4 * g;
        float4 wv_;
        wv_.x = __shfl(gvs, lb_) * gelu_tanh(acc[0]); wv_.y = __shfl(gvs, lb_ + 1) * gelu_tanh(acc[1]);
        wv_.z = __shfl(gvs, lb_ + 2) * gelu_tanh(acc[2]); wv_.w = __shfl(gvs, lb_ + 3) * gelu_tanh(acc[3]);
        if (lr == 0) *(float4*)(wl + grp * 16 + 4 * g) = wv_;
        __builtin_amdgcn_sched_barrier(0);
      }
    }
    __builtin_amdgcn_sched_barrier(0);
    float out[32];
#pragma unroll
    for (int i = 0; i < 32; ++i) out[i] = 0.f;
#pragma unroll 1
    for (int grp = 0; grp < 8; ++grp) {
      const int esel = grp < 4 ? e0 : e1;
      const int lb = (grp & 3) * 16;
      u32x4 vd4[8]; u32x2 vd2[8]; unsigned vsc[8];
#pragma unroll
      for (int pp = 0; pp < 8; ++pp) {
        const int ea = __builtin_amdgcn_readlane(esel, lb + 2 * pp), eb = __builtin_amdgcn_readlane(esel, lb + 2 * pp + 1);
        const unsigned char* vr = V6 + (size_t)(half ? eb : ea) * V_PITCH;
        if (V_FP4) { vd4[pp] = *(const u32x4*)(vr + 16 * blk); vd2[pp] = (u32x2){0u, 0u}; vsc[pp] = vr[mx4_scale_pos(blk)]; }
        else { vd4[pp] = *(const u32x4*)(vr + 24 * blk); vd2[pp] = *(const u32x2*)(vr + 24 * blk + 16); vsc[pp] = vr[mx_scale_pos(blk)]; }
      }
      __builtin_amdgcn_sched_barrier(0);
#pragma unroll
      for (int pp = 0; pp < 8; ++pp) {
        const float wgt = wl[grp * 16 + 2 * pp + half] * __uint_as_float(vsc[pp] << 23);
        if (V_FP4) {
          unsigned q0 = vd4[pp][0], q1 = vd4[pp][1], q2 = vd4[pp][2], q3 = vd4[pp][3];
          asm volatile("" : "+v"(q0), "+v"(q1) : "v"(out[0]), "v"(out[1]), "v"(out[2]), "v"(out[3]), "v"(out[4]), "v"(out[5]), "v"(out[6]), "v"(out[7]),
                       "v"(out[8]), "v"(out[9]), "v"(out[10]), "v"(out[11]), "v"(out[12]), "v"(out[13]), "v"(out[14]), "v"(out[15]));
          asm volatile("" : "+v"(q2), "+v"(q3) : "v"(out[16]), "v"(out[17]), "v"(out[18]), "v"(out[19]), "v"(out[20]), "v"(out[21]), "v"(out[22]), "v"(out[23]),
                       "v"(out[24]), "v"(out[25]), "v"(out[26]), "v"(out[27]), "v"(out[28]), "v"(out[29]), "v"(out[30]), "v"(out[31]));
          const u32x4 qd = {q0, q1, q2, q3};
#pragma unroll
          for (int d = 0; d < 4; ++d) {
            const f32x2 t0 = __builtin_amdgcn_cvt_scalef32_pk_f32_fp4(qd[d], 1.0f, 0), t1 = __builtin_amdgcn_cvt_scalef32_pk_f32_fp4(qd[d], 1.0f, 1);
            const f32x2 t2 = __builtin_amdgcn_cvt_scalef32_pk_f32_fp4(qd[d], 1.0f, 2), t3 = __builtin_amdgcn_cvt_scalef32_pk_f32_fp4(qd[d], 1.0f, 3);
            out[8 * d + 0] += wgt * t0[0]; out[8 * d + 1] += wgt * t0[1]; out[8 * d + 2] += wgt * t1[0]; out[8 * d + 3] += wgt * t1[1];
            out[8 * d + 4] += wgt * t2[0]; out[8 * d + 5] += wgt * t2[1]; out[8 * d + 6] += wgt * t3[0]; out[8 * d + 7] += wgt * t3[1];
          }
        } else {
          unsigned pk0 = vd4[pp][0], pk1 = vd4[pp][1];
          asm volatile("" : "+v"(pk0) : "v"(out[0]), "v"(out[1]), "v"(out[2]), "v"(out[3]), "v"(out[4]), "v"(out[5]), "v"(out[6]), "v"(out[7]),
                       "v"(out[8]), "v"(out[9]), "v"(out[10]), "v"(out[11]), "v"(out[12]), "v"(out[13]), "v"(out[14]), "v"(out[15]));
          asm volatile("" : "+v"(pk1) : "v"(out[16]), "v"(out[17]), "v"(out[18]), "v"(out[19]), "v"(out[20]), "v"(out[21]), "v"(out[22]), "v"(out[23]),
                       "v"(out[24]), "v"(out[25]), "v"(out[26]), "v"(out[27]), "v"(out[28]), "v"(out[29]), "v"(out[30]), "v"(out[31]));
          const u32x6 pk = {pk0, pk1, vd4[pp][2], vd4[pp][3], vd2[pp][0], vd2[pp][1]};
          const f32x32 vals = __builtin_amdgcn_cvt_scalef32_pk32_f32_fp6(pk, 1.0f);
  #pragma unroll
          for (int i = 0; i < 32; ++i) out[i] += wgt * vals[i];
        }
        __builtin_amdgcn_sched_barrier(0);
      }
    }
    float o16[16];
#pragma unroll
    for (int i = 0; i < 16; ++i) {
      const u32x2 s0 = __builtin_amdgcn_permlane32_swap(__float_as_uint(out[i]), __float_as_uint(out[i]), false, false);
      const u32x2 s1 = __builtin_amdgcn_permlane32_swap(__float_as_uint(out[16 + i]), __float_as_uint(out[16 + i]), false, false);
      const float t0 = __uint_as_float(s0[0]) + __uint_as_float(s0[1]), t1 = __uint_as_float(s1[0]) + __uint_as_float(s1[1]);
      o16[i] = half ? t1 : t0;
    }
    const int cb = 32 * blk + 16 * half;
    const int b = t < TL ? (t >> 11) : 16;
    const float* md = modbuf + ((size_t)l * 17 + b) * 6144 + 5 * 1024 + cb;
    bf16_t* xr = xres + (size_t)t * 1024 + cb;
    float xn[16];
    float ss = 0.f;
    {
      const u32x4 r0 = *(const u32x4*)xr, r1 = *(const u32x4*)(xr + 8);
      unpack8(r0, xn); unpack8(r1, xn + 8);
    }
    unsigned xp[8];
#pragma unroll
    for (int q = 0; q < 4; ++q) {
      const float4 m4 = *(const float4*)(md + 4 * q);
      xn[4 * q] += m4.x * o16[4 * q + 0]; xn[4 * q + 1] += m4.y * o16[4 * q + 1]; xn[4 * q + 2] += m4.z * o16[4 * q + 2]; xn[4 * q + 3] += m4.w * o16[4 * q + 3];
      ss += xn[4 * q] * xn[4 * q] + xn[4 * q + 1] * xn[4 * q + 1] + xn[4 * q + 2] * xn[4 * q + 2] + xn[4 * q + 3] * xn[4 * q + 3];
      xp[2 * q] = pk2(xn[4 * q], xn[4 * q + 1]); xp[2 * q + 1] = pk2(xn[4 * q + 2], xn[4 * q + 3]);
    }
    if (dry) asm volatile("" :: "v"(xp[0]), "v"(xp[7]));
    else if (l < NL - 1) { *(u32x4*)xr = (u32x4){xp[0], xp[1], xp[2], xp[3]}; *(u32x4*)(xr + 8) = (u32x4){xp[4], xp[5], xp[6], xp[7]}; }
    if (!dry) {
      ss = wave_sum(ss);
      const float rstd = rsqrtf(ss * (1.f / 1024.f) + 1e-6f);
      if (l == NL - 1) {
        const float* fg = p.final_g + cb;
        float* orow = p.out + (size_t)t * 1024 + cb;
#pragma unroll
        for (int q = 0; q < 4; ++q) {
          const float4 g4 = *(const float4*)(fg + 4 * q);
          float4 o = {xn[4 * q] * rstd * g4.x, xn[4 * q + 1] * rstd * g4.y, xn[4 * q + 2] * rstd * g4.z, xn[4 * q + 3] * rstd * g4.w};
          *(float4*)(orow + 4 * q) = o;
        }
      } else {
        const float* gvec = p.norm1_g + (l + 1) * 1024 + cb;
        const float* mdn = modbuf + ((size_t)(l + 1) * 17 + b) * 6144 + cb;
        bf16_t* hrow = (bf16_t*)(p.ws + OFF_H) + (size_t)t * 1024 + cb;
        unsigned pk[8];
#pragma unroll
        for (int q = 0; q < 4; ++q) {
          const float4 g4 = *(const float4*)(gvec + 4 * q), sh = *(const float4*)(mdn + 4 * q), sc = *(const float4*)(mdn + 1024 + 4 * q);
          const float o0 = xn[4 * q] * rstd * g4.x * (1.f + sc.x) + sh.x, o1 = xn[4 * q + 1] * rstd * g4.y * (1.f + sc.y) + sh.y;
          const float o2 = xn[4 * q + 2] * rstd * g4.z * (1.f + sc.z) + sh.z, o3 = xn[4 * q + 3] * rstd * g4.w * (1.f + sc.w) + sh.w;
          pk[2 * q] = pk2(o0, o1); pk[2 * q + 1] = pk2(o2, o3);
        }
        *(u32x4*)hrow = (u32x4){pk[0], pk[1], pk[2], pk[3]};
        *(u32x4*)(hrow + 8) = (u32x4){pk[4], pk[5], pk[6], pk[7]};
      }
    }
  }
}


DI void phase_topk_gather(const Params& p, int l, int ntok, unsigned* ctr, unsigned char* lds, bool dry = false) {
  const int tid = ltid(), lane = tid & 63, w = tid >> 6, lr = lane & 15, g = lane >> 4;
  const bf16_t* QP = (const bf16_t*)(p.ws + OFF_QP);
  const bf16_t* sk = (const bf16_t*)(p.ws + OFF_SK) + (size_t)l * 2 * 128 * 64;
  int* eid_l = (int*)lds;
  float* gate_l = (float*)(lds + 8192);
  unsigned char* hl = lds + 16384 + w * 2048;
  float* wl = (float*)(hl + 1024);
  volatile int* slot = (volatile int*)(lds + LDS_BYTES - 16);
  const int ntile = ntok / 16;
  for (;;) {
    __syncthreads();
    if (tid == 0) *slot = (int)atomicAdd(ctr, 1u);
    __syncthreads();
    const int tile = *slot;
    if (tile >= ntile) break;
#pragma unroll 1
    for (int hh = 0; hh < 2; ++hh) {
      topk_tile(QP, sk, tile, 2 * w + hh, eid_l, gate_l, lr, g);
      __builtin_amdgcn_sched_barrier(0);
    }
    __syncthreads();
#pragma unroll 1
    for (int q = 0; q < 4; ++q) {
      const int r = 4 * w + q;
      gather_token(p, l, tile * 16 + r, eid_l + r * 128, gate_l + r * 128, hl, wl, dry);
    }
  }
}

DI void phase_final(const Params& p) {
  const int lane = ltid() & 63, gw = lbid() * 4 + (ltid() >> 6), nw = lgdim() * 4;
  const float* xres = (const float*)(p.ws + OFF_XRES);
  for (int t = gw; t < TL; t += nw) {
    const float* src = xres + (size_t)t * 1024;
    float4 v[4];
    float ss = 0.f;
#pragma unroll
    for (int i = 0; i < 4; ++i) {
      v[i] = *(const float4*)(src + 4 * lane + 256 * i);
      ss += v[i].x * v[i].x + v[i].y * v[i].y + v[i].z * v[i].z + v[i].w * v[i].w;
    }
    ss = wave_sum(ss);
    const float rstd = rsqrtf(ss * (1.f / 1024.f) + 1e-6f);
#pragma unroll
    for (int i = 0; i < 4; ++i) {
      const int col = 4 * lane + 256 * i;
      const float4 g4 = *(const float4*)(p.final_g + col);
      float4 o = {v[i].x * rstd * g4.x, v[i].y * rstd * g4.y, v[i].z * rstd * g4.z, v[i].w * rstd * g4.w};
      *(float4*)(p.out + (size_t)t * 1024 + col) = o;
    }
  }
}


#define LAS __attribute__((address_space(3)))
#define XB_TMO      128
#define XB_XCNT(j)  (256  + 64 * (j))
#define XB_XSUB(j)  (1280 + 64 * (j))
#define XB_XGEN(j)  (2304 + 64 * (j))
#define XB_TOP      3328
#define XB_TOPGEN   3392
#define XCD_BAR_WORDS 3456
#define XB_SPIN_CAP (1u << 22)
DI unsigned xb_ld(unsigned* p) { return __hip_atomic_load(p, __ATOMIC_RELAXED, __HIP_MEMORY_SCOPE_AGENT); }
DI unsigned xb_add(unsigned* p, unsigned v) { return __hip_atomic_fetch_add(p, v, __ATOMIC_RELAXED, __HIP_MEMORY_SCOPE_AGENT); }
DI unsigned xb_xcc_id() { return (unsigned)__builtin_amdgcn_s_getreg((3 << 11) | 20) & 0xFu; }
#define XB_SPIN(cond, bar) do { unsigned _sp = 0; while (cond) { __builtin_amdgcn_s_sleep(1); \
    if ((++_sp & 255u) == 0u) { if (xb_ld(&(bar)[XB_TMO])) break; if (_sp > XB_SPIN_CAP) { atomicAdd(&(bar)[XB_TMO], 1u); break; } } } } while (0)
struct XcdBarrier { unsigned* bar; unsigned x; volatile unsigned* st; };
DI XcdBarrier xcd_barrier_post(unsigned* bar, volatile unsigned* st) {
  XcdBarrier b; b.bar = bar; b.x = xb_xcc_id(); b.st = st;
  if (threadIdx.x == 0) (void)xb_add(&bar[XB_XCNT(b.x)], 1u);
  return b;
}
DI void xcd_barrier_complete(unsigned* bar, unsigned x, unsigned& nloc, unsigned& nx) {
  const unsigned G = gridDim.x * gridDim.y * gridDim.z;
  unsigned sum, cnt, mine, sp = 0u;
  for (;;) {
    sum = 0u; cnt = 0u; mine = 0u;
#pragma unroll 1
    for (unsigned j = 0; j < 16; ++j) { const unsigned c = xb_ld(&bar[XB_XCNT(j)]); sum += c; cnt += (c > 0u) ? 1u : 0u; mine = (j == x) ? c : mine; }
    if (sum == G) break;
    __builtin_amdgcn_s_sleep(1);
    if ((++sp & 255u) == 0u) { if (xb_ld(&bar[XB_TMO])) break; if (sp > XB_SPIN_CAP) { atomicAdd(&bar[XB_TMO], 1u); break; } }
  }
  nloc = mine > 0u ? mine : 1u; nx = cnt > 0u ? cnt : 1u;
}
DI void xcd_barrier(const XcdBarrier& b) {
  asm volatile("s_waitcnt vmcnt(0)" ::: "memory");
  __syncthreads();
  if (threadIdx.x == 0) {
    unsigned* bar = b.bar;
    __builtin_amdgcn_s_waitcnt(0);
    unsigned nloc = b.st[0], nx = b.st[1];
    if (nloc == 0u) { xcd_barrier_complete(bar, b.x, nloc, nx); b.st[0] = nloc; b.st[1] = nx; }
    const unsigned old = xb_add(&bar[XB_XSUB(b.x)], 1u);
    const unsigned gen = old / nloc;
    if (old + 1u == (gen + 1u) * nloc) {
      __builtin_amdgcn_fence(__ATOMIC_RELEASE, "agent");
      asm volatile("s_waitcnt vmcnt(0)" ::: "memory");
      const unsigned og = xb_add(&bar[XB_TOP], 1u);
      const unsigned tg = og / nx;
      if (og + 1u == (tg + 1u) * nx) xb_add(&bar[XB_TOPGEN], 1u);
      else XB_SPIN(xb_ld(&bar[XB_TOPGEN]) == tg, bar);
      __builtin_amdgcn_fence(__ATOMIC_ACQUIRE, "agent");
      xb_add(&bar[XB_XGEN(b.x)], 1u);
      asm volatile("s_waitcnt vmcnt(0)" ::: "memory");
    } else {
      XB_SPIN(xb_ld(&bar[XB_XGEN(b.x)]) == gen, bar);
      __builtin_amdgcn_fence(__ATOMIC_ACQUIRE, "agent");
      asm volatile("s_waitcnt vmcnt(0)" ::: "memory");
    }
  }
  __syncthreads();
}

constexpr int PH_PER_LAYER = 10;
constexpr int N_PHASES = 1 + NL * PH_PER_LAYER + 1;

template <int KIND>
DI void run_phase(const Params& p, int ph, unsigned char* lds) {
  unsigned* ctl = (unsigned*)(p.ws + OFF_CTL);
  if (ph == 0) { if (KIND < 0 || KIND == 0) phase_prologue(p, lds); }
  else if (ph == N_PHASES - 1) { if (KIND < 0 || KIND == 11) phase_final(p); }
  else {
    const int l = (ph - 1) / PH_PER_LAYER, s = (ph - 1) % PH_PER_LAYER;
    const bool last = (l == NL - 1);
    const int ntok = last ? TL : TT;
    if (s == 0) { if (KIND < 0 || KIND == 1) phase_norm(p, l, 0, TT); }
    else if (s == 1) { if (KIND < 0 || KIND == 2) phase_gemm_in(p, l, lds); }
    else if (s == 2) { if (KIND < 0 || KIND == 3) phase_rope(p, lds); }
    else if (s == 3) { if (KIND < 0 || KIND == 4) phase_mixers(p, l, last, ctl + 64 * (1 + l), lds); }
    else if (s == 4) { if (KIND < 0 || KIND == 5) phase_gla_fin(p, l, ntok); }
    else if (s == 5) { if (KIND < 0 || KIND == 6) phase_gemm_out(p, l, ntok, lds); }
    else if (s == 6) { if (KIND < 0 || KIND == 7) phase_norm(p, l, 1, ntok); }
    else if (s == 7) { if (KIND < 0 || KIND == 8) phase_gemm_q(p, l, ntok, lds); }
    else if (s == 8) { }
    else { if (KIND < 0 || KIND == 10) phase_topk_gather(p, l, ntok, (unsigned*)(p.ws + OFF_CTL) + 64 * (8 + l), lds); }
  }
}

#if N_LAUNCH_MODE == 1
#ifndef PROBE_KIND
#define PROBE_KIND -1
#endif
#ifndef GLA_VAR
#define GLA_VAR 0
#endif
constexpr int CW_BAR = 4096;
template <int l>
DI void run_layer(const Params& p, unsigned char* lds) {
  unsigned* ctl = (unsigned*)(p.ws + OFF_CTL);
#define GSYNC() do { XcdBarrier bb; bb.bar = (unsigned*)(p.ws + OFF_CTL) + CW_BAR; bb.x = xb_xcc_id(); bb.st = (volatile unsigned*)(lds + LDS_BYTES - 32); xcd_barrier(bb); } while (0)

    const bool last = (l == NL - 1);
    const int ntok = last ? TL : TT;
    if (l == 0) { { Params q = p; { size_t z_ = 0; asm volatile("" : "+s"(z_)); q.ws = p.ws + z_; } phase_norm(q, l, 0, TT); } GSYNC(); }
    if (PROBE_KIND == 1) { { Params q = p; { size_t z_ = 0; asm volatile("" : "+s"(z_)); q.ws = p.ws + z_; } phase_norm(q, l, 0, TT); } GSYNC(); }
    if (PROBE_KIND == 2) { { Params q = p; { size_t z_ = 0; asm volatile("" : "+s"(z_)); q.ws = p.ws + z_; } phase_gemm_in(q, l, lds, true); } GSYNC(); }
    { Params q = p; { size_t z_ = 0; asm volatile("" : "+s"(z_)); q.ws = p.ws + z_; } phase_gemm_in(q, l, lds); } GSYNC();
    if (PROBE_KIND == 4 || (PROBE_KIND >= 41 && PROBE_KIND <= 47)) { { Params q = p; { size_t z_ = 0; asm volatile("" : "+s"(z_)); q.ws = p.ws + z_; } phase_mixers(q, l, last, ctl + 64 * (1 + l) + 1, lds, PROBE_KIND == 4 ? 15 : PROBE_KIND - 40, GLA_VAR); } GSYNC(); }
    { Params q = p; { size_t z_ = 0; asm volatile("" : "+s"(z_)); q.ws = p.ws + z_; } phase_mixers(q, l, last, ctl + 64 * (1 + l), lds); } GSYNC();
    { Params q = p; { size_t z_ = 0; asm volatile("" : "+s"(z_)); q.ws = p.ws + z_; } phase_gla_fin(q, l, ntok); } GSYNC();
    if (PROBE_KIND == 5) { { Params q = p; { size_t z_ = 0; asm volatile("" : "+s"(z_)); q.ws = p.ws + z_; } phase_gla_fin(q, l, ntok); } GSYNC(); }
    { Params q = p; { size_t z_ = 0; asm volatile("" : "+s"(z_)); q.ws = p.ws + z_; } phase_gemm_out(q, l, ntok, lds); } GSYNC();
    { Params q = p; { size_t z_ = 0; asm volatile("" : "+s"(z_)); q.ws = p.ws + z_; } phase_norm2(q, l, ntok); } GSYNC();
    if (PROBE_KIND == 7) { { Params q = p; { size_t z_ = 0; asm volatile("" : "+s"(z_)); q.ws = p.ws + z_; } phase_norm2(q, l, ntok); } GSYNC(); }
    { Params q = p; { size_t z_ = 0; asm volatile("" : "+s"(z_)); q.ws = p.ws + z_; } phase_gemm_q(q, l, ntok, lds); } GSYNC();
    if (PROBE_KIND == 8) { { Params q = p; { size_t z_ = 0; asm volatile("" : "+s"(z_)); q.ws = p.ws + z_; } phase_gemm_q(q, l, ntok, lds); } GSYNC(); }
    if (PROBE_KIND == 11) { { Params q = p; { size_t z_ = 0; asm volatile("" : "+s"(z_)); q.ws = p.ws + z_; } phase_topk_gather(q, l, ntok, ctl + 64 * (8 + l) + 1, lds, true); } GSYNC(); }
    { Params q = p; { size_t z_ = 0; asm volatile("" : "+s"(z_)); q.ws = p.ws + z_; } phase_topk_gather(q, l, ntok, ctl + 64 * (8 + l), lds); } if (l + 1 < NL) GSYNC();
}
__global__ void __launch_bounds__(256, 2) mk_fwd(Params p) {
  __shared__ __attribute__((aligned(16))) unsigned char lds[LDS_BYTES];
  unsigned* ctl = (unsigned*)(p.ws + OFF_CTL);
  volatile unsigned* st = (volatile unsigned*)(lds + LDS_BYTES - 32);
  if (threadIdx.x < 2) st[threadIdx.x] = 0u;
  __syncthreads();
  (void)xcd_barrier_post(ctl + CW_BAR, st);
#define GSYNC() do { XcdBarrier bb; bb.bar = (unsigned*)(p.ws + OFF_CTL) + CW_BAR; bb.x = xb_xcc_id(); bb.st = (volatile unsigned*)(lds + LDS_BYTES - 32); xcd_barrier(bb); } while (0)
  { Params q = p; { size_t z_ = 0; asm volatile("" : "+s"(z_)); q.ws = p.ws + z_; } phase_prologue(q, lds); } cg::this_grid().sync();
  if (PROBE_KIND == 0) { { Params q = p; { size_t z_ = 0; asm volatile("" : "+s"(z_)); q.ws = p.ws + z_; } phase_prologue(q, lds); } GSYNC(); }
  run_layer<0>(p, lds); run_layer<1>(p, lds); run_layer<2>(p, lds); run_layer<3>(p, lds);
}
#else
template <int KIND>
__global__ void __launch_bounds__(256, 2) mk_phase(Params p) {
  __shared__ __attribute__((aligned(16))) unsigned char lds[LDS_BYTES];
  run_phase<KIND>(p, p.ph_lo, lds);
}
#endif

extern "C" void kernel_launch(void* const* d_in, const int* in_sizes, int n_in, void* d_out, int out_size, void* d_ws,
                              size_t ws_size, hipStream_t stream) {
  static int grid = 0;
  if (grid == 0) {
    if (n_in != 21 || ws_size < WS_END || out_size != TL * DM) { fprintf(stderr, "kernel_launch: unexpected shapes (n_in %d ws %zu out %d)\n", n_in, ws_size, out_size); grid = -1; return; }
    int dev = 0, cus = 0, per_cu = 2;
    (void)hipGetDevice(&dev);
    (void)hipDeviceGetAttribute(&cus, hipDeviceAttributeMultiprocessorCount, dev);
#if N_LAUNCH_MODE == 1
    (void)hipOccupancyMaxActiveBlocksPerMultiprocessor(&per_cu, (const void*)mk_fwd, 256, 0);
    if (per_cu < 1) per_cu = 1;
    if (per_cu > 2) per_cu = 2;
#endif
    grid = cus * per_cu;
  }
  if (grid < 0) return;
  (void)hipMemsetAsync((char*)d_ws + OFF_CTL, 0, 65536, stream);
  Params p{};
  const float** pp = (const float**)&p;
  for (int i = 0; i < 21; ++i) pp[i] = (const float*)d_in[i];
  p.out = (float*)d_out;
  p.ws = (unsigned char*)d_ws;
#if N_LAUNCH_MODE == 1
  p.ph_lo = 0; p.ph_hi = N_PHASES;
  void* args[] = {&p};
  hipError_t e = hipLaunchCooperativeKernel((const void*)mk_fwd, dim3(grid), dim3(256), args, 0, stream);
  if (e != hipSuccess) fprintf(stderr, "cooperative launch failed: %s (grid %d)\n", hipGetErrorString(e), grid);
#else
  for (int ph = 0; ph < N_PHASES; ++ph) {
    p.ph_lo = ph; p.ph_hi = ph + 1;
    const int kind = ph == 0 ? 0 : (ph == N_PHASES - 1 ? 11 : 1 + (ph - 1) % PH_PER_LAYER);
    switch (kind) {
      case 0: hipLaunchKernelGGL(mk_phase<0>, dim3(grid), dim3(256), 0, stream, p); break;
      case 1: hipLaunchKernelGGL(mk_phase<1>, dim3(grid), dim3(256), 0, stream, p); break;
      case 2: hipLaunchKernelGGL(mk_phase<2>, dim3(grid), dim3(256), 0, stream, p); break;
      case 3: hipLaunchKernelGGL(mk_phase<3>, dim3(grid), dim3(256), 0, stream, p); break;
      case 4: hipLaunchKernelGGL(mk_phase<4>, dim3(grid), dim3(256), 0, stream, p); break;
      case 5: hipLaunchKernelGGL(mk_phase<5>, dim3(grid), dim3(256), 0, stream, p); break;
      case 6: hipLaunchKernelGGL(mk_phase<6>, dim3(grid), dim3(256), 0, stream, p); break;
      case 7: hipLaunchKernelGGL(mk_phase<7>, dim3(grid), dim3(256), 0, stream, p); break;
      case 8: hipLaunchKernelGGL(mk_phase<8>, dim3(grid), dim3(256), 0, stream, p); break;
      case 9: hipLaunchKernelGGL(mk_phase<9>, dim3(grid), dim3(256), 0, stream, p); break;
      case 10: hipLaunchKernelGGL(mk_phase<10>, dim3(grid), dim3(256), 0, stream, p); break;
      default: hipLaunchKernelGGL(mk_phase<11>, dim3(grid), dim3(256), 0, stream, p); break;
    }
  }
#endif
}
```

```cpp
#include <hip/hip_runtime.h>
#include <hip/hip_cooperative_groups.h>
#include <stdint.h>
#include <stdio.h>
namespace cg = cooperative_groups;

#ifndef N_LAUNCH_MODE
#define N_LAUNCH_MODE 1
#endif

#define DI __device__ __forceinline__
#ifndef GEMM_VAR
#define GEMM_VAR 0
#endif
typedef unsigned short bf16_t;
typedef short bf16x8 __attribute__((ext_vector_type(8)));
typedef float f32x4 __attribute__((ext_vector_type(4)));
typedef float f32x2 __attribute__((ext_vector_type(2)));
typedef float f32x16 __attribute__((ext_vector_type(16)));
typedef float f32x32 __attribute__((ext_vector_type(32)));
typedef unsigned u32x6 __attribute__((ext_vector_type(6)));
typedef int i32x8 __attribute__((ext_vector_type(8)));
typedef unsigned u32x4 __attribute__((ext_vector_type(4)));
typedef unsigned u32x2 __attribute__((ext_vector_type(2)));

constexpr int NB = 16, SEQ = 2048, DM = 1024, NL = 4, CTXL = 256;
constexpr int TL = NB * SEQ;
constexpr int TC = NB * CTXL;
constexpr int TT = TL + TC;
constexpr int PN_LD = 2176;
constexpr int C_GQ = 0, C_GK = 128, C_GR = 256, C_NQ = 512, C_NK = 768, C_DQ = 1024, C_DK = 1536, C_GATE = 2048;
constexpr int R_GV = 0, R_NV = 256, R_DV = 512;
constexpr float LOG2E = 1.4426950408889634f;
constexpr float SC_LOG2 = 0.125f * LOG2E;
constexpr float NEG_BIG = -1e30f;

constexpr size_t MiB = 1u << 20;
constexpr size_t OFF_CTL = 0;
constexpr size_t OFF_MOD = 1 * MiB;
constexpr size_t OFF_WIN = 3 * MiB;
constexpr size_t OFF_WOUT = 28 * MiB;
constexpr size_t OFF_WQ = 36 * MiB;
constexpr size_t OFF_SK = 44 * MiB;
constexpr size_t OFF_USCL = 44 * MiB + 256 * 1024;
constexpr size_t OFF_VSCL = 44 * MiB + 512 * 1024;
constexpr size_t OFF_U = 45 * MiB;
constexpr size_t OFF_V = 109 * MiB;
constexpr int V6_PITCH = 800;
#ifndef U_FP4
#define U_FP4 1
#endif
#ifndef V_FP4
#define V_FP4 1
#endif
constexpr int P4_PITCH = 544;
constexpr int U_PITCH = U_FP4 ? P4_PITCH : V6_PITCH, V_PITCH = V_FP4 ? P4_PITCH : V6_PITCH;
constexpr size_t OFF_XRES = 301 * MiB;
constexpr size_t OFF_H = 445 * MiB;
constexpr size_t OFF_P = 517 * MiB;
constexpr size_t OFF_VT = OFF_P + 153 * MiB;
constexpr size_t OFF_QP = OFF_P;
constexpr size_t OFF_EID = OFF_P + 72 * MiB;
constexpr size_t OFF_GATE = OFF_P + 90 * MiB;
constexpr size_t OFF_H8 = OFF_P + 126 * MiB;
constexpr size_t OFF_HINV = OFF_P + 162 * MiB;
constexpr size_t OFF_Y = 742 * MiB;
constexpr size_t WS_END = 814 * MiB;

constexpr int LDS_BYTES = 65536 + 8192;

struct Params {
  const float *x, *c, *ctx, *c_ctx, *ada_w, *ada_b, *norm1_g, *norm2_g, *w_in, *gate_up, *gate_b, *gla_norm_g,
      *rpb, *dlam, *diff_g, *w_out, *wq, *subkeys, *pu, *pv, *final_g;
  float* out;
  unsigned char* ws;
  int ph_lo, ph_hi;
};

DI int ltid() { int t = threadIdx.x; asm volatile("" : "+v"(t)); return t; }
DI int lbid() { int t = blockIdx.x; asm volatile("" : "+s"(t)); return t; }
DI int lgdim() { int t = gridDim.x; asm volatile("" : "+s"(t)); return t; }

DI unsigned f2bf(float f) { unsigned u = __float_as_uint(f); return (u + 0x7fffu + ((u >> 16) & 1u)) >> 16; }
typedef __bf16 bf16x2_t __attribute__((ext_vector_type(2)));
DI unsigned pk2(float lo, float hi) { f32x2 v = {lo, hi}; return __builtin_bit_cast(unsigned, __builtin_convertvector(v, bf16x2_t)); }
DI float bflo(unsigned u) { return __uint_as_float(u << 16); }
DI float bfhi(unsigned u) { return __uint_as_float(u & 0xffff0000u); }
DI void unpack8(const u32x4 v, float* f) {
  f[0] = bflo(v.x); f[1] = bfhi(v.x); f[2] = bflo(v.y); f[3] = bfhi(v.y);
  f[4] = bflo(v.z); f[5] = bfhi(v.z); f[6] = bflo(v.w); f[7] = bfhi(v.w);
}
DI float wave_sum(float v) {
#pragma unroll
  for (int o = 32; o >= 1; o >>= 1) v += __shfl_xor(v, o);
  return v;
}

DI float rows_max(float x) {
  unsigned u = __float_as_uint(x);
  u32x2 a = __builtin_amdgcn_permlane32_swap(u, u, false, false);
  const float m = fmaxf(__uint_as_float(a[0]), __uint_as_float(a[1]));
  unsigned v = __float_as_uint(m);
  u32x2 b = __builtin_amdgcn_permlane16_swap(v, v, false, false);
  return fmaxf(__uint_as_float(b[0]), __uint_as_float(b[1]));
}
DI float rows_sum(float x) {
  unsigned u = __float_as_uint(x);
  u32x2 a = __builtin_amdgcn_permlane32_swap(u, u, false, false);
  const float m = __uint_as_float(a[0]) + __uint_as_float(a[1]);
  unsigned v = __float_as_uint(m);
  u32x2 b = __builtin_amdgcn_permlane16_swap(v, v, false, false);
  return __uint_as_float(b[0]) + __uint_as_float(b[1]);
}

DI u32x6 mxfp6_pack32(float (&x)[32], unsigned& sbyte) {
  float am = 0.f;
#pragma unroll
  for (int i = 0; i < 32; ++i) am = fmaxf(am, fabsf(x[i]));
  const unsigned ab = __float_as_uint(am);
  int e = am > 0.f ? (int)(ab >> 23) - 127 - 2 + ((ab & 0x7fffffu) > 0x700000u ? 1 : 0) : -126;
  e = e < -126 ? -126 : (e > 127 ? 127 : e);
  const float sc = __uint_as_float((unsigned)(127 - e) << 23);
  f32x16 lo, hi;
#pragma unroll
  for (int i = 0; i < 16; ++i) { lo[i] = x[2 * i] * sc; hi[i] = x[2 * i + 1] * sc; }
  sbyte = (unsigned)(127 + e);
  return __builtin_amdgcn_cvt_scalef32_2xpk16_fp6_f32(lo, hi, 1.0f);
}

DI u32x4 mxfp4_pack32(float (&x)[32], unsigned& sbyte) {
  float am = 0.f;
#pragma unroll
  for (int i = 0; i < 32; ++i) am = fmaxf(am, fabsf(x[i]));
  const unsigned ab = __float_as_uint(am);
  int e = am > 0.f ? (int)(ab >> 23) - 127 - 2 + ((ab & 0x7fffffu) > 0x400000u ? 1 : 0) : -126;
  e = e < -126 ? -126 : (e > 127 ? 127 : e);
  const float sc = __uint_as_float((unsigned)(127 - e) << 23);
  sbyte = (unsigned)(127 + e);
  u32x4 q;
#pragma unroll
  for (int d = 0; d < 4; ++d) {
    unsigned v = 0;
    v = __builtin_amdgcn_cvt_scalef32_pk_fp4_f32(v, x[8 * d + 0] * sc, x[8 * d + 1] * sc, 1.0f, 0);
    v = __builtin_amdgcn_cvt_scalef32_pk_fp4_f32(v, x[8 * d + 2] * sc, x[8 * d + 3] * sc, 1.0f, 1);
    v = __builtin_amdgcn_cvt_scalef32_pk_fp4_f32(v, x[8 * d + 4] * sc, x[8 * d + 5] * sc, 1.0f, 2);
    v = __builtin_amdgcn_cvt_scalef32_pk_fp4_f32(v, x[8 * d + 6] * sc, x[8 * d + 7] * sc, 1.0f, 3);
    q[d] = v;
  }
  return q;
}
DI int mx4_scale_pos(int blk) { return 512 + (blk & 3) * 8 + (blk >> 2); }
DI int mx_scale_pos(int blk) { return 768 + (blk & 3) * 8 + (blk >> 2); }
DI f32x4 mfma16(bf16x8 a, bf16x8 b, f32x4 c) { return __builtin_amdgcn_mfma_f32_16x16x32_bf16(a, b, c, 0, 0, 0); }

DI int win_src_col(int r) {
  if (r < 256) return r;
  if (r < 512) return r - 256 + 512;
  if (r < 768) return r - 512 + 800;
  if (r < 1024) return r - 768 + 1056;
  if (r < 1536) return r - 1024 + 1568;
  if (r < 2048) return r - 1536 + 2080;
  if (r < 2080) return r - 2048 + 768;
  if (r < 2176) return -1;
  if (r < 2432) return r - 2176 + 256;
  if (r < 2688) return r - 2432 + 1312;
  return r - 2688 + 2592;
}

DI void transpose_item(const float* __restrict__ W, int N, int src, bf16_t* __restrict__ dst, float* lds) {
  const int tid = ltid();
  for (int kc = 0; kc < 8; ++kc) {
    __syncthreads();
#pragma unroll
    for (int i = 0; i < 16; ++i) {
      int k = i * 8 + (tid >> 5), n = tid & 31;
      lds[k * 33 + n] = (src < 0) ? 0.f : W[(size_t)(kc * 128 + k) * N + src + n];
    }
    __syncthreads();
    int row = tid >> 3, k0 = (tid & 7) * 16;
    unsigned o[8];
#pragma unroll
    for (int e = 0; e < 8; ++e) o[e] = pk2(lds[(k0 + 2 * e) * 33 + row], lds[(k0 + 2 * e + 1) * 33 + row]);
    u32x4 a = {o[0], o[1], o[2], o[3]}, b = {o[4], o[5], o[6], o[7]};
    bf16_t* d = dst + (size_t)row * 1024 + kc * 128 + k0;
    *(u32x4*)d = a; *(u32x4*)(d + 8) = b;
  }
}

DI void convert_table_pairs(const Params& p, int pr0, int pr1, int wave, int nwave, int lane) {
  for (int pr = pr0 + __builtin_amdgcn_readfirstlane(wave); pr < pr1; pr += nwave) {
    const int tab = pr >= NL * 16384 / 2, pq = tab ? pr - NL * 16384 / 2 : pr;
    const int r = 2 * pq + (lane >> 5), blk = lane & 31;
    const float* src = (tab ? p.pv : p.pu) + (size_t)r * 1024 + 32 * blk;
    float x[32];
#pragma unroll
    for (int i = 0; i < 8; ++i) { const float4 a = *(const float4*)(src + 4 * i); x[4 * i] = a.x; x[4 * i + 1] = a.y; x[4 * i + 2] = a.z; x[4 * i + 3] = a.w; }
    unsigned sb;
    if (tab ? V_FP4 : U_FP4) {
      const u32x4 q = mxfp4_pack32(x, sb);
      unsigned char* row = p.ws + (tab ? OFF_V : OFF_U) + (size_t)r * P4_PITCH;
      *(u32x4*)(row + 16 * blk) = q;
      row[mx4_scale_pos(blk)] = (unsigned char)sb;
    } else {
      const u32x6 q = mxfp6_pack32(x, sb);
      unsigned char* row = p.ws + (tab ? OFF_V : OFF_U) + (size_t)r * V6_PITCH;
      *(u32x2*)(row + 24 * blk) = (u32x2){q[0], q[1]};
      *(u32x2*)(row + 24 * blk + 8) = (u32x2){q[2], q[3]};
      *(u32x2*)(row + 24 * blk + 16) = (u32x2){q[4], q[5]};
      row[mx_scale_pos(blk)] = (unsigned char)sb;
    }
  }
}

DI void phase_prologue(const Params& p, unsigned char* lds) {
  const int tid = ltid(), nb = lgdim(), bid = lbid();
  bf16_t* winT = (bf16_t*)(p.ws + OFF_WIN);
  bf16_t* woutT = (bf16_t*)(p.ws + OFF_WOUT);
  bf16_t* wqT = (bf16_t*)(p.ws + OFF_WQ);
  constexpr int PER_LAYER = 100 + 32 + 32;
  for (int item = bid; item < NL * PER_LAYER; item += nb) {
    int l = item / PER_LAYER, r = item % PER_LAYER;
    if (r < 100) {
      int row = r * 32;
      transpose_item(p.w_in + (size_t)l * 1024 * 3104, 3104, win_src_col(row), winT + ((size_t)l * 3200 + row) * 1024, (float*)lds);
    } else if (r < 132) {
      int row = (r - 100) * 32;
      transpose_item(p.w_out + (size_t)l * 1024 * 1024, 1024, row, woutT + ((size_t)l * 1024 + row) * 1024, (float*)lds);
    } else {
      int row = (r - 132) * 32;
      transpose_item(p.wq + (size_t)l * 1024 * 1024, 1024, row, wqT + ((size_t)l * 1024 + row) * 1024, (float*)lds);
    }
  }
  {
    bf16_t* sk = (bf16_t*)(p.ws + OFF_SK);
    for (int i = bid * 256 + tid; i < NL * 2 * 128 * 64; i += nb * 256) sk[i] = (bf16_t)f2bf(p.subkeys[i]);
  }
  {
    float* modbuf = (float*)(p.ws + OFF_MOD);
    float* sc = (float*)lds;
    float* red = (float*)(lds + 17 * 512 * 4);
    for (int item = bid; item < NL * 96; item += nb) {
      const int l = item / 96, cb = item % 96, col = cb * 64 + (tid & 63), kq = tid >> 6;
      float acc[17];
#pragma unroll
      for (int r = 0; r < 17; ++r) acc[r] = 0.f;
      for (int half = 0; half < 2; ++half) {
        __syncthreads();
        for (int e = tid; e < 17 * 512; e += 256) {
          int r = e >> 9, k = e & 511;
          float cv = (r < 16) ? p.c[r * 1024 + half * 512 + k] : p.c_ctx[half * 512 + k];
          sc[e] = cv / (1.f + __expf(-cv));
        }
        __syncthreads();
        const float* wp = p.ada_w + ((size_t)l * 1024 + half * 512 + kq * 128) * 6144 + col;
        for (int kk = 0; kk < 128; ++kk) {
          const float w = wp[(size_t)kk * 6144];
#pragma unroll
          for (int r = 0; r < 17; ++r) acc[r] += sc[r * 512 + kq * 128 + kk] * w;
        }
      }
#pragma unroll
      for (int r = 0; r < 17; ++r) red[(kq * 17 + r) * 64 + (tid & 63)] = acc[r];
      __syncthreads();
      for (int e = tid; e < 17 * 64; e += 256) {
        int r = e >> 6, cc = e & 63;
        float s = red[(0 * 17 + r) * 64 + cc] + red[(1 * 17 + r) * 64 + cc] + red[(2 * 17 + r) * 64 + cc] + red[(3 * 17 + r) * 64 + cc];
        int colg = cb * 64 + cc;
        modbuf[((size_t)l * 17 + r) * 6144 + colg] = s + p.ada_b[l * 6144 + colg];
      }
      __syncthreads();
    }
  }
}

DI void phase_norm(const Params& p, int l, int which, int ntok) {
  const int lane = ltid() & 63, gw = lbid() * 4 + (ltid() >> 6), nw = lgdim() * 4;
  const float* gvec = (which == 0 ? p.norm1_g : p.norm2_g) + l * 1024;
  const int ish = which == 0 ? 0 : 3, isc = which == 0 ? 1 : 4;
  const float* xres = (const float*)(p.ws + OFF_XRES);
  const float* modbuf = (const float*)(p.ws + OFF_MOD);
  bf16_t* hbuf = (bf16_t*)(p.ws + OFF_H);
  for (int t = gw; t < ntok; t += nw) {
    const float* src = (which == 0 && l == 0) ? (t < TL ? p.x + (size_t)t * 1024 : p.ctx + (size_t)(t - TL) * 1024) : xres + (size_t)t * 1024;
    const int b = t < TL ? (t >> 11) : 16;
    const float* md = modbuf + ((size_t)l * 17 + b) * 6144;
    float4 v[4];
    float ss = 0.f;
#pragma unroll
    for (int i = 0; i < 4; ++i) {
      v[i] = *(const float4*)(src + 4 * lane + 256 * i);
      ss += v[i].x * v[i].x + v[i].y * v[i].y + v[i].z * v[i].z + v[i].w * v[i].w;
    }
    ss = wave_sum(ss);
    const float rstd = rsqrtf(ss * (1.f / 1024.f) + 1e-6f);
    float am = 0.f;
#pragma unroll
    for (int i = 0; i < 4; ++i) {
      const int col = 4 * lane + 256 * i;
      const float4 g4 = *(const float4*)(gvec + col), sh = *(const float4*)(md + ish * 1024 + col), sc = *(const float4*)(md + isc * 1024 + col);
      float o0 = v[i].x * rstd * g4.x * (1.f + sc.x) + sh.x;
      float o1 = v[i].y * rstd * g4.y * (1.f + sc.y) + sh.y;
      float o2 = v[i].z * rstd * g4.z * (1.f + sc.z) + sh.z;
      float o3 = v[i].w * rstd * g4.w * (1.f + sc.w) + sh.w;
      u32x2 o = {pk2(o0, o1), pk2(o2, o3)};
      *(u32x2*)(hbuf + (size_t)t * 1024 + col) = o;
      v[i].x = o0; v[i].y = o1; v[i].z = o2; v[i].w = o3;
      am = fmaxf(am, fmaxf(fmaxf(fabsf(o0), fabsf(o1)), fmaxf(fabsf(o2), fabsf(o3))));
    }
  }
}

DI void phase_norm2(const Params& p, int l, int ntok) {
  const int lane = ltid() & 63, gw = lbid() * 4 + (ltid() >> 6), nw = lgdim() * 4;
  const int half = lane >> 5, blk = lane & 31;
  const float* gvec = p.norm2_g + l * 1024 + 32 * blk;
  const bf16_t* xres = (const bf16_t*)(p.ws + OFF_XRES);
  const float* modbuf = (const float*)(p.ws + OFF_MOD);
  bf16_t* hbuf = (bf16_t*)(p.ws + OFF_H);
  unsigned char* h6 = p.ws + OFF_H8;
  for (int pr = gw; pr < ntok / 2; pr += nw) {
    const int t = 2 * pr + half;
    const bf16_t* src = xres + (size_t)t * 1024 + 32 * blk;
    const int b = t < TL ? (t >> 11) : 16;
    const float* md = modbuf + ((size_t)l * 17 + b) * 6144 + 32 * blk;
    float x[32];
    float ss = 0.f;
#pragma unroll
    for (int i = 0; i < 4; ++i) { const u32x4 a = *(const u32x4*)(src + 8 * i); unpack8(a, x + 8 * i); }
#pragma unroll
    for (int i = 0; i < 32; ++i) ss += x[i] * x[i];
#pragma unroll
    for (int o = 16; o >= 1; o >>= 1) ss += __shfl_xor(ss, o);
    const float rstd = rsqrtf(ss * (1.f / 1024.f) + 1e-6f);
    unsigned pk[16];
#pragma unroll
    for (int i = 0; i < 8; ++i) {
      const float4 g4 = *(const float4*)(gvec + 4 * i), sh = *(const float4*)(md + 3 * 1024 + 4 * i), sc = *(const float4*)(md + 4 * 1024 + 4 * i);
      x[4 * i] = x[4 * i] * rstd * g4.x * (1.f + sc.x) + sh.x;
      x[4 * i + 1] = x[4 * i + 1] * rstd * g4.y * (1.f + sc.y) + sh.y;
      x[4 * i + 2] = x[4 * i + 2] * rstd * g4.z * (1.f + sc.z) + sh.z;
      x[4 * i + 3] = x[4 * i + 3] * rstd * g4.w * (1.f + sc.w) + sh.w;
      pk[2 * i] = pk2(x[4 * i], x[4 * i + 1]); pk[2 * i + 1] = pk2(x[4 * i + 2], x[4 * i + 3]);
    }
    bf16_t* hrow = hbuf + (size_t)t * 1024 + 32 * blk;
#pragma unroll
    for (int i = 0; i < 4; ++i) *(u32x4*)(hrow + 8 * i) = (u32x4){pk[4 * i], pk[4 * i + 1], pk[4 * i + 2], pk[4 * i + 3]};
    unsigned sb;
    const u32x6 q = mxfp6_pack32(x, sb);
    unsigned char* row = h6 + (size_t)t * V6_PITCH;
    *(u32x2*)(row + 24 * blk) = (u32x2){q[0], q[1]};
    *(u32x2*)(row + 24 * blk + 8) = (u32x2){q[2], q[3]};
    *(u32x2*)(row + 24 * blk + 16) = (u32x2){q[4], q[5]};
    row[mx_scale_pos(blk)] = (unsigned char)sb;
  }
}

template <int EPI>
DI void gemm_tile(const bf16_t* __restrict__ P, const bf16_t* __restrict__ Q, int it, int jt, void* outp, int ld,
                  const float* xin_lat, const float* xin_ctx, const float* modl, unsigned char* lds, bool gvar = false) {
  const int tid = ltid(), lane = tid & 63, w = tid >> 6, wi = w >> 1, wj = w & 1, lr = lane & 15, g = lane >> 4;
  const int wu = __builtin_amdgcn_readfirstlane(w);
  f32x4 acc[4][4];
#pragma unroll
  for (int a = 0; a < 4; ++a)
#pragma unroll
    for (int b = 0; b < 4; ++b) acc[a][b] = (f32x4){0.f, 0.f, 0.f, 0.f};
  const unsigned lo0 = (unsigned)((lane >> 3) * 1024 + (((lane & 7) ^ (lane >> 4)) << 3));
  const unsigned lo1 = (unsigned)((lane >> 3) * 1024 + (((lane & 7) ^ (4 + (lane >> 4))) << 3));
  const bf16_t* pg = P + (size_t)(it * 128 + 32 * wu) * 1024;
  const bf16_t* qg = Q + (size_t)(jt * 128 + 32 * wu) * 1024;
#define GT_DMA(kb, bf) do { _Pragma("unroll") for (int jj = 0; jj < 4; ++jj) { const unsigned lo_ = (jj & 1) ? lo1 : lo0; \
      __builtin_amdgcn_global_load_lds((const unsigned*)(pg + (size_t)jj * 8192 + (kb) * 64 + lo_), (unsigned*)(lds + (bf) * 32768 + (4 * wu + jj) * 1024), 16, 0, 0); \
      __builtin_amdgcn_global_load_lds((const unsigned*)(qg + (size_t)jj * 8192 + (kb) * 64 + lo_), (unsigned*)(lds + (bf) * 32768 + 16384 + (4 * wu + jj) * 1024), 16, 0, 0); } } while (0)
  __syncthreads();
  GT_DMA(0, 0);
  asm volatile("s_waitcnt vmcnt(0)" ::: "memory");
  __syncthreads();
  for (int kb = 0; kb < 16; ++kb) {
    if (kb < 15 && !(GEMM_VAR == 1 && gvar)) GT_DMA(kb + 1, (kb + 1) & 1);
    const unsigned char* Ps = lds + (kb & 1) * 32768;
    const unsigned char* Qs = Ps + 16384;
    bf16x8 pf[2][4], qf[2][4];
#pragma unroll
    for (int ks = 0; ks < 2; ++ks) {
      const int ch = ks * 4 + g;
#pragma unroll
      for (int mi = 0; mi < 4; ++mi) { const int row = wi * 64 + mi * 16 + lr; pf[ks][mi] = *(const bf16x8*)(Ps + (row >> 1) * 256 + (((((row & 1) << 3) | ch) ^ ((row >> 1) & 7)) << 4)); }
#pragma unroll
      for (int nj = 0; nj < 4; ++nj) { const int row = wj * 64 + nj * 16 + lr; qf[ks][nj] = *(const bf16x8*)(Qs + (row >> 1) * 256 + (((((row & 1) << 3) | ch) ^ ((row >> 1) & 7)) << 4)); }
    }
    __builtin_amdgcn_sched_barrier(0);
    __builtin_amdgcn_s_setprio(1);
#pragma unroll
    for (int ks = 0; ks < 2; ++ks)
#pragma unroll
      for (int mi = 0; mi < 4; ++mi)
#pragma unroll
        for (int nj = 0; nj < 4; ++nj) { if (GEMM_VAR == 2 && gvar) { asm volatile("" :: "v"(pf[ks][mi]), "v"(qf[ks][nj])); } else acc[mi][nj] = mfma16(pf[ks][mi], qf[ks][nj], acc[mi][nj]); }
    __builtin_amdgcn_s_setprio(0);
    __builtin_amdgcn_sched_barrier(0);
    asm volatile("s_waitcnt vmcnt(0)" ::: "memory");
    __syncthreads();
  }
#undef GT_DMA
  if (EPI == 2) {
    float inv[4];
#pragma unroll
    for (int r = 0; r < 4; ++r) inv[r] = __builtin_amdgcn_exp2f(-(float)(4 * g + r) * (13.287712379549449f / 16.f));
#pragma unroll
    for (int nj = 0; nj < 4; ++nj) {
      const int j = jt * 128 + wj * 64 + nj * 16 + lr;
      if (j < TL) {
        const float prow = (float)((j & 2047) >> 6), pcol = (float)(j & 63);
#pragma unroll
        for (int r = 0; r < 4; ++r) {
          const float a1 = prow * inv[r], a2 = pcol * inv[r];
          const float c1 = __cosf(a1), s1 = __sinf(a1), c2 = __cosf(a2), s2 = __sinf(a2);
          const float x1 = acc[0][nj][r], x2 = acc[1][nj][r], y1 = acc[2][nj][r], y2 = acc[3][nj][r];
          acc[0][nj][r] = x1 * c1 - x2 * s1; acc[1][nj][r] = x2 * c1 + x1 * s1;
          acc[2][nj][r] = y1 * c2 - y2 * s2; acc[3][nj][r] = y2 * c2 + y1 * s2;
        }
      }
    }
  }
#pragma unroll
  for (int mi = 0; mi < 4; ++mi)
#pragma unroll
    for (int nj = 0; nj < 4; ++nj) {
      const int j = jt * 128 + wj * 64 + nj * 16 + lr;
      const int i = it * 128 + wi * 64 + mi * 16 + 4 * g;
      const f32x4 a = acc[mi][nj];
      if (EPI == 0 || EPI == 2) {
        u32x2 o = {pk2(a[0], a[1]), pk2(a[2], a[3])};
        *(u32x2*)((bf16_t*)outp + (size_t)j * ld + i) = o;
      } else {
        const int b = j < TL ? (j >> 11) : 16;
        const float4 gt = *(const float4*)(modl + (size_t)b * 6144 + 2 * 1024 + i);
        float4 xv;
        if (xin_lat) {
          const float* xs = (j < TL) ? xin_lat + (size_t)j * 1024 + i : xin_ctx + (size_t)(j - TL) * 1024 + i;
          xv = *(const float4*)xs;
        } else {
          const u32x2 r = *(const u32x2*)((const bf16_t*)outp + (size_t)j * 1024 + i);
          xv = (float4){bflo(r.x), bfhi(r.x), bflo(r.y), bfhi(r.y)};
        }
        u32x2 o = {pk2(xv.x + gt.x * a[0], xv.y + gt.y * a[1]), pk2(xv.z + gt.z * a[2], xv.w + gt.w * a[3])};
        *(u32x2*)((bf16_t*)outp + (size_t)j * 1024 + i) = o;
      }
    }
}

struct TileIter {
  int u, step, total, nf, tpx, x;
  DI void init(int n_tok_tiles, int n_feat_tiles) {
    const int bid = lbid(), nb = lgdim();
    nf = n_feat_tiles;
    if ((nb & 7) == 0 && (n_tok_tiles & 7) == 0) { x = bid & 7; u = bid >> 3; step = nb >> 3; tpx = n_tok_tiles >> 3; }
    else { x = 0; u = bid; step = nb; tpx = n_tok_tiles; }
    total = tpx * nf;
  }
  DI bool valid() const { return u < total; }
  DI void next() { u += step; }
  DI void get(int& tok_tile, int& feat_tile) const {
    const int g = u / (8 * nf), rem = u - g * 8 * nf;
    const int gs = (tpx - 8 * g) < 8 ? (tpx - 8 * g) : 8;
    const int f = rem / gs, tt = rem - f * gs;
    tok_tile = x * tpx + 8 * g + tt; feat_tile = f;
  }
};

DI void phase_gemm_in(const Params& p, int l, unsigned char* lds, bool gvar = false) {
  const bf16_t* W = (const bf16_t*)(p.ws + OFF_WIN) + (size_t)l * 3200 * 1024;
  const bf16_t* H = (const bf16_t*)(p.ws + OFF_H);
  bf16_t* PN = (bf16_t*)(p.ws + OFF_P);
  bf16_t* VT = (bf16_t*)(p.ws + OFF_VT);
  TileIter ti; ti.init(TT / 128, 25);
  for (; ti.valid(); ti.next()) {
    int jt, f; ti.get(jt, f);
    if (f >= 8 && f < 16) gemm_tile<2>(W, H, f, jt, PN, PN_LD, nullptr, nullptr, nullptr, lds, gvar);
    else if (f < 17) gemm_tile<0>(W, H, f, jt, PN, PN_LD, nullptr, nullptr, nullptr, lds, gvar);
    else gemm_tile<0>(H, W + (size_t)2176 * 1024, jt, f - 17, VT, TT, nullptr, nullptr, nullptr, lds, gvar);
  }
}
DI void phase_gemm_out(const Params& p, int l, int ntok, unsigned char* lds) {
  const bf16_t* W = (const bf16_t*)(p.ws + OFF_WOUT) + (size_t)l * 1024 * 1024;
  const bf16_t* Y = (const bf16_t*)(p.ws + OFF_Y);
  bf16_t* xres = (bf16_t*)(p.ws + OFF_XRES);
  const float* modl = (const float*)(p.ws + OFF_MOD) + (size_t)l * 17 * 6144;
  const float* xl = (l == 0) ? p.x : nullptr;
  const float* xc = (l == 0) ? p.ctx : nullptr;
  TileIter ti; ti.init(ntok / 128, 8);
  for (; ti.valid(); ti.next()) {
    int jt, f; ti.get(jt, f);
    gemm_tile<1>(W, Y, f, jt, xres, 1024, xl, xc, modl, lds);
  }
}
DI void phase_gemm_q(const Params& p, int l, int ntok, unsigned char* lds) {
  const bf16_t* W = (const bf16_t*)(p.ws + OFF_WQ) + (size_t)l * 1024 * 1024;
  const bf16_t* H = (const bf16_t*)(p.ws + OFF_H);
  bf16_t* QP = (bf16_t*)(p.ws + OFF_QP);
  TileIter ti; ti.init(ntok / 128, 8);
  for (; ti.valid(); ti.next()) {
    int jt, f; ti.get(jt, f);
    gemm_tile<0>(W, H, f, jt, QP, 1024, nullptr, nullptr, nullptr, lds);
  }
}

DI void phase_rope(const Params& p, unsigned char* lds) {
  float2* tab = (float2*)lds;
  for (int e = ltid(); e < 1024; e += 256) {
    const int pos = e >> 4, i = e & 15;
    const float inv = exp2f(-(float)i * (13.287712379549449f / 16.f));
    const float ang = (float)pos * inv;
    tab[e] = make_float2(__cosf(ang), __sinf(ang));
  }
  __syncthreads();
  bf16_t* PN = (bf16_t*)(p.ws + OFF_P);
  const int total = TL * 16;
  for (int idx = lbid() * 256 + ltid(); idx < total; idx += lgdim() * 256) {
    const int t = idx >> 4, vec = idx & 15;
    const int col = ((vec >> 3) ? C_DK : C_DQ) + ((vec >> 1) & 3) * 128 + (vec & 1) * 64;
    bf16_t* ptr = PN + (size_t)t * PN_LD + col;
    float xv[64];
#pragma unroll
    for (int q = 0; q < 8; ++q) { const u32x4 v = *(const u32x4*)(ptr + q * 8); unpack8(v, xv + q * 8); }
    const int row = (t & 2047) >> 6, cp = t & 63;
#pragma unroll
    for (int i = 0; i < 16; ++i) {
      const float2 cs = tab[row * 16 + i];
      const float x1 = xv[i], x2 = xv[16 + i];
      xv[i] = x1 * cs.x - x2 * cs.y; xv[16 + i] = x2 * cs.x + x1 * cs.y;
      const float2 cs2 = tab[cp * 16 + i];
      const float y1 = xv[32 + i], y2 = xv[48 + i];
      xv[32 + i] = y1 * cs2.x - y2 * cs2.y; xv[48 + i] = y2 * cs2.x + y1 * cs2.y;
    }
#pragma unroll
    for (int q = 0; q < 8; ++q) {
      u32x4 o = {pk2(xv[q * 8], xv[q * 8 + 1]), pk2(xv[q * 8 + 2], xv[q * 8 + 3]), pk2(xv[q * 8 + 4], xv[q * 8 + 5]), pk2(xv[q * 8 + 6], xv[q * 8 + 7])};
      *(u32x4*)(ptr + q * 8) = o;
    }
  }
}

struct SrcSeg {
  const bf16_t* PN; const bf16_t* VT; int kcol, vrow, t0, n0, t1, n1, lr, g;
  DI int nsteps() const { return n0 + n1; }
  DI int tok0(int st) const { return st < n0 ? t0 + st * 32 : t1 + (st - n0) * 32; }
  DI float score(float raw, int st, int kt, int r) const { return raw * SC_LOG2; }
};
struct SrcNat {
  const bf16_t* PN; const bf16_t* VT; int kcol, vrow, b, rq, rs, cs, qc, cstart, lr, g;
  const float* rpbh;
  DI int nsteps() const { return 16; }
  DI int tok0(int st) const { return st < 8 ? b * 2048 + (rs + st) * 64 + cs : TL + b * 256 + (st - 8) * 32; }
  DI float score(float raw, int st, int kt, int r) const {
    if (st >= 8) return raw * SC_LOG2;
    const int kc = cs + 8 * g + 4 * kt + r;
    const bool valid = (kc >= cstart) && (kc < cstart + 16);
    int dc = kc - qc + 15; dc = dc < 0 ? 0 : (dc > 30 ? 30 : dc);
    const float bias = rpbh[(rs + st - rq + 7) * 31 + dc];
    return valid ? (raw * 0.125f + bias) * LOG2E : NEG_BIG;
  }
};

template <class Src>
struct FlashFrags { bf16x8 k[2][2]; bf16x8 v[4]; };
template <class Src>
DI void flash_load(const Src& S, int st, FlashFrags<Src>& F) {
  const int tk = S.tok0(st);
  const int kap = 8 * (S.lr >> 2) + (S.lr & 3);
  const bf16_t* k0p = S.PN + (size_t)(tk + kap) * PN_LD + S.kcol + 8 * S.g;
  const bf16_t* vp = S.VT + (size_t)(S.vrow + S.lr) * TT + tk + 8 * S.g;
#pragma unroll
  for (int kt = 0; kt < 2; ++kt)
#pragma unroll
    for (int ks = 0; ks < 2; ++ks) F.k[kt][ks] = *(const bf16x8*)(k0p + (size_t)kt * 4 * PN_LD + ks * 32);
#pragma unroll
  for (int dt = 0; dt < 4; ++dt) F.v[dt] = *(const bf16x8*)(vp + (size_t)dt * 16 * TT);
}
template <class Src>
DI void flash_step(const Src& S, int st, const FlashFrags<Src>& F, const bf16x8 (&qf)[2], f32x4 (&o)[4], float& mrun, float& lrun) {
  f32x4 s[2];
#pragma unroll
  for (int kt = 0; kt < 2; ++kt) {
    s[kt] = (f32x4){0.f, 0.f, 0.f, 0.f};
#pragma unroll
    for (int ks = 0; ks < 2; ++ks) s[kt] = mfma16(F.k[kt][ks], qf[ks], s[kt]);
  }
  float mt = NEG_BIG;
#pragma unroll
  for (int kt = 0; kt < 2; ++kt)
#pragma unroll
    for (int r = 0; r < 4; ++r) { s[kt][r] = S.score(s[kt][r], st, kt, r); mt = fmaxf(mt, s[kt][r]); }
  mt = rows_max(mt);
  const bool need = mt > mrun + 8.f;
  if (__any(need)) {
    const float mnew = need ? mt : mrun;
    const float alpha = __builtin_amdgcn_exp2f(mrun - mnew);
    lrun *= alpha;
#pragma unroll
    for (int dt = 0; dt < 4; ++dt) { o[dt][0] *= alpha; o[dt][1] *= alpha; o[dt][2] *= alpha; o[dt][3] *= alpha; }
    mrun = mnew;
  }
  float pv[8], ls = 0.f;
#pragma unroll
  for (int kt = 0; kt < 2; ++kt)
#pragma unroll
    for (int r = 0; r < 4; ++r) { pv[kt * 4 + r] = __builtin_amdgcn_exp2f(s[kt][r] - mrun); ls += pv[kt * 4 + r]; }
  lrun += ls;
  u32x4 pk = {pk2(pv[0], pv[1]), pk2(pv[2], pv[3]), pk2(pv[4], pv[5]), pk2(pv[6], pv[7])};
  const bf16x8 pf = __builtin_bit_cast(bf16x8, pk);
#pragma unroll
  for (int dt = 0; dt < 4; ++dt) o[dt] = mfma16(F.v[dt], pf, o[dt]);
}
template <class Src>
DI void flash_wave(const Src& S, const bf16_t* qptr  , f32x4 (&o)[4], float& ltot) {
  bf16x8 qf[2];
  qf[0] = *(const bf16x8*)(qptr); qf[1] = *(const bf16x8*)(qptr + 32);
  float mrun = NEG_BIG, lrun = 0.f;
#pragma unroll
  for (int dt = 0; dt < 4; ++dt) o[dt] = (f32x4){0.f, 0.f, 0.f, 0.f};
  const int ns = S.nsteps();
  FlashFrags<Src> f0, f1, f2;
  flash_load(S, 0, f0);
  if (ns > 1) flash_load(S, 1, f1);
  for (int st = 0; st < ns; st += 3) {
    if (st + 2 < ns) flash_load(S, st + 2, f2);
    flash_step(S, st, f0, qf, o, mrun, lrun);
    if (st + 1 < ns) {
      if (st + 3 < ns) flash_load(S, st + 3, f0);
      flash_step(S, st + 1, f1, qf, o, mrun, lrun);
    }
    if (st + 2 < ns) {
      if (st + 4 < ns) flash_load(S, st + 4, f1);
      flash_step(S, st + 2, f2, qf, o, mrun, lrun);
    }
  }
  ltot = rows_sum(lrun);
}

DI void nat_wave_task(const Params& p, int l, int b, int head, int rq, int ct, const float* rpb_lds) {
  const int lane = ltid() & 63, lr = lane & 15, g = lane >> 4;
  const bf16_t* PN = (const bf16_t*)(p.ws + OFF_P);
  const bf16_t* VT = (const bf16_t*)(p.ws + OFF_VT);
  bf16_t* Y = (bf16_t*)(p.ws + OFF_Y);
  SrcNat S;
  S.PN = PN; S.VT = VT; S.kcol = C_NK + head * 64; S.vrow = R_NV + head * 64; S.b = b; S.rq = rq; S.lr = lr; S.g = g;
  int rs = rq - 4; rs = rs < 0 ? 0 : (rs > 24 ? 24 : rs);
  S.rs = rs;
  int cs = 16 * ct - 8; cs = cs < 0 ? 0 : (cs > 32 ? 32 : cs);
  S.cs = cs;
  S.qc = 16 * ct + lr;
  int cst = S.qc - 8; cst = cst < 0 ? 0 : (cst > 48 ? 48 : cst);
  S.cstart = cst;
  S.rpbh = rpb_lds + head * 465;
  f32x4 o[4];
  float lt;
  const int qtok = b * 2048 + rq * 64 + 16 * ct + lr;
  flash_wave<SrcNat>(S, PN + (size_t)qtok * PN_LD + C_NQ + head * 64 + 8 * g, o, lt);
  const float inv = 1.f / lt;
#pragma unroll
  for (int dt = 0; dt < 4; ++dt) {
    u32x2 ov = {pk2(o[dt][0] * inv, o[dt][1] * inv), pk2(o[dt][2] * inv, o[dt][3] * inv)};
    *(u32x2*)(Y + (size_t)qtok * 1024 + 256 + head * 64 + dt * 16 + 4 * g) = ov;
  }
}
DI void natctx_wave_task(const Params& p, int b, int head, int qt) {
  const int lane = ltid() & 63, lr = lane & 15, g = lane >> 4;
  const bf16_t* PN = (const bf16_t*)(p.ws + OFF_P);
  const bf16_t* VT = (const bf16_t*)(p.ws + OFF_VT);
  bf16_t* Y = (bf16_t*)(p.ws + OFF_Y);
  SrcSeg S;
  S.PN = PN; S.VT = VT; S.kcol = C_NK + head * 64; S.vrow = R_NV + head * 64; S.lr = lr; S.g = g;
  S.t0 = TL + b * 256; S.n0 = 8; S.t1 = 0; S.n1 = 0;
  f32x4 o[4];
  float lt;
  const int qtok = TL + b * 256 + qt * 16 + lr;
  flash_wave<SrcSeg>(S, PN + (size_t)qtok * PN_LD + C_NQ + head * 64 + 8 * g, o, lt);
  const float inv = 1.f / lt;
#pragma unroll
  for (int dt = 0; dt < 4; ++dt) {
    u32x2 ov = {pk2(o[dt][0] * inv, o[dt][1] * inv), pk2(o[dt][2] * inv, o[dt][3] * inv)};
    *(u32x2*)(Y + (size_t)qtok * 1024 + 256 + head * 64 + dt * 16 + 4 * g) = ov;
  }
}

DI f32x16 mfma32(bf16x8 a, bf16x8 b, f32x16 c) { return __builtin_amdgcn_mfma_f32_32x32x16_bf16(a, b, c, 0, 0, 0); }
DI float half_max(float x) {
  unsigned u = __float_as_uint(x);
  u32x2 a = __builtin_amdgcn_permlane32_swap(u, u, false, false);
  return fmaxf(__uint_as_float(a[0]), __uint_as_float(a[1]));
}
DI float half_sum(float x) {
  unsigned u = __float_as_uint(x);
  u32x2 a = __builtin_amdgcn_permlane32_swap(u, u, false, false);
  return __uint_as_float(a[0]) + __uint_as_float(a[1]);
}
DI void diff_block_task(const Params& p, int l, int b, int hd, int qtok0, int nsteps, unsigned char* lds, int dvar = 0) {
  const int tid = ltid(), lane = tid & 63, w = tid >> 6, l31 = lane & 31, h = lane >> 5;
  unsigned char* Kb = lds;
  unsigned char* Vb = lds + 8192;
  const bf16_t* PN = (const bf16_t*)(p.ws + OFF_P);
  const bf16_t* VT = (const bf16_t*)(p.ws + OFF_VT);
  bf16_t* Y = (bf16_t*)(p.ws + OFF_Y);
  bf16x8 qf[2][4];
  {
    const bf16_t* qp = PN + (size_t)(qtok0 + 32 * w + l31) * PN_LD + C_DQ + hd * 128 + 8 * h;
#pragma unroll
    for (int m = 0; m < 2; ++m)
#pragma unroll
      for (int kd = 0; kd < 4; ++kd) {
        const u32x4 raw = *(const u32x4*)(qp + m * 64 + kd * 16);
        float f[8];
        unpack8(raw, f);
        u32x4 sc = {pk2(f[0] * SC_LOG2, f[1] * SC_LOG2), pk2(f[2] * SC_LOG2, f[3] * SC_LOG2), pk2(f[4] * SC_LOG2, f[5] * SC_LOG2), pk2(f[6] * SC_LOG2, f[7] * SC_LOG2)};
        qf[m][kd] = __builtin_bit_cast(bf16x8, sc);
      }
  }
  const int wu = __builtin_amdgcn_readfirstlane(w);
  unsigned kofs[2], vofs[2];
#pragma unroll
  for (int jj = 0; jj < 2; ++jj) {
    const int krow = 4 * (2 * w + jj) + (lane >> 4), kpc = lane & 15;
    const int kch = kpc ^ (krow & 15);
    kofs[jj] = (unsigned)(krow * PN_LD + C_DK + hd * 128 + kch * 8) * 2u;
    const int vrow = 16 * (2 * w + jj) + (lane >> 2), vpc = lane & 3;
    const int vch = vpc ^ ((vrow >> 2) & 3);
    vofs[jj] = (unsigned)((R_DV + hd * 128 + vrow) * TT + vch * 8) * 2u;
  }
#define DB_DMA(st, sl) do { const int tk = (st) < 8 ? TL + b * 256 + (st) * 32 : b * 2048 + ((st) - 8) * 32; \
    const char* kb_ = (const char*)(PN + (size_t)tk * PN_LD); const char* vb_ = (const char*)(VT + tk); \
    _Pragma("unroll") for (int jj = 0; jj < 2; ++jj) { \
      __builtin_amdgcn_global_load_lds((const unsigned*)(kb_ + kofs[jj]), (unsigned*)(Kb + (sl) * 16384 + (2 * wu + jj) * 1024), 16, 0, 0); \
      __builtin_amdgcn_global_load_lds((const unsigned*)(vb_ + vofs[jj]), (unsigned*)(Vb + (sl) * 16384 + (2 * wu + jj) * 1024), 16, 0, 0); } } while (0)
  asm volatile("s_waitcnt vmcnt(0)" ::: "memory");
  __syncthreads();
  DB_DMA(0, 0);
  DB_DMA(nsteps > 1 ? 1 : 0, 1);
  DB_DMA(nsteps > 2 ? 2 : nsteps - 1, 2);
  asm volatile("s_waitcnt vmcnt(8)" ::: "memory");
  __builtin_amdgcn_s_barrier();

  f32x16 o[2][4];
  float mrun[2], lrun[2];
#pragma unroll
  for (int m = 0; m < 2; ++m) {
    mrun[m] = NEG_BIG; lrun[m] = 0.f;
#pragma unroll
    for (int dt = 0; dt < 4; ++dt)
#pragma unroll
      for (int i = 0; i < 16; ++i) o[m][dt][i] = 0.f;
  }
  const int krw = (l31 & 0x13) | ((l31 & 4) << 1) | ((l31 & 8) >> 1);
  const unsigned kro = (unsigned)(krw * 256), kx = (unsigned)(h ^ (krw & 15));
  const unsigned vro = (unsigned)(l31 * 64), vx = (unsigned)(h ^ ((l31 >> 2) & 3));
#define DF_LOADK(kf, Kt_, m_) _Pragma("unroll") for (int kd = 0; kd < 4; ++kd) \
    kf[kd] = *(const bf16x8*)((Kt_) + kro + ((kx ^ (unsigned)((m_) * 8 + 2 * kd)) << 4))
#define DF_LOADV(vf, Vt_, d0_) _Pragma("unroll") for (int dd = 0; dd < 2; ++dd) _Pragma("unroll") for (int kk = 0; kk < 2; ++kk) \
    vf[dd][kk] = *(const bf16x8*)((Vt_) + ((d0_) + dd) * 2048 + vro + ((vx ^ (unsigned)(2 * kk)) << 4))
#define DF_SMFMA(s, kf, m_) { _Pragma("unroll") for (int i = 0; i < 16; ++i) s[i] = 0.f; \
    _Pragma("unroll") for (int kd = 0; kd < 4; ++kd) s = mfma32(kf[kd], qf[m_][kd], s); }
#define DF_SOFTMAX(s, m_) { \
    float mt = NEG_BIG; \
    _Pragma("unroll") for (int i = 0; i < 16; ++i) mt = fmaxf(mt, s[i]); \
    mt = half_max(mt); \
    const bool need = mt > mrun[m_] + 8.f; \
    if (__any(need)) { \
      const float mnew = need ? mt : mrun[m_]; \
      const float alpha = __builtin_amdgcn_exp2f(mrun[m_] - mnew); \
      lrun[m_] *= alpha; \
      _Pragma("unroll") for (int dt = 0; dt < 4; ++dt) _Pragma("unroll") for (int i = 0; i < 16; ++i) o[m_][dt][i] *= alpha; \
      mrun[m_] = mnew; \
    } \
    float pv[16], ls = 0.f; \
    _Pragma("unroll") for (int i = 0; i < 16; ++i) { pv[i] = __builtin_amdgcn_exp2f(s[i] - mrun[m_]); ls += pv[i]; } \
    lrun[m_] += ls; \
    _Pragma("unroll") for (int kk = 0; kk < 2; ++kk) { \
      u32x4 pk = {pk2(pv[8 * kk], pv[8 * kk + 1]), pk2(pv[8 * kk + 2], pv[8 * kk + 3]), pk2(pv[8 * kk + 4], pv[8 * kk + 5]), pk2(pv[8 * kk + 6], pv[8 * kk + 7])}; \
      pf[m_][kk] = __builtin_bit_cast(bf16x8, pk); } }
#define DF_PV(vf, d0_, dd_) _Pragma("unroll") for (int kk = 0; kk < 2; ++kk) _Pragma("unroll") for (int m = 0; m < 2; ++m) \
    o[m][(d0_) + (dd_)] = mfma32(vf[dd_][kk], pf[m][kk], o[m][(d0_) + (dd_)])
  bf16x8 kf0[4];
  DF_LOADK(kf0, Kb, 0);
  for (int st = 0; st < nsteps; ++st) {
    { const int sn = st + 3 < nsteps ? st + 3 : nsteps - 1; DB_DMA(sn, (st + 3) & 3); }
    const unsigned char* Kt = Kb + (st & 3) * 16384;
    const unsigned char* Vt = Vb + (st & 3) * 16384;
    bf16x8 pf[2][2];
    bf16x8 kf1[4];
    DF_LOADK(kf1, Kt, 1);
    f32x16 s0;
    DF_SMFMA(s0, kf0, 0)
    __builtin_amdgcn_sched_barrier(0);
    DF_SOFTMAX(s0, 0)
    __builtin_amdgcn_sched_barrier(0);
    f32x16 s1;
    DF_SMFMA(s1, kf1, 1)
    __builtin_amdgcn_sched_barrier(0);
    bf16x8 vfA[2][2];
    DF_LOADV(vfA, Vt, 0);
    DF_SOFTMAX(s1, 1)
    __builtin_amdgcn_sched_barrier(0);
    DF_PV(vfA, 0, 0);
    __builtin_amdgcn_sched_barrier(0);
    bf16x8 vfB[2][2];
    DF_LOADV(vfB, Vt, 2);
    DF_PV(vfA, 0, 1);
    __builtin_amdgcn_sched_barrier(0);
    asm volatile("s_waitcnt vmcnt(8) lgkmcnt(0)" ::: "memory");
    __builtin_amdgcn_s_barrier();
    __builtin_amdgcn_sched_barrier(0);
    DF_PV(vfB, 2, 0);
    __builtin_amdgcn_sched_barrier(0);
    DF_LOADK(kf0, Kb + ((st + 1) & 3) * 16384, 0);
    DF_PV(vfB, 2, 1);
    __builtin_amdgcn_sched_barrier(0);
  }
#undef DF_LOADK
#undef DF_LOADV
#undef DF_SMFMA
#undef DF_SOFTMAX
#undef DF_PV
  asm volatile("s_waitcnt vmcnt(0)" ::: "memory");
#undef DB_DMA
  const int tid2 = ltid(), lane2 = tid2 & 63, w2 = tid2 >> 6, q2 = lane2 & 31, h2 = lane2 >> 5;
  const float* lv = p.dlam + l * 256;
  float sa = lv[lane2] * lv[64 + lane2], sb = lv[128 + lane2] * lv[192 + lane2];
  sa = wave_sum(sa); sb = wave_sum(sb);
  const float lam_init = 0.8f - 0.6f * expf(-0.3f * (float)l);
  const float lam = expf(sa) - expf(sb) + lam_init;
  const float* dg = p.diff_g + l * 512 + hd * 128;
  {
    const float l0 = half_sum(lrun[0]), l1 = half_sum(lrun[1]);
    const float i0 = 1.f / l0, i1 = lam / l1;
    float ss = 0.f;
#pragma unroll
    for (int dt = 0; dt < 4; ++dt)
#pragma unroll
      for (int i = 0; i < 16; ++i) { const float v = o[0][dt][i] * i0 - o[1][dt][i] * i1; o[0][dt][i] = v; ss += v * v; }
    ss = half_sum(ss);
    const float rstd = rsqrtf(ss * (1.f / 128.f) + 1e-6f) * (1.f - lam_init);
    const int qtok = qtok0 + 32 * w2 + q2;
#pragma unroll
    for (int dt = 0; dt < 4; ++dt)
#pragma unroll
      for (int i4 = 0; i4 < 4; ++i4) {
        const int dv = 32 * dt + 8 * i4 + 4 * h2;
        const float4 gg = *(const float4*)(dg + dv);
        u32x2 ov = {pk2(o[0][dt][4 * i4] * rstd * gg.x, o[0][dt][4 * i4 + 1] * rstd * gg.y), pk2(o[0][dt][4 * i4 + 2] * rstd * gg.z, o[0][dt][4 * i4 + 3] * rstd * gg.w)};
        *(u32x2*)(Y + (size_t)qtok * 1024 + 512 + hd * 128 + dv) = ov;
      }
  }
}


DI void nat_block_task(const Params& p, int l, int b, int head, int rq, const float* rpb_lds, unsigned char* lds) {
  const int tid = ltid(), lane = tid & 63, w = tid >> 6, lr = lane & 15, g = lane >> 4;
  const int wu = __builtin_amdgcn_readfirstlane(w);
  unsigned char* Kb = lds;
  unsigned char* Vb = lds + 8192;
  const bf16_t* PN = (const bf16_t*)(p.ws + OFF_P);
  const bf16_t* VT = (const bf16_t*)(p.ws + OFF_VT);
  bf16_t* Y = (bf16_t*)(p.ws + OFF_Y);
  int rs = rq - 4; rs = rs < 0 ? 0 : (rs > 24 ? 24 : rs);
  const int ct = w;
  int cs = 16 * ct - 8; cs = cs < 0 ? 0 : (cs > 32 ? 32 : cs);
  const int qc = 16 * ct + lr;
  int cstart = qc - 8; cstart = cstart < 0 ? 0 : (cstart > 48 ? 48 : cstart);
  const float* rpbh = rpb_lds + head * 465;
  const int qtok = b * 2048 + rq * 64 + qc;
  bf16x8 qf[2];
  { const bf16_t* qp = PN + (size_t)qtok * PN_LD + C_NQ + head * 64 + 8 * g; qf[0] = *(const bf16x8*)qp; qf[1] = *(const bf16x8*)(qp + 32); }
  unsigned kofs[2], vofs[2];
#pragma unroll
  for (int jj = 0; jj < 2; ++jj) {
    const int pidx = 2 * w + jj, row = 8 * pidx + (lane >> 3);
    const int kch = (lane & 7) ^ ((((row >> 3) & 3) << 1) | ((row >> 1) & 1));
    kofs[jj] = (unsigned)(row * PN_LD + C_NK + head * 64 + kch * 8);
    const int vch = (lane & 7) ^ ((row >> 1) & 7);
    vofs[jj] = (unsigned)((R_NV + head * 64 + row) * TT + vch * 8);
  }
#define NB_DMA(st, bf) do { const int tk = (st) < 8 ? b * 2048 + (rs + (st)) * 64 : TL + b * 256 + ((st) - 8) * 64; \
    const bf16_t* kb_ = PN + (size_t)tk * PN_LD; const bf16_t* vb_ = VT + tk; \
    _Pragma("unroll") for (int jj = 0; jj < 2; ++jj) { \
      __builtin_amdgcn_global_load_lds((const unsigned*)(kb_ + kofs[jj]), (unsigned*)(Kb + (bf) * 16384 + (2 * wu + jj) * 1024), 16, 0, 0); \
      __builtin_amdgcn_global_load_lds((const unsigned*)(vb_ + vofs[jj]), (unsigned*)(Vb + (bf) * 16384 + (2 * wu + jj) * 1024), 16, 0, 0); } } while (0)
  asm volatile("s_waitcnt vmcnt(0)" ::: "memory");
  __syncthreads();
  NB_DMA(0, 0); NB_DMA(1, 1); NB_DMA(2, 2);
  asm volatile("s_waitcnt vmcnt(8)" ::: "memory");
  __builtin_amdgcn_s_barrier();
  f32x4 o[4];
#pragma unroll
  for (int dt = 0; dt < 4; ++dt) o[dt] = (f32x4){0.f, 0.f, 0.f, 0.f};
  float mrun = NEG_BIG, lrun = 0.f;
  const int kap = 8 * (lr >> 2) + (lr & 3);
  for (int st = 0; st < 12; ++st) {
    { const int sn = st + 3 < 12 ? st + 3 : 11; NB_DMA(sn, (st + 3) & 3); }
    const unsigned char* Kt = Kb + (st & 3) * 16384;
    const unsigned char* Vt = Vb + (st & 3) * 16384;
    const int nsub = st < 8 ? 1 : 2;
    for (int sub = 0; sub < nsub; ++sub) {
      const int koff = st < 8 ? cs : 32 * sub;
      bf16x8 kf[2][2], vf[4];
#pragma unroll
      for (int kt = 0; kt < 2; ++kt) {
        const int row = koff + kap + 4 * kt;
        const int sw = (((row >> 3) & 3) << 1) | ((row >> 1) & 1);
#pragma unroll
        for (int ks = 0; ks < 2; ++ks) kf[kt][ks] = *(const bf16x8*)(Kt + (row >> 1) * 256 + ((((row & 1) << 3) | ((ks * 4 + g) ^ sw)) << 4));
      }
#pragma unroll
      for (int dt = 0; dt < 4; ++dt) {
        const int row = 16 * dt + lr, ch = (koff >> 3) + g;
        vf[dt] = *(const bf16x8*)(Vt + (row >> 1) * 256 + (((((row & 1) << 3) | ch) ^ ((row >> 1) & 7)) << 4));
      }
      f32x4 s[2];
#pragma unroll
      for (int kt = 0; kt < 2; ++kt) {
        s[kt] = (f32x4){0.f, 0.f, 0.f, 0.f};
#pragma unroll
        for (int ks = 0; ks < 2; ++ks) s[kt] = mfma16(kf[kt][ks], qf[ks], s[kt]);
      }
      float mt = NEG_BIG;
#pragma unroll
      for (int kt = 0; kt < 2; ++kt)
#pragma unroll
        for (int r = 0; r < 4; ++r) {
          float sv;
          if (st < 8) {
            const int kc = cs + 8 * g + 4 * kt + r;
            const bool valid = (kc >= cstart) && (kc < cstart + 16);
            int dc = kc - qc + 15; dc = dc < 0 ? 0 : (dc > 30 ? 30 : dc);
            const float bias = rpbh[(rs + st - rq + 7) * 31 + dc];
            sv = valid ? (s[kt][r] * 0.125f + bias) * LOG2E : NEG_BIG;
          } else sv = s[kt][r] * SC_LOG2;
          s[kt][r] = sv; mt = fmaxf(mt, sv);
        }
      mt = rows_max(mt);
      const bool need = mt > mrun + 8.f;
      if (__any(need)) {
        const float mnew = need ? mt : mrun;
        const float alpha = __builtin_amdgcn_exp2f(mrun - mnew);
        lrun *= alpha;
#pragma unroll
        for (int dt = 0; dt < 4; ++dt) { o[dt][0] *= alpha; o[dt][1] *= alpha; o[dt][2] *= alpha; o[dt][3] *= alpha; }
        mrun = mnew;
      }
      float pv[8], ls = 0.f;
#pragma unroll
      for (int kt = 0; kt < 2; ++kt)
#pragma unroll
        for (int r = 0; r < 4; ++r) { pv[kt * 4 + r] = __builtin_amdgcn_exp2f(s[kt][r] - mrun); ls += pv[kt * 4 + r]; }
      lrun += ls;
      u32x4 pk = {pk2(pv[0], pv[1]), pk2(pv[2], pv[3]), pk2(pv[4], pv[5]), pk2(pv[6], pv[7])};
      const bf16x8 pf = __builtin_bit_cast(bf16x8, pk);
#pragma unroll
      for (int dt = 0; dt < 4; ++dt) o[dt] = mfma16(vf[dt], pf, o[dt]);
    }
    asm volatile("s_waitcnt vmcnt(8)" ::: "memory");
    __builtin_amdgcn_s_barrier();
  }
  asm volatile("s_waitcnt vmcnt(0)" ::: "memory");
#undef NB_DMA
  const float inv = 1.f / rows_sum(lrun);
#pragma unroll
  for (int dt = 0; dt < 4; ++dt) {
    u32x2 ov = {pk2(o[dt][0] * inv, o[dt][1] * inv), pk2(o[dt][2] * inv, o[dt][3] * inv)};
    *(u32x2*)(Y + (size_t)qtok * 1024 + 256 + head * 64 + dt * 16 + 4 * g) = ov;
  }
}

DI float quad_sum(float v) {
  v += __int_as_float(__builtin_amdgcn_mov_dpp(__float_as_int(v), 0xB1, 0xF, 0xF, true));
  v += __int_as_float(__builtin_amdgcn_mov_dpp(__float_as_int(v), 0x4E, 0xF, 0xF, true));
  return v;
}
DI void gla_task(const Params& p, int l, int task, unsigned char* lds, int var = 0) {
  const int tid = ltid(), lane = tid & 63, w = tid >> 6, vv = lane >> 2, g = lane & 3;
  const int b = task >> 3, h = (task >> 1) & 3, dir = task & 1;
  const bf16_t* PN = (const bf16_t*)(p.ws + OFF_P);
  const bf16_t* VT = (const bf16_t*)(p.ws + OFF_VT);
  float* og = (float*)(p.ws + OFF_H);
  float* Gup = (float*)lds;
  float* Gb = Gup + 512;
  float* As = Gb + 32;
  float* Ks = As + 2048;
  float* Qs = Ks + 2048;
  float* Vs = Qs + 2048;
  __syncthreads();
  for (int e = tid; e < 512; e += 256) { const int r = e >> 5, kd = e & 31; Gup[e] = p.gate_up[((size_t)(l * 2 + dir) * 16 + r) * 128 + h * 32 + kd]; }
  if (tid < 32) Gb[tid] = p.gate_b[(l * 2 + dir) * 128 + h * 32 + tid];
  float S[8];
#pragma unroll
  for (int e = 0; e < 8; ++e) S[e] = 0.f;
  const int si = tid >> 2, part = tid & 3;
  u32x4 rq, rk, rg0, rg1, rv0, rv1;
#define GLA_TOK0(cc) ((cc) < 4 ? TL + b * 256 + (dir == 0 ? (cc) : 3 - (cc)) * 64 : b * 2048 + (dir == 0 ? (cc) - 4 : 35 - (cc)) * 64)
#define GLA_LOAD(cc) do { const int t0_ = GLA_TOK0(cc); const bf16_t* row = PN + (size_t)(t0_ + si) * PN_LD; \
    rq = *(const u32x4*)(row + C_GQ + h * 32 + part * 8); rk = *(const u32x4*)(row + C_GK + h * 32 + part * 8); \
    rg0 = *(const u32x4*)(row + C_GATE + dir * 16); rg1 = *(const u32x4*)(row + C_GATE + dir * 16 + 8); \
    const bf16_t* vp = VT + (size_t)(R_GV + h * 64 + si) * TT + t0_ + part * 16; rv0 = *(const u32x4*)vp; rv1 = *(const u32x4*)(vp + 8); } while (0)
#define GLA_WRITE() do { float gd[16], qf[8], kf[8], vf[16], pre[8]; \
    unpack8(rg0, gd); unpack8(rg1, gd + 8); unpack8(rq, qf); unpack8(rk, kf); unpack8(rv0, vf); unpack8(rv1, vf + 8); \
    { const float4 b0 = *(const float4*)(Gb + part * 8), b1 = *(const float4*)(Gb + part * 8 + 4); \
      pre[0] = b0.x; pre[1] = b0.y; pre[2] = b0.z; pre[3] = b0.w; pre[4] = b1.x; pre[5] = b1.y; pre[6] = b1.z; pre[7] = b1.w; } \
    _Pragma("unroll") for (int r = 0; r < 16; ++r) { const float4 u0 = *(const float4*)(Gup + r * 32 + part * 8), u1 = *(const float4*)(Gup + r * 32 + part * 8 + 4); \
      pre[0] += gd[r] * u0.x; pre[1] += gd[r] * u0.y; pre[2] += gd[r] * u0.z; pre[3] += gd[r] * u0.w; \
      pre[4] += gd[r] * u1.x; pre[5] += gd[r] * u1.y; pre[6] += gd[r] * u1.z; pre[7] += gd[r] * u1.w; } \
    float av[8]; \
    _Pragma("unroll") for (int e = 0; e < 8; ++e) { const float ls = fminf(pre[e], 0.f) - __logf(1.f + __expf(-fabsf(pre[e]))); av[e] = __expf(ls * (1.f / 16.f)); } \
    *(float4*)(As + si * 32 + part * 8) = (float4){av[0], av[1], av[2], av[3]}; *(float4*)(As + si * 32 + part * 8 + 4) = (float4){av[4], av[5], av[6], av[7]}; \
    *(float4*)(Ks + si * 32 + part * 8) = (float4){kf[0], kf[1], kf[2], kf[3]}; *(float4*)(Ks + si * 32 + part * 8 + 4) = (float4){kf[4], kf[5], kf[6], kf[7]}; \
    { const float qs_ = 0.17677669529663687f; \
      *(float4*)(Qs + si * 32 + part * 8) = (float4){qf[0] * qs_, qf[1] * qs_, qf[2] * qs_, qf[3] * qs_}; *(float4*)(Qs + si * 32 + part * 8 + 4) = (float4){qf[4] * qs_, qf[5] * qs_, qf[6] * qs_, qf[7] * qs_}; } \
      \
    _Pragma("unroll") for (int e = 0; e < 4; ++e) *(float4*)(Vs + si * 68 + part * 16 + 4 * e) = (float4){vf[4 * e], vf[4 * e + 1], vf[4 * e + 2], vf[4 * e + 3]}; } while (0)
  GLA_LOAD(0);
  __syncthreads();
  GLA_WRITE();
  __syncthreads();
  for (int cc = 0; cc < 36; ++cc) {
    const int tok0 = GLA_TOK0(cc);
    if (cc + 1 < 36) GLA_LOAD(cc + 1);
    float* ob = og + ((size_t)dir * TT + tok0) * 256 + h * 64 + 16 * w + vv;
#pragma unroll 1
    for (int s0 = 0; s0 < 64; s0 += 4) {
      float4 a0[4], a1[4], k0[4], k1[4], q0[4], q1[4];
      float vx[4];
      const int ib = dir == 0 ? s0 : 63 - s0, di = dir == 0 ? 1 : -1;
#pragma unroll
      for (int u = 0; u < 4; ++u) {
        const int i = ib + di * u;
        a0[u] = *(const float4*)(As + i * 32 + 8 * g); a1[u] = *(const float4*)(As + i * 32 + 8 * g + 4);
        k0[u] = *(const float4*)(Ks + i * 32 + 8 * g); k1[u] = *(const float4*)(Ks + i * 32 + 8 * g + 4);
        q0[u] = *(const float4*)(Qs + i * 32 + 8 * g); q1[u] = *(const float4*)(Qs + i * 32 + 8 * g + 4);
        vx[u] = Vs[(16 * w + vv) * 68 + i];
      }
      float* op = ob + (ptrdiff_t)ib * 256;
#pragma unroll
      for (int u = 0; u < 4; ++u) {
        const float v = vx[u];
        S[0] = fmaf(a0[u].x, S[0], k0[u].x * v); S[1] = fmaf(a0[u].y, S[1], k0[u].y * v);
        S[2] = fmaf(a0[u].z, S[2], k0[u].z * v); S[3] = fmaf(a0[u].w, S[3], k0[u].w * v);
        S[4] = fmaf(a1[u].x, S[4], k1[u].x * v); S[5] = fmaf(a1[u].y, S[5], k1[u].y * v);
        S[6] = fmaf(a1[u].z, S[6], k1[u].z * v); S[7] = fmaf(a1[u].w, S[7], k1[u].w * v);
        const float oa = fmaf(q0[u].x, S[0], q0[u].y * S[1]), ob2 = fmaf(q0[u].z, S[2], q0[u].w * S[3]);
        const float oc = fmaf(q1[u].x, S[4], q1[u].y * S[5]), od = fmaf(q1[u].z, S[6], q1[u].w * S[7]);
        float o = (oa + ob2) + (oc + od);
        o = quad_sum(o);
        op[(ptrdiff_t)(di * u) * 256] = o;
      }
    }
    __syncthreads();
    if (cc + 1 < 36) GLA_WRITE();
    __syncthreads();
  }
#undef GLA_TOK0
#undef GLA_LOAD
#undef GLA_WRITE
}

DI void phase_mixers(const Params& p, int l, bool last, unsigned* ctr, unsigned char* lds, int mask = 15, int gvar = 0) {
  const int tid = ltid(), w = tid >> 6;
  volatile int* slot = (volatile int*)(lds + LDS_BYTES - 16);
  float* rpb_lds = (float*)(lds + 65536);
  for (int e = tid; e < 4 * 465; e += 256) rpb_lds[e] = p.rpb[(size_t)l * 4 * 465 + e];
  const int nconv = (l == 0 && (mask & 8)) ? 1024 : 0;
  const int t1 = 128 + nconv, t2 = t1 + 1024, t3 = t2 + 2048, t4 = t3 + 128;
  const int ntask = last ? t3 : t4 + 256;
  for (;;) {
    __syncthreads();
    if (tid == 0) *slot = (int)atomicAdd(ctr, 1u);
    __syncthreads();
    const int task = *slot;
    if (task >= ntask) break;
    if (task < 128) { if (mask & 1) { __builtin_amdgcn_s_setprio(3); gla_task(p, l, task, lds, gvar); __builtin_amdgcn_s_setprio(0); } }
    else if (nconv && task < t2 && ((task - 128) & 1)) { const int c = (task - 128) >> 1; convert_table_pairs(p, c * 64, c * 64 + 64, w, 4, tid & 63); }
    else if (!(mask & 2) && (task < t2 || (task >= t3 && task < t4))) {}
    else if (!(mask & 4) && ((task >= t2 && task < t3) || task >= t4)) {}
    else if (task < t2) { const int d = nconv ? (task - 128) >> 1 : task - 128; const int b = d >> 6; diff_block_task(p, l, b, (d >> 4) & 3, b * 2048 + (d & 15) * 128, 72, lds, gvar); }
    else if (task < t3) { const int d = task - t2; nat_block_task(p, l, d >> 7, (d >> 5) & 3, d & 31, rpb_lds, lds); }
    else if (task < t4) { const int d = task - t3; const int b = d >> 3; diff_block_task(p, l, b, (d >> 1) & 3, TL + b * 256 + (d & 1) * 128, 8, lds); }
    else { const int wt = (task - t4) * 4 + w; natctx_wave_task(p, wt >> 6, (wt >> 4) & 3, wt & 15); }
  }
}

DI void phase_gla_fin(const Params& p, int l, int ntok) {
  const int lane = ltid() & 63, gw = lbid() * 4 + (ltid() >> 6), nw = lgdim() * 4;
  const float* og = (const float*)(p.ws + OFF_H);
  const bf16_t* PN = (const bf16_t*)(p.ws + OFF_P);
  bf16_t* Y = (bf16_t*)(p.ws + OFF_Y);
  const float4 gg = *(const float4*)(p.gla_norm_g + l * 256 + 4 * lane);
  for (int t = gw; t < ntok; t += nw) {
    const float4 a = *(const float4*)(og + (size_t)t * 256 + 4 * lane), bq = *(const float4*)(og + ((size_t)TT + t) * 256 + 4 * lane);
    const float o0 = a.x + bq.x, o1 = a.y + bq.y, o2 = a.z + bq.z, o3 = a.w + bq.w;
    float ss = o0 * o0 + o1 * o1 + o2 * o2 + o3 * o3;
    ss += __shfl_xor(ss, 1); ss += __shfl_xor(ss, 2); ss += __shfl_xor(ss, 4); ss += __shfl_xor(ss, 8);
    const float rstd = rsqrtf(ss * (1.f / 64.f) + 1e-6f);
    const u32x2 rv = *(const u32x2*)(PN + (size_t)t * PN_LD + C_GR + 4 * lane);
    const float r0 = bflo(rv.x), r1 = bfhi(rv.x), r2 = bflo(rv.y), r3 = bfhi(rv.y);
    const float y0 = o0 * rstd * gg.x * (r0 / (1.f + __expf(-r0)));
    const float y1 = o1 * rstd * gg.y * (r1 / (1.f + __expf(-r1)));
    const float y2 = o2 * rstd * gg.z * (r2 / (1.f + __expf(-r2)));
    const float y3 = o3 * rstd * gg.w * (r3 / (1.f + __expf(-r3)));
    u32x2 ov = {pk2(y0, y1), pk2(y2, y3)};
    *(u32x2*)(Y + (size_t)t * 1024 + 4 * lane) = ov;
  }
}


DI void ce_desc(float& a, float& b) {
  float hi, lo;
  asm("v_max_f32 %0, %2, %3\n\tv_min_f32 %1, %2, %3" : "=&v"(hi), "=&v"(lo) : "v"(a), "v"(b));
  a = hi; b = lo;
}
DI float vmaxf(float a, float b) { float r; asm("v_max_f32 %0, %1, %2" : "=v"(r) : "v"(a), "v"(b)); return r; }
template <int N>
DI void bitonic_sort_desc(float (&x)[N]) {
#pragma unroll
  for (int k = 2; k <= N; k <<= 1)
#pragma unroll
    for (int j = k >> 1; j > 0; j >>= 1)
#pragma unroll
      for (int i = 0; i < N; ++i) {
        const int l = i ^ j;
        if (l > i) { if ((i & k) == 0) ce_desc(x[i], x[l]); else ce_desc(x[l], x[i]); }
      }
}
template <int N>
DI void bitonic_merge_desc(float (&x)[N]) {
#pragma unroll
  for (int j = N >> 1; j > 0; j >>= 1)
#pragma unroll
    for (int i = 0; i < N; ++i) { const int l = i ^ j; if (l > i) ce_desc(x[i], x[l]); }
}
DI void rows_merge_top16(float (&L)[16]) {
  {
    float A0[16], A1[16];
#pragma unroll
    for (int i = 0; i < 16; ++i) { const u32x2 s = __builtin_amdgcn_permlane32_swap(__float_as_uint(L[i]), __float_as_uint(L[i]), false, false); A0[i] = __uint_as_float(s[0]); A1[i] = __uint_as_float(s[1]); }
#pragma unroll
    for (int i = 0; i < 16; ++i) L[i] = vmaxf(A0[i], A1[15 - i]);
    bitonic_merge_desc<16>(L);
  }
  {
    float A0[16], A1[16];
#pragma unroll
    for (int i = 0; i < 16; ++i) { const u32x2 s = __builtin_amdgcn_permlane16_swap(__float_as_uint(L[i]), __float_as_uint(L[i]), false, false); A0[i] = __uint_as_float(s[0]); A1[i] = __uint_as_float(s[1]); }
#pragma unroll
    for (int i = 0; i < 16; ++i) L[i] = vmaxf(A0[i], A1[15 - i]);
    bitonic_merge_desc<16>(L);
  }
}

struct PairTab { int a[52], b[52]; };
constexpr PairTab make_pairs() {
  PairTab t{};
  int n = 0;
  for (int a = 0; a < 16; ++a)
    for (int b = 0; b < 16; ++b)
      if ((a + 1) * (b + 1) <= 16) { t.a[n] = a; t.b[n] = b; ++n; }
  for (; n < 52; ++n) { t.a[n] = -1; t.b[n] = -1; }
  return t;
}

DI void topk_half(const bf16_t* skh  , const bf16_t* qrow  , int lr, int g, float (&list)[16]) {
  bf16x8 qf[2];
  qf[0] = *(const bf16x8*)(qrow); qf[1] = *(const bf16x8*)(qrow + 32);
  float s[32];
#pragma unroll
  for (int nt = 0; nt < 8; ++nt) {
    f32x4 acc = {0.f, 0.f, 0.f, 0.f};
#pragma unroll
    for (int ks = 0; ks < 2; ++ks) {
      const bf16x8 af = *(const bf16x8*)(skh + (size_t)(nt * 16 + lr) * 64 + ks * 32 + 8 * g);
      acc = mfma16(af, qf[ks], acc);
    }
#pragma unroll
    for (int r = 0; r < 4; ++r) {
      const unsigned n = nt * 16 + 4 * g + r;
      s[nt * 4 + r] = __uint_as_float((__float_as_uint(acc[r]) & ~127u) | n);
    }
  }
  float a[16], bq[16];
#pragma unroll
  for (int i = 0; i < 16; ++i) { a[i] = s[i]; bq[i] = s[16 + i]; }
  bitonic_sort_desc<16>(a);
  bitonic_sort_desc<16>(bq);
#pragma unroll
  for (int i = 0; i < 16; ++i) list[i] = vmaxf(a[i], bq[15 - i]);
  bitonic_merge_desc<16>(list);
  rows_merge_top16(list);
}

DI void topk_tile(const bf16_t* QP, const bf16_t* sk, int tt, int hd, int* eid_rows, float* gate_rows, int lr, int g) {
  constexpr PairTab PT = make_pairs();
  {
    const int tok = tt * 16 + lr;
    float v1[16], v2[16];
    topk_half(sk, QP + (size_t)tok * 1024 + hd * 128 + 8 * g, lr, g, v1);
    __builtin_amdgcn_sched_barrier(0);
    topk_half(sk + 128 * 64, QP + (size_t)tok * 1024 + hd * 128 + 64 + 8 * g, lr, g, v2);
    __builtin_amdgcn_sched_barrier(0);
    float cand[13];
#pragma unroll
    for (int c = 0; c < 13; ++c) {
      float sv[4];
#pragma unroll
      for (int gi = 0; gi < 4; ++gi) {
        const int pi = 4 * c + gi;
        if (PT.a[pi] >= 0) {
          const float a = v1[PT.a[pi] < 0 ? 0 : PT.a[pi]], bq = v2[PT.b[pi] < 0 ? 0 : PT.b[pi]];
          sv[gi] = __uint_as_float((__float_as_uint(a + bq) & ~255u) | (unsigned)(PT.a[pi] * 16 + PT.b[pi]));
        } else { sv[gi] = -3.0e38f; }
      }
      cand[c] = g == 0 ? sv[0] : (g == 1 ? sv[1] : (g == 2 ? sv[2] : sv[3]));
    }
    float topv[16];
#pragma unroll
    for (int c = 0; c < 13; ++c) topv[c] = cand[c];
    topv[13] = -3.0e38f; topv[14] = -3.1e38f; topv[15] = -3.2e38f;
    bitonic_sort_desc<16>(topv);
    rows_merge_top16(topv);
#pragma unroll
    for (int q = 0; q < 4; ++q) {
      const float wv = g == 0 ? topv[q] : (g == 1 ? topv[4 + q] : (g == 2 ? topv[8 + q] : topv[12 + q]));
      const int ia = (int)((__float_as_uint(wv) >> 4) & 15u), ib = (int)(__float_as_uint(wv) & 15u);
      unsigned e1 = 0, e2 = 0;
#pragma unroll
      for (int c = 0; c < 16; ++c) { if (ia == c) e1 = __float_as_uint(v1[c]) & 127u; if (ib == c) e2 = __float_as_uint(v2[c]) & 127u; }
      eid_rows[lr * 128 + hd * 16 + 4 * g + q] = (int)(e1 * 128u + e2);
    }
    if (g == 0) {
      float ex[16], sum = 0.f;
#pragma unroll
      for (int k = 0; k < 16; ++k) { ex[k] = __expf(topv[k] - topv[0]); sum += ex[k]; }
      const float inv = 1.f / sum;
#pragma unroll
      for (int q = 0; q < 4; ++q) {
        float4 o = {ex[4 * q] * inv, ex[4 * q + 1] * inv, ex[4 * q + 2] * inv, ex[4 * q + 3] * inv};
        *(float4*)(gate_rows + lr * 128 + hd * 16 + 4 * q) = o;
      }
    }
  }
}

DI float gelu_tanh(float x) {
  const float z = 0.7978845608028654f * (x + 0.044715f * x * x * x);
  const float e = __expf(2.f * z);
  const float th = 1.f - 2.f / (e + 1.f);
  return 0.5f * x * (1.f + th);
}
DI void gather_token(const Params& p, int l, int t, const int* eid_row, const float* gate_row, unsigned char* hl, float* wl, bool dry) {
  const int lane = ltid() & 63, lr = lane & 15, g = lane >> 4;
  const unsigned char* U6 = p.ws + OFF_U + (size_t)l * 16384 * U_PITCH;
  const unsigned char* V6 = p.ws + OFF_V + (size_t)l * 16384 * V_PITCH;
  const int half = lane >> 5, blk = lane & 31;
  const unsigned char* H6 = p.ws + OFF_H8;
  bf16_t* xres = (bf16_t*)(p.ws + OFF_XRES);
  const float* modbuf = (const float*)(p.ws + OFF_MOD);
  {
    if (lane < 50) {
      const u32x4 hq = *(const u32x4*)(H6 + (size_t)t * V6_PITCH + lane * 16);
      *(u32x4*)(hl + lane * 16) = hq;
    }
    const int e0 = eid_row[lane], e1 = eid_row[64 + lane];
    const float gv0 = gate_row[lane], gv1 = gate_row[64 + lane];
    {
      const u32x2 hsc = *(const u32x2*)(hl + 768 + 8 * g);
#pragma unroll 1
      for (int grp = 0; grp < 8; ++grp) {
        const int er = __shfl(grp < 4 ? e0 : e1, (grp & 3) * 16 + lr);
        const unsigned char* ur = U6 + (size_t)er * U_PITCH;
        u32x4 ua[8]; u32x2 ub[8];
#pragma unroll
        for (int s = 0; s < 8; ++s) {
          if (U_FP4) { ua[s] = *(const u32x4*)(ur + 16 * (4 * s + g)); ub[s] = (u32x2){0u, 0u}; }
          else { ua[s] = *(const u32x4*)(ur + 24 * (4 * s + g)); ub[s] = *(const u32x2*)(ur + 24 * (4 * s + g) + 16); }
        }
        const u32x2 usc = *(const u32x2*)(ur + (U_FP4 ? 512 : 768) + 8 * g);
        __builtin_amdgcn_sched_barrier(0);
        f32x4 acc = {0.f, 0.f, 0.f, 0.f};
#define G_STEP(s, OS, USC, HSC) do { const unsigned char* hb = hl + 24 * (4 * (s) + g); \
          const u32x2 h0 = *(const u32x2*)hb, h1 = *(const u32x2*)(hb + 8), h2v = *(const u32x2*)(hb + 16); \
          const i32x8 av = {(int)ua[s][0], (int)ua[s][1], (int)ua[s][2], (int)ua[s][3], (int)ub[s][0], (int)ub[s][1], 0, 0}; \
          const i32x8 bv = {(int)h0[0], (int)h0[1], (int)h1[0], (int)h1[1], (int)h2v[0], (int)h2v[1], 0, 0}; \
          acc = __builtin_amdgcn_mfma_scale_f32_16x16x128_f8f6f4(av, bv, acc, U_FP4 ? 4 : 2, 2, OS, (int)(USC), OS, (int)(HSC)); } while (0)
        G_STEP(0, 0, usc[0], hsc[0]); G_STEP(1, 1, usc[0], hsc[0]); G_STEP(2, 2, usc[0], hsc[0]); G_STEP(3, 3, usc[0], hsc[0]);
        G_STEP(4, 0, usc[1], hsc[1]); G_STEP(5, 1, usc[1], hsc[1]); G_STEP(6, 2, usc[1], hsc[1]); G_STEP(7, 3, usc[1], hsc[1]);
#undef G_STEP
        const float gvs = grp < 4 ? gv0 : gv1;
        const int lb_ = (grp & 3) * 16 + 4 * g;
        float4 wv_;
        wv_.x = __shfl(gvs, lb_) * gelu_tanh(acc[0]); wv_.y = __shfl(gvs, lb_ + 1) * gelu_tanh(acc[1]);
        wv_.z = __shfl(gvs, lb_ + 2) * gelu_tanh(acc[2]); wv_.w = __shfl(gvs, lb_ + 3) * gelu_tanh(acc[3]);
        if (lr == 0) *(float4*)(wl + grp * 16 + 4 * g) = wv_;
        __builtin_amdgcn_sched_barrier(0);
      }
    }
    __builtin_amdgcn_sched_barrier(0);
    float out[32];
#pragma unroll
    for (int i = 0; i < 32; ++i) out[i] = 0.f;
#pragma unroll 1
    for (int grp = 0; grp < 8; ++grp) {
      const int esel = grp < 4 ? e0 : e1;
      const int lb = (grp & 3) * 16;
      u32x4 vd4[8]; u32x2 vd2[8]; unsigned vsc[8];
#pragma unroll
      for (int pp = 0; pp < 8; ++pp) {
        const int ea = __builtin_amdgcn_readlane(esel, lb + 2 * pp), eb = __builtin_amdgcn_readlane(esel, lb + 2 * pp + 1);
        const unsigned char* vr = V6 + (size_t)(half ? eb : ea) * V_PITCH;
        if (V_FP4) { vd4[pp] = *(const u32x4*)(vr + 16 * blk); vd2[pp] = (u32x2){0u, 0u}; vsc[pp] = vr[mx4_scale_pos(blk)]; }
        else { vd4[pp] = *(const u32x4*)(vr + 24 * blk); vd2[pp] = *(const u32x2*)(vr + 24 * blk + 16); vsc[pp] = vr[mx_scale_pos(blk)]; }
      }
      __builtin_amdgcn_sched_barrier(0);
#pragma unroll
      for (int pp = 0; pp < 8; ++pp) {
        const float wgt = wl[grp * 16 + 2 * pp + half] * __uint_as_float(vsc[pp] << 23);
        if (V_FP4) {
          unsigned q0 = vd4[pp][0], q1 = vd4[pp][1], q2 = vd4[pp][2], q3 = vd4[pp][3];
          asm volatile("" : "+v"(q0), "+v"(q1) : "v"(out[0]), "v"(out[1]), "v"(out[2]), "v"(out[3]), "v"(out[4]), "v"(out[5]), "v"(out[6]), "v"(out[7]),
                       "v"(out[8]), "v"(out[9]), "v"(out[10]), "v"(out[11]), "v"(out[12]), "v"(out[13]), "v"(out[14]), "v"(out[15]));
          asm volatile("" : "+v"(q2), "+v"(q3) : "v"(out[16]), "v"(out[17]), "v"(out[18]), "v"(out[19]), "v"(out[20]), "v"(out[21]), "v"(out[22]), "v"(out[23]),
                       "v"(out[24]), "v"(out[25]), "v"(out[26]), "v"(out[27]), "v"(out[28]), "v"(out[29]), "v"(out[30]), "v"(out[31]));
          const u32x4 qd = {q0, q1, q2, q3};
#pragma unroll
          for (int d = 0; d < 4; ++d) {
            const f32x2 t0 = __builtin_amdgcn_cvt_scalef32_pk_f32_fp4(qd[d], 1.0f, 0), t1 = __builtin_amdgcn_cvt_scalef32_pk_f32_fp4(qd[d], 1.0f, 1);
            const f32x2 t2 = __builtin_amdgcn_cvt_scalef32_pk_f32_fp4(qd[d], 1.0f, 2), t3 = __builtin_amdgcn_cvt_scalef32_pk_f32_fp4(qd[d], 1.0f, 3);
            out[8 * d + 0] += wgt * t0[0]; out[8 * d + 1] += wgt * t0[1]; out[8 * d + 2] += wgt * t1[0]; out[8 * d + 3] += wgt * t1[1];
            out[8 * d + 4] += wgt * t2[0]; out[8 * d + 5] += wgt * t2[1]; out[8 * d + 6] += wgt * t3[0]; out[8 * d + 7] += wgt * t3[1];
          }
        } else {
          unsigned pk0 = vd4[pp][0], pk1 = vd4[pp][1];
          asm volatile("" : "+v"(pk0) : "v"(out[0]), "v"(out[1]), "v"(out[2]), "v"(out[3]), "v"(out[4]), "v"(out[5]), "v"(out[6]), "v"(out[7]),
                       "v"(out[8]), "v"(out[9]), "v"(out[10]), "v"(out[11]), "v"(out[12]), "v"(out[13]), "v"(out[14]), "v"(out[15]));
          asm volatile("" : "+v"(pk1) : "v"(out[16]), "v"(out[17]), "v"(out[18]), "v"(out[19]), "v"(out[20]), "v"(out[21]), "v"(out[22]), "v"(out[23]),
                       "v"(out[24]), "v"(out[25]), "v"(out[26]), "v"(out[27]), "v"(out[28]), "v"(out[29]), "v"(out[30]), "v"(out[31]));
          const u32x6 pk = {pk0, pk1, vd4[pp][2], vd4[pp][3], vd2[pp][0], vd2[pp][1]};
          const f32x32 vals = __builtin_amdgcn_cvt_scalef32_pk32_f32_fp6(pk, 1.0f);
  #pragma unroll
          for (int i = 0; i < 32; ++i) out[i] += wgt * vals[i];
        }
        __builtin_amdgcn_sched_barrier(0);
      }
    }
    float o16[16];
#pragma unroll
    for (int i = 0; i < 16; ++i) {
      const u32x2 s0 = __builtin_amdgcn_permlane32_swap(__float_as_uint(out[i]), __float_as_uint(out[i]), false, false);
      const u32x2 s1 = __builtin_amdgcn_permlane32_swap(__float_as_uint(out[16 + i]), __float_as_uint(out[16 + i]), false, false);
      const float t0 = __uint_as_float(s0[0]) + __uint_as_float(s0[1]), t1 = __uint_as_float(s1[0]) + __uint_as_float(s1[1]);
      o16[i] = half ? t1 : t0;
    }
    const int cb = 32 * blk + 16 * half;
    const int b = t < TL ? (t >> 11) : 16;
    const float* md = modbuf + ((size_t)l * 17 + b) * 6144 + 5 * 1024 + cb;
    bf16_t* xr = xres + (size_t)t * 1024 + cb;
    float xn[16];
    float ss = 0.f;
    {
      const u32x4 r0 = *(const u32x4*)xr, r1 = *(const u32x4*)(xr + 8);
      unpack8(r0, xn); unpack8(r1, xn + 8);
    }
    unsigned xp[8];
#pragma unroll
    for (int q = 0; q < 4; ++q) {
      const float4 m4 = *(const float4*)(md + 4 * q);
      xn[4 * q] += m4.x * o16[4 * q + 0]; xn[4 * q + 1] += m4.y * o16[4 * q + 1]; xn[4 * q + 2] += m4.z * o16[4 * q + 2]; xn[4 * q + 3] += m4.w * o16[4 * q + 3];
      ss += xn[4 * q] * xn[4 * q] + xn[4 * q + 1] * xn[4 * q + 1] + xn[4 * q + 2] * xn[4 * q + 2] + xn[4 * q + 3] * xn[4 * q + 3];
      xp[2 * q] = pk2(xn[4 * q], xn[4 * q + 1]); xp[2 * q + 1] = pk2(xn[4 * q + 2], xn[4 * q + 3]);
    }
    if (dry) asm volatile("" :: "v"(xp[0]), "v"(xp[7]));
    else if (l < NL - 1) { *(u32x4*)xr = (u32x4){xp[0], xp[1], xp[2], xp[3]}; *(u32x4*)(xr + 8) = (u32x4){xp[4], xp[5], xp[6], xp[7]}; }
    if (!dry) {
      ss = wave_sum(ss);
      const float rstd = rsqrtf(ss * (1.f / 1024.f) + 1e-6f);
      if (l == NL - 1) {
        const float* fg = p.final_g + cb;
        float* orow = p.out + (size_t)t * 1024 + cb;
#pragma unroll
        for (int q = 0; q < 4; ++q) {
          const float4 g4 = *(const float4*)(fg + 4 * q);
          float4 o = {xn[4 * q] * rstd * g4.x, xn[4 * q + 1] * rstd * g4.y, xn[4 * q + 2] * rstd * g4.z, xn[4 * q + 3] * rstd * g4.w};
          *(float4*)(orow + 4 * q) = o;
        }
      } else {
        const float* gvec = p.norm1_g + (l + 1) * 1024 + cb;
        const float* mdn = modbuf + ((size_t)(l + 1) * 17 + b) * 6144 + cb;
        bf16_t* hrow = (bf16_t*)(p.ws + OFF_H) + (size_t)t * 1024 + cb;
        unsigned pk[8];
#pragma unroll
        for (int q = 0; q < 4; ++q) {
          const float4 g4 = *(const float4*)(gvec + 4 * q), sh = *(const float4*)(mdn + 4 * q), sc = *(const float4*)(mdn + 1024 + 4 * q);
          const float o0 = xn[4 * q] * rstd * g4.x * (1.f + sc.x) + sh.x, o1 = xn[4 * q + 1] * rstd * g4.y * (1.f + sc.y) + sh.y;
          const float o2 = xn[4 * q + 2] * rstd * g4.z * (1.f + sc.z) + sh.z, o3 = xn[4 * q + 3] * rstd * g4.w * (1.f + sc.w) + sh.w;
          pk[2 * q] = pk2(o0, o1); pk[2 * q + 1] = pk2(o2, o3);
        }
        *(u32x4*)hrow = (u32x4){pk[0], pk[1], pk[2], pk[3]};
        *(u32x4*)(hrow + 8) = (u32x4){pk[4], pk[5], pk[6], pk[7]};
      }
    }
  }
}


DI void phase_topk_gather(const Params& p, int l, int ntok, unsigned* ctr, unsigned char* lds, bool dry = false) {
  const int tid = ltid(), lane = tid & 63, w = tid >> 6, lr = lane & 15, g = lane >> 4;
  const bf16_t* QP = (const bf16_t*)(p.ws + OFF_QP);
  const bf16_t* sk = (const bf16_t*)(p.ws + OFF_SK) + (size_t)l * 2 * 128 * 64;
  int* eid_l = (int*)lds;
  float* gate_l = (float*)(lds + 8192);
  unsigned char* hl = lds + 16384 + w * 2048;
  float* wl = (float*)(hl + 1024);
  volatile int* slot = (volatile int*)(lds + LDS_BYTES - 16);
  const int ntile = ntok / 16;
  for (;;) {
    __syncthreads();
    if (tid == 0) *slot = (int)atomicAdd(ctr, 1u);
    __syncthreads();
    const int tile = *slot;
    if (tile >= ntile) break;
#pragma unroll 1
    for (int hh = 0; hh < 2; ++hh) {
      topk_tile(QP, sk, tile, 2 * w + hh, eid_l, gate_l, lr, g);
      __builtin_amdgcn_sched_barrier(0);
    }
    __syncthreads();
#pragma unroll 1
    for (int q = 0; q < 4; ++q) {
      const int r = 4 * w + q;
      gather_token(p, l, tile * 16 + r, eid_l + r * 128, gate_l + r * 128, hl, wl, dry);
    }
  }
}

DI void phase_final(const Params& p) {
  const int lane = ltid() & 63, gw = lbid() * 4 + (ltid() >> 6), nw = lgdim() * 4;
  const float* xres = (const float*)(p.ws + OFF_XRES);
  for (int t = gw; t < TL; t += nw) {
    const float* src = xres + (size_t)t * 1024;
    float4 v[4];
    float ss = 0.f;
#pragma unroll
    for (int i = 0; i < 4; ++i) {
      v[i] = *(const float4*)(src + 4 * lane + 256 * i);
      ss += v[i].x * v[i].x + v[i].y * v[i].y + v[i].z * v[i].z + v[i].w * v[i].w;
    }
    ss = wave_sum(ss);
    const float rstd = rsqrtf(ss * (1.f / 1024.f) + 1e-6f);
#pragma unroll
    for (int i = 0; i < 4; ++i) {
      const int col = 4 * lane + 256 * i;
      const float4 g4 = *(const float4*)(p.final_g + col);
      float4 o = {v[i].x * rstd * g4.x, v[i].y * rstd * g4.y, v[i].z * rstd * g4.z, v[i].w * rstd * g4.w};
      *(float4*)(p.out + (size_t)t * 1024 + col) = o;
    }
  }
}


#define LAS __attribute__((address_space(3)))
#define XB_TMO      128
#define XB_XCNT(j)  (256  + 64 * (j))
#define XB_XSUB(j)  (1280 + 64 * (j))
#define XB_XGEN(j)  (2304 + 64 * (j))
#define XB_TOP      3328
#define XB_TOPGEN   3392
#define XCD_BAR_WORDS 3456
#define XB_SPIN_CAP (1u << 22)
DI unsigned xb_ld(unsigned* p) { return __hip_atomic_load(p, __ATOMIC_RELAXED, __HIP_MEMORY_SCOPE_AGENT); }
DI unsigned xb_add(unsigned* p, unsigned v) { return __hip_atomic_fetch_add(p, v, __ATOMIC_RELAXED, __HIP_MEMORY_SCOPE_AGENT); }
DI unsigned xb_xcc_id() { return (unsigned)__builtin_amdgcn_s_getreg((3 << 11) | 20) & 0xFu; }
#define XB_SPIN(cond, bar) do { unsigned _sp = 0; while (cond) { __builtin_amdgcn_s_sleep(1); \
    if ((++_sp & 255u) == 0u) { if (xb_ld(&(bar)[XB_TMO])) break; if (_sp > XB_SPIN_CAP) { atomicAdd(&(bar)[XB_TMO], 1u); break; } } } } while (0)
struct XcdBarrier { unsigned* bar; unsigned x; volatile unsigned* st; };
DI XcdBarrier xcd_barrier_post(unsigned* bar, volatile unsigned* st) {
  XcdBarrier b; b.bar = bar; b.x = xb_xcc_id(); b.st = st;
  if (threadIdx.x == 0) (void)xb_add(&bar[XB_XCNT(b.x)], 1u);
  return b;
}
DI void xcd_barrier_complete(unsigned* bar, unsigned x, unsigned& nloc, unsigned& nx) {
  const unsigned G = gridDim.x * gridDim.y * gridDim.z;
  unsigned sum, cnt, mine, sp = 0u;
  for (;;) {
    sum = 0u; cnt = 0u; mine = 0u;
#pragma unroll 1
    for (unsigned j = 0; j < 16; ++j) { const unsigned c = xb_ld(&bar[XB_XCNT(j)]); sum += c; cnt += (c > 0u) ? 1u : 0u; mine = (j == x) ? c : mine; }
    if (sum == G) break;
    __builtin_amdgcn_s_sleep(1);
    if ((++sp & 255u) == 0u) { if (xb_ld(&bar[XB_TMO])) break; if (sp > XB_SPIN_CAP) { atomicAdd(&bar[XB_TMO], 1u); break; } }
  }
  nloc = mine > 0u ? mine : 1u; nx = cnt > 0u ? cnt : 1u;
}
DI void xcd_barrier(const XcdBarrier& b) {
  asm volatile("s_waitcnt vmcnt(0)" ::: "memory");
  __syncthreads();
  if (threadIdx.x == 0) {
    unsigned* bar = b.bar;
    __builtin_amdgcn_s_waitcnt(0);
    unsigned nloc = b.st[0], nx = b.st[1];
    if (nloc == 0u) { xcd_barrier_complete(bar, b.x, nloc, nx); b.st[0] = nloc; b.st[1] = nx; }
    const unsigned old = xb_add(&bar[XB_XSUB(b.x)], 1u);
    const unsigned gen = old / nloc;
    if (old + 1u == (gen + 1u) * nloc) {
      __builtin_amdgcn_fence(__ATOMIC_RELEASE, "agent");
      asm volatile("s_waitcnt vmcnt(0)" ::: "memory");
      const unsigned og = xb_add(&bar[XB_TOP], 1u);
      const unsigned tg = og / nx;
      if (og + 1u == (tg + 1u) * nx) xb_add(&bar[XB_TOPGEN], 1u);
      else XB_SPIN(xb_ld(&bar[XB_TOPGEN]) == tg, bar);
      __builtin_amdgcn_fence(__ATOMIC_ACQUIRE, "agent");
      xb_add(&bar[XB_XGEN(b.x)], 1u);
      asm volatile("s_waitcnt vmcnt(0)" ::: "memory");
    } else {
      XB_SPIN(xb_ld(&bar[XB_XGEN(b.x)]) == gen, bar);
      __builtin_amdgcn_fence(__ATOMIC_ACQUIRE, "agent");
      asm volatile("s_waitcnt vmcnt(0)" ::: "memory");
    }
  }
  __syncthreads();
}

constexpr int PH_PER_LAYER = 10;
constexpr int N_PHASES = 1 + NL * PH_PER_LAYER + 1;

template <int KIND>
DI void run_phase(const Params& p, int ph, unsigned char* lds) {
  unsigned* ctl = (unsigned*)(p.ws + OFF_CTL);
  if (ph == 0) { if (KIND < 0 || KIND == 0) phase_prologue(p, lds); }
  else if (ph == N_PHASES - 1) { if (KIND < 0 || KIND == 11) phase_final(p); }
  else {
    const int l = (ph - 1) / PH_PER_LAYER, s = (ph - 1) % PH_PER_LAYER;
    const bool last = (l == NL - 1);
    const int ntok = last ? TL : TT;
    if (s == 0) { if (KIND < 0 || KIND == 1) phase_norm(p, l, 0, TT); }
    else if (s == 1) { if (KIND < 0 || KIND == 2) phase_gemm_in(p, l, lds); }
    else if (s == 2) { if (KIND < 0 || KIND == 3) phase_rope(p, lds); }
    else if (s == 3) { if (KIND < 0 || KIND == 4) phase_mixers(p, l, last, ctl + 64 * (1 + l), lds); }
    else if (s == 4) { if (KIND < 0 || KIND == 5) phase_gla_fin(p, l, ntok); }
    else if (s == 5) { if (KIND < 0 || KIND == 6) phase_gemm_out(p, l, ntok, lds); }
    else if (s == 6) { if (KIND < 0 || KIND == 7) phase_norm(p, l, 1, ntok); }
    else if (s == 7) { if (KIND < 0 || KIND == 8) phase_gemm_q(p, l, ntok, lds); }
    else if (s == 8) { }
    else { if (KIND < 0 || KIND == 10) phase_topk_gather(p, l, ntok, (unsigned*)(p.ws + OFF_CTL) + 64 * (8 + l), lds); }
  }
}

#if N_LAUNCH_MODE == 1
#ifndef PROBE_KIND
#define PROBE_KIND -1
#endif
#ifndef GLA_VAR
#define GLA_VAR 0
#endif
constexpr int CW_BAR = 4096;
template <int l>
DI void run_layer(const Params& p, unsigned char* lds) {
  unsigned* ctl = (unsigned*)(p.ws + OFF_CTL);
#define GSYNC() do { XcdBarrier bb; bb.bar = (unsigned*)(p.ws + OFF_CTL) + CW_BAR; bb.x = xb_xcc_id(); bb.st = (volatile unsigned*)(lds + LDS_BYTES - 32); xcd_barrier(bb); } while (0)

    const bool last = (l == NL - 1);
    const int ntok = last ? TL : TT;
    if (l == 0) { { Params q = p; { size_t z_ = 0; asm volatile("" : "+s"(z_)); q.ws = p.ws + z_; } phase_norm(q, l, 0, TT); } GSYNC(); }
    if (PROBE_KIND == 1) { { Params q = p; { size_t z_ = 0; asm volatile("" : "+s"(z_)); q.ws = p.ws + z_; } phase_norm(q, l, 0, TT); } GSYNC(); }
    if (PROBE_KIND == 2) { { Params q = p; { size_t z_ = 0; asm volatile("" : "+s"(z_)); q.ws = p.ws + z_; } phase_gemm_in(q, l, lds, true); } GSYNC(); }
    { Params q = p; { size_t z_ = 0; asm volatile("" : "+s"(z_)); q.ws = p.ws + z_; } phase_gemm_in(q, l, lds); } GSYNC();
    if (PROBE_KIND == 4 || (PROBE_KIND >= 41 && PROBE_KIND <= 47)) { { Params q = p; { size_t z_ = 0; asm volatile("" : "+s"(z_)); q.ws = p.ws + z_; } phase_mixers(q, l, last, ctl + 64 * (1 + l) + 1, lds, PROBE_KIND == 4 ? 15 : PROBE_KIND - 40, GLA_VAR); } GSYNC(); }
    { Params q = p; { size_t z_ = 0; asm volatile("" : "+s"(z_)); q.ws = p.ws + z_; } phase_mixers(q, l, last, ctl + 64 * (1 + l), lds); } GSYNC();
    { Params q = p; { size_t z_ = 0; asm volatile("" : "+s"(z_)); q.ws = p.ws + z_; } phase_gla_fin(q, l, ntok); } GSYNC();
    if (PROBE_KIND == 5) { { Params q = p; { size_t z_ = 0; asm volatile("" : "+s"(z_)); q.ws = p.ws + z_; } phase_gla_fin(q, l, ntok); } GSYNC(); }
    { Params q = p; { size_t z_ = 0; asm volatile("" : "+s"(z_)); q.ws = p.ws + z_; } phase_gemm_out(q, l, ntok, lds); } GSYNC();
    { Params q = p; { size_t z_ = 0; asm volatile("" : "+s"(z_)); q.ws = p.ws + z_; } phase_norm2(q, l, ntok); } GSYNC();
    if (PROBE_KIND == 7) { { Params q = p; { size_t z_ = 0; asm volatile("" : "+s"(z_)); q.ws = p.ws + z_; } phase_norm2(q, l, ntok); } GSYNC(); }
    { Params q = p; { size_t z_ = 0; asm volatile("" : "+s"(z_)); q.ws = p.ws + z_; } phase_gemm_q(q, l, ntok, lds); } GSYNC();
    if (PROBE_KIND == 8) { { Params q = p; { size_t z_ = 0; asm volatile("" : "+s"(z_)); q.ws = p.ws + z_; } phase_gemm_q(q, l, ntok, lds); } GSYNC(); }
    if (PROBE_KIND == 11) { { Params q = p; { size_t z_ = 0; asm volatile("" : "+s"(z_)); q.ws = p.ws + z_; } phase_topk_gather(q, l, ntok, ctl + 64 * (8 + l) + 1, lds, true); } GSYNC(); }
    { Params q = p; { size_t z_ = 0; asm volatile("" : "+s"(z_)); q.ws = p.ws + z_; } phase_topk_gather(q, l, ntok, ctl + 64 * (8 + l), lds); } if (l + 1 < NL) GSYNC();
}
__global__ void __launch_bounds__(256, 2) mk_fwd(Params p) {
  __shared__ __attribute__((aligned(16))) unsigned char lds[LDS_BYTES];
  unsigned* ctl = (unsigned*)(p.ws + OFF_CTL);
  volatile unsigned* st = (volatile unsigned*)(lds + LDS_BYTES - 32);
  if (threadIdx.x < 2) st[threadIdx.x] = 0u;
  __syncthreads();
  (void)xcd_barrier_post(ctl + CW_BAR, st);
#define GSYNC() do { XcdBarrier bb; bb.bar = (unsigned*)(p.ws + OFF_CTL) + CW_BAR; bb.x = xb_xcc_id(); bb.st = (volatile unsigned*)(lds + LDS_BYTES - 32); xcd_barrier(bb); } while (0)
  { Params q = p; { size_t z_ = 0; asm volatile("" : "+s"(z_)); q.ws = p.ws + z_; } phase_prologue(q, lds); } cg::this_grid().sync();
  if (PROBE_KIND == 0) { { Params q = p; { size_t z_ = 0; asm volatile("" : "+s"(z_)); q.ws = p.ws + z_; } phase_prologue(q, lds); } GSYNC(); }
  run_layer<0>(p, lds); run_layer<1>(p, lds); run_layer<2>(p, lds); run_layer<3>(p, lds);
}
#else
template <int KIND>
__global__ void __launch_bounds__(256, 2) mk_phase(Params p) {
  __shared__ __attribute__((aligned(16))) unsigned char lds[LDS_BYTES];
  run_phase<KIND>(p, p.ph_lo, lds);
}
#endif

extern "C" void kernel_launch(void* const* d_in, const int* in_sizes, int n_in, void* d_out, int out_size, void* d_ws,
                              size_t ws_size, hipStream_t stream) {
  static int grid = 0;
  if (grid == 0) {
    if (n_in != 21 || ws_size < WS_END || out_size != TL * DM) { fprintf(stderr, "kernel_launch: unexpected shapes (n_in %d ws %zu out %d)\n", n_in, ws_size, out_size); grid = -1; return; }
    int dev = 0, cus = 0, per_cu = 2;
    (void)hipGetDevice(&dev);
    (void)hipDeviceGetAttribute(&cus, hipDeviceAttributeMultiprocessorCount, dev);
#if N_LAUNCH_MODE == 1
    (void)hipOccupancyMaxActiveBlocksPerMultiprocessor(&per_cu, (const void*)mk_fwd, 256, 0);
    if (per_cu < 1) per_cu = 1;
    if (per_cu > 2) per_cu = 2;
#endif
    grid = cus * per_cu;
  }
  if (grid < 0) return;
  (void)hipMemsetAsync((char*)d_ws + OFF_CTL, 0, 65536, stream);
  Params p{};
  const float** pp = (const float**)&p;
  for (int i = 0; i < 21; ++i) pp[i] = (const float*)d_in[i];
  p.out = (float*)d_out;
  p.ws = (unsigned char*)d_ws;
#if N_LAUNCH_MODE == 1
  p.ph_lo = 0; p.ph_hi = N_PHASES;
  void* args[] = {&p};
  hipError_t e = hipLaunchCooperativeKernel((const void*)mk_fwd, dim3(grid), dim3(256), args, 0, stream);
  if (e != hipSuccess) fprintf(stderr, "cooperative launch failed: %s (grid %d)\n", hipGetErrorString(e), grid);
#else
  for (int ph = 0; ph < N_PHASES; ++ph) {
    p.ph_lo = ph; p.ph_hi = ph + 1;
    const int kind = ph == 0 ? 0 : (ph == N_PHASES - 1 ? 11 : 1 + (ph - 1) % PH_PER_LAYER);
    switch (kind) {
      case 0: hipLaunchKernelGGL(mk_phase<0>, dim3(grid), dim3(256), 0, stream, p); break;
      case 1: hipLaunchKernelGGL(mk_phase<1>, dim3(grid), dim3(256), 0, stream, p); break;
      case 2: hipLaunchKernelGGL(mk_phase<2>, dim3(grid), dim3(256), 0, stream, p); break;
      case 3: hipLaunchKernelGGL(mk_phase<3>, dim3(grid), dim3(256), 0, stream, p); break;
      case 4: hipLaunchKernelGGL(mk_phase<4>, dim3(grid), dim3(256), 0, stream, p); break;
      case 5: hipLaunchKernelGGL(mk_phase<5>, dim3(grid), dim3(256), 0, stream, p); break;
      case 6: hipLaunchKernelGGL(mk_phase<6>, dim3(grid), dim3(256), 0, stream, p); break;
      case 7: hipLaunchKernelGGL(mk_phase<7>, dim3(grid), dim3(256), 0, stream, p); break;
      case 8: hipLaunchKernelGGL(mk_phase<8>, dim3(grid), dim3(256), 0, stream, p); break;
      case 9: hipLaunchKernelGGL(mk_phase<9>, dim3(grid), dim3(256), 0, stream, p); break;
      case 10: hipLaunchKernelGGL(mk_phase<10>, dim3(grid), dim3(256), 0, stream, p); break;
      default: hipLaunchKernelGGL(mk_phase<11>, dim3(grid), dim3(256), 0, stream, p); break;
    }
  }
#endif
}
```

```cpp
#include <hip/hip_runtime.h>
#include <hip/hip_cooperative_groups.h>
#include <stdint.h>
#include <stdio.h>
namespace cg = cooperative_groups;

#ifndef N_LAUNCH_MODE
#define N_LAUNCH_MODE 1
#endif

#define DI __device__ __forceinline__
#ifndef GEMM_VAR
#define GEMM_VAR 0
#endif
typedef unsigned short bf16_t;
typedef short bf16x8 __attribute__((ext_vector_type(8)));
typedef float f32x4 __attribute__((ext_vector_type(4)));
typedef float f32x2 __attribute__((ext_vector_type(2)));
typedef float f32x16 __attribute__((ext_vector_type(16)));
typedef float f32x32 __attribute__((ext_vector_type(32)));
typedef unsigned u32x6 __attribute__((ext_vector_type(6)));
typedef int i32x8 __attribute__((ext_vector_type(8)));
typedef unsigned u32x4 __attribute__((ext_vector_type(4)));
typedef unsigned u32x2 __attribute__((ext_vector_type(2)));

constexpr int NB = 16, SEQ = 2048, DM = 1024, NL = 4, CTXL = 256;
constexpr int TL = NB * SEQ;
constexpr int TC = NB * CTXL;
constexpr int TT = TL + TC;
constexpr int PN_LD = 2176;
constexpr int C_GQ = 0, C_GK = 128, C_GR = 256, C_NQ = 512, C_NK = 768, C_DQ = 1024, C_DK = 1536, C_GATE = 2048;
constexpr int R_GV = 0, R_NV = 256, R_DV = 512;
constexpr float LOG2E = 1.4426950408889634f;
constexpr float SC_LOG2 = 0.125f * LOG2E;
constexpr float NEG_BIG = -1e30f;

constexpr size_t MiB = 1u << 20;
constexpr size_t OFF_CTL = 0;
constexpr size_t OFF_MOD = 1 * MiB;
constexpr size_t OFF_WIN = 3 * MiB;
constexpr size_t OFF_WOUT = 28 * MiB;
constexpr size_t OFF_WQ = 36 * MiB;
constexpr size_t OFF_SK = 44 * MiB;
constexpr size_t OFF_USCL = 44 * MiB + 256 * 1024;
constexpr size_t OFF_VSCL = 44 * MiB + 512 * 1024;
constexpr size_t OFF_U = 45 * MiB;
constexpr size_t OFF_V = 109 * MiB;
constexpr int V6_PITCH = 800;
#ifndef U_FP4
#define U_FP4 1
#endif
#ifndef V_FP4
#define V_FP4 1
#endif
constexpr int P4_PITCH = 544;
constexpr int U_PITCH = U_FP4 ? P4_PITCH : V6_PITCH, V_PITCH = V_FP4 ? P4_PITCH : V6_PITCH;
constexpr size_t OFF_XRES = 301 * MiB;
constexpr size_t OFF_H = 445 * MiB;
constexpr size_t OFF_P = 517 * MiB;
constexpr size_t OFF_VT = OFF_P + 153 * MiB;
constexpr size_t OFF_QP = OFF_P;
constexpr size_t OFF_EID = OFF_P + 72 * MiB;
constexpr size_t OFF_GATE = OFF_P + 90 * MiB;
constexpr size_t OFF_H8 = OFF_P + 126 * MiB;
constexpr size_t OFF_HINV = OFF_P + 162 * MiB;
constexpr size_t OFF_Y = 742 * MiB;
constexpr size_t WS_END = 814 * MiB;

constexpr int LDS_BYTES = 65536 + 8192;

struct Params {
  const float *x, *c, *ctx, *c_ctx, *ada_w, *ada_b, *norm1_g, *norm2_g, *w_in, *gate_up, *gate_b, *gla_norm_g,
      *rpb, *dlam, *diff_g, *w_out, *wq, *subkeys, *pu, *pv, *final_g;
  float* out;
  unsigned char* ws;
  int ph_lo, ph_hi;
};

DI int ltid() { int t = threadIdx.x; asm volatile("" : "+v"(t)); return t; }
DI int lbid() { int t = blockIdx.x; asm volatile("" : "+s"(t)); return t; }
DI int lgdim() { int t = gridDim.x; asm volatile("" : "+s"(t)); return t; }

DI unsigned f2bf(float f) { unsigned u = __float_as_uint(f); return (u + 0x7fffu + ((u >> 16) & 1u)) >> 16; }
typedef __bf16 bf16x2_t __attribute__((ext_vector_type(2)));
DI unsigned pk2(float lo, float hi) { f32x2 v = {lo, hi}; return __builtin_bit_cast(unsigned, __builtin_convertvector(v, bf16x2_t)); }
DI float bflo(unsigned u) { return __uint_as_float(u << 16); }
DI float bfhi(unsigned u) { return __uint_as_float(u & 0xffff0000u); }
DI void unpack8(const u32x4 v, float* f) {
  f[0] = bflo(v.x); f[1] = bfhi(v.x); f[2] = bflo(v.y); f[3] = bfhi(v.y);
  f[4] = bflo(v.z); f[5] = bfhi(v.z); f[6] = bflo(v.w); f[7] = bfhi(v.w);
}
DI float wave_sum(float v) {
#pragma unroll
  for (int o = 32; o >= 1; o >>= 1) v += __shfl_xor(v, o);
  return v;
}

DI float rows_max(float x) {
  unsigned u = __float_as_uint(x);
  u32x2 a = __builtin_amdgcn_permlane32_swap(u, u, false, false);
  const float m = fmaxf(__uint_as_float(a[0]), __uint_as_float(a[1]));
  unsigned v = __float_as_uint(m);
  u32x2 b = __builtin_amdgcn_permlane16_swap(v, v, false, false);
  return fmaxf(__uint_as_float(b[0]), __uint_as_float(b[1]));
}
DI float rows_sum(float x) {
  unsigned u = __float_as_uint(x);
  u32x2 a = __builtin_amdgcn_permlane32_swap(u, u, false, false);
  const float m = __uint_as_float(a[0]) + __uint_as_float(a[1]);
  unsigned v = __float_as_uint(m);
  u32x2 b = __builtin_amdgcn_permlane16_swap(v, v, false, false);
  return __uint_as_float(b[0]) + __uint_as_float(b[1]);
}

DI u32x6 mxfp6_pack32(float (&x)[32], unsigned& sbyte) {
  float am = 0.f;
#pragma unroll
  for (int i = 0; i < 32; ++i) am = fmaxf(am, fabsf(x[i]));
  const unsigned ab = __float_as_uint(am);
  int e = am > 0.f ? (int)(ab >> 23) - 127 - 2 + ((ab & 0x7fffffu) > 0x700000u ? 1 : 0) : -126;
  e = e < -126 ? -126 : (e > 127 ? 127 : e);
  const float sc = __uint_as_float((unsigned)(127 - e) << 23);
  f32x16 lo, hi;
#pragma unroll
  for (int i = 0; i < 16; ++i) { lo[i] = x[2 * i] * sc; hi[i] = x[2 * i + 1] * sc; }
  sbyte = (unsigned)(127 + e);
  return __builtin_amdgcn_cvt_scalef32_2xpk16_fp6_f32(lo, hi, 1.0f);
}

DI u32x4 mxfp4_pack32(float (&x)[32], unsigned& sbyte) {
  float am = 0.f;
#pragma unroll
  for (int i = 0; i < 32; ++i) am = fmaxf(am, fabsf(x[i]));
  const unsigned ab = __float_as_uint(am);
  int e = am > 0.f ? (int)(ab >> 23) - 127 - 2 + ((ab & 0x7fffffu) > 0x400000u ? 1 : 0) : -126;
  e = e < -126 ? -126 : (e > 127 ? 127 : e);
  const float sc = __uint_as_float((unsigned)(127 - e) << 23);
  sbyte = (unsigned)(127 + e);
  u32x4 q;
#pragma unroll
  for (int d = 0; d < 4; ++d) {
    unsigned v = 0;
    v = __builtin_amdgcn_cvt_scalef32_pk_fp4_f32(v, x[8 * d + 0] * sc, x[8 * d + 1] * sc, 1.0f, 0);
    v = __builtin_amdgcn_cvt_scalef32_pk_fp4_f32(v, x[8 * d + 2] * sc, x[8 * d + 3] * sc, 1.0f, 1);
    v = __builtin_amdgcn_cvt_scalef32_pk_fp4_f32(v, x[8 * d + 4] * sc, x[8 * d + 5] * sc, 1.0f, 2);
    v = __builtin_amdgcn_cvt_scalef32_pk_fp4_f32(v, x[8 * d + 6] * sc, x[8 * d + 7] * sc, 1.0f, 3);
    q[d] = v;
  }
  return q;
}
DI int mx4_scale_pos(int blk) { return 512 + (blk & 3) * 8 + (blk >> 2); }
DI int mx_scale_pos(int blk) { return 768 + (blk & 3) * 8 + (blk >> 2); }
DI f32x4 mfma16(bf16x8 a, bf16x8 b, f32x4 c) { return __builtin_amdgcn_mfma_f32_16x16x32_bf16(a, b, c, 0, 0, 0); }

DI int win_src_col(int r) {
  if (r < 256) return r;
  if (r < 512) return r - 256 + 512;
  if (r < 768) return r - 512 + 800;
  if (r < 1024) return r - 768 + 1056;
  if (r < 1536) return r - 1024 + 1568;
  if (r < 2048) return r - 1536 + 2080;
  if (r < 2080) return r - 2048 + 768;
  if (r < 2176) return -1;
  if (r < 2432) return r - 2176 + 256;
  if (r < 2688) return r - 2432 + 1312;
  return r - 2688 + 2592;
}

DI void transpose_item(const float* __restrict__ W, int N, int src, bf16_t* __restrict__ dst, float* lds) {
  const int tid = ltid();
  for (int kc = 0; kc < 8; ++kc) {
    __syncthreads();
#pragma unroll
    for (int i = 0; i < 16; ++i) {
      int k = i * 8 + (tid >> 5), n = tid & 31;
      lds[k * 33 + n] = (src < 0) ? 0.f : W[(size_t)(kc * 128 + k) * N + src + n];
    }
    __syncthreads();
    int row = tid >> 3, k0 = (tid & 7) * 16;
    unsigned o[8];
#pragma unroll
    for (int e = 0; e < 8; ++e) o[e] = pk2(lds[(k0 + 2 * e) * 33 + row], lds[(k0 + 2 * e + 1) * 33 + row]);
    u32x4 a = {o[0], o[1], o[2], o[3]}, b = {o[4], o[5], o[6], o[7]};
    bf16_t* d = dst + (size_t)row * 1024 + kc * 128 + k0;
    *(u32x4*)d = a; *(u32x4*)(d + 8) = b;
  }
}

DI void convert_table_pairs(const Params& p, int pr0, int pr1, int wave, int nwave, int lane) {
  for (int pr = pr0 + __builtin_amdgcn_readfirstlane(wave); pr < pr1; pr += nwave) {
    const int tab = pr >= NL * 16384 / 2, pq = tab ? pr - NL * 16384 / 2 : pr;
    const int r = 2 * pq + (lane >> 5), blk = lane & 31;
    const float* src = (tab ? p.pv : p.pu) + (size_t)r * 1024 + 32 * blk;
    float x[32];
#pragma unroll
    for (int i = 0; i < 8; ++i) { const float4 a = *(const float4*)(src + 4 * i); x[4 * i] = a.x; x[4 * i + 1] = a.y; x[4 * i + 2] = a.z; x[4 * i + 3] = a.w; }
    unsigned sb;
    if (tab ? V_FP4 : U_FP4) {
      const u32x4 q = mxfp4_pack32(x, sb);
      unsigned char* row = p.ws + (tab ? OFF_V : OFF_U) + (size_t)r * P4_PITCH;
      *(u32x4*)(row + 16 * blk) = q;
      row[mx4_scale_pos(blk)] = (unsigned char)sb;
    } else {
      const u32x6 q = mxfp6_pack32(x, sb);
      unsigned char* row = p.ws + (tab ? OFF_V : OFF_U) + (size_t)r * V6_PITCH;
      *(u32x2*)(row + 24 * blk) = (u32x2){q[0], q[1]};
      *(u32x2*)(row + 24 * blk + 8) = (u32x2){q[2], q[3]};
      *(u32x2*)(row + 24 * blk + 16) = (u32x2){q[4], q[5]};
      row[mx_scale_pos(blk)] = (unsigned char)sb;
    }
  }
}

DI void phase_prologue(const Params& p, unsigned char* lds) {
  const int tid = ltid(), nb = lgdim(), bid = lbid();
  bf16_t* winT = (bf16_t*)(p.ws + OFF_WIN);
  bf16_t* woutT = (bf16_t*)(p.ws + OFF_WOUT);
  bf16_t* wqT = (bf16_t*)(p.ws + OFF_WQ);
  constexpr int PER_LAYER = 100 + 32 + 32;
  for (int item = bid; item < NL * PER_LAYER; item += nb) {
    int l = item / PER_LAYER, r = item % PER_LAYER;
    if (r < 100) {
      int row = r * 32;
      transpose_item(p.w_in + (size_t)l * 1024 * 3104, 3104, win_src_col(row), winT + ((size_t)l * 3200 + row) * 1024, (float*)lds);
    } else if (r < 132) {
      int row = (r - 100) * 32;
      transpose_item(p.w_out + (size_t)l * 1024 * 1024, 1024, row, woutT + ((size_t)l * 1024 + row) * 1024, (float*)lds);
    } else {
      int row = (r - 132) * 32;
      transpose_item(p.wq + (size_t)l * 1024 * 1024, 1024, row, wqT + ((size_t)l * 1024 + row) * 1024, (float*)lds);
    }
  }
  {
    bf16_t* sk = (bf16_t*)(p.ws + OFF_SK);
    for (int i = bid * 256 + tid; i < NL * 2 * 128 * 64; i += nb * 256) sk[i] = (bf16_t)f2bf(p.subkeys[i]);
  }
  {
    float* modbuf = (float*)(p.ws + OFF_MOD);
    float* sc = (float*)lds;
    float* red = (float*)(lds + 17 * 512 * 4);
    for (int item = bid; item < NL * 96; item += nb) {
      const int l = item / 96, cb = item % 96, col = cb * 64 + (tid & 63), kq = tid >> 6;
      float acc[17];
#pragma unroll
      for (int r = 0; r < 17; ++r) acc[r] = 0.f;
      for (int half = 0; half < 2; ++half) {
        __syncthreads();
        for (int e = tid; e < 17 * 512; e += 256) {
          int r = e >> 9, k = e & 511;
          float cv = (r < 16) ? p.c[r * 1024 + half * 512 + k] : p.c_ctx[half * 512 + k];
          sc[e] = cv / (1.f + __expf(-cv));
        }
        __syncthreads();
        const float* wp = p.ada_w + ((size_t)l * 1024 + half * 512 + kq * 128) * 6144 + col;
        for (int kk = 0; kk < 128; ++kk) {
          const float w = wp[(size_t)kk * 6144];
#pragma unroll
          for (int r = 0; r < 17; ++r) acc[r] += sc[r * 512 + kq * 128 + kk] * w;
        }
      }
#pragma unroll
      for (int r = 0; r < 17; ++r) red[(kq * 17 + r) * 64 + (tid & 63)] = acc[r];
      __syncthreads();
      for (int e = tid; e < 17 * 64; e += 256) {
        int r = e >> 6, cc = e & 63;
        float s = red[(0 * 17 + r) * 64 + cc] + red[(1 * 17 + r) * 64 + cc] + red[(2 * 17 + r) * 64 + cc] + red[(3 * 17 + r) * 64 + cc];
        int colg = cb * 64 + cc;
        modbuf[((size_t)l * 17 + r) * 6144 + colg] = s + p.ada_b[l * 6144 + colg];
      }
      __syncthreads();
    }
  }
}

DI void phase_norm(const Params& p, int l, int which, int ntok) {
  const int lane = ltid() & 63, gw = lbid() * 4 + (ltid() >> 6), nw = lgdim() * 4;
  const float* gvec = (which == 0 ? p.norm1_g : p.norm2_g) + l * 1024;
  const int ish = which == 0 ? 0 : 3, isc = which == 0 ? 1 : 4;
  const float* xres = (const float*)(p.ws + OFF_XRES);
  const float* modbuf = (const float*)(p.ws + OFF_MOD);
  bf16_t* hbuf = (bf16_t*)(p.ws + OFF_H);
  for (int t = gw; t < ntok; t += nw) {
    const float* src = (which == 0 && l == 0) ? (t < TL ? p.x + (size_t)t * 1024 : p.ctx + (size_t)(t - TL) * 1024) : xres + (size_t)t * 1024;
    const int b = t < TL ? (t >> 11) : 16;
    const float* md = modbuf + ((size_t)l * 17 + b) * 6144;
    float4 v[4];
    float ss = 0.f;
#pragma unroll
    for (int i = 0; i < 4; ++i) {
      v[i] = *(const float4*)(src + 4 * lane + 256 * i);
      ss += v[i].x * v[i].x + v[i].y * v[i].y + v[i].z * v[i].z + v[i].w * v[i].w;
    }
    ss = wave_sum(ss);
    const float rstd = rsqrtf(ss * (1.f / 1024.f) + 1e-6f);
    float am = 0.f;
#pragma unroll
    for (int i = 0; i < 4; ++i) {
      const int col = 4 * lane + 256 * i;
      const float4 g4 = *(const float4*)(gvec + col), sh = *(const float4*)(md + ish * 1024 + col), sc = *(const float4*)(md + isc * 1024 + col);
      float o0 = v[i].x * rstd * g4.x * (1.f + sc.x) + sh.x;
      float o1 = v[i].y * rstd * g4.y * (1.f + sc.y) + sh.y;
      float o2 = v[i].z * rstd * g4.z * (1.f + sc.z) + sh.z;
      float o3 = v[i].w * rstd * g4.w * (1.f + sc.w) + sh.w;
      u32x2 o = {pk2(o0, o1), pk2(o2, o3)};
      *(u32x2*)(hbuf + (size_t)t * 1024 + col) = o;
      v[i].x = o0; v[i].y = o1; v[i].z = o2; v[i].w = o3;
      am = fmaxf(am, fmaxf(fmaxf(fabsf(o0), fabsf(o1)), fmaxf(fabsf(o2), fabsf(o3))));
    }
  }
}

DI void phase_norm2(const Params& p, int l, int ntok) {
  const int lane = ltid() & 63, gw = lbid() * 4 + (ltid() >> 6), nw = lgdim() * 4;
  const int half = lane >> 5, blk = lane & 31;
  const float* gvec = p.norm2_g + l * 1024 + 32 * blk;
  const bf16_t* xres = (const bf16_t*)(p.ws + OFF_XRES);
  const float* modbuf = (const float*)(p.ws + OFF_MOD);
  bf16_t* hbuf = (bf16_t*)(p.ws + OFF_H);
  unsigned char* h6 = p.ws + OFF_H8;
  for (int pr = gw; pr < ntok / 2; pr += nw) {
    const int t = 2 * pr + half;
    const bf16_t* src = xres + (size_t)t * 1024 + 32 * blk;
    const int b = t < TL ? (t >> 11) : 16;
    const float* md = modbuf + ((size_t)l * 17 + b) * 6144 + 32 * blk;
    float x[32];
    float ss = 0.f;
#pragma unroll
    for (int i = 0; i < 4; ++i) { const u32x4 a = *(const u32x4*)(src + 8 * i); unpack8(a, x + 8 * i); }
#pragma unroll
    for (int i = 0; i < 32; ++i) ss += x[i] * x[i];
#pragma unroll
    for (int o = 16; o >= 1; o >>= 1) ss += __shfl_xor(ss, o);
    const float rstd = rsqrtf(ss * (1.f / 1024.f) + 1e-6f);
    unsigned pk[16];
#pragma unroll
    for (int i = 0; i < 8; ++i) {
      const float4 g4 = *(const float4*)(gvec + 4 * i), sh = *(const float4*)(md + 3 * 1024 + 4 * i), sc = *(const float4*)(md + 4 * 1024 + 4 * i);
      x[4 * i] = x[4 * i] * rstd * g4.x * (1.f + sc.x) + sh.x;
      x[4 * i + 1] = x[4 * i + 1] * rstd * g4.y * (1.f + sc.y) + sh.y;
      x[4 * i + 2] = x[4 * i + 2] * rstd * g4.z * (1.f + sc.z) + sh.z;
      x[4 * i + 3] = x[4 * i + 3] * rstd * g4.w * (1.f + sc.w) + sh.w;
      pk[2 * i] = pk2(x[4 * i], x[4 * i + 1]); pk[2 * i + 1] = pk2(x[4 * i + 2], x[4 * i + 3]);
    }
    bf16_t* hrow = hbuf + (size_t)t * 1024 + 32 * blk;
#pragma unroll
    for (int i = 0; i < 4; ++i) *(u32x4*)(hrow + 8 * i) = (u32x4){pk[4 * i], pk[4 * i + 1], pk[4 * i + 2], pk[4 * i + 3]};
    unsigned sb;
    const u32x6 q = mxfp6_pack32(x, sb);
    unsigned char* row = h6 + (size_t)t * V6_PITCH;
    *(u32x2*)(row + 24 * blk) = (u32x2){q[0], q[1]};
    *(u32x2*)(row + 24 * blk + 8) = (u32x2){q[2], q[3]};
    *(u32x2*)(row + 24 * blk + 16) = (u32x2){q[4], q[5]};
    row[mx_scale_pos(blk)] = (unsigned char)sb;
  }
}

template <int EPI>
DI void gemm_tile(const bf16_t* __restrict__ P, const bf16_t* __restrict__ Q, int it, int jt, void* outp, int ld,
                  const float* xin_lat, const float* xin_ctx, const float* modl, unsigned char* lds, bool gvar = false) {
  const int tid = ltid(), lane = tid & 63, w = tid >> 6, wi = w >> 1, wj = w & 1, lr = lane & 15, g = lane >> 4;
  const int wu = __builtin_amdgcn_readfirstlane(w);
  f32x4 acc[4][4];
#pragma unroll
  for (int a = 0; a < 4; ++a)
#pragma unroll
    for (int b = 0; b < 4; ++b) acc[a][b] = (f32x4){0.f, 0.f, 0.f, 0.f};
  const unsigned lo0 = (unsigned)((lane >> 3) * 1024 + (((lane & 7) ^ (lane >> 4)) << 3));
  const unsigned lo1 = (unsigned)((lane >> 3) * 1024 + (((lane & 7) ^ (4 + (lane >> 4))) << 3));
  const bf16_t* pg = P + (size_t)(it * 128 + 32 * wu) * 1024;
  const bf16_t* qg = Q + (size_t)(jt * 128 + 32 * wu) * 1024;
#define GT_DMA(kb, bf) do { _Pragma("unroll") for (int jj = 0; jj < 4; ++jj) { const unsigned lo_ = (jj & 1) ? lo1 : lo0; \
      __builtin_amdgcn_global_load_lds((const unsigned*)(pg + (size_t)jj * 8192 + (kb) * 64 + lo_), (unsigned*)(lds + (bf) * 32768 + (4 * wu + jj) * 1024), 16, 0, 0); \
      __builtin_amdgcn_global_load_lds((const unsigned*)(qg + (size_t)jj * 8192 + (kb) * 64 + lo_), (unsigned*)(lds + (bf) * 32768 + 16384 + (4 * wu + jj) * 1024), 16, 0, 0); } } while (0)
  __syncthreads();
  GT_DMA(0, 0);
  asm volatile("s_waitcnt vmcnt(0)" ::: "memory");
  __syncthreads();
  for (int kb = 0; kb < 16; ++kb) {
    if (kb < 15 && !(GEMM_VAR == 1 && gvar)) GT_DMA(kb + 1, (kb + 1) & 1);
    const unsigned char* Ps = lds + (kb & 1) * 32768;
    const unsigned char* Qs = Ps + 16384;
    bf16x8 pf[2][4], qf[2][4];
#pragma unroll
    for (int ks = 0; ks < 2; ++ks) {
      const int ch = ks * 4 + g;
#pragma unroll
      for (int mi = 0; mi < 4; ++mi) { const int row = wi * 64 + mi * 16 + lr; pf[ks][mi] = *(const bf16x8*)(Ps + (row >> 1) * 256 + (((((row & 1) << 3) | ch) ^ ((row >> 1) & 7)) << 4)); }
#pragma unroll
      for (int nj = 0; nj < 4; ++nj) { const int row = wj * 64 + nj * 16 + lr; qf[ks][nj] = *(const bf16x8*)(Qs + (row >> 1) * 256 + (((((row & 1) << 3) | ch) ^ ((row >> 1) & 7)) << 4)); }
    }
    __builtin_amdgcn_sched_barrier(0);
    __builtin_amdgcn_s_setprio(1);
#pragma unroll
    for (int ks = 0; ks < 2; ++ks)
#pragma unroll
      for (int mi = 0; mi < 4; ++mi)
#pragma unroll
        for (int nj = 0; nj < 4; ++nj) { if (GEMM_VAR == 2 && gvar) { asm volatile("" :: "v"(pf[ks][mi]), "v"(qf[ks][nj])); } else acc[mi][nj] = mfma16(pf[ks][mi], qf[ks][nj], acc[mi][nj]); }
    __builtin_amdgcn_s_setprio(0);
    __builtin_amdgcn_sched_barrier(0);
    asm volatile("s_waitcnt vmcnt(0)" ::: "memory");
    __syncthreads();
  }
#undef GT_DMA
  if (EPI == 2) {
    float inv[4];
#pragma unroll
    for (int r = 0; r < 4; ++r) inv[r] = __builtin_amdgcn_exp2f(-(float)(4 * g + r) * (13.287712379549449f / 16.f));
#pragma unroll
    for (int nj = 0; nj < 4; ++nj) {
      const int j = jt * 128 + wj * 64 + nj * 16 + lr;
      if (j < TL) {
        const float prow = (float)((j & 2047) >> 6), pcol = (float)(j & 63);
#pragma unroll
        for (int r = 0; r < 4; ++r) {
          const float a1 = prow * inv[r], a2 = pcol * inv[r];
          const float c1 = __cosf(a1), s1 = __sinf(a1), c2 = __cosf(a2), s2 = __sinf(a2);
          const float x1 = acc[0][nj][r], x2 = acc[1][nj][r], y1 = acc[2][nj][r], y2 = acc[3][nj][r];
          acc[0][nj][r] = x1 * c1 - x2 * s1; acc[1][nj][r] = x2 * c1 + x1 * s1;
          acc[2][nj][r] = y1 * c2 - y2 * s2; acc[3][nj][r] = y2 * c2 + y1 * s2;
        }
      }
    }
  }
#pragma unroll
  for (int mi = 0; mi < 4; ++mi)
#pragma unroll
    for (int nj = 0; nj < 4; ++nj) {
      const int j = jt * 128 + wj * 64 + nj * 16 + lr;
      const int i = it * 128 + wi * 64 + mi * 16 + 4 * g;
      const f32x4 a = acc[mi][nj];
      if (EPI == 0 || EPI == 2) {
        u32x2 o = {pk2(a[0], a[1]), pk2(a[2], a[3])};
        *(u32x2*)((bf16_t*)outp + (size_t)j * ld + i) = o;
      } else {
        const int b = j < TL ? (j >> 11) : 16;
        const float4 gt = *(const float4*)(modl + (size_t)b * 6144 + 2 * 1024 + i);
        float4 xv;
        if (xin_lat) {
          const float* xs = (j < TL) ? xin_lat + (size_t)j * 1024 + i : xin_ctx + (size_t)(j - TL) * 1024 + i;
          xv = *(const float4*)xs;
        } else {
          const u32x2 r = *(const u32x2*)((const bf16_t*)outp + (size_t)j * 1024 + i);
          xv = (float4){bflo(r.x), bfhi(r.x), bflo(r.y), bfhi(r.y)};
        }
        u32x2 o = {pk2(xv.x + gt.x * a[0], xv.y + gt.y * a[1]), pk2(xv.z + gt.z * a[2], xv.w + gt.w * a[3])};
        *(u32x2*)((bf16_t*)outp + (size_t)j * 1024 + i) = o;
      }
    }
}

struct TileIter {
  int u, step, total, nf, tpx, x;
  DI void init(int n_tok_tiles, int n_feat_tiles) {
    const int bid = lbid(), nb = lgdim();
    nf = n_feat_tiles;
    if ((nb & 7) == 0 && (n_tok_tiles & 7) == 0) { x = bid & 7; u = bid >> 3; step = nb >> 3; tpx = n_tok_tiles >> 3; }
    else { x = 0; u = bid; step = nb; tpx = n_tok_tiles; }
    total = tpx * nf;
  }
  DI bool valid() const { return u < total; }
  DI void next() { u += step; }
  DI void get(int& tok_tile, int& feat_tile) const {
    const int g = u / (8 * nf), rem = u - g * 8 * nf;
    const int gs = (tpx - 8 * g) < 8 ? (tpx - 8 * g) : 8;
    const int f = rem / gs, tt = rem - f * gs;
    tok_tile = x * tpx + 8 * g + tt; feat_tile = f;
  }
};

DI void phase_gemm_in(const Params& p, int l, unsigned char* lds, bool gvar = false) {
  const bf16_t* W = (const bf16_t*)(p.ws + OFF_WIN) + (size_t)l * 3200 * 1024;
  const bf16_t* H = (const bf16_t*)(p.ws + OFF_H);
  bf16_t* PN = (bf16_t*)(p.ws + OFF_P);
  bf16_t* VT = (bf16_t*)(p.ws + OFF_VT);
  TileIter ti; ti.init(TT / 128, 25);
  for (; ti.valid(); ti.next()) {
    int jt, f; ti.get(jt, f);
    if (f >= 8 && f < 16) gemm_tile<2>(W, H, f, jt, PN, PN_LD, nullptr, nullptr, nullptr, lds, gvar);
    else if (f < 17) gemm_tile<0>(W, H, f, jt, PN, PN_LD, nullptr, nullptr, nullptr, lds, gvar);
    else gemm_tile<0>(H, W + (size_t)2176 * 1024, jt, f - 17, VT, TT, nullptr, nullptr, nullptr, lds, gvar);
  }
}
DI void phase_gemm_out(const Params& p, int l, int ntok, unsigned char* lds) {
  const bf16_t* W = (const bf16_t*)(p.ws + OFF_WOUT) + (size_t)l * 1024 * 1024;
  const bf16_t* Y = (const bf16_t*)(p.ws + OFF_Y);
  bf16_t* xres = (bf16_t*)(p.ws + OFF_XRES);
  const float* modl = (const float*)(p.ws + OFF_MOD) + (size_t)l * 17 * 6144;
  const float* xl = (l == 0) ? p.x : nullptr;
  const float* xc = (l == 0) ? p.ctx : nullptr;
  TileIter ti; ti.init(ntok / 128, 8);
  for (; ti.valid(); ti.next()) {
    int jt, f; ti.get(jt, f);
    gemm_tile<1>(W, Y, f, jt, xres, 1024, xl, xc, modl, lds);
  }
}
DI void phase_gemm_q(const Params& p, int l, int ntok, unsigned char* lds) {
  const bf16_t* W = (const bf16_t*)(p.ws + OFF_WQ) + (size_t)l * 1024 * 1024;
  const bf16_t* H = (const bf16_t*)(p.ws + OFF_H);
  bf16_t* QP = (bf16_t*)(p.ws + OFF_QP);
  TileIter ti; ti.init(ntok / 128, 8);
  for (; ti.valid(); ti.next()) {
    int jt, f; ti.get(jt, f);
    gemm_tile<0>(W, H, f, jt, QP, 1024, nullptr, nullptr, nullptr, lds);
  }
}

DI void phase_rope(const Params& p, unsigned char* lds) {
  float2* tab = (float2*)lds;
  for (int e = ltid(); e < 1024; e += 256) {
    const int pos = e >> 4, i = e & 15;
    const float inv = exp2f(-(float)i * (13.287712379549449f / 16.f));
    const float ang = (float)pos * inv;
    tab[e] = make_float2(__cosf(ang), __sinf(ang));
  }
  __syncthreads();
  bf16_t* PN = (bf16_t*)(p.ws + OFF_P);
  const int total = TL * 16;
  for (int idx = lbid() * 256 + ltid(); idx < total; idx += lgdim() * 256) {
    const int t = idx >> 4, vec = idx & 15;
    const int col = ((vec >> 3) ? C_DK : C_DQ) + ((vec >> 1) & 3) * 128 + (vec & 1) * 64;
    bf16_t* ptr = PN + (size_t)t * PN_LD + col;
    float xv[64];
#pragma unroll
    for (int q = 0; q < 8; ++q) { const u32x4 v = *(const u32x4*)(ptr + q * 8); unpack8(v, xv + q * 8); }
    const int row = (t & 2047) >> 6, cp = t & 63;
#pragma unroll
    for (int i = 0; i < 16; ++i) {
      const float2 cs = tab[row * 16 + i];
      const float x1 = xv[i], x2 = xv[16 + i];
      xv[i] = x1 * cs.x - x2 * cs.y; xv[16 + i] = x2 * cs.x + x1 * cs.y;
      const float2 cs2 = tab[cp * 16 + i];
      const float y1 = xv[32 + i], y2 = xv[48 + i];
      xv[32 + i] = y1 * cs2.x - y2 * cs2.y; xv[48 + i] = y2 * cs2.x + y1 * cs2.y;
    }
#pragma unroll
    for (int q = 0; q < 8; ++q) {
      u32x4 o = {pk2(xv[q * 8], xv[q * 8 + 1]), pk2(xv[q * 8 + 2], xv[q * 8 + 3]), pk2(xv[q * 8 + 4], xv[q * 8 + 5]), pk2(xv[q * 8 + 6], xv[q * 8 + 7])};
      *(u32x4*)(ptr + q * 8) = o;
    }
  }
}

struct SrcSeg {
  const bf16_t* PN; const bf16_t* VT; int kcol, vrow, t0, n0, t1, n1, lr, g;
  DI int nsteps() const { return n0 + n1; }
  DI int tok0(int st) const { return st < n0 ? t0 + st * 32 : t1 + (st - n0) * 32; }
  DI float score(float raw, int st, int kt, int r) const { return raw * SC_LOG2; }
};
struct SrcNat {
  const bf16_t* PN; const bf16_t* VT; int kcol, vrow, b, rq, rs, cs, qc, cstart, lr, g;
  const float* rpbh;
  DI int nsteps() const { return 16; }
  DI int tok0(int st) const { return st < 8 ? b * 2048 + (rs + st) * 64 + cs : TL + b * 256 + (st - 8) * 32; }
  DI float score(float raw, int st, int kt, int r) const {
    if (st >= 8) return raw * SC_LOG2;
    const int kc = cs + 8 * g + 4 * kt + r;
    const bool valid = (kc >= cstart) && (kc < cstart + 16);
    int dc = kc - qc + 15; dc = dc < 0 ? 0 : (dc > 30 ? 30 : dc);
    const float bias = rpbh[(rs + st - rq + 7) * 31 + dc];
    return valid ? (raw * 0.125f + bias) * LOG2E : NEG_BIG;
  }
};

template <class Src>
struct FlashFrags { bf16x8 k[2][2]; bf16x8 v[4]; };
template <class Src>
DI void flash_load(const Src& S, int st, FlashFrags<Src>& F) {
  const int tk = S.tok0(st);
  const int kap = 8 * (S.lr >> 2) + (S.lr & 3);
  const bf16_t* k0p = S.PN + (size_t)(tk + kap) * PN_LD + S.kcol + 8 * S.g;
  const bf16_t* vp = S.VT + (size_t)(S.vrow + S.lr) * TT + tk + 8 * S.g;
#pragma unroll
  for (int kt = 0; kt < 2; ++kt)
#pragma unroll
    for (int ks = 0; ks < 2; ++ks) F.k[kt][ks] = *(const bf16x8*)(k0p + (size_t)kt * 4 * PN_LD + ks * 32);
#pragma unroll
  for (int dt = 0; dt < 4; ++dt) F.v[dt] = *(const bf16x8*)(vp + (size_t)dt * 16 * TT);
}
template <class Src>
DI void flash_step(const Src& S, int st, const FlashFrags<Src>& F, const bf16x8 (&qf)[2], f32x4 (&o)[4], float& mrun, float& lrun) {
  f32x4 s[2];
#pragma unroll
  for (int kt = 0; kt < 2; ++kt) {
    s[kt] = (f32x4){0.f, 0.f, 0.f, 0.f};
#pragma unroll
    for (int ks = 0; ks < 2; ++ks) s[kt] = mfma16(F.k[kt][ks], qf[ks], s[kt]);
  }
  float mt = NEG_BIG;
#pragma unroll
  for (int kt = 0; kt < 2; ++kt)
#pragma unroll
    for (int r = 0; r < 4; ++r) { s[kt][r] = S.score(s[kt][r], st, kt, r); mt = fmaxf(mt, s[kt][r]); }
  mt = rows_max(mt);
  const bool need = mt > mrun + 8.f;
  if (__any(need)) {
    const float mnew = need ? mt : mrun;
    const float alpha = __builtin_amdgcn_exp2f(mrun - mnew);
    lrun *= alpha;
#pragma unroll
    for (int dt = 0; dt < 4; ++dt) { o[dt][0] *= alpha; o[dt][1] *= alpha; o[dt][2] *= alpha; o[dt][3] *= alpha; }
    mrun = mnew;
  }
  float pv[8], ls = 0.f;
#pragma unroll
  for (int kt = 0; kt < 2; ++kt)
#pragma unroll
    for (int r = 0; r < 4; ++r) { pv[kt * 4 + r] = __builtin_amdgcn_exp2f(s[kt][r] - mrun); ls += pv[kt * 4 + r]; }
  lrun += ls;
  u32x4 pk = {pk2(pv[0], pv[1]), pk2(pv[2], pv[3]), pk2(pv[4], pv[5]), pk2(pv[6], pv[7])};
  const bf16x8 pf = __builtin_bit_cast(bf16x8, pk);
#pragma unroll
  for (int dt = 0; dt < 4; ++dt) o[dt] = mfma16(F.v[dt], pf, o[dt]);
}
template <class Src>
DI void flash_wave(const Src& S, const bf16_t* qptr  , f32x4 (&o)[4], float& ltot) {
  bf16x8 qf[2];
  qf[0] = *(const bf16x8*)(qptr); qf[1] = *(const bf16x8*)(qptr + 32);
  float mrun = NEG_BIG, lrun = 0.f;
#pragma unroll
  for (int dt = 0; dt < 4; ++dt) o[dt] = (f32x4){0.f, 0.f, 0.f, 0.f};
  const int ns = S.nsteps();
  FlashFrags<Src> f0, f1, f2;
  flash_load(S, 0, f0);
  if (ns > 1) flash_load(S, 1, f1);
  for (int st = 0; st < ns; st += 3) {
    if (st + 2 < ns) flash_load(S, st + 2, f2);
    flash_step(S, st, f0, qf, o, mrun, lrun);
    if (st + 1 < ns) {
      if (st + 3 < ns) flash_load(S, st + 3, f0);
      flash_step(S, st + 1, f1, qf, o, mrun, lrun);
    }
    if (st + 2 < ns) {
      if (st + 4 < ns) flash_load(S, st + 4, f1);
      flash_step(S, st + 2, f2, qf, o, mrun, lrun);
    }
  }
  ltot = rows_sum(lrun);
}

DI void nat_wave_task(const Params& p, int l, int b, int head, int rq, int ct, const float* rpb_lds) {
  const int lane = ltid() & 63, lr = lane & 15, g = lane >> 4;
  const bf16_t* PN = (const bf16_t*)(p.ws + OFF_P);
  const bf16_t* VT = (const bf16_t*)(p.ws + OFF_VT);
  bf16_t* Y = (bf16_t*)(p.ws + OFF_Y);
  SrcNat S;
  S.PN = PN; S.VT = VT; S.kcol = C_NK + head * 64; S.vrow = R_NV + head * 64; S.b = b; S.rq = rq; S.lr = lr; S.g = g;
  int rs = rq - 4; rs = rs < 0 ? 0 : (rs > 24 ? 24 : rs);
  S.rs = rs;
  int cs = 16 * ct - 8; cs = cs < 0 ? 0 : (cs > 32 ? 32 : cs);
  S.cs = cs;
  S.qc = 16 * ct + lr;
  int cst = S.qc - 8; cst = cst < 0 ? 0 : (cst > 48 ? 48 : cst);
  S.cstart = cst;
  S.rpbh = rpb_lds + head * 465;
  f32x4 o[4];
  float lt;
  const int qtok = b * 2048 + rq * 64 + 16 * ct + lr;
  flash_wave<SrcNat>(S, PN + (size_t)qtok * PN_LD + C_NQ + head * 64 + 8 * g, o, lt);
  const float inv = 1.f / lt;
#pragma unroll
  for (int dt = 0; dt < 4; ++dt) {
    u32x2 ov = {pk2(o[dt][0] * inv, o[dt][1] * inv), pk2(o[dt][2] * inv, o[dt][3] * inv)};
    *(u32x2*)(Y + (size_t)qtok * 1024 + 256 + head * 64 + dt * 16 + 4 * g) = ov;
  }
}
DI void natctx_wave_task(const Params& p, int b, int head, int qt) {
  const int lane = ltid() & 63, lr = lane & 15, g = lane >> 4;
  const bf16_t* PN = (const bf16_t*)(p.ws + OFF_P);
  const bf16_t* VT = (const bf16_t*)(p.ws + OFF_VT);
  bf16_t* Y = (bf16_t*)(p.ws + OFF_Y);
  SrcSeg S;
  S.PN = PN; S.VT = VT; S.kcol = C_NK + head * 64; S.vrow = R_NV + head * 64; S.lr = lr; S.g = g;
  S.t0 = TL + b * 256; S.n0 = 8; S.t1 = 0; S.n1 = 0;
  f32x4 o[4];
  float lt;
  const int qtok = TL + b * 256 + qt * 16 + lr;
  flash_wave<SrcSeg>(S, PN + (size_t)qtok * PN_LD + C_NQ + head * 64 + 8 * g, o, lt);
  const float inv = 1.f / lt;
#pragma unroll
  for (int dt = 0; dt < 4; ++dt) {
    u32x2 ov = {pk2(o[dt][0] * inv, o[dt][1] * inv), pk2(o[dt][2] * inv, o[dt][3] * inv)};
    *(u32x2*)(Y + (size_t)qtok * 1024 + 256 + head * 64 + dt * 16 + 4 * g) = ov;
  }
}

DI f32x16 mfma32(bf16x8 a, bf16x8 b, f32x16 c) { return __builtin_amdgcn_mfma_f32_32x32x16_bf16(a, b, c, 0, 0, 0); }
DI float half_max(float x) {
  unsigned u = __float_as_uint(x);
  u32x2 a = __builtin_amdgcn_permlane32_swap(u, u, false, false);
  return fmaxf(__uint_as_float(a[0]), __uint_as_float(a[1]));
}
DI float half_sum(float x) {
  unsigned u = __float_as_uint(x);
  u32x2 a = __builtin_amdgcn_permlane32_swap(u, u, false, false);
  return __uint_as_float(a[0]) + __uint_as_float(a[1]);
}
DI void diff_block_task(const Params& p, int l, int b, int hd, int qtok0, int nsteps, unsigned char* lds, int dvar = 0) {
  const int tid = ltid(), lane = tid & 63, w = tid >> 6, l31 = lane & 31, h = lane >> 5;
  unsigned char* Kb = lds;
  unsigned char* Vb = lds + 8192;
  const bf16_t* PN = (const bf16_t*)(p.ws + OFF_P);
  const bf16_t* VT = (const bf16_t*)(p.ws + OFF_VT);
  bf16_t* Y = (bf16_t*)(p.ws + OFF_Y);
  bf16x8 qf[2][4];
  {
    const bf16_t* qp = PN + (size_t)(qtok0 + 32 * w + l31) * PN_LD + C_DQ + hd * 128 + 8 * h;
#pragma unroll
    for (int m = 0; m < 2; ++m)
#pragma unroll
      for (int kd = 0; kd < 4; ++kd) {
        const u32x4 raw = *(const u32x4*)(qp + m * 64 + kd * 16);
        float f[8];
        unpack8(raw, f);
        u32x4 sc = {pk2(f[0] * SC_LOG2, f[1] * SC_LOG2), pk2(f[2] * SC_LOG2, f[3] * SC_LOG2), pk2(f[4] * SC_LOG2, f[5] * SC_LOG2), pk2(f[6] * SC_LOG2, f[7] * SC_LOG2)};
        qf[m][kd] = __builtin_bit_cast(bf16x8, sc);
      }
  }
  const int wu = __builtin_amdgcn_readfirstlane(w);
  unsigned kofs[2], vofs[2];
#pragma unroll
  for (int jj = 0; jj < 2; ++jj) {
    const int krow = 4 * (2 * w + jj) + (lane >> 4), kpc = lane & 15;
    const int kch = kpc ^ (krow & 15);
    kofs[jj] = (unsigned)(krow * PN_LD + C_DK + hd * 128 + kch * 8) * 2u;
    const int vrow = 16 * (2 * w + jj) + (lane >> 2), vpc = lane & 3;
    const int vch = vpc ^ ((vrow >> 2) & 3);
    vofs[jj] = (unsigned)((R_DV + hd * 128 + vrow) * TT + vch * 8) * 2u;
  }
#define DB_DMA(st, sl) do { const int tk = (st) < 8 ? TL + b * 256 + (st) * 32 : b * 2048 + ((st) - 8) * 32; \
    const char* kb_ = (const char*)(PN + (size_t)tk * PN_LD); const char* vb_ = (const char*)(VT + tk); \
    _Pragma("unroll") for (int jj = 0; jj < 2; ++jj) { \
      __builtin_amdgcn_global_load_lds((const unsigned*)(kb_ + kofs[jj]), (unsigned*)(Kb + (sl) * 16384 + (2 * wu + jj) * 1024), 16, 0, 0); \
      __builtin_amdgcn_global_load_lds((const unsigned*)(vb_ + vofs[jj]), (unsigned*)(Vb + (sl) * 16384 + (2 * wu + jj) * 1024), 16, 0, 0); } } while (0)
  asm volatile("s_waitcnt vmcnt(0)" ::: "memory");
  __syncthreads();
  DB_DMA(0, 0);
  DB_DMA(nsteps > 1 ? 1 : 0, 1);
  DB_DMA(nsteps > 2 ? 2 : nsteps - 1, 2);
  asm volatile("s_waitcnt vmcnt(8)" ::: "memory");
  __builtin_amdgcn_s_barrier();

  f32x16 o[2][4];
  float mrun[2], lrun[2];
#pragma unroll
  for (int m = 0; m < 2; ++m) {
    mrun[m] = NEG_BIG; lrun[m] = 0.f;
#pragma unroll
    for (int dt = 0; dt < 4; ++dt)
#pragma unroll
      for (int i = 0; i < 16; ++i) o[m][dt][i] = 0.f;
  }
  const int krw = (l31 & 0x13) | ((l31 & 4) << 1) | ((l31 & 8) >> 1);
  const unsigned kro = (unsigned)(krw * 256), kx = (unsigned)(h ^ (krw & 15));
  const unsigned vro = (unsigned)(l31 * 64), vx = (unsigned)(h ^ ((l31 >> 2) & 3));
#define DF_LOADK(kf, Kt_, m_) _Pragma("unroll") for (int kd = 0; kd < 4; ++kd) \
    kf[kd] = *(const bf16x8*)((Kt_) + kro + ((kx ^ (unsigned)((m_) * 8 + 2 * kd)) << 4))
#define DF_LOADV(vf, Vt_, d0_) _Pragma("unroll") for (int dd = 0; dd < 2; ++dd) _Pragma("unroll") for (int kk = 0; kk < 2; ++kk) \
    vf[dd][kk] = *(const bf16x8*)((Vt_) + ((d0_) + dd) * 2048 + vro + ((vx ^ (unsigned)(2 * kk)) << 4))
#define DF_SMFMA(s, kf, m_) { _Pragma("unroll") for (int i = 0; i < 16; ++i) s[i] = 0.f; \
    _Pragma("unroll") for (int kd = 0; kd < 4; ++kd) s = mfma32(kf[kd], qf[m_][kd], s); }
#define DF_SOFTMAX(s, m_) { \
    float mt = NEG_BIG; \
    _Pragma("unroll") for (int i = 0; i < 16; ++i) mt = fmaxf(mt, s[i]); \
    mt = half_max(mt); \
    const bool need = mt > mrun[m_] + 8.f; \
    if (__any(need)) { \
      const float mnew = need ? mt : mrun[m_]; \
      const float alpha = __builtin_amdgcn_exp2f(mrun[m_] - mnew); \
      lrun[m_] *= alpha; \
      _Pragma("unroll") for (int dt = 0; dt < 4; ++dt) _Pragma("unroll") for (int i = 0; i < 16; ++i) o[m_][dt][i] *= alpha; \
      mrun[m_] = mnew; \
    } \
    float pv[16], ls = 0.f; \
    _Pragma("unroll") for (int i = 0; i < 16; ++i) { pv[i] = __builtin_amdgcn_exp2f(s[i] - mrun[m_]); ls += pv[i]; } \
    lrun[m_] += ls; \
    _Pragma("unroll") for (int kk = 0; kk < 2; ++kk) { \
      u32x4 pk = {pk2(pv[8 * kk], pv[8 * kk + 1]), pk2(pv[8 * kk + 2], pv[8 * kk + 3]), pk2(pv[8 * kk + 4], pv[8 * kk + 5]), pk2(pv[8 * kk + 6], pv[8 * kk + 7])}; \
      pf[m_][kk] = __builtin_bit_cast(bf16x8, pk); } }
#define DF_PV(vf, d0_, dd_) _Pragma("unroll") for (int kk = 0; kk < 2; ++kk) _Pragma("unroll") for (int m = 0; m < 2; ++m) \
    o[m][(d0_) + (dd_)] = mfma32(vf[dd_][kk], pf[m][kk], o[m][(d0_) + (dd_)])
  bf16x8 kf0[4];
  DF_LOADK(kf0, Kb, 0);
  for (int st = 0; st < nsteps; ++st) {
    { const int sn = st + 3 < nsteps ? st + 3 : nsteps - 1; DB_DMA(sn, (st + 3) & 3); }
    const unsigned char* Kt = Kb + (st & 3) * 16384;
    const unsigned char* Vt = Vb + (st & 3) * 16384;
    bf16x8 pf[2][2];
    bf16x8 kf1[4];
    DF_LOADK(kf1, Kt, 1);
    f32x16 s0;
    DF_SMFMA(s0, kf0, 0)
    __builtin_amdgcn_sched_barrier(0);
    DF_SOFTMAX(s0, 0)
    __builtin_amdgcn_sched_barrier(0);
    f32x16 s1;
    DF_SMFMA(s1, kf1, 1)
    __builtin_amdgcn_sched_barrier(0);
    bf16x8 vfA[2][2];
    DF_LOADV(vfA, Vt, 0);
    DF_SOFTMAX(s1, 1)
    __builtin_amdgcn_sched_barrier(0);
    DF_PV(vfA, 0, 0);
    __builtin_amdgcn_sched_barrier(0);
    bf16x8 vfB[2][2];
    DF_LOADV(vfB, Vt, 2);
    DF_PV(vfA, 0, 1);
    __builtin_amdgcn_sched_barrier(0);
    asm volatile("s_waitcnt vmcnt(8) lgkmcnt(0)" ::: "memory");
    __builtin_amdgcn_s_barrier();
    __builtin_amdgcn_sched_barrier(0);
    DF_PV(vfB, 2, 0);
    __builtin_amdgcn_sched_barrier(0);
    DF_LOADK(kf0, Kb + ((st + 1) & 3) * 16384, 0);
    DF_PV(vfB, 2, 1);
    __builtin_amdgcn_sched_barrier(0);
  }
#undef DF_LOADK
#undef DF_LOADV
#undef DF_SMFMA
#undef DF_SOFTMAX
#undef DF_PV
  asm volatile("s_waitcnt vmcnt(0)" ::: "memory");
#undef DB_DMA
  const int tid2 = ltid(), lane2 = tid2 & 63, w2 = tid2 >> 6, q2 = lane2 & 31, h2 = lane2 >> 5;
  const float* lv = p.dlam + l * 256;
  float sa = lv[lane2] * lv[64 + lane2], sb = lv[128 + lane2] * lv[192 + lane2];
  sa = wave_sum(sa); sb = wave_sum(sb);
  const float lam_init = 0.8f - 0.6f * expf(-0.3f * (float)l);
  const float lam = expf(sa) - expf(sb) + lam_init;
  const float* dg = p.diff_g + l * 512 + hd * 128;
  {
    const float l0 = half_sum(lrun[0]), l1 = half_sum(lrun[1]);
    const float i0 = 1.f / l0, i1 = lam / l1;
    float ss = 0.f;
#pragma unroll
    for (int dt = 0; dt < 4; ++dt)
#pragma unroll
      for (int i = 0; i < 16; ++i) { const float v = o[0][dt][i] * i0 - o[1][dt][i] * i1; o[0][dt][i] = v; ss += v * v; }
    ss = half_sum(ss);
    const float rstd = rsqrtf(ss * (1.f / 128.f) + 1e-6f) * (1.f - lam_init);
    const int qtok = qtok0 + 32 * w2 + q2;
#pragma unroll
    for (int dt = 0; dt < 4; ++dt)
#pragma unroll
      for (int i4 = 0; i4 < 4; ++i4) {
        const int dv = 32 * dt + 8 * i4 + 4 * h2;
        const float4 gg = *(const float4*)(dg + dv);
        u32x2 ov = {pk2(o[0][dt][4 * i4] * rstd * gg.x, o[0][dt][4 * i4 + 1] * rstd * gg.y), pk2(o[0][dt][4 * i4 + 2] * rstd * gg.z, o[0][dt][4 * i4 + 3] * rstd * gg.w)};
        *(u32x2*)(Y + (size_t)qtok * 1024 + 512 + hd * 128 + dv) = ov;
      }
  }
}


DI void nat_block_task(const Params& p, int l, int b, int head, int rq, const float* rpb_lds, unsigned char* lds) {
  const int tid = ltid(), lane = tid & 63, w = tid >> 6, lr = lane & 15, g = lane >> 4;
  const int wu = __builtin_amdgcn_readfirstlane(w);
  unsigned char* Kb = lds;
  unsigned char* Vb = lds + 8192;
  const bf16_t* PN = (const bf16_t*)(p.ws + OFF_P);
  const bf16_t* VT = (const bf16_t*)(p.ws + OFF_VT);
  bf16_t* Y = (bf16_t*)(p.ws + OFF_Y);
  int rs = rq - 4; rs = rs < 0 ? 0 : (rs > 24 ? 24 : rs);
  const int ct = w;
  int cs = 16 * ct - 8; cs = cs < 0 ? 0 : (cs > 32 ? 32 : cs);
  const int qc = 16 * ct + lr;
  int cstart = qc - 8; cstart = cstart < 0 ? 0 : (cstart > 48 ? 48 : cstart);
  const float* rpbh = rpb_lds + head * 465;
  const int qtok = b * 2048 + rq * 64 + qc;
  bf16x8 qf[2];
  {
    const bf16_t* qp = PN + (size_t)qtok * PN_LD + C_NQ + head * 64 + 8 * g;
#pragma unroll
    for (int ks = 0; ks < 2; ++ks) {
      const u32x4 raw = *(const u32x4*)(qp + ks * 32);
      float f[8];
      unpack8(raw, f);
      u32x4 sc = {pk2(f[0] * SC_LOG2, f[1] * SC_LOG2), pk2(f[2] * SC_LOG2, f[3] * SC_LOG2), pk2(f[4] * SC_LOG2, f[5] * SC_LOG2), pk2(f[6] * SC_LOG2, f[7] * SC_LOG2)};
      qf[ks] = __builtin_bit_cast(bf16x8, sc);
    }
  }
  unsigned kofs[2], vofs[2];
#pragma unroll
  for (int jj = 0; jj < 2; ++jj) {
    const int pidx = 2 * w + jj, row = 8 * pidx + (lane >> 3);
    const int kch = (lane & 7) ^ ((((row >> 3) & 3) << 1) | ((row >> 1) & 1));
    kofs[jj] = (unsigned)(row * PN_LD + C_NK + head * 64 + kch * 8);
    const int vch = (lane & 7) ^ ((row >> 1) & 7);
    vofs[jj] = (unsigned)((R_NV + head * 64 + row) * TT + vch * 8);
  }
#define NB_DMA(st, bf) do { const int tk = (st) < 8 ? b * 2048 + (rs + (st)) * 64 : TL + b * 256 + ((st) - 8) * 64; \
    const bf16_t* kb_ = PN + (size_t)tk * PN_LD; const bf16_t* vb_ = VT + tk; \
    _Pragma("unroll") for (int jj = 0; jj < 2; ++jj) { \
      __builtin_amdgcn_global_load_lds((const unsigned*)(kb_ + kofs[jj]), (unsigned*)(Kb + (bf) * 16384 + (2 * wu + jj) * 1024), 16, 0, 0); \
      __builtin_amdgcn_global_load_lds((const unsigned*)(vb_ + vofs[jj]), (unsigned*)(Vb + (bf) * 16384 + (2 * wu + jj) * 1024), 16, 0, 0); } } while (0)
  asm volatile("s_waitcnt vmcnt(0)" ::: "memory");
  __syncthreads();
  NB_DMA(0, 0); NB_DMA(1, 1); NB_DMA(2, 2);
  asm volatile("s_waitcnt vmcnt(8)" ::: "memory");
  __builtin_amdgcn_s_barrier();
  f32x4 o[4];
#pragma unroll
  for (int dt = 0; dt < 4; ++dt) o[dt] = (f32x4){0.f, 0.f, 0.f, 0.f};
  float mrun = NEG_BIG, lrun = 0.f;
  const int kap = 8 * (lr >> 2) + (lr & 3);
  bool vld[8]; int dcv[8];
#pragma unroll
  for (int kt = 0; kt < 2; ++kt)
#pragma unroll
    for (int r = 0; r < 4; ++r) {
      const int kc = cs + 8 * g + 4 * kt + r;
      vld[kt * 4 + r] = (kc >= cstart) && (kc < cstart + 16);
      int dc = kc - qc + 15; dc = dc < 0 ? 0 : (dc > 30 ? 30 : dc);
      dcv[kt * 4 + r] = dc;
    }
#define NB_SUB(Kt_, Vt_, koff_, WIN) do { \
      bf16x8 kf[2][2], vf[4]; \
      _Pragma("unroll") for (int kt = 0; kt < 2; ++kt) { \
        const int row = (koff_) + kap + 4 * kt; \
        const int sw = (((row >> 3) & 3) << 1) | ((row >> 1) & 1); \
        _Pragma("unroll") for (int ks = 0; ks < 2; ++ks) kf[kt][ks] = *(const bf16x8*)((Kt_) + (row >> 1) * 256 + ((((row & 1) << 3) | ((ks * 4 + g) ^ sw)) << 4)); \
      } \
      _Pragma("unroll") for (int dt = 0; dt < 4; ++dt) { \
        const int row = 16 * dt + lr, ch = ((koff_) >> 3) + g; \
        vf[dt] = *(const bf16x8*)((Vt_) + (row >> 1) * 256 + (((((row & 1) << 3) | ch) ^ ((row >> 1) & 7)) << 4)); \
      } \
      f32x4 s[2]; \
      _Pragma("unroll") for (int kt = 0; kt < 2; ++kt) { \
        s[kt] = (f32x4){0.f, 0.f, 0.f, 0.f}; \
        _Pragma("unroll") for (int ks = 0; ks < 2; ++ks) s[kt] = mfma16(kf[kt][ks], qf[ks], s[kt]); \
      } \
      float mt = NEG_BIG; \
      _Pragma("unroll") for (int kt = 0; kt < 2; ++kt) _Pragma("unroll") for (int r = 0; r < 4; ++r) { \
          float sv = s[kt][r]; \
          if (WIN) sv = vld[kt * 4 + r] ? sv + bias[kt * 4 + r] : NEG_BIG; \
          s[kt][r] = sv; mt = fmaxf(mt, sv); \
        } \
      mt = rows_max(mt); \
      const bool need = mt > mrun + 8.f; \
      if (__any(need)) { \
        const float mnew = need ? mt : mrun; \
        const float alpha = __builtin_amdgcn_exp2f(mrun - mnew); \
        lrun *= alpha; \
        _Pragma("unroll") for (int dt = 0; dt < 4; ++dt) { o[dt][0] *= alpha; o[dt][1] *= alpha; o[dt][2] *= alpha; o[dt][3] *= alpha; } \
        mrun = mnew; \
      } \
      float pv[8], ls = 0.f; \
      _Pragma("unroll") for (int kt = 0; kt < 2; ++kt) _Pragma("unroll") for (int r = 0; r < 4; ++r) { pv[kt * 4 + r] = __builtin_amdgcn_exp2f(s[kt][r] - mrun); ls += pv[kt * 4 + r]; } \
      lrun += ls; \
      u32x4 pk = {pk2(pv[0], pv[1]), pk2(pv[2], pv[3]), pk2(pv[4], pv[5]), pk2(pv[6], pv[7])}; \
      const bf16x8 pf = __builtin_bit_cast(bf16x8, pk); \
      _Pragma("unroll") for (int dt = 0; dt < 4; ++dt) o[dt] = mfma16(vf[dt], pf, o[dt]); \
    } while (0)
  for (int st = 0; st < 8; ++st) {
    NB_DMA(st + 3, (st + 3) & 3);
    const float* brow = rpbh + (rs + st - rq + 7) * 31;
    float bias[8];
#pragma unroll
    for (int i = 0; i < 8; ++i) bias[i] = brow[dcv[i]];
    const unsigned char* Kt = Kb + (st & 3) * 16384;
    const unsigned char* Vt = Vb + (st & 3) * 16384;
    NB_SUB(Kt, Vt, cs, true);
    asm volatile("s_waitcnt vmcnt(8)" ::: "memory");
    __builtin_amdgcn_s_barrier();
  }
  for (int st = 8; st < 12; ++st) {
    { const int sn = st + 3 < 12 ? st + 3 : 11; NB_DMA(sn, (st + 3) & 3); }
    const float bias[8] = {0.f, 0.f, 0.f, 0.f, 0.f, 0.f, 0.f, 0.f};
    const unsigned char* Kt = Kb + (st & 3) * 16384;
    const unsigned char* Vt = Vb + (st & 3) * 16384;
    NB_SUB(Kt, Vt, 0, false);
    NB_SUB(Kt, Vt, 32, false);
    asm volatile("s_waitcnt vmcnt(8)" ::: "memory");
    __builtin_amdgcn_s_barrier();
  }
  asm volatile("s_waitcnt vmcnt(0)" ::: "memory");
#undef NB_SUB
#undef NB_DMA
  const float inv = 1.f / rows_sum(lrun);
#pragma unroll
  for (int dt = 0; dt < 4; ++dt) {
    u32x2 ov = {pk2(o[dt][0] * inv, o[dt][1] * inv), pk2(o[dt][2] * inv, o[dt][3] * inv)};
    *(u32x2*)(Y + (size_t)qtok * 1024 + 256 + head * 64 + dt * 16 + 4 * g) = ov;
  }
}

DI float quad_sum(float v) {
  v += __int_as_float(__builtin_amdgcn_mov_dpp(__float_as_int(v), 0xB1, 0xF, 0xF, true));
  v += __int_as_float(__builtin_amdgcn_mov_dpp(__float_as_int(v), 0x4E, 0xF, 0xF, true));
  return v;
}
DI void gla_task(const Params& p, int l, int task, unsigned char* lds, int var = 0) {
  const int tid = ltid(), lane = tid & 63, w = tid >> 6, vv = lane >> 2, g = lane & 3;
  const int b = task >> 3, h = (task >> 1) & 3, dir = task & 1;
  const bf16_t* PN = (const bf16_t*)(p.ws + OFF_P);
  const bf16_t* VT = (const bf16_t*)(p.ws + OFF_VT);
  float* og = (float*)(p.ws + OFF_H);
  float* Gup = (float*)lds;
  float* Gb = Gup + 512;
  float* As = Gb + 32;
  float* Ks = As + 2048;
  float* Qs = Ks + 2048;
  float* Vs = Qs + 2048;
  __syncthreads();
  for (int e = tid; e < 512; e += 256) { const int r = e >> 5, kd = e & 31; Gup[e] = p.gate_up[((size_t)(l * 2 + dir) * 16 + r) * 128 + h * 32 + kd]; }
  if (tid < 32) Gb[tid] = p.gate_b[(l * 2 + dir) * 128 + h * 32 + tid];
  float S[8];
#pragma unroll
  for (int e = 0; e < 8; ++e) S[e] = 0.f;
  const int si = tid >> 2, part = tid & 3;
  u32x4 rq, rk, rg0, rg1, rv0, rv1;
#define GLA_TOK0(cc) ((cc) < 4 ? TL + b * 256 + (dir == 0 ? (cc) : 3 - (cc)) * 64 : b * 2048 + (dir == 0 ? (cc) - 4 : 35 - (cc)) * 64)
#define GLA_LOAD(cc) do { const int t0_ = GLA_TOK0(cc); const bf16_t* row = PN + (size_t)(t0_ + si) * PN_LD; \
    rq = *(const u32x4*)(row + C_GQ + h * 32 + part * 8); rk = *(const u32x4*)(row + C_GK + h * 32 + part * 8); \
    rg0 = *(const u32x4*)(row + C_GATE + dir * 16); rg1 = *(const u32x4*)(row + C_GATE + dir * 16 + 8); \
    const bf16_t* vp = VT + (size_t)(R_GV + h * 64 + si) * TT + t0_ + part * 16; rv0 = *(const u32x4*)vp; rv1 = *(const u32x4*)(vp + 8); } while (0)
#define GLA_WRITE() do { float gd[16], qf[8], kf[8], vf[16], pre[8]; \
    unpack8(rg0, gd); unpack8(rg1, gd + 8); unpack8(rq, qf); unpack8(rk, kf); unpack8(rv0, vf); unpack8(rv1, vf + 8); \
    { const float4 b0 = *(const float4*)(Gb + part * 8), b1 = *(const float4*)(Gb + part * 8 + 4); \
      pre[0] = b0.x; pre[1] = b0.y; pre[2] = b0.z; pre[3] = b0.w; pre[4] = b1.x; pre[5] = b1.y; pre[6] = b1.z; pre[7] = b1.w; } \
    _Pragma("unroll") for (int r = 0; r < 16; ++r) { const float4 u0 = *(const float4*)(Gup + r * 32 + part * 8), u1 = *(const float4*)(Gup + r * 32 + part * 8 + 4); \
      pre[0] += gd[r] * u0.x; pre[1] += gd[r] * u0.y; pre[2] += gd[r] * u0.z; pre[3] += gd[r] * u0.w; \
      pre[4] += gd[r] * u1.x; pre[5] += gd[r] * u1.y; pre[6] += gd[r] * u1.z; pre[7] += gd[r] * u1.w; } \
    float av[8]; \
    _Pragma("unroll") for (int e = 0; e < 8; ++e) { const float ls = fminf(pre[e], 0.f) - __logf(1.f + __expf(-fabsf(pre[e]))); av[e] = __expf(ls * (1.f / 16.f)); } \
    *(float4*)(As + si * 32 + part * 8) = (float4){av[0], av[1], av[2], av[3]}; *(float4*)(As + si * 32 + part * 8 + 4) = (float4){av[4], av[5], av[6], av[7]}; \
    *(float4*)(Ks + si * 32 + part * 8) = (float4){kf[0], kf[1], kf[2], kf[3]}; *(float4*)(Ks + si * 32 + part * 8 + 4) = (float4){kf[4], kf[5], kf[6], kf[7]}; \
    { const float qs_ = 0.17677669529663687f; \
      *(float4*)(Qs + si * 32 + part * 8) = (float4){qf[0] * qs_, qf[1] * qs_, qf[2] * qs_, qf[3] * qs_}; *(float4*)(Qs + si * 32 + part * 8 + 4) = (float4){qf[4] * qs_, qf[5] * qs_, qf[6] * qs_, qf[7] * qs_}; } \
      \
    _Pragma("unroll") for (int e = 0; e < 4; ++e) *(float4*)(Vs + si * 68 + part * 16 + 4 * e) = (float4){vf[4 * e], vf[4 * e + 1], vf[4 * e + 2], vf[4 * e + 3]}; } while (0)
  GLA_LOAD(0);
  __syncthreads();
  GLA_WRITE();
  __syncthreads();
  for (int cc = 0; cc < 36; ++cc) {
    const int tok0 = GLA_TOK0(cc);
    if (cc + 1 < 36) GLA_LOAD(cc + 1);
    float* ob = og + ((size_t)dir * TT + tok0) * 256 + h * 64 + 16 * w + vv;
#pragma unroll 1
    for (int s0 = 0; s0 < 64; s0 += 4) {
      float4 a0[4], a1[4], k0[4], k1[4], q0[4], q1[4];
      float vx[4];
      const int ib = dir == 0 ? s0 : 63 - s0, di = dir == 0 ? 1 : -1;
#pragma unroll
      for (int u = 0; u < 4; ++u) {
        const int i = ib + di * u;
        a0[u] = *(const float4*)(As + i * 32 + 8 * g); a1[u] = *(const float4*)(As + i * 32 + 8 * g + 4);
        k0[u] = *(const float4*)(Ks + i * 32 + 8 * g); k1[u] = *(const float4*)(Ks + i * 32 + 8 * g + 4);
        q0[u] = *(const float4*)(Qs + i * 32 + 8 * g); q1[u] = *(const float4*)(Qs + i * 32 + 8 * g + 4);
        vx[u] = Vs[(16 * w + vv) * 68 + i];
      }
      float* op = ob + (ptrdiff_t)ib * 256;
#pragma unroll
      for (int u = 0; u < 4; ++u) {
        const float v = vx[u];
        S[0] = fmaf(a0[u].x, S[0], k0[u].x * v); S[1] = fmaf(a0[u].y, S[1], k0[u].y * v);
        S[2] = fmaf(a0[u].z, S[2], k0[u].z * v); S[3] = fmaf(a0[u].w, S[3], k0[u].w * v);
        S[4] = fmaf(a1[u].x, S[4], k1[u].x * v); S[5] = fmaf(a1[u].y, S[5], k1[u].y * v);
        S[6] = fmaf(a1[u].z, S[6], k1[u].z * v); S[7] = fmaf(a1[u].w, S[7], k1[u].w * v);
        const float oa = fmaf(q0[u].x, S[0], q0[u].y * S[1]), ob2 = fmaf(q0[u].z, S[2], q0[u].w * S[3]);
        const float oc = fmaf(q1[u].x, S[4], q1[u].y * S[5]), od = fmaf(q1[u].z, S[6], q1[u].w * S[7]);
        float o = (oa + ob2) + (oc + od);
        o = quad_sum(o);
        op[(ptrdiff_t)(di * u) * 256] = o;
      }
    }
    __syncthreads();
    if (cc + 1 < 36) GLA_WRITE();
    __syncthreads();
  }
#undef GLA_TOK0
#undef GLA_LOAD
#undef GLA_WRITE
}

DI void phase_mixers(const Params& p, int l, bool last, unsigned* ctr, unsigned char* lds, int mask = 15, int gvar = 0) {
  const int tid = ltid(), w = tid >> 6;
  volatile int* slot = (volatile int*)(lds + LDS_BYTES - 16);
  float* rpb_lds = (float*)(lds + 65536);
  for (int e = tid; e < 4 * 465; e += 256) rpb_lds[e] = p.rpb[(size_t)l * 4 * 465 + e] * LOG2E;
  const int nconv = (l == 0 && (mask & 8)) ? 1024 : 0;
  const int t1 = 128 + nconv, t2 = t1 + 1024, t3 = t2 + 2048, t4 = t3 + 128;
  const int ntask = last ? t3 : t4 + 256;
  for (;;) {
    __syncthreads();
    if (tid == 0) *slot = (int)atomicAdd(ctr, 1u);
    __syncthreads();
    const int task = *slot;
    if (task >= ntask) break;
    if (task < 128) { if (mask & 1) { __builtin_amdgcn_s_setprio(3); gla_task(p, l, task, lds, gvar); __builtin_amdgcn_s_setprio(0); } }
    else if (nconv && task < t2 && ((task - 128) & 1)) { const int c = (task - 128) >> 1; convert_table_pairs(p, c * 64, c * 64 + 64, w, 4, tid & 63); }
    else if (!(mask & 2) && (task < t2 || (task >= t3 && task < t4))) {}
    else if (!(mask & 4) && ((task >= t2 && task < t3) || task >= t4)) {}
    else if (task < t2) { const int d = nconv ? (task - 128) >> 1 : task - 128; const int b = d >> 6; diff_block_task(p, l, b, (d >> 4) & 3, b * 2048 + (d & 15) * 128, 72, lds, gvar); }
    else if (task < t3) { const int d = task - t2; nat_block_task(p, l, d >> 7, (d >> 5) & 3, d & 31, rpb_lds, lds); }
    else if (task < t4) { const int d = task - t3; const int b = d >> 3; diff_block_task(p, l, b, (d >> 1) & 3, TL + b * 256 + (d & 1) * 128, 8, lds); }
    else { const int wt = (task - t4) * 4 + w; natctx_wave_task(p, wt >> 6, (wt >> 4) & 3, wt & 15); }
  }
}

DI void phase_gla_fin(const Params& p, int l, int ntok) {
  const int lane = ltid() & 63, gw = lbid() * 4 + (ltid() >> 6), nw = lgdim() * 4;
  const float* og = (const float*)(p.ws + OFF_H);
  const bf16_t* PN = (const bf16_t*)(p.ws + OFF_P);
  bf16_t* Y = (bf16_t*)(p.ws + OFF_Y);
  const float4 gg = *(const float4*)(p.gla_norm_g + l * 256 + 4 * lane);
  for (int t = gw; t < ntok; t += nw) {
    const float4 a = *(const float4*)(og + (size_t)t * 256 + 4 * lane), bq = *(const float4*)(og + ((size_t)TT + t) * 256 + 4 * lane);
    const float o0 = a.x + bq.x, o1 = a.y + bq.y, o2 = a.z + bq.z, o3 = a.w + bq.w;
    float ss = o0 * o0 + o1 * o1 + o2 * o2 + o3 * o3;
    ss += __shfl_xor(ss, 1); ss += __shfl_xor(ss, 2); ss += __shfl_xor(ss, 4); ss += __shfl_xor(ss, 8);
    const float rstd = rsqrtf(ss * (1.f / 64.f) + 1e-6f);
    const u32x2 rv = *(const u32x2*)(PN + (size_t)t * PN_LD + C_GR + 4 * lane);
    const float r0 = bflo(rv.x), r1 = bfhi(rv.x), r2 = bflo(rv.y), r3 = bfhi(rv.y);
    const float y0 = o0 * rstd * gg.x * (r0 / (1.f + __expf(-r0)));
    const float y1 = o1 * rstd * gg.y * (r1 / (1.f + __expf(-r1)));
    const float y2 = o2 * rstd * gg.z * (r2 / (1.f + __expf(-r2)));
    const float y3 = o3 * rstd * gg.w * (r3 / (1.f + __expf(-r3)));
    u32x2 ov = {pk2(y0, y1), pk2(y2, y3)};
    *(u32x2*)(Y + (size_t)t * 1024 + 4 * lane) = ov;
  }
}


DI void ce_desc(float& a, float& b) {
  float hi, lo;
  asm("v_max_f32 %0, %2, %3\n\tv_min_f32 %1, %2, %3" : "=&v"(hi), "=&v"(lo) : "v"(a), "v"(b));
  a = hi; b = lo;
}
DI float vmaxf(float a, float b) { float r; asm("v_max_f32 %0, %1, %2" : "=v"(r) : "v"(a), "v"(b)); return r; }
template <int N>
DI void bitonic_sort_desc(float (&x)[N]) {
#pragma unroll
  for (int k = 2; k <= N; k <<= 1)
#pragma unroll
    for (int j = k >> 1; j > 0; j >>= 1)
#pragma unroll
      for (int i = 0; i < N; ++i) {
        const int l = i ^ j;
        if (l > i) { if ((i & k) == 0) ce_desc(x[i], x[l]); else ce_desc(x[l], x[i]); }
      }
}
template <int N>
DI void bitonic_merge_desc(float (&x)[N]) {
#pragma unroll
  for (int j = N >> 1; j > 0; j >>= 1)
#pragma unroll
    for (int i = 0; i < N; ++i) { const int l = i ^ j; if (l > i) ce_desc(x[i], x[l]); }
}
DI void rows_merge_top16(float (&L)[16]) {
  {
    float A0[16], A1[16];
#pragma unroll
    for (int i = 0; i < 16; ++i) { const u32x2 s = __builtin_amdgcn_permlane32_swap(__float_as_uint(L[i]), __float_as_uint(L[i]), false, false); A0[i] = __uint_as_float(s[0]); A1[i] = __uint_as_float(s[1]); }
#pragma unroll
    for (int i = 0; i < 16; ++i) L[i] = vmaxf(A0[i], A1[15 - i]);
    bitonic_merge_desc<16>(L);
  }
  {
    float A0[16], A1[16];
#pragma unroll
    for (int i = 0; i < 16; ++i) { const u32x2 s = __builtin_amdgcn_permlane16_swap(__float_as_uint(L[i]), __float_as_uint(L[i]), false, false); A0[i] = __uint_as_float(s[0]); A1[i] = __uint_as_float(s[1]); }
#pragma unroll
    for (int i = 0; i < 16; ++i) L[i] = vmaxf(A0[i], A1[15 - i]);
    bitonic_merge_desc<16>(L);
  }
}

struct PairTab { int a[52], b[52]; };
constexpr PairTab make_pairs() {
  PairTab t{};
  int n = 0;
  for (int a = 0; a < 16; ++a)
    for (int b = 0; b < 16; ++b)
      if ((a + 1) * (b + 1) <= 16) { t.a[n] = a; t.b[n] = b; ++n; }
  for (; n < 52; ++n) { t.a[n] = -1; t.b[n] = -1; }
  return t;
}

DI void topk_half(const bf16_t* skh  , const bf16_t* qrow  , int lr, int g, float (&list)[16]) {
  bf16x8 qf[2];
  qf[0] = *(const bf16x8*)(qrow); qf[1] = *(const bf16x8*)(qrow + 32);
  float s[32];
#pragma unroll
  for (int nt = 0; nt < 8; ++nt) {
    f32x4 acc = {0.f, 0.f, 0.f, 0.f};
#pragma unroll
    for (int ks = 0; ks < 2; ++ks) {
      const bf16x8 af = *(const bf16x8*)(skh + (size_t)(nt * 16 + lr) * 64 + ks * 32 + 8 * g);
      acc = mfma16(af, qf[ks], acc);
    }
#pragma unroll
    for (int r = 0; r < 4; ++r) {
      const unsigned n = nt * 16 + 4 * g + r;
      s[nt * 4 + r] = __uint_as_float((__float_as_uint(acc[r]) & ~127u) | n);
    }
  }
  float a[16], bq[16];
#pragma unroll
  for (int i = 0; i < 16; ++i) { a[i] = s[i]; bq[i] = s[16 + i]; }
  bitonic_sort_desc<16>(a);
  bitonic_sort_desc<16>(bq);
#pragma unroll
  for (int i = 0; i < 16; ++i) list[i] = vmaxf(a[i], bq[15 - i]);
  bitonic_merge_desc<16>(list);
  rows_merge_top16(list);
}

DI void topk_tile(const bf16_t* QP, const bf16_t* sk, int tt, int hd, int* eid_rows, float* gate_rows, int lr, int g) {
  constexpr PairTab PT = make_pairs();
  {
    const int tok = tt * 16 + lr;
    float v1[16], v2[16];
    topk_half(sk, QP + (size_t)tok * 1024 + hd * 128 + 8 * g, lr, g, v1);
    __builtin_amdgcn_sched_barrier(0);
    topk_half(sk + 128 * 64, QP + (size_t)tok * 1024 + hd * 128 + 64 + 8 * g, lr, g, v2);
    __builtin_amdgcn_sched_barrier(0);
    float cand[13];
#pragma unroll
    for (int c = 0; c < 13; ++c) {
      float sv[4];
#pragma unroll
      for (int gi = 0; gi < 4; ++gi) {
        const int pi = 4 * c + gi;
        if (PT.a[pi] >= 0) {
          const float a = v1[PT.a[pi] < 0 ? 0 : PT.a[pi]], bq = v2[PT.b[pi] < 0 ? 0 : PT.b[pi]];
          sv[gi] = __uint_as_float((__float_as_uint(a + bq) & ~255u) | (unsigned)(PT.a[pi] * 16 + PT.b[pi]));
        } else { sv[gi] = -3.0e38f; }
      }
      cand[c] = g == 0 ? sv[0] : (g == 1 ? sv[1] : (g == 2 ? sv[2] : sv[3]));
    }
    float topv[16];
#pragma unroll
    for (int c = 0; c < 13; ++c) topv[c] = cand[c];
    topv[13] = -3.0e38f; topv[14] = -3.1e38f; topv[15] = -3.2e38f;
    bitonic_sort_desc<16>(topv);
    rows_merge_top16(topv);
#pragma unroll
    for (int q = 0; q < 4; ++q) {
      const float wv = g == 0 ? topv[q] : (g == 1 ? topv[4 + q] : (g == 2 ? topv[8 + q] : topv[12 + q]));
      const int ia = (int)((__float_as_uint(wv) >> 4) & 15u), ib = (int)(__float_as_uint(wv) & 15u);
      unsigned e1 = 0, e2 = 0;
#pragma unroll
      for (int c = 0; c < 16; ++c) { if (ia == c) e1 = __float_as_uint(v1[c]) & 127u; if (ib == c) e2 = __float_as_uint(v2[c]) & 127u; }
      eid_rows[lr * 128 + hd * 16 + 4 * g + q] = (int)(e1 * 128u + e2);
    }
    if (g == 0) {
      float ex[16], sum = 0.f;
#pragma unroll
      for (int k = 0; k < 16; ++k) { ex[k] = __expf(topv[k] - topv[0]); sum += ex[k]; }
      const float inv = 1.f / sum;
#pragma unroll
      for (int q = 0; q < 4; ++q) {
        float4 o = {ex[4 * q] * inv, ex[4 * q + 1] * inv, ex[4 * q + 2] * inv, ex[4 * q + 3] * inv};
        *(float4*)(gate_rows + lr * 128 + hd * 16 + 4 * q) = o;
      }
    }
  }
}

DI float gelu_tanh(float x) {
  const float z = 0.7978845608028654f * (x + 0.044715f * x * x * x);
  const float e = __expf(2.f * z);
  const float th = 1.f - 2.f / (e + 1.f);
  return 0.5f * x * (1.f + th);
}
DI void gather_token(const Params& p, int l, int t, const int* eid_row, const float* gate_row, unsigned char* hl, float* wl, bool dry) {
  const int lane = ltid() & 63, lr = lane & 15, g = lane >> 4;
  const unsigned char* U6 = p.ws + OFF_U + (size_t)l * 16384 * U_PITCH;
  const unsigned char* V6 = p.ws + OFF_V + (size_t)l * 16384 * V_PITCH;
  const int half = lane >> 5, blk = lane & 31;
  const unsigned char* H6 = p.ws + OFF_H8;
  bf16_t* xres = (bf16_t*)(p.ws + OFF_XRES);
  const float* modbuf = (const float*)(p.ws + OFF_MOD);
  {
    if (lane < 50) {
      const u32x4 hq = *(const u32x4*)(H6 + (size_t)t * V6_PITCH + lane * 16);
      *(u32x4*)(hl + lane * 16) = hq;
    }
    const int e0 = eid_row[lane], e1 = eid_row[64 + lane];
    const float gv0 = gate_row[lane], gv1 = gate_row[64 + lane];
    {
      const u32x2 hsc = *(const u32x2*)(hl + 768 + 8 * g);
#pragma unroll 1
      for (int grp = 0; grp < 8; ++grp) {
        const int er = __shfl(grp < 4 ? e0 : e1, (grp & 3) * 16 + lr);
        const unsigned char* ur = U6 + (size_t)er * U_PITCH;
        u32x4 ua[8]; u32x2 ub[8];
#pragma unroll
        for (int s = 0; s < 8; ++s) {
          if (U_FP4) { ua[s] = *(const u32x4*)(ur + 16 * (4 * s + g)); ub[s] = (u32x2){0u, 0u}; }
          else { ua[s] = *(const u32x4*)(ur + 24 * (4 * s + g)); ub[s] = *(const u32x2*)(ur + 24 * (4 * s + g) + 16); }
        }
        const u32x2 usc = *(const u32x2*)(ur + (U_FP4 ? 512 : 768) + 8 * g);
        __builtin_amdgcn_sched_barrier(0);
        f32x4 acc = {0.f, 0.f, 0.f, 0.f};
#define G_STEP(s, OS, USC, HSC) do { const unsigned char* hb = hl + 24 * (4 * (s) + g); \
          const u32x2 h0 = *(const u32x2*)hb, h1 = *(const u32x2*)(hb + 8), h2v = *(const u32x2*)(hb + 16); \
          const i32x8 av = {(int)ua[s][0], (int)ua[s][1], (int)ua[s][2], (int)ua[s][3], (int)ub[s][0], (int)ub[s][1], 0, 0}; \
          const i32x8 bv = {(int)h0[0], (int)h0[1], (int)h1[0], (int)h1[1], (int)h2v[0], (int)h2v[1], 0, 0}; \
          acc = __builtin_amdgcn_mfma_scale_f32_16x16x128_f8f6f4(av, bv, acc, U_FP4 ? 4 : 2, 2, OS, (int)(USC), OS, (int)(HSC)); } while (0)
        G_STEP(0, 0, usc[0], hsc[0]); G_STEP(1, 1, usc[0], hsc[0]); G_STEP(2, 2, usc[0], hsc[0]); G_STEP(3, 3, usc[0], hsc[0]);
        G_STEP(4, 0, usc[1], hsc[1]); G_STEP(5, 1, usc[1], hsc[1]); G_STEP(6, 2, usc[1], hsc[1]); G_STEP(7, 3, usc[1], hsc[1]);
#undef G_STEP
        const float gvs = grp < 4 ? gv0 : gv1;
        const int lb_ = (grp & 3) * 16 + 4 * g;
        float4 wv_;
        wv_.x = __shfl(gvs, lb_) * gelu_tanh(acc[0]); wv_.y = __shfl(gvs, lb_ + 1) * gelu_tanh(acc[1]);
        wv_.z = __shfl(gvs, lb_ + 2) * gelu_tanh(acc[2]); wv_.w = __shfl(gvs, lb_ + 3) * gelu_tanh(acc[3]);
        if (lr == 0) *(float4*)(wl + grp * 16 + 4 * g) = wv_;
        __builtin_amdgcn_sched_barrier(0);
      }
    }
    __builtin_amdgcn_sched_barrier(0);
    float out[32];
#pragma unroll
    for (int i = 0; i < 32; ++i) out[i] = 0.f;
#pragma unroll 1
    for (int grp = 0; grp < 8; ++grp) {
      const int esel = grp < 4 ? e0 : e1;
      const int lb = (grp & 3) * 16;
      u32x4 vd4[8]; u32x2 vd2[8]; unsigned vsc[8];
#pragma unroll
      for (int pp = 0; pp < 8; ++pp) {
        const int ea = __builtin_amdgcn_readlane(esel, lb + 2 * pp), eb = __builtin_amdgcn_readlane(esel, lb + 2 * pp + 1);
        const unsigned char* vr = V6 + (size_t)(half ? eb : ea) * V_PITCH;
        if (V_FP4) { vd4[pp] = *(const u32x4*)(vr + 16 * blk); vd2[pp] = (u32x2){0u, 0u}; vsc[pp] = vr[mx4_scale_pos(blk)]; }
        else { vd4[pp] = *(const u32x4*)(vr + 24 * blk); vd2[pp] = *(const u32x2*)(vr + 24 * blk + 16); vsc[pp] = vr[mx_scale_pos(blk)]; }
      }
      __builtin_amdgcn_sched_barrier(0);
#pragma unroll
      for (int pp = 0; pp < 8; ++pp) {
        const float wgt = wl[grp * 16 + 2 * pp + half] * __uint_as_float(vsc[pp] << 23);
        if (V_FP4) {
          unsigned q0 = vd4[pp][0], q1 = vd4[pp][1], q2 = vd4[pp][2], q3 = vd4[pp][3];
          asm volatile("" : "+v"(q0), "+v"(q1) : "v"(out[0]), "v"(out[1]), "v"(out[2]), "v"(out[3]), "v"(out[4]), "v"(out[5]), "v"(out[6]), "v"(out[7]),
                       "v"(out[8]), "v"(out[9]), "v"(out[10]), "v"(out[11]), "v"(out[12]), "v"(out[13]), "v"(out[14]), "v"(out[15]));
          asm volatile("" : "+v"(q2), "+v"(q3) : "v"(out[16]), "v"(out[17]), "v"(out[18]), "v"(out[19]), "v"(out[20]), "v"(out[21]), "v"(out[22]), "v"(out[23]),
                       "v"(out[24]), "v"(out[25]), "v"(out[26]), "v"(out[27]), "v"(out[28]), "v"(out[29]), "v"(out[30]), "v"(out[31]));
          const u32x4 qd = {q0, q1, q2, q3};
#pragma unroll
          for (int d = 0; d < 4; ++d) {
            const f32x2 t0 = __builtin_amdgcn_cvt_scalef32_pk_f32_fp4(qd[d], 1.0f, 0), t1 = __builtin_amdgcn_cvt_scalef32_pk_f32_fp4(qd[d], 1.0f, 1);
            const f32x2 t2 = __builtin_amdgcn_cvt_scalef32_pk_f32_fp4(qd[d], 1.0f, 2), t3 = __builtin_amdgcn_cvt_scalef32_pk_f32_fp4(qd[d], 1.0f, 3);
            out[8 * d + 0] += wgt * t0[0]; out[8 * d + 1] += wgt * t0[1]; out[8 * d + 2] += wgt * t1[0]; out[8 * d + 3] += wgt * t1[1];
            out[8 * d + 4] += wgt * t2[0]; out[8 * d + 5] += wgt * t2[1]; out[8 * d + 6] += wgt * t3[0]; out[8 * d + 7] += wgt * t3[1];
          }
        } else {
          unsigned pk0 = vd4[pp][0], pk1 = vd4[pp][1];
          asm volatile("" : "+v"(pk0) : "v"(out[0]), "v"(out[1]), "v"(out[2]), "v"(out[3]), "v"(out[4]), "v"(out[5]), "v"(out[6]), "v"(out[7]),
                       "v"(out[8]), "v"(out[9]), "v"(out[10]), "v"(out[11]), "v"(out[12]), "v"(out[13]), "v"(out[14]), "v"(out[15]));
          asm volatile("" : "+v"(pk1) : "v"(out[16]), "v"(out[17]), "v"(out[18]), "v"(out[19]), "v"(out[20]), "v"(out[21]), "v"(out[22]), "v"(out[23]),
                       "v"(out[24]), "v"(out[25]), "v"(out[26]), "v"(out[27]), "v"(out[28]), "v"(out[29]), "v"(out[30]), "v"(out[31]));
          const u32x6 pk = {pk0, pk1, vd4[pp][2], vd4[pp][3], vd2[pp][0], vd2[pp][1]};
          const f32x32 vals = __builtin_amdgcn_cvt_scalef32_pk32_f32_fp6(pk, 1.0f);
  #pragma unroll
          for (int i = 0; i < 32; ++i) out[i] += wgt * vals[i];
        }
        __builtin_amdgcn_sched_barrier(0);
      }
    }
    float o16[16];
#pragma unroll
    for (int i = 0; i < 16; ++i) {
      const u32x2 s0 = __builtin_amdgcn_permlane32_swap(__float_as_uint(out[i]), __float_as_uint(out[i]), false, false);
      const u32x2 s1 = __builtin_amdgcn_permlane32_swap(__float_as_uint(out[16 + i]), __float_as_uint(out[16 + i]), false, false);
      const float t0 = __uint_as_float(s0[0]) + __uint_as_float(s0[1]), t1 = __uint_as_float(s1[0]) + __uint_as_float(s1[1]);
      o16[i] = half ? t1 : t0;
    }
    const int cb = 32 * blk + 16 * half;
    const int b = t < TL ? (t >> 11) : 16;
    const float* md = modbuf + ((size_t)l * 17 + b) * 6144 + 5 * 1024 + cb;
    bf16_t* xr = xres + (size_t)t * 1024 + cb;
    float xn[16];
    float ss = 0.f;
    {
      const u32x4 r0 = *(const u32x4*)xr, r1 = *(const u32x4*)(xr + 8);
      unpack8(r0, xn); unpack8(r1, xn + 8);
    }
    unsigned xp[8];
#pragma unroll
    for (int q = 0; q < 4; ++q) {
      const float4 m4 = *(const float4*)(md + 4 * q);
      xn[4 * q] += m4.x * o16[4 * q + 0]; xn[4 * q + 1] += m4.y * o16[4 * q + 1]; xn[4 * q + 2] += m4.z * o16[4 * q + 2]; xn[4 * q + 3] += m4.w * o16[4 * q + 3];
      ss += xn[4 * q] * xn[4 * q] + xn[4 * q + 1] * xn[4 * q + 1] + xn[4 * q + 2] * xn[4 * q + 2] + xn[4 * q + 3] * xn[4 * q + 3];
      xp[2 * q] = pk2(xn[4 * q], xn[4 * q + 1]); xp[2 * q + 1] = pk2(xn[4 * q + 2], xn[4 * q + 3]);
    }
    if (dry) asm volatile("" :: "v"(xp[0]), "v"(xp[7]));
    else if (l < NL - 1) { *(u32x4*)xr = (u32x4){xp[0], xp[1], xp[2], xp[3]}; *(u32x4*)(xr + 8) = (u32x4){xp[4], xp[5], xp[6], xp[7]}; }
    if (!dry) {
      ss = wave_sum(ss);
      const float rstd = rsqrtf(ss * (1.f / 1024.f) + 1e-6f);
      if (l == NL - 1) {
        const float* fg = p.final_g + cb;
        float* orow = p.out + (size_t)t * 1024 + cb;
#pragma unroll
        for (int q = 0; q < 4; ++q) {
          const float4 g4 = *(const float4*)(fg + 4 * q);
          float4 o = {xn[4 * q] * rstd * g4.x, xn[4 * q + 1] * rstd * g4.y, xn[4 * q + 2] * rstd * g4.z, xn[4 * q + 3] * rstd * g4.w};
          *(float4*)(orow + 4 * q) = o;
        }
      } else {
        const float* gvec = p.norm1_g + (l + 1) * 1024 + cb;
        const float* mdn = modbuf + ((size_t)(l + 1) * 17 + b) * 6144 + cb;
        bf16_t* hrow = (bf16_t*)(p.ws + OFF_H) + (size_t)t * 1024 + cb;
        unsigned pk[8];
#pragma unroll
        for (int q = 0; q < 4; ++q) {
          const float4 g4 = *(const float4*)(gvec + 4 * q), sh = *(const float4*)(mdn + 4 * q), sc = *(const float4*)(mdn + 1024 + 4 * q);
          const float o0 = xn[4 * q] * rstd * g4.x * (1.f + sc.x) + sh.x, o1 = xn[4 * q + 1] * rstd * g4.y * (1.f + sc.y) + sh.y;
          const float o2 = xn[4 * q + 2] * rstd * g4.z * (1.f + sc.z) + sh.z, o3 = xn[4 * q + 3] * rstd * g4.w * (1.f + sc.w) + sh.w;
          pk[2 * q] = pk2(o0, o1); pk[2 * q + 1] = pk2(o2, o3);
        }
        *(u32x4*)hrow = (u32x4){pk[0], pk[1], pk[2], pk[3]};
        *(u32x4*)(hrow + 8) = (u32x4){pk[4], pk[5], pk[6], pk[7]};
      }
    }
  }
}


DI void phase_topk_gather(const Params& p, int l, int ntok, unsigned* ctr, unsigned char* lds, bool dry = false) {
  const int tid = ltid(), lane = tid & 63, w = tid >> 6, lr = lane & 15, g = lane >> 4;
  const bf16_t* QP = (const bf16_t*)(p.ws + OFF_QP);
  const bf16_t* sk = (const bf16_t*)(p.ws + OFF_SK) + (size_t)l * 2 * 128 * 64;
  int* eid_l = (int*)lds;
  float* gate_l = (float*)(lds + 8192);
  unsigned char* hl = lds + 16384 + w * 2048;
  float* wl = (float*)(hl + 1024);
  volatile int* slot = (volatile int*)(lds + LDS_BYTES - 16);
  const int ntile = ntok / 16;
  for (;;) {
    __syncthreads();
    if (tid == 0) *slot = (int)atomicAdd(ctr, 1u);
    __syncthreads();
    const int tile = *slot;
    if (tile >= ntile) break;
#pragma unroll 1
    for (int hh = 0; hh < 2; ++hh) {
      topk_tile(QP, sk, tile, 2 * w + hh, eid_l, gate_l, lr, g);
      __builtin_amdgcn_sched_barrier(0);
    }
    __syncthreads();
#pragma unroll 1
    for (int q = 0; q < 4; ++q) {
      const int r = 4 * w + q;
      gather_token(p, l, tile * 16 + r, eid_l + r * 128, gate_l + r * 128, hl, wl, dry);
    }
  }
}

DI void phase_final(const Params& p) {
  const int lane = ltid() & 63, gw = lbid() * 4 + (ltid() >> 6), nw = lgdim() * 4;
  const float* xres = (const float*)(p.ws + OFF_XRES);
  for (int t = gw; t < TL; t += nw) {
    const float* src = xres + (size_t)t * 1024;
    float4 v[4];
    float ss = 0.f;
#pragma unroll
    for (int i = 0; i < 4; ++i) {
      v[i] = *(const float4*)(src + 4 * lane + 256 * i);
      ss += v[i].x * v[i].x + v[i].y * v[i].y + v[i].z * v[i].z + v[i].w * v[i].w;
    }
    ss = wave_sum(ss);
    const float rstd = rsqrtf(ss * (1.f / 1024.f) + 1e-6f);
#pragma unroll
    for (int i = 0; i < 4; ++i) {
      const int col = 4 * lane + 256 * i;
      const float4 g4 = *(const float4*)(p.final_g + col);
      float4 o = {v[i].x * rstd * g4.x, v[i].y * rstd * g4.y, v[i].z * rstd * g4.z, v[i].w * rstd * g4.w};
      *(float4*)(p.out + (size_t)t * 1024 + col) = o;
    }
  }
}


#define LAS __attribute__((address_space(3)))
#define XB_TMO      128
#define XB_XCNT(j)  (256  + 64 * (j))
#define XB_XSUB(j)  (1280 + 64 * (j))
#define XB_XGEN(j)  (2304 + 64 * (j))
#define XB_TOP      3328
#define XB_TOPGEN   3392
#define XCD_BAR_WORDS 3456
#define XB_SPIN_CAP (1u << 22)
DI unsigned xb_ld(unsigned* p) { return __hip_atomic_load(p, __ATOMIC_RELAXED, __HIP_MEMORY_SCOPE_AGENT); }
DI unsigned xb_add(unsigned* p, unsigned v) { return __hip_atomic_fetch_add(p, v, __ATOMIC_RELAXED, __HIP_MEMORY_SCOPE_AGENT); }
DI unsigned xb_xcc_id() { return (unsigned)__builtin_amdgcn_s_getreg((3 << 11) | 20) & 0xFu; }
#define XB_SPIN(cond, bar) do { unsigned _sp = 0; while (cond) { __builtin_amdgcn_s_sleep(1); \
    if ((++_sp & 255u) == 0u) { if (xb_ld(&(bar)[XB_TMO])) break; if (_sp > XB_SPIN_CAP) { atomicAdd(&(bar)[XB_TMO], 1u); break; } } } } while (0)
struct XcdBarrier { unsigned* bar; unsigned x; volatile unsigned* st; };
DI XcdBarrier xcd_barrier_post(unsigned* bar, volatile unsigned* st) {
  XcdBarrier b; b.bar = bar; b.x = xb_xcc_id(); b.st = st;
  if (threadIdx.x == 0) (void)xb_add(&bar[XB_XCNT(b.x)], 1u);
  return b;
}
DI void xcd_barrier_complete(unsigned* bar, unsigned x, unsigned& nloc, unsigned& nx) {
  const unsigned G = gridDim.x * gridDim.y * gridDim.z;
  unsigned sum, cnt, mine, sp = 0u;
  for (;;) {
    sum = 0u; cnt = 0u; mine = 0u;
#pragma unroll 1
    for (unsigned j = 0; j < 16; ++j) { const unsigned c = xb_ld(&bar[XB_XCNT(j)]); sum += c; cnt += (c > 0u) ? 1u : 0u; mine = (j == x) ? c : mine; }
    if (sum == G) break;
    __builtin_amdgcn_s_sleep(1);
    if ((++sp & 255u) == 0u) { if (xb_ld(&bar[XB_TMO])) break; if (sp > XB_SPIN_CAP) { atomicAdd(&bar[XB_TMO], 1u); break; } }
  }
  nloc = mine > 0u ? mine : 1u; nx = cnt > 0u ? cnt : 1u;
}
DI void xcd_barrier(const XcdBarrier& b) {
  asm volatile("s_waitcnt vmcnt(0)" ::: "memory");
  __syncthreads();
  if (threadIdx.x == 0) {
    unsigned* bar = b.bar;
    __builtin_amdgcn_s_waitcnt(0);
    unsigned nloc = b.st[0], nx = b.st[1];
    if (nloc == 0u) { xcd_barrier_complete(bar, b.x, nloc, nx); b.st[0] = nloc; b.st[1] = nx; }
    const unsigned old = xb_add(&bar[XB_XSUB(b.x)], 1u);
    const unsigned gen = old / nloc;
    if (old + 1u == (gen + 1u) * nloc) {
      __builtin_amdgcn_fence(__ATOMIC_RELEASE, "agent");
      asm volatile("s_waitcnt vmcnt(0)" ::: "memory");
      const unsigned og = xb_add(&bar[XB_TOP], 1u);
      const unsigned tg = og / nx;
      if (og + 1u == (tg + 1u) * nx) xb_add(&bar[XB_TOPGEN], 1u);
      else XB_SPIN(xb_ld(&bar[XB_TOPGEN]) == tg, bar);
      __builtin_amdgcn_fence(__ATOMIC_ACQUIRE, "agent");
      xb_add(&bar[XB_XGEN(b.x)], 1u);
      asm volatile("s_waitcnt vmcnt(0)" ::: "memory");
    } else {
      XB_SPIN(xb_ld(&bar[XB_XGEN(b.x)]) == gen, bar);
      __builtin_amdgcn_fence(__ATOMIC_ACQUIRE, "agent");
      asm volatile("s_waitcnt vmcnt(0)" ::: "memory");
    }
  }
  __syncthreads();
}

constexpr int PH_PER_LAYER = 10;
constexpr int N_PHASES = 1 + NL * PH_PER_LAYER + 1;

template <int KIND>
DI void run_phase(const Params& p, int ph, unsigned char* lds) {
  unsigned* ctl = (unsigned*)(p.ws + OFF_CTL);
  if (ph == 0) { if (KIND < 0 || KIND == 0) phase_prologue(p, lds); }
  else if (ph == N_PHASES - 1) { if (KIND < 0 || KIND == 11) phase_final(p); }
  else {
    const int l = (ph - 1) / PH_PER_LAYER, s = (ph - 1) % PH_PER_LAYER;
    const bool last = (l == NL - 1);
    const int ntok = last ? TL : TT;
    if (s == 0) { if (KIND < 0 || KIND == 1) phase_norm(p, l, 0, TT); }
    else if (s == 1) { if (KIND < 0 || KIND == 2) phase_gemm_in(p, l, lds); }
    else if (s == 2) { if (KIND < 0 || KIND == 3) phase_rope(p, lds); }
    else if (s == 3) { if (KIND < 0 || KIND == 4) phase_mixers(p, l, last, ctl + 64 * (1 + l), lds); }
    else if (s == 4) { if (KIND < 0 || KIND == 5) phase_gla_fin(p, l, ntok); }
    else if (s == 5) { if (KIND < 0 || KIND == 6) phase_gemm_out(p, l, ntok, lds); }
    else if (s == 6) { if (KIND < 0 || KIND == 7) phase_norm(p, l, 1, ntok); }
    else if (s == 7) { if (KIND < 0 || KIND == 8) phase_gemm_q(p, l, ntok, lds); }
    else if (s == 8) { }
    else { if (KIND < 0 || KIND == 10) phase_topk_gather(p, l, ntok, (unsigned*)(p.ws + OFF_CTL) + 64 * (8 + l), lds); }
  }
}

#if N_LAUNCH_MODE == 1
#ifndef PROBE_KIND
#define PROBE_KIND -1
#endif
#ifndef GLA_VAR
#define GLA_VAR 0
#endif
constexpr int CW_BAR = 4096;
template <int l>
DI void run_layer(const Params& p, unsigned char* lds) {
  unsigned* ctl = (unsigned*)(p.ws + OFF_CTL);
#define GSYNC() do { XcdBarrier bb; bb.bar = (unsigned*)(p.ws + OFF_CTL) + CW_BAR; bb.x = xb_xcc_id(); bb.st = (volatile unsigned*)(lds + LDS_BYTES - 32); xcd_barrier(bb); } while (0)

    const bool last = (l == NL - 1);
    const int ntok = last ? TL : TT;
    if (l == 0) { { Params q = p; { size_t z_ = 0; asm volatile("" : "+s"(z_)); q.ws = p.ws + z_; } phase_norm(q, l, 0, TT); } GSYNC(); }
    if (PROBE_KIND == 1) { { Params q = p; { size_t z_ = 0; asm volatile("" : "+s"(z_)); q.ws = p.ws + z_; } phase_norm(q, l, 0, TT); } GSYNC(); }
    if (PROBE_KIND == 2) { { Params q = p; { size_t z_ = 0; asm volatile("" : "+s"(z_)); q.ws = p.ws + z_; } phase_gemm_in(q, l, lds, true); } GSYNC(); }
    { Params q = p; { size_t z_ = 0; asm volatile("" : "+s"(z_)); q.ws = p.ws + z_; } phase_gemm_in(q, l, lds); } GSYNC();
    if (PROBE_KIND == 4 || (PROBE_KIND >= 41 && PROBE_KIND <= 47)) { { Params q = p; { size_t z_ = 0; asm volatile("" : "+s"(z_)); q.ws = p.ws + z_; } phase_mixers(q, l, last, ctl + 64 * (1 + l) + 1, lds, PROBE_KIND == 4 ? 15 : PROBE_KIND - 40, GLA_VAR); } GSYNC(); }
    { Params q = p; { size_t z_ = 0; asm volatile("" : "+s"(z_)); q.ws = p.ws + z_; } phase_mixers(q, l, last, ctl + 64 * (1 + l), lds); } GSYNC();
    { Params q = p; { size_t z_ = 0; asm volatile("" : "+s"(z_)); q.ws = p.ws + z_; } phase_gla_fin(q, l, ntok); } GSYNC();
    if (PROBE_KIND == 5) { { Params q = p; { size_t z_ = 0; asm volatile("" : "+s"(z_)); q.ws = p.ws + z_; } phase_gla_fin(q, l, ntok); } GSYNC(); }
    { Params q = p; { size_t z_ = 0; asm volatile("" : "+s"(z_)); q.ws = p.ws + z_; } phase_gemm_out(q, l, ntok, lds); } GSYNC();
    { Params q = p; { size_t z_ = 0; asm volatile("" : "+s"(z_)); q.ws = p.ws + z_; } phase_norm2(q, l, ntok); } GSYNC();
    if (PROBE_KIND == 7) { { Params q = p; { size_t z_ = 0; asm volatile("" : "+s"(z_)); q.ws = p.ws + z_; } phase_norm2(q, l, ntok); } GSYNC(); }
    { Params q = p; { size_t z_ = 0; asm volatile("" : "+s"(z_)); q.ws = p.ws + z_; } phase_gemm_q(q, l, ntok, lds); } GSYNC();
    if (PROBE_KIND == 8) { { Params q = p; { size_t z_ = 0; asm volatile("" : "+s"(z_)); q.ws = p.ws + z_; } phase_gemm_q(q, l, ntok, lds); } GSYNC(); }
    if (PROBE_KIND == 11) { { Params q = p; { size_t z_ = 0; asm volatile("" : "+s"(z_)); q.ws = p.ws + z_; } phase_topk_gather(q, l, ntok, ctl + 64 * (8 + l) + 1, lds, true); } GSYNC(); }
    { Params q = p; { size_t z_ = 0; asm volatile("" : "+s"(z_)); q.ws = p.ws + z_; } phase_topk_gather(q, l, ntok, ctl + 64 * (8 + l), lds); } if (l + 1 < NL) GSYNC();
}
__global__ void __launch_bounds__(256, 2) mk_fwd(Params p) {
  __shared__ __attribute__((aligned(16))) unsigned char lds[LDS_BYTES];
  unsigned* ctl = (unsigned*)(p.ws + OFF_CTL);
  volatile unsigned* st = (volatile unsigned*)(lds + LDS_BYTES - 32);
  if (threadIdx.x < 2) st[threadIdx.x] = 0u;
  __syncthreads();
  (void)xcd_barrier_post(ctl + CW_BAR, st);
#define GSYNC() do { XcdBarrier bb; bb.bar = (unsigned*)(p.ws + OFF_CTL) + CW_BAR; bb.x = xb_xcc_id(); bb.st = (volatile unsigned*)(lds + LDS_BYTES - 32); xcd_barrier(bb); } while (0)
  { Params q = p; { size_t z_ = 0; asm volatile("" : "+s"(z_)); q.ws = p.ws + z_; } phase_prologue(q, lds); } cg::this_grid().sync();
  if (PROBE_KIND == 0) { { Params q = p; { size_t z_ = 0; asm volatile("" : "+s"(z_)); q.ws = p.ws + z_; } phase_prologue(q, lds); } GSYNC(); }
  run_layer<0>(p, lds); run_layer<1>(p, lds); run_layer<2>(p, lds); run_layer<3>(p, lds);
}
#else
template <int KIND>
__global__ void __launch_bounds__(256, 2) mk_phase(Params p) {
  __shared__ __attribute__((aligned(16))) unsigned char lds[LDS_BYTES];
  run_phase<KIND>(p, p.ph_lo, lds);
}
#endif

extern "C" void kernel_launch(void* const* d_in, const int* in_sizes, int n_in, void* d_out, int out_size, void* d_ws,
                              size_t ws_size, hipStream_t stream) {
  static int grid = 0;
  if (grid == 0) {
    if (n_in != 21 || ws_size < WS_END || out_size != TL * DM) { fprintf(stderr, "kernel_launch: unexpected shapes (n_in %d ws %zu out %d)\n", n_in, ws_size, out_size); grid = -1; return; }
    int dev = 0, cus = 0, per_cu = 2;
    (void)hipGetDevice(&dev);
    (void)hipDeviceGetAttribute(&cus, hipDeviceAttributeMultiprocessorCount, dev);
#if N_LAUNCH_MODE == 1
    (void)hipOccupancyMaxActiveBlocksPerMultiprocessor(&per_cu, (const void*)mk_fwd, 256, 0);
    if (per_cu < 1) per_cu = 1;
    if (per_cu > 2) per_cu = 2;
#endif
    grid = cus * per_cu;
  }
  if (grid < 0) return;
  (void)hipMemsetAsync((char*)d_ws + OFF_CTL, 0, 65536, stream);
  Params p{};
  const float** pp = (const float**)&p;
  for (int i = 0; i < 21; ++i) pp[i] = (const float*)d_in[i];
  p.out = (float*)d_out;
  p.ws = (unsigned char*)d_ws;
#if N_LAUNCH_MODE == 1
  p.ph_lo = 0; p.ph_hi = N_PHASES;
  void* args[] = {&p};
  hipError_t e = hipLaunchCooperativeKernel((const void*)mk_fwd, dim3(grid), dim3(256), args, 0, stream);
  if (e != hipSuccess) fprintf(stderr, "cooperative launch failed: %s (grid %d)\n", hipGetErrorString(e), grid);
#else
  for (int ph = 0; ph < N_PHASES; ++ph) {
    p.ph_lo = ph; p.ph_hi = ph + 1;
    const int kind = ph == 0 ? 0 : (ph == N_PHASES - 1 ? 11 : 1 + (ph - 1) % PH_PER_LAYER);
    switch (kind) {
      case 0: hipLaunchKernelGGL(mk_phase<0>, dim3(grid), dim3(256), 0, stream, p); break;
      case 1: hipLaunchKernelGGL(mk_phase<1>, dim3(grid), dim3(256), 0, stream, p); break;
      case 2: hipLaunchKernelGGL(mk_phase<2>, dim3(grid), dim3(256), 0, stream, p); break;
      case 3: hipLaunchKernelGGL(mk_phase<3>, dim3(grid), dim3(256), 0, stream, p); break;
      case 4: hipLaunchKernelGGL(mk_phase<4>, dim3(grid), dim3(256), 0, stream, p); break;
      case 5: hipLaunchKernelGGL(mk_phase<5>, dim3(grid), dim3(256), 0, stream, p); break;
      case 6: hipLaunchKernelGGL(mk_phase<6>, dim3(grid), dim3(256), 0, stream, p); break;
      case 7: hipLaunchKernelGGL(mk_phase<7>, dim3(grid), dim3(256), 0, stream, p); break;
      case 8: hipLaunchKernelGGL(mk_phase<8>, dim3(grid), dim3(256), 0, stream, p); break;
      case 9: hipLaunchKernelGGL(mk_phase<9>, dim3(grid), dim3(256), 0, stream, p); break;
      case 10: hipLaunchKernelGGL(mk_phase<10>, dim3(grid), dim3(256), 0, stream, p); break;
      default: hipLaunchKernelGGL(mk_phase<11>, dim3(grid), dim3(256), 0, stream, p); break;
    }
  }
#endif
}
```

```cpp
#include <hip/hip_runtime.h>
#include <hip/hip_cooperative_groups.h>
#include <stdint.h>
#include <stdio.h>
namespace cg = cooperative_groups;

#ifndef N_LAUNCH_MODE
#define N_LAUNCH_MODE 1
#endif

#define DI __device__ __forceinline__
#ifndef GEMM_VAR
#define GEMM_VAR 0
#endif
typedef unsigned short bf16_t;
typedef short bf16x8 __attribute__((ext_vector_type(8)));
typedef float f32x4 __attribute__((ext_vector_type(4)));
typedef float f32x2 __attribute__((ext_vector_type(2)));
typedef float f32x16 __attribute__((ext_vector_type(16)));
typedef float f32x32 __attribute__((ext_vector_type(32)));
typedef unsigned u32x6 __attribute__((ext_vector_type(6)));
typedef int i32x8 __attribute__((ext_vector_type(8)));
typedef unsigned u32x4 __attribute__((ext_vector_type(4)));
typedef unsigned u32x2 __attribute__((ext_vector_type(2)));

constexpr int NB = 16, SEQ = 2048, DM = 1024, NL = 4, CTXL = 256;
constexpr int TL = NB * SEQ;
constexpr int TC = NB * CTXL;
constexpr int TT = TL + TC;
constexpr int PN_LD = 2176;
constexpr int C_GQ = 0, C_GK = 128, C_GR = 256, C_NQ = 512, C_NK = 768, C_DQ = 1024, C_DK = 1536, C_GATE = 2048;
constexpr int R_GV = 0, R_NV = 256, R_DV = 512;
constexpr float LOG2E = 1.4426950408889634f;
constexpr float SC_LOG2 = 0.125f * LOG2E;
constexpr float NEG_BIG = -1e30f;

constexpr size_t MiB = 1u << 20;
constexpr size_t OFF_CTL = 0;
constexpr size_t OFF_MOD = 1 * MiB;
constexpr size_t OFF_WIN = 3 * MiB;
constexpr size_t OFF_WOUT = 28 * MiB;
constexpr size_t OFF_WQ = 36 * MiB;
constexpr size_t OFF_SK = 44 * MiB;
constexpr size_t OFF_USCL = 44 * MiB + 256 * 1024;
constexpr size_t OFF_VSCL = 44 * MiB + 512 * 1024;
constexpr size_t OFF_U = 45 * MiB;
constexpr size_t OFF_V = 109 * MiB;
constexpr int V6_PITCH = 800;
#ifndef U_FP4
#define U_FP4 1
#endif
#ifndef V_FP4
#define V_FP4 1
#endif
constexpr int P4_PITCH = 544;
constexpr int U_PITCH = U_FP4 ? P4_PITCH : V6_PITCH, V_PITCH = V_FP4 ? P4_PITCH : V6_PITCH;
constexpr size_t OFF_XRES = 301 * MiB;
constexpr size_t OFF_H = 445 * MiB;
constexpr size_t OFF_P = 517 * MiB;
constexpr size_t OFF_VT = OFF_P + 153 * MiB;
constexpr size_t OFF_QP = OFF_P;
constexpr size_t OFF_EID = OFF_P + 72 * MiB;
constexpr size_t OFF_GATE = OFF_P + 90 * MiB;
constexpr size_t OFF_H8 = OFF_P + 126 * MiB;
constexpr size_t OFF_HINV = OFF_P + 162 * MiB;
constexpr size_t OFF_Y = 742 * MiB;
constexpr size_t WS_END = 814 * MiB;

constexpr int LDS_BYTES = 65536 + 8192;

struct Params {
  const float *x, *c, *ctx, *c_ctx, *ada_w, *ada_b, *norm1_g, *norm2_g, *w_in, *gate_up, *gate_b, *gla_norm_g,
      *rpb, *dlam, *diff_g, *w_out, *wq, *subkeys, *pu, *pv, *final_g;
  float* out;
  unsigned char* ws;
  int ph_lo, ph_hi;
};

DI int ltid() { int t = threadIdx.x; asm volatile("" : "+v"(t)); return t; }
DI int lbid() { int t = blockIdx.x; asm volatile("" : "+s"(t)); return t; }
DI int lgdim() { int t = gridDim.x; asm volatile("" : "+s"(t)); return t; }

DI unsigned f2bf(float f) { unsigned u = __float_as_uint(f); return (u + 0x7fffu + ((u >> 16) & 1u)) >> 16; }
typedef __bf16 bf16x2_t __attribute__((ext_vector_type(2)));
DI unsigned pk2(float lo, float hi) { f32x2 v = {lo, hi}; return __builtin_bit_cast(unsigned, __builtin_convertvector(v, bf16x2_t)); }
DI float bflo(unsigned u) { return __uint_as_float(u << 16); }
DI float bfhi(unsigned u) { return __uint_as_float(u & 0xffff0000u); }
DI void unpack8(const u32x4 v, float* f) {
  f[0] = bflo(v.x); f[1] = bfhi(v.x); f[2] = bflo(v.y); f[3] = bfhi(v.y);
  f[4] = bflo(v.z); f[5] = bfhi(v.z); f[6] = bflo(v.w); f[7] = bfhi(v.w);
}
DI float wave_sum(float v) {
#pragma unroll
  for (int o = 32; o >= 1; o >>= 1) v += __shfl_xor(v, o);
  return v;
}

DI float rows_max(float x) {
  unsigned u = __float_as_uint(x);
  u32x2 a = __builtin_amdgcn_permlane32_swap(u, u, false, false);
  const float m = fmaxf(__uint_as_float(a[0]), __uint_as_float(a[1]));
  unsigned v = __float_as_uint(m);
  u32x2 b = __builtin_amdgcn_permlane16_swap(v, v, false, false);
  return fmaxf(__uint_as_float(b[0]), __uint_as_float(b[1]));
}
DI float rows_sum(float x) {
  unsigned u = __float_as_uint(x);
  u32x2 a = __builtin_amdgcn_permlane32_swap(u, u, false, false);
  const float m = __uint_as_float(a[0]) + __uint_as_float(a[1]);
  unsigned v = __float_as_uint(m);
  u32x2 b = __builtin_amdgcn_permlane16_swap(v, v, false, false);
  return __uint_as_float(b[0]) + __uint_as_float(b[1]);
}

DI u32x6 mxfp6_pack32(float (&x)[32], unsigned& sbyte) {
  float am = 0.f;
#pragma unroll
  for (int i = 0; i < 32; ++i) am = fmaxf(am, fabsf(x[i]));
  const unsigned ab = __float_as_uint(am);
  int e = am > 0.f ? (int)(ab >> 23) - 127 - 2 + ((ab & 0x7fffffu) > 0x700000u ? 1 : 0) : -126;
  e = e < -126 ? -126 : (e > 127 ? 127 : e);
  const float sc = __uint_as_float((unsigned)(127 - e) << 23);
  f32x16 lo, hi;
#pragma unroll
  for (int i = 0; i < 16; ++i) { lo[i] = x[2 * i] * sc; hi[i] = x[2 * i + 1] * sc; }
  sbyte = (unsigned)(127 + e);
  return __builtin_amdgcn_cvt_scalef32_2xpk16_fp6_f32(lo, hi, 1.0f);
}

DI u32x4 mxfp4_pack32(float (&x)[32], unsigned& sbyte) {
  float am = 0.f;
#pragma unroll
  for (int i = 0; i < 32; ++i) am = fmaxf(am, fabsf(x[i]));
  const unsigned ab = __float_as_uint(am);
  int e = am > 0.f ? (int)(ab >> 23) - 127 - 2 + ((ab & 0x7fffffu) > 0x400000u ? 1 : 0) : -126;
  e = e < -126 ? -126 : (e > 127 ? 127 : e);
  const float sc = __uint_as_float((unsigned)(127 - e) << 23);
  sbyte = (unsigned)(127 + e);
  u32x4 q;
#pragma unroll
  for (int d = 0; d < 4; ++d) {
    unsigned v = 0;
    v = __builtin_amdgcn_cvt_scalef32_pk_fp4_f32(v, x[8 * d + 0] * sc, x[8 * d + 1] * sc, 1.0f, 0);
    v = __builtin_amdgcn_cvt_scalef32_pk_fp4_f32(v, x[8 * d + 2] * sc, x[8 * d + 3] * sc, 1.0f, 1);
    v = __builtin_amdgcn_cvt_scalef32_pk_fp4_f32(v, x[8 * d + 4] * sc, x[8 * d + 5] * sc, 1.0f, 2);
    v = __builtin_amdgcn_cvt_scalef32_pk_fp4_f32(v, x[8 * d + 6] * sc, x[8 * d + 7] * sc, 1.0f, 3);
    q[d] = v;
  }
  return q;
}
DI int mx4_scale_pos(int blk) { return 512 + (blk & 3) * 8 + (blk >> 2); }
DI int mx_scale_pos(int blk) { return 768 + (blk & 3) * 8 + (blk >> 2); }
DI f32x4 mfma16(bf16x8 a, bf16x8 b, f32x4 c) { return __builtin_amdgcn_mfma_f32_16x16x32_bf16(a, b, c, 0, 0, 0); }

DI int win_src_col(int r) {
  if (r < 256) return r;
  if (r < 512) return r - 256 + 512;
  if (r < 768) return r - 512 + 800;
  if (r < 1024) return r - 768 + 1056;
  if (r < 1536) return r - 1024 + 1568;
  if (r < 2048) return r - 1536 + 2080;
  if (r < 2080) return r - 2048 + 768;
  if (r < 2176) return -1;
  if (r < 2432) return r - 2176 + 256;
  if (r < 2688) return r - 2432 + 1312;
  return r - 2688 + 2592;
}

DI void transpose_item(const float* __restrict__ W, int N, int src, bf16_t* __restrict__ dst, float* lds) {
  const int tid = ltid();
  for (int kc = 0; kc < 8; ++kc) {
    __syncthreads();
#pragma unroll
    for (int i = 0; i < 16; ++i) {
      int k = i * 8 + (tid >> 5), n = tid & 31;
      lds[k * 33 + n] = (src < 0) ? 0.f : W[(size_t)(kc * 128 + k) * N + src + n];
    }
    __syncthreads();
    int row = tid >> 3, k0 = (tid & 7) * 16;
    unsigned o[8];
#pragma unroll
    for (int e = 0; e < 8; ++e) o[e] = pk2(lds[(k0 + 2 * e) * 33 + row], lds[(k0 + 2 * e + 1) * 33 + row]);
    u32x4 a = {o[0], o[1], o[2], o[3]}, b = {o[4], o[5], o[6], o[7]};
    bf16_t* d = dst + (size_t)row * 1024 + kc * 128 + k0;
    *(u32x4*)d = a; *(u32x4*)(d + 8) = b;
  }
}

DI void convert_table_pairs(const Params& p, int pr0, int pr1, int wave, int nwave, int lane) {
  for (int pr = pr0 + __builtin_amdgcn_readfirstlane(wave); pr < pr1; pr += nwave) {
    const int tab = pr >= NL * 16384 / 2, pq = tab ? pr - NL * 16384 / 2 : pr;
    const int r = 2 * pq + (lane >> 5), blk = lane & 31;
    const float* src = (tab ? p.pv : p.pu) + (size_t)r * 1024 + 32 * blk;
    float x[32];
#pragma unroll
    for (int i = 0; i < 8; ++i) { const float4 a = *(const float4*)(src + 4 * i); x[4 * i] = a.x; x[4 * i + 1] = a.y; x[4 * i + 2] = a.z; x[4 * i + 3] = a.w; }
    unsigned sb;
    if (tab ? V_FP4 : U_FP4) {
      const u32x4 q = mxfp4_pack32(x, sb);
      unsigned char* row = p.ws + (tab ? OFF_V : OFF_U) + (size_t)r * P4_PITCH;
      *(u32x4*)(row + 16 * blk) = q;
      row[mx4_scale_pos(blk)] = (unsigned char)sb;
    } else {
      const u32x6 q = mxfp6_pack32(x, sb);
      unsigned char* row = p.ws + (tab ? OFF_V : OFF_U) + (size_t)r * V6_PITCH;
      *(u32x2*)(row + 24 * blk) = (u32x2){q[0], q[1]};
      *(u32x2*)(row + 24 * blk + 8) = (u32x2){q[2], q[3]};
      *(u32x2*)(row + 24 * blk + 16) = (u32x2){q[4], q[5]};
      row[mx_scale_pos(blk)] = (unsigned char)sb;
    }
  }
}

DI void phase_prologue(const Params& p, unsigned char* lds) {
  const int tid = ltid(), nb = lgdim(), bid = lbid();
  bf16_t* winT = (bf16_t*)(p.ws + OFF_WIN);
  bf16_t* woutT = (bf16_t*)(p.ws + OFF_WOUT);
  bf16_t* wqT = (bf16_t*)(p.ws + OFF_WQ);
  constexpr int PER_LAYER = 100 + 32 + 32;
  for (int item = bid; item < NL * PER_LAYER; item += nb) {
    int l = item / PER_LAYER, r = item % PER_LAYER;
    if (r < 100) {
      int row = r * 32;
      transpose_item(p.w_in + (size_t)l * 1024 * 3104, 3104, win_src_col(row), winT + ((size_t)l * 3200 + row) * 1024, (float*)lds);
    } else if (r < 132) {
      int row = (r - 100) * 32;
      transpose_item(p.w_out + (size_t)l * 1024 * 1024, 1024, row, woutT + ((size_t)l * 1024 + row) * 1024, (float*)lds);
    } else {
      int row = (r - 132) * 32;
      transpose_item(p.wq + (size_t)l * 1024 * 1024, 1024, row, wqT + ((size_t)l * 1024 + row) * 1024, (float*)lds);
    }
  }
  {
    bf16_t* sk = (bf16_t*)(p.ws + OFF_SK);
    for (int i = bid * 256 + tid; i < NL * 2 * 128 * 64; i += nb * 256) sk[i] = (bf16_t)f2bf(p.subkeys[i]);
  }
  {
    float* modbuf = (float*)(p.ws + OFF_MOD);
    float* sc = (float*)lds;
    float* red = (float*)(lds + 17 * 512 * 4);
    for (int item = bid; item < NL * 96; item += nb) {
      const int l = item / 96, cb = item % 96, col = cb * 64 + (tid & 63), kq = tid >> 6;
      float acc[17];
#pragma unroll
      for (int r = 0; r < 17; ++r) acc[r] = 0.f;
      for (int half = 0; half < 2; ++half) {
        __syncthreads();
        for (int e = tid; e < 17 * 512; e += 256) {
          int r = e >> 9, k = e & 511;
          float cv = (r < 16) ? p.c[r * 1024 + half * 512 + k] : p.c_ctx[half * 512 + k];
          sc[e] = cv / (1.f + __expf(-cv));
        }
        __syncthreads();
        const float* wp = p.ada_w + ((size_t)l * 1024 + half * 512 + kq * 128) * 6144 + col;
        for (int kk = 0; kk < 128; ++kk) {
          const float w = wp[(size_t)kk * 6144];
#pragma unroll
          for (int r = 0; r < 17; ++r) acc[r] += sc[r * 512 + kq * 128 + kk] * w;
        }
      }
#pragma unroll
      for (int r = 0; r < 17; ++r) red[(kq * 17 + r) * 64 + (tid & 63)] = acc[r];
      __syncthreads();
      for (int e = tid; e < 17 * 64; e += 256) {
        int r = e >> 6, cc = e & 63;
        float s = red[(0 * 17 + r) * 64 + cc] + red[(1 * 17 + r) * 64 + cc] + red[(2 * 17 + r) * 64 + cc] + red[(3 * 17 + r) * 64 + cc];
        int colg = cb * 64 + cc;
        modbuf[((size_t)l * 17 + r) * 6144 + colg] = s + p.ada_b[l * 6144 + colg];
      }
      __syncthreads();
    }
  }
}

DI void phase_norm(const Params& p, int l, int which, int ntok) {
  const int lane = ltid() & 63, gw = lbid() * 4 + (ltid() >> 6), nw = lgdim() * 4;
  const float* gvec = (which == 0 ? p.norm1_g : p.norm2_g) + l * 1024;
  const int ish = which == 0 ? 0 : 3, isc = which == 0 ? 1 : 4;
  const float* xres = (const float*)(p.ws + OFF_XRES);
  const float* modbuf = (const float*)(p.ws + OFF_MOD);
  bf16_t* hbuf = (bf16_t*)(p.ws + OFF_H);
  for (int t = gw; t < ntok; t += nw) {
    const float* src = (which == 0 && l == 0) ? (t < TL ? p.x + (size_t)t * 1024 : p.ctx + (size_t)(t - TL) * 1024) : xres + (size_t)t * 1024;
    const int b = t < TL ? (t >> 11) : 16;
    const float* md = modbuf + ((size_t)l * 17 + b) * 6144;
    float4 v[4];
    float ss = 0.f;
#pragma unroll
    for (int i = 0; i < 4; ++i) {
      v[i] = *(const float4*)(src + 4 * lane + 256 * i);
      ss += v[i].x * v[i].x + v[i].y * v[i].y + v[i].z * v[i].z + v[i].w * v[i].w;
    }
    ss = wave_sum(ss);
    const float rstd = rsqrtf(ss * (1.f / 1024.f) + 1e-6f);
    float am = 0.f;
#pragma unroll
    for (int i = 0; i < 4; ++i) {
      const int col = 4 * lane + 256 * i;
      const float4 g4 = *(const float4*)(gvec + col), sh = *(const float4*)(md + ish * 1024 + col), sc = *(const float4*)(md + isc * 1024 + col);
      float o0 = v[i].x * rstd * g4.x * (1.f + sc.x) + sh.x;
      float o1 = v[i].y * rstd * g4.y * (1.f + sc.y) + sh.y;
      float o2 = v[i].z * rstd * g4.z * (1.f + sc.z) + sh.z;
      float o3 = v[i].w * rstd * g4.w * (1.f + sc.w) + sh.w;
      u32x2 o = {pk2(o0, o1), pk2(o2, o3)};
      *(u32x2*)(hbuf + (size_t)t * 1024 + col) = o;
      v[i].x = o0; v[i].y = o1; v[i].z = o2; v[i].w = o3;
      am = fmaxf(am, fmaxf(fmaxf(fabsf(o0), fabsf(o1)), fmaxf(fabsf(o2), fabsf(o3))));
    }
  }
}

DI void phase_norm2(const Params& p, int l, int ntok) {
  const int lane = ltid() & 63, gw = lbid() * 4 + (ltid() >> 6), nw = lgdim() * 4;
  const int half = lane >> 5, blk = lane & 31;
  const float* gvec = p.norm2_g + l * 1024 + 32 * blk;
  const bf16_t* xres = (const bf16_t*)(p.ws + OFF_XRES);
  const float* modbuf = (const float*)(p.ws + OFF_MOD);
  bf16_t* hbuf = (bf16_t*)(p.ws + OFF_H);
  unsigned char* h6 = p.ws + OFF_H8;
  const int npair = ntok / 2, chunk = (npair + nw - 1) / nw;
  int pr = gw * chunk;
  const int pend = (pr + chunk) < npair ? (pr + chunk) : npair;
  float4 av[8], shv[8];
  int bcur = -1;
  u32x4 xa[4];
  if (pr < pend) {
    const bf16_t* src = xres + (size_t)(2 * pr + half) * 1024 + 32 * blk;
#pragma unroll
    for (int i = 0; i < 4; ++i) xa[i] = *(const u32x4*)(src + 8 * i);
  }
  for (; pr < pend; ++pr) {
    const int t = 2 * pr + half;
    const int b = __builtin_amdgcn_readfirstlane(t < TL ? (t >> 11) : 16);
    if (b != bcur) {
      const float* md = modbuf + ((size_t)l * 17 + b) * 6144 + 32 * blk;
#pragma unroll
      for (int i = 0; i < 8; ++i) {
        const float4 g4 = *(const float4*)(gvec + 4 * i), sc = *(const float4*)(md + 4 * 1024 + 4 * i);
        shv[i] = *(const float4*)(md + 3 * 1024 + 4 * i);
        av[i] = (float4){g4.x * (1.f + sc.x), g4.y * (1.f + sc.y), g4.z * (1.f + sc.z), g4.w * (1.f + sc.w)};
      }
      bcur = b;
    }
    float x[32];
    float ss = 0.f;
#pragma unroll
    for (int i = 0; i < 4; ++i) unpack8(xa[i], x + 8 * i);
    if (pr + 1 < pend) {
      const bf16_t* src = xres + (size_t)(2 * (pr + 1) + half) * 1024 + 32 * blk;
#pragma unroll
      for (int i = 0; i < 4; ++i) xa[i] = *(const u32x4*)(src + 8 * i);
    }
#pragma unroll
    for (int i = 0; i < 32; ++i) ss += x[i] * x[i];
#pragma unroll
    for (int o = 16; o >= 1; o >>= 1) ss += __shfl_xor(ss, o);
    const float rstd = rsqrtf(ss * (1.f / 1024.f) + 1e-6f);
    unsigned pk[16];
#pragma unroll
    for (int i = 0; i < 8; ++i) {
      const float4 a4 = av[i], sh = shv[i];
      x[4 * i] = x[4 * i] * rstd * a4.x + sh.x;
      x[4 * i + 1] = x[4 * i + 1] * rstd * a4.y + sh.y;
      x[4 * i + 2] = x[4 * i + 2] * rstd * a4.z + sh.z;
      x[4 * i + 3] = x[4 * i + 3] * rstd * a4.w + sh.w;
      pk[2 * i] = pk2(x[4 * i], x[4 * i + 1]); pk[2 * i + 1] = pk2(x[4 * i + 2], x[4 * i + 3]);
    }
    bf16_t* hrow = hbuf + (size_t)t * 1024 + 32 * blk;
#pragma unroll
    for (int i = 0; i < 4; ++i) *(u32x4*)(hrow + 8 * i) = (u32x4){pk[4 * i], pk[4 * i + 1], pk[4 * i + 2], pk[4 * i + 3]};
    unsigned sb;
    const u32x6 q = mxfp6_pack32(x, sb);
    unsigned char* row = h6 + (size_t)t * V6_PITCH;
    *(u32x2*)(row + 24 * blk) = (u32x2){q[0], q[1]};
    *(u32x2*)(row + 24 * blk + 8) = (u32x2){q[2], q[3]};
    *(u32x2*)(row + 24 * blk + 16) = (u32x2){q[4], q[5]};
    row[mx_scale_pos(blk)] = (unsigned char)sb;
  }
}

template <int EPI>
DI void gemm_tile(const bf16_t* __restrict__ P, const bf16_t* __restrict__ Q, int it, int jt, void* outp, int ld,
                  const float* xin_lat, const float* xin_ctx, const float* modl, unsigned char* lds, bool gvar = false) {
  const int tid = ltid(), lane = tid & 63, w = tid >> 6, wi = w >> 1, wj = w & 1, lr = lane & 15, g = lane >> 4;
  const int wu = __builtin_amdgcn_readfirstlane(w);
  f32x4 acc[4][4];
#pragma unroll
  for (int a = 0; a < 4; ++a)
#pragma unroll
    for (int b = 0; b < 4; ++b) acc[a][b] = (f32x4){0.f, 0.f, 0.f, 0.f};
  const unsigned lo0 = (unsigned)((lane >> 3) * 1024 + (((lane & 7) ^ (lane >> 4)) << 3));
  const unsigned lo1 = (unsigned)((lane >> 3) * 1024 + (((lane & 7) ^ (4 + (lane >> 4))) << 3));
  const bf16_t* pg = P + (size_t)(it * 128 + 32 * wu) * 1024;
  const bf16_t* qg = Q + (size_t)(jt * 128 + 32 * wu) * 1024;
#define GT_DMA(kb, bf) do { _Pragma("unroll") for (int jj = 0; jj < 4; ++jj) { const unsigned lo_ = (jj & 1) ? lo1 : lo0; \
      __builtin_amdgcn_global_load_lds((const unsigned*)(pg + (size_t)jj * 8192 + (kb) * 64 + lo_), (unsigned*)(lds + (bf) * 32768 + (4 * wu + jj) * 1024), 16, 0, 0); \
      __builtin_amdgcn_global_load_lds((const unsigned*)(qg + (size_t)jj * 8192 + (kb) * 64 + lo_), (unsigned*)(lds + (bf) * 32768 + 16384 + (4 * wu + jj) * 1024), 16, 0, 0); } } while (0)
  __syncthreads();
  GT_DMA(0, 0);
  asm volatile("s_waitcnt vmcnt(0)" ::: "memory");
  __syncthreads();
  for (int kb = 0; kb < 16; ++kb) {
    if (kb < 15 && !(GEMM_VAR == 1 && gvar)) GT_DMA(kb + 1, (kb + 1) & 1);
    const unsigned char* Ps = lds + (kb & 1) * 32768;
    const unsigned char* Qs = Ps + 16384;
    bf16x8 pf[2][4], qf[2][4];
#pragma unroll
    for (int ks = 0; ks < 2; ++ks) {
      const int ch = ks * 4 + g;
#pragma unroll
      for (int mi = 0; mi < 4; ++mi) { const int row = wi * 64 + mi * 16 + lr; pf[ks][mi] = *(const bf16x8*)(Ps + (row >> 1) * 256 + (((((row & 1) << 3) | ch) ^ ((row >> 1) & 7)) << 4)); }
#pragma unroll
      for (int nj = 0; nj < 4; ++nj) { const int row = wj * 64 + nj * 16 + lr; qf[ks][nj] = *(const bf16x8*)(Qs + (row >> 1) * 256 + (((((row & 1) << 3) | ch) ^ ((row >> 1) & 7)) << 4)); }
    }
    __builtin_amdgcn_sched_barrier(0);
    __builtin_amdgcn_s_setprio(1);
#pragma unroll
    for (int ks = 0; ks < 2; ++ks)
#pragma unroll
      for (int mi = 0; mi < 4; ++mi)
#pragma unroll
        for (int nj = 0; nj < 4; ++nj) { if (GEMM_VAR == 2 && gvar) { asm volatile("" :: "v"(pf[ks][mi]), "v"(qf[ks][nj])); } else acc[mi][nj] = mfma16(pf[ks][mi], qf[ks][nj], acc[mi][nj]); }
    __builtin_amdgcn_s_setprio(0);
    __builtin_amdgcn_sched_barrier(0);
    asm volatile("s_waitcnt vmcnt(0)" ::: "memory");
    __syncthreads();
  }
#undef GT_DMA
  if (EPI == 2) {
    float inv[4];
#pragma unroll
    for (int r = 0; r < 4; ++r) inv[r] = __builtin_amdgcn_exp2f(-(float)(4 * g + r) * (13.287712379549449f / 16.f));
#pragma unroll
    for (int nj = 0; nj < 4; ++nj) {
      const int j = jt * 128 + wj * 64 + nj * 16 + lr;
      if (j < TL) {
        const float prow = (float)((j & 2047) >> 6), pcol = (float)(j & 63);
#pragma unroll
        for (int r = 0; r < 4; ++r) {
          const float a1 = prow * inv[r], a2 = pcol * inv[r];
          const float c1 = __cosf(a1), s1 = __sinf(a1), c2 = __cosf(a2), s2 = __sinf(a2);
          const float x1 = acc[0][nj][r], x2 = acc[1][nj][r], y1 = acc[2][nj][r], y2 = acc[3][nj][r];
          acc[0][nj][r] = x1 * c1 - x2 * s1; acc[1][nj][r] = x2 * c1 + x1 * s1;
          acc[2][nj][r] = y1 * c2 - y2 * s2; acc[3][nj][r] = y2 * c2 + y1 * s2;
        }
      }
    }
  }
  if (EPI == 0 || EPI == 2) {
#pragma unroll
    for (int mi = 0; mi < 4; ++mi)
#pragma unroll
      for (int nj = 0; nj < 4; ++nj) {
        const int j = jt * 128 + wj * 64 + nj * 16 + lr;
        const int i = it * 128 + wi * 64 + mi * 16 + 4 * g;
        const f32x4 a = acc[mi][nj];
        u32x2 o = {pk2(a[0], a[1]), pk2(a[2], a[3])};
        *(u32x2*)((bf16_t*)outp + (size_t)j * ld + i) = o;
      }
  } else {
    const int jb = jt * 128;
    const bool lat = jb < TL;
    const int b = lat ? (jb >> 11) : 16;
    const int ib = it * 128 + wi * 64 + 4 * g;
    float4 gt[4];
#pragma unroll
    for (int mi = 0; mi < 4; ++mi) gt[mi] = *(const float4*)(modl + (size_t)b * 6144 + 2 * 1024 + ib + mi * 16);
    bf16_t* xo = (bf16_t*)outp + (size_t)(jb + wj * 64 + lr) * 1024 + ib;
    if (xin_lat) {
      const float* xs = (lat ? xin_lat + (size_t)jb * 1024 : xin_ctx + (size_t)(jb - TL) * 1024) + (size_t)(wj * 64 + lr) * 1024 + ib;
      float4 xv[4][4];
#pragma unroll
      for (int mi = 0; mi < 4; ++mi)
#pragma unroll
        for (int nj = 0; nj < 4; ++nj) xv[mi][nj] = *(const float4*)(xs + (size_t)nj * 16 * 1024 + mi * 16);
#pragma unroll
      for (int mi = 0; mi < 4; ++mi)
#pragma unroll
        for (int nj = 0; nj < 4; ++nj) {
          const f32x4 a = acc[mi][nj];
          u32x2 o = {pk2(xv[mi][nj].x + gt[mi].x * a[0], xv[mi][nj].y + gt[mi].y * a[1]), pk2(xv[mi][nj].z + gt[mi].z * a[2], xv[mi][nj].w + gt[mi].w * a[3])};
          *(u32x2*)(xo + (size_t)nj * 16 * 1024 + mi * 16) = o;
        }
    } else {
      u32x2 rv[4][4];
#pragma unroll
      for (int mi = 0; mi < 4; ++mi)
#pragma unroll
        for (int nj = 0; nj < 4; ++nj) rv[mi][nj] = *(const u32x2*)(xo + (size_t)nj * 16 * 1024 + mi * 16);
#pragma unroll
      for (int mi = 0; mi < 4; ++mi)
#pragma unroll
        for (int nj = 0; nj < 4; ++nj) {
          const f32x4 a = acc[mi][nj];
          const u32x2 r = rv[mi][nj];
          u32x2 o = {pk2(bflo(r.x) + gt[mi].x * a[0], bfhi(r.x) + gt[mi].y * a[1]), pk2(bflo(r.y) + gt[mi].z * a[2], bfhi(r.y) + gt[mi].w * a[3])};
          *(u32x2*)(xo + (size_t)nj * 16 * 1024 + mi * 16) = o;
        }
    }
  }
}

struct TileIter {
  int u, step, total, nf, tpx, x;
  DI void init(int n_tok_tiles, int n_feat_tiles) {
    const int bid = lbid(), nb = lgdim();
    nf = n_feat_tiles;
    if ((nb & 7) == 0 && (n_tok_tiles & 7) == 0) { x = bid & 7; u = bid >> 3; step = nb >> 3; tpx = n_tok_tiles >> 3; }
    else { x = 0; u = bid; step = nb; tpx = n_tok_tiles; }
    total = tpx * nf;
  }
  DI bool valid() const { return u < total; }
  DI void next() { u += step; }
  DI void get(int& tok_tile, int& feat_tile) const {
    const int g = u / (8 * nf), rem = u - g * 8 * nf;
    const int gs = (tpx - 8 * g) < 8 ? (tpx - 8 * g) : 8;
    const int f = rem / gs, tt = rem - f * gs;
    tok_tile = x * tpx + 8 * g + tt; feat_tile = f;
  }
};

DI void phase_gemm_in(const Params& p, int l, unsigned char* lds, bool gvar = false) {
  const bf16_t* W = (const bf16_t*)(p.ws + OFF_WIN) + (size_t)l * 3200 * 1024;
  const bf16_t* H = (const bf16_t*)(p.ws + OFF_H);
  bf16_t* PN = (bf16_t*)(p.ws + OFF_P);
  bf16_t* VT = (bf16_t*)(p.ws + OFF_VT);
  TileIter ti; ti.init(TT / 128, 25);
  for (; ti.valid(); ti.next()) {
    int jt, f; ti.get(jt, f);
    if (f >= 8 && f < 16) gemm_tile<2>(W, H, f, jt, PN, PN_LD, nullptr, nullptr, nullptr, lds, gvar);
    else if (f < 17) gemm_tile<0>(W, H, f, jt, PN, PN_LD, nullptr, nullptr, nullptr, lds, gvar);
    else gemm_tile<0>(H, W + (size_t)2176 * 1024, jt, f - 17, VT, TT, nullptr, nullptr, nullptr, lds, gvar);
  }
}
DI void phase_gemm_out(const Params& p, int l, int ntok, unsigned char* lds) {
  const bf16_t* W = (const bf16_t*)(p.ws + OFF_WOUT) + (size_t)l * 1024 * 1024;
  const bf16_t* Y = (const bf16_t*)(p.ws + OFF_Y);
  bf16_t* xres = (bf16_t*)(p.ws + OFF_XRES);
  const float* modl = (const float*)(p.ws + OFF_MOD) + (size_t)l * 17 * 6144;
  const float* xl = (l == 0) ? p.x : nullptr;
  const float* xc = (l == 0) ? p.ctx : nullptr;
  TileIter ti; ti.init(ntok / 128, 8);
  for (; ti.valid(); ti.next()) {
    int jt, f; ti.get(jt, f);
    gemm_tile<1>(W, Y, f, jt, xres, 1024, xl, xc, modl, lds);
  }
}
DI void phase_gemm_q(const Params& p, int l, int ntok, unsigned char* lds) {
  const bf16_t* W = (const bf16_t*)(p.ws + OFF_WQ) + (size_t)l * 1024 * 1024;
  const bf16_t* H = (const bf16_t*)(p.ws + OFF_H);
  bf16_t* QP = (bf16_t*)(p.ws + OFF_QP);
  TileIter ti; ti.init(ntok / 128, 8);
  for (; ti.valid(); ti.next()) {
    int jt, f; ti.get(jt, f);
    gemm_tile<0>(W, H, f, jt, QP, 1024, nullptr, nullptr, nullptr, lds);
  }
}

DI void phase_rope(const Params& p, unsigned char* lds) {
  float2* tab = (float2*)lds;
  for (int e = ltid(); e < 1024; e += 256) {
    const int pos = e >> 4, i = e & 15;
    const float inv = exp2f(-(float)i * (13.287712379549449f / 16.f));
    const float ang = (float)pos * inv;
    tab[e] = make_float2(__cosf(ang), __sinf(ang));
  }
  __syncthreads();
  bf16_t* PN = (bf16_t*)(p.ws + OFF_P);
  const int total = TL * 16;
  for (int idx = lbid() * 256 + ltid(); idx < total; idx += lgdim() * 256) {
    const int t = idx >> 4, vec = idx & 15;
    const int col = ((vec >> 3) ? C_DK : C_DQ) + ((vec >> 1) & 3) * 128 + (vec & 1) * 64;
    bf16_t* ptr = PN + (size_t)t * PN_LD + col;
    float xv[64];
#pragma unroll
    for (int q = 0; q < 8; ++q) { const u32x4 v = *(const u32x4*)(ptr + q * 8); unpack8(v, xv + q * 8); }
    const int row = (t & 2047) >> 6, cp = t & 63;
#pragma unroll
    for (int i = 0; i < 16; ++i) {
      const float2 cs = tab[row * 16 + i];
      const float x1 = xv[i], x2 = xv[16 + i];
      xv[i] = x1 * cs.x - x2 * cs.y; xv[16 + i] = x2 * cs.x + x1 * cs.y;
      const float2 cs2 = tab[cp * 16 + i];
      const float y1 = xv[32 + i], y2 = xv[48 + i];
      xv[32 + i] = y1 * cs2.x - y2 * cs2.y; xv[48 + i] = y2 * cs2.x + y1 * cs2.y;
    }
#pragma unroll
    for (int q = 0; q < 8; ++q) {
      u32x4 o = {pk2(xv[q * 8], xv[q * 8 + 1]), pk2(xv[q * 8 + 2], xv[q * 8 + 3]), pk2(xv[q * 8 + 4], xv[q * 8 + 5]), pk2(xv[q * 8 + 6], xv[q * 8 + 7])};
      *(u32x4*)(ptr + q * 8) = o;
    }
  }
}

struct SrcSeg {
  const bf16_t* PN; const bf16_t* VT; int kcol, vrow, t0, n0, t1, n1, lr, g;
  DI int nsteps() const { return n0 + n1; }
  DI int tok0(int st) const { return st < n0 ? t0 + st * 32 : t1 + (st - n0) * 32; }
  DI float score(float raw, int st, int kt, int r) const { return raw * SC_LOG2; }
};
struct SrcNat {
  const bf16_t* PN; const bf16_t* VT; int kcol, vrow, b, rq, rs, cs, qc, cstart, lr, g;
  const float* rpbh;
  DI int nsteps() const { return 16; }
  DI int tok0(int st) const { return st < 8 ? b * 2048 + (rs + st) * 64 + cs : TL + b * 256 + (st - 8) * 32; }
  DI float score(float raw, int st, int kt, int r) const {
    if (st >= 8) return raw * SC_LOG2;
    const int kc = cs + 8 * g + 4 * kt + r;
    const bool valid = (kc >= cstart) && (kc < cstart + 16);
    int dc = kc - qc + 15; dc = dc < 0 ? 0 : (dc > 30 ? 30 : dc);
    const float bias = rpbh[(rs + st - rq + 7) * 31 + dc];
    return valid ? (raw * 0.125f + bias) * LOG2E : NEG_BIG;
  }
};

template <class Src>
struct FlashFrags { bf16x8 k[2][2]; bf16x8 v[4]; };
template <class Src>
DI void flash_load(const Src& S, int st, FlashFrags<Src>& F) {
  const int tk = S.tok0(st);
  const int kap = 8 * (S.lr >> 2) + (S.lr & 3);
  const bf16_t* k0p = S.PN + (size_t)(tk + kap) * PN_LD + S.kcol + 8 * S.g;
  const bf16_t* vp = S.VT + (size_t)(S.vrow + S.lr) * TT + tk + 8 * S.g;
#pragma unroll
  for (int kt = 0; kt < 2; ++kt)
#pragma unroll
    for (int ks = 0; ks < 2; ++ks) F.k[kt][ks] = *(const bf16x8*)(k0p + (size_t)kt * 4 * PN_LD + ks * 32);
#pragma unroll
  for (int dt = 0; dt < 4; ++dt) F.v[dt] = *(const bf16x8*)(vp + (size_t)dt * 16 * TT);
}
template <class Src>
DI void flash_step(const Src& S, int st, const FlashFrags<Src>& F, const bf16x8 (&qf)[2], f32x4 (&o)[4], float& mrun, float& lrun) {
  f32x4 s[2];
#pragma unroll
  for (int kt = 0; kt < 2; ++kt) {
    s[kt] = (f32x4){0.f, 0.f, 0.f, 0.f};
#pragma unroll
    for (int ks = 0; ks < 2; ++ks) s[kt] = mfma16(F.k[kt][ks], qf[ks], s[kt]);
  }
  float mt = NEG_BIG;
#pragma unroll
  for (int kt = 0; kt < 2; ++kt)
#pragma unroll
    for (int r = 0; r < 4; ++r) { s[kt][r] = S.score(s[kt][r], st, kt, r); mt = fmaxf(mt, s[kt][r]); }
  mt = rows_max(mt);
  const bool need = mt > mrun + 8.f;
  if (__any(need)) {
    const float mnew = need ? mt : mrun;
    const float alpha = __builtin_amdgcn_exp2f(mrun - mnew);
    lrun *= alpha;
#pragma unroll
    for (int dt = 0; dt < 4; ++dt) { o[dt][0] *= alpha; o[dt][1] *= alpha; o[dt][2] *= alpha; o[dt][3] *= alpha; }
    mrun = mnew;
  }
  float pv[8], ls = 0.f;
#pragma unroll
  for (int kt = 0; kt < 2; ++kt)
#pragma unroll
    for (int r = 0; r < 4; ++r) { pv[kt * 4 + r] = __builtin_amdgcn_exp2f(s[kt][r] - mrun); ls += pv[kt * 4 + r]; }
  lrun += ls;
  u32x4 pk = {pk2(pv[0], pv[1]), pk2(pv[2], pv[3]), pk2(pv[4], pv[5]), pk2(pv[6], pv[7])};
  const bf16x8 pf = __builtin_bit_cast(bf16x8, pk);
#pragma unroll
  for (int dt = 0; dt < 4; ++dt) o[dt] = mfma16(F.v[dt], pf, o[dt]);
}
template <class Src>
DI void flash_wave(const Src& S, const bf16_t* qptr  , f32x4 (&o)[4], float& ltot) {
  bf16x8 qf[2];
  qf[0] = *(const bf16x8*)(qptr); qf[1] = *(const bf16x8*)(qptr + 32);
  float mrun = NEG_BIG, lrun = 0.f;
#pragma unroll
  for (int dt = 0; dt < 4; ++dt) o[dt] = (f32x4){0.f, 0.f, 0.f, 0.f};
  const int ns = S.nsteps();
  FlashFrags<Src> f0, f1, f2;
  flash_load(S, 0, f0);
  if (ns > 1) flash_load(S, 1, f1);
  for (int st = 0; st < ns; st += 3) {
    if (st + 2 < ns) flash_load(S, st + 2, f2);
    flash_step(S, st, f0, qf, o, mrun, lrun);
    if (st + 1 < ns) {
      if (st + 3 < ns) flash_load(S, st + 3, f0);
      flash_step(S, st + 1, f1, qf, o, mrun, lrun);
    }
    if (st + 2 < ns) {
      if (st + 4 < ns) flash_load(S, st + 4, f1);
      flash_step(S, st + 2, f2, qf, o, mrun, lrun);
    }
  }
  ltot = rows_sum(lrun);
}

DI void nat_wave_task(const Params& p, int l, int b, int head, int rq, int ct, const float* rpb_lds) {
  const int lane = ltid() & 63, lr = lane & 15, g = lane >> 4;
  const bf16_t* PN = (const bf16_t*)(p.ws + OFF_P);
  const bf16_t* VT = (const bf16_t*)(p.ws + OFF_VT);
  bf16_t* Y = (bf16_t*)(p.ws + OFF_Y);
  SrcNat S;
  S.PN = PN; S.VT = VT; S.kcol = C_NK + head * 64; S.vrow = R_NV + head * 64; S.b = b; S.rq = rq; S.lr = lr; S.g = g;
  int rs = rq - 4; rs = rs < 0 ? 0 : (rs > 24 ? 24 : rs);
  S.rs = rs;
  int cs = 16 * ct - 8; cs = cs < 0 ? 0 : (cs > 32 ? 32 : cs);
  S.cs = cs;
  S.qc = 16 * ct + lr;
  int cst = S.qc - 8; cst = cst < 0 ? 0 : (cst > 48 ? 48 : cst);
  S.cstart = cst;
  S.rpbh = rpb_lds + head * 465;
  f32x4 o[4];
  float lt;
  const int qtok = b * 2048 + rq * 64 + 16 * ct + lr;
  flash_wave<SrcNat>(S, PN + (size_t)qtok * PN_LD + C_NQ + head * 64 + 8 * g, o, lt);
  const float inv = 1.f / lt;
#pragma unroll
  for (int dt = 0; dt < 4; ++dt) {
    u32x2 ov = {pk2(o[dt][0] * inv, o[dt][1] * inv), pk2(o[dt][2] * inv, o[dt][3] * inv)};
    *(u32x2*)(Y + (size_t)qtok * 1024 + 256 + head * 64 + dt * 16 + 4 * g) = ov;
  }
}
DI void natctx_wave_task(const Params& p, int b, int head, int qt) {
  const int lane = ltid() & 63, lr = lane & 15, g = lane >> 4;
  const bf16_t* PN = (const bf16_t*)(p.ws + OFF_P);
  const bf16_t* VT = (const bf16_t*)(p.ws + OFF_VT);
  bf16_t* Y = (bf16_t*)(p.ws + OFF_Y);
  SrcSeg S;
  S.PN = PN; S.VT = VT; S.kcol = C_NK + head * 64; S.vrow = R_NV + head * 64; S.lr = lr; S.g = g;
  S.t0 = TL + b * 256; S.n0 = 8; S.t1 = 0; S.n1 = 0;
  f32x4 o[4];
  float lt;
  const int qtok = TL + b * 256 + qt * 16 + lr;
  flash_wave<SrcSeg>(S, PN + (size_t)qtok * PN_LD + C_NQ + head * 64 + 8 * g, o, lt);
  const float inv = 1.f / lt;
#pragma unroll
  for (int dt = 0; dt < 4; ++dt) {
    u32x2 ov = {pk2(o[dt][0] * inv, o[dt][1] * inv), pk2(o[dt][2] * inv, o[dt][3] * inv)};
    *(u32x2*)(Y + (size_t)qtok * 1024 + 256 + head * 64 + dt * 16 + 4 * g) = ov;
  }
}

DI f32x16 mfma32(bf16x8 a, bf16x8 b, f32x16 c) { return __builtin_amdgcn_mfma_f32_32x32x16_bf16(a, b, c, 0, 0, 0); }
DI float half_max(float x) {
  unsigned u = __float_as_uint(x);
  u32x2 a = __builtin_amdgcn_permlane32_swap(u, u, false, false);
  return fmaxf(__uint_as_float(a[0]), __uint_as_float(a[1]));
}
DI float half_sum(float x) {
  unsigned u = __float_as_uint(x);
  u32x2 a = __builtin_amdgcn_permlane32_swap(u, u, false, false);
  return __uint_as_float(a[0]) + __uint_as_float(a[1]);
}
DI void diff_block_task(const Params& p, int l, int b, int hd, int qtok0, int nsteps, unsigned char* lds, int dvar = 0) {
  const int tid = ltid(), lane = tid & 63, w = tid >> 6, l31 = lane & 31, h = lane >> 5;
  unsigned char* Kb = lds;
  unsigned char* Vb = lds + 8192;
  const bf16_t* PN = (const bf16_t*)(p.ws + OFF_P);
  const bf16_t* VT = (const bf16_t*)(p.ws + OFF_VT);
  bf16_t* Y = (bf16_t*)(p.ws + OFF_Y);
  bf16x8 qf[2][4];
  {
    const bf16_t* qp = PN + (size_t)(qtok0 + 32 * w + l31) * PN_LD + C_DQ + hd * 128 + 8 * h;
#pragma unroll
    for (int m = 0; m < 2; ++m)
#pragma unroll
      for (int kd = 0; kd < 4; ++kd) {
        const u32x4 raw = *(const u32x4*)(qp + m * 64 + kd * 16);
        float f[8];
        unpack8(raw, f);
        u32x4 sc = {pk2(f[0] * SC_LOG2, f[1] * SC_LOG2), pk2(f[2] * SC_LOG2, f[3] * SC_LOG2), pk2(f[4] * SC_LOG2, f[5] * SC_LOG2), pk2(f[6] * SC_LOG2, f[7] * SC_LOG2)};
        qf[m][kd] = __builtin_bit_cast(bf16x8, sc);
      }
  }
  const int wu = __builtin_amdgcn_readfirstlane(w);
  unsigned kofs[2], vofs[2];
#pragma unroll
  for (int jj = 0; jj < 2; ++jj) {
    const int krow = 4 * (2 * w + jj) + (lane >> 4), kpc = lane & 15;
    const int kch = kpc ^ (krow & 15);
    kofs[jj] = (unsigned)(krow * PN_LD + C_DK + hd * 128 + kch * 8) * 2u;
    const int vrow = 16 * (2 * w + jj) + (lane >> 2), vpc = lane & 3;
    const int vch = vpc ^ ((vrow >> 2) & 3);
    vofs[jj] = (unsigned)((R_DV + hd * 128 + vrow) * TT + vch * 8) * 2u;
  }
#define DB_DMA(st, sl) do { const int tk = (st) < 8 ? TL + b * 256 + (st) * 32 : b * 2048 + ((st) - 8) * 32; \
    const char* kb_ = (const char*)(PN + (size_t)tk * PN_LD); const char* vb_ = (const char*)(VT + tk); \
    _Pragma("unroll") for (int jj = 0; jj < 2; ++jj) { \
      __builtin_amdgcn_global_load_lds((const unsigned*)(kb_ + kofs[jj]), (unsigned*)(Kb + (sl) * 16384 + (2 * wu + jj) * 1024), 16, 0, 0); \
      __builtin_amdgcn_global_load_lds((const unsigned*)(vb_ + vofs[jj]), (unsigned*)(Vb + (sl) * 16384 + (2 * wu + jj) * 1024), 16, 0, 0); } } while (0)
  asm volatile("s_waitcnt vmcnt(0)" ::: "memory");
  __syncthreads();
  DB_DMA(0, 0);
  DB_DMA(nsteps > 1 ? 1 : 0, 1);
  DB_DMA(nsteps > 2 ? 2 : nsteps - 1, 2);
  asm volatile("s_waitcnt vmcnt(8)" ::: "memory");
  __builtin_amdgcn_s_barrier();

  f32x16 o[2][4];
  float mrun[2], lrun[2];
#pragma unroll
  for (int m = 0; m < 2; ++m) {
    mrun[m] = NEG_BIG; lrun[m] = 0.f;
#pragma unroll
    for (int dt = 0; dt < 4; ++dt)
#pragma unroll
      for (int i = 0; i < 16; ++i) o[m][dt][i] = 0.f;
  }
  const int krw = (l31 & 0x13) | ((l31 & 4) << 1) | ((l31 & 8) >> 1);
  const unsigned kro = (unsigned)(krw * 256), kx = (unsigned)(h ^ (krw & 15));
  const unsigned vro = (unsigned)(l31 * 64), vx = (unsigned)(h ^ ((l31 >> 2) & 3));
#define DF_LOADK(kf, Kt_, m_) _Pragma("unroll") for (int kd = 0; kd < 4; ++kd) \
    kf[kd] = *(const bf16x8*)((Kt_) + kro + ((kx ^ (unsigned)((m_) * 8 + 2 * kd)) << 4))
#define DF_LOADV(vf, Vt_, d0_) _Pragma("unroll") for (int dd = 0; dd < 2; ++dd) _Pragma("unroll") for (int kk = 0; kk < 2; ++kk) \
    vf[dd][kk] = *(const bf16x8*)((Vt_) + ((d0_) + dd) * 2048 + vro + ((vx ^ (unsigned)(2 * kk)) << 4))
#define DF_SMFMA(s, kf, m_) { _Pragma("unroll") for (int i = 0; i < 16; ++i) s[i] = 0.f; \
    _Pragma("unroll") for (int kd = 0; kd < 4; ++kd) s = mfma32(kf[kd], qf[m_][kd], s); }
#define DF_SOFTMAX(s, m_) { \
    float mt = NEG_BIG; \
    _Pragma("unroll") for (int i = 0; i < 16; ++i) mt = fmaxf(mt, s[i]); \
    mt = half_max(mt); \
    const bool need = mt > mrun[m_] + 8.f; \
    if (__any(need)) { \
      const float mnew = need ? mt : mrun[m_]; \
      const float alpha = __builtin_amdgcn_exp2f(mrun[m_] - mnew); \
      lrun[m_] *= alpha; \
      _Pragma("unroll") for (int dt = 0; dt < 4; ++dt) _Pragma("unroll") for (int i = 0; i < 16; ++i) o[m_][dt][i] *= alpha; \
      mrun[m_] = mnew; \
    } \
    float pv[16], ls = 0.f; \
    _Pragma("unroll") for (int i = 0; i < 16; ++i) { pv[i] = __builtin_amdgcn_exp2f(s[i] - mrun[m_]); ls += pv[i]; } \
    lrun[m_] += ls; \
    _Pragma("unroll") for (int kk = 0; kk < 2; ++kk) { \
      u32x4 pk = {pk2(pv[8 * kk], pv[8 * kk + 1]), pk2(pv[8 * kk + 2], pv[8 * kk + 3]), pk2(pv[8 * kk + 4], pv[8 * kk + 5]), pk2(pv[8 * kk + 6], pv[8 * kk + 7])}; \
      pf[m_][kk] = __builtin_bit_cast(bf16x8, pk); } }
#define DF_PV(vf, d0_, dd_) _Pragma("unroll") for (int kk = 0; kk < 2; ++kk) _Pragma("unroll") for (int m = 0; m < 2; ++m) \
    o[m][(d0_) + (dd_)] = mfma32(vf[dd_][kk], pf[m][kk], o[m][(d0_) + (dd_)])
  bf16x8 kf0[4];
  DF_LOADK(kf0, Kb, 0);
  for (int st = 0; st < nsteps; ++st) {
    { const int sn = st + 3 < nsteps ? st + 3 : nsteps - 1; DB_DMA(sn, (st + 3) & 3); }
    const unsigned char* Kt = Kb + (st & 3) * 16384;
    const unsigned char* Vt = Vb + (st & 3) * 16384;
    bf16x8 pf[2][2];
    bf16x8 kf1[4];
    DF_LOADK(kf1, Kt, 1);
    f32x16 s0;
    DF_SMFMA(s0, kf0, 0)
    __builtin_amdgcn_sched_barrier(0);
    DF_SOFTMAX(s0, 0)
    __builtin_amdgcn_sched_barrier(0);
    f32x16 s1;
    DF_SMFMA(s1, kf1, 1)
    __builtin_amdgcn_sched_barrier(0);
    bf16x8 vfA[2][2];
    DF_LOADV(vfA, Vt, 0);
    DF_SOFTMAX(s1, 1)
    __builtin_amdgcn_sched_barrier(0);
    DF_PV(vfA, 0, 0);
    __builtin_amdgcn_sched_barrier(0);
    bf16x8 vfB[2][2];
    DF_LOADV(vfB, Vt, 2);
    DF_PV(vfA, 0, 1);
    __builtin_amdgcn_sched_barrier(0);
    asm volatile("s_waitcnt vmcnt(8) lgkmcnt(0)" ::: "memory");
    __builtin_amdgcn_s_barrier();
    __builtin_amdgcn_sched_barrier(0);
    DF_PV(vfB, 2, 0);
    __builtin_amdgcn_sched_barrier(0);
    DF_LOADK(kf0, Kb + ((st + 1) & 3) * 16384, 0);
    DF_PV(vfB, 2, 1);
    __builtin_amdgcn_sched_barrier(0);
  }
#undef DF_LOADK
#undef DF_LOADV
#undef DF_SMFMA
#undef DF_SOFTMAX
#undef DF_PV
  asm volatile("s_waitcnt vmcnt(0)" ::: "memory");
#undef DB_DMA
  const int tid2 = ltid(), lane2 = tid2 & 63, w2 = tid2 >> 6, q2 = lane2 & 31, h2 = lane2 >> 5;
  const float* lv = p.dlam + l * 256;
  float sa = lv[lane2] * lv[64 + lane2], sb = lv[128 + lane2] * lv[192 + lane2];
  sa = wave_sum(sa); sb = wave_sum(sb);
  const float lam_init = 0.8f - 0.6f * expf(-0.3f * (float)l);
  const float lam = expf(sa) - expf(sb) + lam_init;
  const float* dg = p.diff_g + l * 512 + hd * 128;
  {
    const float l0 = half_sum(lrun[0]), l1 = half_sum(lrun[1]);
    const float i0 = 1.f / l0, i1 = lam / l1;
    float ss = 0.f;
#pragma unroll
    for (int dt = 0; dt < 4; ++dt)
#pragma unroll
      for (int i = 0; i < 16; ++i) { const float v = o[0][dt][i] * i0 - o[1][dt][i] * i1; o[0][dt][i] = v; ss += v * v; }
    ss = half_sum(ss);
    const float rstd = rsqrtf(ss * (1.f / 128.f) + 1e-6f) * (1.f - lam_init);
    const int qtok = qtok0 + 32 * w2 + q2;
    float4 gg[4][4];
#pragma unroll
    for (int dt = 0; dt < 4; ++dt)
#pragma unroll
      for (int i4 = 0; i4 < 4; ++i4) gg[dt][i4] = *(const float4*)(dg + 32 * dt + 8 * i4 + 4 * h2);
#pragma unroll
    for (int dt = 0; dt < 4; ++dt)
#pragma unroll
      for (int i4 = 0; i4 < 4; ++i4) {
        const int dv = 32 * dt + 8 * i4 + 4 * h2;
        const float4 g4 = gg[dt][i4];
        u32x2 ov = {pk2(o[0][dt][4 * i4] * rstd * g4.x, o[0][dt][4 * i4 + 1] * rstd * g4.y), pk2(o[0][dt][4 * i4 + 2] * rstd * g4.z, o[0][dt][4 * i4 + 3] * rstd * g4.w)};
        *(u32x2*)(Y + (size_t)qtok * 1024 + 512 + hd * 128 + dv) = ov;
      }
  }
}


DI void nat_block_task(const Params& p, int l, int b, int head, int rq, const float* rpb_lds, unsigned char* lds) {
  const int tid = ltid(), lane = tid & 63, w = tid >> 6, lr = lane & 15, g = lane >> 4;
  const int wu = __builtin_amdgcn_readfirstlane(w);
  unsigned char* Kb = lds;
  unsigned char* Vb = lds + 8192;
  const bf16_t* PN = (const bf16_t*)(p.ws + OFF_P);
  const bf16_t* VT = (const bf16_t*)(p.ws + OFF_VT);
  bf16_t* Y = (bf16_t*)(p.ws + OFF_Y);
  int rs = rq - 4; rs = rs < 0 ? 0 : (rs > 24 ? 24 : rs);
  const int ct = w;
  int cs = 16 * ct - 8; cs = cs < 0 ? 0 : (cs > 32 ? 32 : cs);
  const int qc = 16 * ct + lr;
  int cstart = qc - 8; cstart = cstart < 0 ? 0 : (cstart > 48 ? 48 : cstart);
  const float* rpbh = rpb_lds + head * 465;
  const int qtok = b * 2048 + rq * 64 + qc;
  bf16x8 qf[2];
  {
    const bf16_t* qp = PN + (size_t)qtok * PN_LD + C_NQ + head * 64 + 8 * g;
#pragma unroll
    for (int ks = 0; ks < 2; ++ks) {
      const u32x4 raw = *(const u32x4*)(qp + ks * 32);
      float f[8];
      unpack8(raw, f);
      u32x4 sc = {pk2(f[0] * SC_LOG2, f[1] * SC_LOG2), pk2(f[2] * SC_LOG2, f[3] * SC_LOG2), pk2(f[4] * SC_LOG2, f[5] * SC_LOG2), pk2(f[6] * SC_LOG2, f[7] * SC_LOG2)};
      qf[ks] = __builtin_bit_cast(bf16x8, sc);
    }
  }
  unsigned kofs[2], vofs[2];
#pragma unroll
  for (int jj = 0; jj < 2; ++jj) {
    const int pidx = 2 * w + jj, row = 8 * pidx + (lane >> 3);
    const int kch = (lane & 7) ^ ((((row >> 3) & 3) << 1) | ((row >> 1) & 1));
    kofs[jj] = (unsigned)(row * PN_LD + C_NK + head * 64 + kch * 8);
    const int vch = (lane & 7) ^ ((row >> 1) & 7);
    vofs[jj] = (unsigned)((R_NV + head * 64 + row) * TT + vch * 8);
  }
#define NB_DMA(st, bf) do { const int tk = (st) < 8 ? b * 2048 + (rs + (st)) * 64 : TL + b * 256 + ((st) - 8) * 64; \
    const bf16_t* kb_ = PN + (size_t)tk * PN_LD; const bf16_t* vb_ = VT + tk; \
    _Pragma("unroll") for (int jj = 0; jj < 2; ++jj) { \
      __builtin_amdgcn_global_load_lds((const unsigned*)(kb_ + kofs[jj]), (unsigned*)(Kb + (bf) * 16384 + (2 * wu + jj) * 1024), 16, 0, 0); \
      __builtin_amdgcn_global_load_lds((const unsigned*)(vb_ + vofs[jj]), (unsigned*)(Vb + (bf) * 16384 + (2 * wu + jj) * 1024), 16, 0, 0); } } while (0)
  asm volatile("s_waitcnt vmcnt(0)" ::: "memory");
  __syncthreads();
  NB_DMA(0, 0); NB_DMA(1, 1); NB_DMA(2, 2);
  asm volatile("s_waitcnt vmcnt(8)" ::: "memory");
  __builtin_amdgcn_s_barrier();
  f32x4 o[4];
#pragma unroll
  for (int dt = 0; dt < 4; ++dt) o[dt] = (f32x4){0.f, 0.f, 0.f, 0.f};
  float mrun = NEG_BIG, lrun = 0.f;
  const int kap = 8 * (lr >> 2) + (lr & 3);
  bool vld[8]; int dcv[8];
#pragma unroll
  for (int kt = 0; kt < 2; ++kt)
#pragma unroll
    for (int r = 0; r < 4; ++r) {
      const int kc = cs + 8 * g + 4 * kt + r;
      vld[kt * 4 + r] = (kc >= cstart) && (kc < cstart + 16);
      int dc = kc - qc + 15; dc = dc < 0 ? 0 : (dc > 30 ? 30 : dc);
      dcv[kt * 4 + r] = dc;
    }
#define NB_SUB(Kt_, Vt_, koff_, WIN) do { \
      bf16x8 kf[2][2], vf[4]; \
      _Pragma("unroll") for (int kt = 0; kt < 2; ++kt) { \
        const int row = (koff_) + kap + 4 * kt; \
        const int sw = (((row >> 3) & 3) << 1) | ((row >> 1) & 1); \
        _Pragma("unroll") for (int ks = 0; ks < 2; ++ks) kf[kt][ks] = *(const bf16x8*)((Kt_) + (row >> 1) * 256 + ((((row & 1) << 3) | ((ks * 4 + g) ^ sw)) << 4)); \
      } \
      _Pragma("unroll") for (int dt = 0; dt < 4; ++dt) { \
        const int row = 16 * dt + lr, ch = ((koff_) >> 3) + g; \
        vf[dt] = *(const bf16x8*)((Vt_) + (row >> 1) * 256 + (((((row & 1) << 3) | ch) ^ ((row >> 1) & 7)) << 4)); \
      } \
      f32x4 s[2]; \
      _Pragma("unroll") for (int kt = 0; kt < 2; ++kt) { \
        s[kt] = (f32x4){0.f, 0.f, 0.f, 0.f}; \
        _Pragma("unroll") for (int ks = 0; ks < 2; ++ks) s[kt] = mfma16(kf[kt][ks], qf[ks], s[kt]); \
      } \
      float mt = NEG_BIG; \
      _Pragma("unroll") for (int kt = 0; kt < 2; ++kt) _Pragma("unroll") for (int r = 0; r < 4; ++r) { \
          float sv = s[kt][r]; \
          if (WIN) sv = vld[kt * 4 + r] ? sv + bias[kt * 4 + r] : NEG_BIG; \
          s[kt][r] = sv; mt = fmaxf(mt, sv); \
        } \
      mt = rows_max(mt); \
      const bool need = mt > mrun + 8.f; \
      if (__any(need)) { \
        const float mnew = need ? mt : mrun; \
        const float alpha = __builtin_amdgcn_exp2f(mrun - mnew); \
        lrun *= alpha; \
        _Pragma("unroll") for (int dt = 0; dt < 4; ++dt) { o[dt][0] *= alpha; o[dt][1] *= alpha; o[dt][2] *= alpha; o[dt][3] *= alpha; } \
        mrun = mnew; \
      } \
      float pv[8], ls = 0.f; \
      _Pragma("unroll") for (int kt = 0; kt < 2; ++kt) _Pragma("unroll") for (int r = 0; r < 4; ++r) { pv[kt * 4 + r] = __builtin_amdgcn_exp2f(s[kt][r] - mrun); ls += pv[kt * 4 + r]; } \
      lrun += ls; \
      u32x4 pk = {pk2(pv[0], pv[1]), pk2(pv[2], pv[3]), pk2(pv[4], pv[5]), pk2(pv[6], pv[7])}; \
      const bf16x8 pf = __builtin_bit_cast(bf16x8, pk); \
      _Pragma("unroll") for (int dt = 0; dt < 4; ++dt) o[dt] = mfma16(vf[dt], pf, o[dt]); \
    } while (0)
  for (int st = 0; st < 8; ++st) {
    NB_DMA(st + 3, (st + 3) & 3);
    const float* brow = rpbh + (rs + st - rq + 7) * 31;
    float bias[8];
#pragma unroll
    for (int i = 0; i < 8; ++i) bias[i] = brow[dcv[i]];
    const unsigned char* Kt = Kb + (st & 3) * 16384;
    const unsigned char* Vt = Vb + (st & 3) * 16384;
    NB_SUB(Kt, Vt, cs, true);
    asm volatile("s_waitcnt vmcnt(8)" ::: "memory");
    __builtin_amdgcn_s_barrier();
  }
  for (int st = 8; st < 12; ++st) {
    { const int sn = st + 3 < 12 ? st + 3 : 11; NB_DMA(sn, (st + 3) & 3); }
    const float bias[8] = {0.f, 0.f, 0.f, 0.f, 0.f, 0.f, 0.f, 0.f};
    const unsigned char* Kt = Kb + (st & 3) * 16384;
    const unsigned char* Vt = Vb + (st & 3) * 16384;
    NB_SUB(Kt, Vt, 0, false);
    NB_SUB(Kt, Vt, 32, false);
    asm volatile("s_waitcnt vmcnt(8)" ::: "memory");
    __builtin_amdgcn_s_barrier();
  }
  asm volatile("s_waitcnt vmcnt(0)" ::: "memory");
#undef NB_SUB
#undef NB_DMA
  const float inv = 1.f / rows_sum(lrun);
#pragma unroll
  for (int dt = 0; dt < 4; ++dt) {
    u32x2 ov = {pk2(o[dt][0] * inv, o[dt][1] * inv), pk2(o[dt][2] * inv, o[dt][3] * inv)};
    *(u32x2*)(Y + (size_t)qtok * 1024 + 256 + head * 64 + dt * 16 + 4 * g) = ov;
  }
}

DI float quad_sum(float v) {
  v += __int_as_float(__builtin_amdgcn_mov_dpp(__float_as_int(v), 0xB1, 0xF, 0xF, true));
  v += __int_as_float(__builtin_amdgcn_mov_dpp(__float_as_int(v), 0x4E, 0xF, 0xF, true));
  return v;
}
DI void gla_task(const Params& p, int l, int task, unsigned char* lds, int var = 0) {
  const int tid = ltid(), lane = tid & 63, w = tid >> 6, vv = lane >> 2, g = lane & 3;
  const int b = task >> 3, h = (task >> 1) & 3, dir = task & 1;
  const bf16_t* PN = (const bf16_t*)(p.ws + OFF_P);
  const bf16_t* VT = (const bf16_t*)(p.ws + OFF_VT);
  float* og = (float*)(p.ws + OFF_H);
  float* Gup = (float*)lds;
  float* Gb = Gup + 512;
  float* As = Gb + 32;
  float* Ks = As + 2048;
  float* Qs = Ks + 2048;
  float* Vs = Qs + 2048;
  __syncthreads();
  for (int e = tid; e < 512; e += 256) { const int r = e >> 5, kd = e & 31; Gup[e] = p.gate_up[((size_t)(l * 2 + dir) * 16 + r) * 128 + h * 32 + kd]; }
  if (tid < 32) Gb[tid] = p.gate_b[(l * 2 + dir) * 128 + h * 32 + tid];
  float S[8];
#pragma unroll
  for (int e = 0; e < 8; ++e) S[e] = 0.f;
  const int si = tid >> 2, part = tid & 3;
  u32x4 rq, rk, rg0, rg1, rv0, rv1;
#define GLA_TOK0(cc) ((cc) < 4 ? TL + b * 256 + (dir == 0 ? (cc) : 3 - (cc)) * 64 : b * 2048 + (dir == 0 ? (cc) - 4 : 35 - (cc)) * 64)
#define GLA_LOAD(cc) do { const int t0_ = GLA_TOK0(cc); const bf16_t* row = PN + (size_t)(t0_ + si) * PN_LD; \
    rq = *(const u32x4*)(row + C_GQ + h * 32 + part * 8); rk = *(const u32x4*)(row + C_GK + h * 32 + part * 8); \
    rg0 = *(const u32x4*)(row + C_GATE + dir * 16); rg1 = *(const u32x4*)(row + C_GATE + dir * 16 + 8); \
    const bf16_t* vp = VT + (size_t)(R_GV + h * 64 + si) * TT + t0_ + part * 16; rv0 = *(const u32x4*)vp; rv1 = *(const u32x4*)(vp + 8); } while (0)
#define GLA_WRITE() do { float gd[16], qf[8], kf[8], vf[16], pre[8]; \
    unpack8(rg0, gd); unpack8(rg1, gd + 8); unpack8(rq, qf); unpack8(rk, kf); unpack8(rv0, vf); unpack8(rv1, vf + 8); \
    { const float4 b0 = *(const float4*)(Gb + part * 8), b1 = *(const float4*)(Gb + part * 8 + 4); \
      pre[0] = b0.x; pre[1] = b0.y; pre[2] = b0.z; pre[3] = b0.w; pre[4] = b1.x; pre[5] = b1.y; pre[6] = b1.z; pre[7] = b1.w; } \
    _Pragma("unroll") for (int r = 0; r < 16; ++r) { const float4 u0 = *(const float4*)(Gup + r * 32 + part * 8), u1 = *(const float4*)(Gup + r * 32 + part * 8 + 4); \
      pre[0] += gd[r] * u0.x; pre[1] += gd[r] * u0.y; pre[2] += gd[r] * u0.z; pre[3] += gd[r] * u0.w; \
      pre[4] += gd[r] * u1.x; pre[5] += gd[r] * u1.y; pre[6] += gd[r] * u1.z; pre[7] += gd[r] * u1.w; } \
    float av[8]; \
    _Pragma("unroll") for (int e = 0; e < 8; ++e) { const float ls = fminf(pre[e], 0.f) - __logf(1.f + __expf(-fabsf(pre[e]))); av[e] = __expf(ls * (1.f / 16.f)); } \
    *(float4*)(As + si * 32 + part * 8) = (float4){av[0], av[1], av[2], av[3]}; *(float4*)(As + si * 32 + part * 8 + 4) = (float4){av[4], av[5], av[6], av[7]}; \
    *(float4*)(Ks + si * 32 + part * 8) = (float4){kf[0], kf[1], kf[2], kf[3]}; *(float4*)(Ks + si * 32 + part * 8 + 4) = (float4){kf[4], kf[5], kf[6], kf[7]}; \
    { const float qs_ = 0.17677669529663687f; \
      *(float4*)(Qs + si * 32 + part * 8) = (float4){qf[0] * qs_, qf[1] * qs_, qf[2] * qs_, qf[3] * qs_}; *(float4*)(Qs + si * 32 + part * 8 + 4) = (float4){qf[4] * qs_, qf[5] * qs_, qf[6] * qs_, qf[7] * qs_}; } \
      \
    _Pragma("unroll") for (int e = 0; e < 4; ++e) *(float4*)(Vs + si * 68 + part * 16 + 4 * e) = (float4){vf[4 * e], vf[4 * e + 1], vf[4 * e + 2], vf[4 * e + 3]}; } while (0)
  GLA_LOAD(0);
  __syncthreads();
  GLA_WRITE();
  __syncthreads();
  for (int cc = 0; cc < 36; ++cc) {
    const int tok0 = GLA_TOK0(cc);
    if (cc + 1 < 36) GLA_LOAD(cc + 1);
    float* ob = og + ((size_t)dir * TT + tok0) * 256 + h * 64 + 16 * w + vv;
#pragma unroll 1
    for (int s0 = 0; s0 < 64; s0 += 4) {
      float4 a0[4], a1[4], k0[4], k1[4], q0[4], q1[4];
      float vx[4];
      const int ib = dir == 0 ? s0 : 63 - s0, di = dir == 0 ? 1 : -1;
#pragma unroll
      for (int u = 0; u < 4; ++u) {
        const int i = ib + di * u;
        a0[u] = *(const float4*)(As + i * 32 + 8 * g); a1[u] = *(const float4*)(As + i * 32 + 8 * g + 4);
        k0[u] = *(const float4*)(Ks + i * 32 + 8 * g); k1[u] = *(const float4*)(Ks + i * 32 + 8 * g + 4);
        q0[u] = *(const float4*)(Qs + i * 32 + 8 * g); q1[u] = *(const float4*)(Qs + i * 32 + 8 * g + 4);
        vx[u] = Vs[(16 * w + vv) * 68 + i];
      }
      float* op = ob + (ptrdiff_t)ib * 256;
#pragma unroll
      for (int u = 0; u < 4; ++u) {
        const float v = vx[u];
        S[0] = fmaf(a0[u].x, S[0], k0[u].x * v); S[1] = fmaf(a0[u].y, S[1], k0[u].y * v);
        S[2] = fmaf(a0[u].z, S[2], k0[u].z * v); S[3] = fmaf(a0[u].w, S[3], k0[u].w * v);
        S[4] = fmaf(a1[u].x, S[4], k1[u].x * v); S[5] = fmaf(a1[u].y, S[5], k1[u].y * v);
        S[6] = fmaf(a1[u].z, S[6], k1[u].z * v); S[7] = fmaf(a1[u].w, S[7], k1[u].w * v);
        const float oa = fmaf(q0[u].x, S[0], q0[u].y * S[1]), ob2 = fmaf(q0[u].z, S[2], q0[u].w * S[3]);
        const float oc = fmaf(q1[u].x, S[4], q1[u].y * S[5]), od = fmaf(q1[u].z, S[6], q1[u].w * S[7]);
        float o = (oa + ob2) + (oc + od);
        o = quad_sum(o);
        op[(ptrdiff_t)(di * u) * 256] = o;
      }
    }
    __syncthreads();
    if (cc + 1 < 36) GLA_WRITE();
    __syncthreads();
  }
#undef GLA_TOK0
#undef GLA_LOAD
#undef GLA_WRITE
}

DI void phase_mixers(const Params& p, int l, bool last, unsigned* ctr, unsigned char* lds, int mask = 15, int gvar = 0) {
  const int tid = ltid(), w = tid >> 6;
  volatile int* slot = (volatile int*)(lds + LDS_BYTES - 16);
  float* rpb_lds = (float*)(lds + 65536);
  for (int e = tid; e < 4 * 465; e += 256) rpb_lds[e] = p.rpb[(size_t)l * 4 * 465 + e] * LOG2E;
  const int nconv = (l == 0 && (mask & 8)) ? 1024 : 0;
  const int t1 = 128 + nconv, t2 = t1 + 1024, t3 = t2 + 2048, t4 = t3 + 128;
  const int ntask = last ? t3 : t4 + 256;
  for (;;) {
    __syncthreads();
    if (tid == 0) *slot = (int)atomicAdd(ctr, 1u);
    __syncthreads();
    const int task = *slot;
    if (task >= ntask) break;
    if (task < 128) { if (mask & 1) { __builtin_amdgcn_s_setprio(3); gla_task(p, l, task, lds, gvar); __builtin_amdgcn_s_setprio(0); } }
    else if (nconv && task < t2 && ((task - 128) & 1)) { const int c = (task - 128) >> 1; convert_table_pairs(p, c * 64, c * 64 + 64, w, 4, tid & 63); }
    else if (!(mask & 2) && (task < t2 || (task >= t3 && task < t4))) {}
    else if (!(mask & 4) && ((task >= t2 && task < t3) || task >= t4)) {}
    else if (task < t2) { const int d = nconv ? (task - 128) >> 1 : task - 128; const int b = d >> 6; diff_block_task(p, l, b, (d >> 4) & 3, b * 2048 + (d & 15) * 128, 72, lds, gvar); }
    else if (task < t3) { const int d = task - t2; nat_block_task(p, l, d >> 7, (d >> 5) & 3, d & 31, rpb_lds, lds); }
    else if (task < t4) { const int d = task - t3; const int b = d >> 3; diff_block_task(p, l, b, (d >> 1) & 3, TL + b * 256 + (d & 1) * 128, 8, lds); }
    else { const int wt = (task - t4) * 4 + w; natctx_wave_task(p, wt >> 6, (wt >> 4) & 3, wt & 15); }
  }
}

DI void phase_gla_fin(const Params& p, int l, int ntok) {
  const int lane = ltid() & 63, gw = lbid() * 4 + (ltid() >> 6), nw = lgdim() * 4;
  const float* og = (const float*)(p.ws + OFF_H);
  const bf16_t* PN = (const bf16_t*)(p.ws + OFF_P);
  bf16_t* Y = (bf16_t*)(p.ws + OFF_Y);
  const float4 gg = *(const float4*)(p.gla_norm_g + l * 256 + 4 * lane);
  for (int t0 = gw; t0 < ntok; t0 += 4 * nw) {
    float4 a[4], bq[4]; u32x2 rv[4];
#pragma unroll
    for (int k = 0; k < 4; ++k) {
      const int t = t0 + k * nw;
      if (t < ntok) {
        a[k] = *(const float4*)(og + (size_t)t * 256 + 4 * lane); bq[k] = *(const float4*)(og + ((size_t)TT + t) * 256 + 4 * lane);
        rv[k] = *(const u32x2*)(PN + (size_t)t * PN_LD + C_GR + 4 * lane);
      }
    }
#pragma unroll
    for (int k = 0; k < 4; ++k) {
      const int t = t0 + k * nw;
      if (t < ntok) {
        const float o0 = a[k].x + bq[k].x, o1 = a[k].y + bq[k].y, o2 = a[k].z + bq[k].z, o3 = a[k].w + bq[k].w;
        float ss = o0 * o0 + o1 * o1 + o2 * o2 + o3 * o3;
        ss += __shfl_xor(ss, 1); ss += __shfl_xor(ss, 2); ss += __shfl_xor(ss, 4); ss += __shfl_xor(ss, 8);
        const float rstd = rsqrtf(ss * (1.f / 64.f) + 1e-6f);
        const float r0 = bflo(rv[k].x), r1 = bfhi(rv[k].x), r2 = bflo(rv[k].y), r3 = bfhi(rv[k].y);
        const float y0 = o0 * rstd * gg.x * (r0 / (1.f + __expf(-r0)));
        const float y1 = o1 * rstd * gg.y * (r1 / (1.f + __expf(-r1)));
        const float y2 = o2 * rstd * gg.z * (r2 / (1.f + __expf(-r2)));
        const float y3 = o3 * rstd * gg.w * (r3 / (1.f + __expf(-r3)));
        u32x2 ov = {pk2(y0, y1), pk2(y2, y3)};
        *(u32x2*)(Y + (size_t)t * 1024 + 4 * lane) = ov;
      }
    }
  }
}


DI void ce_desc(float& a, float& b) {
  float hi, lo;
  asm("v_max_f32 %0, %2, %3\n\tv_min_f32 %1, %2, %3" : "=&v"(hi), "=&v"(lo) : "v"(a), "v"(b));
  a = hi; b = lo;
}
DI float vmaxf(float a, float b) { float r; asm("v_max_f32 %0, %1, %2" : "=v"(r) : "v"(a), "v"(b)); return r; }
template <int N>
DI void bitonic_sort_desc(float (&x)[N]) {
#pragma unroll
  for (int k = 2; k <= N; k <<= 1)
#pragma unroll
    for (int j = k >> 1; j > 0; j >>= 1)
#pragma unroll
      for (int i = 0; i < N; ++i) {
        const int l = i ^ j;
        if (l > i) { if ((i & k) == 0) ce_desc(x[i], x[l]); else ce_desc(x[l], x[i]); }
      }
}
template <int N>
DI void bitonic_merge_desc(float (&x)[N]) {
#pragma unroll
  for (int j = N >> 1; j > 0; j >>= 1)
#pragma unroll
    for (int i = 0; i < N; ++i) { const int l = i ^ j; if (l > i) ce_desc(x[i], x[l]); }
}
DI void rows_merge_top16(float (&L)[16]) {
  {
    float A0[16], A1[16];
#pragma unroll
    for (int i = 0; i < 16; ++i) { const u32x2 s = __builtin_amdgcn_permlane32_swap(__float_as_uint(L[i]), __float_as_uint(L[i]), false, false); A0[i] = __uint_as_float(s[0]); A1[i] = __uint_as_float(s[1]); }
#pragma unroll
    for (int i = 0; i < 16; ++i) L[i] = vmaxf(A0[i], A1[15 - i]);
    bitonic_merge_desc<16>(L);
  }
  {
    float A0[16], A1[16];
#pragma unroll
    for (int i = 0; i < 16; ++i) { const u32x2 s = __builtin_amdgcn_permlane16_swap(__float_as_uint(L[i]), __float_as_uint(L[i]), false, false); A0[i] = __uint_as_float(s[0]); A1[i] = __uint_as_float(s[1]); }
#pragma unroll
    for (int i = 0; i < 16; ++i) L[i] = vmaxf(A0[i], A1[15 - i]);
    bitonic_merge_desc<16>(L);
  }
}

struct PairTab { int a[52], b[52]; };
constexpr PairTab make_pairs() {
  PairTab t{};
  int n = 0;
  for (int a = 0; a < 16; ++a)
    for (int b = 0; b < 16; ++b)
      if ((a + 1) * (b + 1) <= 16) { t.a[n] = a; t.b[n] = b; ++n; }
  for (; n < 52; ++n) { t.a[n] = -1; t.b[n] = -1; }
  return t;
}

DI void topk_half(const bf16_t* skh  , const bf16_t* qrow  , int lr, int g, float (&list)[16]) {
  bf16x8 qf[2];
  qf[0] = *(const bf16x8*)(qrow); qf[1] = *(const bf16x8*)(qrow + 32);
  float s[32];
#pragma unroll
  for (int nt = 0; nt < 8; ++nt) {
    f32x4 acc = {0.f, 0.f, 0.f, 0.f};
#pragma unroll
    for (int ks = 0; ks < 2; ++ks) {
      const bf16x8 af = *(const bf16x8*)(skh + (size_t)(nt * 16 + lr) * 64 + ks * 32 + 8 * g);
      acc = mfma16(af, qf[ks], acc);
    }
#pragma unroll
    for (int r = 0; r < 4; ++r) {
      const unsigned n = nt * 16 + 4 * g + r;
      s[nt * 4 + r] = __uint_as_float((__float_as_uint(acc[r]) & ~127u) | n);
    }
  }
  float a[16], bq[16];
#pragma unroll
  for (int i = 0; i < 16; ++i) { a[i] = s[i]; bq[i] = s[16 + i]; }
  bitonic_sort_desc<16>(a);
  bitonic_sort_desc<16>(bq);
#pragma unroll
  for (int i = 0; i < 16; ++i) list[i] = vmaxf(a[i], bq[15 - i]);
  bitonic_merge_desc<16>(list);
  rows_merge_top16(list);
}

DI void topk_tile(const bf16_t* QP, const bf16_t* sk, int tt, int hd, int* eid_rows, float* gate_rows, int lr, int g) {
  constexpr PairTab PT = make_pairs();
  {
    const int tok = tt * 16 + lr;
    float v1[16], v2[16];
    topk_half(sk, QP + (size_t)tok * 1024 + hd * 128 + 8 * g, lr, g, v1);
    __builtin_amdgcn_sched_barrier(0);
    topk_half(sk + 128 * 64, QP + (size_t)tok * 1024 + hd * 128 + 64 + 8 * g, lr, g, v2);
    __builtin_amdgcn_sched_barrier(0);
    float cand[13];
#pragma unroll
    for (int c = 0; c < 13; ++c) {
      float sv[4];
#pragma unroll
      for (int gi = 0; gi < 4; ++gi) {
        const int pi = 4 * c + gi;
        if (PT.a[pi] >= 0) {
          const float a = v1[PT.a[pi] < 0 ? 0 : PT.a[pi]], bq = v2[PT.b[pi] < 0 ? 0 : PT.b[pi]];
          sv[gi] = __uint_as_float((__float_as_uint(a + bq) & ~255u) | (unsigned)(PT.a[pi] * 16 + PT.b[pi]));
        } else { sv[gi] = -3.0e38f; }
      }
      cand[c] = g == 0 ? sv[0] : (g == 1 ? sv[1] : (g == 2 ? sv[2] : sv[3]));
    }
    float topv[16];
#pragma unroll
    for (int c = 0; c < 13; ++c) topv[c] = cand[c];
    topv[13] = -3.0e38f; topv[14] = -3.1e38f; topv[15] = -3.2e38f;
    bitonic_sort_desc<16>(topv);
    rows_merge_top16(topv);
#pragma unroll
    for (int q = 0; q < 4; ++q) {
      const float wv = g == 0 ? topv[q] : (g == 1 ? topv[4 + q] : (g == 2 ? topv[8 + q] : topv[12 + q]));
      const int ia = (int)((__float_as_uint(wv) >> 4) & 15u), ib = (int)(__float_as_uint(wv) & 15u);
      unsigned e1 = 0, e2 = 0;
#pragma unroll
      for (int c = 0; c < 16; ++c) { if (ia == c) e1 = __float_as_uint(v1[c]) & 127u; if (ib == c) e2 = __float_as_uint(v2[c]) & 127u; }
      eid_rows[lr * 128 + hd * 16 + 4 * g + q] = (int)(e1 * 128u + e2);
    }
    if (g == 0) {
      float ex[16], sum = 0.f;
#pragma unroll
      for (int k = 0; k < 16; ++k) { ex[k] = __expf(topv[k] - topv[0]); sum += ex[k]; }
      const float inv = 1.f / sum;
#pragma unroll
      for (int q = 0; q < 4; ++q) {
        float4 o = {ex[4 * q] * inv, ex[4 * q + 1] * inv, ex[4 * q + 2] * inv, ex[4 * q + 3] * inv};
        *(float4*)(gate_rows + lr * 128 + hd * 16 + 4 * q) = o;
      }
    }
  }
}

DI float gelu_tanh(float x) {
  const float z = 0.7978845608028654f * (x + 0.044715f * x * x * x);
  const float e = __expf(2.f * z);
  const float th = 1.f - 2.f / (e + 1.f);
  return 0.5f * x * (1.f + th);
}
DI void gather_token(const Params& p, int l, int t, const int* eid_row, const float* gate_row, unsigned char* hl, float* wl, bool dry) {
  const int lane = ltid() & 63, lr = lane & 15, g = lane >> 4;
  const unsigned char* U6 = p.ws + OFF_U + (size_t)l * 16384 * U_PITCH;
  const unsigned char* V6 = p.ws + OFF_V + (size_t)l * 16384 * V_PITCH;
  const int half = lane >> 5, blk = lane & 31;
  const unsigned char* H6 = p.ws + OFF_H8;
  bf16_t* xres = (bf16_t*)(p.ws + OFF_XRES);
  const float* modbuf = (const float*)(p.ws + OFF_MOD);
  {
    if (lane < 50) {
      const u32x4 hq = *(const u32x4*)(H6 + (size_t)t * V6_PITCH + lane * 16);
      *(u32x4*)(hl + lane * 16) = hq;
    }
    const int e0 = eid_row[lane], e1 = eid_row[64 + lane];
    const float gv0 = gate_row[lane], gv1 = gate_row[64 + lane];
    {
      const u32x2 hsc = *(const u32x2*)(hl + 768 + 8 * g);
      u32x2 hq[8][3];
#pragma unroll
      for (int s = 0; s < 8; ++s) { const unsigned char* hb = hl + 24 * (4 * s + g); hq[s][0] = *(const u32x2*)hb; hq[s][1] = *(const u32x2*)(hb + 8); hq[s][2] = *(const u32x2*)(hb + 16); }
#pragma unroll 1
      for (int grp = 0; grp < 8; ++grp) {
        const int er = __shfl(grp < 4 ? e0 : e1, (grp & 3) * 16 + lr);
        const unsigned char* ur = U6 + (size_t)er * U_PITCH;
        u32x4 ua[8]; u32x2 ub[8];
#pragma unroll
        for (int s = 0; s < 8; ++s) {
          if (U_FP4) { ua[s] = *(const u32x4*)(ur + 16 * (4 * s + g)); ub[s] = (u32x2){0u, 0u}; }
          else { ua[s] = *(const u32x4*)(ur + 24 * (4 * s + g)); ub[s] = *(const u32x2*)(ur + 24 * (4 * s + g) + 16); }
        }
        const u32x2 usc = *(const u32x2*)(ur + (U_FP4 ? 512 : 768) + 8 * g);
        __builtin_amdgcn_sched_barrier(0);
        f32x4 acc = {0.f, 0.f, 0.f, 0.f};
#define G_STEP(s, OS, USC, HSC) do { \
          const u32x2 h0 = hq[s][0], h1 = hq[s][1], h2v = hq[s][2]; \
          const i32x8 av = {(int)ua[s][0], (int)ua[s][1], (int)ua[s][2], (int)ua[s][3], (int)ub[s][0], (int)ub[s][1], 0, 0}; \
          const i32x8 bv = {(int)h0[0], (int)h0[1], (int)h1[0], (int)h1[1], (int)h2v[0], (int)h2v[1], 0, 0}; \
          acc = __builtin_amdgcn_mfma_scale_f32_16x16x128_f8f6f4(av, bv, acc, U_FP4 ? 4 : 2, 2, OS, (int)(USC), OS, (int)(HSC)); } while (0)
        G_STEP(0, 0, usc[0], hsc[0]); G_STEP(1, 1, usc[0], hsc[0]); G_STEP(2, 2, usc[0], hsc[0]); G_STEP(3, 3, usc[0], hsc[0]);
        G_STEP(4, 0, usc[1], hsc[1]); G_STEP(5, 1, usc[1], hsc[1]); G_STEP(6, 2, usc[1], hsc[1]); G_STEP(7, 3, usc[1], hsc[1]);
#undef G_STEP
        const float gvs = grp < 4 ? gv0 : gv1;
        const int lb_ = (grp & 3) * 16 + 4 * g;
        float4 wv_;
        wv_.x = __shfl(gvs, lb_) * gelu_tanh(acc[0]); wv_.y = __shfl(gvs, lb_ + 1) * gelu_tanh(acc[1]);
        wv_.z = __shfl(gvs, lb_ + 2) * gelu_tanh(acc[2]); wv_.w = __shfl(gvs, lb_ + 3) * gelu_tanh(acc[3]);
        if (lr == 0) *(float4*)(wl + grp * 16 + 4 * g) = wv_;
        __builtin_amdgcn_sched_barrier(0);
      }
    }
    __builtin_amdgcn_sched_barrier(0);
    float out[32];
#pragma unroll
    for (int i = 0; i < 32; ++i) out[i] = 0.f;
#pragma unroll 1
    for (int grp = 0; grp < 8; ++grp) {
      const int esel = grp < 4 ? e0 : e1;
      const int lb = (grp & 3) * 16;
      u32x4 vd4[8]; u32x2 vd2[8]; unsigned vsc[8];
#pragma unroll
      for (int pp = 0; pp < 8; ++pp) {
        const int ea = __builtin_amdgcn_readlane(esel, lb + 2 * pp), eb = __builtin_amdgcn_readlane(esel, lb + 2 * pp + 1);
        const unsigned char* vr = V6 + (size_t)(half ? eb : ea) * V_PITCH;
        if (V_FP4) { vd4[pp] = *(const u32x4*)(vr + 16 * blk); vd2[pp] = (u32x2){0u, 0u}; vsc[pp] = vr[mx4_scale_pos(blk)]; }
        else { vd4[pp] = *(const u32x4*)(vr + 24 * blk); vd2[pp] = *(const u32x2*)(vr + 24 * blk + 16); vsc[pp] = vr[mx_scale_pos(blk)]; }
      }
      __builtin_amdgcn_sched_barrier(0);
#pragma unroll
      for (int pp = 0; pp < 8; ++pp) {
        const float wgt = wl[grp * 16 + 2 * pp + half] * __uint_as_float(vsc[pp] << 23);
        if (V_FP4) {
          unsigned q0 = vd4[pp][0], q1 = vd4[pp][1], q2 = vd4[pp][2], q3 = vd4[pp][3];
          asm volatile("" : "+v"(q0), "+v"(q1) : "v"(out[0]), "v"(out[1]), "v"(out[2]), "v"(out[3]), "v"(out[4]), "v"(out[5]), "v"(out[6]), "v"(out[7]),
                       "v"(out[8]), "v"(out[9]), "v"(out[10]), "v"(out[11]), "v"(out[12]), "v"(out[13]), "v"(out[14]), "v"(out[15]));
          asm volatile("" : "+v"(q2), "+v"(q3) : "v"(out[16]), "v"(out[17]), "v"(out[18]), "v"(out[19]), "v"(out[20]), "v"(out[21]), "v"(out[22]), "v"(out[23]),
                       "v"(out[24]), "v"(out[25]), "v"(out[26]), "v"(out[27]), "v"(out[28]), "v"(out[29]), "v"(out[30]), "v"(out[31]));
          const u32x4 qd = {q0, q1, q2, q3};
#pragma unroll
          for (int d = 0; d < 4; ++d) {
            const f32x2 t0 = __builtin_amdgcn_cvt_scalef32_pk_f32_fp4(qd[d], 1.0f, 0), t1 = __builtin_amdgcn_cvt_scalef32_pk_f32_fp4(qd[d], 1.0f, 1);
            const f32x2 t2 = __builtin_amdgcn_cvt_scalef32_pk_f32_fp4(qd[d], 1.0f, 2), t3 = __builtin_amdgcn_cvt_scalef32_pk_f32_fp4(qd[d], 1.0f, 3);
            out[8 * d + 0] += wgt * t0[0]; out[8 * d + 1] += wgt * t0[1]; out[8 * d + 2] += wgt * t1[0]; out[8 * d + 3] += wgt * t1[1];
            out[8 * d + 4] += wgt * t2[0]; out[8 * d + 5] += wgt * t2[1]; out[8 * d + 6] += wgt * t3[0]; out[8 * d + 7] += wgt * t3[1];
          }
        } else {
          unsigned pk0 = vd4[pp][0], pk1 = vd4[pp][1];
          asm volatile("" : "+v"(pk0) : "v"(out[0]), "v"(out[1]), "v"(out[2]), "v"(out[3]), "v"(out[4]), "v"(out[5]), "v"(out[6]), "v"(out[7]),
                       "v"(out[8]), "v"(out[9]), "v"(out[10]), "v"(out[11]), "v"(out[12]), "v"(out[13]), "v"(out[14]), "v"(out[15]));
          asm volatile("" : "+v"(pk1) : "v"(out[16]), "v"(out[17]), "v"(out[18]), "v"(out[19]), "v"(out[20]), "v"(out[21]), "v"(out[22]), "v"(out[23]),
                       "v"(out[24]), "v"(out[25]), "v"(out[26]), "v"(out[27]), "v"(out[28]), "v"(out[29]), "v"(out[30]), "v"(out[31]));
          const u32x6 pk = {pk0, pk1, vd4[pp][2], vd4[pp][3], vd2[pp][0], vd2[pp][1]};
          const f32x32 vals = __builtin_amdgcn_cvt_scalef32_pk32_f32_fp6(pk, 1.0f);
  #pragma unroll
          for (int i = 0; i < 32; ++i) out[i] += wgt * vals[i];
        }
        __builtin_amdgcn_sched_barrier(0);
      }
    }
    float o16[16];
#pragma unroll
    for (int i = 0; i < 16; ++i) {
      const u32x2 s0 = __builtin_amdgcn_permlane32_swap(__float_as_uint(out[i]), __float_as_uint(out[i]), false, false);
      const u32x2 s1 = __builtin_amdgcn_permlane32_swap(__float_as_uint(out[16 + i]), __float_as_uint(out[16 + i]), false, false);
      const float t0 = __uint_as_float(s0[0]) + __uint_as_float(s0[1]), t1 = __uint_as_float(s1[0]) + __uint_as_float(s1[1]);
      o16[i] = half ? t1 : t0;
    }
    const int cb = 32 * blk + 16 * half;
    const int b = t < TL ? (t >> 11) : 16;
    const float* md = modbuf + ((size_t)l * 17 + b) * 6144 + 5 * 1024 + cb;
    bf16_t* xr = xres + (size_t)t * 1024 + cb;
    float xn[16];
    float ss = 0.f;
    {
      const u32x4 r0 = *(const u32x4*)xr, r1 = *(const u32x4*)(xr + 8);
      unpack8(r0, xn); unpack8(r1, xn + 8);
    }
    float4 eg[4], esh[4], esc[4];
    if (!dry) {
      if (l == NL - 1) {
#pragma unroll
        for (int q = 0; q < 4; ++q) eg[q] = *(const float4*)(p.final_g + cb + 4 * q);
      } else {
        const float* gvec = p.norm1_g + (l + 1) * 1024 + cb;
        const float* mdn = modbuf + ((size_t)(l + 1) * 17 + b) * 6144 + cb;
#pragma unroll
        for (int q = 0; q < 4; ++q) { eg[q] = *(const float4*)(gvec + 4 * q); esh[q] = *(const float4*)(mdn + 4 * q); esc[q] = *(const float4*)(mdn + 1024 + 4 * q); }
      }
    }
    unsigned xp[8];
#pragma unroll
    for (int q = 0; q < 4; ++q) {
      const float4 m4 = *(const float4*)(md + 4 * q);
      xn[4 * q] += m4.x * o16[4 * q + 0]; xn[4 * q + 1] += m4.y * o16[4 * q + 1]; xn[4 * q + 2] += m4.z * o16[4 * q + 2]; xn[4 * q + 3] += m4.w * o16[4 * q + 3];
      ss += xn[4 * q] * xn[4 * q] + xn[4 * q + 1] * xn[4 * q + 1] + xn[4 * q + 2] * xn[4 * q + 2] + xn[4 * q + 3] * xn[4 * q + 3];
      xp[2 * q] = pk2(xn[4 * q], xn[4 * q + 1]); xp[2 * q + 1] = pk2(xn[4 * q + 2], xn[4 * q + 3]);
    }
    if (dry) asm volatile("" :: "v"(xp[0]), "v"(xp[7]));
    else if (l < NL - 1) { *(u32x4*)xr = (u32x4){xp[0], xp[1], xp[2], xp[3]}; *(u32x4*)(xr + 8) = (u32x4){xp[4], xp[5], xp[6], xp[7]}; }
    if (!dry) {
      ss = wave_sum(ss);
      const float rstd = rsqrtf(ss * (1.f / 1024.f) + 1e-6f);
      if (l == NL - 1) {
        float* orow = p.out + (size_t)t * 1024 + cb;
#pragma unroll
        for (int q = 0; q < 4; ++q) {
          const float4 g4 = eg[q];
          float4 o = {xn[4 * q] * rstd * g4.x, xn[4 * q + 1] * rstd * g4.y, xn[4 * q + 2] * rstd * g4.z, xn[4 * q + 3] * rstd * g4.w};
          *(float4*)(orow + 4 * q) = o;
        }
      } else {
        bf16_t* hrow = (bf16_t*)(p.ws + OFF_H) + (size_t)t * 1024 + cb;
        unsigned pk[8];
#pragma unroll
        for (int q = 0; q < 4; ++q) {
          const float4 g4 = eg[q], sh = esh[q], sc = esc[q];
          const float o0 = xn[4 * q] * rstd * g4.x * (1.f + sc.x) + sh.x, o1 = xn[4 * q + 1] * rstd * g4.y * (1.f + sc.y) + sh.y;
          const float o2 = xn[4 * q + 2] * rstd * g4.z * (1.f + sc.z) + sh.z, o3 = xn[4 * q + 3] * rstd * g4.w * (1.f + sc.w) + sh.w;
          pk[2 * q] = pk2(o0, o1); pk[2 * q + 1] = pk2(o2, o3);
        }
        *(u32x4*)hrow = (u32x4){pk[0], pk[1], pk[2], pk[3]};
        *(u32x4*)(hrow + 8) = (u32x4){pk[4], pk[5], pk[6], pk[7]};
      }
    }
  }
}


DI void phase_topk_gather(const Params& p, int l, int ntok, unsigned* ctr, unsigned char* lds, bool dry = false) {
  const int tid = ltid(), lane = tid & 63, w = tid >> 6, lr = lane & 15, g = lane >> 4;
  const bf16_t* QP = (const bf16_t*)(p.ws + OFF_QP);
  const bf16_t* sk = (const bf16_t*)(p.ws + OFF_SK) + (size_t)l * 2 * 128 * 64;
  int* eid_l = (int*)lds;
  float* gate_l = (float*)(lds + 8192);
  unsigned char* hl = lds + 16384 + w * 2048;
  float* wl = (float*)(hl + 1024);
  volatile int* slot = (volatile int*)(lds + LDS_BYTES - 16);
  const int ntile = ntok / 16;
  for (;;) {
    __syncthreads();
    if (tid == 0) *slot = (int)atomicAdd(ctr, 1u);
    __syncthreads();
    const int tile = *slot;
    if (tile >= ntile) break;
#pragma unroll 1
    for (int hh = 0; hh < 2; ++hh) {
      topk_tile(QP, sk, tile, 2 * w + hh, eid_l, gate_l, lr, g);
      __builtin_amdgcn_sched_barrier(0);
    }
    __syncthreads();
#pragma unroll 1
    for (int q = 0; q < 4; ++q) {
      const int r = 4 * w + q;
      gather_token(p, l, tile * 16 + r, eid_l + r * 128, gate_l + r * 128, hl, wl, dry);
    }
  }
}

DI void phase_final(const Params& p) {
  const int lane = ltid() & 63, gw = lbid() * 4 + (ltid() >> 6), nw = lgdim() * 4;
  const float* xres = (const float*)(p.ws + OFF_XRES);
  for (int t = gw; t < TL; t += nw) {
    const float* src = xres + (size_t)t * 1024;
    float4 v[4];
    float ss = 0.f;
#pragma unroll
    for (int i = 0; i < 4; ++i) {
      v[i] = *(const float4*)(src + 4 * lane + 256 * i);
      ss += v[i].x * v[i].x + v[i].y * v[i].y + v[i].z * v[i].z + v[i].w * v[i].w;
    }
    ss = wave_sum(ss);
    const float rstd = rsqrtf(ss * (1.f / 1024.f) + 1e-6f);
#pragma unroll
    for (int i = 0; i < 4; ++i) {
      const int col = 4 * lane + 256 * i;
      const float4 g4 = *(const float4*)(p.final_g + col);
      float4 o = {v[i].x * rstd * g4.x, v[i].y * rstd * g4.y, v[i].z * rstd * g4.z, v[i].w * rstd * g4.w};
      *(float4*)(p.out + (size_t)t * 1024 + col) = o;
    }
  }
}


#define LAS __attribute__((address_space(3)))
#define XB_TMO      128
#define XB_XCNT(j)  (256  + 64 * (j))
#define XB_XSUB(j)  (1280 + 64 * (j))
#define XB_XGEN(j)  (2304 + 64 * (j))
#define XB_TOP      3328
#define XB_TOPGEN   3392
#define XCD_BAR_WORDS 3456
#define XB_SPIN_CAP (1u << 22)
DI unsigned xb_ld(unsigned* p) { return __hip_atomic_load(p, __ATOMIC_RELAXED, __HIP_MEMORY_SCOPE_AGENT); }
DI unsigned xb_add(unsigned* p, unsigned v) { return __hip_atomic_fetch_add(p, v, __ATOMIC_RELAXED, __HIP_MEMORY_SCOPE_AGENT); }
DI unsigned xb_xcc_id() { return (unsigned)__builtin_amdgcn_s_getreg((3 << 11) | 20) & 0xFu; }
#define XB_SPIN(cond, bar) do { unsigned _sp = 0; while (cond) { __builtin_amdgcn_s_sleep(1); \
    if ((++_sp & 255u) == 0u) { if (xb_ld(&(bar)[XB_TMO])) break; if (_sp > XB_SPIN_CAP) { atomicAdd(&(bar)[XB_TMO], 1u); break; } } } } while (0)
struct XcdBarrier { unsigned* bar; unsigned x; volatile unsigned* st; };
DI XcdBarrier xcd_barrier_post(unsigned* bar, volatile unsigned* st) {
  XcdBarrier b; b.bar = bar; b.x = xb_xcc_id(); b.st = st;
  if (threadIdx.x == 0) (void)xb_add(&bar[XB_XCNT(b.x)], 1u);
  return b;
}
DI void xcd_barrier_complete(unsigned* bar, unsigned x, unsigned& nloc, unsigned& nx) {
  const unsigned G = gridDim.x * gridDim.y * gridDim.z;
  unsigned sum, cnt, mine, sp = 0u;
  for (;;) {
    sum = 0u; cnt = 0u; mine = 0u;
#pragma unroll 1
    for (unsigned j = 0; j < 16; ++j) { const unsigned c = xb_ld(&bar[XB_XCNT(j)]); sum += c; cnt += (c > 0u) ? 1u : 0u; mine = (j == x) ? c : mine; }
    if (sum == G) break;
    __builtin_amdgcn_s_sleep(1);
    if ((++sp & 255u) == 0u) { if (xb_ld(&bar[XB_TMO])) break; if (sp > XB_SPIN_CAP) { atomicAdd(&bar[XB_TMO], 1u); break; } }
  }
  nloc = mine > 0u ? mine : 1u; nx = cnt > 0u ? cnt : 1u;
}
DI void xcd_barrier(const XcdBarrier& b) {
  asm volatile("s_waitcnt vmcnt(0)" ::: "memory");
  __syncthreads();
  if (threadIdx.x == 0) {
    unsigned* bar = b.bar;
    __builtin_amdgcn_s_waitcnt(0);
    unsigned nloc = b.st[0], nx = b.st[1];
    if (nloc == 0u) { xcd_barrier_complete(bar, b.x, nloc, nx); b.st[0] = nloc; b.st[1] = nx; }
    const unsigned old = xb_add(&bar[XB_XSUB(b.x)], 1u);
    const unsigned gen = old / nloc;
    if (old + 1u == (gen + 1u) * nloc) {
      __builtin_amdgcn_s_sleep(64); __builtin_amdgcn_s_sleep(64);
      __builtin_amdgcn_fence(__ATOMIC_RELEASE, "agent");
      asm volatile("s_waitcnt vmcnt(0)" ::: "memory");
      const unsigned og = xb_add(&bar[XB_TOP], 1u);
      const unsigned tg = og / nx;
      if (og + 1u == (tg + 1u) * nx) xb_add(&bar[XB_TOPGEN], 1u);
      else XB_SPIN(xb_ld(&bar[XB_TOPGEN]) == tg, bar);
      __builtin_amdgcn_fence(__ATOMIC_ACQUIRE, "agent");
      xb_add(&bar[XB_XGEN(b.x)], 1u);
      asm volatile("s_waitcnt vmcnt(0)" ::: "memory");
    } else {
      XB_SPIN(xb_ld(&bar[XB_XGEN(b.x)]) == gen, bar);
      __builtin_amdgcn_fence(__ATOMIC_ACQUIRE, "agent");
      asm volatile("s_waitcnt vmcnt(0)" ::: "memory");
    }
  }
  __syncthreads();
}

constexpr int PH_PER_LAYER = 10;
constexpr int N_PHASES = 1 + NL * PH_PER_LAYER + 1;

template <int KIND>
DI void run_phase(const Params& p, int ph, unsigned char* lds) {
  unsigned* ctl = (unsigned*)(p.ws + OFF_CTL);
  if (ph == 0) { if (KIND < 0 || KIND == 0) phase_prologue(p, lds); }
  else if (ph == N_PHASES - 1) { if (KIND < 0 || KIND == 11) phase_final(p); }
  else {
    const int l = (ph - 1) / PH_PER_LAYER, s = (ph - 1) % PH_PER_LAYER;
    const bool last = (l == NL - 1);
    const int ntok = last ? TL : TT;
    if (s == 0) { if (KIND < 0 || KIND == 1) phase_norm(p, l, 0, TT); }
    else if (s == 1) { if (KIND < 0 || KIND == 2) phase_gemm_in(p, l, lds); }
    else if (s == 2) { if (KIND < 0 || KIND == 3) phase_rope(p, lds); }
    else if (s == 3) { if (KIND < 0 || KIND == 4) phase_mixers(p, l, last, ctl + 64 * (1 + l), lds); }
    else if (s == 4) { if (KIND < 0 || KIND == 5) phase_gla_fin(p, l, ntok); }
    else if (s == 5) { if (KIND < 0 || KIND == 6) phase_gemm_out(p, l, ntok, lds); }
    else if (s == 6) { if (KIND < 0 || KIND == 7) phase_norm(p, l, 1, ntok); }
    else if (s == 7) { if (KIND < 0 || KIND == 8) phase_gemm_q(p, l, ntok, lds); }
    else if (s == 8) { }
    else { if (KIND < 0 || KIND == 10) phase_topk_gather(p, l, ntok, (unsigned*)(p.ws + OFF_CTL) + 64 * (8 + l), lds); }
  }
}

#if N_LAUNCH_MODE == 1
#ifndef PROBE_KIND
#define PROBE_KIND -1
#endif
#ifndef GLA_VAR
#define GLA_VAR 0
#endif
constexpr int CW_BAR = 4096;
template <int l>
DI void run_layer(const Params& p, unsigned char* lds) {
  unsigned* ctl = (unsigned*)(p.ws + OFF_CTL);
#define GSYNC() do { XcdBarrier bb; bb.bar = (unsigned*)(p.ws + OFF_CTL) + CW_BAR; bb.x = xb_xcc_id(); bb.st = (volatile unsigned*)(lds + LDS_BYTES - 32); xcd_barrier(bb); } while (0)

    const bool last = (l == NL - 1);
    const int ntok = last ? TL : TT;
    if (l == 0) { { Params q = p; { size_t z_ = 0; asm volatile("" : "+s"(z_)); q.ws = p.ws + z_; } phase_norm(q, l, 0, TT); } GSYNC(); }
    if (PROBE_KIND == 1) { { Params q = p; { size_t z_ = 0; asm volatile("" : "+s"(z_)); q.ws = p.ws + z_; } phase_norm(q, l, 0, TT); } GSYNC(); }
    if (PROBE_KIND == 2) { { Params q = p; { size_t z_ = 0; asm volatile("" : "+s"(z_)); q.ws = p.ws + z_; } phase_gemm_in(q, l, lds, true); } GSYNC(); }
    { Params q = p; { size_t z_ = 0; asm volatile("" : "+s"(z_)); q.ws = p.ws + z_; } phase_gemm_in(q, l, lds); } GSYNC();
    if (PROBE_KIND == 4 || (PROBE_KIND >= 41 && PROBE_KIND <= 47)) { { Params q = p; { size_t z_ = 0; asm volatile("" : "+s"(z_)); q.ws = p.ws + z_; } phase_mixers(q, l, last, ctl + 64 * (1 + l) + 1, lds, PROBE_KIND == 4 ? 15 : PROBE_KIND - 40, GLA_VAR); } GSYNC(); }
    { Params q = p; { size_t z_ = 0; asm volatile("" : "+s"(z_)); q.ws = p.ws + z_; } phase_mixers(q, l, last, ctl + 64 * (1 + l), lds); } GSYNC();
    { Params q = p; { size_t z_ = 0; asm volatile("" : "+s"(z_)); q.ws = p.ws + z_; } phase_gla_fin(q, l, ntok); } GSYNC();
    if (PROBE_KIND == 5) { { Params q = p; { size_t z_ = 0; asm volatile("" : "+s"(z_)); q.ws = p.ws + z_; } phase_gla_fin(q, l, ntok); } GSYNC(); }
    { Params q = p; { size_t z_ = 0; asm volatile("" : "+s"(z_)); q.ws = p.ws + z_; } phase_gemm_out(q, l, ntok, lds); } GSYNC();
    { Params q = p; { size_t z_ = 0; asm volatile("" : "+s"(z_)); q.ws = p.ws + z_; } phase_norm2(q, l, ntok); } GSYNC();
    if (PROBE_KIND == 7) { { Params q = p; { size_t z_ = 0; asm volatile("" : "+s"(z_)); q.ws = p.ws + z_; } phase_norm2(q, l, ntok); } GSYNC(); }
    { Params q = p; { size_t z_ = 0; asm volatile("" : "+s"(z_)); q.ws = p.ws + z_; } phase_gemm_q(q, l, ntok, lds); } GSYNC();
    if (PROBE_KIND == 8) { { Params q = p; { size_t z_ = 0; asm volatile("" : "+s"(z_)); q.ws = p.ws + z_; } phase_gemm_q(q, l, ntok, lds); } GSYNC(); }
    if (PROBE_KIND == 11) { { Params q = p; { size_t z_ = 0; asm volatile("" : "+s"(z_)); q.ws = p.ws + z_; } phase_topk_gather(q, l, ntok, ctl + 64 * (8 + l) + 1, lds, true); } GSYNC(); }
    { Params q = p; { size_t z_ = 0; asm volatile("" : "+s"(z_)); q.ws = p.ws + z_; } phase_topk_gather(q, l, ntok, ctl + 64 * (8 + l), lds); } if (l + 1 < NL) GSYNC();
}
__global__ void __launch_bounds__(256, 2) mk_fwd(Params p) {
  __shared__ __attribute__((aligned(16))) unsigned char lds[LDS_BYTES];
  unsigned* ctl = (unsigned*)(p.ws + OFF_CTL);
  volatile unsigned* st = (volatile unsigned*)(lds + LDS_BYTES - 32);
  if (threadIdx.x < 2) st[threadIdx.x] = 0u;
  __syncthreads();
  (void)xcd_barrier_post(ctl + CW_BAR, st);
#define GSYNC() do { XcdBarrier bb; bb.bar = (unsigned*)(p.ws + OFF_CTL) + CW_BAR; bb.x = xb_xcc_id(); bb.st = (volatile unsigned*)(lds + LDS_BYTES - 32); xcd_barrier(bb); } while (0)
  { Params q = p; { size_t z_ = 0; asm volatile("" : "+s"(z_)); q.ws = p.ws + z_; } phase_prologue(q, lds); } cg::this_grid().sync(); GSYNC();
  if (PROBE_KIND == 0) { { Params q = p; { size_t z_ = 0; asm volatile("" : "+s"(z_)); q.ws = p.ws + z_; } phase_prologue(q, lds); } GSYNC(); }
  run_layer<0>(p, lds); run_layer<1>(p, lds); run_layer<2>(p, lds); run_layer<3>(p, lds);
}
#else
template <int KIND>
__global__ void __launch_bounds__(256, 2) mk_phase(Params p) {
  __shared__ __attribute__((aligned(16))) unsigned char lds[LDS_BYTES];
  run_phase<KIND>(p, p.ph_lo, lds);
}
#endif

extern "C" void kernel_launch(void* const* d_in, const int* in_sizes, int n_in, void* d_out, int out_size, void* d_ws,
                              size_t ws_size, hipStream_t stream) {
  static int grid = 0;
  if (grid == 0) {
    if (n_in != 21 || ws_size < WS_END || out_size != TL * DM) { fprintf(stderr, "kernel_launch: unexpected shapes (n_in %d ws %zu out %d)\n", n_in, ws_size, out_size); grid = -1; return; }
    int dev = 0, cus = 0, per_cu = 2;
    (void)hipGetDevice(&dev);
    (void)hipDeviceGetAttribute(&cus, hipDeviceAttributeMultiprocessorCount, dev);
#if N_LAUNCH_MODE == 1
    (void)hipOccupancyMaxActiveBlocksPerMultiprocessor(&per_cu, (const void*)mk_fwd, 256, 0);
    if (per_cu < 1) per_cu = 1;
    if (per_cu > 2) per_cu = 2;
#endif
    grid = cus * per_cu;
  }
  if (grid < 0) return;
  (void)hipMemsetAsync((char*)d_ws + OFF_CTL, 0, 65536, stream);
  Params p{};
  const float** pp = (const float**)&p;
  for (int i = 0; i < 21; ++i) pp[i] = (const float*)d_in[i];
  p.out = (float*)d_out;
  p.ws = (unsigned char*)d_ws;
#if N_LAUNCH_MODE == 1
  p.ph_lo = 0; p.ph_hi = N_PHASES;
  void* args[] = {&p};
  hipError_t e = hipLaunchCooperativeKernel((const void*)mk_fwd, dim3(grid), dim3(256), args, 0, stream);
  if (e != hipSuccess) fprintf(stderr, "cooperative launch failed: %s (grid %d)\n", hipGetErrorString(e), grid);
#else
  for (int ph = 0; ph < N_PHASES; ++ph) {
    p.ph_lo = ph; p.ph_hi = ph + 1;
    const int kind = ph == 0 ? 0 : (ph == N_PHASES - 1 ? 11 : 1 + (ph - 1) % PH_PER_LAYER);
    switch (kind) {
      case 0: hipLaunchKernelGGL(mk_phase<0>, dim3(grid), dim3(256), 0, stream, p); break;
      case 1: hipLaunchKernelGGL(mk_phase<1>, dim3(grid), dim3(256), 0, stream, p); break;
      case 2: hipLaunchKernelGGL(mk_phase<2>, dim3(grid), dim3(256), 0, stream, p); break;
      case 3: hipLaunchKernelGGL(mk_phase<3>, dim3(grid), dim3(256), 0, stream, p); break;
      case 4: hipLaunchKernelGGL(mk_phase<4>, dim3(grid), dim3(256), 0, stream, p); break;
      case 5: hipLaunchKernelGGL(mk_phase<5>, dim3(grid), dim3(256), 0, stream, p); break;
      case 6: hipLaunchKernelGGL(mk_phase<6>, dim3(grid), dim3(256), 0, stream, p); break;
      case 7: hipLaunchKernelGGL(mk_phase<7>, dim3(grid), dim3(256), 0, stream, p); break;
      case 8: hipLaunchKernelGGL(mk_phase<8>, dim3(grid), dim3(256), 0, stream, p); break;
      case 9: hipLaunchKernelGGL(mk_phase<9>, dim3(grid), dim3(256), 0, stream, p); break;
      case 10: hipLaunchKernelGGL(mk_phase<10>, dim3(grid), dim3(256), 0, stream, p); break;
      default: hipLaunchKernelGGL(mk_phase<11>, dim3(grid), dim3(256), 0, stream, p); break;
    }
  }
#endif
}
```
